# Optimizing an MI355X kernel written in HIP

```python
import math
import jax, jax.numpy as jnp
from jax import lax
import numpy as np

D_MODEL = 1024
BATCH = 2
SEQ = 8192
DEPTH = 2

CHUNK = 64
D_FF = 2816
MIX_W = 256
N_BRANCH = 4
S5_GROUPS = 16
S5_GROUP_CH = MIX_W // S5_GROUPS
S5_STATE = 64
POOL_WINDOWS = (2, 4, 8, 16)
POOL_GROUP_CH = MIX_W // len(POOL_WINDOWS)
RW_HEAD = 64
RW_HEADS = MIX_W // RW_HEAD
RW_W_RANK = 64
RW_A_RANK = 64
RW_G_RANK = 128
RW_GN_EPS = 64e-5
CONV_W = 3
NORM_EPS = 1e-6
SPLIT_POINTS = tuple(MIX_W * i for i in range(1, 9))
IN_WIDTH = 8 * MIX_W + N_BRANCH * D_MODEL

kernel_name = 'hybrid_gated_s5_pool_rwkv7_shortconv_macaron'


def rmsnorm(x, g):
    x32 = x.astype(jnp.float32)
    y = x32 * lax.rsqrt(jnp.mean(x32 * x32, axis=-1, keepdims=True) + NORM_EPS)
    return (y * g.astype(jnp.float32)).astype(x.dtype)


def swiglu(h, w_gate, w_up, w_down):
    return (jax.nn.silu(h @ w_gate) * (h @ w_up)) @ w_down


def shift1(z):
    return jnp.pad(z, ((0, 0), (1, 0), (0, 0)))[:, :-1]


def cmul(ar, ai, br, bi):
    return ar * br - ai * bi, ar * bi + ai * br


def _linrec_combine(e1, e2):
    a1r, a1i, b1r, b1i = e1
    a2r, a2i, b2r, b2i = e2
    ar, ai = cmul(a2r, a2i, a1r, a1i)
    br, bi = cmul(a2r, a2i, b1r, b1i)
    return ar, ai, br + b2r, bi + b2i


def s5_mixer(u, lam_re, lam_im, log_dt, b_re, b_im, c_re, c_im, d, w_glu):
    f32 = jnp.float32
    bsz, s, _ = u.shape
    n_chunk = s // CHUNK
    u32 = u.astype(f32).reshape(bsz, n_chunk, CHUNK, S5_GROUPS, S5_GROUP_CH)
    lr = lam_re.astype(f32)
    li = lam_im.astype(f32)
    dt = jnp.exp(log_dt.astype(f32))[:, None]
    mag = jnp.exp(lr * dt)
    abar_re, abar_im = mag * jnp.cos(li * dt), mag * jnp.sin(li * dt)
    inv = 1.0 / (lr * lr + li * li)
    coef_re, coef_im = cmul(abar_re - 1.0, abar_im, lr * inv, -li * inv)
    bb_re, bb_im = cmul(coef_re[..., None], coef_im[..., None],
                        b_re.astype(f32), b_im.astype(f32))
    bu_re = jnp.einsum('bncgh,gph->bncgp', u32, bb_re)
    bu_im = jnp.einsum('bncgh,gph->bncgp', u32, bb_im)
    a_re = jnp.broadcast_to(abar_re, bu_re.shape)
    a_im = jnp.broadcast_to(abar_im, bu_im.shape)
    pw_re, pw_im, hl_re, hl_im = lax.associative_scan(
        _linrec_combine, (a_re, a_im, bu_re, bu_im), axis=2)
    _, _, he_re, he_im = lax.associative_scan(
        _linrec_combine,
        (pw_re[:, :, -1], pw_im[:, :, -1], hl_re[:, :, -1], hl_im[:, :, -1]), axis=1)
    pad = ((0, 0), (1, 0), (0, 0), (0, 0))
    prev_re = jnp.pad(he_re, pad)[:, :-1][:, :, None]
    prev_im = jnp.pad(he_im, pad)[:, :-1][:, :, None]
    cr, ci = cmul(pw_re, pw_im, prev_re, prev_im)
    h_re, h_im = hl_re + cr, hl_im + ci
    y = (jnp.einsum('bncgp,ghp->bncgh', h_re, c_re.astype(f32))
         - jnp.einsum('bncgp,ghp->bncgh', h_im, c_im.astype(f32)))
    y = y.reshape(bsz, s, MIX_W) + d.astype(f32) * u32.reshape(bsz, s, MIX_W)
    g = jax.nn.gelu(y)
    out = g * jax.nn.sigmoid(g @ w_glu.astype(f32))
    return out.astype(u.dtype)


def pool_mixer(u, w, scale):
    f32 = jnp.float32
    bsz, s, _ = u.shape
    u32 = u.astype(f32)
    cs = jnp.cumsum(u32, axis=1)
    t = jnp.arange(1, s + 1, dtype=f32)[None, :, None]
    outs = []
    for gi, win in enumerate(POOL_WINDOWS):
        sl = slice(gi * POOL_GROUP_CH, (gi + 1) * POOL_GROUP_CH)
        c = cs[..., sl]
        lagged = jnp.pad(c, ((0, 0), (win, 0), (0, 0)))[:, :s]
        mean = (c - lagged) / jnp.minimum(t, float(win))
        outs.append(mean - u32[..., sl])
    pooled = jnp.stack(outs, axis=2)
    y = jnp.einsum('bsgc,gcd->bsgd', pooled, w.astype(f32)).reshape(bsz, s, MIX_W)
    return (y * scale.astype(f32)).astype(u.dtype)


def rwkv7_mixer(h, r_p, k_p, v_p, mu_rkv, mu_wag, w0, w1, w2, a0, a1, a2,
                g1, g2, k_k, k_a, r_k, ln_w, ln_b):
    f32 = jnp.float32
    bsz, s, _ = r_p.shape
    r = r_p + (shift1(r_p) - r_p) * mu_rkv[0]
    k = k_p + (shift1(k_p) - k_p) * mu_rkv[1]
    v = v_p + (shift1(v_p) - v_p) * mu_rkv[2]
    hx = shift1(h) - h
    xw = h + hx * mu_wag[0]
    xa = h + hx * mu_wag[1]
    xg = h + hx * mu_wag[2]
    w_log = -jax.nn.softplus(-(w0 + jnp.tanh(xw @ w1) @ w2)) - 0.5
    decay = jnp.exp(-jnp.exp(w_log.astype(f32)))
    a = jax.nn.sigmoid((a0 + (xa @ a1) @ a2).astype(f32))
    g = jax.nn.sigmoid(xg @ g1) @ g2
    k32 = k.astype(f32)
    kk = (k32 * k_k.astype(f32)).reshape(bsz, s, RW_HEADS, RW_HEAD)
    kk = kk / jnp.maximum(jnp.sqrt(jnp.sum(kk * kk, -1, keepdims=True)), 1e-12)
    k32 = k32 * (1.0 + (a - 1.0) * k_a.astype(f32))

    def heads(z):
        return z.astype(f32).reshape(bsz, s, RW_HEADS, RW_HEAD)

    rh, kh, vh = heads(r), heads(k32), heads(v)
    kka = kk * heads(a)
    tm = lambda z: jnp.transpose(z, (1, 0, 2, 3))
    xs = (tm(rh), tm(heads(decay)), tm(kh), tm(vh), tm(kk), tm(kka))

    def step(state, inp):
        r_t, w_t, k_t, v_t, kk_t, b_t = inp
        sa = jnp.einsum('bhvk,bhk->bhv', state, -kk_t)
        state = (state * w_t[:, :, None, :] + sa[..., None] * b_t[:, :, None, :]
                 + v_t[..., None] * k_t[:, :, None, :])
        return state, jnp.einsum('bhvk,bhk->bhv', state, r_t)

    state0 = jnp.zeros((bsz, RW_HEADS, RW_HEAD, RW_HEAD), f32)
    _, o = lax.scan(step, state0, xs)
    o = jnp.transpose(o, (1, 0, 2, 3))
    mu = jnp.mean(o, -1, keepdims=True)
    var = jnp.mean(jnp.square(o - mu), -1, keepdims=True)
    o = ((o - mu) * lax.rsqrt(var + RW_GN_EPS)).reshape(bsz, s, MIX_W)
    o = o * ln_w.astype(f32) + ln_b.astype(f32)
    bonus = jnp.sum(rh * kh * r_k.astype(f32), -1, keepdims=True) * vh
    out = (o + bonus.reshape(bsz, s, MIX_W)) * g.astype(f32)
    return out.astype(h.dtype)


def short_conv_mixer(z_in, b_g, c_g, conv_w):
    z = c_g * z_in
    y = lax.conv_general_dilated(
        z, conv_w.astype(z.dtype)[:, None, :], window_strides=(1,),
        padding=((CONV_W - 1, 0),), dimension_numbers=('NWC', 'WIO', 'NWC'),
        feature_group_count=MIX_W)
    return b_g * y


def setup_inputs(seed: int = 0) -> dict:
    key = jax.random.key(seed)
    ks = iter(jax.random.split(key, 48))
    f32 = jnp.float32
    L, D, F = DEPTH, D_MODEL, D_FF
    G, P, H = S5_GROUPS, S5_STATE, S5_GROUP_CH

    def nrm(shape, scale):
        return jax.random.normal(next(ks), shape, f32) * scale

    def gain(shape):
        return 1.0 + nrm(shape, 0.02)

    def unif(shape, lo, hi):
        return jax.random.uniform(next(ks), shape, f32, lo, hi)

    inp = {}
    inp['x'] = nrm((BATCH, SEQ, D), 1.0)
    inp['ffn1_norm'] = gain((L, D))
    inp['ffn1_w_gate'] = nrm((L, D, F), D ** -0.5)
    inp['ffn1_w_up'] = nrm((L, D, F), D ** -0.5)
    inp['ffn1_w_down'] = nrm((L, F, D), F ** -0.5)
    inp['mix_norm'] = gain((L, D))
    inp['w_in'] = nrm((L, D, IN_WIDTH), D ** -0.5)
    inp['s5_lambda_re'] = -0.5 + nrm((L, G, P), 0.01)
    inp['s5_lambda_im'] = math.pi * jnp.arange(P, dtype=f32)[None, None, :] + nrm((L, G, P), 0.01)
    inp['s5_log_dt'] = unif((L, G), math.log(1e-3), math.log(1e-1))
    inp['s5_b_re'] = nrm((L, G, P, H), (2.0 * H) ** -0.5)
    inp['s5_b_im'] = nrm((L, G, P, H), (2.0 * H) ** -0.5)
    inp['s5_c_re'] = nrm((L, G, H, P), P ** -0.5)
    inp['s5_c_im'] = nrm((L, G, H, P), P ** -0.5)
    inp['s5_d'] = nrm((L, MIX_W), 1.0)
    inp['s5_w_glu'] = nrm((L, MIX_W, MIX_W), MIX_W ** -0.5)
    inp['pool_w'] = nrm((L, len(POOL_WINDOWS), POOL_GROUP_CH, POOL_GROUP_CH), POOL_GROUP_CH ** -0.5)
    inp['pool_scale'] = 1.0 + nrm((L, MIX_W), 0.1)
    inp['rwkv_mu_rkv'] = unif((L, 3, MIX_W), 0.0, 1.0)
    inp['rwkv_mu_wag'] = unif((L, 3, D), 0.0, 1.0)
    inp['rwkv_w0'] = jnp.linspace(-6.5, -1.5, MIX_W, dtype=f32)[None, :] + nrm((L, MIX_W), 0.1)
    inp['rwkv_w1'] = nrm((L, D, RW_W_RANK), D ** -0.5)
    inp['rwkv_w2'] = nrm((L, RW_W_RANK, MIX_W), 0.1 * RW_W_RANK ** -0.5)
    inp['rwkv_a0'] = nrm((L, MIX_W), 0.1)
    inp['rwkv_a1'] = nrm((L, D, RW_A_RANK), D ** -0.5)
    inp['rwkv_a2'] = nrm((L, RW_A_RANK, MIX_W), 0.5 * RW_A_RANK ** -0.5)
    inp['rwkv_g1'] = nrm((L, D, RW_G_RANK), D ** -0.5)
    inp['rwkv_g2'] = nrm((L, RW_G_RANK, MIX_W), RW_G_RANK ** -0.5)
    inp['rwkv_k_k'] = 0.85 + nrm((L, MIX_W), 0.02)
    inp['rwkv_k_a'] = gain((L, MIX_W))
    inp['rwkv_r_k'] = nrm((L, RW_HEADS, RW_HEAD), 0.1)
    inp['rwkv_ln_w'] = gain((L, MIX_W))
    inp['rwkv_ln_b'] = nrm((L, MIX_W), 0.02)
    inp['conv_w'] = nrm((L, CONV_W, MIX_W), CONV_W ** -0.5)
    inp['w_branch'] = nrm((L, N_BRANCH, MIX_W, D), MIX_W ** -0.5)
    inp['w_out'] = nrm((L, D, D), D ** -0.5)
    inp['ffn2_norm'] = gain((L, D))
    inp['ffn2_w_gate'] = nrm((L, D, F), D ** -0.5)
    inp['ffn2_w_up'] = nrm((L, D, F), D ** -0.5)
    inp['ffn2_w_down'] = nrm((L, F, D), F ** -0.5)
    inp['final_norm'] = gain((D,))
    return inp


def reference(x, ffn1_norm, ffn1_w_gate, ffn1_w_up, ffn1_w_down, mix_norm, w_in,
              s5_lambda_re, s5_lambda_im, s5_log_dt, s5_b_re, s5_b_im, s5_c_re, s5_c_im,
              s5_d, s5_w_glu, pool_w, pool_scale, rwkv_mu_rkv, rwkv_mu_wag, rwkv_w0,
              rwkv_w1, rwkv_w2, rwkv_a0, rwkv_a1, rwkv_a2, rwkv_g1, rwkv_g2, rwkv_k_k,
              rwkv_k_a, rwkv_r_k, rwkv_ln_w, rwkv_ln_b, conv_w, w_branch, w_out,
              ffn2_norm, ffn2_w_gate, ffn2_w_up, ffn2_w_down, final_norm):
    bsz, s, _ = x.shape
    for l in range(DEPTH):
        x = x + 0.5 * swiglu(rmsnorm(x, ffn1_norm[l]), ffn1_w_gate[l], ffn1_w_up[l], ffn1_w_down[l])
        h = rmsnorm(x, mix_norm[l])
        p = h @ w_in[l]
        u_a, u_b, r_p, k_p, v_p, z_in, b_g, c_g, gate_pre = jnp.split(p, SPLIT_POINTS, axis=-1)
        y_a = s5_mixer(u_a, s5_lambda_re[l], s5_lambda_im[l], s5_log_dt[l], s5_b_re[l],
                       s5_b_im[l], s5_c_re[l], s5_c_im[l], s5_d[l], s5_w_glu[l])
        y_b = pool_mixer(u_b, pool_w[l], pool_scale[l])
        y_c = rwkv7_mixer(h, r_p, k_p, v_p, rwkv_mu_rkv[l], rwkv_mu_wag[l], rwkv_w0[l],
                          rwkv_w1[l], rwkv_w2[l], rwkv_a0[l], rwkv_a1[l], rwkv_a2[l],
                          rwkv_g1[l], rwkv_g2[l], rwkv_k_k[l], rwkv_k_a[l], rwkv_r_k[l],
                          rwkv_ln_w[l], rwkv_ln_b[l])
        y_d = short_conv_mixer(z_in, b_g, c_g, conv_w[l])
        ys = jnp.stack([y_a, y_b, y_c, y_d], axis=2)
        branches = jnp.einsum('bsgc,gcd->bsgd', ys, w_branch[l])
        gates = jax.nn.sigmoid(gate_pre.reshape(bsz, s, N_BRANCH, D_MODEL))
        merged = jnp.sum(branches * gates, axis=2)
        x = x + merged @ w_out[l]
        x = x + 0.5 * swiglu(rmsnorm(x, ffn2_norm[l]), ffn2_w_gate[l], ffn2_w_up[l], ffn2_w_down[l])
    return rmsnorm(x, final_norm)
```

```cpp
#include <hip/hip_runtime.h>
#include <hip/hip_cooperative_groups.h>
#include <cstdio>
#include <cstdint>
#include <cstddef>
namespace cg = cooperative_groups;
namespace pg8 {
#define PG8_LAS __attribute__((address_space(3)))
typedef unsigned short bf16_t;
typedef short bf16x8 __attribute__((ext_vector_type(8)));
typedef float f32x4 __attribute__((ext_vector_type(4)));
typedef unsigned u32x4 __attribute__((ext_vector_type(4)));
constexpr int BM = 256, BK = 64, HALF = 128, HTB = HALF * BK * 2  , STAGE_BYTES = 8 * HTB, NXCD = 8, WGM = 8;

__host__ __device__ __forceinline__ int lds_byte(int r, int c) { const int st = (r >> 4) * 2 + (c >> 5), rr = r & 15, cc = c & 31, ob = rr * 64 + cc * 2; return st * 1024 + (ob ^ (((ob >> 9) & 1) << 5)); }
__host__ __device__ __forceinline__ void stage_rc(int b, int& R, int& C) { const int st = b / 1024, sb = b % 1024, swz = sb ^ (((sb >> 9) & 1) << 5); R = (st >> 1) * 16 + swz / 64; C = (st & 1) * 32 + (swz % 64) / 2; }
__host__ __device__ __forceinline__ int perm32(int rho) { const int n = rho >> 4, i = rho & 15; return 8 * (i >> 2) + 4 * n + (i & 3); }

struct Unit { int pm, pn, g; };
struct Gemm { const bf16_t* A; const bf16_t* Bt; int M, N, K, nseg; };

struct StaticOrder {
    int nM, nN, nwg, G, c;
    __host__ __device__ void init(int M, int N, int G_, int c_) { nM = M / BM; nN = N / BM; nwg = nM * nN; G = G_; c = c_; }
    __host__ __device__ bool next(int i, Unit& u) const {
        const long L = (long)i * G + c; if (L >= nwg) return false;
        int wgid = (int)L; { const int q = nwg / NXCD, r = nwg % NXCD, xcd = wgid % NXCD, off = wgid / NXCD; wgid = (xcd < r ? xcd * (q + 1) : r * (q + 1) + (xcd - r) * q) + off; }
        const int nig = WGM * nN, gid = wgid / nig, fm = gid * WGM, gsz = (nM - fm) < WGM ? (nM - fm) : WGM;
        u.pm = fm + ((wgid % nig) % gsz); u.pn = (wgid % nig) / gsz; u.g = 0; return true;
    }
    __device__ __forceinline__ void a_ready(const Unit&) const {}
    __device__ __forceinline__ void done(const Unit&) const {}
};


struct SegOrder4 {
    StaticOrder so;
    __host__ __device__ bool next(int i, Unit& u) const { if (!so.next(i >> 2, u)) return false; u.g = i & 3; return true; }
    __device__ __forceinline__ void a_ready(const Unit&) const {}
    __device__ __forceinline__ void done(const Unit&) const {}
};

typedef _Float16 h16;
typedef _Float16 h16x4 __attribute__((ext_vector_type(4)));
typedef unsigned u32x2 __attribute__((ext_vector_type(2)));
__device__ __forceinline__ unsigned cvt_pk_bf16(float lo, float hi) { unsigned r; asm volatile("v_cvt_pk_bf16_f32 %0, %1, %2" : "=v"(r) : "v"(lo), "v"(hi)); return r; }
__device__ __forceinline__ u32x2 pack_bf16x4(f32x4 v) { u32x2 w; w.x = cvt_pk_bf16(v[0], v[1]); w.y = cvt_pk_bf16(v[2], v[3]); return w; }
__device__ __forceinline__ h16x4 pack_h16x4(f32x4 v) { h16x4 w; w[0] = (h16)v[0]; w[1] = (h16)v[1]; w[2] = (h16)v[2]; w[3] = (h16)v[3]; return w; }
__device__ __forceinline__ float fast_sigmoid(float x) { return __builtin_amdgcn_rcpf(1.0f + __expf(-x)); }
__device__ __forceinline__ float row_rstd(const float* SS, int row) {
    const f32x4* p = (const f32x4*)(SS + (size_t)row * 16);
    const f32x4 a = p[0], b = p[1], c = p[2], d = p[3];
    const float s = ((a[0] + a[1]) + (a[2] + a[3])) + ((b[0] + b[1]) + (b[2] + b[3])) + ((c[0] + c[1]) + (c[2] + c[3])) + ((d[0] + d[1]) + (d[2] + d[3]));
    return rsqrtf(s * (1.0f / 1024.0f) + 1e-6f);
}

struct EpiGU {
    static constexpr bool PERM = true, KSEG = false;
    bf16_t* hid; const float* SS;
    __device__ __forceinline__ void operator()(const f32x4 (&acc)[2][2][4][2], const Unit& u, int wr, int wc, int fr, int fq) const {
        int row0 = u.pm * BM + wr * 64 + fr; asm volatile("" : "+v"(row0)); const int j0 = u.pn * 128 + wc * 16 + fq * 4;
#pragma unroll
        for (int ai = 0; ai < 2; ++ai)
#pragma unroll
            for (int m = 0; m < 4; ++m) { const int row = row0 + ai * HALF + m * 16; const float rs = row_rstd(SS, row);
#pragma unroll
                for (int bj = 0; bj < 2; ++bj) { const f32x4 g = acc[ai][bj][m][0] * rs, up = acc[ai][bj][m][1] * rs; f32x4 h;
#pragma unroll
                    for (int i = 0; i < 4; ++i) h[i] = g[i] * fast_sigmoid(g[i]) * up[i];
                    *(u32x2*)(hid + (size_t)row * 2816 + j0 + bj * 64) = pack_bf16x4(h); } }
    }
};
struct EpiDown {
    static constexpr bool PERM = false, KSEG = false;
    const float* res; float* X; bf16_t* xb; float* SS; float alpha;
    __device__ __forceinline__ void operator()(const f32x4 (&acc)[2][2][4][2], const Unit& u, int wr, int wc, int fr, int fq) const {
        int row0 = u.pm * BM + wr * 64 + fr; asm volatile("" : "+v"(row0)); const int c0 = u.pn * BM + wc * 32 + fq * 4;
#pragma unroll
        for (int ai = 0; ai < 2; ++ai)
#pragma unroll
            for (int m = 0; m < 4; ++m) { const int row = row0 + ai * HALF + m * 16; float ss = 0.f;
#pragma unroll
                for (int bj = 0; bj < 2; ++bj)
#pragma unroll
                    for (int n = 0; n < 2; ++n) { const size_t off = (size_t)row * 1024 + c0 + bj * HALF + n * 16;
                        const f32x4 r = *(const f32x4*)(res + off); const f32x4 o = r + acc[ai][bj][m][n] * alpha;
                        *(f32x4*)(X + off) = o; *(u32x2*)(xb + off) = pack_bf16x4(o);
                        ss += (o[0] * o[0] + o[1] * o[1]) + (o[2] * o[2] + o[3] * o[3]); }
                ss += __shfl_xor(ss, 16); ss += __shfl_xor(ss, 32);
                if (fq == 0) SS[(size_t)row * 16 + u.pn * 4 + wc] = ss;
                asm volatile("" ::: "memory"); }
    }
};
struct EpiInA {
    static constexpr bool PERM = false, KSEG = false;
    h16* U5; h16* PP; h16* L16; const float* SS;
    __device__ __forceinline__ void operator()(const f32x4 (&acc)[2][2][4][2], const Unit& u, int wr, int wc, int fr, int fq) const {
        int row0 = u.pm * BM + wr * 64 + fr; asm volatile("" : "+v"(row0)); const int cl = wc * 32 + fq * 4;
        h16* base; int ld, cb;
        if (u.pn == 0) { base = U5; ld = 256; cb = 0; } else if (u.pn < 8) { base = PP; ld = 1792; cb = (u.pn - 1) * 256; } else { base = L16; ld = 512; cb = (u.pn - 8) * 256; }
#pragma unroll
        for (int ai = 0; ai < 2; ++ai)
#pragma unroll
            for (int m = 0; m < 4; ++m) { const int row = row0 + ai * HALF + m * 16; const float rs = row_rstd(SS, row);
#pragma unroll
                for (int bj = 0; bj < 2; ++bj)
#pragma unroll
                    for (int n = 0; n < 2; ++n) *(h16x4*)(base + (size_t)row * ld + cb + cl + bj * HALF + n * 16) = pack_h16x4(acc[ai][bj][m][n] * rs); }
    }
};
struct EpiGate {
    static constexpr bool PERM = false, KSEG = false;
    h16* R; const float* SS;
    __device__ __forceinline__ void operator()(const f32x4 (&acc)[2][2][4][2], const Unit& u, int wr, int wc, int fr, int fq) const {
        int row0 = u.pm * BM + wr * 64 + fr; asm volatile("" : "+v"(row0)); const int d0 = 256 * (u.pn >> 2) + 128 * ((u.pn >> 1) & 1) + 16 * (u.pn & 1) + 32 * wc + 4 * fq;
#pragma unroll
        for (int ai = 0; ai < 2; ++ai)
#pragma unroll
            for (int m = 0; m < 4; ++m) { const int row = row0 + ai * HALF + m * 16; const float rs = row_rstd(SS, row);
                f32x4 e[4];
#pragma unroll
                for (int g = 0; g < 4; ++g)
#pragma unroll
                    for (int i = 0; i < 4; ++i) e[g][i] = 1.0f + __expf(-fminf(fmaxf(acc[ai][g >> 1][m][g & 1][i] * rs, -10.f), 30.f));
                f32x4 r[4];
#pragma unroll
                for (int i = 0; i < 4; ++i) { const float i0 = __builtin_amdgcn_rcpf(e[0][i]), i1 = __builtin_amdgcn_rcpf(e[1][i]), i2 = __builtin_amdgcn_rcpf(e[2][i]), i3 = __builtin_amdgcn_rcpf(e[3][i]);
                    r[0][i] = e[1][i] * i0; r[1][i] = e[2][i] * i1; r[2][i] = e[3][i] * i2; r[3][i] = i3; }
#pragma unroll
                for (int g = 0; g < 4; ++g) *(h16x4*)(R + ((size_t)row * 4 + g) * 1024 + d0) = pack_h16x4(r[g]); }
    }
};
struct EpiBranch {
    static constexpr bool PERM = false, KSEG = true;
    const h16* R; bf16_t* out;
    __device__ __forceinline__ void operator()(f32x4 (&acc)[2][2][4][2], const Unit& u, int wr, int wc, int fr, int fq) const {
        unsigned q0 = (unsigned)(u.pm * BM + wr * 64 + fr) * 1024u + (unsigned)(u.pn * BM + wc * 32 + fq * 4); asm volatile("" : "+v"(q0));
        const unsigned r0 = (q0 - (q0 & 1023u)) * 4u + (unsigned)u.g * 1024u + (q0 & 1023u);
        const bool last = u.g == 3;
#pragma unroll
        for (int ai = 0; ai < 2; ++ai)
#pragma unroll
            for (int m = 0; m < 4; ++m) {
#pragma unroll
                for (int bj = 0; bj < 2; ++bj)
#pragma unroll
                    for (int n = 0; n < 2; ++n) { const unsigned off = q0 + (unsigned)((ai * HALF + m * 16) * 1024 + bj * HALF + n * 16);
                        const h16x4 r = *(const h16x4*)(R + (r0 + (unsigned)((ai * HALF + m * 16) * 4096 + bj * HALF + n * 16)));
                        f32x4 rf; rf[0] = (float)r[0]; rf[1] = (float)r[1]; rf[2] = (float)r[2]; rf[3] = (float)r[3];
                        acc[ai][bj][m][n] = acc[ai][bj][m][n] * rf;
                        if (last) *(u32x2*)(out + off) = pack_bf16x4(acc[ai][bj][m][n]); }
                asm volatile("" ::: "memory"); }
    }
};
struct EpiGlu {
    static constexpr bool PERM = false, KSEG = false;
    const bf16_t* gl; bf16_t* ys;
    __device__ __forceinline__ void operator()(const f32x4 (&acc)[2][2][4][2], const Unit& u, int wr, int wc, int fr, int fq) const {
        int row0 = u.pm * BM + wr * 64 + fr; asm volatile("" : "+v"(row0)); const int c0 = wc * 32 + fq * 4;
#pragma unroll
        for (int ai = 0; ai < 2; ++ai)
#pragma unroll
            for (int m = 0; m < 4; ++m) { const int row = row0 + ai * HALF + m * 16;
#pragma unroll
                for (int bj = 0; bj < 2; ++bj)
#pragma unroll
                    for (int n = 0; n < 2; ++n) { const int c = c0 + bj * HALF + n * 16; const u32x2 gv = *(const u32x2*)(gl + (size_t)row * 256 + c);
                        f32x4 g; g[0] = __uint_as_float(gv.x << 16); g[1] = __uint_as_float(gv.x & 0xffff0000u); g[2] = __uint_as_float(gv.y << 16); g[3] = __uint_as_float(gv.y & 0xffff0000u);
                        f32x4 o;
#pragma unroll
                        for (int i = 0; i < 4; ++i) o[i] = g[i] * fast_sigmoid(acc[ai][bj][m][n][i]);
                        *(u32x2*)(ys + (size_t)row * 1024 + c) = pack_bf16x4(o); }
                asm volatile("" ::: "memory"); }
    }
};

template <class Epi, class Sched, bool ALIGN_EPI = false, bool SP2 = false>
__device__ __forceinline__ void gemm_phase(PG8_LAS unsigned char* lds, const Gemm g, const Sched& S, const Epi& E, const int tid) {
    const int wid = __builtin_amdgcn_readfirstlane(tid >> 6), lane = tid & 63, wr = wid >> 2, wc = wid & 3, fr = lane & 15, fq = lane >> 4;
    const int K = g.K, nt = K / BK / g.nseg; const size_t segb = (size_t)(K / g.nseg) * 2;
    unsigned voffA[2], voffB[2];
#pragma unroll
    for (int i = 0; i < 2; ++i) { int R, C; stage_rc(tid * 16 + i * 8192, R, C); const int Rb = Epi::PERM ? ((R & ~31) + perm32(R & 31)) : R;
        voffA[i] = (unsigned)(R * K + C) * 2u; voffB[i] = (unsigned)(Rb * K + C) * 2u; }
    const size_t kstep = (size_t)(BK * 2);
    const size_t hstep = (size_t)HALF * K * 2;
    const size_t tstep = 2 * hstep;
    const unsigned ldsw = (unsigned)wid * 1024u;
    const int aoff = lds_byte(wr * 64 + fr, fq * 8), boff = lds_byte(wc * 32 + fr, fq * 8);
#define PG8_SA(b, h) (((b) * 2 + (h)) * HTB)
#define PG8_SB(b, h) ((4 + (b) * 2 + (h)) * HTB)
#define PG8_STAGE(bufoff, gbase, voff) do { _Pragma("unroll") for (int _i = 0; _i < 2; ++_i) \
        __builtin_amdgcn_global_load_lds((const unsigned*)((const char*)(gbase) + (voff)[_i]), (PG8_LAS unsigned*)(lds + (bufoff) + ldsw + _i * 8192), 16, 0, 0); } while (0)
#define PG8_LDA(dst, b, h) do { _Pragma("unroll") for (int m = 0; m < 4; ++m) _Pragma("unroll") for (int k = 0; k < 2; ++k) dst[m][k] = *(const PG8_LAS bf16x8*)(lds + PG8_SA(b, h) + aoff + m * 2048 + k * 1024); } while (0)
#define PG8_LDB(dst, b, h) do { _Pragma("unroll") for (int n = 0; n < 2; ++n) _Pragma("unroll") for (int k = 0; k < 2; ++k) dst[n][k] = *(const PG8_LAS bf16x8*)(lds + PG8_SB(b, h) + boff + n * 2048 + k * 1024); } while (0)
#define PG8_MMA(ai, bj, At, Bt) do { __builtin_amdgcn_s_setprio(1); _Pragma("unroll") for (int m = 0; m < 4; ++m) _Pragma("unroll") for (int n = 0; n < 2; ++n) _Pragma("unroll") for (int k = 0; k < 2; ++k) \
        acc[ai][bj][m][n] = __builtin_amdgcn_mfma_f32_16x16x32_bf16(Bt[n][k], At[m][k], acc[ai][bj][m][n], 0, 0, 0); __builtin_amdgcn_s_setprio(0); } while (0)
#define PG8_WAIT_V(n) asm volatile("s_waitcnt vmcnt(" #n ")" ::: "memory")
#define PG8_WAIT_L(n) asm volatile("s_waitcnt lgkmcnt(" #n ")" ::: "memory")
#define PG8_BAR __builtin_amdgcn_s_barrier()
#define PG8_SCHED __builtin_amdgcn_sched_barrier(0)
    Unit cur, nxt; int ui = 0;
    if (!S.next(0, cur)) return;
    f32x4 acc[2][2][4][2];
#pragma unroll
    for (int a = 0; a < 2; ++a)
#pragma unroll
        for (int b = 0; b < 2; ++b)
#pragma unroll
            for (int m = 0; m < 4; ++m)
#pragma unroll
                for (int n = 0; n < 2; ++n) acc[a][b][m][n] = (f32x4){0.f, 0.f, 0.f, 0.f};
    bf16x8 At[4][2], B0[2][2], B1[2][2];
    const char* cA = (const char*)g.A + (size_t)cur.pm * tstep + (size_t)cur.g * segb; const char* cB = (const char*)g.Bt + (size_t)cur.pn * tstep + (size_t)cur.g * segb;
    S.a_ready(cur);
    if constexpr (SP2) {
        PG8_STAGE(PG8_SB(0, 0), cB, voffB); PG8_STAGE(PG8_SB(0, 1), cB + hstep, voffB); PG8_STAGE(PG8_SA(0, 0), cA, voffA); PG8_STAGE(PG8_SA(0, 1), cA + hstep, voffA);
        if (wr == 1) PG8_BAR;
        PG8_WAIT_V(2); PG8_BAR;
        PG8_STAGE(PG8_SB(1, 0), cB + kstep, voffB); PG8_STAGE(PG8_SA(1, 0), cA + kstep, voffA); PG8_STAGE(PG8_SB(1, 1), cB + hstep + kstep, voffB);
        PG8_WAIT_V(6); PG8_BAR;
    } else {
        PG8_STAGE(PG8_SB(0, 0), cB, voffB); PG8_STAGE(PG8_SA(0, 0), cA, voffA); PG8_STAGE(PG8_SB(0, 1), cB + hstep, voffB); PG8_STAGE(PG8_SA(0, 1), cA + hstep, voffA);
        if (wr == 1) PG8_BAR;
        PG8_WAIT_V(4); PG8_BAR;
        PG8_STAGE(PG8_SB(1, 0), cB + kstep, voffB); PG8_STAGE(PG8_SA(1, 0), cA + kstep, voffA); PG8_STAGE(PG8_SB(1, 1), cB + hstep + kstep, voffB);
        PG8_WAIT_V(6); PG8_BAR;
    }
    for (;;) {
        const bool has_next = S.next(ui + 1, nxt);
        const char* nA = has_next ? (const char*)g.A + (size_t)nxt.pm * tstep + (size_t)nxt.g * segb : cA; const char* nB = has_next ? (const char*)g.Bt + (size_t)nxt.pn * tstep + (size_t)nxt.g * segb : cB;
        for (int t = 0; t < nt; t += 2) {
            const bool last = (t == nt - 2);
            const char* a1 = cA + (size_t)(t + 1) * kstep;
            const char* a2 = last ? nA : cA + (size_t)(t + 2) * kstep; const char* b2 = last ? nB : cB + (size_t)(t + 2) * kstep;
            const char* a3 = a2 + kstep; const char* b3 = b2 + kstep;
            if (last && has_next) S.a_ready(nxt);
            if constexpr (SP2) {
            PG8_LDB(B0, 0, 0); PG8_LDB(B1, 0, 1); PG8_SCHED; PG8_LDA(At, 0, 0); PG8_STAGE(PG8_SA(1, 1), a1 + hstep, voffA);
            PG8_WAIT_V(8); PG8_WAIT_L(0); PG8_BAR; PG8_MMA(0, 0, At, B0); PG8_MMA(0, 1, At, B1); PG8_BAR; PG8_SCHED;
            PG8_LDA(At, 0, 1); PG8_STAGE(PG8_SB(0, 0), b2, voffB); PG8_STAGE(PG8_SB(0, 1), b2 + hstep, voffB); PG8_STAGE(PG8_SA(0, 0), a2, voffA);
            PG8_WAIT_V(8); PG8_WAIT_L(0); PG8_BAR; PG8_MMA(1, 0, At, B0); PG8_MMA(1, 1, At, B1); PG8_BAR; PG8_SCHED;
            PG8_LDB(B0, 1, 0); PG8_LDB(B1, 1, 1); PG8_SCHED; PG8_LDA(At, 1, 0); PG8_STAGE(PG8_SA(0, 1), a2 + hstep, voffA);
            PG8_WAIT_V(8); PG8_WAIT_L(0); PG8_BAR; PG8_MMA(0, 0, At, B0); PG8_MMA(0, 1, At, B1); PG8_BAR; PG8_SCHED;
            PG8_LDA(At, 1, 1); PG8_STAGE(PG8_SB(1, 0), b3, voffB); PG8_STAGE(PG8_SB(1, 1), b3 + hstep, voffB); PG8_STAGE(PG8_SA(1, 0), a3, voffA);
            PG8_WAIT_V(8); PG8_WAIT_L(0); PG8_BAR; PG8_MMA(1, 0, At, B0); PG8_MMA(1, 1, At, B1); PG8_BAR; PG8_SCHED;
            } else {
            PG8_LDB(B0, 0, 0); PG8_SCHED; PG8_LDA(At, 0, 0); PG8_STAGE(PG8_SA(1, 1), a1 + hstep, voffA);
            PG8_WAIT_L(8); PG8_BAR; PG8_WAIT_L(0); PG8_MMA(0, 0, At, B0); PG8_BAR; PG8_SCHED;
            PG8_LDB(B1, 0, 1); PG8_STAGE(PG8_SB(0, 0), b2, voffB);
            PG8_BAR; PG8_WAIT_L(0); PG8_MMA(0, 1, At, B1); PG8_BAR;
            PG8_LDA(At, 0, 1); PG8_STAGE(PG8_SA(0, 0), a2, voffA);
            PG8_BAR; PG8_WAIT_L(0); PG8_MMA(1, 0, At, B0); PG8_BAR; PG8_SCHED;
            PG8_STAGE(PG8_SB(0, 1), b2 + hstep, voffB);
            PG8_WAIT_V(6); PG8_BAR; PG8_MMA(1, 1, At, B1); PG8_BAR;
            PG8_LDB(B0, 1, 0); PG8_SCHED; PG8_LDA(At, 1, 0); PG8_STAGE(PG8_SA(0, 1), a2 + hstep, voffA);
            PG8_WAIT_L(8); PG8_BAR; PG8_WAIT_L(0); PG8_MMA(0, 0, At, B0); PG8_BAR; PG8_SCHED;
            PG8_LDB(B1, 1, 1); PG8_STAGE(PG8_SB(1, 0), b3, voffB);
            PG8_BAR; PG8_WAIT_L(0); PG8_MMA(0, 1, At, B1); PG8_BAR;
            PG8_LDA(At, 1, 1); PG8_STAGE(PG8_SA(1, 0), a3, voffA);
            PG8_BAR; PG8_WAIT_L(0); PG8_MMA(1, 0, At, B0); PG8_BAR; PG8_SCHED;
            PG8_STAGE(PG8_SB(1, 1), b3 + hstep, voffB);
            PG8_WAIT_V(6); PG8_BAR; PG8_MMA(1, 1, At, B1); PG8_BAR;
            }
        }
        if constexpr (ALIGN_EPI) { if (wr == 0) PG8_BAR; }
        E(acc, cur, wr, wc, fr, fq); S.done(cur);
        if (!has_next) break;
        if (!(Epi::KSEG && nxt.g != 0))
#pragma unroll
        for (int a = 0; a < 2; ++a)
#pragma unroll
            for (int b = 0; b < 2; ++b)
#pragma unroll
                for (int m = 0; m < 4; ++m)
#pragma unroll
                    for (int n = 0; n < 2; ++n) acc[a][b][m][n] = (f32x4){0.f, 0.f, 0.f, 0.f};
        cur = nxt; cA = nA; cB = nB; ++ui;
        if constexpr (ALIGN_EPI) { if (wr == 1) PG8_BAR; }
    }
    PG8_WAIT_V(0);
    if constexpr (!ALIGN_EPI) { if (wr == 0) PG8_BAR; }
    PG8_BAR;
#undef PG8_SA
#undef PG8_SB
#undef PG8_STAGE
#undef PG8_LDA
#undef PG8_LDB
#undef PG8_MMA
#undef PG8_WAIT_V
#undef PG8_WAIT_L
#undef PG8_BAR
#undef PG8_SCHED
}
}

#define LAS __attribute__((address_space(3)))
typedef unsigned short bf16_t;
typedef _Float16 h16;
typedef _Float16 h16x4 __attribute__((ext_vector_type(4)));
typedef _Float16 h16x8 __attribute__((ext_vector_type(8)));
typedef float f32x4 __attribute__((ext_vector_type(4)));
typedef float f32x2 __attribute__((ext_vector_type(2)));
typedef unsigned u32x4 __attribute__((ext_vector_type(4)));
typedef unsigned u32x2 __attribute__((ext_vector_type(2)));

#ifndef ONE_LAUNCH
#define ONE_LAUNCH 0
#endif
constexpr int NWAVES = 8, NTHR = 512;
constexpr int TT = 16384, SEQ = 8192, DM = 1024, FF = 2816, MW = 256, INW = 6144;
constexpr int LDS_BYTES = 147456;
constexpr size_t MiB = 1u << 20;
constexpr size_t WS_SS = 1 * MiB, WS_E = 2 * MiB, WS_W = 4 * MiB, WS_B1 = 34 * MiB, WS_B2 = 66 * MiB, WS_Z = 98 * MiB, WS_END = 242 * MiB;
constexpr size_t W_GU1 = 0, W_D1 = W_GU1 + (size_t)2 * FF * DM * 2, W_INA = W_D1 + (size_t)DM * FF * 2;
constexpr size_t W_ING = 0, W_BR = W_ING + (size_t)4096 * DM * 2, W_O = W_BR + (size_t)DM * DM * 2, W_GU2 = W_O + (size_t)DM * DM * 2, W_D2 = W_GU2 + (size_t)2 * FF * DM * 2, W_GLU = W_D2 + (size_t)DM * FF * 2, W_END2 = W_GLU + 256 * 256 * 2;
static_assert(W_END2 <= 30 * MiB && W_INA + (size_t)2560 * DM * 2 <= 30 * MiB, "W region");
constexpr size_t Z_RW = 0, Z_G16 = 56 * MiB, Z_U5 = 64 * MiB, Z_L16 = 72 * MiB, Z_PP = 88 * MiB, Z_O = 88 * MiB, Z_GL = 104 * MiB;
constexpr size_t Z_HID = 0, Z_R = 0;
static_assert((size_t)TT * 4 * 896 <= 56 * MiB && (size_t)TT * 1792 * 2 <= 56 * MiB && (size_t)TT * FF * 2 <= 144 * MiB && (size_t)TT * 4096 * 2 <= 144 * MiB, "Z region");

typedef const float* cfp_t;
typedef const __attribute__((address_space(4))) cfp_t* in_t;
struct Args { const float* in[41]; float* out; unsigned char* ws; int ph_lo, ph_hi; };

struct Frame {
    LAS unsigned char* lds;
    int tid, lane, wave, G, bx;
    in_t in;
    float* X; unsigned char* ws;
    float* SS; float* E;
    bf16_t *B1, *B2, *HID, *GL;
    h16 *U5, *PP, *L16, *G16, *R;
    float* O; unsigned char* RW;
};

__device__ __forceinline__ unsigned f2bf(float f) { unsigned u = __builtin_bit_cast(unsigned, f); return (u + 0x7fffu + ((u >> 16) & 1u)) >> 16; }
__device__ __forceinline__ unsigned pk2(float lo, float hi) { return f2bf(lo) | (f2bf(hi) << 16); }
#define LDS_WAIT() asm volatile("s_waitcnt lgkmcnt(0)" ::: "memory")
template <int CTRL> __device__ __forceinline__ float dppx(float x) { return __builtin_bit_cast(float, __builtin_amdgcn_update_dpp(0, __builtin_bit_cast(int, x), CTRL, 0xf, 0xf, true)); }
__device__ __forceinline__ float allreduce16(float x) { x += dppx<0xB1>(x); x += dppx<0x4E>(x); x += dppx<0x141>(x); x += dppx<0x140>(x); return x; }
__device__ __forceinline__ float wave_sum(float x) { x = allreduce16(x); x += __shfl_xor(x, 16); x += __shfl_xor(x, 32); return x; }
__device__ __forceinline__ float sigmoidf_(float x) { return 1.0f / (1.0f + __expf(-x)); }

__device__ __forceinline__ int tr_rowmap(int mode, int j, int row0) {
    if (mode == 0) return row0 + j;
    if (mode == 1) return 8 * (j >> 2) + (j & 3);
    if (mode == 2) return 8 * (j >> 2) + 4 + (j & 3);
    const int g = j >> 10, d = j & 1023;
    const int pn = 4 * (d >> 8) + 2 * ((d >> 7) & 1) + ((d >> 4) & 1);
    return 256 * pn + 128 * (g >> 1) + 32 * ((d >> 5) & 3) + 16 * (g & 1) + 4 * ((d >> 2) & 3) + (d & 3);
}
__device__ __forceinline__ void tr_item(const float* W, int ldw, int K, int N, bf16_t* WT, int mode, int row0, const float* s1, const float* s2, int smode, LAS float* scr, int item, int lane) {
    const int nblk = N / 32, kb = item / nblk, nb = item % nblk, k0 = 64 * kb, n0 = 32 * nb;
#pragma unroll 8
    for (int i = 0; i < 32; ++i) { const int kk = 2 * i + (lane >> 5); const int k = k0 + kk; float sc = 1.0f;
        if (s1) sc = s1[k];
        if (smode == 1) sc *= s2[k]; else if (smode == 2) sc *= (1.0f - s2[k]);
        scr[kk * 33 + (lane & 31)] = W[(size_t)k * ldw + n0 + (lane & 31)] * sc; }
    LDS_WAIT(); asm volatile("" ::: "memory");
    const int c = lane & 7;
#pragma unroll
    for (int j = 0; j < 4; ++j) { const int n = (lane >> 3) + 8 * j; const LAS float* s = scr + (8 * c) * 33 + n;
        u32x4 o; o.x = pk2(s[0 * 33], s[1 * 33]); o.y = pk2(s[2 * 33], s[3 * 33]); o.z = pk2(s[4 * 33], s[5 * 33]); o.w = pk2(s[6 * 33], s[7 * 33]);
        *(u32x4*)(WT + (size_t)tr_rowmap(mode, n0 + n, row0) * K + k0 + 8 * c) = o; }
    LDS_WAIT(); asm volatile("" ::: "memory");
}
#define TRJ(W_, ldw_, K_, N_, dst_, mode_, row0_, s1_, s2_, smode_) { const int ni_ = ((K_) / 64) * ((N_) / 32); if (r >= 0 && r < ni_) tr_item(W_, ldw_, K_, N_, dst_, mode_, row0_, s1_, s2_, smode_, scr, r, F.lane); r -= ni_; }
__device__ __forceinline__ void conv_first_half(Frame& F, int l) {
    LAS float* scr = (LAS float*)(F.lds + F.wave * 16384);
    const int gw = F.bx * NWAVES + F.wave, NGW = F.G * NWAVES;
    unsigned char* wb = F.ws + WS_W;
    const float* n1 = F.in[1] + (size_t)l * DM; const float* nm = F.in[5] + (size_t)l * DM; const float* mu = F.in[19] + (size_t)l * 3 * DM;
    const float* w1 = F.in[21] + (size_t)l * DM * 64; const float* a1 = F.in[24] + (size_t)l * DM * 64; const float* g1 = F.in[26] + (size_t)l * DM * 128;
    bf16_t* ina = (bf16_t*)(wb + W_INA);
    for (int it = gw;; it += NGW) { int r = it;
        TRJ(F.in[2] + (size_t)l * DM * FF, FF, DM, FF, (bf16_t*)(wb + W_GU1), 1, 0, n1, nullptr, 0)
        TRJ(F.in[3] + (size_t)l * DM * FF, FF, DM, FF, (bf16_t*)(wb + W_GU1), 2, 0, n1, nullptr, 0)
        TRJ(F.in[4] + (size_t)l * FF * DM, DM, FF, DM, (bf16_t*)(wb + W_D1), 0, 0, nullptr, nullptr, 0)
        TRJ(F.in[6] + (size_t)l * DM * INW, INW, DM, 2048, ina, 0, 0, nm, nullptr, 0)
        TRJ(w1, 64, DM, 64, ina, 0, 2048, nm, mu, 2)
        TRJ(a1, 64, DM, 64, ina, 0, 2112, nm, mu + DM, 2)
        TRJ(g1, 128, DM, 128, ina, 0, 2176, nm, mu + 2 * DM, 2)
        TRJ(w1, 64, DM, 64, ina, 0, 2304, nm, mu, 1)
        TRJ(a1, 64, DM, 64, ina, 0, 2368, nm, mu + DM, 1)
        TRJ(g1, 128, DM, 128, ina, 0, 2432, nm, mu + 2 * DM, 1)
        if (r >= 0) break; }
}
__device__ __forceinline__ void conv_second_half(Frame& F, int l) {
    LAS float* scr = (LAS float*)(F.lds + F.wave * 16384);
    const int gw = F.bx * NWAVES + F.wave, NGW = F.G * NWAVES;
    unsigned char* wb = F.ws + WS_W;
    const float* nm = F.in[5] + (size_t)l * DM; const float* n2 = F.in[36] + (size_t)l * DM;
    for (int it = gw;; it += NGW) { int r = it;
        TRJ(F.in[6] + (size_t)l * DM * INW + 2048, INW, DM, 4096, (bf16_t*)(wb + W_ING), 3, 0, nm, nullptr, 0)
        TRJ(F.in[34] + (size_t)l * DM * DM, DM, DM, DM, (bf16_t*)(wb + W_BR), 0, 0, nullptr, nullptr, 0)
        TRJ(F.in[35] + (size_t)l * DM * DM, DM, DM, DM, (bf16_t*)(wb + W_O), 0, 0, nullptr, nullptr, 0)
        TRJ(F.in[37] + (size_t)l * DM * FF, FF, DM, FF, (bf16_t*)(wb + W_GU2), 1, 0, n2, nullptr, 0)
        TRJ(F.in[38] + (size_t)l * DM * FF, FF, DM, FF, (bf16_t*)(wb + W_GU2), 2, 0, n2, nullptr, 0)
        TRJ(F.in[39] + (size_t)l * FF * DM, DM, FF, DM, (bf16_t*)(wb + W_D2), 0, 0, nullptr, nullptr, 0)
        TRJ(F.in[15] + (size_t)l * 256 * 256, 256, 256, 256, (bf16_t*)(wb + W_GLU), 0, 0, nullptr, nullptr, 0)
        if (r >= 0) break; }
}
__device__ __forceinline__ void prep_x(Frame& F) {
    const int gw = F.bx * NWAVES + F.wave, NGW = F.G * NWAVES;
    const float* x = F.in[0];
    for (int m = gw; m < TT; m += NGW) {
        const f32x4* xr = (const f32x4*)(x + (size_t)m * DM) + F.lane; float s = 0.f;
        unsigned long long* o8 = (unsigned long long*)(F.B1 + (size_t)m * DM) + F.lane;
#pragma unroll
        for (int j = 0; j < 4; ++j) { const f32x4 v = xr[64 * j]; s += (v[0] * v[0] + v[1] * v[1]) + (v[2] * v[2] + v[3] * v[3]);
            o8[64 * j] = (unsigned long long)pk2(v[0], v[1]) | ((unsigned long long)pk2(v[2], v[3]) << 32); }
        s += __shfl_xor(s, 1); s += __shfl_xor(s, 2);
        if ((F.lane & 3) == 0) F.SS[(size_t)m * 16 + (F.lane >> 2)] = s;
    }
}
__device__ __forceinline__ void final_norm(Frame& F) {
    const int gw = F.bx * NWAVES + F.wave, NGW = F.G * NWAVES;
    const f32x4* gn = (const f32x4*)F.in[40] + F.lane;
    for (int m = gw; m < TT; m += NGW) {
        const float rs = pg8::row_rstd(F.SS, m);
        f32x4* xr = (f32x4*)(F.X + (size_t)m * DM) + F.lane;
#pragma unroll
        for (int j = 0; j < 4; ++j) { const f32x4 v = xr[64 * j]; xr[64 * j] = v * rs * gn[64 * j]; }
    }
}

struct S5Par { float ar, ai; float bbr[16], bbi[16]; };
__device__ __forceinline__ void s5_params(Frame& F, int l, int g, int p, S5Par& P) {
    asm volatile("" : "+v"(p));
    const float lr = F.in[7][((size_t)l * 16 + g) * 64 + p], li = F.in[8][((size_t)l * 16 + g) * 64 + p], dt = expf(F.in[9][l * 16 + g]);
    const float mag = expf(lr * dt); P.ar = mag * cosf(li * dt); P.ai = mag * sinf(li * dt);
    const float inv = 1.0f / (lr * lr + li * li); const float qr = lr * inv, qi = -li * inv;
    const float cr = (P.ar - 1.0f) * qr - P.ai * qi, ci = (P.ar - 1.0f) * qi + P.ai * qr;
    const f32x4* br = (const f32x4*)(F.in[10] + (((size_t)l * 16 + g) * 64 + p) * 16); const f32x4* bi = (const f32x4*)(F.in[11] + (((size_t)l * 16 + g) * 64 + p) * 16);
#pragma unroll
    for (int q = 0; q < 4; ++q) { const f32x4 a = br[q], b = bi[q];
#pragma unroll
        for (int i = 0; i < 4; ++i) { P.bbr[4 * q + i] = cr * a[i] - ci * b[i]; P.bbi[4 * q + i] = cr * b[i] + ci * a[i]; } }
}
__device__ __forceinline__ void s5_step(const S5Par& P, const LAS float* urow, float& hr, float& hi) {
    const LAS f32x4* u4 = (const LAS f32x4*)urow; float bur = 0.f, bui = 0.f;
#pragma unroll
    for (int q = 0; q < 4; ++q) { const f32x4 u = u4[q];
#pragma unroll
        for (int i = 0; i < 4; ++i) { bur += P.bbr[4 * q + i] * u[i]; bui += P.bbi[4 * q + i] * u[i]; } }
    const float nr = P.ar * hr - P.ai * hi + bur, ni = P.ar * hi + P.ai * hr + bui; hr = nr; hi = ni;
}
__device__ __forceinline__ void load_u5_tile(Frame& F, int t0, LAS float* ubuf) {
    for (int i = F.tid; i < 64 * 64; i += NTHR) { const int t = i >> 6, q = i & 63; const h16x4 v = *(const h16x4*)(F.U5 + (size_t)(t0 + t) * 256 + 4 * q);
        f32x4 f; f[0] = (float)v[0]; f[1] = (float)v[1]; f[2] = (float)v[2]; f[3] = (float)v[3]; *(LAS f32x4*)(ubuf + t * 256 + 4 * q) = f; }
}


template <bool FIRST> __device__ __forceinline__ void mv32(LAS float* accp, float init, const LAS float* hb, const float* wsrc, int ldw) {
    float w[32];
    asm volatile("" : "+v"(wsrc));
#pragma unroll
    for (int j = 0; j < 32; ++j) w[j] = wsrc[(size_t)j * ldw];
#pragma unroll 2
    for (int tt = 0; tt < 32; ++tt) { const LAS f32x4* h4 = (const LAS f32x4*)(hb + tt * 256); float a = FIRST ? init : accp[tt * 256];
#pragma unroll
        for (int q = 0; q < 8; ++q) { const f32x4 v = h4[q]; a += v[0] * w[4 * q] + v[1] * w[4 * q + 1] + v[2] * w[4 * q + 2] + v[3] * w[4 * q + 3]; }
        accp[tt * 256] = a; }
}
__device__ __forceinline__ void m1_phase(Frame& F, int l) {
    conv_second_half(F, l);
    __syncthreads();
    LAS float* ubuf = (LAS float*)F.lds;
    LAS float* pl = (LAS float*)(F.lds + 65536);
    const int tid = F.tid, lane = F.lane, wave = F.wave;
    const int ch = tid & 255, half = tid >> 8;
    for (int c = F.bx; c < TT / 64; c += F.G) {
        const int t0 = c * 64, tb = t0 + half * 32, sb = tb & (SEQ - 1);
        load_u5_tile(F, t0, ubuf);
        {
            const int grp = ch >> 6, win = 2 << grp;
            const h16* up = F.PP + (size_t)tb * 1792 + ch;
            float s = 0.f;
            for (int j = 1; j <= win; ++j) if (sb - j >= 0) s += (float)up[-(ptrdiff_t)j * 1792];
            for (int tt = 0; tt < 32; ++tt) { const float u = (float)up[(size_t)tt * 1792]; s += u; const int pos = sb + tt;
                if (pos - win >= 0) s -= (float)up[(ptrdiff_t)(tt - win) * 1792];
                const float cnt = (float)((pos + 1 < win) ? (pos + 1) : win);
                pl[(half * 32 + tt) * 256 + ch] = s / cnt - u; }
        }
        {
            const h16* zp = F.PP + (size_t)tb * 1792 + 1024 + ch;
            const float cw0 = F.in[33][((size_t)l * 3 + 0) * 256 + ch], cw1 = F.in[33][((size_t)l * 3 + 1) * 256 + ch], cw2 = F.in[33][((size_t)l * 3 + 2) * 256 + ch];
            float z2 = 0.f, z1 = 0.f;
            if (sb >= 1) z1 = (float)zp[-(ptrdiff_t)1792 + 512] * (float)zp[-(ptrdiff_t)1792];
            if (sb >= 2) z2 = (float)zp[-(ptrdiff_t)2 * 1792 + 512] * (float)zp[-(ptrdiff_t)2 * 1792];
            for (int tt = 0; tt < 32; ++tt) { const h16* q = zp + (size_t)tt * 1792; const float z0 = (float)q[512] * (float)q[0];
                const float y = (float)q[256] * (cw0 * z2 + cw1 * z1 + cw2 * z0);
                F.B2[(size_t)(tb + tt) * 1024 + 768 + ch] = (bf16_t)f2bf(y); z2 = z1; z1 = z0; }
        }
        __syncthreads();
#pragma unroll 1
        for (int gi = 0; gi < 2; ++gi) { const int g = wave + 8 * gi; S5Par P; s5_params(F, l, g, lane, P); float hr = 0.f, hi = 0.f;
#pragma unroll 2
            for (int j = 0; j < 64; ++j) s5_step(P, ubuf + j * 256 + g * 16, hr, hi);
            *(f32x2*)(F.E + (((size_t)c * 16 + g) * 64 + lane) * 2) = (f32x2){hr, hi}; }
        __syncthreads();
        LAS float* accu = ubuf + half * 32 * 256 + ch;
        LAS float* accp = pl + half * 32 * 256 + ch;
        {
            const int grp = ch >> 6, d = ch & 63;
            const float* pw = F.in[16] + (((size_t)l * 4 + grp) * 64) * 64 + d;
            mv32<true>(accu, 0.f, pl + half * 32 * 256 + grp * 64, pw, 64);
            mv32<false>(accu, 0.f, pl + half * 32 * 256 + grp * 64 + 32, pw + 32 * 64, 64);
            const float sc = F.in[17][(size_t)l * 256 + ch];
#pragma unroll 4
            for (int tt = 0; tt < 32; ++tt) F.B2[(size_t)(tb + tt) * 1024 + 256 + ch] = (bf16_t)f2bf(accu[tt * 256] * sc);
        }
        __syncthreads();
#pragma unroll 4
        for (int tt = 0; tt < 32; ++tt) { const int t = tb + tt; float pre = (float)F.L16[(size_t)t * 512 + ch];
            if (sb + tt > 0) pre += (float)F.L16[(size_t)(t - 1) * 512 + 256 + ch];
            float a = pre; if (ch < 64) a = tanhf(pre); else if (ch >= 128) a = sigmoidf_(pre);
            ubuf[(half * 32 + tt) * 256 + ch] = a; }
        __syncthreads();
        const int hb = (t0 / SEQ) * 4 + (ch >> 6);
        unsigned char* rwb = F.RW + ((size_t)hb * SEQ + sb) * 896;
        const int cl = ch & 63;
        const LAS float* hrow = ubuf + half * 32 * 256;
        {
            const float* wp = F.in[22] + (size_t)l * 64 * 256 + ch;
            mv32<true>(accp, F.in[20][(size_t)l * 256 + ch], hrow, wp, 256);
            mv32<false>(accp, 0.f, hrow + 32, wp + 32 * 256, 256);
#pragma unroll 2
            for (int tt = 0; tt < 32; ++tt) { const float z = -accp[tt * 256]; const float sp = fmaxf(z, 0.f) + log1pf(expf(-fabsf(z)));
                const float wlog = -sp - 0.5f; const float dec = expf(-expf(wlog));
                *(float*)(rwb + (size_t)tt * 896 + cl * 4) = dec; }
        }
        {
            const float* gp = F.in[27] + (size_t)l * 128 * 256 + ch;
            mv32<true>(accp, 0.f, hrow + 128, gp, 256);
#pragma unroll 1
            for (int kc = 1; kc < 4; ++kc) mv32<false>(accp, 0.f, hrow + 128 + kc * 32, gp + (size_t)kc * 32 * 256, 256);
#pragma unroll 4
            for (int tt = 0; tt < 32; ++tt) F.G16[(size_t)(tb + tt) * 256 + ch] = (h16)accp[tt * 256];
        }
        {
            const float* ap = F.in[25] + (size_t)l * 64 * 256 + ch;
            mv32<true>(accp, F.in[23][(size_t)l * 256 + ch], hrow + 64, ap, 256);
            mv32<false>(accp, 0.f, hrow + 96, ap + 32 * 256, 256);
            const float mur = F.in[18][((size_t)l * 3 + 0) * 256 + ch], muk = F.in[18][((size_t)l * 3 + 1) * 256 + ch], muv = F.in[18][((size_t)l * 3 + 2) * 256 + ch];
            const float kkw = F.in[28][(size_t)l * 256 + ch], kaw = F.in[29][(size_t)l * 256 + ch];
            const h16* pp = F.PP + (size_t)tb * 1792 + 256 + ch;
            float rprev = 0.f, kprev = 0.f, vprev = 0.f;
            if (sb > 0) { rprev = (float)pp[-(ptrdiff_t)1792]; kprev = (float)pp[-(ptrdiff_t)1792 + 256]; vprev = (float)pp[-(ptrdiff_t)1792 + 512]; }
#pragma unroll 2
            for (int tt = 0; tt < 32; ++tt) { const float a = sigmoidf_(accp[tt * 256]);
                const h16* q = pp + (size_t)tt * 1792; const float rp = (float)q[0], kp = (float)q[256], vp = (float)q[512];
                const float r = rp + (rprev - rp) * mur, k = kp + (kprev - kp) * muk, v = vp + (vprev - vp) * muv;
                rprev = rp; kprev = kp; vprev = vp;
                const float kkv = k * kkw; const float nrm = sqrtf(wave_sum(kkv * kkv)); const float kk = kkv / fmaxf(nrm, 1e-12f);
                const float kt = k * (1.0f + (a - 1.0f) * kaw); const float bb = kk * a;
                h16* o = (h16*)(rwb + (size_t)tt * 896 + 256) + cl;
                o[0] = (h16)r; o[64] = (h16)kt; o[128] = (h16)v; o[192] = (h16)kk; o[256] = (h16)bb; }
        }
        __syncthreads();
    }
}

constexpr int SC_STEPS = 32, SC_FL = SC_STEPS * 384;
__device__ __forceinline__ void scan_load(const unsigned char* src, int cc, int lt, u32x4 (&rg)[7]) {
#pragma unroll
    for (int n = 0; n < 7; ++n) { const int i = lt + 256 * n, step = i / 56, j = i % 56;
        rg[n] = *(const u32x4*)(src + ((size_t)cc * SC_STEPS + step) * 896 + (j < 16 ? j * 16 : 256 + (j - 16) * 16)); }
}
__device__ __forceinline__ void scan_store(LAS float* buf, int lt, const u32x4 (&rg)[7]) {
#pragma unroll
    for (int n = 0; n < 7; ++n) { const int i = lt + 256 * n, step = i / 56, j = i % 56;
        if (j < 16) { *(LAS u32x4*)(buf + step * 384 + j * 4) = rg[n]; }
        else { const int a = (j - 16) >> 3, e = (j - 16) & 7; const h16x8 h = __builtin_bit_cast(h16x8, rg[n]); f32x4 lo, hi;
            lo[0] = (float)h[0]; lo[1] = (float)h[1]; lo[2] = (float)h[2]; lo[3] = (float)h[3]; hi[0] = (float)h[4]; hi[1] = (float)h[5]; hi[2] = (float)h[6]; hi[3] = (float)h[7];
            LAS f32x4* d = (LAS f32x4*)(buf + step * 384 + 64 + a * 64 + e * 8); d[0] = lo; d[1] = hi; } }
}
#define RAW_BAR() do { asm volatile("s_waitcnt lgkmcnt(0)" ::: "memory"); __builtin_amdgcn_s_barrier(); asm volatile("" ::: "memory"); } while (0)
__device__ __forceinline__ void rwkv_scan(Frame& F) {
    const int blk = F.bx, hb = blk >> 2, q = blk & 3, b = hb >> 2, h = hb & 3;
    const unsigned char* src = F.RW + (size_t)hb * SEQ * 896;
    LAS float* buf = (LAS float*)F.lds;
    LAS float* obuf = (LAS float*)(F.lds + 2 * SC_FL * 4);
    const int wave = F.wave, lane = F.lane; const bool loader = wave >= 4; const int lt = F.tid - 256;
    constexpr int NCH = SEQ / SC_STEPS;
    u32x4 rg[7];
    if (loader) { scan_load(src, 0, lt, rg); scan_store(buf, lt, rg); scan_load(src, 1, lt, rg); }
    RAW_BAR();
    float S0 = 0.f, S1 = 0.f, S2 = 0.f, S3 = 0.f;
    const int rl = (wave & 3) * 4 + (lane >> 4), row = q * 16 + rl, ks = lane & 15;
    float* Og = F.O + ((size_t)b * SEQ) * 256 + h * 64 + q * 16;
#pragma unroll 1
    for (int cc = 0; cc < NCH; ++cc) {
        if (loader) {
            if (cc > 0) { const LAS float* ob = obuf + ((cc - 1) & 1) * 512;
#pragma unroll
                for (int n = 0; n < 2; ++n) { const int i = lt + 256 * n; Og[((size_t)(cc - 1) * SC_STEPS + (i >> 4)) * 256 + (i & 15)] = ob[i]; } }
            if (cc + 1 < NCH) { scan_store(buf + ((cc + 1) & 1) * SC_FL, lt, rg); if (cc + 2 < NCH) scan_load(src, cc + 2, lt, rg); }
        } else {
            const LAS float* bb = buf + (cc & 1) * SC_FL; LAS float* ob = obuf + (cc & 1) * 512;
#pragma unroll 4
            for (int s = 0; s < SC_STEPS; ++s) { const LAS float* p = bb + s * 384;
                const f32x4 w = *(const LAS f32x4*)(p + 4 * ks), r = *(const LAS f32x4*)(p + 64 + 4 * ks), k = *(const LAS f32x4*)(p + 128 + 4 * ks);
                const f32x4 kk = *(const LAS f32x4*)(p + 256 + 4 * ks), bv = *(const LAS f32x4*)(p + 320 + 4 * ks); const float v = p[192 + row];
                float sa = (S0 * kk[0] + S1 * kk[1]) + (S2 * kk[2] + S3 * kk[3]); sa = allreduce16(sa); const float nsa = -sa;
                S0 = S0 * w[0] + (v * k[0] + nsa * bv[0]); S1 = S1 * w[1] + (v * k[1] + nsa * bv[1]); S2 = S2 * w[2] + (v * k[2] + nsa * bv[2]); S3 = S3 * w[3] + (v * k[3] + nsa * bv[3]);
                float o = (S0 * r[0] + S1 * r[1]) + (S2 * r[2] + S3 * r[3]); o = allreduce16(o);
                if (ks == 0) ob[s * 16 + rl] = o; }
        }
        RAW_BAR();
    }
    if (loader) { const LAS float* ob = obuf + ((NCH - 1) & 1) * 512;
#pragma unroll
        for (int n = 0; n < 2; ++n) { const int i = lt + 256 * n; Og[((size_t)(NCH - 1) * SC_STEPS + (i >> 4)) * 256 + (i & 15)] = ob[i]; } }
    RAW_BAR();
}
__device__ __forceinline__ float gelu_tanh(float x) { const float u = 0.7978845608028654f * (x + 0.044715f * x * x * x); return 0.5f * x * (1.0f + tanhf(u)); }
__device__ __forceinline__ void s5_pass2(Frame& F, int l, int c) {
    LAS float* ubuf = (LAS float*)F.lds;
    LAS float* ybuf = (LAS float*)(F.lds + 65536);
    const int t0 = c * 64, lane = F.lane, wave = F.wave, cb0 = c & ~127;
    load_u5_tile(F, t0, ubuf);
    __syncthreads();
#pragma unroll 1
    for (int gi = 0; gi < 2; ++gi) { const int g = wave + 8 * gi; S5Par P; s5_params(F, l, g, lane, P);
        float cr[16], ci[16]; int lane_l = lane; asm volatile("" : "+v"(lane_l));
#pragma unroll
        for (int hh = 0; hh < 16; ++hh) { cr[hh] = F.in[12][(((size_t)l * 16 + g) * 16 + hh) * 64 + lane_l]; ci[hh] = F.in[13][(((size_t)l * 16 + g) * 16 + hh) * 64 + lane_l]; }
        float pr = P.ar, pi = P.ai;
#pragma unroll
        for (int s = 0; s < 6; ++s) { const float nr = pr * pr - pi * pi, ni = 2.0f * pr * pi; pr = nr; pi = ni; }
        float hr = 0.f, hi = 0.f;
#pragma unroll 2
        for (int c2 = cb0; c2 < c; ++c2) { const f32x2 e = *(const f32x2*)(F.E + (((size_t)c2 * 16 + g) * 64 + lane) * 2);
            const float nr = pr * hr - pi * hi + e[0], ni = pr * hi + pi * hr + e[1]; hr = nr; hi = ni; }
#pragma unroll 1
        for (int j = 0; j < 64; ++j) { s5_step(P, ubuf + j * 256 + g * 16, hr, hi); float keep = 0.f;
#pragma unroll
            for (int hh = 0; hh < 16; ++hh) { const float s = wave_sum(hr * cr[hh] - hi * ci[hh]); keep = (lane == hh) ? s : keep; }
            if (lane < 16) ybuf[j * 256 + g * 16 + lane] = keep; }
    }
    __syncthreads();
    { const int ch = F.tid & 255, half = F.tid >> 8; const float dd = F.in[14][(size_t)l * 256 + ch];
        for (int tt = 0; tt < 32; ++tt) { const int tl = half * 32 + tt; const float y = ybuf[tl * 256 + ch] + dd * ubuf[tl * 256 + ch];
            F.GL[(size_t)(t0 + tl) * 256 + ch] = (bf16_t)f2bf(gelu_tanh(y)); } }
    __syncthreads();
}
__device__ __forceinline__ void m2_phase(Frame& F, int l) {
#ifndef NO_SCAN
    int bxs = F.bx; asm volatile("" : "+s"(bxs));
    if (bxs < 32) { rwkv_scan(F); return; }
#endif
#ifndef NO_P2
    for (int c = F.bx - 32; c < TT / 64; c += F.G - 32) s5_pass2(F, l, c);
#endif
}
__device__ __forceinline__ void rwkv_post(Frame& F, int l) {
    const int gw = F.bx * NWAVES + F.wave, NGW = F.G * NWAVES, lane = F.lane;
    for (int it = gw; it < TT * 4; it += NGW) { const int t = it >> 2, hh = it & 3, c = hh * 64 + lane;
        const float o = F.O[(size_t)t * 256 + c];
        const float mu = wave_sum(o) * (1.0f / 64.0f); const float d = o - mu; const float var = wave_sum(d * d) * (1.0f / 64.0f);
        const float on = d * rsqrtf(var + 64e-5f) * F.in[31][(size_t)l * 256 + c] + F.in[32][(size_t)l * 256 + c];
        const int b = t / SEQ, pos = t & (SEQ - 1);
        const h16* rw = (const h16*)(F.RW + ((size_t)(b * 4 + hh) * SEQ + pos) * 896 + 256) + lane;
        const float r = (float)rw[0], k = (float)rw[64], v = (float)rw[128];
        const float bs = wave_sum(r * k * F.in[30][(size_t)l * 256 + c]);
        const float out = (on + bs * v) * (float)F.G16[(size_t)t * 256 + c];
        F.B2[(size_t)t * 1024 + 512 + c] = (bf16_t)f2bf(out); }
}

constexpr int NPH = 25;
#ifndef PHMASK
#define PHMASK 0xFFFF
#endif
#define PHON(k) (((PHMASK) >> (k)) & 1)
template <int PH> __device__ __forceinline__ void run_phase(const int wave_s, unsigned char* lds_raw) {
    typedef pg8::StaticOrder SO;
    int tid = wave_s * 64 + (int)__builtin_amdgcn_mbcnt_hi(~0u, __builtin_amdgcn_mbcnt_lo(~0u, 0u)); asm volatile("" : "+v"(tid));
    int G = gridDim.x, bx = blockIdx.x; asm volatile("" : "+s"(G), "+s"(bx));
    const __attribute__((address_space(4))) unsigned char* ka = (const __attribute__((address_space(4))) unsigned char*)__builtin_amdgcn_kernarg_segment_ptr();
    asm volatile("" : "+s"(ka));
    const __attribute__((address_space(4))) Args* ap = (const __attribute__((address_space(4))) Args*)ka;
    Frame F;
    F.lds = (LAS unsigned char*)lds_raw;
    F.tid = tid; F.lane = tid & 63; F.wave = __builtin_amdgcn_readfirstlane(tid >> 6); F.G = G; F.bx = bx;
    F.in = (in_t)ka; F.X = ap->out; F.ws = ap->ws;
    unsigned char* ws = F.ws;
    F.SS = (float*)(ws + WS_SS); F.E = (float*)(ws + WS_E); F.B1 = (bf16_t*)(ws + WS_B1); F.B2 = (bf16_t*)(ws + WS_B2);
    unsigned char* z = ws + WS_Z;
    F.HID = (bf16_t*)(z + Z_HID); F.GL = (bf16_t*)(z + Z_GL); F.U5 = (h16*)(z + Z_U5); F.PP = (h16*)(z + Z_PP); F.L16 = (h16*)(z + Z_L16); F.G16 = (h16*)(z + Z_G16); F.R = (h16*)(z + Z_R);
    F.O = (float*)(z + Z_O); F.RW = z + Z_RW;
    if constexpr (PH == 0) { conv_first_half(F, 0); prep_x(F); }
    else { constexpr int l = (PH - 1) / 12, k = (PH - 1) % 12;
        if constexpr (k == 0) { pg8::Gemm g{F.B1, (const bf16_t*)(ws + WS_W + W_GU1), TT, 2 * FF, DM, 1}; SO S; S.init(TT, 2 * FF, G, bx); pg8::EpiGU E{F.HID, F.SS}; pg8::gemm_phase<pg8::EpiGU, SO, true, true>(F.lds, g, S, E, tid); }
        else if constexpr (k == 1) { pg8::Gemm g{F.HID, (const bf16_t*)(ws + WS_W + W_D1), TT, DM, FF, 1}; SO S; S.init(TT, DM, G, bx); pg8::EpiDown E{l == 0 ? F.in[0] : F.X, F.X, F.B1, F.SS, 0.5f}; pg8::gemm_phase<pg8::EpiDown, SO, true, true>(F.lds, g, S, E, tid); }
        else if constexpr (k == 2) { pg8::Gemm g{F.B1, (const bf16_t*)(ws + WS_W + W_INA), TT, 2560, DM, 1}; SO S; S.init(TT, 2560, G, bx); pg8::EpiInA E{F.U5, F.PP, F.L16, F.SS}; pg8::gemm_phase<pg8::EpiInA, SO, true, true>(F.lds, g, S, E, tid); }
        else if constexpr (k == 3) { m1_phase(F, l); }
        else if constexpr (k == 4) { m2_phase(F, l); }
        else if constexpr (k == 5) { { pg8::Gemm g{F.GL, (const bf16_t*)(ws + WS_W + W_GLU), TT, 256, 256, 1}; SO S; S.init(TT, 256, G, bx); pg8::EpiGlu E{F.GL, F.B2}; pg8::gemm_phase<pg8::EpiGlu, SO, true, true>(F.lds, g, S, E, tid); } rwkv_post(F, l); }
        else if constexpr (k == 6) { pg8::Gemm g{F.B1, (const bf16_t*)(ws + WS_W + W_ING), TT, 4096, DM, 1}; SO S; S.init(TT, 4096, G, bx); pg8::EpiGate E{F.R, F.SS}; pg8::gemm_phase<pg8::EpiGate, SO, true, true>(F.lds, g, S, E, tid); }
        else if constexpr (k == 7) { pg8::Gemm g{F.B2, (const bf16_t*)(ws + WS_W + W_BR), TT, DM, DM, 4}; pg8::SegOrder4 S; S.so.init(TT, DM, G, bx); pg8::EpiBranch E{F.R, F.B1}; pg8::gemm_phase<pg8::EpiBranch, pg8::SegOrder4, true, true>(F.lds, g, S, E, tid); }
        else if constexpr (k == 8) { pg8::Gemm g{F.B1, (const bf16_t*)(ws + WS_W + W_O), TT, DM, DM, 1}; SO S; S.init(TT, DM, G, bx); pg8::EpiDown E{F.X, F.X, F.B2, F.SS, 1.0f}; pg8::gemm_phase<pg8::EpiDown, SO, true, true>(F.lds, g, S, E, tid); }
        else if constexpr (k == 9) { pg8::Gemm g{F.B2, (const bf16_t*)(ws + WS_W + W_GU2), TT, 2 * FF, DM, 1}; SO S; S.init(TT, 2 * FF, G, bx); pg8::EpiGU E{F.HID, F.SS}; pg8::gemm_phase<pg8::EpiGU, SO, true, true>(F.lds, g, S, E, tid); }
        else if constexpr (k == 10) { pg8::Gemm g{F.HID, (const bf16_t*)(ws + WS_W + W_D2), TT, DM, FF, 1}; SO S; S.init(TT, DM, G, bx); pg8::EpiDown E{F.X, F.X, F.B1, F.SS, 0.5f}; pg8::gemm_phase<pg8::EpiDown, SO, true, true>(F.lds, g, S, E, tid); }
        else { if constexpr (l == 0) conv_first_half(F, 1); else final_norm(F); }
    }
}
#define PHASE(k) if (ph_lo <= (k) && (k) < ph_hi) { run_phase<(k)>(wave_s, lds_raw); if ((k) + 1 < ph_hi) { __syncthreads(); cg::this_grid().sync(); } }
__global__ void __launch_bounds__(NTHR, 2) mk_fwd(Args args) {
    extern __shared__ __attribute__((aligned(16))) unsigned char lds_raw[];
    const int ph_lo = args.ph_lo, ph_hi = args.ph_hi;
    const int wave_s = __builtin_amdgcn_readfirstlane((int)threadIdx.x >> 6);
    PHASE(0) PHASE(1) PHASE(2) PHASE(3) PHASE(4) PHASE(5) PHASE(6) PHASE(7) PHASE(8) PHASE(9) PHASE(10) PHASE(11) PHASE(12)
    PHASE(13) PHASE(14) PHASE(15) PHASE(16) PHASE(17) PHASE(18) PHASE(19) PHASE(20) PHASE(21) PHASE(22) PHASE(23) PHASE(24)
}

extern "C" void kernel_launch(void* const* d_in, const int* in_sizes, int n_in, void* d_out, int out_size, void* d_ws, size_t ws_size, hipStream_t stream) {
    static int grid = 0;
    if (grid == 0) {
        if (n_in != 41 || out_size != TT * DM || ws_size < WS_END) { fprintf(stderr, "kernel_launch: unexpected shapes (n_in %d out %d ws %zu)\n", n_in, out_size, ws_size); grid = -1; return; }
        int dev = 0, cus = 0, per_cu = 0;
        (void)hipGetDevice(&dev); (void)hipDeviceGetAttribute(&cus, hipDeviceAttributeMultiprocessorCount, dev);
        if (hipFuncSetAttribute((const void*)mk_fwd, hipFuncAttributeMaxDynamicSharedMemorySize, LDS_BYTES) != hipSuccess) { fprintf(stderr, "kernel_launch: hipFuncSetAttribute failed\n"); grid = -1; return; }
        if (hipOccupancyMaxActiveBlocksPerMultiprocessor(&per_cu, (const void*)mk_fwd, NTHR, LDS_BYTES) != hipSuccess || per_cu < 1) { fprintf(stderr, "kernel_launch: occupancy query says %d\n", per_cu); per_cu = 1; }
        (void)hipGetLastError();
        grid = cus * (per_cu >= 1 ? 1 : 1);
        if (grid < 64) { fprintf(stderr, "kernel_launch: grid %d too small\n", grid); }
    }
    if (grid < 0) return;
    Args a{};
    for (int i = 0; i < 41; ++i) a.in[i] = (const float*)d_in[i];
    a.out = (float*)d_out; a.ws = (unsigned char*)d_ws;
#if ONE_LAUNCH
    a.ph_lo = 0; a.ph_hi = NPH;
    void* kargs[] = {&a};
    hipError_t e = hipLaunchCooperativeKernel((const void*)mk_fwd, dim3(grid), dim3(NTHR), kargs, LDS_BYTES, stream);
    if (e != hipSuccess) fprintf(stderr, "cooperative launch failed: %s (grid %d)\n", hipGetErrorString(e), grid);
#else
    for (int ph = 0; ph < NPH; ++ph) { a.ph_lo = ph; a.ph_hi = ph + 1; hipLaunchKernelGGL(mk_fwd, dim3(grid), dim3(NTHR), LDS_BYTES, stream, a); }
#endif
}
```

```cpp
#include <hip/hip_runtime.h>
#include <hip/hip_cooperative_groups.h>
#include <cstdio>
#include <cstdint>
#include <cstddef>
namespace cg = cooperative_groups;
namespace pg8 {
#define PG8_LAS __attribute__((address_space(3)))
typedef unsigned short bf16_t;
typedef short bf16x8 __attribute__((ext_vector_type(8)));
typedef float f32x4 __attribute__((ext_vector_type(4)));
typedef unsigned u32x4 __attribute__((ext_vector_type(4)));
constexpr int BM = 256, BK = 64, HALF = 128, HTB = HALF * BK * 2  , STAGE_BYTES = 8 * HTB, NXCD = 8, WGM = 8;

__host__ __device__ __forceinline__ int lds_byte(int r, int c) { const int st = (r >> 4) * 2 + (c >> 5), rr = r & 15, cc = c & 31, ob = rr * 64 + cc * 2; return st * 1024 + (ob ^ (((ob >> 9) & 1) << 5)); }
__host__ __device__ __forceinline__ void stage_rc(int b, int& R, int& C) { const int st = b / 1024, sb = b % 1024, swz = sb ^ (((sb >> 9) & 1) << 5); R = (st >> 1) * 16 + swz / 64; C = (st & 1) * 32 + (swz % 64) / 2; }
__host__ __device__ __forceinline__ int perm32(int rho) { const int n = rho >> 4, i = rho & 15; return 8 * (i >> 2) + 4 * n + (i & 3); }

struct Unit { int pm, pn, g; };
struct Gemm { const bf16_t* A; const bf16_t* Bt; int M, N, K, nseg; };

struct StaticOrder {
    int nM, nN, nwg, G, c;
    __host__ __device__ void init(int M, int N, int G_, int c_) { nM = M / BM; nN = N / BM; nwg = nM * nN; G = G_; c = c_; }
    __host__ __device__ bool next(int i, Unit& u) const {
        const long L = (long)i * G + c; if (L >= nwg) return false;
        int wgid = (int)L; { const int q = nwg / NXCD, r = nwg % NXCD, xcd = wgid % NXCD, off = wgid / NXCD; wgid = (xcd < r ? xcd * (q + 1) : r * (q + 1) + (xcd - r) * q) + off; }
        const int nig = WGM * nN, gid = wgid / nig, fm = gid * WGM, gsz = (nM - fm) < WGM ? (nM - fm) : WGM;
        u.pm = fm + ((wgid % nig) % gsz); u.pn = (wgid % nig) / gsz; u.g = 0; return true;
    }
    __device__ __forceinline__ void a_ready(const Unit&) const {}
    __device__ __forceinline__ void done(const Unit&) const {}
};


struct SegOrder4 {
    StaticOrder so;
    __host__ __device__ bool next(int i, Unit& u) const { if (!so.next(i >> 2, u)) return false; u.g = i & 3; return true; }
    __device__ __forceinline__ void a_ready(const Unit&) const {}
    __device__ __forceinline__ void done(const Unit&) const {}
};

typedef _Float16 h16;
typedef _Float16 h16x4 __attribute__((ext_vector_type(4)));
typedef unsigned u32x2 __attribute__((ext_vector_type(2)));
__device__ __forceinline__ unsigned cvt_pk_bf16(float lo, float hi) { unsigned r; asm volatile("v_cvt_pk_bf16_f32 %0, %1, %2" : "=v"(r) : "v"(lo), "v"(hi)); return r; }
__device__ __forceinline__ u32x2 pack_bf16x4(f32x4 v) { u32x2 w; w.x = cvt_pk_bf16(v[0], v[1]); w.y = cvt_pk_bf16(v[2], v[3]); return w; }
__device__ __forceinline__ h16x4 pack_h16x4(f32x4 v) { h16x4 w; w[0] = (h16)v[0]; w[1] = (h16)v[1]; w[2] = (h16)v[2]; w[3] = (h16)v[3]; return w; }
__device__ __forceinline__ float fast_sigmoid(float x) { return __builtin_amdgcn_rcpf(1.0f + __expf(-x)); }
__device__ __forceinline__ float row_rstd(const float* SS, int row) {
    const f32x4* p = (const f32x4*)(SS + (size_t)row * 16);
    const f32x4 a = p[0], b = p[1], c = p[2], d = p[3];
    const float s = ((a[0] + a[1]) + (a[2] + a[3])) + ((b[0] + b[1]) + (b[2] + b[3])) + ((c[0] + c[1]) + (c[2] + c[3])) + ((d[0] + d[1]) + (d[2] + d[3]));
    return rsqrtf(s * (1.0f / 1024.0f) + 1e-6f);
}

struct EpiGU {
    static constexpr bool PERM = true, KSEG = false;
    bf16_t* hid; const float* SS;
    __device__ __forceinline__ void operator()(const f32x4 (&acc)[2][2][4][2], const Unit& u, int wr, int wc, int fr, int fq) const {
        int row0 = u.pm * BM + wr * 64 + fr; asm volatile("" : "+v"(row0)); const int j0 = u.pn * 128 + wc * 16 + fq * 4;
#pragma unroll
        for (int ai = 0; ai < 2; ++ai)
#pragma unroll
            for (int m = 0; m < 4; ++m) { const int row = row0 + ai * HALF + m * 16; const float rs = row_rstd(SS, row);
#pragma unroll
                for (int bj = 0; bj < 2; ++bj) { const f32x4 g = acc[ai][bj][m][0] * rs, up = acc[ai][bj][m][1] * rs; f32x4 h;
#pragma unroll
                    for (int i = 0; i < 4; ++i) h[i] = g[i] * fast_sigmoid(g[i]) * up[i];
                    *(u32x2*)(hid + (size_t)row * 2816 + j0 + bj * 64) = pack_bf16x4(h); } }
    }
};
struct EpiDown {
    static constexpr bool PERM = false, KSEG = false;
    const float* res; float* X; bf16_t* xb; float* SS; float alpha;
    __device__ __forceinline__ void operator()(const f32x4 (&acc)[2][2][4][2], const Unit& u, int wr, int wc, int fr, int fq) const {
        int row0 = u.pm * BM + wr * 64 + fr; asm volatile("" : "+v"(row0)); const int c0 = u.pn * BM + wc * 32 + fq * 4;
#pragma unroll
        for (int ai = 0; ai < 2; ++ai)
#pragma unroll
            for (int m = 0; m < 4; ++m) { const int row = row0 + ai * HALF + m * 16; float ss = 0.f;
#pragma unroll
                for (int bj = 0; bj < 2; ++bj)
#pragma unroll
                    for (int n = 0; n < 2; ++n) { const size_t off = (size_t)row * 1024 + c0 + bj * HALF + n * 16;
                        const f32x4 r = *(const f32x4*)(res + off); const f32x4 o = r + acc[ai][bj][m][n] * alpha;
                        *(f32x4*)(X + off) = o; *(u32x2*)(xb + off) = pack_bf16x4(o);
                        ss += (o[0] * o[0] + o[1] * o[1]) + (o[2] * o[2] + o[3] * o[3]); }
                ss += __shfl_xor(ss, 16); ss += __shfl_xor(ss, 32);
                if (fq == 0) SS[(size_t)row * 16 + u.pn * 4 + wc] = ss;
                asm volatile("" ::: "memory"); }
    }
};
struct EpiInA {
    static constexpr bool PERM = false, KSEG = false;
    h16* U5; h16* PP; h16* L16; const float* SS;
    __device__ __forceinline__ void operator()(const f32x4 (&acc)[2][2][4][2], const Unit& u, int wr, int wc, int fr, int fq) const {
        int row0 = u.pm * BM + wr * 64 + fr; asm volatile("" : "+v"(row0)); const int cl = wc * 32 + fq * 4;
        h16* base; int ld, cb;
        if (u.pn == 0) { base = U5; ld = 256; cb = 0; } else if (u.pn < 8) { base = PP; ld = 1792; cb = (u.pn - 1) * 256; } else { base = L16; ld = 512; cb = (u.pn - 8) * 256; }
#pragma unroll
        for (int ai = 0; ai < 2; ++ai)
#pragma unroll
            for (int m = 0; m < 4; ++m) { const int row = row0 + ai * HALF + m * 16; const float rs = row_rstd(SS, row);
#pragma unroll
                for (int bj = 0; bj < 2; ++bj)
#pragma unroll
                    for (int n = 0; n < 2; ++n) *(h16x4*)(base + (size_t)row * ld + cb + cl + bj * HALF + n * 16) = pack_h16x4(acc[ai][bj][m][n] * rs); }
    }
};
struct EpiGate {
    static constexpr bool PERM = false, KSEG = false;
    h16* R; const float* SS;
    __device__ __forceinline__ void operator()(const f32x4 (&acc)[2][2][4][2], const Unit& u, int wr, int wc, int fr, int fq) const {
        int row0 = u.pm * BM + wr * 64 + fr; asm volatile("" : "+v"(row0)); const int d0 = 256 * (u.pn >> 2) + 128 * ((u.pn >> 1) & 1) + 16 * (u.pn & 1) + 32 * wc + 4 * fq;
#pragma unroll
        for (int ai = 0; ai < 2; ++ai)
#pragma unroll
            for (int m = 0; m < 4; ++m) { const int row = row0 + ai * HALF + m * 16; const float rs = row_rstd(SS, row);
                f32x4 e[4];
#pragma unroll
                for (int g = 0; g < 4; ++g)
#pragma unroll
                    for (int i = 0; i < 4; ++i) e[g][i] = 1.0f + __expf(-fminf(fmaxf(acc[ai][g >> 1][m][g & 1][i] * rs, -10.f), 30.f));
                f32x4 r[4];
#pragma unroll
                for (int i = 0; i < 4; ++i) { const float i0 = __builtin_amdgcn_rcpf(e[0][i]), i1 = __builtin_amdgcn_rcpf(e[1][i]), i2 = __builtin_amdgcn_rcpf(e[2][i]), i3 = __builtin_amdgcn_rcpf(e[3][i]);
                    r[0][i] = e[1][i] * i0; r[1][i] = e[2][i] * i1; r[2][i] = e[3][i] * i2; r[3][i] = i3; }
#pragma unroll
                for (int g = 0; g < 4; ++g) *(h16x4*)(R + ((size_t)row * 4 + g) * 1024 + d0) = pack_h16x4(r[g]); }
    }
};
struct EpiBranch {
    static constexpr bool PERM = false, KSEG = true;
    const h16* R; bf16_t* out;
    __device__ __forceinline__ void operator()(f32x4 (&acc)[2][2][4][2], const Unit& u, int wr, int wc, int fr, int fq) const {
        unsigned q0 = (unsigned)(u.pm * BM + wr * 64 + fr) * 1024u + (unsigned)(u.pn * BM + wc * 32 + fq * 4); asm volatile("" : "+v"(q0));
        const unsigned r0 = (q0 - (q0 & 1023u)) * 4u + (unsigned)u.g * 1024u + (q0 & 1023u);
        const bool last = u.g == 3;
#pragma unroll
        for (int ai = 0; ai < 2; ++ai)
#pragma unroll
            for (int m = 0; m < 4; ++m) {
#pragma unroll
                for (int bj = 0; bj < 2; ++bj)
#pragma unroll
                    for (int n = 0; n < 2; ++n) { const unsigned off = q0 + (unsigned)((ai * HALF + m * 16) * 1024 + bj * HALF + n * 16);
                        const h16x4 r = *(const h16x4*)(R + (r0 + (unsigned)((ai * HALF + m * 16) * 4096 + bj * HALF + n * 16)));
                        f32x4 rf; rf[0] = (float)r[0]; rf[1] = (float)r[1]; rf[2] = (float)r[2]; rf[3] = (float)r[3];
                        acc[ai][bj][m][n] = acc[ai][bj][m][n] * rf;
                        if (last) *(u32x2*)(out + off) = pack_bf16x4(acc[ai][bj][m][n]); }
                asm volatile("" ::: "memory"); }
    }
};
struct EpiGlu {
    static constexpr bool PERM = false, KSEG = false;
    const bf16_t* gl; bf16_t* ys;
    __device__ __forceinline__ void operator()(const f32x4 (&acc)[2][2][4][2], const Unit& u, int wr, int wc, int fr, int fq) const {
        int row0 = u.pm * BM + wr * 64 + fr; asm volatile("" : "+v"(row0)); const int c0 = wc * 32 + fq * 4;
#pragma unroll
        for (int ai = 0; ai < 2; ++ai)
#pragma unroll
            for (int m = 0; m < 4; ++m) { const int row = row0 + ai * HALF + m * 16;
#pragma unroll
                for (int bj = 0; bj < 2; ++bj)
#pragma unroll
                    for (int n = 0; n < 2; ++n) { const int c = c0 + bj * HALF + n * 16; const u32x2 gv = *(const u32x2*)(gl + (size_t)row * 256 + c);
                        f32x4 g; g[0] = __uint_as_float(gv.x << 16); g[1] = __uint_as_float(gv.x & 0xffff0000u); g[2] = __uint_as_float(gv.y << 16); g[3] = __uint_as_float(gv.y & 0xffff0000u);
                        f32x4 o;
#pragma unroll
                        for (int i = 0; i < 4; ++i) o[i] = g[i] * fast_sigmoid(acc[ai][bj][m][n][i]);
                        *(u32x2*)(ys + (size_t)row * 1024 + c) = pack_bf16x4(o); }
                asm volatile("" ::: "memory"); }
    }
};

template <class Epi, class Sched, bool ALIGN_EPI = false, bool SP2 = false>
__device__ __forceinline__ void gemm_phase(PG8_LAS unsigned char* lds, const Gemm g, const Sched& S, const Epi& E, const int tid) {
    const int wid = __builtin_amdgcn_readfirstlane(tid >> 6), lane = tid & 63, wr = wid >> 2, wc = wid & 3, fr = lane & 15, fq = lane >> 4;
    const int K = g.K, nt = K / BK / g.nseg; const size_t segb = (size_t)(K / g.nseg) * 2;
    unsigned voffA[2], voffB[2];
#pragma unroll
    for (int i = 0; i < 2; ++i) { int R, C; stage_rc(tid * 16 + i * 8192, R, C); const int Rb = Epi::PERM ? ((R & ~31) + perm32(R & 31)) : R;
        voffA[i] = (unsigned)(R * K + C) * 2u; voffB[i] = (unsigned)(Rb * K + C) * 2u; }
    const size_t kstep = (size_t)(BK * 2);
    const size_t hstep = (size_t)HALF * K * 2;
    const size_t tstep = 2 * hstep;
    const unsigned ldsw = (unsigned)wid * 1024u;
    const int aoff = lds_byte(wr * 64 + fr, fq * 8), boff = lds_byte(wc * 32 + fr, fq * 8);
#define PG8_SA(b, h) (((b) * 2 + (h)) * HTB)
#define PG8_SB(b, h) ((4 + (b) * 2 + (h)) * HTB)
#define PG8_STAGE(bufoff, gbase, voff) do { _Pragma("unroll") for (int _i = 0; _i < 2; ++_i) \
        __builtin_amdgcn_global_load_lds((const unsigned*)((const char*)(gbase) + (voff)[_i]), (PG8_LAS unsigned*)(lds + (bufoff) + ldsw + _i * 8192), 16, 0, 0); } while (0)
#define PG8_LDA(dst, b, h) do { _Pragma("unroll") for (int m = 0; m < 4; ++m) _Pragma("unroll") for (int k = 0; k < 2; ++k) dst[m][k] = *(const PG8_LAS bf16x8*)(lds + PG8_SA(b, h) + aoff + m * 2048 + k * 1024); } while (0)
#define PG8_LDB(dst, b, h) do { _Pragma("unroll") for (int n = 0; n < 2; ++n) _Pragma("unroll") for (int k = 0; k < 2; ++k) dst[n][k] = *(const PG8_LAS bf16x8*)(lds + PG8_SB(b, h) + boff + n * 2048 + k * 1024); } while (0)
#define PG8_MMA(ai, bj, At, Bt) do { __builtin_amdgcn_s_setprio(1); _Pragma("unroll") for (int m = 0; m < 4; ++m) _Pragma("unroll") for (int n = 0; n < 2; ++n) _Pragma("unroll") for (int k = 0; k < 2; ++k) \
        acc[ai][bj][m][n] = __builtin_amdgcn_mfma_f32_16x16x32_bf16(Bt[n][k], At[m][k], acc[ai][bj][m][n], 0, 0, 0); __builtin_amdgcn_s_setprio(0); } while (0)
#define PG8_WAIT_V(n) asm volatile("s_waitcnt vmcnt(" #n ")" ::: "memory")
#define PG8_WAIT_L(n) asm volatile("s_waitcnt lgkmcnt(" #n ")" ::: "memory")
#define PG8_BAR __builtin_amdgcn_s_barrier()
#define PG8_SCHED __builtin_amdgcn_sched_barrier(0)
    Unit cur, nxt; int ui = 0;
    if (!S.next(0, cur)) return;
    f32x4 acc[2][2][4][2];
#pragma unroll
    for (int a = 0; a < 2; ++a)
#pragma unroll
        for (int b = 0; b < 2; ++b)
#pragma unroll
            for (int m = 0; m < 4; ++m)
#pragma unroll
                for (int n = 0; n < 2; ++n) acc[a][b][m][n] = (f32x4){0.f, 0.f, 0.f, 0.f};
    bf16x8 At[4][2], B0[2][2], B1[2][2];
    const char* cA = (const char*)g.A + (size_t)cur.pm * tstep + (size_t)cur.g * segb; const char* cB = (const char*)g.Bt + (size_t)cur.pn * tstep + (size_t)cur.g * segb;
    S.a_ready(cur);
    if constexpr (SP2) {
        PG8_STAGE(PG8_SB(0, 0), cB, voffB); PG8_STAGE(PG8_SB(0, 1), cB + hstep, voffB); PG8_STAGE(PG8_SA(0, 0), cA, voffA); PG8_STAGE(PG8_SA(0, 1), cA + hstep, voffA);
        if (wr == 1) PG8_BAR;
        PG8_WAIT_V(2); PG8_BAR;
        PG8_STAGE(PG8_SB(1, 0), cB + kstep, voffB); PG8_STAGE(PG8_SA(1, 0), cA + kstep, voffA); PG8_STAGE(PG8_SB(1, 1), cB + hstep + kstep, voffB);
        PG8_WAIT_V(6); PG8_BAR;
    } else {
        PG8_STAGE(PG8_SB(0, 0), cB, voffB); PG8_STAGE(PG8_SA(0, 0), cA, voffA); PG8_STAGE(PG8_SB(0, 1), cB + hstep, voffB); PG8_STAGE(PG8_SA(0, 1), cA + hstep, voffA);
        if (wr == 1) PG8_BAR;
        PG8_WAIT_V(4); PG8_BAR;
        PG8_STAGE(PG8_SB(1, 0), cB + kstep, voffB); PG8_STAGE(PG8_SA(1, 0), cA + kstep, voffA); PG8_STAGE(PG8_SB(1, 1), cB + hstep + kstep, voffB);
        PG8_WAIT_V(6); PG8_BAR;
    }
    for (;;) {
        const bool has_next = S.next(ui + 1, nxt);
        const char* nA = has_next ? (const char*)g.A + (size_t)nxt.pm * tstep + (size_t)nxt.g * segb : cA; const char* nB = has_next ? (const char*)g.Bt + (size_t)nxt.pn * tstep + (size_t)nxt.g * segb : cB;
        for (int t = 0; t < nt; t += 2) {
            const bool last = (t == nt - 2);
            const char* a1 = cA + (size_t)(t + 1) * kstep;
            const char* a2 = last ? nA : cA + (size_t)(t + 2) * kstep; const char* b2 = last ? nB : cB + (size_t)(t + 2) * kstep;
            const char* a3 = a2 + kstep; const char* b3 = b2 + kstep;
            if (last && has_next) S.a_ready(nxt);
            if constexpr (SP2) {
            PG8_LDB(B0, 0, 0); PG8_LDB(B1, 0, 1); PG8_SCHED; PG8_LDA(At, 0, 0); PG8_STAGE(PG8_SA(1, 1), a1 + hstep, voffA);
            PG8_WAIT_V(8); PG8_WAIT_L(0); PG8_BAR; PG8_MMA(0, 0, At, B0); PG8_MMA(0, 1, At, B1); PG8_BAR; PG8_SCHED;
            PG8_LDA(At, 0, 1); PG8_STAGE(PG8_SB(0, 0), b2, voffB); PG8_STAGE(PG8_SB(0, 1), b2 + hstep, voffB); PG8_STAGE(PG8_SA(0, 0), a2, voffA);
            PG8_WAIT_V(8); PG8_WAIT_L(0); PG8_BAR; PG8_MMA(1, 0, At, B0); PG8_MMA(1, 1, At, B1); PG8_BAR; PG8_SCHED;
            PG8_LDB(B0, 1, 0); PG8_LDB(B1, 1, 1); PG8_SCHED; PG8_LDA(At, 1, 0); PG8_STAGE(PG8_SA(0, 1), a2 + hstep, voffA);
            PG8_WAIT_V(8); PG8_WAIT_L(0); PG8_BAR; PG8_MMA(0, 0, At, B0); PG8_MMA(0, 1, At, B1); PG8_BAR; PG8_SCHED;
            PG8_LDA(At, 1, 1); PG8_STAGE(PG8_SB(1, 0), b3, voffB); PG8_STAGE(PG8_SB(1, 1), b3 + hstep, voffB); PG8_STAGE(PG8_SA(1, 0), a3, voffA);
            PG8_WAIT_V(8); PG8_WAIT_L(0); PG8_BAR; PG8_MMA(1, 0, At, B0); PG8_MMA(1, 1, At, B1); PG8_BAR; PG8_SCHED;
            } else {
            PG8_LDB(B0, 0, 0); PG8_SCHED; PG8_LDA(At, 0, 0); PG8_STAGE(PG8_SA(1, 1), a1 + hstep, voffA);
            PG8_WAIT_L(8); PG8_BAR; PG8_WAIT_L(0); PG8_MMA(0, 0, At, B0); PG8_BAR; PG8_SCHED;
            PG8_LDB(B1, 0, 1); PG8_STAGE(PG8_SB(0, 0), b2, voffB);
            PG8_BAR; PG8_WAIT_L(0); PG8_MMA(0, 1, At, B1); PG8_BAR;
            PG8_LDA(At, 0, 1); PG8_STAGE(PG8_SA(0, 0), a2, voffA);
            PG8_BAR; PG8_WAIT_L(0); PG8_MMA(1, 0, At, B0); PG8_BAR; PG8_SCHED;
            PG8_STAGE(PG8_SB(0, 1), b2 + hstep, voffB);
            PG8_WAIT_V(6); PG8_BAR; PG8_MMA(1, 1, At, B1); PG8_BAR;
            PG8_LDB(B0, 1, 0); PG8_SCHED; PG8_LDA(At, 1, 0); PG8_STAGE(PG8_SA(0, 1), a2 + hstep, voffA);
            PG8_WAIT_L(8); PG8_BAR; PG8_WAIT_L(0); PG8_MMA(0, 0, At, B0); PG8_BAR; PG8_SCHED;
            PG8_LDB(B1, 1, 1); PG8_STAGE(PG8_SB(1, 0), b3, voffB);
            PG8_BAR; PG8_WAIT_L(0); PG8_MMA(0, 1, At, B1); PG8_BAR;
            PG8_LDA(At, 1, 1); PG8_STAGE(PG8_SA(1, 0), a3, voffA);
            PG8_BAR; PG8_WAIT_L(0); PG8_MMA(1, 0, At, B0); PG8_BAR; PG8_SCHED;
            PG8_STAGE(PG8_SB(1, 1), b3 + hstep, voffB);
            PG8_WAIT_V(6); PG8_BAR; PG8_MMA(1, 1, At, B1); PG8_BAR;
            }
        }
        if constexpr (ALIGN_EPI) { if (wr == 0) PG8_BAR; }
        E(acc, cur, wr, wc, fr, fq); S.done(cur);
        if (!has_next) break;
        if (!(Epi::KSEG && nxt.g != 0))
#pragma unroll
        for (int a = 0; a < 2; ++a)
#pragma unroll
            for (int b = 0; b < 2; ++b)
#pragma unroll
                for (int m = 0; m < 4; ++m)
#pragma unroll
                    for (int n = 0; n < 2; ++n) acc[a][b][m][n] = (f32x4){0.f, 0.f, 0.f, 0.f};
        cur = nxt; cA = nA; cB = nB; ++ui;
        if constexpr (ALIGN_EPI) { if (wr == 1) PG8_BAR; }
    }
    PG8_WAIT_V(0);
    if constexpr (!ALIGN_EPI) { if (wr == 0) PG8_BAR; }
    PG8_BAR;
#undef PG8_SA
#undef PG8_SB
#undef PG8_STAGE
#undef PG8_LDA
#undef PG8_LDB
#undef PG8_MMA
#undef PG8_WAIT_V
#undef PG8_WAIT_L
#undef PG8_BAR
#undef PG8_SCHED
}
}

#define LAS __attribute__((address_space(3)))
typedef unsigned short bf16_t;
typedef _Float16 h16;
typedef _Float16 h16x4 __attribute__((ext_vector_type(4)));
typedef _Float16 h16x8 __attribute__((ext_vector_type(8)));
typedef float f32x4 __attribute__((ext_vector_type(4)));
typedef float f32x2 __attribute__((ext_vector_type(2)));
typedef unsigned u32x4 __attribute__((ext_vector_type(4)));
typedef unsigned u32x2 __attribute__((ext_vector_type(2)));

#ifndef ONE_LAUNCH
#define ONE_LAUNCH 1
#endif
constexpr int NWAVES = 8, NTHR = 512;
constexpr int TT = 16384, SEQ = 8192, DM = 1024, FF = 2816, MW = 256, INW = 6144;
constexpr int LDS_BYTES = 147456;
constexpr size_t MiB = 1u << 20;
constexpr size_t WS_SS = 1 * MiB, WS_E = 2 * MiB, WS_W = 4 * MiB, WS_B1 = 34 * MiB, WS_B2 = 66 * MiB, WS_Z = 98 * MiB, WS_END = 242 * MiB;
constexpr size_t W_GU1 = 0, W_D1 = W_GU1 + (size_t)2 * FF * DM * 2, W_INA = W_D1 + (size_t)DM * FF * 2;
constexpr size_t W_ING = 0, W_BR = W_ING + (size_t)4096 * DM * 2, W_O = W_BR + (size_t)DM * DM * 2, W_GU2 = W_O + (size_t)DM * DM * 2, W_D2 = W_GU2 + (size_t)2 * FF * DM * 2, W_GLU = W_D2 + (size_t)DM * FF * 2, W_END2 = W_GLU + 256 * 256 * 2;
static_assert(W_END2 <= 30 * MiB && W_INA + (size_t)2560 * DM * 2 <= 30 * MiB, "W region");
constexpr size_t Z_RW = 0, Z_G16 = 56 * MiB, Z_U5 = 64 * MiB, Z_L16 = 72 * MiB, Z_PP = 88 * MiB, Z_O = 88 * MiB, Z_GL = 104 * MiB;
constexpr size_t Z_HID = 0, Z_R = 0;
static_assert((size_t)TT * 4 * 896 <= 56 * MiB && (size_t)TT * 1792 * 2 <= 56 * MiB && (size_t)TT * FF * 2 <= 144 * MiB && (size_t)TT * 4096 * 2 <= 144 * MiB, "Z region");

typedef const float* cfp_t;
typedef const __attribute__((address_space(4))) cfp_t* in_t;
struct Args { const float* in[41]; float* out; unsigned char* ws; int ph_lo, ph_hi; };

struct Frame {
    LAS unsigned char* lds;
    int tid, lane, wave, G, bx;
    in_t in;
    float* X; unsigned char* ws;
    float* SS; float* E;
    bf16_t *B1, *B2, *HID, *GL;
    h16 *U5, *PP, *L16, *G16, *R;
    float* O; unsigned char* RW;
};

__device__ __forceinline__ unsigned f2bf(float f) { unsigned u = __builtin_bit_cast(unsigned, f); return (u + 0x7fffu + ((u >> 16) & 1u)) >> 16; }
__device__ __forceinline__ unsigned pk2(float lo, float hi) { return f2bf(lo) | (f2bf(hi) << 16); }
#define LDS_WAIT() asm volatile("s_waitcnt lgkmcnt(0)" ::: "memory")
template <int CTRL> __device__ __forceinline__ float dppx(float x) { return __builtin_bit_cast(float, __builtin_amdgcn_update_dpp(0, __builtin_bit_cast(int, x), CTRL, 0xf, 0xf, true)); }
__device__ __forceinline__ float allreduce16(float x) { x += dppx<0xB1>(x); x += dppx<0x4E>(x); x += dppx<0x141>(x); x += dppx<0x140>(x); return x; }
__device__ __forceinline__ float wave_sum(float x) { x = allreduce16(x); x += __shfl_xor(x, 16); x += __shfl_xor(x, 32); return x; }
__device__ __forceinline__ float sigmoidf_(float x) { return 1.0f / (1.0f + __expf(-x)); }

__device__ __forceinline__ int tr_rowmap(int mode, int j, int row0) {
    if (mode == 0) return row0 + j;
    if (mode == 1) return 8 * (j >> 2) + (j & 3);
    if (mode == 2) return 8 * (j >> 2) + 4 + (j & 3);
    const int g = j >> 10, d = j & 1023;
    const int pn = 4 * (d >> 8) + 2 * ((d >> 7) & 1) + ((d >> 4) & 1);
    return 256 * pn + 128 * (g >> 1) + 32 * ((d >> 5) & 3) + 16 * (g & 1) + 4 * ((d >> 2) & 3) + (d & 3);
}
__device__ __forceinline__ void tr_item(const float* W, int ldw, int K, int N, bf16_t* WT, int mode, int row0, const float* s1, const float* s2, int smode, LAS float* scr, int item, int lane) {
    const int nblk = N / 32, kb = item / nblk, nb = item % nblk, k0 = 64 * kb, n0 = 32 * nb;
#pragma unroll 8
    for (int i = 0; i < 32; ++i) { const int kk = 2 * i + (lane >> 5); const int k = k0 + kk; float sc = 1.0f;
        if (s1) sc = s1[k];
        if (smode == 1) sc *= s2[k]; else if (smode == 2) sc *= (1.0f - s2[k]);
        scr[kk * 33 + (lane & 31)] = W[(size_t)k * ldw + n0 + (lane & 31)] * sc; }
    LDS_WAIT(); asm volatile("" ::: "memory");
    const int c = lane & 7;
#pragma unroll
    for (int j = 0; j < 4; ++j) { const int n = (lane >> 3) + 8 * j; const LAS float* s = scr + (8 * c) * 33 + n;
        u32x4 o; o.x = pk2(s[0 * 33], s[1 * 33]); o.y = pk2(s[2 * 33], s[3 * 33]); o.z = pk2(s[4 * 33], s[5 * 33]); o.w = pk2(s[6 * 33], s[7 * 33]);
        *(u32x4*)(WT + (size_t)tr_rowmap(mode, n0 + n, row0) * K + k0 + 8 * c) = o; }
    LDS_WAIT(); asm volatile("" ::: "memory");
}
#define TRJ(W_, ldw_, K_, N_, dst_, mode_, row0_, s1_, s2_, smode_) { const int ni_ = ((K_) / 64) * ((N_) / 32); if (r >= 0 && r < ni_) tr_item(W_, ldw_, K_, N_, dst_, mode_, row0_, s1_, s2_, smode_, scr, r, F.lane); r -= ni_; }
__device__ __forceinline__ void conv_first_half(Frame& F, int l) {
    LAS float* scr = (LAS float*)(F.lds + F.wave * 16384);
    const int gw = F.bx * NWAVES + F.wave, NGW = F.G * NWAVES;
    unsigned char* wb = F.ws + WS_W;
    const float* n1 = F.in[1] + (size_t)l * DM; const float* nm = F.in[5] + (size_t)l * DM; const float* mu = F.in[19] + (size_t)l * 3 * DM;
    const float* w1 = F.in[21] + (size_t)l * DM * 64; const float* a1 = F.in[24] + (size_t)l * DM * 64; const float* g1 = F.in[26] + (size_t)l * DM * 128;
    bf16_t* ina = (bf16_t*)(wb + W_INA);
    for (int it = gw;; it += NGW) { int r = it;
        TRJ(F.in[2] + (size_t)l * DM * FF, FF, DM, FF, (bf16_t*)(wb + W_GU1), 1, 0, n1, nullptr, 0)
        TRJ(F.in[3] + (size_t)l * DM * FF, FF, DM, FF, (bf16_t*)(wb + W_GU1), 2, 0, n1, nullptr, 0)
        TRJ(F.in[4] + (size_t)l * FF * DM, DM, FF, DM, (bf16_t*)(wb + W_D1), 0, 0, nullptr, nullptr, 0)
        TRJ(F.in[6] + (size_t)l * DM * INW, INW, DM, 2048, ina, 0, 0, nm, nullptr, 0)
        TRJ(w1, 64, DM, 64, ina, 0, 2048, nm, mu, 2)
        TRJ(a1, 64, DM, 64, ina, 0, 2112, nm, mu + DM, 2)
        TRJ(g1, 128, DM, 128, ina, 0, 2176, nm, mu + 2 * DM, 2)
        TRJ(w1, 64, DM, 64, ina, 0, 2304, nm, mu, 1)
        TRJ(a1, 64, DM, 64, ina, 0, 2368, nm, mu + DM, 1)
        TRJ(g1, 128, DM, 128, ina, 0, 2432, nm, mu + 2 * DM, 1)
        if (r >= 0) break; }
}
__device__ __forceinline__ void conv_second_half(Frame& F, int l) {
    LAS float* scr = (LAS float*)(F.lds + F.wave * 16384);
    const int gw = F.bx * NWAVES + F.wave, NGW = F.G * NWAVES;
    unsigned char* wb = F.ws + WS_W;
    const float* nm = F.in[5] + (size_t)l * DM; const float* n2 = F.in[36] + (size_t)l * DM;
    for (int it = gw;; it += NGW) { int r = it;
        TRJ(F.in[6] + (size_t)l * DM * INW + 2048, INW, DM, 4096, (bf16_t*)(wb + W_ING), 3, 0, nm, nullptr, 0)
        TRJ(F.in[34] + (size_t)l * DM * DM, DM, DM, DM, (bf16_t*)(wb + W_BR), 0, 0, nullptr, nullptr, 0)
        TRJ(F.in[35] + (size_t)l * DM * DM, DM, DM, DM, (bf16_t*)(wb + W_O), 0, 0, nullptr, nullptr, 0)
        TRJ(F.in[37] + (size_t)l * DM * FF, FF, DM, FF, (bf16_t*)(wb + W_GU2), 1, 0, n2, nullptr, 0)
        TRJ(F.in[38] + (size_t)l * DM * FF, FF, DM, FF, (bf16_t*)(wb + W_GU2), 2, 0, n2, nullptr, 0)
        TRJ(F.in[39] + (size_t)l * FF * DM, DM, FF, DM, (bf16_t*)(wb + W_D2), 0, 0, nullptr, nullptr, 0)
        TRJ(F.in[15] + (size_t)l * 256 * 256, 256, 256, 256, (bf16_t*)(wb + W_GLU), 0, 0, nullptr, nullptr, 0)
        if (r >= 0) break; }
}
__device__ __forceinline__ void prep_x(Frame& F) {
    const int gw = F.bx * NWAVES + F.wave, NGW = F.G * NWAVES;
    const float* x = F.in[0];
    for (int m = gw; m < TT; m += NGW) {
        const f32x4* xr = (const f32x4*)(x + (size_t)m * DM) + F.lane; float s = 0.f;
        unsigned long long* o8 = (unsigned long long*)(F.B1 + (size_t)m * DM) + F.lane;
#pragma unroll
        for (int j = 0; j < 4; ++j) { const f32x4 v = xr[64 * j]; s += (v[0] * v[0] + v[1] * v[1]) + (v[2] * v[2] + v[3] * v[3]);
            o8[64 * j] = (unsigned long long)pk2(v[0], v[1]) | ((unsigned long long)pk2(v[2], v[3]) << 32); }
        s += __shfl_xor(s, 1); s += __shfl_xor(s, 2);
        if ((F.lane & 3) == 0) F.SS[(size_t)m * 16 + (F.lane >> 2)] = s;
    }
}
__device__ __forceinline__ void final_norm(Frame& F) {
    const int gw = F.bx * NWAVES + F.wave, NGW = F.G * NWAVES;
    const f32x4* gn = (const f32x4*)F.in[40] + F.lane;
    for (int m = gw; m < TT; m += NGW) {
        const float rs = pg8::row_rstd(F.SS, m);
        f32x4* xr = (f32x4*)(F.X + (size_t)m * DM) + F.lane;
#pragma unroll
        for (int j = 0; j < 4; ++j) { const f32x4 v = xr[64 * j]; xr[64 * j] = v * rs * gn[64 * j]; }
    }
}

struct S5Par { float ar, ai; float bbr[16], bbi[16]; };
__device__ __forceinline__ void s5_params(Frame& F, int l, int g, int p, S5Par& P) {
    asm volatile("" : "+v"(p));
    const float lr = F.in[7][((size_t)l * 16 + g) * 64 + p], li = F.in[8][((size_t)l * 16 + g) * 64 + p], dt = expf(F.in[9][l * 16 + g]);
    const float mag = expf(lr * dt); P.ar = mag * cosf(li * dt); P.ai = mag * sinf(li * dt);
    const float inv = 1.0f / (lr * lr + li * li); const float qr = lr * inv, qi = -li * inv;
    const float cr = (P.ar - 1.0f) * qr - P.ai * qi, ci = (P.ar - 1.0f) * qi + P.ai * qr;
    const f32x4* br = (const f32x4*)(F.in[10] + (((size_t)l * 16 + g) * 64 + p) * 16); const f32x4* bi = (const f32x4*)(F.in[11] + (((size_t)l * 16 + g) * 64 + p) * 16);
#pragma unroll
    for (int q = 0; q < 4; ++q) { const f32x4 a = br[q], b = bi[q];
#pragma unroll
        for (int i = 0; i < 4; ++i) { P.bbr[4 * q + i] = cr * a[i] - ci * b[i]; P.bbi[4 * q + i] = cr * b[i] + ci * a[i]; } }
}
__device__ __forceinline__ void s5_step(const S5Par& P, const LAS float* urow, float& hr, float& hi) {
    const LAS f32x4* u4 = (const LAS f32x4*)urow; float bur = 0.f, bui = 0.f;
#pragma unroll
    for (int q = 0; q < 4; ++q) { const f32x4 u = u4[q];
#pragma unroll
        for (int i = 0; i < 4; ++i) { bur += P.bbr[4 * q + i] * u[i]; bui += P.bbi[4 * q + i] * u[i]; } }
    const float nr = P.ar * hr - P.ai * hi + bur, ni = P.ar * hi + P.ai * hr + bui; hr = nr; hi = ni;
}
__device__ __forceinline__ void load_u5_tile(Frame& F, int t0, LAS float* ubuf) {
    for (int i = F.tid; i < 64 * 64; i += NTHR) { const int t = i >> 6, q = i & 63; const h16x4 v = *(const h16x4*)(F.U5 + (size_t)(t0 + t) * 256 + 4 * q);
        f32x4 f; f[0] = (float)v[0]; f[1] = (float)v[1]; f[2] = (float)v[2]; f[3] = (float)v[3]; *(LAS f32x4*)(ubuf + t * 256 + 4 * q) = f; }
}


template <bool FIRST> __device__ __forceinline__ void mv32(LAS float* accp, float init, const LAS float* hb, const float* wsrc, int ldw) {
    float w[32];
    asm volatile("" : "+v"(wsrc));
#pragma unroll
    for (int j = 0; j < 32; ++j) w[j] = wsrc[(size_t)j * ldw];
#pragma unroll 2
    for (int tt = 0; tt < 32; ++tt) { const LAS f32x4* h4 = (const LAS f32x4*)(hb + tt * 256); float a = FIRST ? init : accp[tt * 256];
#pragma unroll
        for (int q = 0; q < 8; ++q) { const f32x4 v = h4[q]; a += v[0] * w[4 * q] + v[1] * w[4 * q + 1] + v[2] * w[4 * q + 2] + v[3] * w[4 * q + 3]; }
        accp[tt * 256] = a; }
}
__device__ __forceinline__ void m1_phase(Frame& F, int l) {
    conv_second_half(F, l);
    __syncthreads();
    LAS float* ubuf = (LAS float*)F.lds;
    LAS float* pl = (LAS float*)(F.lds + 65536);
    const int tid = F.tid, lane = F.lane, wave = F.wave;
    const int ch = tid & 255, half = tid >> 8;
    for (int c = F.bx; c < TT / 64; c += F.G) {
        const int t0 = c * 64, tb = t0 + half * 32, sb = tb & (SEQ - 1);
        load_u5_tile(F, t0, ubuf);
        {
            const int grp = ch >> 6, win = 2 << grp;
            const h16* up = F.PP + (size_t)tb * 1792 + ch;
            float s = 0.f;
            for (int j = 1; j <= win; ++j) if (sb - j >= 0) s += (float)up[-(ptrdiff_t)j * 1792];
            for (int tt = 0; tt < 32; ++tt) { const float u = (float)up[(size_t)tt * 1792]; s += u; const int pos = sb + tt;
                if (pos - win >= 0) s -= (float)up[(ptrdiff_t)(tt - win) * 1792];
                const float cnt = (float)((pos + 1 < win) ? (pos + 1) : win);
                pl[(half * 32 + tt) * 256 + ch] = s / cnt - u; }
        }
        {
            const h16* zp = F.PP + (size_t)tb * 1792 + 1024 + ch;
            const float cw0 = F.in[33][((size_t)l * 3 + 0) * 256 + ch], cw1 = F.in[33][((size_t)l * 3 + 1) * 256 + ch], cw2 = F.in[33][((size_t)l * 3 + 2) * 256 + ch];
            float z2 = 0.f, z1 = 0.f;
            if (sb >= 1) z1 = (float)zp[-(ptrdiff_t)1792 + 512] * (float)zp[-(ptrdiff_t)1792];
            if (sb >= 2) z2 = (float)zp[-(ptrdiff_t)2 * 1792 + 512] * (float)zp[-(ptrdiff_t)2 * 1792];
            for (int tt = 0; tt < 32; ++tt) { const h16* q = zp + (size_t)tt * 1792; const float z0 = (float)q[512] * (float)q[0];
                const float y = (float)q[256] * (cw0 * z2 + cw1 * z1 + cw2 * z0);
                F.B2[(size_t)(tb + tt) * 1024 + 768 + ch] = (bf16_t)f2bf(y); z2 = z1; z1 = z0; }
        }
        __syncthreads();
#pragma unroll 1
        for (int gi = 0; gi < 2; ++gi) { const int g = wave + 8 * gi; S5Par P; s5_params(F, l, g, lane, P); float hr = 0.f, hi = 0.f;
#pragma unroll 2
            for (int j = 0; j < 64; ++j) s5_step(P, ubuf + j * 256 + g * 16, hr, hi);
            *(f32x2*)(F.E + (((size_t)c * 16 + g) * 64 + lane) * 2) = (f32x2){hr, hi}; }
        __syncthreads();
        LAS float* accu = ubuf + half * 32 * 256 + ch;
        LAS float* accp = pl + half * 32 * 256 + ch;
        {
            const int grp = ch >> 6, d = ch & 63;
            const float* pw = F.in[16] + (((size_t)l * 4 + grp) * 64) * 64 + d;
            mv32<true>(accu, 0.f, pl + half * 32 * 256 + grp * 64, pw, 64);
            mv32<false>(accu, 0.f, pl + half * 32 * 256 + grp * 64 + 32, pw + 32 * 64, 64);
            const float sc = F.in[17][(size_t)l * 256 + ch];
#pragma unroll 4
            for (int tt = 0; tt < 32; ++tt) F.B2[(size_t)(tb + tt) * 1024 + 256 + ch] = (bf16_t)f2bf(accu[tt * 256] * sc);
        }
        __syncthreads();
#pragma unroll 4
        for (int tt = 0; tt < 32; ++tt) { const int t = tb + tt; float pre = (float)F.L16[(size_t)t * 512 + ch];
            if (sb + tt > 0) pre += (float)F.L16[(size_t)(t - 1) * 512 + 256 + ch];
            float a = pre; if (ch < 64) a = tanhf(pre); else if (ch >= 128) a = sigmoidf_(pre);
            ubuf[(half * 32 + tt) * 256 + ch] = a; }
        __syncthreads();
        const int hb = (t0 / SEQ) * 4 + (ch >> 6);
        unsigned char* rwb = F.RW + ((size_t)hb * SEQ + sb) * 896;
        const int cl = ch & 63;
        const LAS float* hrow = ubuf + half * 32 * 256;
        {
            const float* wp = F.in[22] + (size_t)l * 64 * 256 + ch;
            mv32<true>(accp, F.in[20][(size_t)l * 256 + ch], hrow, wp, 256);
            mv32<false>(accp, 0.f, hrow + 32, wp + 32 * 256, 256);
#pragma unroll 2
            for (int tt = 0; tt < 32; ++tt) { const float z = -accp[tt * 256]; const float sp = fmaxf(z, 0.f) + log1pf(expf(-fabsf(z)));
                const float wlog = -sp - 0.5f; const float dec = expf(-expf(wlog));
                *(float*)(rwb + (size_t)tt * 896 + cl * 4) = dec; }
        }
        {
            const float* gp = F.in[27] + (size_t)l * 128 * 256 + ch;
            mv32<true>(accp, 0.f, hrow + 128, gp, 256);
#pragma unroll 1
            for (int kc = 1; kc < 4; ++kc) mv32<false>(accp, 0.f, hrow + 128 + kc * 32, gp + (size_t)kc * 32 * 256, 256);
#pragma unroll 4
            for (int tt = 0; tt < 32; ++tt) F.G16[(size_t)(tb + tt) * 256 + ch] = (h16)accp[tt * 256];
        }
        {
            const float* ap = F.in[25] + (size_t)l * 64 * 256 + ch;
            mv32<true>(accp, F.in[23][(size_t)l * 256 + ch], hrow + 64, ap, 256);
            mv32<false>(accp, 0.f, hrow + 96, ap + 32 * 256, 256);
            const float mur = F.in[18][((size_t)l * 3 + 0) * 256 + ch], muk = F.in[18][((size_t)l * 3 + 1) * 256 + ch], muv = F.in[18][((size_t)l * 3 + 2) * 256 + ch];
            const float kkw = F.in[28][(size_t)l * 256 + ch], kaw = F.in[29][(size_t)l * 256 + ch];
            const h16* pp = F.PP + (size_t)tb * 1792 + 256 + ch;
            float rprev = 0.f, kprev = 0.f, vprev = 0.f;
            if (sb > 0) { rprev = (float)pp[-(ptrdiff_t)1792]; kprev = (float)pp[-(ptrdiff_t)1792 + 256]; vprev = (float)pp[-(ptrdiff_t)1792 + 512]; }
#pragma unroll 2
            for (int tt = 0; tt < 32; ++tt) { const float a = sigmoidf_(accp[tt * 256]);
                const h16* q = pp + (size_t)tt * 1792; const float rp = (float)q[0], kp = (float)q[256], vp = (float)q[512];
                const float r = rp + (rprev - rp) * mur, k = kp + (kprev - kp) * muk, v = vp + (vprev - vp) * muv;
                rprev = rp; kprev = kp; vprev = vp;
                const float kkv = k * kkw; const float nrm = sqrtf(wave_sum(kkv * kkv)); const float kk = kkv / fmaxf(nrm, 1e-12f);
                const float kt = k * (1.0f + (a - 1.0f) * kaw); const float bb = kk * a;
                h16* o = (h16*)(rwb + (size_t)tt * 896 + 256) + cl;
                o[0] = (h16)r; o[64] = (h16)kt; o[128] = (h16)v; o[192] = (h16)kk; o[256] = (h16)bb; }
        }
        __syncthreads();
    }
}

constexpr int SC_STEPS = 32, SC_FL = SC_STEPS * 384;
__device__ __forceinline__ void scan_load(const unsigned char* src, int cc, int lt, u32x4 (&rg)[7]) {
#pragma unroll
    for (int n = 0; n < 7; ++n) { const int i = lt + 256 * n, step = i / 56, j = i % 56;
        rg[n] = *(const u32x4*)(src + ((size_t)cc * SC_STEPS + step) * 896 + (j < 16 ? j * 16 : 256 + (j - 16) * 16)); }
}
__device__ __forceinline__ void scan_store(LAS float* buf, int lt, const u32x4 (&rg)[7]) {
#pragma unroll
    for (int n = 0; n < 7; ++n) { const int i = lt + 256 * n, step = i / 56, j = i % 56;
        if (j < 16) { *(LAS u32x4*)(buf + step * 384 + j * 4) = rg[n]; }
        else { const int a = (j - 16) >> 3, e = (j - 16) & 7; const h16x8 h = __builtin_bit_cast(h16x8, rg[n]); f32x4 lo, hi;
            lo[0] = (float)h[0]; lo[1] = (float)h[1]; lo[2] = (float)h[2]; lo[3] = (float)h[3]; hi[0] = (float)h[4]; hi[1] = (float)h[5]; hi[2] = (float)h[6]; hi[3] = (float)h[7];
            LAS f32x4* d = (LAS f32x4*)(buf + step * 384 + 64 + a * 64 + e * 8); d[0] = lo; d[1] = hi; } }
}
#define RAW_BAR() do { asm volatile("s_waitcnt lgkmcnt(0)" ::: "memory"); __builtin_amdgcn_s_barrier(); asm volatile("" ::: "memory"); } while (0)
__device__ __forceinline__ void rwkv_scan(Frame& F) {
    const int blk = F.bx, hb = blk >> 2, q = blk & 3, b = hb >> 2, h = hb & 3;
    const unsigned char* src = F.RW + (size_t)hb * SEQ * 896;
    LAS float* buf = (LAS float*)F.lds;
    LAS float* obuf = (LAS float*)(F.lds + 2 * SC_FL * 4);
    const int wave = F.wave, lane = F.lane; const bool loader = wave >= 4; const int lt = F.tid - 256;
    constexpr int NCH = SEQ / SC_STEPS;
    u32x4 rg[7];
    if (loader) { scan_load(src, 0, lt, rg); scan_store(buf, lt, rg); scan_load(src, 1, lt, rg); }
    RAW_BAR();
    float S0 = 0.f, S1 = 0.f, S2 = 0.f, S3 = 0.f;
    const int rl = (wave & 3) * 4 + (lane >> 4), row = q * 16 + rl, ks = lane & 15;
    float* Og = F.O + ((size_t)b * SEQ) * 256 + h * 64 + q * 16;
#pragma unroll 1
    for (int cc = 0; cc < NCH; ++cc) {
        if (loader) {
            if (cc > 0) { const LAS float* ob = obuf + ((cc - 1) & 1) * 512;
#pragma unroll
                for (int n = 0; n < 2; ++n) { const int i = lt + 256 * n; Og[((size_t)(cc - 1) * SC_STEPS + (i >> 4)) * 256 + (i & 15)] = ob[i]; } }
            if (cc + 1 < NCH) { scan_store(buf + ((cc + 1) & 1) * SC_FL, lt, rg); if (cc + 2 < NCH) scan_load(src, cc + 2, lt, rg); }
        } else {
            const LAS float* bb = buf + (cc & 1) * SC_FL; LAS float* ob = obuf + (cc & 1) * 512;
#pragma unroll 4
            for (int s = 0; s < SC_STEPS; ++s) { const LAS float* p = bb + s * 384;
                const f32x4 w = *(const LAS f32x4*)(p + 4 * ks), r = *(const LAS f32x4*)(p + 64 + 4 * ks), k = *(const LAS f32x4*)(p + 128 + 4 * ks);
                const f32x4 kk = *(const LAS f32x4*)(p + 256 + 4 * ks), bv = *(const LAS f32x4*)(p + 320 + 4 * ks); const float v = p[192 + row];
                float sa = (S0 * kk[0] + S1 * kk[1]) + (S2 * kk[2] + S3 * kk[3]); sa = allreduce16(sa); const float nsa = -sa;
                S0 = S0 * w[0] + (v * k[0] + nsa * bv[0]); S1 = S1 * w[1] + (v * k[1] + nsa * bv[1]); S2 = S2 * w[2] + (v * k[2] + nsa * bv[2]); S3 = S3 * w[3] + (v * k[3] + nsa * bv[3]);
                float o = (S0 * r[0] + S1 * r[1]) + (S2 * r[2] + S3 * r[3]); o = allreduce16(o);
                if (ks == 0) ob[s * 16 + rl] = o; }
        }
        RAW_BAR();
    }
    if (loader) { const LAS float* ob = obuf + ((NCH - 1) & 1) * 512;
#pragma unroll
        for (int n = 0; n < 2; ++n) { const int i = lt + 256 * n; Og[((size_t)(NCH - 1) * SC_STEPS + (i >> 4)) * 256 + (i & 15)] = ob[i]; } }
    RAW_BAR();
}
__device__ __forceinline__ float gelu_tanh(float x) { const float u = 0.7978845608028654f * (x + 0.044715f * x * x * x); return 0.5f * x * (1.0f + tanhf(u)); }
__device__ __forceinline__ void s5_pass2(Frame& F, int l, int c) {
    LAS float* ubuf = (LAS float*)F.lds;
    LAS float* ybuf = (LAS float*)(F.lds + 65536);
    const int t0 = c * 64, lane = F.lane, wave = F.wave, cb0 = c & ~127;
    load_u5_tile(F, t0, ubuf);
    __syncthreads();
#pragma unroll 1
    for (int gi = 0; gi < 2; ++gi) { const int g = wave + 8 * gi; S5Par P; s5_params(F, l, g, lane, P);
        float cr[16], ci[16]; int lane_l = lane; asm volatile("" : "+v"(lane_l));
#pragma unroll
        for (int hh = 0; hh < 16; ++hh) { cr[hh] = F.in[12][(((size_t)l * 16 + g) * 16 + hh) * 64 + lane_l]; ci[hh] = F.in[13][(((size_t)l * 16 + g) * 16 + hh) * 64 + lane_l]; }
        float pr = P.ar, pi = P.ai;
#pragma unroll
        for (int s = 0; s < 6; ++s) { const float nr = pr * pr - pi * pi, ni = 2.0f * pr * pi; pr = nr; pi = ni; }
        float hr = 0.f, hi = 0.f;
#pragma unroll 2
        for (int c2 = cb0; c2 < c; ++c2) { const f32x2 e = *(const f32x2*)(F.E + (((size_t)c2 * 16 + g) * 64 + lane) * 2);
            const float nr = pr * hr - pi * hi + e[0], ni = pr * hi + pi * hr + e[1]; hr = nr; hi = ni; }
#pragma unroll 1
        for (int j = 0; j < 64; ++j) { s5_step(P, ubuf + j * 256 + g * 16, hr, hi); float keep = 0.f;
#pragma unroll
            for (int hh = 0; hh < 16; ++hh) { const float s = wave_sum(hr * cr[hh] - hi * ci[hh]); keep = (lane == hh) ? s : keep; }
            if (lane < 16) ybuf[j * 256 + g * 16 + lane] = keep; }
    }
    __syncthreads();
    { const int ch = F.tid & 255, half = F.tid >> 8; const float dd = F.in[14][(size_t)l * 256 + ch];
        for (int tt = 0; tt < 32; ++tt) { const int tl = half * 32 + tt; const float y = ybuf[tl * 256 + ch] + dd * ubuf[tl * 256 + ch];
            F.GL[(size_t)(t0 + tl) * 256 + ch] = (bf16_t)f2bf(gelu_tanh(y)); } }
    __syncthreads();
}
__device__ __forceinline__ void m2_phase(Frame& F, int l) {
#ifndef NO_SCAN
    int bxs = F.bx; asm volatile("" : "+s"(bxs));
    if (bxs < 32) { rwkv_scan(F); return; }
#endif
#ifndef NO_P2
    for (int c = F.bx - 32; c < TT / 64; c += F.G - 32) s5_pass2(F, l, c);
#endif
}
__device__ __forceinline__ void rwkv_post(Frame& F, int l) {
    const int gw = F.bx * NWAVES + F.wave, NGW = F.G * NWAVES, lane = F.lane;
    for (int it = gw; it < TT * 4; it += NGW) { const int t = it >> 2, hh = it & 3, c = hh * 64 + lane;
        const float o = F.O[(size_t)t * 256 + c];
        const float mu = wave_sum(o) * (1.0f / 64.0f); const float d = o - mu; const float var = wave_sum(d * d) * (1.0f / 64.0f);
        const float on = d * rsqrtf(var + 64e-5f) * F.in[31][(size_t)l * 256 + c] + F.in[32][(size_t)l * 256 + c];
        const int b = t / SEQ, pos = t & (SEQ - 1);
        const h16* rw = (const h16*)(F.RW + ((size_t)(b * 4 + hh) * SEQ + pos) * 896 + 256) + lane;
        const float r = (float)rw[0], k = (float)rw[64], v = (float)rw[128];
        const float bs = wave_sum(r * k * F.in[30][(size_t)l * 256 + c]);
        const float out = (on + bs * v) * (float)F.G16[(size_t)t * 256 + c];
        F.B2[(size_t)t * 1024 + 512 + c] = (bf16_t)f2bf(out); }
}

constexpr int NPH = 25;
#ifndef PHMASK
#define PHMASK 0xFFFF
#endif
#define PHON(k) (((PHMASK) >> (k)) & 1)
template <int PH> __device__ __forceinline__ void run_phase(const int wave_s, unsigned char* lds_raw) {
    typedef pg8::StaticOrder SO;
    int tid = wave_s * 64 + (int)__builtin_amdgcn_mbcnt_hi(~0u, __builtin_amdgcn_mbcnt_lo(~0u, 0u)); asm volatile("" : "+v"(tid));
    int G = gridDim.x, bx = blockIdx.x; asm volatile("" : "+s"(G), "+s"(bx));
    const __attribute__((address_space(4))) unsigned char* ka = (const __attribute__((address_space(4))) unsigned char*)__builtin_amdgcn_kernarg_segment_ptr();
    asm volatile("" : "+s"(ka));
    const __attribute__((address_space(4))) Args* ap = (const __attribute__((address_space(4))) Args*)ka;
    Frame F;
    F.lds = (LAS unsigned char*)lds_raw;
    F.tid = tid; F.lane = tid & 63; F.wave = __builtin_amdgcn_readfirstlane(tid >> 6); F.G = G; F.bx = bx;
    F.in = (in_t)ka; F.X = ap->out; F.ws = ap->ws;
    unsigned char* ws = F.ws;
    F.SS = (float*)(ws + WS_SS); F.E = (float*)(ws + WS_E); F.B1 = (bf16_t*)(ws + WS_B1); F.B2 = (bf16_t*)(ws + WS_B2);
    unsigned char* z = ws + WS_Z;
    F.HID = (bf16_t*)(z + Z_HID); F.GL = (bf16_t*)(z + Z_GL); F.U5 = (h16*)(z + Z_U5); F.PP = (h16*)(z + Z_PP); F.L16 = (h16*)(z + Z_L16); F.G16 = (h16*)(z + Z_G16); F.R = (h16*)(z + Z_R);
    F.O = (float*)(z + Z_O); F.RW = z + Z_RW;
    if constexpr (PH == 0) { conv_first_half(F, 0); prep_x(F); }
    else { constexpr int l = (PH - 1) / 12, k = (PH - 1) % 12;
        if constexpr (k == 0) { pg8::Gemm g{F.B1, (const bf16_t*)(ws + WS_W + W_GU1), TT, 2 * FF, DM, 1}; SO S; S.init(TT, 2 * FF, G, bx); pg8::EpiGU E{F.HID, F.SS}; pg8::gemm_phase<pg8::EpiGU, SO, true, true>(F.lds, g, S, E, tid); }
        else if constexpr (k == 1) { pg8::Gemm g{F.HID, (const bf16_t*)(ws + WS_W + W_D1), TT, DM, FF, 1}; SO S; S.init(TT, DM, G, bx); pg8::EpiDown E{l == 0 ? F.in[0] : F.X, F.X, F.B1, F.SS, 0.5f}; pg8::gemm_phase<pg8::EpiDown, SO, true, true>(F.lds, g, S, E, tid); }
        else if constexpr (k == 2) { pg8::Gemm g{F.B1, (const bf16_t*)(ws + WS_W + W_INA), TT, 2560, DM, 1}; SO S; S.init(TT, 2560, G, bx); pg8::EpiInA E{F.U5, F.PP, F.L16, F.SS}; pg8::gemm_phase<pg8::EpiInA, SO, true, true>(F.lds, g, S, E, tid); }
        else if constexpr (k == 3) { m1_phase(F, l); }
        else if constexpr (k == 4) { m2_phase(F, l); }
        else if constexpr (k == 5) { { pg8::Gemm g{F.GL, (const bf16_t*)(ws + WS_W + W_GLU), TT, 256, 256, 1}; SO S; S.init(TT, 256, G, bx); pg8::EpiGlu E{F.GL, F.B2}; pg8::gemm_phase<pg8::EpiGlu, SO, true, true>(F.lds, g, S, E, tid); } rwkv_post(F, l); }
        else if constexpr (k == 6) { pg8::Gemm g{F.B1, (const bf16_t*)(ws + WS_W + W_ING), TT, 4096, DM, 1}; SO S; S.init(TT, 4096, G, bx); pg8::EpiGate E{F.R, F.SS}; pg8::gemm_phase<pg8::EpiGate, SO, true, true>(F.lds, g, S, E, tid); }
        else if constexpr (k == 7) { pg8::Gemm g{F.B2, (const bf16_t*)(ws + WS_W + W_BR), TT, DM, DM, 4}; pg8::SegOrder4 S; S.so.init(TT, DM, G, bx); pg8::EpiBranch E{F.R, F.B1}; pg8::gemm_phase<pg8::EpiBranch, pg8::SegOrder4, true, true>(F.lds, g, S, E, tid); }
        else if constexpr (k == 8) { pg8::Gemm g{F.B1, (const bf16_t*)(ws + WS_W + W_O), TT, DM, DM, 1}; SO S; S.init(TT, DM, G, bx); pg8::EpiDown E{F.X, F.X, F.B2, F.SS, 1.0f}; pg8::gemm_phase<pg8::EpiDown, SO, true, true>(F.lds, g, S, E, tid); }
        else if constexpr (k == 9) { pg8::Gemm g{F.B2, (const bf16_t*)(ws + WS_W + W_GU2), TT, 2 * FF, DM, 1}; SO S; S.init(TT, 2 * FF, G, bx); pg8::EpiGU E{F.HID, F.SS}; pg8::gemm_phase<pg8::EpiGU, SO, true, true>(F.lds, g, S, E, tid); }
        else if constexpr (k == 10) { pg8::Gemm g{F.HID, (const bf16_t*)(ws + WS_W + W_D2), TT, DM, FF, 1}; SO S; S.init(TT, DM, G, bx); pg8::EpiDown E{F.X, F.X, F.B1, F.SS, 0.5f}; pg8::gemm_phase<pg8::EpiDown, SO, true, true>(F.lds, g, S, E, tid); }
        else { if constexpr (l == 0) conv_first_half(F, 1); else final_norm(F); }
    }
}
#define PHASE(k) if (ph_lo <= (k) && (k) < ph_hi) { run_phase<(k)>(wave_s, lds_raw); if ((k) + 1 < ph_hi) { __syncthreads(); cg::this_grid().sync(); } }
__global__ void __launch_bounds__(NTHR, 2) mk_fwd(Args args) {
    extern __shared__ __attribute__((aligned(16))) unsigned char lds_raw[];
    const int ph_lo = args.ph_lo, ph_hi = args.ph_hi;
    const int wave_s = __builtin_amdgcn_readfirstlane((int)threadIdx.x >> 6);
    PHASE(0) PHASE(1) PHASE(2) PHASE(3) PHASE(4) PHASE(5) PHASE(6) PHASE(7) PHASE(8) PHASE(9) PHASE(10) PHASE(11) PHASE(12)
    PHASE(13) PHASE(14) PHASE(15) PHASE(16) PHASE(17) PHASE(18) PHASE(19) PHASE(20) PHASE(21) PHASE(22) PHASE(23) PHASE(24)
}

extern "C" void kernel_launch(void* const* d_in, const int* in_sizes, int n_in, void* d_out, int out_size, void* d_ws, size_t ws_size, hipStream_t stream) {
    static int grid = 0;
    if (grid == 0) {
        if (n_in != 41 || out_size != TT * DM || ws_size < WS_END) { fprintf(stderr, "kernel_launch: unexpected shapes (n_in %d out %d ws %zu)\n", n_in, out_size, ws_size); grid = -1; return; }
        int dev = 0, cus = 0, per_cu = 0;
        (void)hipGetDevice(&dev); (void)hipDeviceGetAttribute(&cus, hipDeviceAttributeMultiprocessorCount, dev);
        if (hipFuncSetAttribute((const void*)mk_fwd, hipFuncAttributeMaxDynamicSharedMemorySize, LDS_BYTES) != hipSuccess) { fprintf(stderr, "kernel_launch: hipFuncSetAttribute failed\n"); grid = -1; return; }
        if (hipOccupancyMaxActiveBlocksPerMultiprocessor(&per_cu, (const void*)mk_fwd, NTHR, LDS_BYTES) != hipSuccess || per_cu < 1) { fprintf(stderr, "kernel_launch: occupancy query says %d\n", per_cu); per_cu = 1; }
        (void)hipGetLastError();
        grid = cus * (per_cu >= 1 ? 1 : 1);
        if (grid < 64) { fprintf(stderr, "kernel_launch: grid %d too small\n", grid); }
    }
    if (grid < 0) return;
    Args a{};
    for (int i = 0; i < 41; ++i) a.in[i] = (const float*)d_in[i];
    a.out = (float*)d_out; a.ws = (unsigned char*)d_ws;
#if ONE_LAUNCH
    a.ph_lo = 0; a.ph_hi = NPH;
    void* kargs[] = {&a};
    hipError_t e = hipLaunchCooperativeKernel((const void*)mk_fwd, dim3(grid), dim3(NTHR), kargs, LDS_BYTES, stream);
    if (e != hipSuccess) fprintf(stderr, "cooperative launch failed: %s (grid %d)\n", hipGetErrorString(e), grid);
#else
    for (int ph = 0; ph < NPH; ++ph) { a.ph_lo = ph; a.ph_hi = ph + 1; hipLaunchKernelGGL(mk_fwd, dim3(grid), dim3(NTHR), LDS_BYTES, stream, a); }
#endif
}
```

```cpp
#include <hip/hip_runtime.h>
#include <hip/hip_cooperative_groups.h>
#include <cstdio>
#include <cstdint>
#include <cstddef>
namespace cg = cooperative_groups;
namespace pg8 {
#define PG8_LAS __attribute__((address_space(3)))
typedef unsigned short bf16_t;
typedef short bf16x8 __attribute__((ext_vector_type(8)));
typedef float f32x4 __attribute__((ext_vector_type(4)));
typedef unsigned u32x4 __attribute__((ext_vector_type(4)));
constexpr int BM = 256, BK = 64, HALF = 128, HTB = HALF * BK * 2  , STAGE_BYTES = 8 * HTB, NXCD = 8, WGM = 8;

__host__ __device__ __forceinline__ int lds_byte(int r, int c) { const int st = (r >> 4) * 2 + (c >> 5), rr = r & 15, cc = c & 31, ob = rr * 64 + cc * 2; return st * 1024 + (ob ^ (((ob >> 9) & 1) << 5)); }
__host__ __device__ __forceinline__ void stage_rc(int b, int& R, int& C) { const int st = b / 1024, sb = b % 1024, swz = sb ^ (((sb >> 9) & 1) << 5); R = (st >> 1) * 16 + swz / 64; C = (st & 1) * 32 + (swz % 64) / 2; }
__host__ __device__ __forceinline__ int perm32(int rho) { const int n = rho >> 4, i = rho & 15; return 8 * (i >> 2) + 4 * n + (i & 3); }

struct Unit { int pm, pn, g; };
struct Gemm { const bf16_t* A; const bf16_t* Bt; int M, N, K, nseg; };

struct StaticOrder {
    int nM, nN, nwg, G, c;
    __host__ __device__ void init(int M, int N, int G_, int c_) { nM = M / BM; nN = N / BM; nwg = nM * nN; G = G_; c = c_; }
    __host__ __device__ bool next(int i, Unit& u) const {
        const long L = (long)i * G + c; if (L >= nwg) return false;
        int wgid = (int)L; { const int q = nwg / NXCD, r = nwg % NXCD, xcd = wgid % NXCD, off = wgid / NXCD; wgid = (xcd < r ? xcd * (q + 1) : r * (q + 1) + (xcd - r) * q) + off; }
        const int nig = WGM * nN, gid = wgid / nig, fm = gid * WGM, gsz = (nM - fm) < WGM ? (nM - fm) : WGM;
        u.pm = fm + ((wgid % nig) % gsz); u.pn = (wgid % nig) / gsz; u.g = 0; return true;
    }
    __device__ __forceinline__ void a_ready(const Unit&) const {}
    __device__ __forceinline__ void done(const Unit&) const {}
};


struct SegOrder4 {
    StaticOrder so;
    __host__ __device__ bool next(int i, Unit& u) const { if (!so.next(i >> 2, u)) return false; u.g = i & 3; return true; }
    __device__ __forceinline__ void a_ready(const Unit&) const {}
    __device__ __forceinline__ void done(const Unit&) const {}
};

typedef _Float16 h16;
typedef _Float16 h16x4 __attribute__((ext_vector_type(4)));
typedef unsigned u32x2 __attribute__((ext_vector_type(2)));
__device__ __forceinline__ unsigned cvt_pk_bf16(float lo, float hi) { unsigned r; asm volatile("v_cvt_pk_bf16_f32 %0, %1, %2" : "=v"(r) : "v"(lo), "v"(hi)); return r; }
__device__ __forceinline__ u32x2 pack_bf16x4(f32x4 v) { u32x2 w; w.x = cvt_pk_bf16(v[0], v[1]); w.y = cvt_pk_bf16(v[2], v[3]); return w; }
__device__ __forceinline__ h16x4 pack_h16x4(f32x4 v) { h16x4 w; w[0] = (h16)v[0]; w[1] = (h16)v[1]; w[2] = (h16)v[2]; w[3] = (h16)v[3]; return w; }
__device__ __forceinline__ float fast_sigmoid(float x) { return __builtin_amdgcn_rcpf(1.0f + __expf(-x)); }
__device__ __forceinline__ float row_rstd(const float* SS, int row) {
    const f32x4* p = (const f32x4*)(SS + (size_t)row * 16);
    const f32x4 a = p[0], b = p[1], c = p[2], d = p[3];
    const float s = ((a[0] + a[1]) + (a[2] + a[3])) + ((b[0] + b[1]) + (b[2] + b[3])) + ((c[0] + c[1]) + (c[2] + c[3])) + ((d[0] + d[1]) + (d[2] + d[3]));
    return rsqrtf(s * (1.0f / 1024.0f) + 1e-6f);
}

struct EpiGU {
    static constexpr bool PERM = true, KSEG = false;
    bf16_t* hid; const float* SS;
    __device__ __forceinline__ void operator()(const f32x4 (&acc)[2][2][4][2], const Unit& u, int wr, int wc, int fr, int fq) const {
        int row0 = u.pm * BM + wr * 64 + fr; asm volatile("" : "+v"(row0)); const int j0 = u.pn * 128 + wc * 16 + fq * 4;
#pragma unroll
        for (int ai = 0; ai < 2; ++ai)
#pragma unroll
            for (int m = 0; m < 4; ++m) { const int row = row0 + ai * HALF + m * 16; const float rs = row_rstd(SS, row);
#pragma unroll
                for (int bj = 0; bj < 2; ++bj) { const f32x4 g = acc[ai][bj][m][0] * rs, up = acc[ai][bj][m][1] * rs; f32x4 h;
#pragma unroll
                    for (int i = 0; i < 4; ++i) h[i] = g[i] * fast_sigmoid(g[i]) * up[i];
                    *(u32x2*)(hid + (size_t)row * 2816 + j0 + bj * 64) = pack_bf16x4(h); } }
    }
};
struct EpiDown {
    static constexpr bool PERM = false, KSEG = false;
    const float* res; float* X; bf16_t* xb; float* SS; float alpha;
    __device__ __forceinline__ void operator()(const f32x4 (&acc)[2][2][4][2], const Unit& u, int wr, int wc, int fr, int fq) const {
        int row0 = u.pm * BM + wr * 64 + fr; asm volatile("" : "+v"(row0)); const int c0 = u.pn * BM + wc * 32 + fq * 4;
#pragma unroll
        for (int ai = 0; ai < 2; ++ai)
#pragma unroll
            for (int m = 0; m < 4; ++m) { const int row = row0 + ai * HALF + m * 16; float ss = 0.f;
#pragma unroll
                for (int bj = 0; bj < 2; ++bj)
#pragma unroll
                    for (int n = 0; n < 2; ++n) { const size_t off = (size_t)row * 1024 + c0 + bj * HALF + n * 16;
                        const f32x4 r = *(const f32x4*)(res + off); const f32x4 o = r + acc[ai][bj][m][n] * alpha;
                        *(f32x4*)(X + off) = o; *(u32x2*)(xb + off) = pack_bf16x4(o);
                        ss += (o[0] * o[0] + o[1] * o[1]) + (o[2] * o[2] + o[3] * o[3]); }
                ss += __shfl_xor(ss, 16); ss += __shfl_xor(ss, 32);
                if (fq == 0) SS[(size_t)row * 16 + u.pn * 4 + wc] = ss;
                asm volatile("" ::: "memory"); }
    }
};
struct EpiInA {
    static constexpr bool PERM = false, KSEG = false;
    h16* U5; h16* PP; h16* L16; const float* SS;
    __device__ __forceinline__ void operator()(const f32x4 (&acc)[2][2][4][2], const Unit& u, int wr, int wc, int fr, int fq) const {
        int row0 = u.pm * BM + wr * 64 + fr; asm volatile("" : "+v"(row0)); const int cl = wc * 32 + fq * 4;
        h16* base; int ld, cb;
        if (u.pn == 0) { base = U5; ld = 256; cb = 0; } else if (u.pn < 8) { base = PP; ld = 1792; cb = (u.pn - 1) * 256; } else { base = L16; ld = 512; cb = (u.pn - 8) * 256; }
#pragma unroll
        for (int ai = 0; ai < 2; ++ai)
#pragma unroll
            for (int m = 0; m < 4; ++m) { const int row = row0 + ai * HALF + m * 16; const float rs = row_rstd(SS, row);
#pragma unroll
                for (int bj = 0; bj < 2; ++bj)
#pragma unroll
                    for (int n = 0; n < 2; ++n) *(h16x4*)(base + (size_t)row * ld + cb + cl + bj * HALF + n * 16) = pack_h16x4(acc[ai][bj][m][n] * rs); }
    }
};
struct EpiGate {
    static constexpr bool PERM = false, KSEG = false;
    h16* R; const float* SS;
    __device__ __forceinline__ void operator()(const f32x4 (&acc)[2][2][4][2], const Unit& u, int wr, int wc, int fr, int fq) const {
        int row0 = u.pm * BM + wr * 64 + fr; asm volatile("" : "+v"(row0)); const int d0 = 256 * (u.pn >> 2) + 128 * ((u.pn >> 1) & 1) + 16 * (u.pn & 1) + 32 * wc + 4 * fq;
#pragma unroll
        for (int ai = 0; ai < 2; ++ai)
#pragma unroll
            for (int m = 0; m < 4; ++m) { const int row = row0 + ai * HALF + m * 16; const float rs = row_rstd(SS, row);
                f32x4 e[4];
#pragma unroll
                for (int g = 0; g < 4; ++g)
#pragma unroll
                    for (int i = 0; i < 4; ++i) e[g][i] = 1.0f + __expf(-fminf(fmaxf(acc[ai][g >> 1][m][g & 1][i] * rs, -10.f), 30.f));
                f32x4 r[4];
#pragma unroll
                for (int i = 0; i < 4; ++i) { const float i0 = __builtin_amdgcn_rcpf(e[0][i]), i1 = __builtin_amdgcn_rcpf(e[1][i]), i2 = __builtin_amdgcn_rcpf(e[2][i]), i3 = __builtin_amdgcn_rcpf(e[3][i]);
                    r[0][i] = e[1][i] * i0; r[1][i] = e[2][i] * i1; r[2][i] = e[3][i] * i2; r[3][i] = i3; }
#pragma unroll
                for (int g = 0; g < 4; ++g) *(h16x4*)(R + ((size_t)row * 4 + g) * 1024 + d0) = pack_h16x4(r[g]); }
    }
};
struct EpiBranch {
    static constexpr bool PERM = false, KSEG = true;
    const h16* R; bf16_t* out;
    __device__ __forceinline__ void operator()(f32x4 (&acc)[2][2][4][2], const Unit& u, int wr, int wc, int fr, int fq) const {
        unsigned q0 = (unsigned)(u.pm * BM + wr * 64 + fr) * 1024u + (unsigned)(u.pn * BM + wc * 32 + fq * 4); asm volatile("" : "+v"(q0));
        const unsigned r0 = (q0 - (q0 & 1023u)) * 4u + (unsigned)u.g * 1024u + (q0 & 1023u);
        const bool last = u.g == 3;
#pragma unroll
        for (int ai = 0; ai < 2; ++ai)
#pragma unroll
            for (int m = 0; m < 4; ++m) {
#pragma unroll
                for (int bj = 0; bj < 2; ++bj)
#pragma unroll
                    for (int n = 0; n < 2; ++n) { const unsigned off = q0 + (unsigned)((ai * HALF + m * 16) * 1024 + bj * HALF + n * 16);
                        const h16x4 r = *(const h16x4*)(R + (r0 + (unsigned)((ai * HALF + m * 16) * 4096 + bj * HALF + n * 16)));
                        f32x4 rf; rf[0] = (float)r[0]; rf[1] = (float)r[1]; rf[2] = (float)r[2]; rf[3] = (float)r[3];
                        acc[ai][bj][m][n] = acc[ai][bj][m][n] * rf;
                        if (last) *(u32x2*)(out + off) = pack_bf16x4(acc[ai][bj][m][n]); }
                asm volatile("" ::: "memory"); }
    }
};
struct EpiGlu {
    static constexpr bool PERM = false, KSEG = false;
    const bf16_t* gl; bf16_t* ys;
    __device__ __forceinline__ void operator()(const f32x4 (&acc)[2][2][4][2], const Unit& u, int wr, int wc, int fr, int fq) const {
        int row0 = u.pm * BM + wr * 64 + fr; asm volatile("" : "+v"(row0)); const int c0 = wc * 32 + fq * 4;
#pragma unroll
        for (int ai = 0; ai < 2; ++ai)
#pragma unroll
            for (int m = 0; m < 4; ++m) { const int row = row0 + ai * HALF + m * 16;
#pragma unroll
                for (int bj = 0; bj < 2; ++bj)
#pragma unroll
                    for (int n = 0; n < 2; ++n) { const int c = c0 + bj * HALF + n * 16; const u32x2 gv = *(const u32x2*)(gl + (size_t)row * 256 + c);
                        f32x4 g; g[0] = __uint_as_float(gv.x << 16); g[1] = __uint_as_float(gv.x & 0xffff0000u); g[2] = __uint_as_float(gv.y << 16); g[3] = __uint_as_float(gv.y & 0xffff0000u);
                        f32x4 o;
#pragma unroll
                        for (int i = 0; i < 4; ++i) o[i] = g[i] * fast_sigmoid(acc[ai][bj][m][n][i]);
                        *(u32x2*)(ys + (size_t)row * 1024 + c) = pack_bf16x4(o); }
                asm volatile("" ::: "memory"); }
    }
};

template <class Epi, class Sched, bool ALIGN_EPI = false, bool SP2 = false>
__device__ __forceinline__ void gemm_phase(PG8_LAS unsigned char* lds, const Gemm g, const Sched& S, const Epi& E, const int tid) {
    const int wid = __builtin_amdgcn_readfirstlane(tid >> 6), lane = tid & 63, wr = wid >> 2, wc = wid & 3, fr = lane & 15, fq = lane >> 4;
    const int K = g.K, nt = K / BK / g.nseg; const size_t segb = (size_t)(K / g.nseg) * 2;
    unsigned voffA[2], voffB[2];
#pragma unroll
    for (int i = 0; i < 2; ++i) { int R, C; stage_rc(tid * 16 + i * 8192, R, C); const int Rb = Epi::PERM ? ((R & ~31) + perm32(R & 31)) : R;
        voffA[i] = (unsigned)(R * K + C) * 2u; voffB[i] = (unsigned)(Rb * K + C) * 2u; }
    const size_t kstep = (size_t)(BK * 2);
    const size_t hstep = (size_t)HALF * K * 2;
    const size_t tstep = 2 * hstep;
    const unsigned ldsw = (unsigned)wid * 1024u;
    const int aoff = lds_byte(wr * 64 + fr, fq * 8), boff = lds_byte(wc * 32 + fr, fq * 8);
#define PG8_SA(b, h) (((b) * 2 + (h)) * HTB)
#define PG8_SB(b, h) ((4 + (b) * 2 + (h)) * HTB)
#define PG8_STAGE(bufoff, gbase, voff) do { _Pragma("unroll") for (int _i = 0; _i < 2; ++_i) \
        __builtin_amdgcn_global_load_lds((const unsigned*)((const char*)(gbase) + (voff)[_i]), (PG8_LAS unsigned*)(lds + (bufoff) + ldsw + _i * 8192), 16, 0, 0); } while (0)
#define PG8_LDA(dst, b, h) do { _Pragma("unroll") for (int m = 0; m < 4; ++m) _Pragma("unroll") for (int k = 0; k < 2; ++k) dst[m][k] = *(const PG8_LAS bf16x8*)(lds + PG8_SA(b, h) + aoff + m * 2048 + k * 1024); } while (0)
#define PG8_LDB(dst, b, h) do { _Pragma("unroll") for (int n = 0; n < 2; ++n) _Pragma("unroll") for (int k = 0; k < 2; ++k) dst[n][k] = *(const PG8_LAS bf16x8*)(lds + PG8_SB(b, h) + boff + n * 2048 + k * 1024); } while (0)
#define PG8_MMA(ai, bj, At, Bt) do { __builtin_amdgcn_s_setprio(1); _Pragma("unroll") for (int m = 0; m < 4; ++m) _Pragma("unroll") for (int n = 0; n < 2; ++n) _Pragma("unroll") for (int k = 0; k < 2; ++k) \
        acc[ai][bj][m][n] = __builtin_amdgcn_mfma_f32_16x16x32_bf16(Bt[n][k], At[m][k], acc[ai][bj][m][n], 0, 0, 0); __builtin_amdgcn_s_setprio(0); } while (0)
#define PG8_WAIT_V(n) asm volatile("s_waitcnt vmcnt(" #n ")" ::: "memory")
#define PG8_WAIT_L(n) asm volatile("s_waitcnt lgkmcnt(" #n ")" ::: "memory")
#define PG8_BAR __builtin_amdgcn_s_barrier()
#define PG8_SCHED __builtin_amdgcn_sched_barrier(0)
    Unit cur, nxt; int ui = 0;
    if (!S.next(0, cur)) return;
    f32x4 acc[2][2][4][2];
#pragma unroll
    for (int a = 0; a < 2; ++a)
#pragma unroll
        for (int b = 0; b < 2; ++b)
#pragma unroll
            for (int m = 0; m < 4; ++m)
#pragma unroll
                for (int n = 0; n < 2; ++n) acc[a][b][m][n] = (f32x4){0.f, 0.f, 0.f, 0.f};
    bf16x8 At[4][2], B0[2][2], B1[2][2];
    const char* cA = (const char*)g.A + (size_t)cur.pm * tstep + (size_t)cur.g * segb; const char* cB = (const char*)g.Bt + (size_t)cur.pn * tstep + (size_t)cur.g * segb;
    S.a_ready(cur);
    if constexpr (SP2) {
        PG8_STAGE(PG8_SB(0, 0), cB, voffB); PG8_STAGE(PG8_SB(0, 1), cB + hstep, voffB); PG8_STAGE(PG8_SA(0, 0), cA, voffA); PG8_STAGE(PG8_SA(0, 1), cA + hstep, voffA);
        if (wr == 1) PG8_BAR;
        PG8_WAIT_V(2); PG8_BAR;
        PG8_STAGE(PG8_SB(1, 0), cB + kstep, voffB); PG8_STAGE(PG8_SA(1, 0), cA + kstep, voffA); PG8_STAGE(PG8_SB(1, 1), cB + hstep + kstep, voffB);
        PG8_WAIT_V(6); PG8_BAR;
    } else {
        PG8_STAGE(PG8_SB(0, 0), cB, voffB); PG8_STAGE(PG8_SA(0, 0), cA, voffA); PG8_STAGE(PG8_SB(0, 1), cB + hstep, voffB); PG8_STAGE(PG8_SA(0, 1), cA + hstep, voffA);
        if (wr == 1) PG8_BAR;
        PG8_WAIT_V(4); PG8_BAR;
        PG8_STAGE(PG8_SB(1, 0), cB + kstep, voffB); PG8_STAGE(PG8_SA(1, 0), cA + kstep, voffA); PG8_STAGE(PG8_SB(1, 1), cB + hstep + kstep, voffB);
        PG8_WAIT_V(6); PG8_BAR;
    }
    for (;;) {
        const bool has_next = S.next(ui + 1, nxt);
        const char* nA = has_next ? (const char*)g.A + (size_t)nxt.pm * tstep + (size_t)nxt.g * segb : cA; const char* nB = has_next ? (const char*)g.Bt + (size_t)nxt.pn * tstep + (size_t)nxt.g * segb : cB;
        for (int t = 0; t < nt; t += 2) {
            const bool last = (t == nt - 2);
            const char* a1 = cA + (size_t)(t + 1) * kstep;
            const char* a2 = last ? nA : cA + (size_t)(t + 2) * kstep; const char* b2 = last ? nB : cB + (size_t)(t + 2) * kstep;
            const char* a3 = a2 + kstep; const char* b3 = b2 + kstep;
            if (last && has_next) S.a_ready(nxt);
            if constexpr (SP2) {
            PG8_LDB(B0, 0, 0); PG8_LDB(B1, 0, 1); PG8_SCHED; PG8_LDA(At, 0, 0); PG8_STAGE(PG8_SA(1, 1), a1 + hstep, voffA);
            PG8_WAIT_V(8); PG8_WAIT_L(0); PG8_BAR; PG8_MMA(0, 0, At, B0); PG8_MMA(0, 1, At, B1); PG8_BAR; PG8_SCHED;
            PG8_LDA(At, 0, 1); PG8_STAGE(PG8_SB(0, 0), b2, voffB); PG8_STAGE(PG8_SB(0, 1), b2 + hstep, voffB); PG8_STAGE(PG8_SA(0, 0), a2, voffA);
            PG8_WAIT_V(8); PG8_WAIT_L(0); PG8_BAR; PG8_MMA(1, 0, At, B0); PG8_MMA(1, 1, At, B1); PG8_BAR; PG8_SCHED;
            PG8_LDB(B0, 1, 0); PG8_LDB(B1, 1, 1); PG8_SCHED; PG8_LDA(At, 1, 0); PG8_STAGE(PG8_SA(0, 1), a2 + hstep, voffA);
            PG8_WAIT_V(8); PG8_WAIT_L(0); PG8_BAR; PG8_MMA(0, 0, At, B0); PG8_MMA(0, 1, At, B1); PG8_BAR; PG8_SCHED;
            PG8_LDA(At, 1, 1); PG8_STAGE(PG8_SB(1, 0), b3, voffB); PG8_STAGE(PG8_SB(1, 1), b3 + hstep, voffB); PG8_STAGE(PG8_SA(1, 0), a3, voffA);
            PG8_WAIT_V(8); PG8_WAIT_L(0); PG8_BAR; PG8_MMA(1, 0, At, B0); PG8_MMA(1, 1, At, B1); PG8_BAR; PG8_SCHED;
            } else {
            PG8_LDB(B0, 0, 0); PG8_SCHED; PG8_LDA(At, 0, 0); PG8_STAGE(PG8_SA(1, 1), a1 + hstep, voffA);
            PG8_WAIT_L(8); PG8_BAR; PG8_WAIT_L(0); PG8_MMA(0, 0, At, B0); PG8_BAR; PG8_SCHED;
            PG8_LDB(B1, 0, 1); PG8_STAGE(PG8_SB(0, 0), b2, voffB);
            PG8_BAR; PG8_WAIT_L(0); PG8_MMA(0, 1, At, B1); PG8_BAR;
            PG8_LDA(At, 0, 1); PG8_STAGE(PG8_SA(0, 0), a2, voffA);
            PG8_BAR; PG8_WAIT_L(0); PG8_MMA(1, 0, At, B0); PG8_BAR; PG8_SCHED;
            PG8_STAGE(PG8_SB(0, 1), b2 + hstep, voffB);
            PG8_WAIT_V(6); PG8_BAR; PG8_MMA(1, 1, At, B1); PG8_BAR;
            PG8_LDB(B0, 1, 0); PG8_SCHED; PG8_LDA(At, 1, 0); PG8_STAGE(PG8_SA(0, 1), a2 + hstep, voffA);
            PG8_WAIT_L(8); PG8_BAR; PG8_WAIT_L(0); PG8_MMA(0, 0, At, B0); PG8_BAR; PG8_SCHED;
            PG8_LDB(B1, 1, 1); PG8_STAGE(PG8_SB(1, 0), b3, voffB);
            PG8_BAR; PG8_WAIT_L(0); PG8_MMA(0, 1, At, B1); PG8_BAR;
            PG8_LDA(At, 1, 1); PG8_STAGE(PG8_SA(1, 0), a3, voffA);
            PG8_BAR; PG8_WAIT_L(0); PG8_MMA(1, 0, At, B0); PG8_BAR; PG8_SCHED;
            PG8_STAGE(PG8_SB(1, 1), b3 + hstep, voffB);
            PG8_WAIT_V(6); PG8_BAR; PG8_MMA(1, 1, At, B1); PG8_BAR;
            }
        }
        if constexpr (ALIGN_EPI) { if (wr == 0) PG8_BAR; }
        E(acc, cur, wr, wc, fr, fq); S.done(cur);
        if (!has_next) break;
        if (!(Epi::KSEG && nxt.g != 0))
#pragma unroll
        for (int a = 0; a < 2; ++a)
#pragma unroll
            for (int b = 0; b < 2; ++b)
#pragma unroll
                for (int m = 0; m < 4; ++m)
#pragma unroll
                    for (int n = 0; n < 2; ++n) acc[a][b][m][n] = (f32x4){0.f, 0.f, 0.f, 0.f};
        cur = nxt; cA = nA; cB = nB; ++ui;
        if constexpr (ALIGN_EPI) { if (wr == 1) PG8_BAR; }
    }
    PG8_WAIT_V(0);
    if constexpr (!ALIGN_EPI) { if (wr == 0) PG8_BAR; }
    PG8_BAR;
#undef PG8_SA
#undef PG8_SB
#undef PG8_STAGE
#undef PG8_LDA
#undef PG8_LDB
#undef PG8_MMA
#undef PG8_WAIT_V
#undef PG8_WAIT_L
#undef PG8_BAR
#undef PG8_SCHED
}
}

#define LAS __attribute__((address_space(3)))
typedef unsigned short bf16_t;
typedef _Float16 h16;
typedef _Float16 h16x4 __attribute__((ext_vector_type(4)));
typedef _Float16 h16x8 __attribute__((ext_vector_type(8)));
typedef float f32x4 __attribute__((ext_vector_type(4)));
typedef float f32x2 __attribute__((ext_vector_type(2)));
typedef unsigned u32x4 __attribute__((ext_vector_type(4)));
typedef unsigned u32x2 __attribute__((ext_vector_type(2)));

#ifndef ONE_LAUNCH
#define ONE_LAUNCH 1
#endif
constexpr int NWAVES = 8, NTHR = 512;
constexpr int TT = 16384, SEQ = 8192, DM = 1024, FF = 2816, MW = 256, INW = 6144;
constexpr int LDS_BYTES = 147456;
constexpr size_t MiB = 1u << 20;
constexpr size_t WS_SS = 1 * MiB, WS_E = 2 * MiB, WS_W = 4 * MiB, WS_B1 = 34 * MiB, WS_B2 = 66 * MiB, WS_Z = 98 * MiB, WS_END = 242 * MiB;
constexpr size_t W_GU1 = 0, W_D1 = W_GU1 + (size_t)2 * FF * DM * 2, W_INA = W_D1 + (size_t)DM * FF * 2;
constexpr size_t W_ING = 0, W_BR = W_ING + (size_t)4096 * DM * 2, W_O = W_BR + (size_t)DM * DM * 2, W_GU2 = W_O + (size_t)DM * DM * 2, W_D2 = W_GU2 + (size_t)2 * FF * DM * 2, W_GLU = W_D2 + (size_t)DM * FF * 2, W_END2 = W_GLU + 256 * 256 * 2;
static_assert(W_END2 <= 30 * MiB && W_INA + (size_t)2560 * DM * 2 <= 30 * MiB, "W region");
constexpr size_t Z_RW = 0, Z_G16 = 56 * MiB, Z_U5 = 64 * MiB, Z_L16 = 72 * MiB, Z_PP = 88 * MiB, Z_O = 88 * MiB, Z_GL = 104 * MiB;
constexpr size_t Z_HID = 0, Z_R = 0;
static_assert((size_t)TT * 4 * 896 <= 56 * MiB && (size_t)TT * 1792 * 2 <= 56 * MiB && (size_t)TT * FF * 2 <= 144 * MiB && (size_t)TT * 4096 * 2 <= 144 * MiB, "Z region");

typedef const float* cfp_t;
typedef const __attribute__((address_space(4))) cfp_t* in_t;
struct Args { const float* in[41]; float* out; unsigned char* ws; int ph_lo, ph_hi; };

struct Frame {
    LAS unsigned char* lds;
    int tid, lane, wave, G, bx;
    in_t in;
    float* X; unsigned char* ws;
    float* SS; float* E;
    bf16_t *B1, *B2, *HID, *GL;
    h16 *U5, *PP, *L16, *G16, *R;
    float* O; unsigned char* RW;
};

__device__ __forceinline__ unsigned f2bf(float f) { unsigned u = __builtin_bit_cast(unsigned, f); return (u + 0x7fffu + ((u >> 16) & 1u)) >> 16; }
__device__ __forceinline__ unsigned pk2(float lo, float hi) { return f2bf(lo) | (f2bf(hi) << 16); }
#define LDS_WAIT() asm volatile("s_waitcnt lgkmcnt(0)" ::: "memory")
template <int CTRL> __device__ __forceinline__ float dppx(float x) { return __builtin_bit_cast(float, __builtin_amdgcn_update_dpp(0, __builtin_bit_cast(int, x), CTRL, 0xf, 0xf, true)); }
__device__ __forceinline__ float allreduce16(float x) { x += dppx<0xB1>(x); x += dppx<0x4E>(x); x += dppx<0x141>(x); x += dppx<0x140>(x); return x; }
__device__ __forceinline__ float wave_sum(float x) { x = allreduce16(x); x += __shfl_xor(x, 16); x += __shfl_xor(x, 32); return x; }
__device__ __forceinline__ float sigmoidf_(float x) { return 1.0f / (1.0f + __expf(-x)); }

__device__ __forceinline__ int tr_rowmap(int mode, int j, int row0) {
    if (mode == 0) return row0 + j;
    if (mode == 1) return 8 * (j >> 2) + (j & 3);
    if (mode == 2) return 8 * (j >> 2) + 4 + (j & 3);
    const int g = j >> 10, d = j & 1023;
    const int pn = 4 * (d >> 8) + 2 * ((d >> 7) & 1) + ((d >> 4) & 1);
    return 256 * pn + 128 * (g >> 1) + 32 * ((d >> 5) & 3) + 16 * (g & 1) + 4 * ((d >> 2) & 3) + (d & 3);
}
__device__ __forceinline__ void tr_item(const float* W, int ldw, int K, int N, bf16_t* WT, int mode, int row0, const float* s1, const float* s2, int smode, LAS float* scr, int item, int lane) {
    const int nblk = N / 32, kb = item / nblk, nb = item % nblk, k0 = 64 * kb, n0 = 32 * nb;
#pragma unroll 8
    for (int i = 0; i < 32; ++i) { const int kk = 2 * i + (lane >> 5); const int k = k0 + kk; float sc = 1.0f;
        if (s1) sc = s1[k];
        if (smode == 1) sc *= s2[k]; else if (smode == 2) sc *= (1.0f - s2[k]);
        scr[kk * 33 + (lane & 31)] = W[(size_t)k * ldw + n0 + (lane & 31)] * sc; }
    LDS_WAIT(); asm volatile("" ::: "memory");
    const int c = lane & 7;
#pragma unroll
    for (int j = 0; j < 4; ++j) { const int n = (lane >> 3) + 8 * j; const LAS float* s = scr + (8 * c) * 33 + n;
        u32x4 o; o.x = pk2(s[0 * 33], s[1 * 33]); o.y = pk2(s[2 * 33], s[3 * 33]); o.z = pk2(s[4 * 33], s[5 * 33]); o.w = pk2(s[6 * 33], s[7 * 33]);
        *(u32x4*)(WT + (size_t)tr_rowmap(mode, n0 + n, row0) * K + k0 + 8 * c) = o; }
    LDS_WAIT(); asm volatile("" ::: "memory");
}
#define TRJ(W_, ldw_, K_, N_, dst_, mode_, row0_, s1_, s2_, smode_) { const int ni_ = ((K_) / 64) * ((N_) / 32); if (r >= 0 && r < ni_) tr_item(W_, ldw_, K_, N_, dst_, mode_, row0_, s1_, s2_, smode_, scr, r, F.lane); r -= ni_; }
__device__ __forceinline__ void conv_first_half(Frame& F, int l) {
    LAS float* scr = (LAS float*)(F.lds + F.wave * 16384);
    const int gw = F.bx * NWAVES + F.wave, NGW = F.G * NWAVES;
    unsigned char* wb = F.ws + WS_W;
    const float* n1 = F.in[1] + (size_t)l * DM; const float* nm = F.in[5] + (size_t)l * DM; const float* mu = F.in[19] + (size_t)l * 3 * DM;
    const float* w1 = F.in[21] + (size_t)l * DM * 64; const float* a1 = F.in[24] + (size_t)l * DM * 64; const float* g1 = F.in[26] + (size_t)l * DM * 128;
    bf16_t* ina = (bf16_t*)(wb + W_INA);
    for (int it = gw;; it += NGW) { int r = it;
        TRJ(F.in[2] + (size_t)l * DM * FF, FF, DM, FF, (bf16_t*)(wb + W_GU1), 1, 0, n1, nullptr, 0)
        TRJ(F.in[3] + (size_t)l * DM * FF, FF, DM, FF, (bf16_t*)(wb + W_GU1), 2, 0, n1, nullptr, 0)
        TRJ(F.in[4] + (size_t)l * FF * DM, DM, FF, DM, (bf16_t*)(wb + W_D1), 0, 0, nullptr, nullptr, 0)
        TRJ(F.in[6] + (size_t)l * DM * INW, INW, DM, 2048, ina, 0, 0, nm, nullptr, 0)
        TRJ(w1, 64, DM, 64, ina, 0, 2048, nm, mu, 2)
        TRJ(a1, 64, DM, 64, ina, 0, 2112, nm, mu + DM, 2)
        TRJ(g1, 128, DM, 128, ina, 0, 2176, nm, mu + 2 * DM, 2)
        TRJ(w1, 64, DM, 64, ina, 0, 2304, nm, mu, 1)
        TRJ(a1, 64, DM, 64, ina, 0, 2368, nm, mu + DM, 1)
        TRJ(g1, 128, DM, 128, ina, 0, 2432, nm, mu + 2 * DM, 1)
        if (r >= 0) break; }
}
__device__ __forceinline__ void conv_second_half(Frame& F, int l, int b0) {
    LAS float* scr = (LAS float*)(F.lds + F.wave * 16384);
    const int gw = (F.bx - b0) * NWAVES + F.wave, NGW = (F.G - b0) * NWAVES;
    unsigned char* wb = F.ws + WS_W;
    const float* nm = F.in[5] + (size_t)l * DM; const float* n2 = F.in[36] + (size_t)l * DM;
    for (int it = gw;; it += NGW) { int r = it;
        TRJ(F.in[6] + (size_t)l * DM * INW + 2048, INW, DM, 4096, (bf16_t*)(wb + W_ING), 3, 0, nm, nullptr, 0)
        TRJ(F.in[34] + (size_t)l * DM * DM, DM, DM, DM, (bf16_t*)(wb + W_BR), 0, 0, nullptr, nullptr, 0)
        TRJ(F.in[35] + (size_t)l * DM * DM, DM, DM, DM, (bf16_t*)(wb + W_O), 0, 0, nullptr, nullptr, 0)
        TRJ(F.in[37] + (size_t)l * DM * FF, FF, DM, FF, (bf16_t*)(wb + W_GU2), 1, 0, n2, nullptr, 0)
        TRJ(F.in[38] + (size_t)l * DM * FF, FF, DM, FF, (bf16_t*)(wb + W_GU2), 2, 0, n2, nullptr, 0)
        TRJ(F.in[39] + (size_t)l * FF * DM, DM, FF, DM, (bf16_t*)(wb + W_D2), 0, 0, nullptr, nullptr, 0)
        TRJ(F.in[15] + (size_t)l * 256 * 256, 256, 256, 256, (bf16_t*)(wb + W_GLU), 0, 0, nullptr, nullptr, 0)
        if (r >= 0) break; }
}
__device__ __forceinline__ void prep_x(Frame& F) {
    const int gw = F.bx * NWAVES + F.wave, NGW = F.G * NWAVES;
    const float* x = F.in[0];
    for (int m = gw; m < TT; m += NGW) {
        const f32x4* xr = (const f32x4*)(x + (size_t)m * DM) + F.lane; float s = 0.f;
        unsigned long long* o8 = (unsigned long long*)(F.B1 + (size_t)m * DM) + F.lane;
#pragma unroll
        for (int j = 0; j < 4; ++j) { const f32x4 v = xr[64 * j]; s += (v[0] * v[0] + v[1] * v[1]) + (v[2] * v[2] + v[3] * v[3]);
            o8[64 * j] = (unsigned long long)pk2(v[0], v[1]) | ((unsigned long long)pk2(v[2], v[3]) << 32); }
        s += __shfl_xor(s, 1); s += __shfl_xor(s, 2);
        if ((F.lane & 3) == 0) F.SS[(size_t)m * 16 + (F.lane >> 2)] = s;
    }
}
__device__ __forceinline__ void final_norm(Frame& F) {
    const int gw = F.bx * NWAVES + F.wave, NGW = F.G * NWAVES;
    const f32x4* gn = (const f32x4*)F.in[40] + F.lane;
    for (int m = gw; m < TT; m += NGW) {
        const float rs = pg8::row_rstd(F.SS, m);
        f32x4* xr = (f32x4*)(F.X + (size_t)m * DM) + F.lane;
#pragma unroll
        for (int j = 0; j < 4; ++j) { const f32x4 v = xr[64 * j]; xr[64 * j] = v * rs * gn[64 * j]; }
    }
}

struct S5Par { float ar, ai; float bbr[16], bbi[16]; };
__device__ __forceinline__ void s5_params(Frame& F, int l, int g, int p, S5Par& P) {
    asm volatile("" : "+v"(p));
    const float lr = F.in[7][((size_t)l * 16 + g) * 64 + p], li = F.in[8][((size_t)l * 16 + g) * 64 + p], dt = expf(F.in[9][l * 16 + g]);
    const float mag = expf(lr * dt); P.ar = mag * cosf(li * dt); P.ai = mag * sinf(li * dt);
    const float inv = 1.0f / (lr * lr + li * li); const float qr = lr * inv, qi = -li * inv;
    const float cr = (P.ar - 1.0f) * qr - P.ai * qi, ci = (P.ar - 1.0f) * qi + P.ai * qr;
    const f32x4* br = (const f32x4*)(F.in[10] + (((size_t)l * 16 + g) * 64 + p) * 16); const f32x4* bi = (const f32x4*)(F.in[11] + (((size_t)l * 16 + g) * 64 + p) * 16);
#pragma unroll
    for (int q = 0; q < 4; ++q) { const f32x4 a = br[q], b = bi[q];
#pragma unroll
        for (int i = 0; i < 4; ++i) { P.bbr[4 * q + i] = cr * a[i] - ci * b[i]; P.bbi[4 * q + i] = cr * b[i] + ci * a[i]; } }
}
__device__ __forceinline__ void s5_step(const S5Par& P, const LAS float* urow, float& hr, float& hi) {
    const LAS f32x4* u4 = (const LAS f32x4*)urow; float bur = 0.f, bui = 0.f;
#pragma unroll
    for (int q = 0; q < 4; ++q) { const f32x4 u = u4[q];
#pragma unroll
        for (int i = 0; i < 4; ++i) { bur += P.bbr[4 * q + i] * u[i]; bui += P.bbi[4 * q + i] * u[i]; } }
    const float nr = P.ar * hr - P.ai * hi + bur, ni = P.ar * hi + P.ai * hr + bui; hr = nr; hi = ni;
}
__device__ __forceinline__ void load_u5_tile(Frame& F, int t0, LAS float* ubuf) {
    for (int i = F.tid; i < 64 * 64; i += NTHR) { const int t = i >> 6, q = i & 63; const h16x4 v = *(const h16x4*)(F.U5 + (size_t)(t0 + t) * 256 + 4 * q);
        f32x4 f; f[0] = (float)v[0]; f[1] = (float)v[1]; f[2] = (float)v[2]; f[3] = (float)v[3]; *(LAS f32x4*)(ubuf + t * 256 + 4 * q) = f; }
}


template <bool FIRST> __device__ __forceinline__ void mv32(LAS float* accp, float init, const LAS float* hb, const float* wsrc, int ldw) {
    float w[32];
    asm volatile("" : "+v"(wsrc));
#pragma unroll
    for (int j = 0; j < 32; ++j) w[j] = wsrc[(size_t)j * ldw];
#pragma unroll 2
    for (int tt = 0; tt < 32; ++tt) { const LAS f32x4* h4 = (const LAS f32x4*)(hb + tt * 256); float a = FIRST ? init : accp[tt * 256];
#pragma unroll
        for (int q = 0; q < 8; ++q) { const f32x4 v = h4[q]; a += v[0] * w[4 * q] + v[1] * w[4 * q + 1] + v[2] * w[4 * q + 2] + v[3] * w[4 * q + 3]; }
        accp[tt * 256] = a; }
}
__device__ __forceinline__ void m1_phase(Frame& F, int l) {
    LAS float* ubuf = (LAS float*)F.lds;
    LAS float* pl = (LAS float*)(F.lds + 65536);
    const int tid = F.tid, lane = F.lane, wave = F.wave;
    const int ch = tid & 255, half = tid >> 8;
    for (int c = F.bx; c < TT / 64; c += F.G) {
        const int t0 = c * 64, tb = t0 + half * 32, sb = tb & (SEQ - 1);
        load_u5_tile(F, t0, ubuf);
        {
            const int grp = ch >> 6, win = 2 << grp;
            const h16* up = F.PP + (size_t)tb * 1792 + ch;
            float s = 0.f;
            for (int j = 1; j <= win; ++j) if (sb - j >= 0) s += (float)up[-(ptrdiff_t)j * 1792];
#pragma unroll 8
            for (int tt = 0; tt < 32; ++tt) { const float u = (float)up[(size_t)tt * 1792]; s += u; const int pos = sb + tt;
                if (pos - win >= 0) s -= (float)up[(ptrdiff_t)(tt - win) * 1792];
                const float cnt = (float)((pos + 1 < win) ? (pos + 1) : win);
                pl[(half * 32 + tt) * 256 + ch] = s / cnt - u; }
        }
        {
            const h16* zp = F.PP + (size_t)tb * 1792 + 1024 + ch;
            const float cw0 = F.in[33][((size_t)l * 3 + 0) * 256 + ch], cw1 = F.in[33][((size_t)l * 3 + 1) * 256 + ch], cw2 = F.in[33][((size_t)l * 3 + 2) * 256 + ch];
            float z2 = 0.f, z1 = 0.f;
            if (sb >= 1) z1 = (float)zp[-(ptrdiff_t)1792 + 512] * (float)zp[-(ptrdiff_t)1792];
            if (sb >= 2) z2 = (float)zp[-(ptrdiff_t)2 * 1792 + 512] * (float)zp[-(ptrdiff_t)2 * 1792];
#pragma unroll 8
            for (int tt = 0; tt < 32; ++tt) { const h16* q = zp + (size_t)tt * 1792; const float z0 = (float)q[512] * (float)q[0];
                const float y = (float)q[256] * (cw0 * z2 + cw1 * z1 + cw2 * z0);
                F.B2[(size_t)(tb + tt) * 1024 + 768 + ch] = (bf16_t)f2bf(y); z2 = z1; z1 = z0; }
        }
        __syncthreads();
#pragma unroll 1
        for (int gi = 0; gi < 2; ++gi) { const int g = wave + 8 * gi; S5Par P; s5_params(F, l, g, lane, P); float hr = 0.f, hi = 0.f;
#pragma unroll 2
            for (int j = 0; j < 64; ++j) s5_step(P, ubuf + j * 256 + g * 16, hr, hi);
            *(f32x2*)(F.E + (((size_t)c * 16 + g) * 64 + lane) * 2) = (f32x2){hr, hi}; }
        __syncthreads();
        LAS float* accu = ubuf + half * 32 * 256 + ch;
        LAS float* accp = pl + half * 32 * 256 + ch;
        {
            const int grp = ch >> 6, d = ch & 63;
            const float* pw = F.in[16] + (((size_t)l * 4 + grp) * 64) * 64 + d;
            mv32<true>(accu, 0.f, pl + half * 32 * 256 + grp * 64, pw, 64);
            mv32<false>(accu, 0.f, pl + half * 32 * 256 + grp * 64 + 32, pw + 32 * 64, 64);
            const float sc = F.in[17][(size_t)l * 256 + ch];
#pragma unroll 4
            for (int tt = 0; tt < 32; ++tt) F.B2[(size_t)(tb + tt) * 1024 + 256 + ch] = (bf16_t)f2bf(accu[tt * 256] * sc);
        }
        __syncthreads();
#pragma unroll 8
        for (int tt = 0; tt < 32; ++tt) { const int t = tb + tt; float pre = (float)F.L16[(size_t)t * 512 + ch];
            if (sb + tt > 0) pre += (float)F.L16[(size_t)(t - 1) * 512 + 256 + ch];
            float a = pre; if (ch < 64) a = tanhf(pre); else if (ch >= 128) a = sigmoidf_(pre);
            ubuf[(half * 32 + tt) * 256 + ch] = a; }
        __syncthreads();
        const int hb = (t0 / SEQ) * 4 + (ch >> 6);
        unsigned char* rwb = F.RW + ((size_t)hb * SEQ + sb) * 896;
        const int cl = ch & 63;
        const LAS float* hrow = ubuf + half * 32 * 256;
        {
            const float* wp = F.in[22] + (size_t)l * 64 * 256 + ch;
            mv32<true>(accp, F.in[20][(size_t)l * 256 + ch], hrow, wp, 256);
            mv32<false>(accp, 0.f, hrow + 32, wp + 32 * 256, 256);
#pragma unroll 2
            for (int tt = 0; tt < 32; ++tt) { const float z = -accp[tt * 256]; const float sp = fmaxf(z, 0.f) + log1pf(expf(-fabsf(z)));
                const float wlog = -sp - 0.5f; const float dec = expf(-expf(wlog));
                *(float*)(rwb + (size_t)tt * 896 + cl * 4) = dec; }
        }
        {
            const float* gp = F.in[27] + (size_t)l * 128 * 256 + ch;
            mv32<true>(accp, 0.f, hrow + 128, gp, 256);
#pragma unroll 1
            for (int kc = 1; kc < 4; ++kc) mv32<false>(accp, 0.f, hrow + 128 + kc * 32, gp + (size_t)kc * 32 * 256, 256);
#pragma unroll 4
            for (int tt = 0; tt < 32; ++tt) F.G16[(size_t)(tb + tt) * 256 + ch] = (h16)accp[tt * 256];
        }
        {
            const float* ap = F.in[25] + (size_t)l * 64 * 256 + ch;
            mv32<true>(accp, F.in[23][(size_t)l * 256 + ch], hrow + 64, ap, 256);
            mv32<false>(accp, 0.f, hrow + 96, ap + 32 * 256, 256);
            const float mur = F.in[18][((size_t)l * 3 + 0) * 256 + ch], muk = F.in[18][((size_t)l * 3 + 1) * 256 + ch], muv = F.in[18][((size_t)l * 3 + 2) * 256 + ch];
            const float kkw = F.in[28][(size_t)l * 256 + ch], kaw = F.in[29][(size_t)l * 256 + ch];
            const h16* pp = F.PP + (size_t)tb * 1792 + 256 + ch;
            float rprev = 0.f, kprev = 0.f, vprev = 0.f;
            if (sb > 0) { rprev = (float)pp[-(ptrdiff_t)1792]; kprev = (float)pp[-(ptrdiff_t)1792 + 256]; vprev = (float)pp[-(ptrdiff_t)1792 + 512]; }
#pragma unroll 8
            for (int tt = 0; tt < 32; ++tt) { const float a = sigmoidf_(accp[tt * 256]);
                const h16* q = pp + (size_t)tt * 1792; const float rp = (float)q[0], kp = (float)q[256], vp = (float)q[512];
                const float r = rp + (rprev - rp) * mur, k = kp + (kprev - kp) * muk, v = vp + (vprev - vp) * muv;
                rprev = rp; kprev = kp; vprev = vp;
                const float kkv = k * kkw; const float nrm = sqrtf(wave_sum(kkv * kkv)); const float kk = kkv / fmaxf(nrm, 1e-12f);
                const float kt = k * (1.0f + (a - 1.0f) * kaw); const float bb = kk * a;
                h16* o = (h16*)(rwb + (size_t)tt * 896 + 256) + cl;
                o[0] = (h16)r; o[64] = (h16)kt; o[128] = (h16)v; o[192] = (h16)kk; o[256] = (h16)bb; }
        }
        __syncthreads();
    }
}

constexpr int SC_STEPS = 16, SC_FL = SC_STEPS * 384;
constexpr int SC_PIECES = SC_STEPS * 56;
constexpr int SC_OB = SC_STEPS * 256;
__device__ __forceinline__ void scan_load(const unsigned char* src, int cc, int lt, u32x4 (&rg)[4]) {
#pragma unroll
    for (int n = 0; n < 4; ++n) { const int i = lt + 256 * n; if (i < SC_PIECES) { const int step = i / 56, j = i % 56;
        rg[n] = *(const u32x4*)(src + ((size_t)cc * SC_STEPS + step) * 896 + (j < 16 ? j * 16 : 256 + (j - 16) * 16)); } }
}
__device__ __forceinline__ void scan_store(LAS float* buf, int lt, const u32x4 (&rg)[4]) {
#pragma unroll
    for (int n = 0; n < 4; ++n) { const int i = lt + 256 * n; if (i < SC_PIECES) { const int step = i / 56, j = i % 56;
        if (j < 16) { *(LAS u32x4*)(buf + step * 384 + j * 4) = rg[n]; }
        else { const int a = (j - 16) >> 3, e = (j - 16) & 7; const h16x8 h = __builtin_bit_cast(h16x8, rg[n]); f32x4 lo, hi;
            lo[0] = (float)h[0]; lo[1] = (float)h[1]; lo[2] = (float)h[2]; lo[3] = (float)h[3]; hi[0] = (float)h[4]; hi[1] = (float)h[5]; hi[2] = (float)h[6]; hi[3] = (float)h[7];
            LAS f32x4* d = (LAS f32x4*)(buf + step * 384 + 64 + a * 64 + e * 8); d[0] = lo; d[1] = hi; } } }
}
#define RAW_BAR() do { asm volatile("s_waitcnt lgkmcnt(0)" ::: "memory"); __builtin_amdgcn_s_barrier(); asm volatile("" ::: "memory"); } while (0)
__device__ __forceinline__ void scan_flush(const LAS float* ob, float* Og, int cc, int lt) {
    const LAS f32x4* p = (const LAS f32x4*)(ob + lt * 16); const f32x4 a = p[0], b = p[1], c = p[2], d = p[3];
    const float o = (((a[0] + a[1]) + (a[2] + a[3])) + ((b[0] + b[1]) + (b[2] + b[3]))) + (((c[0] + c[1]) + (c[2] + c[3])) + ((d[0] + d[1]) + (d[2] + d[3])));
    Og[((size_t)cc * SC_STEPS + (lt >> 4)) * 256 + (lt & 15)] = o;
}
__device__ __forceinline__ void rwkv_scan(Frame& F) {
    const int blk = F.bx, hb = blk >> 2, q = blk & 3, b = hb >> 2, h = hb & 3;
    const unsigned char* src = F.RW + (size_t)hb * SEQ * 896;
    LAS float* buf = (LAS float*)F.lds;
    LAS float* obuf = (LAS float*)(F.lds + 2 * SC_FL * 4);
    const int wave = F.wave, lane = F.lane; const bool loader = wave >= 4; const int lt = F.tid - 256;
    constexpr int NCH = SEQ / SC_STEPS;
    u32x4 rg[4];
    if (loader) { scan_load(src, 0, lt, rg); scan_store(buf, lt, rg); scan_load(src, 1, lt, rg); }
    else __builtin_amdgcn_s_setprio(3);
    RAW_BAR();
    f32x2 S01 = {0.f, 0.f}, S23 = {0.f, 0.f};
    const int rl = (wave & 3) * 4 + (lane >> 4), row = q * 16 + rl, ks = lane & 15;
    float* Og = F.O + ((size_t)b * SEQ) * 256 + h * 64 + q * 16;
#pragma unroll 1
    for (int cc = 0; cc < NCH; ++cc) {
        if (loader) {
            if (cc > 0) scan_flush(obuf + ((cc - 1) & 1) * SC_OB, Og, cc - 1, lt);
            if (cc + 1 < NCH) { scan_store(buf + ((cc + 1) & 1) * SC_FL, lt, rg); if (cc + 2 < NCH) scan_load(src, cc + 2, lt, rg); }
        } else {
            const LAS float* bb = buf + (cc & 1) * SC_FL + 4 * ks; const LAS float* vb = buf + (cc & 1) * SC_FL + 192 + row;
            LAS float* ob = obuf + (cc & 1) * SC_OB + rl * 16 + ks;
            f32x4 w_[2], r_[2], k_[2], kk_[2], b_[2]; float v_[2];
#define SC_LD(s_, j_) do { const LAS float* p_ = bb + (s_) * 384; w_[j_] = *(const LAS f32x4*)(p_); r_[j_] = *(const LAS f32x4*)(p_ + 64); k_[j_] = *(const LAS f32x4*)(p_ + 128); \
                kk_[j_] = *(const LAS f32x4*)(p_ + 256); b_[j_] = *(const LAS f32x4*)(p_ + 320); v_[j_] = vb[(s_) * 384]; } while (0)
            SC_LD(0, 0);
#pragma unroll
            for (int s = 0; s < SC_STEPS; ++s) { const int j = s & 1;
                if (s + 1 < SC_STEPS) SC_LD(s + 1, j ^ 1);
                const f32x4 w = w_[j], r = r_[j], k = k_[j], kk = kk_[j], bv = b_[j]; const float v = v_[j];
                f32x2 t = S01 * (f32x2){kk[0], kk[1]}; t = __builtin_elementwise_fma(S23, (f32x2){kk[2], kk[3]}, t);
                float sa = t[0] + t[1]; sa = allreduce16(sa);
                const f32x2 ns = {-sa, -sa}, vv = {v, v};
                const f32x2 u01 = __builtin_elementwise_fma(ns, (f32x2){bv[0], bv[1]}, vv * (f32x2){k[0], k[1]});
                const f32x2 u23 = __builtin_elementwise_fma(ns, (f32x2){bv[2], bv[3]}, vv * (f32x2){k[2], k[3]});
                S01 = __builtin_elementwise_fma(S01, (f32x2){w[0], w[1]}, u01); S23 = __builtin_elementwise_fma(S23, (f32x2){w[2], w[3]}, u23);
                f32x2 o = S01 * (f32x2){r[0], r[1]}; o = __builtin_elementwise_fma(S23, (f32x2){r[2], r[3]}, o);
                ob[s * 256] = o[0] + o[1];
                __builtin_amdgcn_sched_barrier(0); }
#undef SC_LD
        }
        RAW_BAR();
    }
    if (loader) scan_flush(obuf + ((NCH - 1) & 1) * SC_OB, Og, NCH - 1, lt);
    else __builtin_amdgcn_s_setprio(0);
    RAW_BAR();
}
__device__ __forceinline__ float gelu_tanh(float x) { const float u = 0.7978845608028654f * (x + 0.044715f * x * x * x); return 0.5f * x * (1.0f + tanhf(u)); }
__device__ __forceinline__ void s5_pass2(Frame& F, int l, int c) {
    LAS float* ubuf = (LAS float*)F.lds;
    LAS float* ybuf = (LAS float*)(F.lds + 65536);
    const int t0 = c * 64, lane = F.lane, wave = F.wave, cb0 = c & ~127;
    load_u5_tile(F, t0, ubuf);
    __syncthreads();
#pragma unroll 1
    for (int gi = 0; gi < 2; ++gi) { const int g = wave + 8 * gi; S5Par P; s5_params(F, l, g, lane, P);
        float cr[16], ci[16]; int lane_l = lane; asm volatile("" : "+v"(lane_l));
#pragma unroll
        for (int hh = 0; hh < 16; ++hh) { cr[hh] = F.in[12][(((size_t)l * 16 + g) * 16 + hh) * 64 + lane_l]; ci[hh] = F.in[13][(((size_t)l * 16 + g) * 16 + hh) * 64 + lane_l]; }
        float pr = P.ar, pi = P.ai;
#pragma unroll
        for (int s = 0; s < 6; ++s) { const float nr = pr * pr - pi * pi, ni = 2.0f * pr * pi; pr = nr; pi = ni; }
        float hr = 0.f, hi = 0.f;
#pragma unroll 2
        for (int c2 = cb0; c2 < c; ++c2) { const f32x2 e = *(const f32x2*)(F.E + (((size_t)c2 * 16 + g) * 64 + lane) * 2);
            const float nr = pr * hr - pi * hi + e[0], ni = pr * hi + pi * hr + e[1]; hr = nr; hi = ni; }
        const bool b3 = (lane & 8) != 0, b2 = (lane & 4) != 0, b1 = (lane & 2) != 0, b0 = (lane & 1) != 0;
#pragma unroll 1
        for (int j = 0; j < 64; ++j) { s5_step(P, ubuf + j * 256 + g * 16, hr, hi);
            float v8[8], v4[4], v2[2];
#pragma unroll
            for (int i = 0; i < 8; ++i) { const float lo = hr * cr[i] - hi * ci[i], hv = hr * cr[i + 8] - hi * ci[i + 8];
                const float keep = b3 ? hv : lo, send = b3 ? lo : hv; v8[i] = keep + dppx<0x140>(send); }
#pragma unroll
            for (int i = 0; i < 4; ++i) { const float keep = b2 ? v8[i + 4] : v8[i], send = b2 ? v8[i] : v8[i + 4]; v4[i] = keep + dppx<0x141>(send); }
#pragma unroll
            for (int i = 0; i < 2; ++i) { const float keep = b1 ? v4[i + 2] : v4[i], send = b1 ? v4[i] : v4[i + 2]; v2[i] = keep + dppx<0x4E>(send); }
            float y = (b0 ? v2[1] : v2[0]) + dppx<0xB1>(b0 ? v2[0] : v2[1]);
            y += __shfl_xor(y, 16); y += __shfl_xor(y, 32);
            if (lane < 16) ybuf[j * 256 + g * 16 + lane] = y; }
    }
    __syncthreads();
    { const int ch = F.tid & 255, half = F.tid >> 8; const float dd = F.in[14][(size_t)l * 256 + ch];
        for (int tt = 0; tt < 32; ++tt) { const int tl = half * 32 + tt; const float y = ybuf[tl * 256 + ch] + dd * ubuf[tl * 256 + ch];
            F.GL[(size_t)(t0 + tl) * 256 + ch] = (bf16_t)f2bf(gelu_tanh(y)); } }
    __syncthreads();
}
__device__ __forceinline__ void m2_phase(Frame& F, int l) {
#ifndef NO_SCAN
    int bxs = F.bx; asm volatile("" : "+s"(bxs));
    if (bxs < 32) { rwkv_scan(F); return; }
#endif
#ifndef NO_P2
    for (int c = F.bx - 32; c < TT / 64; c += F.G - 32) s5_pass2(F, l, c);
    conv_second_half(F, l, 32);
#endif
}
__device__ __forceinline__ void rwkv_post(Frame& F, int l) {
    const int gw = F.bx * NWAVES + F.wave, NGW = F.G * NWAVES, lane = F.lane;
    for (int it = gw; it < TT * 4; it += NGW) { const int t = it >> 2, hh = it & 3, c = hh * 64 + lane;
        const float o = F.O[(size_t)t * 256 + c];
        const float mu = wave_sum(o) * (1.0f / 64.0f); const float d = o - mu; const float var = wave_sum(d * d) * (1.0f / 64.0f);
        const float on = d * rsqrtf(var + 64e-5f) * F.in[31][(size_t)l * 256 + c] + F.in[32][(size_t)l * 256 + c];
        const int b = t / SEQ, pos = t & (SEQ - 1);
        const h16* rw = (const h16*)(F.RW + ((size_t)(b * 4 + hh) * SEQ + pos) * 896 + 256) + lane;
        const float r = (float)rw[0], k = (float)rw[64], v = (float)rw[128];
        const float bs = wave_sum(r * k * F.in[30][(size_t)l * 256 + c]);
        const float out = (on + bs * v) * (float)F.G16[(size_t)t * 256 + c];
        F.B2[(size_t)t * 1024 + 512 + c] = (bf16_t)f2bf(out); }
}

constexpr int NPH = 25;
#ifndef PHMASK
#define PHMASK 0xFFFF
#endif
#define PHON(k) (((PHMASK) >> (k)) & 1)
template <int PH> __device__ __forceinline__ void run_phase(const int wave_s, unsigned char* lds_raw) {
    typedef pg8::StaticOrder SO;
    int tid = wave_s * 64 + (int)__builtin_amdgcn_mbcnt_hi(~0u, __builtin_amdgcn_mbcnt_lo(~0u, 0u)); asm volatile("" : "+v"(tid));
    int G = gridDim.x, bx = blockIdx.x; asm volatile("" : "+s"(G), "+s"(bx));
    const __attribute__((address_space(4))) unsigned char* ka = (const __attribute__((address_space(4))) unsigned char*)__builtin_amdgcn_kernarg_segment_ptr();
    asm volatile("" : "+s"(ka));
    const __attribute__((address_space(4))) Args* ap = (const __attribute__((address_space(4))) Args*)ka;
    Frame F;
    F.lds = (LAS unsigned char*)lds_raw;
    F.tid = tid; F.lane = tid & 63; F.wave = __builtin_amdgcn_readfirstlane(tid >> 6); F.G = G; F.bx = bx;
    F.in = (in_t)ka; F.X = ap->out; F.ws = ap->ws;
    unsigned char* ws = F.ws;
    F.SS = (float*)(ws + WS_SS); F.E = (float*)(ws + WS_E); F.B1 = (bf16_t*)(ws + WS_B1); F.B2 = (bf16_t*)(ws + WS_B2);
    unsigned char* z = ws + WS_Z;
    F.HID = (bf16_t*)(z + Z_HID); F.GL = (bf16_t*)(z + Z_GL); F.U5 = (h16*)(z + Z_U5); F.PP = (h16*)(z + Z_PP); F.L16 = (h16*)(z + Z_L16); F.G16 = (h16*)(z + Z_G16); F.R = (h16*)(z + Z_R);
    F.O = (float*)(z + Z_O); F.RW = z + Z_RW;
    if constexpr (PH == 0) { conv_first_half(F, 0); prep_x(F); }
    else { constexpr int l = (PH - 1) / 12, k = (PH - 1) % 12;
        if constexpr (k == 0) { pg8::Gemm g{F.B1, (const bf16_t*)(ws + WS_W + W_GU1), TT, 2 * FF, DM, 1}; SO S; S.init(TT, 2 * FF, G, bx); pg8::EpiGU E{F.HID, F.SS}; pg8::gemm_phase<pg8::EpiGU, SO, true, true>(F.lds, g, S, E, tid); }
        else if constexpr (k == 1) { pg8::Gemm g{F.HID, (const bf16_t*)(ws + WS_W + W_D1), TT, DM, FF, 1}; SO S; S.init(TT, DM, G, bx); pg8::EpiDown E{l == 0 ? F.in[0] : F.X, F.X, F.B1, F.SS, 0.5f}; pg8::gemm_phase<pg8::EpiDown, SO, true, true>(F.lds, g, S, E, tid); }
        else if constexpr (k == 2) { pg8::Gemm g{F.B1, (const bf16_t*)(ws + WS_W + W_INA), TT, 2560, DM, 1}; SO S; S.init(TT, 2560, G, bx); pg8::EpiInA E{F.U5, F.PP, F.L16, F.SS}; pg8::gemm_phase<pg8::EpiInA, SO, true, true>(F.lds, g, S, E, tid); }
        else if constexpr (k == 3) { m1_phase(F, l); }
        else if constexpr (k == 4) { m2_phase(F, l); }
        else if constexpr (k == 5) { { pg8::Gemm g{F.GL, (const bf16_t*)(ws + WS_W + W_GLU), TT, 256, 256, 1}; SO S; S.init(TT, 256, G, bx); pg8::EpiGlu E{F.GL, F.B2}; pg8::gemm_phase<pg8::EpiGlu, SO, true, true>(F.lds, g, S, E, tid); } rwkv_post(F, l); }
        else if constexpr (k == 6) { pg8::Gemm g{F.B1, (const bf16_t*)(ws + WS_W + W_ING), TT, 4096, DM, 1}; SO S; S.init(TT, 4096, G, bx); pg8::EpiGate E{F.R, F.SS}; pg8::gemm_phase<pg8::EpiGate, SO, true, true>(F.lds, g, S, E, tid); }
        else if constexpr (k == 7) { pg8::Gemm g{F.B2, (const bf16_t*)(ws + WS_W + W_BR), TT, DM, DM, 4}; pg8::SegOrder4 S; S.so.init(TT, DM, G, bx); pg8::EpiBranch E{F.R, F.B1}; pg8::gemm_phase<pg8::EpiBranch, pg8::SegOrder4, true, true>(F.lds, g, S, E, tid); }
        else if constexpr (k == 8) { pg8::Gemm g{F.B1, (const bf16_t*)(ws + WS_W + W_O), TT, DM, DM, 1}; SO S; S.init(TT, DM, G, bx); pg8::EpiDown E{F.X, F.X, F.B2, F.SS, 1.0f}; pg8::gemm_phase<pg8::EpiDown, SO, true, true>(F.lds, g, S, E, tid); }
        else if constexpr (k == 9) { pg8::Gemm g{F.B2, (const bf16_t*)(ws + WS_W + W_GU2), TT, 2 * FF, DM, 1}; SO S; S.init(TT, 2 * FF, G, bx); pg8::EpiGU E{F.HID, F.SS}; pg8::gemm_phase<pg8::EpiGU, SO, true, true>(F.lds, g, S, E, tid); }
        else if constexpr (k == 10) { pg8::Gemm g{F.HID, (const bf16_t*)(ws + WS_W + W_D2), TT, DM, FF, 1}; SO S; S.init(TT, DM, G, bx); pg8::EpiDown E{F.X, F.X, F.B1, F.SS, 0.5f}; pg8::gemm_phase<pg8::EpiDown, SO, true, true>(F.lds, g, S, E, tid); }
        else { if constexpr (l == 0) conv_first_half(F, 1); else final_norm(F); }
    }
}
#ifndef REPMASK
#define REPMASK 0
#endif
#define SEAM() do { __syncthreads(); cg::this_grid().sync(); } while (0)
#define PHASE(k) if (ph_lo <= (k) && (k) < ph_hi) { run_phase<(k)>(wave_s, lds_raw); \
    if ((k) >= 1 && ((REPMASK >> (((k) - 1) % 12)) & 1)) { SEAM(); run_phase<(k)>(wave_s, lds_raw); } \
    if ((k) + 1 < ph_hi) SEAM(); }
__global__ void __launch_bounds__(NTHR, 2) mk_fwd(Args args) {
    extern __shared__ __attribute__((aligned(16))) unsigned char lds_raw[];
    const int ph_lo = args.ph_lo, ph_hi = args.ph_hi;
    const int wave_s = __builtin_amdgcn_readfirstlane((int)threadIdx.x >> 6);
    PHASE(0) PHASE(1) PHASE(2) PHASE(3) PHASE(4) PHASE(5) PHASE(6) PHASE(7) PHASE(8) PHASE(9) PHASE(10) PHASE(11) PHASE(12)
    PHASE(13) PHASE(14) PHASE(15) PHASE(16) PHASE(17) PHASE(18) PHASE(19) PHASE(20) PHASE(21) PHASE(22) PHASE(23) PHASE(24)
}

extern "C" void kernel_launch(void* const* d_in, const int* in_sizes, int n_in, void* d_out, int out_size, void* d_ws, size_t ws_size, hipStream_t stream) {
    static int grid = 0;
    if (grid == 0) {
        if (n_in != 41 || out_size != TT * DM || ws_size < WS_END) { fprintf(stderr, "kernel_launch: unexpected shapes (n_in %d out %d ws %zu)\n", n_in, out_size, ws_size); grid = -1; return; }
        int dev = 0, cus = 0, per_cu = 0;
        (void)hipGetDevice(&dev); (void)hipDeviceGetAttribute(&cus, hipDeviceAttributeMultiprocessorCount, dev);
        if (hipFuncSetAttribute((const void*)mk_fwd, hipFuncAttributeMaxDynamicSharedMemorySize, LDS_BYTES) != hipSuccess) { fprintf(stderr, "kernel_launch: hipFuncSetAttribute failed\n"); grid = -1; return; }
        if (hipOccupancyMaxActiveBlocksPerMultiprocessor(&per_cu, (const void*)mk_fwd, NTHR, LDS_BYTES) != hipSuccess || per_cu < 1) { fprintf(stderr, "kernel_launch: occupancy query says %d\n", per_cu); per_cu = 1; }
        (void)hipGetLastError();
        grid = cus * (per_cu >= 1 ? 1 : 1);
        if (grid < 64) { fprintf(stderr, "kernel_launch: grid %d too small\n", grid); }
    }
    if (grid < 0) return;
    Args a{};
    for (int i = 0; i < 41; ++i) a.in[i] = (const float*)d_in[i];
    a.out = (float*)d_out; a.ws = (unsigned char*)d_ws;
#if ONE_LAUNCH
    a.ph_lo = 0; a.ph_hi = NPH;
    void* kargs[] = {&a};
    hipError_t e = hipLaunchCooperativeKernel((const void*)mk_fwd, dim3(grid), dim3(NTHR), kargs, LDS_BYTES, stream);
    if (e != hipSuccess) fprintf(stderr, "cooperative launch failed: %s (grid %d)\n", hipGetErrorString(e), grid);
#else
    for (int ph = 0; ph < NPH; ++ph) { a.ph_lo = ph; a.ph_hi = ph + 1; hipLaunchKernelGGL(mk_fwd, dim3(grid), dim3(NTHR), LDS_BYTES, stream, a); }
#endif
}
```

```cpp
#include <hip/hip_runtime.h>
#include <hip/hip_cooperative_groups.h>
#include <cstdio>
#include <cstdint>
#include <cstddef>
namespace cg = cooperative_groups;
namespace pg8 {
#define PG8_LAS __attribute__((address_space(3)))
typedef unsigned short bf16_t;
typedef short bf16x8 __attribute__((ext_vector_type(8)));
typedef float f32x4 __attribute__((ext_vector_type(4)));
typedef unsigned u32x4 __attribute__((ext_vector_type(4)));
constexpr int BM = 256, BK = 64, HALF = 128, HTB = HALF * BK * 2  , STAGE_BYTES = 8 * HTB, NXCD = 8, WGM = 8;

__host__ __device__ __forceinline__ int lds_byte(int r, int c) { const int st = (r >> 4) * 2 + (c >> 5), rr = r & 15, cc = c & 31, ob = rr * 64 + cc * 2; return st * 1024 + (ob ^ (((ob >> 9) & 1) << 5)); }
__host__ __device__ __forceinline__ void stage_rc(int b, int& R, int& C) { const int st = b / 1024, sb = b % 1024, swz = sb ^ (((sb >> 9) & 1) << 5); R = (st >> 1) * 16 + swz / 64; C = (st & 1) * 32 + (swz % 64) / 2; }
__host__ __device__ __forceinline__ int perm32(int rho) { const int n = rho >> 4, i = rho & 15; return 8 * (i >> 2) + 4 * n + (i & 3); }

struct Unit { int pm, pn, g; };
struct Gemm { const bf16_t* A; const bf16_t* Bt; int M, N, K, nseg; };

struct StaticOrder {
    int nM, nN, nwg, G, c;
    __host__ __device__ void init(int M, int N, int G_, int c_) { nM = M / BM; nN = N / BM; nwg = nM * nN; G = G_; c = c_; }
    __host__ __device__ bool next(int i, Unit& u) const {
        const long L = (long)i * G + c; if (L >= nwg) return false;
        int wgid = (int)L; { const int q = nwg / NXCD, r = nwg % NXCD, xcd = wgid % NXCD, off = wgid / NXCD; wgid = (xcd < r ? xcd * (q + 1) : r * (q + 1) + (xcd - r) * q) + off; }
        const int nig = WGM * nN, gid = wgid / nig, fm = gid * WGM, gsz = (nM - fm) < WGM ? (nM - fm) : WGM;
        u.pm = fm + ((wgid % nig) % gsz); u.pn = (wgid % nig) / gsz; u.g = 0; return true;
    }
    __device__ __forceinline__ void a_ready(const Unit&) const {}
    __device__ __forceinline__ void done(const Unit&) const {}
};


struct SegOrder4 {
    StaticOrder so;
    __host__ __device__ bool next(int i, Unit& u) const { if (!so.next(i >> 2, u)) return false; u.g = i & 3; return true; }
    __device__ __forceinline__ void a_ready(const Unit&) const {}
    __device__ __forceinline__ void done(const Unit&) const {}
};

typedef _Float16 h16;
typedef _Float16 h16x4 __attribute__((ext_vector_type(4)));
typedef unsigned u32x2 __attribute__((ext_vector_type(2)));
__device__ __forceinline__ unsigned cvt_pk_bf16(float lo, float hi) { unsigned r; asm volatile("v_cvt_pk_bf16_f32 %0, %1, %2" : "=v"(r) : "v"(lo), "v"(hi)); return r; }
__device__ __forceinline__ u32x2 pack_bf16x4(f32x4 v) { u32x2 w; w.x = cvt_pk_bf16(v[0], v[1]); w.y = cvt_pk_bf16(v[2], v[3]); return w; }
__device__ __forceinline__ h16x4 pack_h16x4(f32x4 v) { h16x4 w; w[0] = (h16)v[0]; w[1] = (h16)v[1]; w[2] = (h16)v[2]; w[3] = (h16)v[3]; return w; }
__device__ __forceinline__ float fast_sigmoid(float x) { return __builtin_amdgcn_rcpf(1.0f + __expf(-x)); }
__device__ __forceinline__ float row_rstd(const float* SS, int row) {
    const f32x4* p = (const f32x4*)(SS + (size_t)row * 16);
    const f32x4 a = p[0], b = p[1], c = p[2], d = p[3];
    const float s = ((a[0] + a[1]) + (a[2] + a[3])) + ((b[0] + b[1]) + (b[2] + b[3])) + ((c[0] + c[1]) + (c[2] + c[3])) + ((d[0] + d[1]) + (d[2] + d[3]));
    return rsqrtf(s * (1.0f / 1024.0f) + 1e-6f);
}

struct EpiGU {
    static constexpr bool PERM = true, KSEG = false;
    bf16_t* hid; const float* SS;
    __device__ __forceinline__ void operator()(const f32x4 (&acc)[2][2][4][2], const Unit& u, int wr, int wc, int fr, int fq) const {
        int row0 = u.pm * BM + wr * 64 + fr; asm volatile("" : "+v"(row0)); const int j0 = u.pn * 128 + wc * 16 + fq * 4;
#pragma unroll
        for (int ai = 0; ai < 2; ++ai)
#pragma unroll
            for (int m = 0; m < 4; ++m) { const int row = row0 + ai * HALF + m * 16; const float rs = row_rstd(SS, row);
#pragma unroll
                for (int bj = 0; bj < 2; ++bj) { const f32x4 g = acc[ai][bj][m][0] * rs, up = acc[ai][bj][m][1] * rs; f32x4 h;
#pragma unroll
                    for (int i = 0; i < 4; ++i) h[i] = g[i] * fast_sigmoid(g[i]) * up[i];
                    *(u32x2*)(hid + (size_t)row * 2816 + j0 + bj * 64) = pack_bf16x4(h); } }
    }
};
struct EpiDown {
    static constexpr bool PERM = false, KSEG = false;
    const float* res; float* X; bf16_t* xb; float* SS; float alpha;
    __device__ __forceinline__ void operator()(const f32x4 (&acc)[2][2][4][2], const Unit& u, int wr, int wc, int fr, int fq) const {
        int row0 = u.pm * BM + wr * 64 + fr; asm volatile("" : "+v"(row0)); const int c0 = u.pn * BM + wc * 32 + fq * 4;
#pragma unroll
        for (int ai = 0; ai < 2; ++ai)
#pragma unroll
            for (int m = 0; m < 4; ++m) { const int row = row0 + ai * HALF + m * 16; float ss = 0.f;
#pragma unroll
                for (int bj = 0; bj < 2; ++bj)
#pragma unroll
                    for (int n = 0; n < 2; ++n) { const size_t off = (size_t)row * 1024 + c0 + bj * HALF + n * 16;
                        const f32x4 r = *(const f32x4*)(res + off); const f32x4 o = r + acc[ai][bj][m][n] * alpha;
                        *(f32x4*)(X + off) = o; *(u32x2*)(xb + off) = pack_bf16x4(o);
                        ss += (o[0] * o[0] + o[1] * o[1]) + (o[2] * o[2] + o[3] * o[3]); }
                ss += __shfl_xor(ss, 16); ss += __shfl_xor(ss, 32);
                if (fq == 0) SS[(size_t)row * 16 + u.pn * 4 + wc] = ss;
                asm volatile("" ::: "memory"); }
    }
};
struct EpiInA {
    static constexpr bool PERM = false, KSEG = false;
    h16* U5; h16* PP; h16* L16; const float* SS;
    __device__ __forceinline__ void operator()(const f32x4 (&acc)[2][2][4][2], const Unit& u, int wr, int wc, int fr, int fq) const {
        int row0 = u.pm * BM + wr * 64 + fr; asm volatile("" : "+v"(row0)); const int cl = wc * 32 + fq * 4;
        h16* base; int ld, cb;
        if (u.pn == 0) { base = U5; ld = 256; cb = 0; } else if (u.pn < 8) { base = PP; ld = 1792; cb = (u.pn - 1) * 256; } else { base = L16; ld = 512; cb = (u.pn - 8) * 256; }
#pragma unroll
        for (int ai = 0; ai < 2; ++ai)
#pragma unroll
            for (int m = 0; m < 4; ++m) { const int row = row0 + ai * HALF + m * 16; const float rs = row_rstd(SS, row);
#pragma unroll
                for (int bj = 0; bj < 2; ++bj)
#pragma unroll
                    for (int n = 0; n < 2; ++n) *(h16x4*)(base + (size_t)row * ld + cb + cl + bj * HALF + n * 16) = pack_h16x4(acc[ai][bj][m][n] * rs); }
    }
};
struct EpiGate {
    static constexpr bool PERM = false, KSEG = false;
    h16* R; const float* SS;
    __device__ __forceinline__ void operator()(const f32x4 (&acc)[2][2][4][2], const Unit& u, int wr, int wc, int fr, int fq) const {
        int row0 = u.pm * BM + wr * 64 + fr; asm volatile("" : "+v"(row0)); const int d0 = 256 * (u.pn >> 2) + 128 * ((u.pn >> 1) & 1) + 16 * (u.pn & 1) + 32 * wc + 4 * fq;
#pragma unroll
        for (int ai = 0; ai < 2; ++ai)
#pragma unroll
            for (int m = 0; m < 4; ++m) { const int row = row0 + ai * HALF + m * 16; const float rs = row_rstd(SS, row);
                f32x4 e[4];
#pragma unroll
                for (int g = 0; g < 4; ++g)
#pragma unroll
                    for (int i = 0; i < 4; ++i) e[g][i] = 1.0f + __expf(-fminf(fmaxf(acc[ai][g >> 1][m][g & 1][i] * rs, -10.f), 30.f));
                f32x4 r[4];
#pragma unroll
                for (int i = 0; i < 4; ++i) { const float i0 = __builtin_amdgcn_rcpf(e[0][i]), i1 = __builtin_amdgcn_rcpf(e[1][i]), i2 = __builtin_amdgcn_rcpf(e[2][i]), i3 = __builtin_amdgcn_rcpf(e[3][i]);
                    r[0][i] = e[1][i] * i0; r[1][i] = e[2][i] * i1; r[2][i] = e[3][i] * i2; r[3][i] = i3; }
#pragma unroll
                for (int g = 0; g < 4; ++g) *(h16x4*)(R + ((size_t)row * 4 + g) * 1024 + d0) = pack_h16x4(r[g]); }
    }
};
struct EpiBranch {
    static constexpr bool PERM = false, KSEG = true;
    const h16* R; bf16_t* out;
    __device__ __forceinline__ void operator()(f32x4 (&acc)[2][2][4][2], const Unit& u, int wr, int wc, int fr, int fq) const {
        unsigned q0 = (unsigned)(u.pm * BM + wr * 64 + fr) * 1024u + (unsigned)(u.pn * BM + wc * 32 + fq * 4); asm volatile("" : "+v"(q0));
        const unsigned r0 = (q0 - (q0 & 1023u)) * 4u + (unsigned)u.g * 1024u + (q0 & 1023u);
        const bool last = u.g == 3;
#pragma unroll
        for (int ai = 0; ai < 2; ++ai)
#pragma unroll
            for (int m = 0; m < 4; ++m) {
#pragma unroll
                for (int bj = 0; bj < 2; ++bj)
#pragma unroll
                    for (int n = 0; n < 2; ++n) { const unsigned off = q0 + (unsigned)((ai * HALF + m * 16) * 1024 + bj * HALF + n * 16);
                        const h16x4 r = *(const h16x4*)(R + (r0 + (unsigned)((ai * HALF + m * 16) * 4096 + bj * HALF + n * 16)));
                        f32x4 rf; rf[0] = (float)r[0]; rf[1] = (float)r[1]; rf[2] = (float)r[2]; rf[3] = (float)r[3];
                        acc[ai][bj][m][n] = acc[ai][bj][m][n] * rf;
                        if (last) *(u32x2*)(out + off) = pack_bf16x4(acc[ai][bj][m][n]); }
                asm volatile("" ::: "memory"); }
    }
};
struct EpiGlu {
    static constexpr bool PERM = false, KSEG = false;
    const bf16_t* gl; bf16_t* ys;
    __device__ __forceinline__ void operator()(const f32x4 (&acc)[2][2][4][2], const Unit& u, int wr, int wc, int fr, int fq) const {
        int row0 = u.pm * BM + wr * 64 + fr; asm volatile("" : "+v"(row0)); const int c0 = wc * 32 + fq * 4;
#pragma unroll
        for (int ai = 0; ai < 2; ++ai)
#pragma unroll
            for (int m = 0; m < 4; ++m) { const int row = row0 + ai * HALF + m * 16;
#pragma unroll
                for (int bj = 0; bj < 2; ++bj)
#pragma unroll
                    for (int n = 0; n < 2; ++n) { const int c = c0 + bj * HALF + n * 16; const u32x2 gv = *(const u32x2*)(gl + (size_t)row * 256 + c);
                        f32x4 g; g[0] = __uint_as_float(gv.x << 16); g[1] = __uint_as_float(gv.x & 0xffff0000u); g[2] = __uint_as_float(gv.y << 16); g[3] = __uint_as_float(gv.y & 0xffff0000u);
                        f32x4 o;
#pragma unroll
                        for (int i = 0; i < 4; ++i) o[i] = g[i] * fast_sigmoid(acc[ai][bj][m][n][i]);
                        *(u32x2*)(ys + (size_t)row * 1024 + c) = pack_bf16x4(o); }
                asm volatile("" ::: "memory"); }
    }
};

template <class Epi, class Sched, bool ALIGN_EPI = false, bool SP2 = false>
__device__ __forceinline__ void gemm_phase(PG8_LAS unsigned char* lds, const Gemm g, const Sched& S, const Epi& E, const int tid) {
    const int wid = __builtin_amdgcn_readfirstlane(tid >> 6), lane = tid & 63, wr = wid >> 2, wc = wid & 3, fr = lane & 15, fq = lane >> 4;
    const int K = g.K, nt = K / BK / g.nseg; const size_t segb = (size_t)(K / g.nseg) * 2;
    unsigned voffA[2], voffB[2];
#pragma unroll
    for (int i = 0; i < 2; ++i) { int R, C; stage_rc(tid * 16 + i * 8192, R, C); const int Rb = Epi::PERM ? ((R & ~31) + perm32(R & 31)) : R;
        voffA[i] = (unsigned)(R * K + C) * 2u; voffB[i] = (unsigned)(Rb * K + C) * 2u; }
    const size_t kstep = (size_t)(BK * 2);
    const size_t hstep = (size_t)HALF * K * 2;
    const size_t tstep = 2 * hstep;
    const unsigned ldsw = (unsigned)wid * 1024u;
    const int aoff = lds_byte(wr * 64 + fr, fq * 8), boff = lds_byte(wc * 32 + fr, fq * 8);
#define PG8_SA(b, h) (((b) * 2 + (h)) * HTB)
#define PG8_SB(b, h) ((4 + (b) * 2 + (h)) * HTB)
#define PG8_STAGE(bufoff, gbase, voff) do { _Pragma("unroll") for (int _i = 0; _i < 2; ++_i) \
        __builtin_amdgcn_global_load_lds((const unsigned*)((const char*)(gbase) + (voff)[_i]), (PG8_LAS unsigned*)(lds + (bufoff) + ldsw + _i * 8192), 16, 0, 0); } while (0)
#define PG8_LDA(dst, b, h) do { _Pragma("unroll") for (int m = 0; m < 4; ++m) _Pragma("unroll") for (int k = 0; k < 2; ++k) dst[m][k] = *(const PG8_LAS bf16x8*)(lds + PG8_SA(b, h) + aoff + m * 2048 + k * 1024); } while (0)
#define PG8_LDB(dst, b, h) do { _Pragma("unroll") for (int n = 0; n < 2; ++n) _Pragma("unroll") for (int k = 0; k < 2; ++k) dst[n][k] = *(const PG8_LAS bf16x8*)(lds + PG8_SB(b, h) + boff + n * 2048 + k * 1024); } while (0)
#define PG8_MMA(ai, bj, At, Bt) do { __builtin_amdgcn_s_setprio(1); _Pragma("unroll") for (int m = 0; m < 4; ++m) _Pragma("unroll") for (int n = 0; n < 2; ++n) _Pragma("unroll") for (int k = 0; k < 2; ++k) \
        acc[ai][bj][m][n] = __builtin_amdgcn_mfma_f32_16x16x32_bf16(Bt[n][k], At[m][k], acc[ai][bj][m][n], 0, 0, 0); __builtin_amdgcn_s_setprio(0); } while (0)
#define PG8_WAIT_V(n) asm volatile("s_waitcnt vmcnt(" #n ")" ::: "memory")
#define PG8_WAIT_L(n) asm volatile("s_waitcnt lgkmcnt(" #n ")" ::: "memory")
#define PG8_BAR __builtin_amdgcn_s_barrier()
#define PG8_SCHED __builtin_amdgcn_sched_barrier(0)
    Unit cur, nxt; int ui = 0;
    if (!S.next(0, cur)) return;
    f32x4 acc[2][2][4][2];
#pragma unroll
    for (int a = 0; a < 2; ++a)
#pragma unroll
        for (int b = 0; b < 2; ++b)
#pragma unroll
            for (int m = 0; m < 4; ++m)
#pragma unroll
                for (int n = 0; n < 2; ++n) acc[a][b][m][n] = (f32x4){0.f, 0.f, 0.f, 0.f};
    bf16x8 At[4][2], B0[2][2], B1[2][2];
    const char* cA = (const char*)g.A + (size_t)cur.pm * tstep + (size_t)cur.g * segb; const char* cB = (const char*)g.Bt + (size_t)cur.pn * tstep + (size_t)cur.g * segb;
    S.a_ready(cur);
    if constexpr (SP2) {
        PG8_STAGE(PG8_SB(0, 0), cB, voffB); PG8_STAGE(PG8_SB(0, 1), cB + hstep, voffB); PG8_STAGE(PG8_SA(0, 0), cA, voffA); PG8_STAGE(PG8_SA(0, 1), cA + hstep, voffA);
        if (wr == 1) PG8_BAR;
        PG8_WAIT_V(2); PG8_BAR;
        PG8_STAGE(PG8_SB(1, 0), cB + kstep, voffB); PG8_STAGE(PG8_SA(1, 0), cA + kstep, voffA); PG8_STAGE(PG8_SB(1, 1), cB + hstep + kstep, voffB);
        PG8_WAIT_V(6); PG8_BAR;
    } else {
        PG8_STAGE(PG8_SB(0, 0), cB, voffB); PG8_STAGE(PG8_SA(0, 0), cA, voffA); PG8_STAGE(PG8_SB(0, 1), cB + hstep, voffB); PG8_STAGE(PG8_SA(0, 1), cA + hstep, voffA);
        if (wr == 1) PG8_BAR;
        PG8_WAIT_V(4); PG8_BAR;
        PG8_STAGE(PG8_SB(1, 0), cB + kstep, voffB); PG8_STAGE(PG8_SA(1, 0), cA + kstep, voffA); PG8_STAGE(PG8_SB(1, 1), cB + hstep + kstep, voffB);
        PG8_WAIT_V(6); PG8_BAR;
    }
    for (;;) {
        const bool has_next = S.next(ui + 1, nxt);
        const char* nA = has_next ? (const char*)g.A + (size_t)nxt.pm * tstep + (size_t)nxt.g * segb : cA; const char* nB = has_next ? (const char*)g.Bt + (size_t)nxt.pn * tstep + (size_t)nxt.g * segb : cB;
        for (int t = 0; t < nt; t += 2) {
            const bool last = (t == nt - 2);
            const char* a1 = cA + (size_t)(t + 1) * kstep;
            const char* a2 = last ? nA : cA + (size_t)(t + 2) * kstep; const char* b2 = last ? nB : cB + (size_t)(t + 2) * kstep;
            const char* a3 = a2 + kstep; const char* b3 = b2 + kstep;
            if (last && has_next) S.a_ready(nxt);
            if constexpr (SP2) {
            PG8_LDB(B0, 0, 0); PG8_LDB(B1, 0, 1); PG8_SCHED; PG8_LDA(At, 0, 0); PG8_STAGE(PG8_SA(1, 1), a1 + hstep, voffA);
            PG8_WAIT_V(8); PG8_WAIT_L(0); PG8_BAR; PG8_MMA(0, 0, At, B0); PG8_MMA(0, 1, At, B1); PG8_BAR; PG8_SCHED;
            PG8_LDA(At, 0, 1); PG8_STAGE(PG8_SB(0, 0), b2, voffB); PG8_STAGE(PG8_SB(0, 1), b2 + hstep, voffB); PG8_STAGE(PG8_SA(0, 0), a2, voffA);
            PG8_WAIT_V(8); PG8_WAIT_L(0); PG8_BAR; PG8_MMA(1, 0, At, B0); PG8_MMA(1, 1, At, B1); PG8_BAR; PG8_SCHED;
            PG8_LDB(B0, 1, 0); PG8_LDB(B1, 1, 1); PG8_SCHED; PG8_LDA(At, 1, 0); PG8_STAGE(PG8_SA(0, 1), a2 + hstep, voffA);
            PG8_WAIT_V(8); PG8_WAIT_L(0); PG8_BAR; PG8_MMA(0, 0, At, B0); PG8_MMA(0, 1, At, B1); PG8_BAR; PG8_SCHED;
            PG8_LDA(At, 1, 1); PG8_STAGE(PG8_SB(1, 0), b3, voffB); PG8_STAGE(PG8_SB(1, 1), b3 + hstep, voffB); PG8_STAGE(PG8_SA(1, 0), a3, voffA);
            PG8_WAIT_V(8); PG8_WAIT_L(0); PG8_BAR; PG8_MMA(1, 0, At, B0); PG8_MMA(1, 1, At, B1); PG8_BAR; PG8_SCHED;
            } else {
            PG8_LDB(B0, 0, 0); PG8_SCHED; PG8_LDA(At, 0, 0); PG8_STAGE(PG8_SA(1, 1), a1 + hstep, voffA);
            PG8_WAIT_L(8); PG8_BAR; PG8_WAIT_L(0); PG8_MMA(0, 0, At, B0); PG8_BAR; PG8_SCHED;
            PG8_LDB(B1, 0, 1); PG8_STAGE(PG8_SB(0, 0), b2, voffB);
            PG8_BAR; PG8_WAIT_L(0); PG8_MMA(0, 1, At, B1); PG8_BAR;
            PG8_LDA(At, 0, 1); PG8_STAGE(PG8_SA(0, 0), a2, voffA);
            PG8_BAR; PG8_WAIT_L(0); PG8_MMA(1, 0, At, B0); PG8_BAR; PG8_SCHED;
            PG8_STAGE(PG8_SB(0, 1), b2 + hstep, voffB);
            PG8_WAIT_V(6); PG8_BAR; PG8_MMA(1, 1, At, B1); PG8_BAR;
            PG8_LDB(B0, 1, 0); PG8_SCHED; PG8_LDA(At, 1, 0); PG8_STAGE(PG8_SA(0, 1), a2 + hstep, voffA);
            PG8_WAIT_L(8); PG8_BAR; PG8_WAIT_L(0); PG8_MMA(0, 0, At, B0); PG8_BAR; PG8_SCHED;
            PG8_LDB(B1, 1, 1); PG8_STAGE(PG8_SB(1, 0), b3, voffB);
            PG8_BAR; PG8_WAIT_L(0); PG8_MMA(0, 1, At, B1); PG8_BAR;
            PG8_LDA(At, 1, 1); PG8_STAGE(PG8_SA(1, 0), a3, voffA);
            PG8_BAR; PG8_WAIT_L(0); PG8_MMA(1, 0, At, B0); PG8_BAR; PG8_SCHED;
            PG8_STAGE(PG8_SB(1, 1), b3 + hstep, voffB);
            PG8_WAIT_V(6); PG8_BAR; PG8_MMA(1, 1, At, B1); PG8_BAR;
            }
        }
        if constexpr (ALIGN_EPI) { if (wr == 0) PG8_BAR; }
        E(acc, cur, wr, wc, fr, fq); S.done(cur);
        if (!has_next) break;
        if (!(Epi::KSEG && nxt.g != 0))
#pragma unroll
        for (int a = 0; a < 2; ++a)
#pragma unroll
            for (int b = 0; b < 2; ++b)
#pragma unroll
                for (int m = 0; m < 4; ++m)
#pragma unroll
                    for (int n = 0; n < 2; ++n) acc[a][b][m][n] = (f32x4){0.f, 0.f, 0.f, 0.f};
        cur = nxt; cA = nA; cB = nB; ++ui;
        if constexpr (ALIGN_EPI) { if (wr == 1) PG8_BAR; }
    }
    PG8_WAIT_V(0);
    if constexpr (!ALIGN_EPI) { if (wr == 0) PG8_BAR; }
    PG8_BAR;
#undef PG8_SA
#undef PG8_SB
#undef PG8_STAGE
#undef PG8_LDA
#undef PG8_LDB
#undef PG8_MMA
#undef PG8_WAIT_V
#undef PG8_WAIT_L
#undef PG8_BAR
#undef PG8_SCHED
}
}

#define LAS __attribute__((address_space(3)))
typedef unsigned short bf16_t;
typedef _Float16 h16;
typedef _Float16 h16x4 __attribute__((ext_vector_type(4)));
typedef _Float16 h16x8 __attribute__((ext_vector_type(8)));
typedef float f32x4 __attribute__((ext_vector_type(4)));
typedef float f32x2 __attribute__((ext_vector_type(2)));
typedef unsigned u32x4 __attribute__((ext_vector_type(4)));
typedef unsigned u32x2 __attribute__((ext_vector_type(2)));

#ifndef ONE_LAUNCH
#define ONE_LAUNCH 1
#endif
constexpr int NWAVES = 8, NTHR = 512;
constexpr int TT = 16384, SEQ = 8192, DM = 1024, FF = 2816, MW = 256, INW = 6144;
constexpr int LDS_BYTES = 147456;
constexpr size_t MiB = 1u << 20;
constexpr size_t WS_CTL = 0, CTL_ZERO_BYTES = 16384, WS_SS = 1 * MiB, WS_E = 2 * MiB, WS_W = 4 * MiB, WS_B1 = 34 * MiB, WS_B2 = 66 * MiB, WS_Z = 98 * MiB, WS_END = 250 * MiB;
constexpr size_t W_GU1 = 0, W_D1 = W_GU1 + (size_t)2 * FF * DM * 2, W_INA = W_D1 + (size_t)DM * FF * 2;
constexpr size_t W_ING = 0, W_BR = W_ING + (size_t)4096 * DM * 2, W_O = W_BR + (size_t)DM * DM * 2, W_GU2 = W_O + (size_t)DM * DM * 2, W_D2 = W_GU2 + (size_t)2 * FF * DM * 2, W_GLU = W_D2 + (size_t)DM * FF * 2, W_END2 = W_GLU + 256 * 256 * 2;
static_assert(W_END2 <= 30 * MiB && W_INA + (size_t)2560 * DM * 2 <= 30 * MiB, "W region");
constexpr size_t Z_RW = 0, Z_G16 = 56 * MiB, Z_U5 = 64 * MiB, Z_L16 = 72 * MiB, Z_PP = 88 * MiB, Z_O = 72 * MiB, Z_GL = 144 * MiB;
constexpr size_t Z_HID = 0, Z_R = 0;
static_assert((size_t)TT * 4 * 896 <= 56 * MiB && (size_t)TT * 1792 * 2 <= 56 * MiB && (size_t)TT * FF * 2 <= 144 * MiB && (size_t)TT * 4096 * 2 <= 144 * MiB, "Z region");

typedef const float* cfp_t;
typedef const __attribute__((address_space(4))) cfp_t* in_t;
struct Args { const float* in[41]; float* out; unsigned char* ws; int ph_lo, ph_hi; };

struct Frame {
    LAS unsigned char* lds;
    int tid, lane, wave, G, bx;
    in_t in;
    float* X; unsigned char* ws;
    float* SS; float* E;
    bf16_t *B1, *B2, *HID, *GL;
    h16 *U5, *PP, *L16, *G16, *R;
    float* O; unsigned char* RW;
};

__device__ __forceinline__ unsigned f2bf(float f) { unsigned u = __builtin_bit_cast(unsigned, f); return (u + 0x7fffu + ((u >> 16) & 1u)) >> 16; }
__device__ __forceinline__ unsigned pk2(float lo, float hi) { return f2bf(lo) | (f2bf(hi) << 16); }
#define LDS_WAIT() asm volatile("s_waitcnt lgkmcnt(0)" ::: "memory")
template <int CTRL> __device__ __forceinline__ float dppx(float x) { return __builtin_bit_cast(float, __builtin_amdgcn_update_dpp(0, __builtin_bit_cast(int, x), CTRL, 0xf, 0xf, true)); }
__device__ __forceinline__ float allreduce16(float x) { x += dppx<0xB1>(x); x += dppx<0x4E>(x); x += dppx<0x141>(x); x += dppx<0x140>(x); return x; }
__device__ __forceinline__ float wave_sum(float x) { x = allreduce16(x); x += __shfl_xor(x, 16); x += __shfl_xor(x, 32); return x; }
__device__ __forceinline__ float sigmoidf_(float x) { return __builtin_amdgcn_rcpf(1.0f + __expf(-x)); }

__device__ __forceinline__ int tr_rowmap(int mode, int j, int row0) {
    if (mode == 0) return row0 + j;
    if (mode == 1) return 8 * (j >> 2) + (j & 3);
    if (mode == 2) return 8 * (j >> 2) + 4 + (j & 3);
    const int g = j >> 10, d = j & 1023;
    const int pn = 4 * (d >> 8) + 2 * ((d >> 7) & 1) + ((d >> 4) & 1);
    return 256 * pn + 128 * (g >> 1) + 32 * ((d >> 5) & 3) + 16 * (g & 1) + 4 * ((d >> 2) & 3) + (d & 3);
}
__device__ __forceinline__ void tr_item(const float* W, int ldw, int K, int N, bf16_t* WT, int mode, int row0, const float* s1, const float* s2, int smode, LAS float* scr, int item, int lane) {
    const int nblk = N / 32, kb = item / nblk, nb = item % nblk, k0 = 64 * kb, n0 = 32 * nb;
#pragma unroll 8
    for (int i = 0; i < 32; ++i) { const int kk = 2 * i + (lane >> 5); const int k = k0 + kk; float sc = 1.0f;
        if (s1) sc = s1[k];
        if (smode == 1) sc *= s2[k]; else if (smode == 2) sc *= (1.0f - s2[k]);
        scr[kk * 33 + (lane & 31)] = W[(size_t)k * ldw + n0 + (lane & 31)] * sc; }
    LDS_WAIT(); asm volatile("" ::: "memory");
    const int c = lane & 7;
#pragma unroll
    for (int j = 0; j < 4; ++j) { const int n = (lane >> 3) + 8 * j; const LAS float* s = scr + (8 * c) * 33 + n;
        u32x4 o; o.x = pk2(s[0 * 33], s[1 * 33]); o.y = pk2(s[2 * 33], s[3 * 33]); o.z = pk2(s[4 * 33], s[5 * 33]); o.w = pk2(s[6 * 33], s[7 * 33]);
        *(u32x4*)(WT + (size_t)tr_rowmap(mode, n0 + n, row0) * K + k0 + 8 * c) = o; }
    LDS_WAIT(); asm volatile("" ::: "memory");
}
#define TRJ(W_, ldw_, K_, N_, dst_, mode_, row0_, s1_, s2_, smode_) { const int ni_ = ((K_) / 64) * ((N_) / 32); if (r >= 0 && r < ni_) tr_item(W_, ldw_, K_, N_, dst_, mode_, row0_, s1_, s2_, smode_, scr, r, F.lane); r -= ni_; }
__device__ __forceinline__ void conv_first_half(Frame& F, int l) {
    LAS float* scr = (LAS float*)(F.lds + F.wave * 16384);
    const int gw = F.bx * NWAVES + F.wave, NGW = F.G * NWAVES;
    unsigned char* wb = F.ws + WS_W;
    const float* n1 = F.in[1] + (size_t)l * DM; const float* nm = F.in[5] + (size_t)l * DM; const float* mu = F.in[19] + (size_t)l * 3 * DM;
    const float* w1 = F.in[21] + (size_t)l * DM * 64; const float* a1 = F.in[24] + (size_t)l * DM * 64; const float* g1 = F.in[26] + (size_t)l * DM * 128;
    bf16_t* ina = (bf16_t*)(wb + W_INA);
    for (int it = gw;; it += NGW) { int r = it;
        TRJ(F.in[2] + (size_t)l * DM * FF, FF, DM, FF, (bf16_t*)(wb + W_GU1), 1, 0, n1, nullptr, 0)
        TRJ(F.in[3] + (size_t)l * DM * FF, FF, DM, FF, (bf16_t*)(wb + W_GU1), 2, 0, n1, nullptr, 0)
        TRJ(F.in[4] + (size_t)l * FF * DM, DM, FF, DM, (bf16_t*)(wb + W_D1), 0, 0, nullptr, nullptr, 0)
        TRJ(F.in[6] + (size_t)l * DM * INW, INW, DM, 2048, ina, 0, 0, nm, nullptr, 0)
        TRJ(w1, 64, DM, 64, ina, 0, 2048, nm, mu, 2)
        TRJ(a1, 64, DM, 64, ina, 0, 2112, nm, mu + DM, 2)
        TRJ(g1, 128, DM, 128, ina, 0, 2176, nm, mu + 2 * DM, 2)
        TRJ(w1, 64, DM, 64, ina, 0, 2304, nm, mu, 1)
        TRJ(a1, 64, DM, 64, ina, 0, 2368, nm, mu + DM, 1)
        TRJ(g1, 128, DM, 128, ina, 0, 2432, nm, mu + 2 * DM, 1)
        if (r >= 0) break; }
}
__device__ __forceinline__ void conv_second_half(Frame& F, int l, int b0) {
    LAS float* scr = (LAS float*)(F.lds + F.wave * 16384);
    const int gw = (F.bx - b0) * NWAVES + F.wave, NGW = (F.G - b0) * NWAVES;
    unsigned char* wb = F.ws + WS_W;
    const float* nm = F.in[5] + (size_t)l * DM; const float* n2 = F.in[36] + (size_t)l * DM;
    for (int it = gw;; it += NGW) { int r = it;
        TRJ(F.in[6] + (size_t)l * DM * INW + 2048, INW, DM, 4096, (bf16_t*)(wb + W_ING), 3, 0, nm, nullptr, 0)
        TRJ(F.in[34] + (size_t)l * DM * DM, DM, DM, DM, (bf16_t*)(wb + W_BR), 0, 0, nullptr, nullptr, 0)
        TRJ(F.in[35] + (size_t)l * DM * DM, DM, DM, DM, (bf16_t*)(wb + W_O), 0, 0, nullptr, nullptr, 0)
        TRJ(F.in[37] + (size_t)l * DM * FF, FF, DM, FF, (bf16_t*)(wb + W_GU2), 1, 0, n2, nullptr, 0)
        TRJ(F.in[38] + (size_t)l * DM * FF, FF, DM, FF, (bf16_t*)(wb + W_GU2), 2, 0, n2, nullptr, 0)
        TRJ(F.in[39] + (size_t)l * FF * DM, DM, FF, DM, (bf16_t*)(wb + W_D2), 0, 0, nullptr, nullptr, 0)
        TRJ(F.in[15] + (size_t)l * 256 * 256, 256, 256, 256, (bf16_t*)(wb + W_GLU), 0, 0, nullptr, nullptr, 0)
        if (r >= 0) break; }
}
__device__ __forceinline__ void prep_x(Frame& F) {
    const int gw = F.bx * NWAVES + F.wave, NGW = F.G * NWAVES;
    const float* x = F.in[0];
    for (int m = gw; m < TT; m += NGW) {
        const f32x4* xr = (const f32x4*)(x + (size_t)m * DM) + F.lane; float s = 0.f;
        unsigned long long* o8 = (unsigned long long*)(F.B1 + (size_t)m * DM) + F.lane;
#pragma unroll
        for (int j = 0; j < 4; ++j) { const f32x4 v = xr[64 * j]; s += (v[0] * v[0] + v[1] * v[1]) + (v[2] * v[2] + v[3] * v[3]);
            o8[64 * j] = (unsigned long long)pk2(v[0], v[1]) | ((unsigned long long)pk2(v[2], v[3]) << 32); }
        s += __shfl_xor(s, 1); s += __shfl_xor(s, 2);
        if ((F.lane & 3) == 0) F.SS[(size_t)m * 16 + (F.lane >> 2)] = s;
    }
}
__device__ __forceinline__ void final_norm(Frame& F) {
    const int gw = F.bx * NWAVES + F.wave, NGW = F.G * NWAVES;
    const f32x4* gn = (const f32x4*)F.in[40] + F.lane;
    for (int m = gw; m < TT; m += NGW) {
        const float rs = pg8::row_rstd(F.SS, m);
        f32x4* xr = (f32x4*)(F.X + (size_t)m * DM) + F.lane;
#pragma unroll
        for (int j = 0; j < 4; ++j) { const f32x4 v = xr[64 * j]; xr[64 * j] = v * rs * gn[64 * j]; }
    }
}

struct S5Par { float ar, ai; float bbr[16], bbi[16]; };
__device__ __forceinline__ void s5_params(Frame& F, int l, int g, int p, S5Par& P) {
    asm volatile("" : "+v"(p));
    const float lr = F.in[7][((size_t)l * 16 + g) * 64 + p], li = F.in[8][((size_t)l * 16 + g) * 64 + p], dt = expf(F.in[9][l * 16 + g]);
    const float mag = expf(lr * dt); P.ar = mag * cosf(li * dt); P.ai = mag * sinf(li * dt);
    const float inv = 1.0f / (lr * lr + li * li); const float qr = lr * inv, qi = -li * inv;
    const float cr = (P.ar - 1.0f) * qr - P.ai * qi, ci = (P.ar - 1.0f) * qi + P.ai * qr;
    const f32x4* br = (const f32x4*)(F.in[10] + (((size_t)l * 16 + g) * 64 + p) * 16); const f32x4* bi = (const f32x4*)(F.in[11] + (((size_t)l * 16 + g) * 64 + p) * 16);
#pragma unroll
    for (int q = 0; q < 4; ++q) { const f32x4 a = br[q], b = bi[q];
#pragma unroll
        for (int i = 0; i < 4; ++i) { P.bbr[4 * q + i] = cr * a[i] - ci * b[i]; P.bbi[4 * q + i] = cr * b[i] + ci * a[i]; } }
}
__device__ __forceinline__ void s5_step(const S5Par& P, const LAS float* urow, float& hr, float& hi) {
    const LAS f32x4* u4 = (const LAS f32x4*)urow; float bur = 0.f, bui = 0.f;
#pragma unroll
    for (int q = 0; q < 4; ++q) { const f32x4 u = u4[q];
#pragma unroll
        for (int i = 0; i < 4; ++i) { bur += P.bbr[4 * q + i] * u[i]; bui += P.bbi[4 * q + i] * u[i]; } }
    const float nr = P.ar * hr - P.ai * hi + bur, ni = P.ar * hi + P.ai * hr + bui; hr = nr; hi = ni;
}
__device__ __forceinline__ void load_u5_tile(Frame& F, int t0, LAS float* ubuf) {
    for (int i = F.tid; i < 64 * 64; i += NTHR) { const int t = i >> 6, q = i & 63; const h16x4 v = *(const h16x4*)(F.U5 + (size_t)(t0 + t) * 256 + 4 * q);
        f32x4 f; f[0] = (float)v[0]; f[1] = (float)v[1]; f[2] = (float)v[2]; f[3] = (float)v[3]; *(LAS f32x4*)(ubuf + t * 256 + 4 * q) = f; }
}


template <bool FIRST> __device__ __forceinline__ void mv32(LAS float* accp, float init, const LAS float* hb, const float* wsrc, int ldw) {
    float w[32];
    asm volatile("" : "+v"(wsrc));
#pragma unroll
    for (int j = 0; j < 32; ++j) w[j] = wsrc[(size_t)j * ldw];
#pragma unroll 2
    for (int tt = 0; tt < 32; ++tt) { const LAS f32x4* h4 = (const LAS f32x4*)(hb + tt * 256); float a = FIRST ? init : accp[tt * 256];
#pragma unroll
        for (int q = 0; q < 8; ++q) { const f32x4 v = h4[q]; a += v[0] * w[4 * q] + v[1] * w[4 * q + 1] + v[2] * w[4 * q + 2] + v[3] * w[4 * q + 3]; }
        accp[tt * 256] = a; }
}
__device__ __forceinline__ void m1_phase(Frame& F, int l) {
    LAS float* ubuf = (LAS float*)F.lds;
    LAS float* pl = (LAS float*)(F.lds + 65536);
    const int tid = F.tid, lane = F.lane, wave = F.wave;
    const int ch = tid & 255, half = tid >> 8;
    for (int c = F.bx; c < TT / 64; c += F.G) {
        const int t0 = c * 64, tb = t0 + half * 32, sb = tb & (SEQ - 1);
        load_u5_tile(F, t0, ubuf);
        __syncthreads();
#pragma unroll 1
        for (int gi = 0; gi < 2; ++gi) { const int g = wave + 8 * gi; S5Par P; s5_params(F, l, g, lane, P); float hr = 0.f, hi = 0.f;
#pragma unroll 2
            for (int j = 0; j < 64; ++j) s5_step(P, ubuf + j * 256 + g * 16, hr, hi);
            *(f32x2*)(F.E + (((size_t)c * 16 + g) * 64 + lane) * 2) = (f32x2){hr, hi}; }
        __syncthreads();
        LAS float* accp = pl + half * 32 * 256 + ch;
        h16 la[32], lb[32];
#pragma unroll
        for (int tt = 0; tt < 32; ++tt) { const int t = tb + tt; la[tt] = F.L16[(size_t)t * 512 + ch]; lb[tt] = (sb + tt > 0) ? F.L16[(size_t)(t - 1) * 512 + 256 + ch] : (h16)0.f; }
#pragma unroll
        for (int tt = 0; tt < 32; ++tt) { float pre = (float)la[tt] + (float)lb[tt];
            float a = pre; if (ch < 64) a = 1.0f - 2.0f * __builtin_amdgcn_rcpf(1.0f + __expf(2.0f * pre)); else if (ch >= 128) a = sigmoidf_(pre);
            ubuf[(half * 32 + tt) * 256 + ch] = a; }
        __syncthreads();
        const int hb = (t0 / SEQ) * 4 + (ch >> 6);
        unsigned char* rwb = F.RW + ((size_t)hb * SEQ + sb) * 896;
        const int cl = ch & 63;
        const LAS float* hrow = ubuf + half * 32 * 256;
        {
            const float* wp = F.in[22] + (size_t)l * 64 * 256 + ch;
            mv32<true>(accp, F.in[20][(size_t)l * 256 + ch], hrow, wp, 256);
            mv32<false>(accp, 0.f, hrow + 32, wp + 32 * 256, 256);
#pragma unroll 2
            for (int tt = 0; tt < 32; ++tt) { const float z = -accp[tt * 256]; const float sp = fmaxf(z, 0.f) + __logf(1.0f + __expf(-fabsf(z)));
                const float wlog = -sp - 0.5f; const float dec = __expf(-__expf(wlog));
                *(float*)(rwb + (size_t)tt * 896 + cl * 4) = dec; }
        }
        {
            const float* gp = F.in[27] + (size_t)l * 128 * 256 + ch;
            mv32<true>(accp, 0.f, hrow + 128, gp, 256);
#pragma unroll 1
            for (int kc = 1; kc < 4; ++kc) mv32<false>(accp, 0.f, hrow + 128 + kc * 32, gp + (size_t)kc * 32 * 256, 256);
#pragma unroll 4
            for (int tt = 0; tt < 32; ++tt) F.G16[(size_t)(tb + tt) * 256 + ch] = (h16)accp[tt * 256];
        }
        {
            const float* ap = F.in[25] + (size_t)l * 64 * 256 + ch;
            mv32<true>(accp, F.in[23][(size_t)l * 256 + ch], hrow + 64, ap, 256);
            mv32<false>(accp, 0.f, hrow + 96, ap + 32 * 256, 256);
            const float mur = F.in[18][((size_t)l * 3 + 0) * 256 + ch], muk = F.in[18][((size_t)l * 3 + 1) * 256 + ch], muv = F.in[18][((size_t)l * 3 + 2) * 256 + ch];
            const float kkw = F.in[28][(size_t)l * 256 + ch], kaw = F.in[29][(size_t)l * 256 + ch];
            const h16* pp = F.PP + (size_t)tb * 1792 + 256 + ch;
            float rprev = 0.f, kprev = 0.f, vprev = 0.f;
            if (sb > 0) { rprev = (float)pp[-(ptrdiff_t)1792]; kprev = (float)pp[-(ptrdiff_t)1792 + 256]; vprev = (float)pp[-(ptrdiff_t)1792 + 512]; }
#pragma unroll 1
            for (int t16 = 0; t16 < 32; t16 += 16) {
                h16 rq[16], kq[16], vq[16];
#pragma unroll
                for (int tt = 0; tt < 16; ++tt) { const h16* q = pp + (size_t)(t16 + tt) * 1792; rq[tt] = q[0]; kq[tt] = q[256]; vq[tt] = q[512]; }
#pragma unroll
                for (int tt = 0; tt < 16; ++tt) { const float a = sigmoidf_(accp[(t16 + tt) * 256]);
                    const float rp = (float)rq[tt], kp = (float)kq[tt], vp = (float)vq[tt];
                    const float r = rp + (rprev - rp) * mur, k = kp + (kprev - kp) * muk, v = vp + (vprev - vp) * muv;
                    rprev = rp; kprev = kp; vprev = vp;
                    const float kkv = k * kkw; const float kk = kkv * rsqrtf(fmaxf(wave_sum(kkv * kkv), 1e-24f));
                    const float kt = k * (1.0f + (a - 1.0f) * kaw); const float bb = kk * a;
                    h16* o = (h16*)(rwb + (size_t)(t16 + tt) * 896 + 256) + cl;
                    o[0] = (h16)r; o[64] = (h16)kt; o[128] = (h16)v; o[192] = (h16)kk; o[256] = (h16)bb; } }
        }
        __syncthreads();
    }
}

__device__ __forceinline__ void pool_conv_chunk(Frame& F, int l, int c) {
    LAS float* ubuf = (LAS float*)F.lds;
    LAS float* pl = (LAS float*)(F.lds + 65536);
    const int tid = F.tid; const int ch = tid & 255, half = tid >> 8;
    const int t0 = c * 64, tb = t0 + half * 32, sb = tb & (SEQ - 1);
    {
    {
        const int grp = ch >> 6, win = 2 << grp;
        const h16* up = F.PP + (size_t)tb * 1792 + ch;
        float s = 0.f;
        for (int j = 1; j <= win; ++j) if (sb - j >= 0) s += (float)up[-(ptrdiff_t)j * 1792];
#pragma unroll 1
        for (int t16 = 0; t16 < 32; t16 += 16) {
            h16 uq[16], ul[16];
#pragma unroll
            for (int tt = 0; tt < 16; ++tt) { uq[tt] = up[(size_t)(t16 + tt) * 1792]; ul[tt] = (sb + t16 + tt - win >= 0) ? up[(ptrdiff_t)(t16 + tt - win) * 1792] : (h16)0.f; }
#pragma unroll
            for (int tt = 0; tt < 16; ++tt) { const float u = (float)uq[tt]; s += u; const int pos = sb + t16 + tt;
                s -= (float)ul[tt];
                const float cnt = (float)((pos + 1 < win) ? (pos + 1) : win);
                pl[(half * 32 + t16 + tt) * 256 + ch] = s / cnt - u; } }
    }
    {
        const h16* zp = F.PP + (size_t)tb * 1792 + 1024 + ch;
        const float cw0 = F.in[33][((size_t)l * 3 + 0) * 256 + ch], cw1 = F.in[33][((size_t)l * 3 + 1) * 256 + ch], cw2 = F.in[33][((size_t)l * 3 + 2) * 256 + ch];
        float z2 = 0.f, z1 = 0.f;
        if (sb >= 1) z1 = (float)zp[-(ptrdiff_t)1792 + 512] * (float)zp[-(ptrdiff_t)1792];
        if (sb >= 2) z2 = (float)zp[-(ptrdiff_t)2 * 1792 + 512] * (float)zp[-(ptrdiff_t)2 * 1792];
#pragma unroll 1
        for (int t16 = 0; t16 < 32; t16 += 16) {
            h16 zx[16], zb[16], zc[16];
#pragma unroll
            for (int tt = 0; tt < 16; ++tt) { const h16* q = zp + (size_t)(t16 + tt) * 1792; zx[tt] = q[0]; zb[tt] = q[256]; zc[tt] = q[512]; }
#pragma unroll
            for (int tt = 0; tt < 16; ++tt) { const float z0 = (float)zc[tt] * (float)zx[tt];
                const float y = (float)zb[tt] * (cw0 * z2 + cw1 * z1 + cw2 * z0);
                F.B2[(size_t)(tb + t16 + tt) * 1024 + 768 + ch] = (bf16_t)f2bf(y); z2 = z1; z1 = z0; } }
    }
    __syncthreads();
    LAS float* accu = ubuf + half * 32 * 256 + ch;
    {
        const int grp = ch >> 6, d = ch & 63;
        const float* pw = F.in[16] + (((size_t)l * 4 + grp) * 64) * 64 + d;
        mv32<true>(accu, 0.f, pl + half * 32 * 256 + grp * 64, pw, 64);
        mv32<false>(accu, 0.f, pl + half * 32 * 256 + grp * 64 + 32, pw + 32 * 64, 64);
        const float sc = F.in[17][(size_t)l * 256 + ch];
#pragma unroll 4
        for (int tt = 0; tt < 32; ++tt) F.B2[(size_t)(tb + tt) * 1024 + 256 + ch] = (bf16_t)f2bf(accu[tt * 256] * sc);
    }
    __syncthreads();
    }
}

__device__ __forceinline__ float a_fma(float a, float b, float c) { float d; asm("v_fma_f32 %0, %1, %2, %3" : "=v"(d) : "v"(a), "v"(b), "v"(c)); return d; }
__device__ __forceinline__ float a_fnma(float a, float b, float c) { float d; asm("v_fma_f32 %0, -%1, %2, %3" : "=v"(d) : "v"(a), "v"(b), "v"(c)); return d; }
__device__ __forceinline__ float a_mul(float a, float b) { float d; asm("v_mul_f32 %0, %1, %2" : "=v"(d) : "v"(a), "v"(b)); return d; }
__device__ __forceinline__ float a_add(float a, float b) { float d; asm("v_add_f32 %0, %1, %2" : "=v"(d) : "v"(a), "v"(b)); return d; }
constexpr int SC_NB = 128;
constexpr int SC_STEPS = 32, SC_FL = SC_STEPS * 384;
constexpr int SC_OB = SC_STEPS * 64;
constexpr int SC_NLD = 384, SC_NPC = SC_STEPS * 56, SC_PT = (SC_NPC + SC_NLD - 1) / SC_NLD;
__device__ __forceinline__ void scan_load(const unsigned char* src, int cc, int lt, u32x4 (&rg)[SC_PT]) {
#pragma unroll
    for (int n = 0; n < SC_PT; ++n) { const int i = lt + SC_NLD * n; if (i < SC_NPC) { const int step = i / 56, j = i % 56;
        rg[n] = *(const u32x4*)(src + ((size_t)cc * SC_STEPS + step) * 896 + (j < 16 ? j * 16 : 256 + (j - 16) * 16)); } }
}
__device__ __forceinline__ void scan_store(LAS float* buf, int lt, const u32x4 (&rg)[SC_PT]) {
#pragma unroll
    for (int n = 0; n < SC_PT; ++n) { const int i = lt + SC_NLD * n; if (i < SC_NPC) { const int step = i / 56, j = i % 56;
        if (j < 16) { *(LAS u32x4*)(buf + step * 384 + j * 4) = rg[n]; }
        else { const int a = (j - 16) >> 3, e = (j - 16) & 7; const h16x8 h = __builtin_bit_cast(h16x8, rg[n]); f32x4 lo, hi;
            lo[0] = (float)h[0]; lo[1] = (float)h[1]; lo[2] = (float)h[2]; lo[3] = (float)h[3]; hi[0] = (float)h[4]; hi[1] = (float)h[5]; hi[2] = (float)h[6]; hi[3] = (float)h[7];
            LAS f32x4* d = (LAS f32x4*)(buf + step * 384 + 64 + a * 64 + e * 8); d[0] = lo; d[1] = hi; } } }
}
#define RAW_BAR() do { asm volatile("s_waitcnt lgkmcnt(0)" ::: "memory"); __builtin_amdgcn_s_barrier(); asm volatile("" ::: "memory"); } while (0)
__device__ __forceinline__ void scan_flush(const LAS float* ob, float* Og, int cc, int lt) {
    if (lt < SC_STEPS * 4) { const LAS f32x4* p = (const LAS f32x4*)(ob + lt * 16); const f32x4 a = p[0], b = p[1], c = p[2], d = p[3];
        const float o = (((a[0] + a[1]) + (a[2] + a[3])) + ((b[0] + b[1]) + (b[2] + b[3]))) + (((c[0] + c[1]) + (c[2] + c[3])) + ((d[0] + d[1]) + (d[2] + d[3])));
        Og[((size_t)cc * SC_STEPS + (lt >> 2)) * 256 + (lt & 3)] = o; }
}
__device__ __forceinline__ void rwkv_scan(Frame& F) {
    const int blk = F.bx, hb = blk >> 4, q = blk & 15, b = hb >> 2, h = hb & 3;
    const unsigned char* src = F.RW + (size_t)hb * SEQ * 896;
    LAS float* buf = (LAS float*)F.lds;
    LAS float* obuf = (LAS float*)(F.lds + 2 * SC_FL * 4);
    const int wave = F.wave, lane = F.lane; const bool loader = wave >= 1 && wave != 4; const int lt = wave < 4 ? F.tid - 64 : F.tid - 128;
    constexpr int NCH = SEQ / SC_STEPS;
    u32x4 rg[4][SC_PT];
    if (loader) { scan_load(src, 0, lt, rg[0]); scan_store(buf, lt, rg[0]); scan_load(src, 1, lt, rg[1]); scan_load(src, 2, lt, rg[2]); scan_load(src, 3, lt, rg[3]); scan_load(src, 4, lt, rg[0]); }
    RAW_BAR();
    float Sa = 0.f, Sb = 0.f, Sc = 0.f, Sd = 0.f;
    const int rl = lane >> 4, row = q * 4 + rl, ks = lane & 15;
    float* Og = F.O + ((size_t)b * SEQ) * 256 + h * 64 + q * 4;
#pragma unroll 1
    for (int cc4 = 0; cc4 < NCH; cc4 += 4) {
#pragma unroll
      for (int u = 0; u < 4; ++u) { const int cc = cc4 + u;
        if (loader) {
            if (cc > 0) scan_flush(obuf + ((cc - 1) & 1) * SC_OB, Og, cc - 1, lt);
            if (cc + 1 < NCH) { scan_store(buf + ((cc + 1) & 1) * SC_FL, lt, rg[(u + 1) & 3]); if (cc + 5 < NCH) scan_load(src, cc + 5, lt, rg[(u + 1) & 3]); }
        } else if (wave == 0) {
            const LAS float* bb = buf + (cc & 1) * SC_FL + 4 * ks; const LAS float* vb = buf + (cc & 1) * SC_FL + 192 + row;
            LAS float* ob = obuf + (cc & 1) * SC_OB + rl * 16 + ks;
            f32x4 w_[2], r_[2], k_[2], kk_[2], b_[2]; float v_[2];
#define SC_LD(s_, j_) do { const LAS float* p_ = bb + (s_) * 384; w_[j_] = *(const LAS f32x4*)(p_); r_[j_] = *(const LAS f32x4*)(p_ + 64); k_[j_] = *(const LAS f32x4*)(p_ + 128); \
                kk_[j_] = *(const LAS f32x4*)(p_ + 256); b_[j_] = *(const LAS f32x4*)(p_ + 320); v_[j_] = vb[(s_) * 384]; } while (0)
#define DPP_ADD(x_, ctl_) "v_add_f32_dpp %[" x_ "], %[" x_ "], %[" x_ "] " ctl_ " row_mask:0xf bank_mask:0xf bound_ctrl:1\n\t"
            SC_LD(0, 0);
#pragma unroll
            for (int s = 0; s < SC_STEPS; ++s) { const int j = s & 1;
                const f32x4 rp = r_[j ^ 1];
                if (s + 1 < SC_STEPS) SC_LD(s + 1, j ^ 1);
                const f32x4 w = w_[j], k = k_[j], kk = kk_[j], bv = b_[j]; const float v = v_[j];
                float sa, t1, q0, q1, op, u0, u1, u2, u3;
                if (s > 0) {
                    asm volatile(
                        "v_mul_f32 %[sa], %[Sa], %[kk0]\n\t" "v_fma_f32 %[sa], %[Sb], %[kk1], %[sa]\n\t" "v_fma_f32 %[sa], %[Sc], %[kk2], %[sa]\n\t" "v_fma_f32 %[sa], %[Sd], %[kk3], %[sa]\n\t"
                        "v_mul_f32 %[op], %[Sa], %[r0]\n\t" "v_fma_f32 %[op], %[Sb], %[r1], %[op]\n\t"
                        DPP_ADD("sa", "quad_perm:[1,0,3,2]") "v_fma_f32 %[op], %[Sc], %[r2], %[op]\n\t" "v_fma_f32 %[op], %[Sd], %[r3], %[op]\n\t"
                        DPP_ADD("sa", "quad_perm:[2,3,0,1]") "v_mul_f32 %[u0], %[v], %[k0]\n\t" "v_mul_f32 %[u1], %[v], %[k1]\n\t"
                        DPP_ADD("sa", "row_half_mirror") "v_mul_f32 %[u2], %[v], %[k2]\n\t" "v_mul_f32 %[u3], %[v], %[k3]\n\t"
                        DPP_ADD("sa", "row_mirror")
                        : [sa] "=&v"(sa), [t1] "=&v"(t1), [q0] "=&v"(q0), [q1] "=&v"(q1), [op] "=&v"(op), [u0] "=&v"(u0), [u1] "=&v"(u1), [u2] "=&v"(u2), [u3] "=&v"(u3)
                        : [Sa] "v"(Sa), [Sb] "v"(Sb), [Sc] "v"(Sc), [Sd] "v"(Sd), [kk0] "v"(kk[0]), [kk1] "v"(kk[1]), [kk2] "v"(kk[2]), [kk3] "v"(kk[3]),
                          [r0] "v"(rp[0]), [r1] "v"(rp[1]), [r2] "v"(rp[2]), [r3] "v"(rp[3]), [v] "v"(v), [k0] "v"(k[0]), [k1] "v"(k[1]), [k2] "v"(k[2]), [k3] "v"(k[3]));
                    ob[(s - 1) * 64] = op;
                } else {
                    asm volatile(
                        "v_mul_f32 %[sa], %[Sa], %[kk0]\n\t" "v_mul_f32 %[t1], %[Sc], %[kk2]\n\t" "v_fma_f32 %[sa], %[Sb], %[kk1], %[sa]\n\t" "v_fma_f32 %[t1], %[Sd], %[kk3], %[t1]\n\t"
                        "v_mul_f32 %[u0], %[v], %[k0]\n\t" "v_add_f32 %[sa], %[sa], %[t1]\n\t" "v_mul_f32 %[u1], %[v], %[k1]\n\t" "v_mul_f32 %[u2], %[v], %[k2]\n\t"
                        DPP_ADD("sa", "quad_perm:[1,0,3,2]") "v_mul_f32 %[u3], %[v], %[k3]\n\t" "s_nop 0\n\t"
                        DPP_ADD("sa", "quad_perm:[2,3,0,1]") "s_nop 1\n\t"
                        DPP_ADD("sa", "row_half_mirror") "s_nop 1\n\t"
                        DPP_ADD("sa", "row_mirror")
                        : [sa] "=&v"(sa), [t1] "=&v"(t1), [u0] "=&v"(u0), [u1] "=&v"(u1), [u2] "=&v"(u2), [u3] "=&v"(u3)
                        : [Sa] "v"(Sa), [Sb] "v"(Sb), [Sc] "v"(Sc), [Sd] "v"(Sd), [kk0] "v"(kk[0]), [kk1] "v"(kk[1]), [kk2] "v"(kk[2]), [kk3] "v"(kk[3]),
                          [v] "v"(v), [k0] "v"(k[0]), [k1] "v"(k[1]), [k2] "v"(k[2]), [k3] "v"(k[3]));
                }
                asm volatile(
                    "v_fma_f32 %[u0], -%[sa], %[b0], %[u0]\n\t" "v_fma_f32 %[u1], -%[sa], %[b1], %[u1]\n\t" "v_fma_f32 %[u2], -%[sa], %[b2], %[u2]\n\t" "v_fma_f32 %[u3], -%[sa], %[b3], %[u3]\n\t"
                    "v_fma_f32 %[Sa], %[Sa], %[w0], %[u0]\n\t" "v_fma_f32 %[Sb], %[Sb], %[w1], %[u1]\n\t" "v_fma_f32 %[Sc], %[Sc], %[w2], %[u2]\n\t" "v_fma_f32 %[Sd], %[Sd], %[w3], %[u3]\n\t"
                    : [Sa] "+v"(Sa), [Sb] "+v"(Sb), [Sc] "+v"(Sc), [Sd] "+v"(Sd), [u0] "+v"(u0), [u1] "+v"(u1), [u2] "+v"(u2), [u3] "+v"(u3)
                    : [sa] "v"(sa), [b0] "v"(bv[0]), [b1] "v"(bv[1]), [b2] "v"(bv[2]), [b3] "v"(bv[3]), [w0] "v"(w[0]), [w1] "v"(w[1]), [w2] "v"(w[2]), [w3] "v"(w[3]));
                __builtin_amdgcn_sched_barrier(0); }
            { const f32x4 r = r_[(SC_STEPS - 1) & 1];
              ob[(SC_STEPS - 1) * 64] = a_add(a_fma(Sb, r[1], a_mul(Sa, r[0])), a_fma(Sd, r[3], a_mul(Sc, r[2]))); }
#undef SC_LD
#undef DPP_ADD
        }
        RAW_BAR();
      }
    }
    if (loader) scan_flush(obuf + ((NCH - 1) & 1) * SC_OB, Og, NCH - 1, lt);
    RAW_BAR();
}
__device__ __forceinline__ float gelu_tanh(float x) { const float u = 0.7978845608028654f * (x + 0.044715f * x * x * x); return 0.5f * x * (1.0f + tanhf(u)); }
__device__ __forceinline__ void s5_pass2(Frame& F, int l, int c) {
    LAS float* ubuf = (LAS float*)F.lds;
    LAS float* ybuf = (LAS float*)(F.lds + 65536);
    const int t0 = c * 64, lane = F.lane, wave = F.wave, cb0 = c & ~127;
    load_u5_tile(F, t0, ubuf);
    __syncthreads();
#pragma unroll 1
    for (int gi = 0; gi < 2; ++gi) { const int g = wave + 8 * gi; S5Par P; s5_params(F, l, g, lane, P);
        float cr[16], ci[16]; int lane_l = lane; asm volatile("" : "+v"(lane_l));
#pragma unroll
        for (int hh = 0; hh < 16; ++hh) { cr[hh] = F.in[12][(((size_t)l * 16 + g) * 16 + hh) * 64 + lane_l]; ci[hh] = F.in[13][(((size_t)l * 16 + g) * 16 + hh) * 64 + lane_l]; }
        float pr = P.ar, pi = P.ai;
#pragma unroll
        for (int s = 0; s < 6; ++s) { const float nr = pr * pr - pi * pi, ni = 2.0f * pr * pi; pr = nr; pi = ni; }
        float hr = 0.f, hi = 0.f;
#pragma unroll 2
        for (int c2 = cb0; c2 < c; ++c2) { const f32x2 e = *(const f32x2*)(F.E + (((size_t)c2 * 16 + g) * 64 + lane) * 2);
            const float nr = pr * hr - pi * hi + e[0], ni = pr * hi + pi * hr + e[1]; hr = nr; hi = ni; }
        const bool b3 = (lane & 8) != 0, b2 = (lane & 4) != 0, b1 = (lane & 2) != 0, b0 = (lane & 1) != 0;
#pragma unroll 1
        for (int j = 0; j < 64; ++j) { s5_step(P, ubuf + j * 256 + g * 16, hr, hi);
            float v8[8], v4[4], v2[2];
#pragma unroll
            for (int i = 0; i < 8; ++i) { const float lo = hr * cr[i] - hi * ci[i], hv = hr * cr[i + 8] - hi * ci[i + 8];
                const float keep = b3 ? hv : lo, send = b3 ? lo : hv; v8[i] = keep + dppx<0x140>(send); }
#pragma unroll
            for (int i = 0; i < 4; ++i) { const float keep = b2 ? v8[i + 4] : v8[i], send = b2 ? v8[i] : v8[i + 4]; v4[i] = keep + dppx<0x141>(send); }
#pragma unroll
            for (int i = 0; i < 2; ++i) { const float keep = b1 ? v4[i + 2] : v4[i], send = b1 ? v4[i] : v4[i + 2]; v2[i] = keep + dppx<0x4E>(send); }
            float y = (b0 ? v2[1] : v2[0]) + dppx<0xB1>(b0 ? v2[0] : v2[1]);
            y += __shfl_xor(y, 16); y += __shfl_xor(y, 32);
            if (lane < 16) ybuf[j * 256 + g * 16 + lane] = y; }
    }
    __syncthreads();
    { const int ch = F.tid & 255, half = F.tid >> 8; const float dd = F.in[14][(size_t)l * 256 + ch];
        for (int tt = 0; tt < 32; ++tt) { const int tl = half * 32 + tt; const float y = ybuf[tl * 256 + ch] + dd * ubuf[tl * 256 + ch];
            F.GL[(size_t)(t0 + tl) * 256 + ch] = (bf16_t)f2bf(gelu_tanh(y)); } }
    __syncthreads();
}
template <int PART> __device__ __forceinline__ void m2_phase(Frame& F, int l) {
#ifndef NO_SCAN
    int bxs = F.bx; asm volatile("" : "+s"(bxs));
    if (bxs < SC_NB) { if (PART != 2) rwkv_scan(F); return; }
    if (PART == 1) return;
#endif
#ifndef NO_P2
    for (int c = F.bx - SC_NB; c < TT / 64; c += F.G - SC_NB) s5_pass2(F, l, c);
#pragma unroll 1
    for (int c = F.bx - SC_NB; c < TT / 64; c += F.G - SC_NB) pool_conv_chunk(F, l, c);
    conv_second_half(F, l, SC_NB);
#endif
}
__device__ __forceinline__ void rwkv_post(Frame& F, int l) {
    const int gw = F.bx * NWAVES + F.wave, NGW = F.G * NWAVES, lane = F.lane;
    for (int it0 = gw * 4; it0 < TT * 4; it0 += NGW * 4) {
        const int t = it0 >> 2, b = t / SEQ, pos = t & (SEQ - 1);
        float o[4], r[4], k[4], v[4], g[4];
#pragma unroll
        for (int hh = 0; hh < 4; ++hh) { const int c = hh * 64 + lane; o[hh] = F.O[(size_t)t * 256 + c]; g[hh] = (float)F.G16[(size_t)t * 256 + c];
            const h16* rw = (const h16*)(F.RW + ((size_t)(b * 4 + hh) * SEQ + pos) * 896 + 256) + lane; r[hh] = (float)rw[0]; k[hh] = (float)rw[64]; v[hh] = (float)rw[128]; }
#pragma unroll
        for (int hh = 0; hh < 4; ++hh) { const int c = hh * 64 + lane;
            const float mu = wave_sum(o[hh]) * (1.0f / 64.0f); const float d = o[hh] - mu; const float var = wave_sum(d * d) * (1.0f / 64.0f);
            const float on = d * rsqrtf(var + 64e-5f) * F.in[31][(size_t)l * 256 + c] + F.in[32][(size_t)l * 256 + c];
            const float bs = wave_sum(r[hh] * k[hh] * F.in[30][(size_t)l * 256 + c]);
            F.B2[(size_t)t * 1024 + 512 + c] = (bf16_t)f2bf((on + bs * v[hh]) * g[hh]); }
    }
}

constexpr int NPH = 25;
#ifndef PHMASK
#define PHMASK 0xFFFF
#endif
#define PHON(k) (((PHMASK) >> (k)) & 1)
#define XB_TMO      128
#define XB_XCNT(j)  (256  + 64 * (j))
#define XB_XSUB(j)  (1280 + 64 * (j))
#define XB_XGEN(j)  (2304 + 64 * (j))
#define XB_TOP      3328
#define XB_TOPGEN   3392
#define XCD_BAR_WORDS 3456
#define XB_SPIN_CAP (1u << 18)

__device__ __forceinline__ unsigned xb_ld(unsigned* p)              { return __hip_atomic_load(p, __ATOMIC_RELAXED, __HIP_MEMORY_SCOPE_AGENT); }
__device__ __forceinline__ unsigned xb_add(unsigned* p, unsigned v) { return __hip_atomic_fetch_add(p, v, __ATOMIC_RELAXED, __HIP_MEMORY_SCOPE_AGENT); }
__device__ __forceinline__ unsigned xb_xcc_id() { return (unsigned)__builtin_amdgcn_s_getreg((3 << 11) | 20) & 0xFu; }
#define XB_SPIN(cond, bar) do { unsigned _sp = 0; while (cond) { __builtin_amdgcn_s_sleep(1); \
    if ((++_sp & 255u) == 0u) { if (xb_ld(&(bar)[XB_TMO])) break; if (_sp > XB_SPIN_CAP) { atomicAdd(&(bar)[XB_TMO], 1u); break; } } } } while (0)

struct XcdBarrier {
    unsigned* bar; unsigned x;
    volatile LAS unsigned* st;
};

__device__ __forceinline__ XcdBarrier xcd_barrier_post(unsigned* bar, volatile LAS unsigned* st) {
    XcdBarrier b; b.bar = bar; b.x = xb_xcc_id(); b.st = st;
    if (threadIdx.x == 0) (void)xb_add(&bar[XB_XCNT(b.x)], 1u);
    return b;
}
__device__ __forceinline__ void xcd_barrier_complete(unsigned* bar, unsigned x, unsigned& nloc, unsigned& nx) {
    const unsigned G = gridDim.x * gridDim.y * gridDim.z;
    unsigned sum, cnt, mine, sp = 0u;
    for (;;) {
        sum = 0u; cnt = 0u; mine = 0u;
#pragma unroll
        for (unsigned j = 0; j < 16; ++j) { const unsigned c = xb_ld(&bar[XB_XCNT(j)]); sum += c; cnt += (c > 0u) ? 1u : 0u; mine = (j == x) ? c : mine; }
        if (sum == G) break;
        __builtin_amdgcn_s_sleep(1);
        if ((++sp & 255u) == 0u) { if (xb_ld(&bar[XB_TMO])) break; if (sp > XB_SPIN_CAP) { atomicAdd(&bar[XB_TMO], 1u); break; } }
    }
    nloc = mine > 0u ? mine : 1u; nx = cnt > 0u ? cnt : 1u;
}

__device__ __forceinline__ void xcd_barrier(const XcdBarrier& b) {
    asm volatile("s_waitcnt vmcnt(0)" ::: "memory");
    __syncthreads();
    if (threadIdx.x == 0) {
        unsigned* bar = b.bar;
        __builtin_amdgcn_s_waitcnt(0);
        unsigned nloc = b.st[0], nx = b.st[1];
        if (nloc == 0u) { xcd_barrier_complete(bar, b.x, nloc, nx); b.st[0] = nloc; b.st[1] = nx; }
        const unsigned old = xb_add(&bar[XB_XSUB(b.x)], 1u);
        const unsigned gen = old / nloc;
        if (old + 1u == (gen + 1u) * nloc) {
            __builtin_amdgcn_fence(__ATOMIC_RELEASE, "agent");
            asm volatile("s_waitcnt vmcnt(0)" ::: "memory");
            const unsigned og = xb_add(&bar[XB_TOP], 1u);
            const unsigned tg = og / nx;
            if (og + 1u == (tg + 1u) * nx) xb_add(&bar[XB_TOPGEN], 1u);
            else XB_SPIN(xb_ld(&bar[XB_TOPGEN]) == tg, bar);
            __builtin_amdgcn_fence(__ATOMIC_ACQUIRE, "agent");
            xb_add(&bar[XB_XGEN(b.x)], 1u);
            asm volatile("s_waitcnt vmcnt(0)" ::: "memory");
        } else {
            XB_SPIN(xb_ld(&bar[XB_XGEN(b.x)]) == gen, bar);
            __builtin_amdgcn_fence(__ATOMIC_ACQUIRE, "agent");
            asm volatile("s_waitcnt vmcnt(0)" ::: "memory");
        }
    }
    __syncthreads();
}

#ifndef REP_PART
#define REP_PART 0
#endif
template <int PH, int PART = 0> __device__ __forceinline__ void run_phase(const int wave_s, unsigned char* lds_raw) {
    typedef pg8::StaticOrder SO;
    int tid = wave_s * 64 + (int)__builtin_amdgcn_mbcnt_hi(~0u, __builtin_amdgcn_mbcnt_lo(~0u, 0u)); asm volatile("" : "+v"(tid));
    int G = gridDim.x, bx = blockIdx.x; asm volatile("" : "+s"(G), "+s"(bx));
    const __attribute__((address_space(4))) unsigned char* ka = (const __attribute__((address_space(4))) unsigned char*)__builtin_amdgcn_kernarg_segment_ptr();
    asm volatile("" : "+s"(ka));
    const __attribute__((address_space(4))) Args* ap = (const __attribute__((address_space(4))) Args*)ka;
    Frame F;
    F.lds = (LAS unsigned char*)lds_raw;
    F.tid = tid; F.lane = tid & 63; F.wave = __builtin_amdgcn_readfirstlane(tid >> 6); F.G = G; F.bx = bx;
    F.in = (in_t)ka; F.X = ap->out; F.ws = ap->ws;
    unsigned char* ws = F.ws;
    F.SS = (float*)(ws + WS_SS); F.E = (float*)(ws + WS_E); F.B1 = (bf16_t*)(ws + WS_B1); F.B2 = (bf16_t*)(ws + WS_B2);
    unsigned char* z = ws + WS_Z;
    F.HID = (bf16_t*)(z + Z_HID); F.GL = (bf16_t*)(z + Z_GL); F.U5 = (h16*)(z + Z_U5); F.PP = (h16*)(z + Z_PP); F.L16 = (h16*)(z + Z_L16); F.G16 = (h16*)(z + Z_G16); F.R = (h16*)(z + Z_R);
    F.O = (float*)(z + Z_O); F.RW = z + Z_RW;
    if constexpr (PH == 0) { conv_first_half(F, 0); prep_x(F); }
    else { constexpr int l = (PH - 1) / 12, k = (PH - 1) % 12;
        if constexpr (k == 0) { pg8::Gemm g{F.B1, (const bf16_t*)(ws + WS_W + W_GU1), TT, 2 * FF, DM, 1}; SO S; S.init(TT, 2 * FF, G, bx); pg8::EpiGU E{F.HID, F.SS}; pg8::gemm_phase<pg8::EpiGU, SO, true, true>(F.lds, g, S, E, tid); }
        else if constexpr (k == 1) { pg8::Gemm g{F.HID, (const bf16_t*)(ws + WS_W + W_D1), TT, DM, FF, 1}; SO S; S.init(TT, DM, G, bx); pg8::EpiDown E{l == 0 ? F.in[0] : F.X, F.X, F.B1, F.SS, 0.5f}; pg8::gemm_phase<pg8::EpiDown, SO, true, true>(F.lds, g, S, E, tid); }
        else if constexpr (k == 2) { pg8::Gemm g{F.B1, (const bf16_t*)(ws + WS_W + W_INA), TT, 2560, DM, 1}; SO S; S.init(TT, 2560, G, bx); pg8::EpiInA E{F.U5, F.PP, F.L16, F.SS}; pg8::gemm_phase<pg8::EpiInA, SO, true, true>(F.lds, g, S, E, tid); }
        else if constexpr (k == 3) { m1_phase(F, l); }
        else if constexpr (k == 4) { m2_phase<PART>(F, l); }
        else if constexpr (k == 5) { { pg8::Gemm g{F.GL, (const bf16_t*)(ws + WS_W + W_GLU), TT, 256, 256, 1}; SO S; S.init(TT, 256, G, bx); pg8::EpiGlu E{F.GL, F.B2}; pg8::gemm_phase<pg8::EpiGlu, SO, true, true>(F.lds, g, S, E, tid); } rwkv_post(F, l); }
        else if constexpr (k == 6) { pg8::Gemm g{F.B1, (const bf16_t*)(ws + WS_W + W_ING), TT, 4096, DM, 1}; SO S; S.init(TT, 4096, G, bx); pg8::EpiGate E{F.R, F.SS}; pg8::gemm_phase<pg8::EpiGate, SO, true, true>(F.lds, g, S, E, tid); }
        else if constexpr (k == 7) { pg8::Gemm g{F.B2, (const bf16_t*)(ws + WS_W + W_BR), TT, DM, DM, 4}; pg8::SegOrder4 S; S.so.init(TT, DM, G, bx); pg8::EpiBranch E{F.R, F.B1}; pg8::gemm_phase<pg8::EpiBranch, pg8::SegOrder4, true, true>(F.lds, g, S, E, tid); }
        else if constexpr (k == 8) { pg8::Gemm g{F.B1, (const bf16_t*)(ws + WS_W + W_O), TT, DM, DM, 1}; SO S; S.init(TT, DM, G, bx); pg8::EpiDown E{F.X, F.X, F.B2, F.SS, 1.0f}; pg8::gemm_phase<pg8::EpiDown, SO, true, true>(F.lds, g, S, E, tid); }
        else if constexpr (k == 9) { pg8::Gemm g{F.B2, (const bf16_t*)(ws + WS_W + W_GU2), TT, 2 * FF, DM, 1}; SO S; S.init(TT, 2 * FF, G, bx); pg8::EpiGU E{F.HID, F.SS}; pg8::gemm_phase<pg8::EpiGU, SO, true, true>(F.lds, g, S, E, tid); }
        else if constexpr (k == 10) { pg8::Gemm g{F.HID, (const bf16_t*)(ws + WS_W + W_D2), TT, DM, FF, 1}; SO S; S.init(TT, DM, G, bx); pg8::EpiDown E{F.X, F.X, F.B1, F.SS, 0.5f}; pg8::gemm_phase<pg8::EpiDown, SO, true, true>(F.lds, g, S, E, tid); }
        else { if constexpr (l == 0) conv_first_half(F, 1); else final_norm(F); }
    }
}
#ifndef REPMASK
#define REPMASK 0
#endif
#define SEAM(k_) do { if ((k_) == 0) { __syncthreads(); cg::this_grid().sync(); } else xcd_barrier(xbar); } while (0)
#define PHASE(k) if (ph_lo <= (k) && (k) < ph_hi) { run_phase<(k)>(wave_s, lds_raw); \
    if ((k) >= 1 && ((REPMASK >> (((k) - 1) % 12)) & 1)) { SEAM(k); run_phase<(k), REP_PART>(wave_s, lds_raw); } \
    if ((k) + 1 < ph_hi) SEAM(k); }
__global__ void __launch_bounds__(NTHR, 2) mk_fwd(Args args) {
    extern __shared__ __attribute__((aligned(16))) unsigned char lds_raw[];
    const int ph_lo = args.ph_lo, ph_hi = args.ph_hi;
    volatile LAS unsigned* xst = (volatile LAS unsigned*)((LAS unsigned char*)lds_raw + (LDS_BYTES - 64));
    if (threadIdx.x == 0) { xst[0] = 0u; xst[1] = 0u; }
    __syncthreads();
    const XcdBarrier xbar = xcd_barrier_post((unsigned*)(args.ws + WS_CTL), xst);
    const int wave_s = __builtin_amdgcn_readfirstlane((int)threadIdx.x >> 6);
    PHASE(0) PHASE(1) PHASE(2) PHASE(3) PHASE(4) PHASE(5) PHASE(6) PHASE(7) PHASE(8) PHASE(9) PHASE(10) PHASE(11) PHASE(12)
    PHASE(13) PHASE(14) PHASE(15) PHASE(16) PHASE(17) PHASE(18) PHASE(19) PHASE(20) PHASE(21) PHASE(22) PHASE(23) PHASE(24)
}

extern "C" void kernel_launch(void* const* d_in, const int* in_sizes, int n_in, void* d_out, int out_size, void* d_ws, size_t ws_size, hipStream_t stream) {
    static int grid = 0;
    if (grid == 0) {
        if (n_in != 41 || out_size != TT * DM || ws_size < WS_END) { fprintf(stderr, "kernel_launch: unexpected shapes (n_in %d out %d ws %zu)\n", n_in, out_size, ws_size); grid = -1; return; }
        int dev = 0, cus = 0, per_cu = 0;
        (void)hipGetDevice(&dev); (void)hipDeviceGetAttribute(&cus, hipDeviceAttributeMultiprocessorCount, dev);
        if (hipFuncSetAttribute((const void*)mk_fwd, hipFuncAttributeMaxDynamicSharedMemorySize, LDS_BYTES) != hipSuccess) { fprintf(stderr, "kernel_launch: hipFuncSetAttribute failed\n"); grid = -1; return; }
        if (hipOccupancyMaxActiveBlocksPerMultiprocessor(&per_cu, (const void*)mk_fwd, NTHR, LDS_BYTES) != hipSuccess || per_cu < 1) { fprintf(stderr, "kernel_launch: occupancy query says %d\n", per_cu); per_cu = 1; }
        (void)hipGetLastError();
        grid = cus * (per_cu >= 1 ? 1 : 1);
        if (grid < 64) { fprintf(stderr, "kernel_launch: grid %d too small\n", grid); }
    }
    if (grid < 0) return;
    if (hipMemsetAsync((char*)d_ws + WS_CTL, 0, CTL_ZERO_BYTES, stream) != hipSuccess) { fprintf(stderr, "kernel_launch: hipMemsetAsync failed\n"); return; }
    Args a{};
    for (int i = 0; i < 41; ++i) a.in[i] = (const float*)d_in[i];
    a.out = (float*)d_out; a.ws = (unsigned char*)d_ws;
#if ONE_LAUNCH
    a.ph_lo = 0; a.ph_hi = NPH;
    void* kargs[] = {&a};
    hipError_t e = hipLaunchCooperativeKernel((const void*)mk_fwd, dim3(grid), dim3(NTHR), kargs, LDS_BYTES, stream);
    if (e != hipSuccess) fprintf(stderr, "cooperative launch failed: %s (grid %d)\n", hipGetErrorString(e), grid);
#else
    for (int ph = 0; ph < NPH; ++ph) { a.ph_lo = ph; a.ph_hi = ph + 1; hipLaunchKernelGGL(mk_fwd, dim3(grid), dim3(NTHR), LDS_BYTES, stream, a); }
#endif
}
```

```cpp
#include <hip/hip_runtime.h>
#include <hip/hip_cooperative_groups.h>
#include <cstdio>
#include <cstdint>
#include <cstddef>
namespace cg = cooperative_groups;
namespace pg8 {
#define PG8_LAS __attribute__((address_space(3)))
typedef unsigned short bf16_t;
typedef short bf16x8 __attribute__((ext_vector_type(8)));
typedef float f32x4 __attribute__((ext_vector_type(4)));
typedef unsigned u32x4 __attribute__((ext_vector_type(4)));
constexpr int BM = 256, BK = 64, HALF = 128, HTB = HALF * BK * 2  , STAGE_BYTES = 8 * HTB, NXCD = 8, WGM = 8;

__host__ __device__ __forceinline__ int lds_byte(int r, int c) { const int st = (r >> 4) * 2 + (c >> 5), rr = r & 15, cc = c & 31, ob = rr * 64 + cc * 2; return st * 1024 + (ob ^ (((ob >> 9) & 1) << 5)); }
__host__ __device__ __forceinline__ void stage_rc(int b, int& R, int& C) { const int st = b / 1024, sb = b % 1024, swz = sb ^ (((sb >> 9) & 1) << 5); R = (st >> 1) * 16 + swz / 64; C = (st & 1) * 32 + (swz % 64) / 2; }
__host__ __device__ __forceinline__ int perm32(int rho) { const int n = rho >> 4, i = rho & 15; return 8 * (i >> 2) + 4 * n + (i & 3); }

struct Unit { int pm, pn, g; };
struct Gemm { const bf16_t* A; const bf16_t* Bt; int M, N, K, nseg; };

struct StaticOrder {
    int nM, nN, nwg, G, c;
    __host__ __device__ void init(int M, int N, int G_, int c_) { nM = M / BM; nN = N / BM; nwg = nM * nN; G = G_; c = c_; }
    __host__ __device__ bool next(int i, Unit& u) const {
        const long L = (long)i * G + c; if (L >= nwg) return false;
        int wgid = (int)L; { const int q = nwg / NXCD, r = nwg % NXCD, xcd = wgid % NXCD, off = wgid / NXCD; wgid = (xcd < r ? xcd * (q + 1) : r * (q + 1) + (xcd - r) * q) + off; }
        const int nig = WGM * nN, gid = wgid / nig, fm = gid * WGM, gsz = (nM - fm) < WGM ? (nM - fm) : WGM;
        u.pm = fm + ((wgid % nig) % gsz); u.pn = (wgid % nig) / gsz; u.g = 0; return true;
    }
    __device__ __forceinline__ void a_ready(const Unit&) const {}
    __device__ __forceinline__ void done(const Unit&) const {}
};


struct SegOrder4 {
    StaticOrder so;
    __host__ __device__ bool next(int i, Unit& u) const { if (!so.next(i >> 2, u)) return false; u.g = i & 3; return true; }
    __device__ __forceinline__ void a_ready(const Unit&) const {}
    __device__ __forceinline__ void done(const Unit&) const {}
};

typedef _Float16 h16;
typedef _Float16 h16x4 __attribute__((ext_vector_type(4)));
typedef unsigned u32x2 __attribute__((ext_vector_type(2)));
__device__ __forceinline__ unsigned cvt_pk_bf16(float lo, float hi) { unsigned r; asm volatile("v_cvt_pk_bf16_f32 %0, %1, %2" : "=v"(r) : "v"(lo), "v"(hi)); return r; }
__device__ __forceinline__ u32x2 pack_bf16x4(f32x4 v) { u32x2 w; w.x = cvt_pk_bf16(v[0], v[1]); w.y = cvt_pk_bf16(v[2], v[3]); return w; }
__device__ __forceinline__ h16x4 pack_h16x4(f32x4 v) { h16x4 w; w[0] = (h16)v[0]; w[1] = (h16)v[1]; w[2] = (h16)v[2]; w[3] = (h16)v[3]; return w; }
__device__ __forceinline__ float fast_sigmoid(float x) { return __builtin_amdgcn_rcpf(1.0f + __expf(-x)); }
__device__ __forceinline__ float row_rstd(const float* SS, int row) {
    const f32x4* p = (const f32x4*)(SS + (size_t)row * 16);
    const f32x4 a = p[0], b = p[1], c = p[2], d = p[3];
    const float s = ((a[0] + a[1]) + (a[2] + a[3])) + ((b[0] + b[1]) + (b[2] + b[3])) + ((c[0] + c[1]) + (c[2] + c[3])) + ((d[0] + d[1]) + (d[2] + d[3]));
    return rsqrtf(s * (1.0f / 1024.0f) + 1e-6f);
}

struct EpiGU {
    static constexpr bool PERM = true, KSEG = false;
    bf16_t* hid; const float* SS;
    __device__ __forceinline__ void operator()(const f32x4 (&acc)[2][2][4][2], const Unit& u, int wr, int wc, int fr, int fq) const {
        int row0 = u.pm * BM + wr * 64 + fr; asm volatile("" : "+v"(row0)); const int j0 = u.pn * 128 + wc * 16 + fq * 4;
#pragma unroll
        for (int ai = 0; ai < 2; ++ai)
#pragma unroll
            for (int m = 0; m < 4; ++m) { const int row = row0 + ai * HALF + m * 16; const float rs = row_rstd(SS, row);
#pragma unroll
                for (int bj = 0; bj < 2; ++bj) { const f32x4 g = acc[ai][bj][m][0] * rs, up = acc[ai][bj][m][1] * rs; f32x4 h;
#pragma unroll
                    for (int i = 0; i < 4; ++i) h[i] = g[i] * fast_sigmoid(g[i]) * up[i];
                    *(u32x2*)(hid + (size_t)row * 2816 + j0 + bj * 64) = pack_bf16x4(h); } }
    }
};
struct EpiDown {
    static constexpr bool PERM = false, KSEG = false;
    const float* res; float* X; bf16_t* xb; float* SS; float alpha;
    __device__ __forceinline__ void operator()(const f32x4 (&acc)[2][2][4][2], const Unit& u, int wr, int wc, int fr, int fq) const {
        int row0 = u.pm * BM + wr * 64 + fr; asm volatile("" : "+v"(row0)); const int c0 = u.pn * BM + wc * 32 + fq * 4;
#pragma unroll
        for (int ai = 0; ai < 2; ++ai)
#pragma unroll
            for (int m = 0; m < 4; ++m) { const int row = row0 + ai * HALF + m * 16; float ss = 0.f;
#pragma unroll
                for (int bj = 0; bj < 2; ++bj)
#pragma unroll
                    for (int n = 0; n < 2; ++n) { const size_t off = (size_t)row * 1024 + c0 + bj * HALF + n * 16;
                        const f32x4 r = *(const f32x4*)(res + off); const f32x4 o = r + acc[ai][bj][m][n] * alpha;
                        *(f32x4*)(X + off) = o; *(u32x2*)(xb + off) = pack_bf16x4(o);
                        ss += (o[0] * o[0] + o[1] * o[1]) + (o[2] * o[2] + o[3] * o[3]); }
                ss += __shfl_xor(ss, 16); ss += __shfl_xor(ss, 32);
                if (fq == 0) SS[(size_t)row * 16 + u.pn * 4 + wc] = ss;
                asm volatile("" ::: "memory"); }
    }
};
struct EpiInA {
    static constexpr bool PERM = false, KSEG = false;
    h16* U5; h16* PP; h16* L16; const float* SS;
    __device__ __forceinline__ void operator()(const f32x4 (&acc)[2][2][4][2], const Unit& u, int wr, int wc, int fr, int fq) const {
        int row0 = u.pm * BM + wr * 64 + fr; asm volatile("" : "+v"(row0)); const int cl = wc * 32 + fq * 4;
        h16* base; int ld, cb;
        if (u.pn == 0) { base = U5; ld = 256; cb = 0; } else if (u.pn < 8) { base = PP; ld = 1792; cb = (u.pn - 1) * 256; } else { base = L16; ld = 512; cb = (u.pn - 8) * 256; }
#pragma unroll
        for (int ai = 0; ai < 2; ++ai)
#pragma unroll
            for (int m = 0; m < 4; ++m) { const int row = row0 + ai * HALF + m * 16; const float rs = row_rstd(SS, row);
#pragma unroll
                for (int bj = 0; bj < 2; ++bj)
#pragma unroll
                    for (int n = 0; n < 2; ++n) *(h16x4*)(base + (size_t)row * ld + cb + cl + bj * HALF + n * 16) = pack_h16x4(acc[ai][bj][m][n] * rs); }
    }
};
struct EpiGate {
    static constexpr bool PERM = false, KSEG = false;
    h16* R; const float* SS;
    __device__ __forceinline__ void operator()(const f32x4 (&acc)[2][2][4][2], const Unit& u, int wr, int wc, int fr, int fq) const {
        int row0 = u.pm * BM + wr * 64 + fr; asm volatile("" : "+v"(row0)); const int d0 = 256 * (u.pn >> 2) + 128 * ((u.pn >> 1) & 1) + 16 * (u.pn & 1) + 32 * wc + 4 * fq;
#pragma unroll
        for (int ai = 0; ai < 2; ++ai)
#pragma unroll
            for (int m = 0; m < 4; ++m) { const int row = row0 + ai * HALF + m * 16; const float rs = row_rstd(SS, row);
                f32x4 e[4];
#pragma unroll
                for (int g = 0; g < 4; ++g)
#pragma unroll
                    for (int i = 0; i < 4; ++i) e[g][i] = 1.0f + __expf(-fminf(fmaxf(acc[ai][g >> 1][m][g & 1][i] * rs, -10.f), 30.f));
                f32x4 r[4];
#pragma unroll
                for (int i = 0; i < 4; ++i) { const float i0 = __builtin_amdgcn_rcpf(e[0][i]), i1 = __builtin_amdgcn_rcpf(e[1][i]), i2 = __builtin_amdgcn_rcpf(e[2][i]), i3 = __builtin_amdgcn_rcpf(e[3][i]);
                    r[0][i] = e[1][i] * i0; r[1][i] = e[2][i] * i1; r[2][i] = e[3][i] * i2; r[3][i] = i3; }
#pragma unroll
                for (int g = 0; g < 4; ++g) *(h16x4*)(R + ((size_t)row * 4 + g) * 1024 + d0) = pack_h16x4(r[g]); }
    }
};
struct EpiBranch {
    static constexpr bool PERM = false, KSEG = true;
    const h16* R; bf16_t* out;
    __device__ __forceinline__ void operator()(f32x4 (&acc)[2][2][4][2], const Unit& u, int wr, int wc, int fr, int fq) const {
        unsigned q0 = (unsigned)(u.pm * BM + wr * 64 + fr) * 1024u + (unsigned)(u.pn * BM + wc * 32 + fq * 4); asm volatile("" : "+v"(q0));
        const unsigned r0 = (q0 - (q0 & 1023u)) * 4u + (unsigned)u.g * 1024u + (q0 & 1023u);
        const bool last = u.g == 3;
#pragma unroll
        for (int ai = 0; ai < 2; ++ai)
#pragma unroll
            for (int m = 0; m < 4; ++m) {
#pragma unroll
                for (int bj = 0; bj < 2; ++bj)
#pragma unroll
                    for (int n = 0; n < 2; ++n) { const unsigned off = q0 + (unsigned)((ai * HALF + m * 16) * 1024 + bj * HALF + n * 16);
                        const h16x4 r = *(const h16x4*)(R + (r0 + (unsigned)((ai * HALF + m * 16) * 4096 + bj * HALF + n * 16)));
                        f32x4 rf; rf[0] = (float)r[0]; rf[1] = (float)r[1]; rf[2] = (float)r[2]; rf[3] = (float)r[3];
                        acc[ai][bj][m][n] = acc[ai][bj][m][n] * rf;
                        if (last) *(u32x2*)(out + off) = pack_bf16x4(acc[ai][bj][m][n]); }
                asm volatile("" ::: "memory"); }
    }
};
struct EpiGlu {
    static constexpr bool PERM = false, KSEG = false;
    const bf16_t* gl; bf16_t* ys;
    __device__ __forceinline__ void operator()(const f32x4 (&acc)[2][2][4][2], const Unit& u, int wr, int wc, int fr, int fq) const {
        int row0 = u.pm * BM + wr * 64 + fr; asm volatile("" : "+v"(row0)); const int c0 = wc * 32 + fq * 4;
#pragma unroll
        for (int ai = 0; ai < 2; ++ai)
#pragma unroll
            for (int m = 0; m < 4; ++m) { const int row = row0 + ai * HALF + m * 16;
#pragma unroll
                for (int bj = 0; bj < 2; ++bj)
#pragma unroll
                    for (int n = 0; n < 2; ++n) { const int c = c0 + bj * HALF + n * 16; const u32x2 gv = *(const u32x2*)(gl + (size_t)row * 256 + c);
                        f32x4 g; g[0] = __uint_as_float(gv.x << 16); g[1] = __uint_as_float(gv.x & 0xffff0000u); g[2] = __uint_as_float(gv.y << 16); g[3] = __uint_as_float(gv.y & 0xffff0000u);
                        f32x4 o;
#pragma unroll
                        for (int i = 0; i < 4; ++i) o[i] = g[i] * fast_sigmoid(acc[ai][bj][m][n][i]);
                        *(u32x2*)(ys + (size_t)row * 1024 + c) = pack_bf16x4(o); }
                asm volatile("" ::: "memory"); }
    }
};

template <class Epi, class Sched, bool ALIGN_EPI = false, bool SP2 = false>
__device__ __forceinline__ void gemm_phase(PG8_LAS unsigned char* lds, const Gemm g, const Sched& S, const Epi& E, const int tid) {
    const int wid = __builtin_amdgcn_readfirstlane(tid >> 6), lane = tid & 63, wr = wid >> 2, wc = wid & 3, fr = lane & 15, fq = lane >> 4;
    const int K = g.K, nt = K / BK / g.nseg; const size_t segb = (size_t)(K / g.nseg) * 2;
    unsigned voffA[2], voffB[2];
#pragma unroll
    for (int i = 0; i < 2; ++i) { int R, C; stage_rc(tid * 16 + i * 8192, R, C); const int Rb = Epi::PERM ? ((R & ~31) + perm32(R & 31)) : R;
        voffA[i] = (unsigned)(R * K + C) * 2u; voffB[i] = (unsigned)(Rb * K + C) * 2u; }
    const size_t kstep = (size_t)(BK * 2);
    const size_t hstep = (size_t)HALF * K * 2;
    const size_t tstep = 2 * hstep;
    const unsigned ldsw = (unsigned)wid * 1024u;
    const int aoff = lds_byte(wr * 64 + fr, fq * 8), boff = lds_byte(wc * 32 + fr, fq * 8);
#define PG8_SA(b, h) (((b) * 2 + (h)) * HTB)
#define PG8_SB(b, h) ((4 + (b) * 2 + (h)) * HTB)
#define PG8_STAGE(bufoff, gbase, voff) do { _Pragma("unroll") for (int _i = 0; _i < 2; ++_i) \
        __builtin_amdgcn_global_load_lds((const unsigned*)((const char*)(gbase) + (voff)[_i]), (PG8_LAS unsigned*)(lds + (bufoff) + ldsw + _i * 8192), 16, 0, 0); } while (0)
#define PG8_LDA(dst, b, h) do { _Pragma("unroll") for (int m = 0; m < 4; ++m) _Pragma("unroll") for (int k = 0; k < 2; ++k) dst[m][k] = *(const PG8_LAS bf16x8*)(lds + PG8_SA(b, h) + aoff + m * 2048 + k * 1024); } while (0)
#define PG8_LDB(dst, b, h) do { _Pragma("unroll") for (int n = 0; n < 2; ++n) _Pragma("unroll") for (int k = 0; k < 2; ++k) dst[n][k] = *(const PG8_LAS bf16x8*)(lds + PG8_SB(b, h) + boff + n * 2048 + k * 1024); } while (0)
#define PG8_MMA(ai, bj, At, Bt) do { __builtin_amdgcn_s_setprio(1); _Pragma("unroll") for (int m = 0; m < 4; ++m) _Pragma("unroll") for (int n = 0; n < 2; ++n) _Pragma("unroll") for (int k = 0; k < 2; ++k) \
        acc[ai][bj][m][n] = __builtin_amdgcn_mfma_f32_16x16x32_bf16(Bt[n][k], At[m][k], acc[ai][bj][m][n], 0, 0, 0); __builtin_amdgcn_s_setprio(0); } while (0)
#define PG8_WAIT_V(n) asm volatile("s_waitcnt vmcnt(" #n ")" ::: "memory")
#define PG8_WAIT_L(n) asm volatile("s_waitcnt lgkmcnt(" #n ")" ::: "memory")
#define PG8_BAR __builtin_amdgcn_s_barrier()
#define PG8_SCHED __builtin_amdgcn_sched_barrier(0)
    Unit cur, nxt; int ui = 0;
    if (!S.next(0, cur)) return;
    f32x4 acc[2][2][4][2];
#pragma unroll
    for (int a = 0; a < 2; ++a)
#pragma unroll
        for (int b = 0; b < 2; ++b)
#pragma unroll
            for (int m = 0; m < 4; ++m)
#pragma unroll
                for (int n = 0; n < 2; ++n) acc[a][b][m][n] = (f32x4){0.f, 0.f, 0.f, 0.f};
    bf16x8 At[4][2], B0[2][2], B1[2][2];
    const char* cA = (const char*)g.A + (size_t)cur.pm * tstep + (size_t)cur.g * segb; const char* cB = (const char*)g.Bt + (size_t)cur.pn * tstep + (size_t)cur.g * segb;
    S.a_ready(cur);
    if constexpr (SP2) {
        PG8_STAGE(PG8_SB(0, 0), cB, voffB); PG8_STAGE(PG8_SB(0, 1), cB + hstep, voffB); PG8_STAGE(PG8_SA(0, 0), cA, voffA); PG8_STAGE(PG8_SA(0, 1), cA + hstep, voffA);
        if (wr == 1) PG8_BAR;
        PG8_WAIT_V(2); PG8_BAR;
        PG8_STAGE(PG8_SB(1, 0), cB + kstep, voffB); PG8_STAGE(PG8_SA(1, 0), cA + kstep, voffA); PG8_STAGE(PG8_SB(1, 1), cB + hstep + kstep, voffB);
        PG8_WAIT_V(6); PG8_BAR;
    } else {
        PG8_STAGE(PG8_SB(0, 0), cB, voffB); PG8_STAGE(PG8_SA(0, 0), cA, voffA); PG8_STAGE(PG8_SB(0, 1), cB + hstep, voffB); PG8_STAGE(PG8_SA(0, 1), cA + hstep, voffA);
        if (wr == 1) PG8_BAR;
        PG8_WAIT_V(4); PG8_BAR;
        PG8_STAGE(PG8_SB(1, 0), cB + kstep, voffB); PG8_STAGE(PG8_SA(1, 0), cA + kstep, voffA); PG8_STAGE(PG8_SB(1, 1), cB + hstep + kstep, voffB);
        PG8_WAIT_V(6); PG8_BAR;
    }
    for (;;) {
        const bool has_next = S.next(ui + 1, nxt);
        const char* nA = has_next ? (const char*)g.A + (size_t)nxt.pm * tstep + (size_t)nxt.g * segb : cA; const char* nB = has_next ? (const char*)g.Bt + (size_t)nxt.pn * tstep + (size_t)nxt.g * segb : cB;
        for (int t = 0; t < nt; t += 2) {
            const bool last = (t == nt - 2);
            const char* a1 = cA + (size_t)(t + 1) * kstep;
            const char* a2 = last ? nA : cA + (size_t)(t + 2) * kstep; const char* b2 = last ? nB : cB + (size_t)(t + 2) * kstep;
            const char* a3 = a2 + kstep; const char* b3 = b2 + kstep;
            if (last && has_next) S.a_ready(nxt);
            if constexpr (SP2) {
            PG8_LDB(B0, 0, 0); PG8_LDB(B1, 0, 1); PG8_SCHED; PG8_LDA(At, 0, 0); PG8_STAGE(PG8_SA(1, 1), a1 + hstep, voffA);
            PG8_WAIT_V(8); PG8_WAIT_L(0); PG8_BAR; PG8_MMA(0, 0, At, B0); PG8_MMA(0, 1, At, B1); PG8_BAR; PG8_SCHED;
            PG8_LDA(At, 0, 1); PG8_STAGE(PG8_SB(0, 0), b2, voffB); PG8_STAGE(PG8_SB(0, 1), b2 + hstep, voffB); PG8_STAGE(PG8_SA(0, 0), a2, voffA);
            PG8_WAIT_V(8); PG8_WAIT_L(0); PG8_BAR; PG8_MMA(1, 0, At, B0); PG8_MMA(1, 1, At, B1); PG8_BAR; PG8_SCHED;
            PG8_LDB(B0, 1, 0); PG8_LDB(B1, 1, 1); PG8_SCHED; PG8_LDA(At, 1, 0); PG8_STAGE(PG8_SA(0, 1), a2 + hstep, voffA);
            PG8_WAIT_V(8); PG8_WAIT_L(0); PG8_BAR; PG8_MMA(0, 0, At, B0); PG8_MMA(0, 1, At, B1); PG8_BAR; PG8_SCHED;
            PG8_LDA(At, 1, 1); PG8_STAGE(PG8_SB(1, 0), b3, voffB); PG8_STAGE(PG8_SB(1, 1), b3 + hstep, voffB); PG8_STAGE(PG8_SA(1, 0), a3, voffA);
            PG8_WAIT_V(8); PG8_WAIT_L(0); PG8_BAR; PG8_MMA(1, 0, At, B0); PG8_MMA(1, 1, At, B1); PG8_BAR; PG8_SCHED;
            } else {
            PG8_LDB(B0, 0, 0); PG8_SCHED; PG8_LDA(At, 0, 0); PG8_STAGE(PG8_SA(1, 1), a1 + hstep, voffA);
            PG8_WAIT_L(8); PG8_BAR; PG8_WAIT_L(0); PG8_MMA(0, 0, At, B0); PG8_BAR; PG8_SCHED;
            PG8_LDB(B1, 0, 1); PG8_STAGE(PG8_SB(0, 0), b2, voffB);
            PG8_BAR; PG8_WAIT_L(0); PG8_MMA(0, 1, At, B1); PG8_BAR;
            PG8_LDA(At, 0, 1); PG8_STAGE(PG8_SA(0, 0), a2, voffA);
            PG8_BAR; PG8_WAIT_L(0); PG8_MMA(1, 0, At, B0); PG8_BAR; PG8_SCHED;
            PG8_STAGE(PG8_SB(0, 1), b2 + hstep, voffB);
            PG8_WAIT_V(6); PG8_BAR; PG8_MMA(1, 1, At, B1); PG8_BAR;
            PG8_LDB(B0, 1, 0); PG8_SCHED; PG8_LDA(At, 1, 0); PG8_STAGE(PG8_SA(0, 1), a2 + hstep, voffA);
            PG8_WAIT_L(8); PG8_BAR; PG8_WAIT_L(0); PG8_MMA(0, 0, At, B0); PG8_BAR; PG8_SCHED;
            PG8_LDB(B1, 1, 1); PG8_STAGE(PG8_SB(1, 0), b3, voffB);
            PG8_BAR; PG8_WAIT_L(0); PG8_MMA(0, 1, At, B1); PG8_BAR;
            PG8_LDA(At, 1, 1); PG8_STAGE(PG8_SA(1, 0), a3, voffA);
            PG8_BAR; PG8_WAIT_L(0); PG8_MMA(1, 0, At, B0); PG8_BAR; PG8_SCHED;
            PG8_STAGE(PG8_SB(1, 1), b3 + hstep, voffB);
            PG8_WAIT_V(6); PG8_BAR; PG8_MMA(1, 1, At, B1); PG8_BAR;
            }
        }
        if constexpr (ALIGN_EPI) { if (wr == 0) PG8_BAR; }
        E(acc, cur, wr, wc, fr, fq); S.done(cur);
        if (!has_next) break;
        if (!(Epi::KSEG && nxt.g != 0))
#pragma unroll
        for (int a = 0; a < 2; ++a)
#pragma unroll
            for (int b = 0; b < 2; ++b)
#pragma unroll
                for (int m = 0; m < 4; ++m)
#pragma unroll
                    for (int n = 0; n < 2; ++n) acc[a][b][m][n] = (f32x4){0.f, 0.f, 0.f, 0.f};
        cur = nxt; cA = nA; cB = nB; ++ui;
        if constexpr (ALIGN_EPI) { if (wr == 1) PG8_BAR; }
    }
    PG8_WAIT_V(0);
    if constexpr (!ALIGN_EPI) { if (wr == 0) PG8_BAR; }
    PG8_BAR;
#undef PG8_SA
#undef PG8_SB
#undef PG8_STAGE
#undef PG8_LDA
#undef PG8_LDB
#undef PG8_MMA
#undef PG8_WAIT_V
#undef PG8_WAIT_L
#undef PG8_BAR
#undef PG8_SCHED
}
}

#define LAS __attribute__((address_space(3)))
typedef unsigned short bf16_t;
typedef _Float16 h16;
typedef _Float16 h16x4 __attribute__((ext_vector_type(4)));
typedef _Float16 h16x8 __attribute__((ext_vector_type(8)));
typedef float f32x4 __attribute__((ext_vector_type(4)));
typedef float f32x2 __attribute__((ext_vector_type(2)));
typedef unsigned u32x4 __attribute__((ext_vector_type(4)));
typedef unsigned u32x2 __attribute__((ext_vector_type(2)));

#ifndef ONE_LAUNCH
#define ONE_LAUNCH 1
#endif
constexpr int NWAVES = 8, NTHR = 512;
constexpr int TT = 16384, SEQ = 8192, DM = 1024, FF = 2816, MW = 256, INW = 6144;
constexpr int LDS_BYTES = 147456;
constexpr size_t MiB = 1u << 20;
constexpr size_t WS_CTL = 0, CTL_ZERO_BYTES = 16384, WS_SS = 1 * MiB, WS_E = 2 * MiB, WS_W = 4 * MiB, WS_B1 = 34 * MiB, WS_B2 = 66 * MiB, WS_Z = 98 * MiB, WS_END = 262 * MiB;
constexpr size_t W_GU1 = 0, W_D1 = W_GU1 + (size_t)2 * FF * DM * 2, W_INA = W_D1 + (size_t)DM * FF * 2;
constexpr size_t W_ING = 0, W_BR = W_ING + (size_t)4096 * DM * 2, W_O = W_BR + (size_t)DM * DM * 2, W_GU2 = W_O + (size_t)DM * DM * 2, W_D2 = W_GU2 + (size_t)2 * FF * DM * 2, W_GLU = W_D2 + (size_t)DM * FF * 2, W_END2 = W_GLU + 256 * 256 * 2;
static_assert(W_END2 <= 30 * MiB && W_INA + (size_t)2560 * DM * 2 <= 30 * MiB, "W region");
constexpr size_t Z_RW = 0, Z_G16 = 56 * MiB, Z_U5 = 64 * MiB, Z_L16 = 72 * MiB, Z_PP = 88 * MiB, Z_O = 72 * MiB, Z_GL = 144 * MiB, Z_PB = 152 * MiB, Z_LB = 156 * MiB, Z_SB = 160 * MiB;
constexpr size_t Z_HID = 0, Z_R = 0;
static_assert((size_t)TT * 4 * 896 <= 56 * MiB && (size_t)TT * 1792 * 2 <= 56 * MiB && (size_t)TT * FF * 2 <= 144 * MiB && (size_t)TT * 4096 * 2 <= 144 * MiB, "Z region");

typedef const float* cfp_t;
typedef const __attribute__((address_space(4))) cfp_t* in_t;
struct Args { const float* in[41]; float* out; unsigned char* ws; int ph_lo, ph_hi; };

struct Frame {
    LAS unsigned char* lds;
    int tid, lane, wave, G, bx;
    in_t in;
    float* X; unsigned char* ws;
    float* SS; float* E;
    bf16_t *B1, *B2, *HID, *GL;
    h16 *U5, *PP, *L16, *G16, *R;
    float* O; unsigned char* RW;
    float *PB, *LB, *SB;
};

__device__ __forceinline__ unsigned f2bf(float f) { unsigned u = __builtin_bit_cast(unsigned, f); return (u + 0x7fffu + ((u >> 16) & 1u)) >> 16; }
__device__ __forceinline__ unsigned pk2(float lo, float hi) { return f2bf(lo) | (f2bf(hi) << 16); }
#define LDS_WAIT() asm volatile("s_waitcnt lgkmcnt(0)" ::: "memory")
template <int CTRL> __device__ __forceinline__ float dppx(float x) { return __builtin_bit_cast(float, __builtin_amdgcn_update_dpp(0, __builtin_bit_cast(int, x), CTRL, 0xf, 0xf, true)); }
__device__ __forceinline__ float allreduce16(float x) { x += dppx<0xB1>(x); x += dppx<0x4E>(x); x += dppx<0x141>(x); x += dppx<0x140>(x); return x; }
__device__ __forceinline__ float wave_sum(float x) { x = allreduce16(x); x += __shfl_xor(x, 16); x += __shfl_xor(x, 32); return x; }
__device__ __forceinline__ float sigmoidf_(float x) { return __builtin_amdgcn_rcpf(1.0f + __expf(-x)); }

__device__ __forceinline__ int tr_rowmap(int mode, int j, int row0) {
    if (mode == 0) return row0 + j;
    if (mode == 1) return 8 * (j >> 2) + (j & 3);
    if (mode == 2) return 8 * (j >> 2) + 4 + (j & 3);
    const int g = j >> 10, d = j & 1023;
    const int pn = 4 * (d >> 8) + 2 * ((d >> 7) & 1) + ((d >> 4) & 1);
    return 256 * pn + 128 * (g >> 1) + 32 * ((d >> 5) & 3) + 16 * (g & 1) + 4 * ((d >> 2) & 3) + (d & 3);
}
__device__ __forceinline__ void tr_item(const float* W, int ldw, int K, int N, bf16_t* WT, int mode, int row0, const float* s1, const float* s2, int smode, LAS float* scr, int item, int lane) {
    const int nblk = N / 32, kb = item / nblk, nb = item % nblk, k0 = 64 * kb, n0 = 32 * nb;
#pragma unroll 8
    for (int i = 0; i < 32; ++i) { const int kk = 2 * i + (lane >> 5); const int k = k0 + kk; float sc = 1.0f;
        if (s1) sc = s1[k];
        if (smode == 1) sc *= s2[k]; else if (smode == 2) sc *= (1.0f - s2[k]);
        scr[kk * 33 + (lane & 31)] = W[(size_t)k * ldw + n0 + (lane & 31)] * sc; }
    LDS_WAIT(); asm volatile("" ::: "memory");
    const int c = lane & 7;
#pragma unroll
    for (int j = 0; j < 4; ++j) { const int n = (lane >> 3) + 8 * j; const LAS float* s = scr + (8 * c) * 33 + n;
        u32x4 o; o.x = pk2(s[0 * 33], s[1 * 33]); o.y = pk2(s[2 * 33], s[3 * 33]); o.z = pk2(s[4 * 33], s[5 * 33]); o.w = pk2(s[6 * 33], s[7 * 33]);
        *(u32x4*)(WT + (size_t)tr_rowmap(mode, n0 + n, row0) * K + k0 + 8 * c) = o; }
    LDS_WAIT(); asm volatile("" ::: "memory");
}
#define TRJ(W_, ldw_, K_, N_, dst_, mode_, row0_, s1_, s2_, smode_) { const int ni_ = ((K_) / 64) * ((N_) / 32); if (r >= 0 && r < ni_) tr_item(W_, ldw_, K_, N_, dst_, mode_, row0_, s1_, s2_, smode_, scr, r, F.lane); r -= ni_; }
__device__ __forceinline__ void conv_first_half(Frame& F, int l) {
    LAS float* scr = (LAS float*)(F.lds + F.wave * 16384);
    const int gw = F.bx * NWAVES + F.wave, NGW = F.G * NWAVES;
    unsigned char* wb = F.ws + WS_W;
    const float* n1 = F.in[1] + (size_t)l * DM; const float* nm = F.in[5] + (size_t)l * DM; const float* mu = F.in[19] + (size_t)l * 3 * DM;
    const float* w1 = F.in[21] + (size_t)l * DM * 64; const float* a1 = F.in[24] + (size_t)l * DM * 64; const float* g1 = F.in[26] + (size_t)l * DM * 128;
    bf16_t* ina = (bf16_t*)(wb + W_INA);
    for (int it = gw;; it += NGW) { int r = it;
        TRJ(F.in[2] + (size_t)l * DM * FF, FF, DM, FF, (bf16_t*)(wb + W_GU1), 1, 0, n1, nullptr, 0)
        TRJ(F.in[3] + (size_t)l * DM * FF, FF, DM, FF, (bf16_t*)(wb + W_GU1), 2, 0, n1, nullptr, 0)
        TRJ(F.in[4] + (size_t)l * FF * DM, DM, FF, DM, (bf16_t*)(wb + W_D1), 0, 0, nullptr, nullptr, 0)
        TRJ(F.in[6] + (size_t)l * DM * INW, INW, DM, 2048, ina, 0, 0, nm, nullptr, 0)
        TRJ(w1, 64, DM, 64, ina, 0, 2048, nm, mu, 2)
        TRJ(a1, 64, DM, 64, ina, 0, 2112, nm, mu + DM, 2)
        TRJ(g1, 128, DM, 128, ina, 0, 2176, nm, mu + 2 * DM, 2)
        TRJ(w1, 64, DM, 64, ina, 0, 2304, nm, mu, 1)
        TRJ(a1, 64, DM, 64, ina, 0, 2368, nm, mu + DM, 1)
        TRJ(g1, 128, DM, 128, ina, 0, 2432, nm, mu + 2 * DM, 1)
        if (r >= 0) break; }
}
__device__ __forceinline__ void conv_second_half(Frame& F, int l, int b0) {
    LAS float* scr = (LAS float*)(F.lds + F.wave * 16384);
    const int gw = (F.bx - b0) * NWAVES + F.wave, NGW = (F.G - b0) * NWAVES;
    unsigned char* wb = F.ws + WS_W;
    const float* nm = F.in[5] + (size_t)l * DM; const float* n2 = F.in[36] + (size_t)l * DM;
    for (int it = gw;; it += NGW) { int r = it;
        TRJ(F.in[6] + (size_t)l * DM * INW + 2048, INW, DM, 4096, (bf16_t*)(wb + W_ING), 3, 0, nm, nullptr, 0)
        TRJ(F.in[34] + (size_t)l * DM * DM, DM, DM, DM, (bf16_t*)(wb + W_BR), 0, 0, nullptr, nullptr, 0)
        TRJ(F.in[35] + (size_t)l * DM * DM, DM, DM, DM, (bf16_t*)(wb + W_O), 0, 0, nullptr, nullptr, 0)
        TRJ(F.in[37] + (size_t)l * DM * FF, FF, DM, FF, (bf16_t*)(wb + W_GU2), 1, 0, n2, nullptr, 0)
        TRJ(F.in[38] + (size_t)l * DM * FF, FF, DM, FF, (bf16_t*)(wb + W_GU2), 2, 0, n2, nullptr, 0)
        TRJ(F.in[39] + (size_t)l * FF * DM, DM, FF, DM, (bf16_t*)(wb + W_D2), 0, 0, nullptr, nullptr, 0)
        TRJ(F.in[15] + (size_t)l * 256 * 256, 256, 256, 256, (bf16_t*)(wb + W_GLU), 0, 0, nullptr, nullptr, 0)
        if (r >= 0) break; }
}
__device__ __forceinline__ void prep_x(Frame& F) {
    const int gw = F.bx * NWAVES + F.wave, NGW = F.G * NWAVES;
    const float* x = F.in[0];
    for (int m = gw; m < TT; m += NGW) {
        const f32x4* xr = (const f32x4*)(x + (size_t)m * DM) + F.lane; float s = 0.f;
        unsigned long long* o8 = (unsigned long long*)(F.B1 + (size_t)m * DM) + F.lane;
#pragma unroll
        for (int j = 0; j < 4; ++j) { const f32x4 v = xr[64 * j]; s += (v[0] * v[0] + v[1] * v[1]) + (v[2] * v[2] + v[3] * v[3]);
            o8[64 * j] = (unsigned long long)pk2(v[0], v[1]) | ((unsigned long long)pk2(v[2], v[3]) << 32); }
        s += __shfl_xor(s, 1); s += __shfl_xor(s, 2);
        if ((F.lane & 3) == 0) F.SS[(size_t)m * 16 + (F.lane >> 2)] = s;
    }
}
__device__ __forceinline__ void final_norm(Frame& F) {
    const int gw = F.bx * NWAVES + F.wave, NGW = F.G * NWAVES;
    const f32x4* gn = (const f32x4*)F.in[40] + F.lane;
    for (int m = gw; m < TT; m += NGW) {
        const float rs = pg8::row_rstd(F.SS, m);
        f32x4* xr = (f32x4*)(F.X + (size_t)m * DM) + F.lane;
#pragma unroll
        for (int j = 0; j < 4; ++j) { const f32x4 v = xr[64 * j]; xr[64 * j] = v * rs * gn[64 * j]; }
    }
}

struct S5Par { float ar, ai; float bbr[16], bbi[16]; };
__device__ __forceinline__ void s5_params(Frame& F, int l, int g, int p, S5Par& P) {
    asm volatile("" : "+v"(p));
    const float lr = F.in[7][((size_t)l * 16 + g) * 64 + p], li = F.in[8][((size_t)l * 16 + g) * 64 + p], dt = expf(F.in[9][l * 16 + g]);
    const float mag = expf(lr * dt); P.ar = mag * cosf(li * dt); P.ai = mag * sinf(li * dt);
    const float inv = 1.0f / (lr * lr + li * li); const float qr = lr * inv, qi = -li * inv;
    const float cr = (P.ar - 1.0f) * qr - P.ai * qi, ci = (P.ar - 1.0f) * qi + P.ai * qr;
    const f32x4* br = (const f32x4*)(F.in[10] + (((size_t)l * 16 + g) * 64 + p) * 16); const f32x4* bi = (const f32x4*)(F.in[11] + (((size_t)l * 16 + g) * 64 + p) * 16);
#pragma unroll
    for (int q = 0; q < 4; ++q) { const f32x4 a = br[q], b = bi[q];
#pragma unroll
        for (int i = 0; i < 4; ++i) { P.bbr[4 * q + i] = cr * a[i] - ci * b[i]; P.bbi[4 * q + i] = cr * b[i] + ci * a[i]; } }
}
__device__ __forceinline__ void s5_step(const S5Par& P, const LAS float* urow, float& hr, float& hi) {
    const LAS f32x4* u4 = (const LAS f32x4*)urow; float bur = 0.f, bui = 0.f;
#pragma unroll
    for (int q = 0; q < 4; ++q) { const f32x4 u = u4[q];
#pragma unroll
        for (int i = 0; i < 4; ++i) { bur += P.bbr[4 * q + i] * u[i]; bui += P.bbi[4 * q + i] * u[i]; } }
    const float nr = P.ar * hr - P.ai * hi + bur, ni = P.ar * hi + P.ai * hr + bui; hr = nr; hi = ni;
}
__device__ __forceinline__ void load_u5_tile(Frame& F, int t0, LAS float* ubuf) {
    for (int i = F.tid; i < 64 * 64; i += NTHR) { const int t = i >> 6, q = i & 63; const h16x4 v = *(const h16x4*)(F.U5 + (size_t)(t0 + t) * 256 + 4 * q);
        f32x4 f; f[0] = (float)v[0]; f[1] = (float)v[1]; f[2] = (float)v[2]; f[3] = (float)v[3]; *(LAS f32x4*)(ubuf + t * 256 + 4 * q) = f; }
}


template <bool FIRST> __device__ __forceinline__ void mv32(LAS float* accp, float init, const LAS float* hb, const float* wsrc, int ldw) {
    float w[32];
    asm volatile("" : "+v"(wsrc));
#pragma unroll
    for (int j = 0; j < 32; ++j) w[j] = wsrc[(size_t)j * ldw];
#pragma unroll 2
    for (int tt = 0; tt < 32; ++tt) { const LAS f32x4* h4 = (const LAS f32x4*)(hb + tt * 256); float a = FIRST ? init : accp[tt * 256];
#pragma unroll
        for (int q = 0; q < 8; ++q) { const f32x4 v = h4[q]; a += v[0] * w[4 * q] + v[1] * w[4 * q + 1] + v[2] * w[4 * q + 2] + v[3] * w[4 * q + 3]; }
        accp[tt * 256] = a; }
}
__device__ __forceinline__ void m1_phase(Frame& F, int l) {
    LAS float* ubuf = (LAS float*)F.lds;
    LAS float* pl = (LAS float*)(F.lds + 65536);
    const int tid = F.tid, lane = F.lane, wave = F.wave;
    const int ch = tid & 255, half = tid >> 8;
    for (int c = F.bx; c < TT / 64; c += F.G) {
        const int t0 = c * 64, tb = t0 + half * 32, sb = tb & (SEQ - 1);
        load_u5_tile(F, t0, ubuf);
        __syncthreads();
#pragma unroll 1
        for (int gi = 0; gi < 2; ++gi) { const int g = wave + 8 * gi; S5Par P; s5_params(F, l, g, lane, P); float hr = 0.f, hi = 0.f;
#pragma unroll 2
            for (int j = 0; j < 64; ++j) s5_step(P, ubuf + j * 256 + g * 16, hr, hi);
            *(f32x2*)(F.E + (((size_t)c * 16 + g) * 64 + lane) * 2) = (f32x2){hr, hi}; }
        __syncthreads();
        LAS float* accp = pl + half * 32 * 256 + ch;
        h16 la[32], lb[32];
#pragma unroll
        for (int tt = 0; tt < 32; ++tt) { const int t = tb + tt; la[tt] = F.L16[(size_t)t * 512 + ch]; lb[tt] = (sb + tt > 0) ? F.L16[(size_t)(t - 1) * 512 + 256 + ch] : (h16)0.f; }
#pragma unroll
        for (int tt = 0; tt < 32; ++tt) { float pre = (float)la[tt] + (float)lb[tt];
            float a = pre; if (ch < 64) a = 1.0f - 2.0f * __builtin_amdgcn_rcpf(1.0f + __expf(2.0f * pre)); else if (ch >= 128) a = sigmoidf_(pre);
            ubuf[(half * 32 + tt) * 256 + ch] = a; }
        __syncthreads();
        const int hb = (t0 / SEQ) * 4 + (ch >> 6);
        unsigned char* rwb = F.RW + ((size_t)hb * SEQ + sb) * 896;
        const int cl = ch & 63;
        const LAS float* hrow = ubuf + half * 32 * 256;
        {
            const float* wp = F.in[22] + (size_t)l * 64 * 256 + ch;
            mv32<true>(accp, F.in[20][(size_t)l * 256 + ch], hrow, wp, 256);
            mv32<false>(accp, 0.f, hrow + 32, wp + 32 * 256, 256);
#pragma unroll 2
            for (int tt = 0; tt < 32; ++tt) { const float z = -accp[tt * 256]; const float sp = fmaxf(z, 0.f) + __logf(1.0f + __expf(-fabsf(z)));
                const float wlog = -sp - 0.5f; const float dec = __expf(-__expf(wlog));
                *(float*)(rwb + (size_t)tt * 896 + cl * 4) = dec; }
        }
        {
            const float* gp = F.in[27] + (size_t)l * 128 * 256 + ch;
            mv32<true>(accp, 0.f, hrow + 128, gp, 256);
#pragma unroll 1
            for (int kc = 1; kc < 4; ++kc) mv32<false>(accp, 0.f, hrow + 128 + kc * 32, gp + (size_t)kc * 32 * 256, 256);
#pragma unroll 4
            for (int tt = 0; tt < 32; ++tt) F.G16[(size_t)(tb + tt) * 256 + ch] = (h16)accp[tt * 256];
        }
        {
            const float* ap = F.in[25] + (size_t)l * 64 * 256 + ch;
            mv32<true>(accp, F.in[23][(size_t)l * 256 + ch], hrow + 64, ap, 256);
            mv32<false>(accp, 0.f, hrow + 96, ap + 32 * 256, 256);
            const float mur = F.in[18][((size_t)l * 3 + 0) * 256 + ch], muk = F.in[18][((size_t)l * 3 + 1) * 256 + ch], muv = F.in[18][((size_t)l * 3 + 2) * 256 + ch];
            const float kkw = F.in[28][(size_t)l * 256 + ch], kaw = F.in[29][(size_t)l * 256 + ch];
            const h16* pp = F.PP + (size_t)tb * 1792 + 256 + ch;
            float rprev = 0.f, kprev = 0.f, vprev = 0.f;
            if (sb > 0) { rprev = (float)pp[-(ptrdiff_t)1792]; kprev = (float)pp[-(ptrdiff_t)1792 + 256]; vprev = (float)pp[-(ptrdiff_t)1792 + 512]; }
#pragma unroll 1
            for (int t16 = 0; t16 < 32; t16 += 16) {
                h16 rq[16], kq[16], vq[16];
#pragma unroll
                for (int tt = 0; tt < 16; ++tt) { const h16* q = pp + (size_t)(t16 + tt) * 1792; rq[tt] = q[0]; kq[tt] = q[256]; vq[tt] = q[512]; }
#pragma unroll
                for (int tt = 0; tt < 16; ++tt) { const float a = sigmoidf_(accp[(t16 + tt) * 256]);
                    const float rp = (float)rq[tt], kp = (float)kq[tt], vp = (float)vq[tt];
                    const float r = rp + (rprev - rp) * mur, k = kp + (kprev - kp) * muk, v = vp + (vprev - vp) * muv;
                    rprev = rp; kprev = kp; vprev = vp;
                    const float kkv = k * kkw; const float kk = kkv * rsqrtf(fmaxf(wave_sum(kkv * kkv), 1e-24f));
                    const float kt = k * (1.0f + (a - 1.0f) * kaw); const float bb = kk * a;
                    h16* o = (h16*)(rwb + (size_t)(t16 + tt) * 896 + 256) + cl;
                    o[0] = (h16)r; o[64] = (h16)kt; o[128] = (h16)v; o[192] = (h16)kk; o[256] = (h16)bb; } }
        }
        __syncthreads();
    }
}

__device__ __forceinline__ void pool_conv_chunk(Frame& F, int l, int c) {
    LAS float* ubuf = (LAS float*)F.lds;
    LAS float* pl = (LAS float*)(F.lds + 65536);
    const int tid = F.tid; const int ch = tid & 255, half = tid >> 8;
    const int t0 = c * 64, tb = t0 + half * 32, sb = tb & (SEQ - 1);
    {
    {
        const int grp = ch >> 6, win = 2 << grp;
        const h16* up = F.PP + (size_t)tb * 1792 + ch;
        float s = 0.f;
        for (int j = 1; j <= win; ++j) if (sb - j >= 0) s += (float)up[-(ptrdiff_t)j * 1792];
#pragma unroll 1
        for (int t16 = 0; t16 < 32; t16 += 16) {
            h16 uq[16], ul[16];
#pragma unroll
            for (int tt = 0; tt < 16; ++tt) { uq[tt] = up[(size_t)(t16 + tt) * 1792]; ul[tt] = (sb + t16 + tt - win >= 0) ? up[(ptrdiff_t)(t16 + tt - win) * 1792] : (h16)0.f; }
#pragma unroll
            for (int tt = 0; tt < 16; ++tt) { const float u = (float)uq[tt]; s += u; const int pos = sb + t16 + tt;
                s -= (float)ul[tt];
                const float cnt = (float)((pos + 1 < win) ? (pos + 1) : win);
                pl[(half * 32 + t16 + tt) * 256 + ch] = s / cnt - u; } }
    }
    {
        const h16* zp = F.PP + (size_t)tb * 1792 + 1024 + ch;
        const float cw0 = F.in[33][((size_t)l * 3 + 0) * 256 + ch], cw1 = F.in[33][((size_t)l * 3 + 1) * 256 + ch], cw2 = F.in[33][((size_t)l * 3 + 2) * 256 + ch];
        float z2 = 0.f, z1 = 0.f;
        if (sb >= 1) z1 = (float)zp[-(ptrdiff_t)1792 + 512] * (float)zp[-(ptrdiff_t)1792];
        if (sb >= 2) z2 = (float)zp[-(ptrdiff_t)2 * 1792 + 512] * (float)zp[-(ptrdiff_t)2 * 1792];
#pragma unroll 1
        for (int t16 = 0; t16 < 32; t16 += 16) {
            h16 zx[16], zb[16], zc[16];
#pragma unroll
            for (int tt = 0; tt < 16; ++tt) { const h16* q = zp + (size_t)(t16 + tt) * 1792; zx[tt] = q[0]; zb[tt] = q[256]; zc[tt] = q[512]; }
#pragma unroll
            for (int tt = 0; tt < 16; ++tt) { const float z0 = (float)zc[tt] * (float)zx[tt];
                const float y = (float)zb[tt] * (cw0 * z2 + cw1 * z1 + cw2 * z0);
                F.B2[(size_t)(tb + t16 + tt) * 1024 + 768 + ch] = (bf16_t)f2bf(y); z2 = z1; z1 = z0; } }
    }
    __syncthreads();
    LAS float* accu = ubuf + half * 32 * 256 + ch;
    {
        const int grp = ch >> 6, d = ch & 63;
        const float* pw = F.in[16] + (((size_t)l * 4 + grp) * 64) * 64 + d;
        mv32<true>(accu, 0.f, pl + half * 32 * 256 + grp * 64, pw, 64);
        mv32<false>(accu, 0.f, pl + half * 32 * 256 + grp * 64 + 32, pw + 32 * 64, 64);
        const float sc = F.in[17][(size_t)l * 256 + ch];
#pragma unroll 4
        for (int tt = 0; tt < 32; ++tt) F.B2[(size_t)(tb + tt) * 1024 + 256 + ch] = (bf16_t)f2bf(accu[tt * 256] * sc);
    }
    __syncthreads();
    }
}

#define XB_TMO      128
#define XB_XCNT(j)  (256  + 64 * (j))
#define XB_XSUB(j)  (1280 + 64 * (j))
#define XB_XGEN(j)  (2304 + 64 * (j))
#define XB_TOP      3328
#define XB_TOPGEN   3392
#define XCD_BAR_WORDS 3456
#define XB_SPIN_CAP (1u << 18)

__device__ __forceinline__ unsigned xb_ld(unsigned* p)              { return __hip_atomic_load(p, __ATOMIC_RELAXED, __HIP_MEMORY_SCOPE_AGENT); }
__device__ __forceinline__ unsigned xb_add(unsigned* p, unsigned v) { return __hip_atomic_fetch_add(p, v, __ATOMIC_RELAXED, __HIP_MEMORY_SCOPE_AGENT); }
__device__ __forceinline__ unsigned xb_xcc_id() { return (unsigned)__builtin_amdgcn_s_getreg((3 << 11) | 20) & 0xFu; }
#define XB_SPIN(cond, bar) do { unsigned _sp = 0; while (cond) { __builtin_amdgcn_s_sleep(1); \
    if ((++_sp & 255u) == 0u) { if (xb_ld(&(bar)[XB_TMO])) break; if (_sp > XB_SPIN_CAP) { atomicAdd(&(bar)[XB_TMO], 1u); break; } } } } while (0)

struct XcdBarrier {
    unsigned* bar; unsigned x;
    volatile LAS unsigned* st;
};

__device__ __forceinline__ XcdBarrier xcd_barrier_post(unsigned* bar, volatile LAS unsigned* st) {
    XcdBarrier b; b.bar = bar; b.x = xb_xcc_id(); b.st = st;
    if (threadIdx.x == 0) (void)xb_add(&bar[XB_XCNT(b.x)], 1u);
    return b;
}
__device__ __forceinline__ void xcd_barrier_complete(unsigned* bar, unsigned x, unsigned& nloc, unsigned& nx) {
    const unsigned G = gridDim.x * gridDim.y * gridDim.z;
    unsigned sum, cnt, mine, sp = 0u;
    for (;;) {
        sum = 0u; cnt = 0u; mine = 0u;
#pragma unroll
        for (unsigned j = 0; j < 16; ++j) { const unsigned c = xb_ld(&bar[XB_XCNT(j)]); sum += c; cnt += (c > 0u) ? 1u : 0u; mine = (j == x) ? c : mine; }
        if (sum == G) break;
        __builtin_amdgcn_s_sleep(1);
        if ((++sp & 255u) == 0u) { if (xb_ld(&bar[XB_TMO])) break; if (sp > XB_SPIN_CAP) { atomicAdd(&bar[XB_TMO], 1u); break; } }
    }
    nloc = mine > 0u ? mine : 1u; nx = cnt > 0u ? cnt : 1u;
}

__device__ __forceinline__ void xcd_barrier(const XcdBarrier& b) {
    asm volatile("s_waitcnt vmcnt(0)" ::: "memory");
    __syncthreads();
    if (threadIdx.x == 0) {
        unsigned* bar = b.bar;
        __builtin_amdgcn_s_waitcnt(0);
        unsigned nloc = b.st[0], nx = b.st[1];
        if (nloc == 0u) { xcd_barrier_complete(bar, b.x, nloc, nx); b.st[0] = nloc; b.st[1] = nx; }
        const unsigned old = xb_add(&bar[XB_XSUB(b.x)], 1u);
        const unsigned gen = old / nloc;
        if (old + 1u == (gen + 1u) * nloc) {
            __builtin_amdgcn_fence(__ATOMIC_RELEASE, "agent");
            asm volatile("s_waitcnt vmcnt(0)" ::: "memory");
            const unsigned og = xb_add(&bar[XB_TOP], 1u);
            const unsigned tg = og / nx;
            if (og + 1u == (tg + 1u) * nx) xb_add(&bar[XB_TOPGEN], 1u);
            else XB_SPIN(xb_ld(&bar[XB_TOPGEN]) == tg, bar);
            __builtin_amdgcn_fence(__ATOMIC_ACQUIRE, "agent");
            xb_add(&bar[XB_XGEN(b.x)], 1u);
            asm volatile("s_waitcnt vmcnt(0)" ::: "memory");
        } else {
            XB_SPIN(xb_ld(&bar[XB_XGEN(b.x)]) == gen, bar);
            __builtin_amdgcn_fence(__ATOMIC_ACQUIRE, "agent");
            asm volatile("s_waitcnt vmcnt(0)" ::: "memory");
        }
    }
    __syncthreads();
}

__device__ __forceinline__ float a_fma(float a, float b, float c) { float d; asm("v_fma_f32 %0, %1, %2, %3" : "=v"(d) : "v"(a), "v"(b), "v"(c)); return d; }
__device__ __forceinline__ float a_fnma(float a, float b, float c) { float d; asm("v_fma_f32 %0, -%1, %2, %3" : "=v"(d) : "v"(a), "v"(b), "v"(c)); return d; }
__device__ __forceinline__ float a_mul(float a, float b) { float d; asm("v_mul_f32 %0, %1, %2" : "=v"(d) : "v"(a), "v"(b)); return d; }
__device__ __forceinline__ float a_add(float a, float b) { float d; asm("v_add_f32 %0, %1, %2" : "=v"(d) : "v"(a), "v"(b)); return d; }
constexpr int RC_LEN = 256, RC_N = SEQ / RC_LEN;
constexpr int ST_STEPS = 16, ST_FL = ST_STEPS * 384, ST_NPC = ST_STEPS * 56, ST_OB = ST_STEPS * 32 * 16, ST_NSUB = RC_LEN / ST_STEPS;
__device__ __forceinline__ void st_load(const unsigned char* src, int sub, int tid, u32x4 (&rg)[2]) {
#pragma unroll
    for (int n = 0; n < 2; ++n) { const int i = tid + NTHR * n; if (i < ST_NPC) { const int step = i / 56, j = i % 56;
        rg[n] = *(const u32x4*)(src + ((size_t)sub * ST_STEPS + step) * 896 + (j < 16 ? j * 16 : 256 + (j - 16) * 16)); } }
}
__device__ __forceinline__ void st_store(LAS float* buf, int tid, const u32x4 (&rg)[2]) {
#pragma unroll
    for (int n = 0; n < 2; ++n) { const int i = tid + NTHR * n; if (i < ST_NPC) { const int step = i / 56, j = i % 56;
        if (j < 16) { *(LAS u32x4*)(buf + step * 384 + j * 4) = rg[n]; }
        else { const int a = (j - 16) >> 3, e = (j - 16) & 7; const h16x8 h = __builtin_bit_cast(h16x8, rg[n]); f32x4 lo, hi;
            lo[0] = (float)h[0]; lo[1] = (float)h[1]; lo[2] = (float)h[2]; lo[3] = (float)h[3]; hi[0] = (float)h[4]; hi[1] = (float)h[5]; hi[2] = (float)h[6]; hi[3] = (float)h[7];
            LAS f32x4* d = (LAS f32x4*)(buf + step * 384 + 64 + a * 64 + e * 8); d[0] = lo; d[1] = hi; } } }
}
#define RAW_BAR() do { asm volatile("s_waitcnt lgkmcnt(0)" ::: "memory"); __builtin_amdgcn_s_barrier(); asm volatile("" ::: "memory"); } while (0)
#define DPP_ADD(x_, ctl_) "v_add_f32_dpp %[" x_ "], %[" x_ "], %[" x_ "] " ctl_ " row_mask:0xf bank_mask:0xf bound_ctrl:1\n\t"
template <bool OUT> __device__ __forceinline__ void scan_task(Frame& F, const unsigned char* src, int rowsel, const float* initS, bool ident, bool use_v, float* endS, float* Og) {
    LAS float* buf = (LAS float*)F.lds;
    LAS float* obuf = (LAS float*)(F.lds + 2 * ST_FL * 4);
    const int tid = F.tid, wave = F.wave, lane = F.lane;
    const int rl = wave * 4 + (lane >> 4), row = rowsel + rl, ks = lane & 15;
    float Sa = 0.f, Sb = 0.f, Sc = 0.f, Sd = 0.f;
    if (initS) { const f32x4 i4 = *(const f32x4*)(initS + (size_t)row * 64 + 4 * ks); Sa = i4[0]; Sb = i4[1]; Sc = i4[2]; Sd = i4[3]; }
    else if (ident) { Sa = (4 * ks + 0 == row) ? 1.f : 0.f; Sb = (4 * ks + 1 == row) ? 1.f : 0.f; Sc = (4 * ks + 2 == row) ? 1.f : 0.f; Sd = (4 * ks + 3 == row) ? 1.f : 0.f; }
    u32x4 rg[2][2];
    st_load(src, 0, tid, rg[0]); st_store(buf, tid, rg[0]); st_load(src, 1, tid, rg[1]); st_load(src, 2, tid, rg[0]);
    RAW_BAR();
#pragma unroll 1
    for (int sc2 = 0; sc2 < ST_NSUB; sc2 += 2) {
#pragma unroll
      for (int u = 0; u < 2; ++u) { const int sc = sc2 + u;
        if (sc + 1 < ST_NSUB) { st_store(buf + ((sc + 1) & 1) * ST_FL, tid, rg[(u + 1) & 1]); if (sc + 3 < ST_NSUB) st_load(src, sc + 3, tid, rg[(u + 1) & 1]); }
        {
            const LAS float* bb = buf + (sc & 1) * ST_FL + 4 * ks; const LAS float* vb = buf + (sc & 1) * ST_FL + 192 + row;
            LAS float* ob = obuf + (sc & 1) * ST_OB + rl * 16 + ks;
            f32x4 w_[2], r_[2], k_[2], kk_[2], b_[2]; float v_[2];
#define SC_LD(s_, j_) do { const LAS float* p_ = bb + (s_) * 384; w_[j_] = *(const LAS f32x4*)(p_); if (OUT) r_[j_] = *(const LAS f32x4*)(p_ + 64); k_[j_] = *(const LAS f32x4*)(p_ + 128); \
                kk_[j_] = *(const LAS f32x4*)(p_ + 256); b_[j_] = *(const LAS f32x4*)(p_ + 320); v_[j_] = vb[(s_) * 384]; } while (0)
            SC_LD(0, 0);
#pragma unroll
            for (int s = 0; s < ST_STEPS; ++s) { const int j = s & 1;
                f32x4 rp; if (OUT) rp = r_[j ^ 1];
                if (s + 1 < ST_STEPS) SC_LD(s + 1, j ^ 1);
                const f32x4 w = w_[j], k = k_[j], kk = kk_[j], bv = b_[j]; const float v = use_v ? v_[j] : 0.f;
                float sa, op, u0, u1, u2, u3;
                if (OUT && s > 0) {
                    asm volatile(
                        "v_mul_f32 %[sa], %[Sa], %[kk0]\n\t" "v_fma_f32 %[sa], %[Sb], %[kk1], %[sa]\n\t" "v_fma_f32 %[sa], %[Sc], %[kk2], %[sa]\n\t" "v_fma_f32 %[sa], %[Sd], %[kk3], %[sa]\n\t"
                        "v_mul_f32 %[op], %[Sa], %[r0]\n\t" "v_fma_f32 %[op], %[Sb], %[r1], %[op]\n\t"
                        DPP_ADD("sa", "quad_perm:[1,0,3,2]") "v_fma_f32 %[op], %[Sc], %[r2], %[op]\n\t" "v_fma_f32 %[op], %[Sd], %[r3], %[op]\n\t"
                        DPP_ADD("sa", "quad_perm:[2,3,0,1]") "v_mul_f32 %[u0], %[v], %[k0]\n\t" "v_mul_f32 %[u1], %[v], %[k1]\n\t"
                        DPP_ADD("sa", "row_half_mirror") "v_mul_f32 %[u2], %[v], %[k2]\n\t" "v_mul_f32 %[u3], %[v], %[k3]\n\t"
                        DPP_ADD("sa", "row_mirror")
                        : [sa] "=&v"(sa), [op] "=&v"(op), [u0] "=&v"(u0), [u1] "=&v"(u1), [u2] "=&v"(u2), [u3] "=&v"(u3)
                        : [Sa] "v"(Sa), [Sb] "v"(Sb), [Sc] "v"(Sc), [Sd] "v"(Sd), [kk0] "v"(kk[0]), [kk1] "v"(kk[1]), [kk2] "v"(kk[2]), [kk3] "v"(kk[3]),
                          [r0] "v"(rp[0]), [r1] "v"(rp[1]), [r2] "v"(rp[2]), [r3] "v"(rp[3]), [v] "v"(v), [k0] "v"(k[0]), [k1] "v"(k[1]), [k2] "v"(k[2]), [k3] "v"(k[3]));
                    ob[(s - 1) * 512] = op;
                } else {
                    asm volatile(
                        "v_mul_f32 %[sa], %[Sa], %[kk0]\n\t" "v_fma_f32 %[sa], %[Sb], %[kk1], %[sa]\n\t" "v_fma_f32 %[sa], %[Sc], %[kk2], %[sa]\n\t" "v_fma_f32 %[sa], %[Sd], %[kk3], %[sa]\n\t"
                        "v_mul_f32 %[u0], %[v], %[k0]\n\t" "v_mul_f32 %[u1], %[v], %[k1]\n\t"
                        DPP_ADD("sa", "quad_perm:[1,0,3,2]") "v_mul_f32 %[u2], %[v], %[k2]\n\t" "v_mul_f32 %[u3], %[v], %[k3]\n\t"
                        DPP_ADD("sa", "quad_perm:[2,3,0,1]") "s_nop 1\n\t"
                        DPP_ADD("sa", "row_half_mirror") "s_nop 1\n\t"
                        DPP_ADD("sa", "row_mirror")
                        : [sa] "=&v"(sa), [u0] "=&v"(u0), [u1] "=&v"(u1), [u2] "=&v"(u2), [u3] "=&v"(u3)
                        : [Sa] "v"(Sa), [Sb] "v"(Sb), [Sc] "v"(Sc), [Sd] "v"(Sd), [kk0] "v"(kk[0]), [kk1] "v"(kk[1]), [kk2] "v"(kk[2]), [kk3] "v"(kk[3]),
                          [v] "v"(v), [k0] "v"(k[0]), [k1] "v"(k[1]), [k2] "v"(k[2]), [k3] "v"(k[3]));
                }
                asm volatile(
                    "v_fma_f32 %[u0], -%[sa], %[b0], %[u0]\n\t" "v_fma_f32 %[u1], -%[sa], %[b1], %[u1]\n\t" "v_fma_f32 %[u2], -%[sa], %[b2], %[u2]\n\t" "v_fma_f32 %[u3], -%[sa], %[b3], %[u3]\n\t"
                    "v_fma_f32 %[Sa], %[Sa], %[w0], %[u0]\n\t" "v_fma_f32 %[Sb], %[Sb], %[w1], %[u1]\n\t" "v_fma_f32 %[Sc], %[Sc], %[w2], %[u2]\n\t" "v_fma_f32 %[Sd], %[Sd], %[w3], %[u3]\n\t"
                    : [Sa] "+v"(Sa), [Sb] "+v"(Sb), [Sc] "+v"(Sc), [Sd] "+v"(Sd), [u0] "+v"(u0), [u1] "+v"(u1), [u2] "+v"(u2), [u3] "+v"(u3)
                    : [sa] "v"(sa), [b0] "v"(bv[0]), [b1] "v"(bv[1]), [b2] "v"(bv[2]), [b3] "v"(bv[3]), [w0] "v"(w[0]), [w1] "v"(w[1]), [w2] "v"(w[2]), [w3] "v"(w[3]));
                __builtin_amdgcn_sched_barrier(0); }
            if (OUT) { const f32x4 r = r_[(ST_STEPS - 1) & 1];
              ob[(ST_STEPS - 1) * 512] = a_fma(Sd, r[3], a_fma(Sc, r[2], a_fma(Sb, r[1], a_mul(Sa, r[0])))); }
#undef SC_LD
        }
        RAW_BAR();
        if (OUT) {
            const LAS f32x4* p = (const LAS f32x4*)(obuf + (sc & 1) * ST_OB + tid * 16); const f32x4 a = p[0], b = p[1], c = p[2], d = p[3];
            const float o = (((a[0] + a[1]) + (a[2] + a[3])) + ((b[0] + b[1]) + (b[2] + b[3]))) + (((c[0] + c[1]) + (c[2] + c[3])) + ((d[0] + d[1]) + (d[2] + d[3])));
            Og[((size_t)sc * ST_STEPS + (tid >> 5)) * 256 + rowsel + (tid & 31)] = o; }
      }
    }
    if (endS) *(f32x4*)(endS + (size_t)row * 64 + 4 * ks) = (f32x4){Sa, Sb, Sc, Sd};
    RAW_BAR();
}
#undef DPP_ADD
__device__ __forceinline__ void rwkv_carry(Frame& F) {
    const int hb = F.bx >> 3, row = (F.bx & 7) * 8 + F.wave, lane = F.lane, tid = F.tid;
    LAS float* Pl = (LAS float*)F.lds;
    LAS float* Sl = (LAS float*)(F.lds + 16384) + F.wave * 64;
    float S = 0.f;
#pragma unroll 1
    for (int c = 0; c < RC_N; ++c) { const size_t mo = ((size_t)hb * RC_N + c) * 4096;
        F.SB[mo + (size_t)row * 64 + lane] = S;
        if (c + 1 == RC_N) break;
        const f32x4 p0 = *(const f32x4*)(F.PB + mo + (size_t)tid * 8), p1 = *(const f32x4*)(F.PB + mo + (size_t)tid * 8 + 4);
        float acc = F.LB[mo + (size_t)row * 64 + lane];
        *(LAS f32x4*)(Pl + tid * 8) = p0; *(LAS f32x4*)(Pl + tid * 8 + 4) = p1; Sl[lane] = S;
        __syncthreads();
#pragma unroll 16
        for (int j = 0; j < 64; ++j) acc += Sl[j] * Pl[j * 64 + lane];
        S = acc;
        __syncthreads();
    }
}
__device__ __forceinline__ float gelu_tanh(float x) { const float u = 0.7978845608028654f * (x + 0.044715f * x * x * x); return 0.5f * x * (1.0f + tanhf(u)); }
__device__ __forceinline__ void s5_pass2(Frame& F, int l, int c) {
    LAS float* ubuf = (LAS float*)F.lds;
    LAS float* ybuf = (LAS float*)(F.lds + 65536);
    const int t0 = c * 64, lane = F.lane, wave = F.wave, cb0 = c & ~127;
    load_u5_tile(F, t0, ubuf);
    __syncthreads();
#pragma unroll 1
    for (int gi = 0; gi < 2; ++gi) { const int g = wave + 8 * gi; S5Par P; s5_params(F, l, g, lane, P);
        float cr[16], ci[16]; int lane_l = lane; asm volatile("" : "+v"(lane_l));
#pragma unroll
        for (int hh = 0; hh < 16; ++hh) { cr[hh] = F.in[12][(((size_t)l * 16 + g) * 16 + hh) * 64 + lane_l]; ci[hh] = F.in[13][(((size_t)l * 16 + g) * 16 + hh) * 64 + lane_l]; }
        float pr = P.ar, pi = P.ai;
#pragma unroll
        for (int s = 0; s < 6; ++s) { const float nr = pr * pr - pi * pi, ni = 2.0f * pr * pi; pr = nr; pi = ni; }
        float hr = 0.f, hi = 0.f;
#pragma unroll 2
        for (int c2 = cb0; c2 < c; ++c2) { const f32x2 e = *(const f32x2*)(F.E + (((size_t)c2 * 16 + g) * 64 + lane) * 2);
            const float nr = pr * hr - pi * hi + e[0], ni = pr * hi + pi * hr + e[1]; hr = nr; hi = ni; }
        const bool b3 = (lane & 8) != 0, b2 = (lane & 4) != 0, b1 = (lane & 2) != 0, b0 = (lane & 1) != 0;
#pragma unroll 1
        for (int j = 0; j < 64; ++j) { s5_step(P, ubuf + j * 256 + g * 16, hr, hi);
            float v8[8], v4[4], v2[2];
#pragma unroll
            for (int i = 0; i < 8; ++i) { const float lo = hr * cr[i] - hi * ci[i], hv = hr * cr[i + 8] - hi * ci[i + 8];
                const float keep = b3 ? hv : lo, send = b3 ? lo : hv; v8[i] = keep + dppx<0x140>(send); }
#pragma unroll
            for (int i = 0; i < 4; ++i) { const float keep = b2 ? v8[i + 4] : v8[i], send = b2 ? v8[i] : v8[i + 4]; v4[i] = keep + dppx<0x141>(send); }
#pragma unroll
            for (int i = 0; i < 2; ++i) { const float keep = b1 ? v4[i + 2] : v4[i], send = b1 ? v4[i] : v4[i + 2]; v2[i] = keep + dppx<0x4E>(send); }
            float y = (b0 ? v2[1] : v2[0]) + dppx<0xB1>(b0 ? v2[0] : v2[1]);
            y += __shfl_xor(y, 16); y += __shfl_xor(y, 32);
            if (lane < 16) ybuf[j * 256 + g * 16 + lane] = y; }
    }
    __syncthreads();
    { const int ch = F.tid & 255, half = F.tid >> 8; const float dd = F.in[14][(size_t)l * 256 + ch];
        for (int tt = 0; tt < 32; ++tt) { const int tl = half * 32 + tt; const float y = ybuf[tl * 256 + ch] + dd * ubuf[tl * 256 + ch];
            F.GL[(size_t)(t0 + tl) * 256 + ch] = (bf16_t)f2bf(gelu_tanh(y)); } }
    __syncthreads();
}
template <int PART> __device__ __forceinline__ void m2_phase(Frame& F, int l, const XcdBarrier& xbar) {
#pragma unroll 1
    for (int id = F.bx; id < 8 * RC_N * 4; id += F.G) { const int hb = id >> 7, c = (id >> 2) & (RC_N - 1), tk = id & 3; const size_t mo = ((size_t)hb * RC_N + c) * 4096;
        const unsigned char* src = F.RW + ((size_t)hb * SEQ + (size_t)c * RC_LEN) * 896;
        scan_task<false>(F, src, (tk & 1) * 32, nullptr, tk >= 2, tk < 2, (tk < 2 ? F.LB : F.PB) + mo, nullptr); }
#pragma unroll 1
    for (int c = F.bx; c < TT / 64; c += F.G) pool_conv_chunk(F, l, c);
    xcd_barrier(xbar);
    { int bxs = F.bx; asm volatile("" : "+s"(bxs));
      if (bxs < 64) rwkv_carry(F);
      else { for (int c = F.bx - 64; c < TT / 64; c += F.G - 64) s5_pass2(F, l, c); } }
    xcd_barrier(xbar);
#pragma unroll 1
    for (int id = F.bx; id < 8 * RC_N * 2; id += F.G) { const int hb = id >> 6, c = (id >> 1) & (RC_N - 1), tk = id & 1; const size_t mo = ((size_t)hb * RC_N + c) * 4096;
        const unsigned char* src = F.RW + ((size_t)hb * SEQ + (size_t)c * RC_LEN) * 896;
        float* Og = F.O + ((size_t)(hb >> 2) * SEQ + (size_t)c * RC_LEN) * 256 + (hb & 3) * 64;
        scan_task<true>(F, src, tk * 32, F.SB + mo, false, true, nullptr, Og); }
    conv_second_half(F, l, 0);
}
__device__ __forceinline__ void rwkv_post(Frame& F, int l) {
    const int gw = F.bx * NWAVES + F.wave, NGW = F.G * NWAVES, lane = F.lane;
    for (int it0 = gw * 4; it0 < TT * 4; it0 += NGW * 4) {
        const int t = it0 >> 2, b = t / SEQ, pos = t & (SEQ - 1);
        float o[4], r[4], k[4], v[4], g[4];
#pragma unroll
        for (int hh = 0; hh < 4; ++hh) { const int c = hh * 64 + lane; o[hh] = F.O[(size_t)t * 256 + c]; g[hh] = (float)F.G16[(size_t)t * 256 + c];
            const h16* rw = (const h16*)(F.RW + ((size_t)(b * 4 + hh) * SEQ + pos) * 896 + 256) + lane; r[hh] = (float)rw[0]; k[hh] = (float)rw[64]; v[hh] = (float)rw[128]; }
#pragma unroll
        for (int hh = 0; hh < 4; ++hh) { const int c = hh * 64 + lane;
            const float mu = wave_sum(o[hh]) * (1.0f / 64.0f); const float d = o[hh] - mu; const float var = wave_sum(d * d) * (1.0f / 64.0f);
            const float on = d * rsqrtf(var + 64e-5f) * F.in[31][(size_t)l * 256 + c] + F.in[32][(size_t)l * 256 + c];
            const float bs = wave_sum(r[hh] * k[hh] * F.in[30][(size_t)l * 256 + c]);
            F.B2[(size_t)t * 1024 + 512 + c] = (bf16_t)f2bf((on + bs * v[hh]) * g[hh]); }
    }
}

constexpr int NPH = 25;
#ifndef PHMASK
#define PHMASK 0xFFFF
#endif
#define PHON(k) (((PHMASK) >> (k)) & 1)
#ifndef REP_PART
#define REP_PART 0
#endif
template <int PH, int PART = 0> __device__ __forceinline__ void run_phase(const int wave_s, unsigned char* lds_raw, const XcdBarrier& xbar) {
    typedef pg8::StaticOrder SO;
    int tid = wave_s * 64 + (int)__builtin_amdgcn_mbcnt_hi(~0u, __builtin_amdgcn_mbcnt_lo(~0u, 0u)); asm volatile("" : "+v"(tid));
    int G = gridDim.x, bx = blockIdx.x; asm volatile("" : "+s"(G), "+s"(bx));
    const __attribute__((address_space(4))) unsigned char* ka = (const __attribute__((address_space(4))) unsigned char*)__builtin_amdgcn_kernarg_segment_ptr();
    asm volatile("" : "+s"(ka));
    const __attribute__((address_space(4))) Args* ap = (const __attribute__((address_space(4))) Args*)ka;
    Frame F;
    F.lds = (LAS unsigned char*)lds_raw;
    F.tid = tid; F.lane = tid & 63; F.wave = __builtin_amdgcn_readfirstlane(tid >> 6); F.G = G; F.bx = bx;
    F.in = (in_t)ka; F.X = ap->out; F.ws = ap->ws;
    unsigned char* ws = F.ws;
    F.SS = (float*)(ws + WS_SS); F.E = (float*)(ws + WS_E); F.B1 = (bf16_t*)(ws + WS_B1); F.B2 = (bf16_t*)(ws + WS_B2);
    unsigned char* z = ws + WS_Z;
    F.HID = (bf16_t*)(z + Z_HID); F.GL = (bf16_t*)(z + Z_GL); F.U5 = (h16*)(z + Z_U5); F.PP = (h16*)(z + Z_PP); F.L16 = (h16*)(z + Z_L16); F.G16 = (h16*)(z + Z_G16); F.R = (h16*)(z + Z_R);
    F.O = (float*)(z + Z_O); F.RW = z + Z_RW; F.PB = (float*)(z + Z_PB); F.LB = (float*)(z + Z_LB); F.SB = (float*)(z + Z_SB);
    if constexpr (PH == 0) { conv_first_half(F, 0); prep_x(F); }
    else { constexpr int l = (PH - 1) / 12, k = (PH - 1) % 12;
        if constexpr (k == 0) { pg8::Gemm g{F.B1, (const bf16_t*)(ws + WS_W + W_GU1), TT, 2 * FF, DM, 1}; SO S; S.init(TT, 2 * FF, G, bx); pg8::EpiGU E{F.HID, F.SS}; pg8::gemm_phase<pg8::EpiGU, SO, true, true>(F.lds, g, S, E, tid); }
        else if constexpr (k == 1) { pg8::Gemm g{F.HID, (const bf16_t*)(ws + WS_W + W_D1), TT, DM, FF, 1}; SO S; S.init(TT, DM, G, bx); pg8::EpiDown E{l == 0 ? F.in[0] : F.X, F.X, F.B1, F.SS, 0.5f}; pg8::gemm_phase<pg8::EpiDown, SO, true, true>(F.lds, g, S, E, tid); }
        else if constexpr (k == 2) { pg8::Gemm g{F.B1, (const bf16_t*)(ws + WS_W + W_INA), TT, 2560, DM, 1}; SO S; S.init(TT, 2560, G, bx); pg8::EpiInA E{F.U5, F.PP, F.L16, F.SS}; pg8::gemm_phase<pg8::EpiInA, SO, true, true>(F.lds, g, S, E, tid); }
        else if constexpr (k == 3) { m1_phase(F, l); }
        else if constexpr (k == 4) { m2_phase<PART>(F, l, xbar); }
        else if constexpr (k == 5) { { pg8::Gemm g{F.GL, (const bf16_t*)(ws + WS_W + W_GLU), TT, 256, 256, 1}; SO S; S.init(TT, 256, G, bx); pg8::EpiGlu E{F.GL, F.B2}; pg8::gemm_phase<pg8::EpiGlu, SO, true, true>(F.lds, g, S, E, tid); } rwkv_post(F, l); }
        else if constexpr (k == 6) { pg8::Gemm g{F.B1, (const bf16_t*)(ws + WS_W + W_ING), TT, 4096, DM, 1}; SO S; S.init(TT, 4096, G, bx); pg8::EpiGate E{F.R, F.SS}; pg8::gemm_phase<pg8::EpiGate, SO, true, true>(F.lds, g, S, E, tid); }
        else if constexpr (k == 7) { pg8::Gemm g{F.B2, (const bf16_t*)(ws + WS_W + W_BR), TT, DM, DM, 4}; pg8::SegOrder4 S; S.so.init(TT, DM, G, bx); pg8::EpiBranch E{F.R, F.B1}; pg8::gemm_phase<pg8::EpiBranch, pg8::SegOrder4, true, true>(F.lds, g, S, E, tid); }
        else if constexpr (k == 8) { pg8::Gemm g{F.B1, (const bf16_t*)(ws + WS_W + W_O), TT, DM, DM, 1}; SO S; S.init(TT, DM, G, bx); pg8::EpiDown E{F.X, F.X, F.B2, F.SS, 1.0f}; pg8::gemm_phase<pg8::EpiDown, SO, true, true>(F.lds, g, S, E, tid); }
        else if constexpr (k == 9) { pg8::Gemm g{F.B2, (const bf16_t*)(ws + WS_W + W_GU2), TT, 2 * FF, DM, 1}; SO S; S.init(TT, 2 * FF, G, bx); pg8::EpiGU E{F.HID, F.SS}; pg8::gemm_phase<pg8::EpiGU, SO, true, true>(F.lds, g, S, E, tid); }
        else if constexpr (k == 10) { pg8::Gemm g{F.HID, (const bf16_t*)(ws + WS_W + W_D2), TT, DM, FF, 1}; SO S; S.init(TT, DM, G, bx); pg8::EpiDown E{F.X, F.X, F.B1, F.SS, 0.5f}; pg8::gemm_phase<pg8::EpiDown, SO, true, true>(F.lds, g, S, E, tid); }
        else { if constexpr (l == 0) conv_first_half(F, 1); else final_norm(F); }
    }
}
#ifndef REPMASK
#define REPMASK 0
#endif
#define SEAM(k_) do { if ((k_) == 0) { __syncthreads(); cg::this_grid().sync(); } else xcd_barrier(xbar); } while (0)
#define PHASE(k) if (ph_lo <= (k) && (k) < ph_hi) { run_phase<(k)>(wave_s, lds_raw, xbar); \
    if ((k) >= 1 && ((REPMASK >> (((k) - 1) % 12)) & 1)) { SEAM(k); run_phase<(k), REP_PART>(wave_s, lds_raw, xbar); } \
    if ((k) + 1 < ph_hi) SEAM(k); }
__global__ void __launch_bounds__(NTHR, 2) mk_fwd(Args args) {
    extern __shared__ __attribute__((aligned(16))) unsigned char lds_raw[];
    const int ph_lo = args.ph_lo, ph_hi = args.ph_hi;
    volatile LAS unsigned* xst = (volatile LAS unsigned*)((LAS unsigned char*)lds_raw + (LDS_BYTES - 64));
    if (threadIdx.x == 0) { xst[0] = 0u; xst[1] = 0u; }
    __syncthreads();
    const XcdBarrier xbar = xcd_barrier_post((unsigned*)(args.ws + WS_CTL), xst);
    const int wave_s = __builtin_amdgcn_readfirstlane((int)threadIdx.x >> 6);
    PHASE(0) PHASE(1) PHASE(2) PHASE(3) PHASE(4) PHASE(5) PHASE(6) PHASE(7) PHASE(8) PHASE(9) PHASE(10) PHASE(11) PHASE(12)
    PHASE(13) PHASE(14) PHASE(15) PHASE(16) PHASE(17) PHASE(18) PHASE(19) PHASE(20) PHASE(21) PHASE(22) PHASE(23) PHASE(24)
}

extern "C" void kernel_launch(void* const* d_in, const int* in_sizes, int n_in, void* d_out, int out_size, void* d_ws, size_t ws_size, hipStream_t stream) {
    static int grid = 0;
    if (grid == 0) {
        if (n_in != 41 || out_size != TT * DM || ws_size < WS_END) { fprintf(stderr, "kernel_launch: unexpected shapes (n_in %d out %d ws %zu)\n", n_in, out_size, ws_size); grid = -1; return; }
        int dev = 0, cus = 0, per_cu = 0;
        (void)hipGetDevice(&dev); (void)hipDeviceGetAttribute(&cus, hipDeviceAttributeMultiprocessorCount, dev);
        if (hipFuncSetAttribute((const void*)mk_fwd, hipFuncAttributeMaxDynamicSharedMemorySize, LDS_BYTES) != hipSuccess) { fprintf(stderr, "kernel_launch: hipFuncSetAttribute failed\n"); grid = -1; return; }
        if (hipOccupancyMaxActiveBlocksPerMultiprocessor(&per_cu, (const void*)mk_fwd, NTHR, LDS_BYTES) != hipSuccess || per_cu < 1) { fprintf(stderr, "kernel_launch: occupancy query says %d\n", per_cu); per_cu = 1; }
        (void)hipGetLastError();
        grid = cus * (per_cu >= 1 ? 1 : 1);
        if (grid < 64) { fprintf(stderr, "kernel_launch: grid %d too small\n", grid); }
    }
    if (grid < 0) return;
    if (hipMemsetAsync((char*)d_ws + WS_CTL, 0, CTL_ZERO_BYTES, stream) != hipSuccess) { fprintf(stderr, "kernel_launch: hipMemsetAsync failed\n"); return; }
    Args a{};
    for (int i = 0; i < 41; ++i) a.in[i] = (const float*)d_in[i];
    a.out = (float*)d_out; a.ws = (unsigned char*)d_ws;
#if ONE_LAUNCH
    a.ph_lo = 0; a.ph_hi = NPH;
    void* kargs[] = {&a};
    hipError_t e = hipLaunchCooperativeKernel((const void*)mk_fwd, dim3(grid), dim3(NTHR), kargs, LDS_BYTES, stream);
    if (e != hipSuccess) fprintf(stderr, "cooperative launch failed: %s (grid %d)\n", hipGetErrorString(e), grid);
#else
    for (int ph = 0; ph < NPH; ++ph) { a.ph_lo = ph; a.ph_hi = ph + 1; hipLaunchKernelGGL(mk_fwd, dim3(grid), dim3(NTHR), LDS_BYTES, stream, a); }
#endif
}
```

```cpp
#include <hip/hip_runtime.h>
#include <hip/hip_cooperative_groups.h>
#include <cstdio>
#include <cstdint>
#include <cstddef>
namespace cg = cooperative_groups;
namespace pg8 {
#define PG8_LAS __attribute__((address_space(3)))
typedef unsigned short bf16_t;
typedef short bf16x8 __attribute__((ext_vector_type(8)));
typedef float f32x4 __attribute__((ext_vector_type(4)));
typedef unsigned u32x4 __attribute__((ext_vector_type(4)));
constexpr int BM = 256, BK = 64, HALF = 128, HTB = HALF * BK * 2  , STAGE_BYTES = 8 * HTB, NXCD = 8, WGM = 8;

__host__ __device__ __forceinline__ int lds_byte(int r, int c) { const int st = (r >> 4) * 2 + (c >> 5), rr = r & 15, cc = c & 31, ob = rr * 64 + cc * 2; return st * 1024 + (ob ^ (((ob >> 9) & 1) << 5)); }
__host__ __device__ __forceinline__ void stage_rc(int b, int& R, int& C) { const int st = b / 1024, sb = b % 1024, swz = sb ^ (((sb >> 9) & 1) << 5); R = (st >> 1) * 16 + swz / 64; C = (st & 1) * 32 + (swz % 64) / 2; }
__host__ __device__ __forceinline__ int perm32(int rho) { const int n = rho >> 4, i = rho & 15; return 8 * (i >> 2) + 4 * n + (i & 3); }

struct Unit { int pm, pn, g; };
struct Gemm { const bf16_t* A; const bf16_t* Bt; int M, N, K, nseg; };

struct StaticOrder {
    int nM, nN, nwg, G, c;
    __host__ __device__ void init(int M, int N, int G_, int c_) { nM = M / BM; nN = N / BM; nwg = nM * nN; G = G_; c = c_; }
    __host__ __device__ bool next(int i, Unit& u) const {
        const long L = (long)i * G + c; if (L >= nwg) return false;
        int wgid = (int)L; { const int q = nwg / NXCD, r = nwg % NXCD, xcd = wgid % NXCD, off = wgid / NXCD; wgid = (xcd < r ? xcd * (q + 1) : r * (q + 1) + (xcd - r) * q) + off; }
        const int nig = WGM * nN, gid = wgid / nig, fm = gid * WGM, gsz = (nM - fm) < WGM ? (nM - fm) : WGM;
        u.pm = fm + ((wgid % nig) % gsz); u.pn = (wgid % nig) / gsz; u.g = 0; return true;
    }
    __device__ __forceinline__ void a_ready(const Unit&) const {}
    __device__ __forceinline__ void done(const Unit&) const {}
};


struct SegOrder4 {
    StaticOrder so;
    __host__ __device__ bool next(int i, Unit& u) const { if (!so.next(i >> 2, u)) return false; u.g = i & 3; return true; }
    __device__ __forceinline__ void a_ready(const Unit&) const {}
    __device__ __forceinline__ void done(const Unit&) const {}
};

typedef _Float16 h16;
typedef _Float16 h16x4 __attribute__((ext_vector_type(4)));
typedef unsigned u32x2 __attribute__((ext_vector_type(2)));
__device__ __forceinline__ unsigned cvt_pk_bf16(float lo, float hi) { unsigned r; asm volatile("v_cvt_pk_bf16_f32 %0, %1, %2" : "=v"(r) : "v"(lo), "v"(hi)); return r; }
__device__ __forceinline__ u32x2 pack_bf16x4(f32x4 v) { u32x2 w; w.x = cvt_pk_bf16(v[0], v[1]); w.y = cvt_pk_bf16(v[2], v[3]); return w; }
__device__ __forceinline__ h16x4 pack_h16x4(f32x4 v) { h16x4 w; w[0] = (h16)v[0]; w[1] = (h16)v[1]; w[2] = (h16)v[2]; w[3] = (h16)v[3]; return w; }
__device__ __forceinline__ float fast_sigmoid(float x) { return __builtin_amdgcn_rcpf(1.0f + __expf(-x)); }
__device__ __forceinline__ float row_rstd(const float* SS, int row) {
    const f32x4* p = (const f32x4*)(SS + (size_t)row * 16);
    const f32x4 a = p[0], b = p[1], c = p[2], d = p[3];
    const float s = ((a[0] + a[1]) + (a[2] + a[3])) + ((b[0] + b[1]) + (b[2] + b[3])) + ((c[0] + c[1]) + (c[2] + c[3])) + ((d[0] + d[1]) + (d[2] + d[3]));
    return rsqrtf(s * (1.0f / 1024.0f) + 1e-6f);
}

struct EpiGU {
    static constexpr bool PERM = true, KSEG = false;
    bf16_t* hid; const float* SS;
    __device__ __forceinline__ void operator()(const f32x4 (&acc)[2][2][4][2], const Unit& u, int wr, int wc, int fr, int fq) const {
        int row0 = u.pm * BM + wr * 64 + fr; asm volatile("" : "+v"(row0)); const int j0 = u.pn * 128 + wc * 16 + fq * 4;
#pragma unroll
        for (int ai = 0; ai < 2; ++ai)
#pragma unroll
            for (int m = 0; m < 4; ++m) { const int row = row0 + ai * HALF + m * 16; const float rs = row_rstd(SS, row);
#pragma unroll
                for (int bj = 0; bj < 2; ++bj) { const f32x4 g = acc[ai][bj][m][0] * rs, up = acc[ai][bj][m][1] * rs; f32x4 h;
#pragma unroll
                    for (int i = 0; i < 4; ++i) h[i] = g[i] * fast_sigmoid(g[i]) * up[i];
                    *(u32x2*)(hid + (size_t)row * 2816 + j0 + bj * 64) = pack_bf16x4(h); } }
    }
};
struct EpiDown {
    static constexpr bool PERM = false, KSEG = false;
    const float* res; float* X; bf16_t* xb; float* SS; float alpha;
    __device__ __forceinline__ void operator()(const f32x4 (&acc)[2][2][4][2], const Unit& u, int wr, int wc, int fr, int fq) const {
        int row0 = u.pm * BM + wr * 64 + fr; asm volatile("" : "+v"(row0)); const int c0 = u.pn * BM + wc * 32 + fq * 4;
#pragma unroll
        for (int ai = 0; ai < 2; ++ai)
#pragma unroll
            for (int m = 0; m < 4; ++m) { const int row = row0 + ai * HALF + m * 16; float ss = 0.f;
#pragma unroll
                for (int bj = 0; bj < 2; ++bj)
#pragma unroll
                    for (int n = 0; n < 2; ++n) { const size_t off = (size_t)row * 1024 + c0 + bj * HALF + n * 16;
                        const f32x4 r = *(const f32x4*)(res + off); const f32x4 o = r + acc[ai][bj][m][n] * alpha;
                        *(f32x4*)(X + off) = o; *(u32x2*)(xb + off) = pack_bf16x4(o);
                        ss += (o[0] * o[0] + o[1] * o[1]) + (o[2] * o[2] + o[3] * o[3]); }
                ss += __shfl_xor(ss, 16); ss += __shfl_xor(ss, 32);
                if (fq == 0) SS[(size_t)row * 16 + u.pn * 4 + wc] = ss;
                asm volatile("" ::: "memory"); }
    }
};
struct EpiInA {
    static constexpr bool PERM = false, KSEG = false;
    h16* U5; h16* PP; h16* L16; const float* SS;
    __device__ __forceinline__ void operator()(const f32x4 (&acc)[2][2][4][2], const Unit& u, int wr, int wc, int fr, int fq) const {
        int row0 = u.pm * BM + wr * 64 + fr; asm volatile("" : "+v"(row0)); const int cl = wc * 32 + fq * 4;
        h16* base; int ld, cb;
        if (u.pn == 0) { base = U5; ld = 256; cb = 0; } else if (u.pn < 8) { base = PP; ld = 1792; cb = (u.pn - 1) * 256; } else { base = L16; ld = 512; cb = (u.pn - 8) * 256; }
#pragma unroll
        for (int ai = 0; ai < 2; ++ai)
#pragma unroll
            for (int m = 0; m < 4; ++m) { const int row = row0 + ai * HALF + m * 16; const float rs = row_rstd(SS, row);
#pragma unroll
                for (int bj = 0; bj < 2; ++bj)
#pragma unroll
                    for (int n = 0; n < 2; ++n) *(h16x4*)(base + (size_t)row * ld + cb + cl + bj * HALF + n * 16) = pack_h16x4(acc[ai][bj][m][n] * rs); }
    }
};
struct EpiGate {
    static constexpr bool PERM = false, KSEG = false;
    h16* R; const float* SS;
    __device__ __forceinline__ void operator()(const f32x4 (&acc)[2][2][4][2], const Unit& u, int wr, int wc, int fr, int fq) const {
        int row0 = u.pm * BM + wr * 64 + fr; asm volatile("" : "+v"(row0)); const int d0 = 256 * (u.pn >> 2) + 128 * ((u.pn >> 1) & 1) + 16 * (u.pn & 1) + 32 * wc + 4 * fq;
#pragma unroll
        for (int ai = 0; ai < 2; ++ai)
#pragma unroll
            for (int m = 0; m < 4; ++m) { const int row = row0 + ai * HALF + m * 16; const float rs = row_rstd(SS, row);
                f32x4 e[4];
#pragma unroll
                for (int g = 0; g < 4; ++g)
#pragma unroll
                    for (int i = 0; i < 4; ++i) e[g][i] = 1.0f + __expf(-fminf(fmaxf(acc[ai][g >> 1][m][g & 1][i] * rs, -10.f), 30.f));
                f32x4 r[4];
#pragma unroll
                for (int i = 0; i < 4; ++i) { const float i0 = __builtin_amdgcn_rcpf(e[0][i]), i1 = __builtin_amdgcn_rcpf(e[1][i]), i2 = __builtin_amdgcn_rcpf(e[2][i]), i3 = __builtin_amdgcn_rcpf(e[3][i]);
                    r[0][i] = e[1][i] * i0; r[1][i] = e[2][i] * i1; r[2][i] = e[3][i] * i2; r[3][i] = i3; }
#pragma unroll
                for (int g = 0; g < 4; ++g) *(h16x4*)(R + ((size_t)row * 4 + g) * 1024 + d0) = pack_h16x4(r[g]); }
    }
};
struct EpiBranch {
    static constexpr bool PERM = false, KSEG = true;
    const h16* R; bf16_t* out;
    __device__ __forceinline__ void operator()(f32x4 (&acc)[2][2][4][2], const Unit& u, int wr, int wc, int fr, int fq) const {
        unsigned q0 = (unsigned)(u.pm * BM + wr * 64 + fr) * 1024u + (unsigned)(u.pn * BM + wc * 32 + fq * 4); asm volatile("" : "+v"(q0));
        const unsigned r0 = (q0 - (q0 & 1023u)) * 4u + (unsigned)u.g * 1024u + (q0 & 1023u);
        const bool last = u.g == 3;
#pragma unroll
        for (int ai = 0; ai < 2; ++ai)
#pragma unroll
            for (int m = 0; m < 4; ++m) {
#pragma unroll
                for (int bj = 0; bj < 2; ++bj)
#pragma unroll
                    for (int n = 0; n < 2; ++n) { const unsigned off = q0 + (unsigned)((ai * HALF + m * 16) * 1024 + bj * HALF + n * 16);
                        const h16x4 r = *(const h16x4*)(R + (r0 + (unsigned)((ai * HALF + m * 16) * 4096 + bj * HALF + n * 16)));
                        f32x4 rf; rf[0] = (float)r[0]; rf[1] = (float)r[1]; rf[2] = (float)r[2]; rf[3] = (float)r[3];
                        acc[ai][bj][m][n] = acc[ai][bj][m][n] * rf;
                        if (last) *(u32x2*)(out + off) = pack_bf16x4(acc[ai][bj][m][n]); }
                asm volatile("" ::: "memory"); }
    }
};
struct EpiGlu {
    static constexpr bool PERM = false, KSEG = false;
    const bf16_t* gl; bf16_t* ys;
    __device__ __forceinline__ void operator()(const f32x4 (&acc)[2][2][4][2], const Unit& u, int wr, int wc, int fr, int fq) const {
        int row0 = u.pm * BM + wr * 64 + fr; asm volatile("" : "+v"(row0)); const int c0 = wc * 32 + fq * 4;
#pragma unroll
        for (int ai = 0; ai < 2; ++ai)
#pragma unroll
            for (int m = 0; m < 4; ++m) { const int row = row0 + ai * HALF + m * 16;
#pragma unroll
                for (int bj = 0; bj < 2; ++bj)
#pragma unroll
                    for (int n = 0; n < 2; ++n) { const int c = c0 + bj * HALF + n * 16; const u32x2 gv = *(const u32x2*)(gl + (size_t)row * 256 + c);
                        f32x4 g; g[0] = __uint_as_float(gv.x << 16); g[1] = __uint_as_float(gv.x & 0xffff0000u); g[2] = __uint_as_float(gv.y << 16); g[3] = __uint_as_float(gv.y & 0xffff0000u);
                        f32x4 o;
#pragma unroll
                        for (int i = 0; i < 4; ++i) o[i] = g[i] * fast_sigmoid(acc[ai][bj][m][n][i]);
                        *(u32x2*)(ys + (size_t)row * 1024 + c) = pack_bf16x4(o); }
                asm volatile("" ::: "memory"); }
    }
};

template <class Epi, class Sched, bool ALIGN_EPI = false, bool SP2 = false>
__device__ __forceinline__ void gemm_phase(PG8_LAS unsigned char* lds, const Gemm g, const Sched& S, const Epi& E, const int tid) {
    const int wid = __builtin_amdgcn_readfirstlane(tid >> 6), lane = tid & 63, wr = wid >> 2, wc = wid & 3, fr = lane & 15, fq = lane >> 4;
    const int K = g.K, nt = K / BK / g.nseg; const size_t segb = (size_t)(K / g.nseg) * 2;
    unsigned voffA[2], voffB[2];
#pragma unroll
    for (int i = 0; i < 2; ++i) { int R, C; stage_rc(tid * 16 + i * 8192, R, C); const int Rb = Epi::PERM ? ((R & ~31) + perm32(R & 31)) : R;
        voffA[i] = (unsigned)(R * K + C) * 2u; voffB[i] = (unsigned)(Rb * K + C) * 2u; }
    const size_t kstep = (size_t)(BK * 2);
    const size_t hstep = (size_t)HALF * K * 2;
    const size_t tstep = 2 * hstep;
    const unsigned ldsw = (unsigned)wid * 1024u;
    const int aoff = lds_byte(wr * 64 + fr, fq * 8), boff = lds_byte(wc * 32 + fr, fq * 8);
#define PG8_SA(b, h) (((b) * 2 + (h)) * HTB)
#define PG8_SB(b, h) ((4 + (b) * 2 + (h)) * HTB)
#define PG8_STAGE(bufoff, gbase, voff) do { _Pragma("unroll") for (int _i = 0; _i < 2; ++_i) \
        __builtin_amdgcn_global_load_lds((const unsigned*)((const char*)(gbase) + (voff)[_i]), (PG8_LAS unsigned*)(lds + (bufoff) + ldsw + _i * 8192), 16, 0, 0); } while (0)
#define PG8_LDA(dst, b, h) do { _Pragma("unroll") for (int m = 0; m < 4; ++m) _Pragma("unroll") for (int k = 0; k < 2; ++k) dst[m][k] = *(const PG8_LAS bf16x8*)(lds + PG8_SA(b, h) + aoff + m * 2048 + k * 1024); } while (0)
#define PG8_LDB(dst, b, h) do { _Pragma("unroll") for (int n = 0; n < 2; ++n) _Pragma("unroll") for (int k = 0; k < 2; ++k) dst[n][k] = *(const PG8_LAS bf16x8*)(lds + PG8_SB(b, h) + boff + n * 2048 + k * 1024); } while (0)
#define PG8_MMA(ai, bj, At, Bt) do { __builtin_amdgcn_s_setprio(1); _Pragma("unroll") for (int m = 0; m < 4; ++m) _Pragma("unroll") for (int n = 0; n < 2; ++n) _Pragma("unroll") for (int k = 0; k < 2; ++k) \
        acc[ai][bj][m][n] = __builtin_amdgcn_mfma_f32_16x16x32_bf16(Bt[n][k], At[m][k], acc[ai][bj][m][n], 0, 0, 0); __builtin_amdgcn_s_setprio(0); } while (0)
#define PG8_WAIT_V(n) asm volatile("s_waitcnt vmcnt(" #n ")" ::: "memory")
#define PG8_WAIT_L(n) asm volatile("s_waitcnt lgkmcnt(" #n ")" ::: "memory")
#define PG8_BAR __builtin_amdgcn_s_barrier()
#define PG8_SCHED __builtin_amdgcn_sched_barrier(0)
    Unit cur, nxt; int ui = 0;
    if (!S.next(0, cur)) return;
    f32x4 acc[2][2][4][2];
#pragma unroll
    for (int a = 0; a < 2; ++a)
#pragma unroll
        for (int b = 0; b < 2; ++b)
#pragma unroll
            for (int m = 0; m < 4; ++m)
#pragma unroll
                for (int n = 0; n < 2; ++n) acc[a][b][m][n] = (f32x4){0.f, 0.f, 0.f, 0.f};
    bf16x8 At[4][2], B0[2][2], B1[2][2];
    const char* cA = (const char*)g.A + (size_t)cur.pm * tstep + (size_t)cur.g * segb; const char* cB = (const char*)g.Bt + (size_t)cur.pn * tstep + (size_t)cur.g * segb;
    S.a_ready(cur);
    if constexpr (SP2) {
        PG8_STAGE(PG8_SB(0, 0), cB, voffB); PG8_STAGE(PG8_SB(0, 1), cB + hstep, voffB); PG8_STAGE(PG8_SA(0, 0), cA, voffA); PG8_STAGE(PG8_SA(0, 1), cA + hstep, voffA);
        if (wr == 1) PG8_BAR;
        PG8_WAIT_V(2); PG8_BAR;
        PG8_STAGE(PG8_SB(1, 0), cB + kstep, voffB); PG8_STAGE(PG8_SA(1, 0), cA + kstep, voffA); PG8_STAGE(PG8_SB(1, 1), cB + hstep + kstep, voffB);
        PG8_WAIT_V(6); PG8_BAR;
    } else {
        PG8_STAGE(PG8_SB(0, 0), cB, voffB); PG8_STAGE(PG8_SA(0, 0), cA, voffA); PG8_STAGE(PG8_SB(0, 1), cB + hstep, voffB); PG8_STAGE(PG8_SA(0, 1), cA + hstep, voffA);
        if (wr == 1) PG8_BAR;
        PG8_WAIT_V(4); PG8_BAR;
        PG8_STAGE(PG8_SB(1, 0), cB + kstep, voffB); PG8_STAGE(PG8_SA(1, 0), cA + kstep, voffA); PG8_STAGE(PG8_SB(1, 1), cB + hstep + kstep, voffB);
        PG8_WAIT_V(6); PG8_BAR;
    }
    for (;;) {
        const bool has_next = S.next(ui + 1, nxt);
        const char* nA = has_next ? (const char*)g.A + (size_t)nxt.pm * tstep + (size_t)nxt.g * segb : cA; const char* nB = has_next ? (const char*)g.Bt + (size_t)nxt.pn * tstep + (size_t)nxt.g * segb : cB;
        for (int t = 0; t < nt; t += 2) {
            const bool last = (t == nt - 2);
            const char* a1 = cA + (size_t)(t + 1) * kstep;
            const char* a2 = last ? nA : cA + (size_t)(t + 2) * kstep; const char* b2 = last ? nB : cB + (size_t)(t + 2) * kstep;
            const char* a3 = a2 + kstep; const char* b3 = b2 + kstep;
            if (last && has_next) S.a_ready(nxt);
            if constexpr (SP2) {
            PG8_LDB(B0, 0, 0); PG8_LDB(B1, 0, 1); PG8_SCHED; PG8_LDA(At, 0, 0); PG8_STAGE(PG8_SA(1, 1), a1 + hstep, voffA);
            PG8_WAIT_V(8); PG8_WAIT_L(0); PG8_BAR; PG8_MMA(0, 0, At, B0); PG8_MMA(0, 1, At, B1); PG8_BAR; PG8_SCHED;
            PG8_LDA(At, 0, 1); PG8_STAGE(PG8_SB(0, 0), b2, voffB); PG8_STAGE(PG8_SB(0, 1), b2 + hstep, voffB); PG8_STAGE(PG8_SA(0, 0), a2, voffA);
            PG8_WAIT_V(8); PG8_WAIT_L(0); PG8_BAR; PG8_MMA(1, 0, At, B0); PG8_MMA(1, 1, At, B1); PG8_BAR; PG8_SCHED;
            PG8_LDB(B0, 1, 0); PG8_LDB(B1, 1, 1); PG8_SCHED; PG8_LDA(At, 1, 0); PG8_STAGE(PG8_SA(0, 1), a2 + hstep, voffA);
            PG8_WAIT_V(8); PG8_WAIT_L(0); PG8_BAR; PG8_MMA(0, 0, At, B0); PG8_MMA(0, 1, At, B1); PG8_BAR; PG8_SCHED;
            PG8_LDA(At, 1, 1); PG8_STAGE(PG8_SB(1, 0), b3, voffB); PG8_STAGE(PG8_SB(1, 1), b3 + hstep, voffB); PG8_STAGE(PG8_SA(1, 0), a3, voffA);
            PG8_WAIT_V(8); PG8_WAIT_L(0); PG8_BAR; PG8_MMA(1, 0, At, B0); PG8_MMA(1, 1, At, B1); PG8_BAR; PG8_SCHED;
            } else {
            PG8_LDB(B0, 0, 0); PG8_SCHED; PG8_LDA(At, 0, 0); PG8_STAGE(PG8_SA(1, 1), a1 + hstep, voffA);
            PG8_WAIT_L(8); PG8_BAR; PG8_WAIT_L(0); PG8_MMA(0, 0, At, B0); PG8_BAR; PG8_SCHED;
            PG8_LDB(B1, 0, 1); PG8_STAGE(PG8_SB(0, 0), b2, voffB);
            PG8_BAR; PG8_WAIT_L(0); PG8_MMA(0, 1, At, B1); PG8_BAR;
            PG8_LDA(At, 0, 1); PG8_STAGE(PG8_SA(0, 0), a2, voffA);
            PG8_BAR; PG8_WAIT_L(0); PG8_MMA(1, 0, At, B0); PG8_BAR; PG8_SCHED;
            PG8_STAGE(PG8_SB(0, 1), b2 + hstep, voffB);
            PG8_WAIT_V(6); PG8_BAR; PG8_MMA(1, 1, At, B1); PG8_BAR;
            PG8_LDB(B0, 1, 0); PG8_SCHED; PG8_LDA(At, 1, 0); PG8_STAGE(PG8_SA(0, 1), a2 + hstep, voffA);
            PG8_WAIT_L(8); PG8_BAR; PG8_WAIT_L(0); PG8_MMA(0, 0, At, B0); PG8_BAR; PG8_SCHED;
            PG8_LDB(B1, 1, 1); PG8_STAGE(PG8_SB(1, 0), b3, voffB);
            PG8_BAR; PG8_WAIT_L(0); PG8_MMA(0, 1, At, B1); PG8_BAR;
            PG8_LDA(At, 1, 1); PG8_STAGE(PG8_SA(1, 0), a3, voffA);
            PG8_BAR; PG8_WAIT_L(0); PG8_MMA(1, 0, At, B0); PG8_BAR; PG8_SCHED;
            PG8_STAGE(PG8_SB(1, 1), b3 + hstep, voffB);
            PG8_WAIT_V(6); PG8_BAR; PG8_MMA(1, 1, At, B1); PG8_BAR;
            }
        }
        if constexpr (ALIGN_EPI) { if (wr == 0) PG8_BAR; }
        E(acc, cur, wr, wc, fr, fq); S.done(cur);
        if (!has_next) break;
        if (!(Epi::KSEG && nxt.g != 0))
#pragma unroll
        for (int a = 0; a < 2; ++a)
#pragma unroll
            for (int b = 0; b < 2; ++b)
#pragma unroll
                for (int m = 0; m < 4; ++m)
#pragma unroll
                    for (int n = 0; n < 2; ++n) acc[a][b][m][n] = (f32x4){0.f, 0.f, 0.f, 0.f};
        cur = nxt; cA = nA; cB = nB; ++ui;
        if constexpr (ALIGN_EPI) { if (wr == 1) PG8_BAR; }
    }
    PG8_WAIT_V(0);
    if constexpr (!ALIGN_EPI) { if (wr == 0) PG8_BAR; }
    PG8_BAR;
#undef PG8_SA
#undef PG8_SB
#undef PG8_STAGE
#undef PG8_LDA
#undef PG8_LDB
#undef PG8_MMA
#undef PG8_WAIT_V
#undef PG8_WAIT_L
#undef PG8_BAR
#undef PG8_SCHED
}
}

#define LAS __attribute__((address_space(3)))
typedef unsigned short bf16_t;
typedef _Float16 h16;
typedef _Float16 h16x4 __attribute__((ext_vector_type(4)));
typedef _Float16 h16x8 __attribute__((ext_vector_type(8)));
typedef float f32x4 __attribute__((ext_vector_type(4)));
typedef float f32x2 __attribute__((ext_vector_type(2)));
typedef unsigned u32x4 __attribute__((ext_vector_type(4)));
typedef unsigned u32x2 __attribute__((ext_vector_type(2)));

#ifndef ONE_LAUNCH
#define ONE_LAUNCH 1
#endif
constexpr int NWAVES = 8, NTHR = 512;
constexpr int TT = 16384, SEQ = 8192, DM = 1024, FF = 2816, MW = 256, INW = 6144;
constexpr int LDS_BYTES = 147456;
constexpr size_t MiB = 1u << 20;
constexpr size_t WS_CTL = 0, CTL_ZERO_BYTES = 16384, WS_SS = 1 * MiB, WS_E = 2 * MiB, WS_W = 4 * MiB, WS_B1 = 34 * MiB, WS_B2 = 66 * MiB, WS_Z = 98 * MiB, WS_END = 262 * MiB;
constexpr size_t W_GU1 = 0, W_D1 = W_GU1 + (size_t)2 * FF * DM * 2, W_INA = W_D1 + (size_t)DM * FF * 2;
constexpr size_t W_ING = 0, W_BR = W_ING + (size_t)4096 * DM * 2, W_O = W_BR + (size_t)DM * DM * 2, W_GU2 = W_O + (size_t)DM * DM * 2, W_D2 = W_GU2 + (size_t)2 * FF * DM * 2, W_GLU = W_D2 + (size_t)DM * FF * 2, W_END2 = W_GLU + 256 * 256 * 2;
static_assert(W_END2 <= 30 * MiB && W_INA + (size_t)2560 * DM * 2 <= 30 * MiB, "W region");
constexpr size_t Z_RW = 0, Z_G16 = 56 * MiB, Z_U5 = 64 * MiB, Z_L16 = 72 * MiB, Z_PP = 88 * MiB, Z_O = 72 * MiB, Z_GL = 144 * MiB, Z_PB = 152 * MiB, Z_LB = 156 * MiB, Z_SB = 160 * MiB;
constexpr size_t Z_HID = 0, Z_R = 0;
static_assert((size_t)TT * 4 * 896 <= 56 * MiB && (size_t)TT * 1792 * 2 <= 56 * MiB && (size_t)TT * FF * 2 <= 144 * MiB && (size_t)TT * 4096 * 2 <= 144 * MiB, "Z region");

typedef const float* cfp_t;
typedef const __attribute__((address_space(4))) cfp_t* in_t;
struct Args { const float* in[41]; float* out; unsigned char* ws; int ph_lo, ph_hi; };

struct Frame {
    LAS unsigned char* lds;
    int tid, lane, wave, G, bx;
    in_t in;
    float* X; unsigned char* ws;
    float* SS; float* E;
    bf16_t *B1, *B2, *HID, *GL;
    h16 *U5, *PP, *L16, *G16, *R;
    float* O; unsigned char* RW;
    float *PB, *LB, *SB;
};

__device__ __forceinline__ unsigned f2bf(float f) { unsigned u = __builtin_bit_cast(unsigned, f); return (u + 0x7fffu + ((u >> 16) & 1u)) >> 16; }
__device__ __forceinline__ unsigned pk2(float lo, float hi) { return f2bf(lo) | (f2bf(hi) << 16); }
#define LDS_WAIT() asm volatile("s_waitcnt lgkmcnt(0)" ::: "memory")
template <int CTRL> __device__ __forceinline__ float dppx(float x) { return __builtin_bit_cast(float, __builtin_amdgcn_update_dpp(0, __builtin_bit_cast(int, x), CTRL, 0xf, 0xf, true)); }
__device__ __forceinline__ float allreduce16(float x) { x += dppx<0xB1>(x); x += dppx<0x4E>(x); x += dppx<0x141>(x); x += dppx<0x140>(x); return x; }
__device__ __forceinline__ float wave_sum(float x) { x = allreduce16(x); x += __shfl_xor(x, 16); x += __shfl_xor(x, 32); return x; }
__device__ __forceinline__ float sigmoidf_(float x) { return __builtin_amdgcn_rcpf(1.0f + __expf(-x)); }

__device__ __forceinline__ int tr_rowmap(int mode, int j, int row0) {
    if (mode == 0) return row0 + j;
    if (mode == 1) return 8 * (j >> 2) + (j & 3);
    if (mode == 2) return 8 * (j >> 2) + 4 + (j & 3);
    const int g = j >> 10, d = j & 1023;
    const int pn = 4 * (d >> 8) + 2 * ((d >> 7) & 1) + ((d >> 4) & 1);
    return 256 * pn + 128 * (g >> 1) + 32 * ((d >> 5) & 3) + 16 * (g & 1) + 4 * ((d >> 2) & 3) + (d & 3);
}
__device__ __forceinline__ void tr_item(const float* W, int ldw, int K, int N, bf16_t* WT, int mode, int row0, const float* s1, const float* s2, int smode, LAS float* scr, int item, int lane) {
    const int nblk = N / 32, kb = item / nblk, nb = item % nblk, k0 = 64 * kb, n0 = 32 * nb;
#pragma unroll 8
    for (int i = 0; i < 32; ++i) { const int kk = 2 * i + (lane >> 5); const int k = k0 + kk; float sc = 1.0f;
        if (s1) sc = s1[k];
        if (smode == 1) sc *= s2[k]; else if (smode == 2) sc *= (1.0f - s2[k]);
        scr[kk * 33 + (lane & 31)] = W[(size_t)k * ldw + n0 + (lane & 31)] * sc; }
    LDS_WAIT(); asm volatile("" ::: "memory");
    const int c = lane & 7;
#pragma unroll
    for (int j = 0; j < 4; ++j) { const int n = (lane >> 3) + 8 * j; const LAS float* s = scr + (8 * c) * 33 + n;
        u32x4 o; o.x = pk2(s[0 * 33], s[1 * 33]); o.y = pk2(s[2 * 33], s[3 * 33]); o.z = pk2(s[4 * 33], s[5 * 33]); o.w = pk2(s[6 * 33], s[7 * 33]);
        *(u32x4*)(WT + (size_t)tr_rowmap(mode, n0 + n, row0) * K + k0 + 8 * c) = o; }
    LDS_WAIT(); asm volatile("" ::: "memory");
}
#define TRJ(W_, ldw_, K_, N_, dst_, mode_, row0_, s1_, s2_, smode_) { const int ni_ = ((K_) / 64) * ((N_) / 32); if (r >= 0 && r < ni_) tr_item(W_, ldw_, K_, N_, dst_, mode_, row0_, s1_, s2_, smode_, scr, r, F.lane); r -= ni_; }
__device__ __forceinline__ void conv_first_half(Frame& F, int l) {
    LAS float* scr = (LAS float*)(F.lds + F.wave * 16384);
    const int gw = F.bx * NWAVES + F.wave, NGW = F.G * NWAVES;
    unsigned char* wb = F.ws + WS_W;
    const float* n1 = F.in[1] + (size_t)l * DM; const float* nm = F.in[5] + (size_t)l * DM; const float* mu = F.in[19] + (size_t)l * 3 * DM;
    const float* w1 = F.in[21] + (size_t)l * DM * 64; const float* a1 = F.in[24] + (size_t)l * DM * 64; const float* g1 = F.in[26] + (size_t)l * DM * 128;
    bf16_t* ina = (bf16_t*)(wb + W_INA);
    for (int it = gw;; it += NGW) { int r = it;
        TRJ(F.in[2] + (size_t)l * DM * FF, FF, DM, FF, (bf16_t*)(wb + W_GU1), 1, 0, n1, nullptr, 0)
        TRJ(F.in[3] + (size_t)l * DM * FF, FF, DM, FF, (bf16_t*)(wb + W_GU1), 2, 0, n1, nullptr, 0)
        TRJ(F.in[4] + (size_t)l * FF * DM, DM, FF, DM, (bf16_t*)(wb + W_D1), 0, 0, nullptr, nullptr, 0)
        TRJ(F.in[6] + (size_t)l * DM * INW, INW, DM, 2048, ina, 0, 0, nm, nullptr, 0)
        TRJ(w1, 64, DM, 64, ina, 0, 2048, nm, mu, 2)
        TRJ(a1, 64, DM, 64, ina, 0, 2112, nm, mu + DM, 2)
        TRJ(g1, 128, DM, 128, ina, 0, 2176, nm, mu + 2 * DM, 2)
        TRJ(w1, 64, DM, 64, ina, 0, 2304, nm, mu, 1)
        TRJ(a1, 64, DM, 64, ina, 0, 2368, nm, mu + DM, 1)
        TRJ(g1, 128, DM, 128, ina, 0, 2432, nm, mu + 2 * DM, 1)
        if (r >= 0) break; }
}
__device__ __forceinline__ void conv_second_half(Frame& F, int l, int b0) {
    LAS float* scr = (LAS float*)(F.lds + F.wave * 16384);
    const int gw = (F.bx - b0) * NWAVES + F.wave, NGW = (F.G - b0) * NWAVES;
    unsigned char* wb = F.ws + WS_W;
    const float* nm = F.in[5] + (size_t)l * DM; const float* n2 = F.in[36] + (size_t)l * DM;
    for (int it = gw;; it += NGW) { int r = it;
        TRJ(F.in[6] + (size_t)l * DM * INW + 2048, INW, DM, 4096, (bf16_t*)(wb + W_ING), 3, 0, nm, nullptr, 0)
        TRJ(F.in[34] + (size_t)l * DM * DM, DM, DM, DM, (bf16_t*)(wb + W_BR), 0, 0, nullptr, nullptr, 0)
        TRJ(F.in[35] + (size_t)l * DM * DM, DM, DM, DM, (bf16_t*)(wb + W_O), 0, 0, nullptr, nullptr, 0)
        TRJ(F.in[37] + (size_t)l * DM * FF, FF, DM, FF, (bf16_t*)(wb + W_GU2), 1, 0, n2, nullptr, 0)
        TRJ(F.in[38] + (size_t)l * DM * FF, FF, DM, FF, (bf16_t*)(wb + W_GU2), 2, 0, n2, nullptr, 0)
        TRJ(F.in[39] + (size_t)l * FF * DM, DM, FF, DM, (bf16_t*)(wb + W_D2), 0, 0, nullptr, nullptr, 0)
        TRJ(F.in[15] + (size_t)l * 256 * 256, 256, 256, 256, (bf16_t*)(wb + W_GLU), 0, 0, nullptr, nullptr, 0)
        if (r >= 0) break; }
}
__device__ __forceinline__ void prep_x(Frame& F) {
    const int gw = F.bx * NWAVES + F.wave, NGW = F.G * NWAVES;
    const float* x = F.in[0];
    for (int m = gw; m < TT; m += NGW) {
        const f32x4* xr = (const f32x4*)(x + (size_t)m * DM) + F.lane; float s = 0.f;
        unsigned long long* o8 = (unsigned long long*)(F.B1 + (size_t)m * DM) + F.lane;
#pragma unroll
        for (int j = 0; j < 4; ++j) { const f32x4 v = xr[64 * j]; s += (v[0] * v[0] + v[1] * v[1]) + (v[2] * v[2] + v[3] * v[3]);
            o8[64 * j] = (unsigned long long)pk2(v[0], v[1]) | ((unsigned long long)pk2(v[2], v[3]) << 32); }
        s += __shfl_xor(s, 1); s += __shfl_xor(s, 2);
        if ((F.lane & 3) == 0) F.SS[(size_t)m * 16 + (F.lane >> 2)] = s;
    }
}
__device__ __forceinline__ void final_norm(Frame& F) {
    const int gw = F.bx * NWAVES + F.wave, NGW = F.G * NWAVES;
    const f32x4* gn = (const f32x4*)F.in[40] + F.lane;
    for (int m = gw; m < TT; m += NGW) {
        const float rs = pg8::row_rstd(F.SS, m);
        f32x4* xr = (f32x4*)(F.X + (size_t)m * DM) + F.lane;
#pragma unroll
        for (int j = 0; j < 4; ++j) { const f32x4 v = xr[64 * j]; xr[64 * j] = v * rs * gn[64 * j]; }
    }
}

struct S5Par { float ar, ai; float bbr[16], bbi[16]; };
__device__ __forceinline__ void s5_params(Frame& F, int l, int g, int p, S5Par& P) {
    asm volatile("" : "+v"(p));
    const float lr = F.in[7][((size_t)l * 16 + g) * 64 + p], li = F.in[8][((size_t)l * 16 + g) * 64 + p], dt = expf(F.in[9][l * 16 + g]);
    const float mag = expf(lr * dt); P.ar = mag * cosf(li * dt); P.ai = mag * sinf(li * dt);
    const float inv = 1.0f / (lr * lr + li * li); const float qr = lr * inv, qi = -li * inv;
    const float cr = (P.ar - 1.0f) * qr - P.ai * qi, ci = (P.ar - 1.0f) * qi + P.ai * qr;
    const f32x4* br = (const f32x4*)(F.in[10] + (((size_t)l * 16 + g) * 64 + p) * 16); const f32x4* bi = (const f32x4*)(F.in[11] + (((size_t)l * 16 + g) * 64 + p) * 16);
#pragma unroll
    for (int q = 0; q < 4; ++q) { const f32x4 a = br[q], b = bi[q];
#pragma unroll
        for (int i = 0; i < 4; ++i) { P.bbr[4 * q + i] = cr * a[i] - ci * b[i]; P.bbi[4 * q + i] = cr * b[i] + ci * a[i]; } }
}
__device__ __forceinline__ void s5_step(const S5Par& P, const LAS float* urow, float& hr, float& hi) {
    const LAS f32x4* u4 = (const LAS f32x4*)urow; float bur = 0.f, bui = 0.f;
#pragma unroll
    for (int q = 0; q < 4; ++q) { const f32x4 u = u4[q];
#pragma unroll
        for (int i = 0; i < 4; ++i) { bur += P.bbr[4 * q + i] * u[i]; bui += P.bbi[4 * q + i] * u[i]; } }
    const float nr = P.ar * hr - P.ai * hi + bur, ni = P.ar * hi + P.ai * hr + bui; hr = nr; hi = ni;
}
__device__ __forceinline__ void load_u5_tile(Frame& F, int t0, LAS float* ubuf) {
    for (int i = F.tid; i < 64 * 64; i += NTHR) { const int t = i >> 6, q = i & 63; const h16x4 v = *(const h16x4*)(F.U5 + (size_t)(t0 + t) * 256 + 4 * q);
        f32x4 f; f[0] = (float)v[0]; f[1] = (float)v[1]; f[2] = (float)v[2]; f[3] = (float)v[3]; *(LAS f32x4*)(ubuf + t * 256 + 4 * q) = f; }
}


template <bool FIRST> __device__ __forceinline__ void mv32(LAS float* accp, float init, const LAS float* hb, const float* wsrc, int ldw) {
    float w[32];
    asm volatile("" : "+v"(wsrc));
#pragma unroll
    for (int j = 0; j < 32; ++j) w[j] = wsrc[(size_t)j * ldw];
#pragma unroll 2
    for (int tt = 0; tt < 32; ++tt) { const LAS f32x4* h4 = (const LAS f32x4*)(hb + tt * 256); float a = FIRST ? init : accp[tt * 256];
#pragma unroll
        for (int q = 0; q < 8; ++q) { const f32x4 v = h4[q]; a += v[0] * w[4 * q] + v[1] * w[4 * q + 1] + v[2] * w[4 * q + 2] + v[3] * w[4 * q + 3]; }
        accp[tt * 256] = a; }
}
__device__ __forceinline__ void m1_phase(Frame& F, int l) {
    LAS float* ubuf = (LAS float*)F.lds;
    LAS float* pl = (LAS float*)(F.lds + 65536);
    const int tid = F.tid, lane = F.lane, wave = F.wave;
    const int ch = tid & 255, half = tid >> 8;
    for (int c = F.bx; c < TT / 64; c += F.G) {
        const int t0 = c * 64, tb = t0 + half * 32, sb = tb & (SEQ - 1);
        load_u5_tile(F, t0, ubuf);
        __syncthreads();
#pragma unroll 1
        for (int gi = 0; gi < 2; ++gi) { const int g = wave + 8 * gi; S5Par P; s5_params(F, l, g, lane, P); float hr = 0.f, hi = 0.f;
#pragma unroll 2
            for (int j = 0; j < 64; ++j) s5_step(P, ubuf + j * 256 + g * 16, hr, hi);
            *(f32x2*)(F.E + (((size_t)c * 16 + g) * 64 + lane) * 2) = (f32x2){hr, hi}; }
        __syncthreads();
        LAS float* accp = pl + half * 32 * 256 + ch;
        h16 la[32], lb[32];
#pragma unroll
        for (int tt = 0; tt < 32; ++tt) { const int t = tb + tt; la[tt] = F.L16[(size_t)t * 512 + ch]; lb[tt] = (sb + tt > 0) ? F.L16[(size_t)(t - 1) * 512 + 256 + ch] : (h16)0.f; }
#pragma unroll
        for (int tt = 0; tt < 32; ++tt) { float pre = (float)la[tt] + (float)lb[tt];
            float a = pre; if (ch < 64) a = 1.0f - 2.0f * __builtin_amdgcn_rcpf(1.0f + __expf(2.0f * pre)); else if (ch >= 128) a = sigmoidf_(pre);
            ubuf[(half * 32 + tt) * 256 + ch] = a; }
        __syncthreads();
        const int hb = (t0 / SEQ) * 4 + (ch >> 6);
        unsigned char* rwb = F.RW + ((size_t)hb * SEQ + sb) * 896;
        const int cl = ch & 63;
        const LAS float* hrow = ubuf + half * 32 * 256;
        {
            const float* wp = F.in[22] + (size_t)l * 64 * 256 + ch;
            mv32<true>(accp, F.in[20][(size_t)l * 256 + ch], hrow, wp, 256);
            mv32<false>(accp, 0.f, hrow + 32, wp + 32 * 256, 256);
#pragma unroll 2
            for (int tt = 0; tt < 32; ++tt) { const float z = -accp[tt * 256]; const float sp = fmaxf(z, 0.f) + __logf(1.0f + __expf(-fabsf(z)));
                const float wlog = -sp - 0.5f; const float dec = __expf(-__expf(wlog));
                *(float*)(rwb + (size_t)tt * 896 + cl * 4) = dec; }
        }
        {
            const float* gp = F.in[27] + (size_t)l * 128 * 256 + ch;
            mv32<true>(accp, 0.f, hrow + 128, gp, 256);
#pragma unroll 1
            for (int kc = 1; kc < 4; ++kc) mv32<false>(accp, 0.f, hrow + 128 + kc * 32, gp + (size_t)kc * 32 * 256, 256);
#pragma unroll 4
            for (int tt = 0; tt < 32; ++tt) F.G16[(size_t)(tb + tt) * 256 + ch] = (h16)accp[tt * 256];
        }
        {
            const float* ap = F.in[25] + (size_t)l * 64 * 256 + ch;
            mv32<true>(accp, F.in[23][(size_t)l * 256 + ch], hrow + 64, ap, 256);
            mv32<false>(accp, 0.f, hrow + 96, ap + 32 * 256, 256);
            const float mur = F.in[18][((size_t)l * 3 + 0) * 256 + ch], muk = F.in[18][((size_t)l * 3 + 1) * 256 + ch], muv = F.in[18][((size_t)l * 3 + 2) * 256 + ch];
            const float kkw = F.in[28][(size_t)l * 256 + ch], kaw = F.in[29][(size_t)l * 256 + ch];
            const h16* pp = F.PP + (size_t)tb * 1792 + 256 + ch;
            float rprev = 0.f, kprev = 0.f, vprev = 0.f;
            if (sb > 0) { rprev = (float)pp[-(ptrdiff_t)1792]; kprev = (float)pp[-(ptrdiff_t)1792 + 256]; vprev = (float)pp[-(ptrdiff_t)1792 + 512]; }
#pragma unroll 1
            for (int t16 = 0; t16 < 32; t16 += 16) {
                h16 rq[16], kq[16], vq[16];
#pragma unroll
                for (int tt = 0; tt < 16; ++tt) { const h16* q = pp + (size_t)(t16 + tt) * 1792; rq[tt] = q[0]; kq[tt] = q[256]; vq[tt] = q[512]; }
#pragma unroll
                for (int tt = 0; tt < 16; ++tt) { const float a = sigmoidf_(accp[(t16 + tt) * 256]);
                    const float rp = (float)rq[tt], kp = (float)kq[tt], vp = (float)vq[tt];
                    const float r = rp + (rprev - rp) * mur, k = kp + (kprev - kp) * muk, v = vp + (vprev - vp) * muv;
                    rprev = rp; kprev = kp; vprev = vp;
                    const float kkv = k * kkw; const float kk = kkv * rsqrtf(fmaxf(wave_sum(kkv * kkv), 1e-24f));
                    const float kt = k * (1.0f + (a - 1.0f) * kaw); const float bb = kk * a;
                    h16* o = (h16*)(rwb + (size_t)(t16 + tt) * 896 + 256) + cl;
                    o[0] = (h16)r; o[64] = (h16)kt; o[128] = (h16)v; o[192] = (h16)kk; o[256] = (h16)bb; } }
        }
        __syncthreads();
    }
}

__device__ __forceinline__ void pool_conv_chunk(Frame& F, int l, int c) {
    LAS float* ubuf = (LAS float*)F.lds;
    LAS float* pl = (LAS float*)(F.lds + 65536);
    const int tid = F.tid; const int ch = tid & 255, half = tid >> 8;
    const int t0 = c * 64, tb = t0 + half * 32, sb = tb & (SEQ - 1);
    {
    {
        const int grp = ch >> 6, win = 2 << grp;
        const h16* up = F.PP + (size_t)tb * 1792 + ch;
        float s = 0.f;
        for (int j = 1; j <= win; ++j) if (sb - j >= 0) s += (float)up[-(ptrdiff_t)j * 1792];
#pragma unroll 1
        for (int t16 = 0; t16 < 32; t16 += 16) {
            h16 uq[16], ul[16];
#pragma unroll
            for (int tt = 0; tt < 16; ++tt) { uq[tt] = up[(size_t)(t16 + tt) * 1792]; ul[tt] = (sb + t16 + tt - win >= 0) ? up[(ptrdiff_t)(t16 + tt - win) * 1792] : (h16)0.f; }
#pragma unroll
            for (int tt = 0; tt < 16; ++tt) { const float u = (float)uq[tt]; s += u; const int pos = sb + t16 + tt;
                s -= (float)ul[tt];
                const float cnt = (float)((pos + 1 < win) ? (pos + 1) : win);
                pl[(half * 32 + t16 + tt) * 256 + ch] = s / cnt - u; } }
    }
    {
        const h16* zp = F.PP + (size_t)tb * 1792 + 1024 + ch;
        const float cw0 = F.in[33][((size_t)l * 3 + 0) * 256 + ch], cw1 = F.in[33][((size_t)l * 3 + 1) * 256 + ch], cw2 = F.in[33][((size_t)l * 3 + 2) * 256 + ch];
        float z2 = 0.f, z1 = 0.f;
        if (sb >= 1) z1 = (float)zp[-(ptrdiff_t)1792 + 512] * (float)zp[-(ptrdiff_t)1792];
        if (sb >= 2) z2 = (float)zp[-(ptrdiff_t)2 * 1792 + 512] * (float)zp[-(ptrdiff_t)2 * 1792];
#pragma unroll 1
        for (int t16 = 0; t16 < 32; t16 += 16) {
            h16 zx[16], zb[16], zc[16];
#pragma unroll
            for (int tt = 0; tt < 16; ++tt) { const h16* q = zp + (size_t)(t16 + tt) * 1792; zx[tt] = q[0]; zb[tt] = q[256]; zc[tt] = q[512]; }
#pragma unroll
            for (int tt = 0; tt < 16; ++tt) { const float z0 = (float)zc[tt] * (float)zx[tt];
                const float y = (float)zb[tt] * (cw0 * z2 + cw1 * z1 + cw2 * z0);
                F.B2[(size_t)(tb + t16 + tt) * 1024 + 768 + ch] = (bf16_t)f2bf(y); z2 = z1; z1 = z0; } }
    }
    __syncthreads();
    LAS float* accu = ubuf + half * 32 * 256 + ch;
    {
        const int grp = ch >> 6, d = ch & 63;
        const float* pw = F.in[16] + (((size_t)l * 4 + grp) * 64) * 64 + d;
        mv32<true>(accu, 0.f, pl + half * 32 * 256 + grp * 64, pw, 64);
        mv32<false>(accu, 0.f, pl + half * 32 * 256 + grp * 64 + 32, pw + 32 * 64, 64);
        const float sc = F.in[17][(size_t)l * 256 + ch];
#pragma unroll 4
        for (int tt = 0; tt < 32; ++tt) F.B2[(size_t)(tb + tt) * 1024 + 256 + ch] = (bf16_t)f2bf(accu[tt * 256] * sc);
    }
    __syncthreads();
    }
}

#define XB_TMO      128
#define XB_XCNT(j)  (256  + 64 * (j))
#define XB_XSUB(j)  (1280 + 64 * (j))
#define XB_XGEN(j)  (2304 + 64 * (j))
#define XB_TOP      3328
#define XB_TOPGEN   3392
#define XCD_BAR_WORDS 3456
#define XB_SPIN_CAP (1u << 18)

__device__ __forceinline__ unsigned xb_ld(unsigned* p)              { return __hip_atomic_load(p, __ATOMIC_RELAXED, __HIP_MEMORY_SCOPE_AGENT); }
__device__ __forceinline__ unsigned xb_add(unsigned* p, unsigned v) { return __hip_atomic_fetch_add(p, v, __ATOMIC_RELAXED, __HIP_MEMORY_SCOPE_AGENT); }
__device__ __forceinline__ unsigned xb_xcc_id() { return (unsigned)__builtin_amdgcn_s_getreg((3 << 11) | 20) & 0xFu; }
#define XB_SPIN(cond, bar) do { unsigned _sp = 0; while (cond) { __builtin_amdgcn_s_sleep(1); \
    if ((++_sp & 255u) == 0u) { if (xb_ld(&(bar)[XB_TMO])) break; if (_sp > XB_SPIN_CAP) { atomicAdd(&(bar)[XB_TMO], 1u); break; } } } } while (0)

struct XcdBarrier {
    unsigned* bar; unsigned x;
    volatile LAS unsigned* st;
};

__device__ __forceinline__ XcdBarrier xcd_barrier_post(unsigned* bar, volatile LAS unsigned* st) {
    XcdBarrier b; b.bar = bar; b.x = xb_xcc_id(); b.st = st;
    if (threadIdx.x == 0) (void)xb_add(&bar[XB_XCNT(b.x)], 1u);
    return b;
}
__device__ __forceinline__ void xcd_barrier_complete(unsigned* bar, unsigned x, unsigned& nloc, unsigned& nx) {
    const unsigned G = gridDim.x * gridDim.y * gridDim.z;
    unsigned sum, cnt, mine, sp = 0u;
    for (;;) {
        sum = 0u; cnt = 0u; mine = 0u;
#pragma unroll
        for (unsigned j = 0; j < 16; ++j) { const unsigned c = xb_ld(&bar[XB_XCNT(j)]); sum += c; cnt += (c > 0u) ? 1u : 0u; mine = (j == x) ? c : mine; }
        if (sum == G) break;
        __builtin_amdgcn_s_sleep(1);
        if ((++sp & 255u) == 0u) { if (xb_ld(&bar[XB_TMO])) break; if (sp > XB_SPIN_CAP) { atomicAdd(&bar[XB_TMO], 1u); break; } }
    }
    nloc = mine > 0u ? mine : 1u; nx = cnt > 0u ? cnt : 1u;
}

__device__ __forceinline__ void xcd_barrier(const XcdBarrier& b) {
    asm volatile("s_waitcnt vmcnt(0)" ::: "memory");
    __syncthreads();
    if (threadIdx.x == 0) {
        unsigned* bar = b.bar;
        __builtin_amdgcn_s_waitcnt(0);
        unsigned nloc = b.st[0], nx = b.st[1];
        if (nloc == 0u) { xcd_barrier_complete(bar, b.x, nloc, nx); b.st[0] = nloc; b.st[1] = nx; }
        const unsigned old = xb_add(&bar[XB_XSUB(b.x)], 1u);
        const unsigned gen = old / nloc;
        if (old + 1u == (gen + 1u) * nloc) {
            __builtin_amdgcn_fence(__ATOMIC_RELEASE, "agent");
            asm volatile("s_waitcnt vmcnt(0)" ::: "memory");
            const unsigned og = xb_add(&bar[XB_TOP], 1u);
            const unsigned tg = og / nx;
            if (og + 1u == (tg + 1u) * nx) xb_add(&bar[XB_TOPGEN], 1u);
            else XB_SPIN(xb_ld(&bar[XB_TOPGEN]) == tg, bar);
            __builtin_amdgcn_fence(__ATOMIC_ACQUIRE, "agent");
            xb_add(&bar[XB_XGEN(b.x)], 1u);
            asm volatile("s_waitcnt vmcnt(0)" ::: "memory");
        } else {
            XB_SPIN(xb_ld(&bar[XB_XGEN(b.x)]) == gen, bar);
            __builtin_amdgcn_fence(__ATOMIC_ACQUIRE, "agent");
            asm volatile("s_waitcnt vmcnt(0)" ::: "memory");
        }
    }
    __syncthreads();
}

__device__ __forceinline__ float a_fma(float a, float b, float c) { float d; asm("v_fma_f32 %0, %1, %2, %3" : "=v"(d) : "v"(a), "v"(b), "v"(c)); return d; }
__device__ __forceinline__ float a_fnma(float a, float b, float c) { float d; asm("v_fma_f32 %0, -%1, %2, %3" : "=v"(d) : "v"(a), "v"(b), "v"(c)); return d; }
__device__ __forceinline__ float a_mul(float a, float b) { float d; asm("v_mul_f32 %0, %1, %2" : "=v"(d) : "v"(a), "v"(b)); return d; }
__device__ __forceinline__ float a_add(float a, float b) { float d; asm("v_add_f32 %0, %1, %2" : "=v"(d) : "v"(a), "v"(b)); return d; }
constexpr int RC_LEN = 256, RC_N = SEQ / RC_LEN;
constexpr int ST_STEPS = 16, ST_FL = ST_STEPS * 384, ST_NPC = ST_STEPS * 56, ST_OB = ST_STEPS * 32 * 16, ST_NSUB = RC_LEN / ST_STEPS;
__device__ __forceinline__ void st_load(const unsigned char* src, int sub, int tid, u32x4 (&rg)[2]) {
#pragma unroll
    for (int n = 0; n < 2; ++n) { const int i = tid + NTHR * n; if (i < ST_NPC) { const int step = i / 56, j = i % 56;
        rg[n] = *(const u32x4*)(src + ((size_t)sub * ST_STEPS + step) * 896 + (j < 16 ? j * 16 : 256 + (j - 16) * 16)); } }
}
__device__ __forceinline__ void st_store(LAS float* buf, int tid, const u32x4 (&rg)[2]) {
#pragma unroll
    for (int n = 0; n < 2; ++n) { const int i = tid + NTHR * n; if (i < ST_NPC) { const int step = i / 56, j = i % 56;
        if (j < 16) { *(LAS u32x4*)(buf + step * 384 + j * 4) = rg[n]; }
        else { const int a = (j - 16) >> 3, e = (j - 16) & 7; const h16x8 h = __builtin_bit_cast(h16x8, rg[n]); f32x4 lo, hi;
            lo[0] = (float)h[0]; lo[1] = (float)h[1]; lo[2] = (float)h[2]; lo[3] = (float)h[3]; hi[0] = (float)h[4]; hi[1] = (float)h[5]; hi[2] = (float)h[6]; hi[3] = (float)h[7];
            LAS f32x4* d = (LAS f32x4*)(buf + step * 384 + 64 + a * 64 + e * 8); d[0] = lo; d[1] = hi; } } }
}
#define RAW_BAR() do { asm volatile("s_waitcnt lgkmcnt(0)" ::: "memory"); __builtin_amdgcn_s_barrier(); asm volatile("" ::: "memory"); } while (0)
#define DPP_ADD(x_, ctl_) "v_add_f32_dpp %[" x_ "], %[" x_ "], %[" x_ "] " ctl_ " row_mask:0xf bank_mask:0xf bound_ctrl:1\n\t"
template <bool OUT> __device__ __forceinline__ void scan_task(Frame& F, const unsigned char* src, int rowsel, const float* initS, bool ident, bool use_v, float* endS, float* Og) {
    LAS float* buf = (LAS float*)F.lds;
    LAS float* obuf = (LAS float*)(F.lds + 2 * ST_FL * 4);
    const int tid = F.tid, wave = F.wave, lane = F.lane;
    const int rl = wave * 4 + (lane >> 4), row = rowsel + rl, ks = lane & 15;
    float Sa = 0.f, Sb = 0.f, Sc = 0.f, Sd = 0.f;
    if (initS) { const f32x4 i4 = *(const f32x4*)(initS + (size_t)row * 64 + 4 * ks); Sa = i4[0]; Sb = i4[1]; Sc = i4[2]; Sd = i4[3]; }
    else if (ident) { Sa = (4 * ks + 0 == row) ? 1.f : 0.f; Sb = (4 * ks + 1 == row) ? 1.f : 0.f; Sc = (4 * ks + 2 == row) ? 1.f : 0.f; Sd = (4 * ks + 3 == row) ? 1.f : 0.f; }
    u32x4 rg[2][2];
    st_load(src, 0, tid, rg[0]); st_store(buf, tid, rg[0]); st_load(src, 1, tid, rg[1]); st_load(src, 2, tid, rg[0]);
    RAW_BAR();
#pragma unroll 1
    for (int sc2 = 0; sc2 < ST_NSUB; sc2 += 2) {
#pragma unroll
      for (int u = 0; u < 2; ++u) { const int sc = sc2 + u;
        if (sc + 1 < ST_NSUB) { st_store(buf + ((sc + 1) & 1) * ST_FL, tid, rg[(u + 1) & 1]); if (sc + 3 < ST_NSUB) st_load(src, sc + 3, tid, rg[(u + 1) & 1]); }
        {
            const LAS float* bb = buf + (sc & 1) * ST_FL + 4 * ks; const LAS float* vb = buf + (sc & 1) * ST_FL + 192 + row;
            LAS float* ob = obuf + (sc & 1) * ST_OB + rl * 16 + ks;
            f32x4 w_[2], r_[2], k_[2], kk_[2], b_[2]; float v_[2];
#define SC_LD(s_, j_) do { const LAS float* p_ = bb + (s_) * 384; w_[j_] = *(const LAS f32x4*)(p_); if (OUT) r_[j_] = *(const LAS f32x4*)(p_ + 64); k_[j_] = *(const LAS f32x4*)(p_ + 128); \
                kk_[j_] = *(const LAS f32x4*)(p_ + 256); b_[j_] = *(const LAS f32x4*)(p_ + 320); v_[j_] = vb[(s_) * 384]; } while (0)
            SC_LD(0, 0);
#pragma unroll
            for (int s = 0; s < ST_STEPS; ++s) { const int j = s & 1;
                f32x4 rp; if (OUT) rp = r_[j ^ 1];
                if (s + 1 < ST_STEPS) SC_LD(s + 1, j ^ 1);
                const f32x4 w = w_[j], k = k_[j], kk = kk_[j], bv = b_[j]; const float v = use_v ? v_[j] : 0.f;
                float sa, op, u0, u1, u2, u3;
                if (OUT && s > 0) {
                    asm volatile(
                        "v_mul_f32 %[sa], %[Sa], %[kk0]\n\t" "v_fma_f32 %[sa], %[Sb], %[kk1], %[sa]\n\t" "v_fma_f32 %[sa], %[Sc], %[kk2], %[sa]\n\t" "v_fma_f32 %[sa], %[Sd], %[kk3], %[sa]\n\t"
                        "v_mul_f32 %[op], %[Sa], %[r0]\n\t" "v_fma_f32 %[op], %[Sb], %[r1], %[op]\n\t"
                        DPP_ADD("sa", "quad_perm:[1,0,3,2]") "v_fma_f32 %[op], %[Sc], %[r2], %[op]\n\t" "v_fma_f32 %[op], %[Sd], %[r3], %[op]\n\t"
                        DPP_ADD("sa", "quad_perm:[2,3,0,1]") "v_mul_f32 %[u0], %[v], %[k0]\n\t" "v_mul_f32 %[u1], %[v], %[k1]\n\t"
                        DPP_ADD("sa", "row_half_mirror") "v_mul_f32 %[u2], %[v], %[k2]\n\t" "v_mul_f32 %[u3], %[v], %[k3]\n\t"
                        DPP_ADD("sa", "row_mirror")
                        : [sa] "=&v"(sa), [op] "=&v"(op), [u0] "=&v"(u0), [u1] "=&v"(u1), [u2] "=&v"(u2), [u3] "=&v"(u3)
                        : [Sa] "v"(Sa), [Sb] "v"(Sb), [Sc] "v"(Sc), [Sd] "v"(Sd), [kk0] "v"(kk[0]), [kk1] "v"(kk[1]), [kk2] "v"(kk[2]), [kk3] "v"(kk[3]),
                          [r0] "v"(rp[0]), [r1] "v"(rp[1]), [r2] "v"(rp[2]), [r3] "v"(rp[3]), [v] "v"(v), [k0] "v"(k[0]), [k1] "v"(k[1]), [k2] "v"(k[2]), [k3] "v"(k[3]));
                    ob[(s - 1) * 512] = op;
                } else {
                    asm volatile(
                        "v_mul_f32 %[sa], %[Sa], %[kk0]\n\t" "v_fma_f32 %[sa], %[Sb], %[kk1], %[sa]\n\t" "v_fma_f32 %[sa], %[Sc], %[kk2], %[sa]\n\t" "v_fma_f32 %[sa], %[Sd], %[kk3], %[sa]\n\t"
                        "v_mul_f32 %[u0], %[v], %[k0]\n\t" "v_mul_f32 %[u1], %[v], %[k1]\n\t"
                        DPP_ADD("sa", "quad_perm:[1,0,3,2]") "v_mul_f32 %[u2], %[v], %[k2]\n\t" "v_mul_f32 %[u3], %[v], %[k3]\n\t"
                        DPP_ADD("sa", "quad_perm:[2,3,0,1]") "s_nop 1\n\t"
                        DPP_ADD("sa", "row_half_mirror") "s_nop 1\n\t"
                        DPP_ADD("sa", "row_mirror")
                        : [sa] "=&v"(sa), [u0] "=&v"(u0), [u1] "=&v"(u1), [u2] "=&v"(u2), [u3] "=&v"(u3)
                        : [Sa] "v"(Sa), [Sb] "v"(Sb), [Sc] "v"(Sc), [Sd] "v"(Sd), [kk0] "v"(kk[0]), [kk1] "v"(kk[1]), [kk2] "v"(kk[2]), [kk3] "v"(kk[3]),
                          [v] "v"(v), [k0] "v"(k[0]), [k1] "v"(k[1]), [k2] "v"(k[2]), [k3] "v"(k[3]));
                }
                asm volatile(
                    "v_fma_f32 %[u0], -%[sa], %[b0], %[u0]\n\t" "v_fma_f32 %[u1], -%[sa], %[b1], %[u1]\n\t" "v_fma_f32 %[u2], -%[sa], %[b2], %[u2]\n\t" "v_fma_f32 %[u3], -%[sa], %[b3], %[u3]\n\t"
                    "v_fma_f32 %[Sa], %[Sa], %[w0], %[u0]\n\t" "v_fma_f32 %[Sb], %[Sb], %[w1], %[u1]\n\t" "v_fma_f32 %[Sc], %[Sc], %[w2], %[u2]\n\t" "v_fma_f32 %[Sd], %[Sd], %[w3], %[u3]\n\t"
                    : [Sa] "+v"(Sa), [Sb] "+v"(Sb), [Sc] "+v"(Sc), [Sd] "+v"(Sd), [u0] "+v"(u0), [u1] "+v"(u1), [u2] "+v"(u2), [u3] "+v"(u3)
                    : [sa] "v"(sa), [b0] "v"(bv[0]), [b1] "v"(bv[1]), [b2] "v"(bv[2]), [b3] "v"(bv[3]), [w0] "v"(w[0]), [w1] "v"(w[1]), [w2] "v"(w[2]), [w3] "v"(w[3]));
                __builtin_amdgcn_sched_barrier(0); }
            if (OUT) { const f32x4 r = r_[(ST_STEPS - 1) & 1];
              ob[(ST_STEPS - 1) * 512] = a_fma(Sd, r[3], a_fma(Sc, r[2], a_fma(Sb, r[1], a_mul(Sa, r[0])))); }
#undef SC_LD
        }
        RAW_BAR();
        if (OUT) {
            const LAS f32x4* p = (const LAS f32x4*)(obuf + (sc & 1) * ST_OB + tid * 16); const f32x4 a = p[0], b = p[1], c = p[2], d = p[3];
            const float o = (((a[0] + a[1]) + (a[2] + a[3])) + ((b[0] + b[1]) + (b[2] + b[3]))) + (((c[0] + c[1]) + (c[2] + c[3])) + ((d[0] + d[1]) + (d[2] + d[3])));
            Og[((size_t)sc * ST_STEPS + (tid >> 5)) * 256 + rowsel + (tid & 31)] = o; }
      }
    }
    if (endS) *(f32x4*)(endS + (size_t)row * 64 + 4 * ks) = (f32x4){Sa, Sb, Sc, Sd};
    RAW_BAR();
}
#undef DPP_ADD
__device__ __forceinline__ void rwkv_carry(Frame& F) {
    const int hb = F.bx >> 3, row = (F.bx & 7) * 8 + F.wave, lane = F.lane, tid = F.tid;
    LAS float* Pl = (LAS float*)F.lds;
    LAS float* Sl = (LAS float*)(F.lds + 16384) + F.wave * 64;
    float S = 0.f;
    const size_t m0 = (size_t)hb * RC_N * 4096;
    f32x4 p0 = *(const f32x4*)(F.PB + m0 + (size_t)tid * 8), p1 = *(const f32x4*)(F.PB + m0 + (size_t)tid * 8 + 4);
    float lc = F.LB[m0 + (size_t)row * 64 + lane];
#pragma unroll 1
    for (int c = 0; c < RC_N; ++c) { const size_t mo = m0 + (size_t)c * 4096;
        F.SB[mo + (size_t)row * 64 + lane] = S;
        if (c + 1 == RC_N) break;
        float acc = lc;
        *(LAS f32x4*)(Pl + tid * 8) = p0; *(LAS f32x4*)(Pl + tid * 8 + 4) = p1; Sl[lane] = S;
        if (c + 2 < RC_N) { p0 = *(const f32x4*)(F.PB + mo + 4096 + (size_t)tid * 8); p1 = *(const f32x4*)(F.PB + mo + 4096 + (size_t)tid * 8 + 4); lc = F.LB[mo + 4096 + (size_t)row * 64 + lane]; }
        RAW_BAR();
        float a0 = 0.f, a1 = 0.f, a2 = 0.f, a3 = 0.f;
#pragma unroll 4
        for (int j = 0; j < 64; j += 4) { const f32x4 s4 = *(const LAS f32x4*)(Sl + j);
            a0 += s4[0] * Pl[(j + 0) * 64 + lane]; a1 += s4[1] * Pl[(j + 1) * 64 + lane]; a2 += s4[2] * Pl[(j + 2) * 64 + lane]; a3 += s4[3] * Pl[(j + 3) * 64 + lane]; }
        S = acc + ((a0 + a1) + (a2 + a3));
        RAW_BAR();
    }
}
__device__ __forceinline__ float gelu_tanh(float x) { const float u = 0.7978845608028654f * (x + 0.044715f * x * x * x); return 0.5f * x * (1.0f + tanhf(u)); }
__device__ __forceinline__ void s5_pass2(Frame& F, int l, int c) {
    LAS float* ubuf = (LAS float*)F.lds;
    LAS float* ybuf = (LAS float*)(F.lds + 65536);
    const int t0 = c * 64, lane = F.lane, wave = F.wave, cb0 = c & ~127;
    load_u5_tile(F, t0, ubuf);
    __syncthreads();
#pragma unroll 1
    for (int gi = 0; gi < 2; ++gi) { const int g = wave + 8 * gi; S5Par P; s5_params(F, l, g, lane, P);
        float cr[16], ci[16]; int lane_l = lane; asm volatile("" : "+v"(lane_l));
#pragma unroll
        for (int hh = 0; hh < 16; ++hh) { cr[hh] = F.in[12][(((size_t)l * 16 + g) * 16 + hh) * 64 + lane_l]; ci[hh] = F.in[13][(((size_t)l * 16 + g) * 16 + hh) * 64 + lane_l]; }
        float pr = P.ar, pi = P.ai;
#pragma unroll
        for (int s = 0; s < 6; ++s) { const float nr = pr * pr - pi * pi, ni = 2.0f * pr * pi; pr = nr; pi = ni; }
        float hr = 0.f, hi = 0.f;
#pragma unroll 1
        for (int c2 = cb0; c2 < c; c2 += 16) {
            f32x2 e[16];
#pragma unroll
            for (int q = 0; q < 16; ++q) { const int cq = (c2 + q < c) ? c2 + q : c2; e[q] = *(const f32x2*)(F.E + (((size_t)cq * 16 + g) * 64 + lane_l) * 2); }
#pragma unroll
            for (int q = 0; q < 16; ++q) if (c2 + q < c) { const float nr = pr * hr - pi * hi + e[q][0], ni = pr * hi + pi * hr + e[q][1]; hr = nr; hi = ni; } }
        const bool b3 = (lane & 8) != 0, b2 = (lane & 4) != 0, b1 = (lane & 2) != 0, b0 = (lane & 1) != 0;
#pragma unroll 1
        for (int j = 0; j < 64; ++j) { s5_step(P, ubuf + j * 256 + g * 16, hr, hi);
            float v8[8], v4[4], v2[2];
#pragma unroll
            for (int i = 0; i < 8; ++i) { const float lo = hr * cr[i] - hi * ci[i], hv = hr * cr[i + 8] - hi * ci[i + 8];
                const float keep = b3 ? hv : lo, send = b3 ? lo : hv; v8[i] = keep + dppx<0x140>(send); }
#pragma unroll
            for (int i = 0; i < 4; ++i) { const float keep = b2 ? v8[i + 4] : v8[i], send = b2 ? v8[i] : v8[i + 4]; v4[i] = keep + dppx<0x141>(send); }
#pragma unroll
            for (int i = 0; i < 2; ++i) { const float keep = b1 ? v4[i + 2] : v4[i], send = b1 ? v4[i] : v4[i + 2]; v2[i] = keep + dppx<0x4E>(send); }
            float y = (b0 ? v2[1] : v2[0]) + dppx<0xB1>(b0 ? v2[0] : v2[1]);
            y += __shfl_xor(y, 16); y += __shfl_xor(y, 32);
            if (lane < 16) ybuf[j * 256 + g * 16 + lane] = y; }
    }
    __syncthreads();
    { const int ch = F.tid & 255, half = F.tid >> 8; const float dd = F.in[14][(size_t)l * 256 + ch];
        for (int tt = 0; tt < 32; ++tt) { const int tl = half * 32 + tt; const float y = ybuf[tl * 256 + ch] + dd * ubuf[tl * 256 + ch];
            F.GL[(size_t)(t0 + tl) * 256 + ch] = (bf16_t)f2bf(gelu_tanh(y)); } }
    __syncthreads();
}
template <int PART> __device__ __forceinline__ void m2_phase(Frame& F, int l, const XcdBarrier& xbar) {
    if (PART == 0 || PART == 1)
#pragma unroll 1
    for (int id = F.bx; id < 8 * RC_N * 4; id += F.G) { const int hb = id >> 7, c = (id >> 2) & (RC_N - 1), tk = id & 3; const size_t mo = ((size_t)hb * RC_N + c) * 4096;
        const unsigned char* src = F.RW + ((size_t)hb * SEQ + (size_t)c * RC_LEN) * 896;
        scan_task<false>(F, src, (tk & 1) * 32, nullptr, tk >= 2, tk < 2, (tk < 2 ? F.LB : F.PB) + mo, nullptr); }
    if (PART == 0 || PART == 2)
#pragma unroll 1
    for (int c = F.bx; c < TT / 64; c += F.G) pool_conv_chunk(F, l, c);
    xcd_barrier(xbar);
    if (PART == 0 || PART == 3) { int bxs = F.bx; asm volatile("" : "+s"(bxs));
      if (bxs < 64) rwkv_carry(F);
      else conv_second_half(F, l, 64); }
    xcd_barrier(xbar);
    if (PART == 0 || PART == 4)
#pragma unroll 1
    for (int id = F.bx; id < 8 * RC_N * 2; id += F.G) { const int hb = id >> 6, c = (id >> 1) & (RC_N - 1), tk = id & 1; const size_t mo = ((size_t)hb * RC_N + c) * 4096;
        const unsigned char* src = F.RW + ((size_t)hb * SEQ + (size_t)c * RC_LEN) * 896;
        float* Og = F.O + ((size_t)(hb >> 2) * SEQ + (size_t)c * RC_LEN) * 256 + (hb & 3) * 64;
        scan_task<true>(F, src, tk * 32, F.SB + mo, false, true, nullptr, Og); }
    if (PART == 0 || PART == 5)
#pragma unroll 1
    for (int c = F.bx; c < TT / 64; c += F.G) s5_pass2(F, l, c);
}
__device__ __forceinline__ void rwkv_post(Frame& F, int l) {
    const int gw = F.bx * NWAVES + F.wave, NGW = F.G * NWAVES, lane = F.lane;
    for (int it0 = gw * 4; it0 < TT * 4; it0 += NGW * 4) {
        const int t = it0 >> 2, b = t / SEQ, pos = t & (SEQ - 1);
        float o[4], r[4], k[4], v[4], g[4];
#pragma unroll
        for (int hh = 0; hh < 4; ++hh) { const int c = hh * 64 + lane; o[hh] = F.O[(size_t)t * 256 + c]; g[hh] = (float)F.G16[(size_t)t * 256 + c];
            const h16* rw = (const h16*)(F.RW + ((size_t)(b * 4 + hh) * SEQ + pos) * 896 + 256) + lane; r[hh] = (float)rw[0]; k[hh] = (float)rw[64]; v[hh] = (float)rw[128]; }
#pragma unroll
        for (int hh = 0; hh < 4; ++hh) { const int c = hh * 64 + lane;
            const float mu = wave_sum(o[hh]) * (1.0f / 64.0f); const float d = o[hh] - mu; const float var = wave_sum(d * d) * (1.0f / 64.0f);
            const float on = d * rsqrtf(var + 64e-5f) * F.in[31][(size_t)l * 256 + c] + F.in[32][(size_t)l * 256 + c];
            const float bs = wave_sum(r[hh] * k[hh] * F.in[30][(size_t)l * 256 + c]);
            F.B2[(size_t)t * 1024 + 512 + c] = (bf16_t)f2bf((on + bs * v[hh]) * g[hh]); }
    }
}

constexpr int NPH = 25;
#ifndef PHMASK
#define PHMASK 0xFFFF
#endif
#define PHON(k) (((PHMASK) >> (k)) & 1)
#ifndef REP_PART
#define REP_PART 0
#endif
template <int PH, int PART = 0> __device__ __forceinline__ void run_phase(const int wave_s, unsigned char* lds_raw, const XcdBarrier& xbar) {
    typedef pg8::StaticOrder SO;
    int tid = wave_s * 64 + (int)__builtin_amdgcn_mbcnt_hi(~0u, __builtin_amdgcn_mbcnt_lo(~0u, 0u)); asm volatile("" : "+v"(tid));
    int G = gridDim.x, bx = blockIdx.x; asm volatile("" : "+s"(G), "+s"(bx));
    const __attribute__((address_space(4))) unsigned char* ka = (const __attribute__((address_space(4))) unsigned char*)__builtin_amdgcn_kernarg_segment_ptr();
    asm volatile("" : "+s"(ka));
    const __attribute__((address_space(4))) Args* ap = (const __attribute__((address_space(4))) Args*)ka;
    Frame F;
    F.lds = (LAS unsigned char*)lds_raw;
    F.tid = tid; F.lane = tid & 63; F.wave = __builtin_amdgcn_readfirstlane(tid >> 6); F.G = G; F.bx = bx;
    F.in = (in_t)ka; F.X = ap->out; F.ws = ap->ws;
    unsigned char* ws = F.ws;
    F.SS = (float*)(ws + WS_SS); F.E = (float*)(ws + WS_E); F.B1 = (bf16_t*)(ws + WS_B1); F.B2 = (bf16_t*)(ws + WS_B2);
    unsigned char* z = ws + WS_Z;
    F.HID = (bf16_t*)(z + Z_HID); F.GL = (bf16_t*)(z + Z_GL); F.U5 = (h16*)(z + Z_U5); F.PP = (h16*)(z + Z_PP); F.L16 = (h16*)(z + Z_L16); F.G16 = (h16*)(z + Z_G16); F.R = (h16*)(z + Z_R);
    F.O = (float*)(z + Z_O); F.RW = z + Z_RW; F.PB = (float*)(z + Z_PB); F.LB = (float*)(z + Z_LB); F.SB = (float*)(z + Z_SB);
    if constexpr (PH == 0) { conv_first_half(F, 0); prep_x(F); }
    else { constexpr int l = (PH - 1) / 12, k = (PH - 1) % 12;
        if constexpr (k == 0) { pg8::Gemm g{F.B1, (const bf16_t*)(ws + WS_W + W_GU1), TT, 2 * FF, DM, 1}; SO S; S.init(TT, 2 * FF, G, bx); pg8::EpiGU E{F.HID, F.SS}; pg8::gemm_phase<pg8::EpiGU, SO, true, true>(F.lds, g, S, E, tid); }
        else if constexpr (k == 1) { pg8::Gemm g{F.HID, (const bf16_t*)(ws + WS_W + W_D1), TT, DM, FF, 1}; SO S; S.init(TT, DM, G, bx); pg8::EpiDown E{l == 0 ? F.in[0] : F.X, F.X, F.B1, F.SS, 0.5f}; pg8::gemm_phase<pg8::EpiDown, SO, true, true>(F.lds, g, S, E, tid); }
        else if constexpr (k == 2) { pg8::Gemm g{F.B1, (const bf16_t*)(ws + WS_W + W_INA), TT, 2560, DM, 1}; SO S; S.init(TT, 2560, G, bx); pg8::EpiInA E{F.U5, F.PP, F.L16, F.SS}; pg8::gemm_phase<pg8::EpiInA, SO, true, true>(F.lds, g, S, E, tid); }
        else if constexpr (k == 3) { m1_phase(F, l); }
        else if constexpr (k == 4) { m2_phase<PART>(F, l, xbar); }
        else if constexpr (k == 5) { { pg8::Gemm g{F.GL, (const bf16_t*)(ws + WS_W + W_GLU), TT, 256, 256, 1}; SO S; S.init(TT, 256, G, bx); pg8::EpiGlu E{F.GL, F.B2}; pg8::gemm_phase<pg8::EpiGlu, SO, true, true>(F.lds, g, S, E, tid); } rwkv_post(F, l); }
        else if constexpr (k == 6) { pg8::Gemm g{F.B1, (const bf16_t*)(ws + WS_W + W_ING), TT, 4096, DM, 1}; SO S; S.init(TT, 4096, G, bx); pg8::EpiGate E{F.R, F.SS}; pg8::gemm_phase<pg8::EpiGate, SO, true, true>(F.lds, g, S, E, tid); }
        else if constexpr (k == 7) { pg8::Gemm g{F.B2, (const bf16_t*)(ws + WS_W + W_BR), TT, DM, DM, 4}; pg8::SegOrder4 S; S.so.init(TT, DM, G, bx); pg8::EpiBranch E{F.R, F.B1}; pg8::gemm_phase<pg8::EpiBranch, pg8::SegOrder4, true, true>(F.lds, g, S, E, tid); }
        else if constexpr (k == 8) { pg8::Gemm g{F.B1, (const bf16_t*)(ws + WS_W + W_O), TT, DM, DM, 1}; SO S; S.init(TT, DM, G, bx); pg8::EpiDown E{F.X, F.X, F.B2, F.SS, 1.0f}; pg8::gemm_phase<pg8::EpiDown, SO, true, true>(F.lds, g, S, E, tid); }
        else if constexpr (k == 9) { pg8::Gemm g{F.B2, (const bf16_t*)(ws + WS_W + W_GU2), TT, 2 * FF, DM, 1}; SO S; S.init(TT, 2 * FF, G, bx); pg8::EpiGU E{F.HID, F.SS}; pg8::gemm_phase<pg8::EpiGU, SO, true, true>(F.lds, g, S, E, tid); }
        else if constexpr (k == 10) { pg8::Gemm g{F.HID, (const bf16_t*)(ws + WS_W + W_D2), TT, DM, FF, 1}; SO S; S.init(TT, DM, G, bx); pg8::EpiDown E{F.X, F.X, F.B1, F.SS, 0.5f}; pg8::gemm_phase<pg8::EpiDown, SO, true, true>(F.lds, g, S, E, tid); }
        else { if constexpr (l == 0) conv_first_half(F, 1); else final_norm(F); }
    }
}
#ifndef REPMASK
#define REPMASK 0
#endif
#define SEAM(k_) do { if ((k_) == 0) { __syncthreads(); cg::this_grid().sync(); } else xcd_barrier(xbar); } while (0)
#define PHASE(k) if (ph_lo <= (k) && (k) < ph_hi) { run_phase<(k)>(wave_s, lds_raw, xbar); \
    if ((k) >= 1 && ((REPMASK >> (((k) - 1) % 12)) & 1)) { SEAM(k); run_phase<(k), REP_PART>(wave_s, lds_raw, xbar); } \
    if ((k) + 1 < ph_hi) SEAM(k); }
__global__ void __launch_bounds__(NTHR, 2) mk_fwd(Args args) {
    extern __shared__ __attribute__((aligned(16))) unsigned char lds_raw[];
    const int ph_lo = args.ph_lo, ph_hi = args.ph_hi;
    volatile LAS unsigned* xst = (volatile LAS unsigned*)((LAS unsigned char*)lds_raw + (LDS_BYTES - 64));
    if (threadIdx.x == 0) { xst[0] = 0u; xst[1] = 0u; }
    __syncthreads();
    const XcdBarrier xbar = xcd_barrier_post((unsigned*)(args.ws + WS_CTL), xst);
    const int wave_s = __builtin_amdgcn_readfirstlane((int)threadIdx.x >> 6);
    PHASE(0) PHASE(1) PHASE(2) PHASE(3) PHASE(4) PHASE(5) PHASE(6) PHASE(7) PHASE(8) PHASE(9) PHASE(10) PHASE(11) PHASE(12)
    PHASE(13) PHASE(14) PHASE(15) PHASE(16) PHASE(17) PHASE(18) PHASE(19) PHASE(20) PHASE(21) PHASE(22) PHASE(23) PHASE(24)
}

extern "C" void kernel_launch(void* const* d_in, const int* in_sizes, int n_in, void* d_out, int out_size, void* d_ws, size_t ws_size, hipStream_t stream) {
    static int grid = 0;
    if (grid == 0) {
        if (n_in != 41 || out_size != TT * DM || ws_size < WS_END) { fprintf(stderr, "kernel_launch: unexpected shapes (n_in %d out %d ws %zu)\n", n_in, out_size, ws_size); grid = -1; return; }
        int dev = 0, cus = 0, per_cu = 0;
        (void)hipGetDevice(&dev); (void)hipDeviceGetAttribute(&cus, hipDeviceAttributeMultiprocessorCount, dev);
        if (hipFuncSetAttribute((const void*)mk_fwd, hipFuncAttributeMaxDynamicSharedMemorySize, LDS_BYTES) != hipSuccess) { fprintf(stderr, "kernel_launch: hipFuncSetAttribute failed\n"); grid = -1; return; }
        if (hipOccupancyMaxActiveBlocksPerMultiprocessor(&per_cu, (const void*)mk_fwd, NTHR, LDS_BYTES) != hipSuccess || per_cu < 1) { fprintf(stderr, "kernel_launch: occupancy query says %d\n", per_cu); per_cu = 1; }
        (void)hipGetLastError();
        grid = cus * (per_cu >= 1 ? 1 : 1);
        if (grid < 64) { fprintf(stderr, "kernel_launch: grid %d too small\n", grid); }
    }
    if (grid < 0) return;
    if (hipMemsetAsync((char*)d_ws + WS_CTL, 0, CTL_ZERO_BYTES, stream) != hipSuccess) { fprintf(stderr, "kernel_launch: hipMemsetAsync failed\n"); return; }
    Args a{};
    for (int i = 0; i < 41; ++i) a.in[i] = (const float*)d_in[i];
    a.out = (float*)d_out; a.ws = (unsigned char*)d_ws;
#if ONE_LAUNCH
    a.ph_lo = 0; a.ph_hi = NPH;
    void* kargs[] = {&a};
    hipError_t e = hipLaunchCooperativeKernel((const void*)mk_fwd, dim3(grid), dim3(NTHR), kargs, LDS_BYTES, stream);
    if (e != hipSuccess) fprintf(stderr, "cooperative launch failed: %s (grid %d)\n", hipGetErrorString(e), grid);
#else
    for (int ph = 0; ph < NPH; ++ph) { a.ph_lo = ph; a.ph_hi = ph + 1; hipLaunchKernelGGL(mk_fwd, dim3(grid), dim3(NTHR), LDS_BYTES, stream, a); }
#endif
}
```

```cpp
#include <hip/hip_runtime.h>
#include <hip/hip_cooperative_groups.h>
#include <cstdio>
#include <cstdint>
#include <cstddef>
namespace cg = cooperative_groups;
namespace pg8 {
#define PG8_LAS __attribute__((address_space(3)))
typedef unsigned short bf16_t;
typedef short bf16x8 __attribute__((ext_vector_type(8)));
typedef float f32x4 __attribute__((ext_vector_type(4)));
typedef unsigned u32x4 __attribute__((ext_vector_type(4)));
constexpr int BM = 256, BK = 64, HALF = 128, HTB = HALF * BK * 2  , STAGE_BYTES = 8 * HTB, NXCD = 8, WGM = 8;

__host__ __device__ __forceinline__ int lds_byte(int r, int c) { const int st = (r >> 4) * 2 + (c >> 5), rr = r & 15, cc = c & 31, ob = rr * 64 + cc * 2; return st * 1024 + (ob ^ (((ob >> 9) & 1) << 5)); }
__host__ __device__ __forceinline__ void stage_rc(int b, int& R, int& C) { const int st = b / 1024, sb = b % 1024, swz = sb ^ (((sb >> 9) & 1) << 5); R = (st >> 1) * 16 + swz / 64; C = (st & 1) * 32 + (swz % 64) / 2; }
__host__ __device__ __forceinline__ int perm32(int rho) { const int n = rho >> 4, i = rho & 15; return 8 * (i >> 2) + 4 * n + (i & 3); }

struct Unit { int pm, pn, g; };
struct Gemm { const bf16_t* A; const bf16_t* Bt; int M, N, K, nseg; };

struct StaticOrder {
    int nM, nN, nwg, G, c;
    __host__ __device__ void init(int M, int N, int G_, int c_) { nM = M / BM; nN = N / BM; nwg = nM * nN; G = G_; c = c_; }
    __host__ __device__ bool next(int i, Unit& u) const {
        const long L = (long)i * G + c; if (L >= nwg) return false;
        int wgid = (int)L; { const int q = nwg / NXCD, r = nwg % NXCD, xcd = wgid % NXCD, off = wgid / NXCD; wgid = (xcd < r ? xcd * (q + 1) : r * (q + 1) + (xcd - r) * q) + off; }
        const int nig = WGM * nN, gid = wgid / nig, fm = gid * WGM, gsz = (nM - fm) < WGM ? (nM - fm) : WGM;
        u.pm = fm + ((wgid % nig) % gsz); u.pn = (wgid % nig) / gsz; u.g = 0; return true;
    }
    __device__ __forceinline__ void a_ready(const Unit&) const {}
    __device__ __forceinline__ void done(const Unit&) const {}
};


struct SegOrder4 {
    StaticOrder so;
    __host__ __device__ bool next(int i, Unit& u) const { if (!so.next(i >> 2, u)) return false; u.g = i & 3; return true; }
    __device__ __forceinline__ void a_ready(const Unit&) const {}
    __device__ __forceinline__ void done(const Unit&) const {}
};

typedef _Float16 h16;
typedef _Float16 h16x4 __attribute__((ext_vector_type(4)));
typedef unsigned u32x2 __attribute__((ext_vector_type(2)));
__device__ __forceinline__ unsigned cvt_pk_bf16(float lo, float hi) { unsigned r; asm volatile("v_cvt_pk_bf16_f32 %0, %1, %2" : "=v"(r) : "v"(lo), "v"(hi)); return r; }
__device__ __forceinline__ u32x2 pack_bf16x4(f32x4 v) { u32x2 w; w.x = cvt_pk_bf16(v[0], v[1]); w.y = cvt_pk_bf16(v[2], v[3]); return w; }
__device__ __forceinline__ h16x4 pack_h16x4(f32x4 v) { h16x4 w; w[0] = (h16)v[0]; w[1] = (h16)v[1]; w[2] = (h16)v[2]; w[3] = (h16)v[3]; return w; }
__device__ __forceinline__ float fast_sigmoid(float x) { return __builtin_amdgcn_rcpf(1.0f + __expf(-x)); }
__device__ __forceinline__ float row_rstd(const float* SS, int row) {
    const f32x4* p = (const f32x4*)(SS + (size_t)row * 16);
    const f32x4 a = p[0], b = p[1], c = p[2], d = p[3];
    const float s = ((a[0] + a[1]) + (a[2] + a[3])) + ((b[0] + b[1]) + (b[2] + b[3])) + ((c[0] + c[1]) + (c[2] + c[3])) + ((d[0] + d[1]) + (d[2] + d[3]));
    return rsqrtf(s * (1.0f / 1024.0f) + 1e-6f);
}

struct EpiGU {
    static constexpr bool PERM = true, KSEG = false;
    bf16_t* hid; const float* SS;
    __device__ __forceinline__ void operator()(const f32x4 (&acc)[2][2][4][2], const Unit& u, int wr, int wc, int fr, int fq) const {
        int row0 = u.pm * BM + wr * 64 + fr; asm volatile("" : "+v"(row0)); const int j0 = u.pn * 128 + wc * 16 + fq * 4;
#pragma unroll
        for (int ai = 0; ai < 2; ++ai)
#pragma unroll
            for (int m = 0; m < 4; ++m) { const int row = row0 + ai * HALF + m * 16; const float rs = row_rstd(SS, row);
#pragma unroll
                for (int bj = 0; bj < 2; ++bj) { const f32x4 g = acc[ai][bj][m][0] * rs, up = acc[ai][bj][m][1] * rs; f32x4 h;
#pragma unroll
                    for (int i = 0; i < 4; ++i) h[i] = g[i] * fast_sigmoid(g[i]) * up[i];
                    *(u32x2*)(hid + (size_t)row * 2816 + j0 + bj * 64) = pack_bf16x4(h); } }
    }
};
struct EpiDown {
    static constexpr bool PERM = false, KSEG = false;
    const float* res; float* X; bf16_t* xb; float* SS; float alpha;
    __device__ __forceinline__ void operator()(const f32x4 (&acc)[2][2][4][2], const Unit& u, int wr, int wc, int fr, int fq) const {
        int row0 = u.pm * BM + wr * 64 + fr; asm volatile("" : "+v"(row0)); const int c0 = u.pn * BM + wc * 32 + fq * 4;
#pragma unroll
        for (int ai = 0; ai < 2; ++ai)
#pragma unroll
            for (int m = 0; m < 4; ++m) { const int row = row0 + ai * HALF + m * 16; float ss = 0.f;
#pragma unroll
                for (int bj = 0; bj < 2; ++bj)
#pragma unroll
                    for (int n = 0; n < 2; ++n) { const size_t off = (size_t)row * 1024 + c0 + bj * HALF + n * 16;
                        const f32x4 r = *(const f32x4*)(res + off); const f32x4 o = r + acc[ai][bj][m][n] * alpha;
                        *(f32x4*)(X + off) = o; *(u32x2*)(xb + off) = pack_bf16x4(o);
                        ss += (o[0] * o[0] + o[1] * o[1]) + (o[2] * o[2] + o[3] * o[3]); }
                ss += __shfl_xor(ss, 16); ss += __shfl_xor(ss, 32);
                if (fq == 0) SS[(size_t)row * 16 + u.pn * 4 + wc] = ss;
                asm volatile("" ::: "memory"); }
    }
};
struct EpiInA {
    static constexpr bool PERM = false, KSEG = false;
    h16* U5; h16* PP; h16* L16; const float* SS;
    __device__ __forceinline__ void operator()(const f32x4 (&acc)[2][2][4][2], const Unit& u, int wr, int wc, int fr, int fq) const {
        int row0 = u.pm * BM + wr * 64 + fr; asm volatile("" : "+v"(row0)); const int cl = wc * 32 + fq * 4;
        h16* base; int ld, cb;
        if (u.pn == 0) { base = U5; ld = 256; cb = 0; } else if (u.pn < 8) { base = PP; ld = 1792; cb = (u.pn - 1) * 256; } else { base = L16; ld = 512; cb = (u.pn - 8) * 256; }
#pragma unroll
        for (int ai = 0; ai < 2; ++ai)
#pragma unroll
            for (int m = 0; m < 4; ++m) { const int row = row0 + ai * HALF + m * 16; const float rs = row_rstd(SS, row);
#pragma unroll
                for (int bj = 0; bj < 2; ++bj)
#pragma unroll
                    for (int n = 0; n < 2; ++n) *(h16x4*)(base + (size_t)row * ld + cb + cl + bj * HALF + n * 16) = pack_h16x4(acc[ai][bj][m][n] * rs); }
    }
};
struct EpiGate {
    static constexpr bool PERM = false, KSEG = false;
    h16* R; const float* SS;
    __device__ __forceinline__ void operator()(const f32x4 (&acc)[2][2][4][2], const Unit& u, int wr, int wc, int fr, int fq) const {
        int row0 = u.pm * BM + wr * 64 + fr; asm volatile("" : "+v"(row0)); const int d0 = 256 * (u.pn >> 2) + 128 * ((u.pn >> 1) & 1) + 16 * (u.pn & 1) + 32 * wc + 4 * fq;
#pragma unroll
        for (int ai = 0; ai < 2; ++ai)
#pragma unroll
            for (int m = 0; m < 4; ++m) { const int row = row0 + ai * HALF + m * 16; const float rs = row_rstd(SS, row);
                f32x4 e[4];
#pragma unroll
                for (int g = 0; g < 4; ++g)
#pragma unroll
                    for (int i = 0; i < 4; ++i) e[g][i] = 1.0f + __expf(-fminf(fmaxf(acc[ai][g >> 1][m][g & 1][i] * rs, -10.f), 30.f));
                f32x4 r[4];
#pragma unroll
                for (int i = 0; i < 4; ++i) { const float i0 = __builtin_amdgcn_rcpf(e[0][i]), i1 = __builtin_amdgcn_rcpf(e[1][i]), i2 = __builtin_amdgcn_rcpf(e[2][i]), i3 = __builtin_amdgcn_rcpf(e[3][i]);
                    r[0][i] = e[1][i] * i0; r[1][i] = e[2][i] * i1; r[2][i] = e[3][i] * i2; r[3][i] = i3; }
#pragma unroll
                for (int g = 0; g < 4; ++g) *(h16x4*)(R + ((size_t)row * 4 + g) * 1024 + d0) = pack_h16x4(r[g]); }
    }
};
struct EpiBranch {
    static constexpr bool PERM = false, KSEG = true;
    const h16* R; bf16_t* out;
    __device__ __forceinline__ void operator()(f32x4 (&acc)[2][2][4][2], const Unit& u, int wr, int wc, int fr, int fq) const {
        unsigned q0 = (unsigned)(u.pm * BM + wr * 64 + fr) * 1024u + (unsigned)(u.pn * BM + wc * 32 + fq * 4); asm volatile("" : "+v"(q0));
        const unsigned r0 = (q0 - (q0 & 1023u)) * 4u + (unsigned)u.g * 1024u + (q0 & 1023u);
        const bool last = u.g == 3;
#pragma unroll
        for (int ai = 0; ai < 2; ++ai)
#pragma unroll
            for (int m = 0; m < 4; ++m) {
#pragma unroll
                for (int bj = 0; bj < 2; ++bj)
#pragma unroll
                    for (int n = 0; n < 2; ++n) { const unsigned off = q0 + (unsigned)((ai * HALF + m * 16) * 1024 + bj * HALF + n * 16);
                        const h16x4 r = *(const h16x4*)(R + (r0 + (unsigned)((ai * HALF + m * 16) * 4096 + bj * HALF + n * 16)));
                        f32x4 rf; rf[0] = (float)r[0]; rf[1] = (float)r[1]; rf[2] = (float)r[2]; rf[3] = (float)r[3];
                        acc[ai][bj][m][n] = acc[ai][bj][m][n] * rf;
                        if (last) *(u32x2*)(out + off) = pack_bf16x4(acc[ai][bj][m][n]); }
                asm volatile("" ::: "memory"); }
    }
};
struct EpiGlu {
    static constexpr bool PERM = false, KSEG = false;
    const bf16_t* gl; bf16_t* ys;
    __device__ __forceinline__ void operator()(const f32x4 (&acc)[2][2][4][2], const Unit& u, int wr, int wc, int fr, int fq) const {
        int row0 = u.pm * BM + wr * 64 + fr; asm volatile("" : "+v"(row0)); const int c0 = wc * 32 + fq * 4;
#pragma unroll
        for (int ai = 0; ai < 2; ++ai)
#pragma unroll
            for (int m = 0; m < 4; ++m) { const int row = row0 + ai * HALF + m * 16;
#pragma unroll
                for (int bj = 0; bj < 2; ++bj)
#pragma unroll
                    for (int n = 0; n < 2; ++n) { const int c = c0 + bj * HALF + n * 16; const u32x2 gv = *(const u32x2*)(gl + (size_t)row * 256 + c);
                        f32x4 g; g[0] = __uint_as_float(gv.x << 16); g[1] = __uint_as_float(gv.x & 0xffff0000u); g[2] = __uint_as_float(gv.y << 16); g[3] = __uint_as_float(gv.y & 0xffff0000u);
                        f32x4 o;
#pragma unroll
                        for (int i = 0; i < 4; ++i) o[i] = g[i] * fast_sigmoid(acc[ai][bj][m][n][i]);
                        *(u32x2*)(ys + (size_t)row * 1024 + c) = pack_bf16x4(o); }
                asm volatile("" ::: "memory"); }
    }
};

template <class Epi, class Sched, bool ALIGN_EPI = false, bool SP2 = false>
__device__ __forceinline__ void gemm_phase(PG8_LAS unsigned char* lds, const Gemm g, const Sched& S, const Epi& E, const int tid) {
    const int wid = __builtin_amdgcn_readfirstlane(tid >> 6), lane = tid & 63, wr = wid >> 2, wc = wid & 3, fr = lane & 15, fq = lane >> 4;
    const int K = g.K, nt = K / BK / g.nseg; const size_t segb = (size_t)(K / g.nseg) * 2;
    unsigned voffA[2], voffB[2];
#pragma unroll
    for (int i = 0; i < 2; ++i) { int R, C; stage_rc(tid * 16 + i * 8192, R, C); const int Rb = Epi::PERM ? ((R & ~31) + perm32(R & 31)) : R;
        voffA[i] = (unsigned)(R * K + C) * 2u; voffB[i] = (unsigned)(Rb * K + C) * 2u; }
    const size_t kstep = (size_t)(BK * 2);
    const size_t hstep = (size_t)HALF * K * 2;
    const size_t tstep = 2 * hstep;
    const unsigned ldsw = (unsigned)wid * 1024u;
    const int aoff = lds_byte(wr * 64 + fr, fq * 8), boff = lds_byte(wc * 32 + fr, fq * 8);
#define PG8_SA(b, h) (((b) * 2 + (h)) * HTB)
#define PG8_SB(b, h) ((4 + (b) * 2 + (h)) * HTB)
#define PG8_STAGE(bufoff, gbase, voff) do { _Pragma("unroll") for (int _i = 0; _i < 2; ++_i) \
        __builtin_amdgcn_global_load_lds((const unsigned*)((const char*)(gbase) + (voff)[_i]), (PG8_LAS unsigned*)(lds + (bufoff) + ldsw + _i * 8192), 16, 0, 0); } while (0)
#define PG8_LDA(dst, b, h) do { _Pragma("unroll") for (int m = 0; m < 4; ++m) _Pragma("unroll") for (int k = 0; k < 2; ++k) dst[m][k] = *(const PG8_LAS bf16x8*)(lds + PG8_SA(b, h) + aoff + m * 2048 + k * 1024); } while (0)
#define PG8_LDB(dst, b, h) do { _Pragma("unroll") for (int n = 0; n < 2; ++n) _Pragma("unroll") for (int k = 0; k < 2; ++k) dst[n][k] = *(const PG8_LAS bf16x8*)(lds + PG8_SB(b, h) + boff + n * 2048 + k * 1024); } while (0)
#define PG8_MMA(ai, bj, At, Bt) do { __builtin_amdgcn_s_setprio(1); _Pragma("unroll") for (int m = 0; m < 4; ++m) _Pragma("unroll") for (int n = 0; n < 2; ++n) _Pragma("unroll") for (int k = 0; k < 2; ++k) \
        acc[ai][bj][m][n] = __builtin_amdgcn_mfma_f32_16x16x32_bf16(Bt[n][k], At[m][k], acc[ai][bj][m][n], 0, 0, 0); __builtin_amdgcn_s_setprio(0); } while (0)
#define PG8_WAIT_V(n) asm volatile("s_waitcnt vmcnt(" #n ")" ::: "memory")
#define PG8_WAIT_L(n) asm volatile("s_waitcnt lgkmcnt(" #n ")" ::: "memory")
#define PG8_BAR __builtin_amdgcn_s_barrier()
#define PG8_SCHED __builtin_amdgcn_sched_barrier(0)
    Unit cur, nxt; int ui = 0;
    if (!S.next(0, cur)) return;
    f32x4 acc[2][2][4][2];
#pragma unroll
    for (int a = 0; a < 2; ++a)
#pragma unroll
        for (int b = 0; b < 2; ++b)
#pragma unroll
            for (int m = 0; m < 4; ++m)
#pragma unroll
                for (int n = 0; n < 2; ++n) acc[a][b][m][n] = (f32x4){0.f, 0.f, 0.f, 0.f};
    bf16x8 At[4][2], B0[2][2], B1[2][2];
    const char* cA = (const char*)g.A + (size_t)cur.pm * tstep + (size_t)cur.g * segb; const char* cB = (const char*)g.Bt + (size_t)cur.pn * tstep + (size_t)cur.g * segb;
    S.a_ready(cur);
    if constexpr (SP2) {
        PG8_STAGE(PG8_SB(0, 0), cB, voffB); PG8_STAGE(PG8_SB(0, 1), cB + hstep, voffB); PG8_STAGE(PG8_SA(0, 0), cA, voffA); PG8_STAGE(PG8_SA(0, 1), cA + hstep, voffA);
        if (wr == 1) PG8_BAR;
        PG8_WAIT_V(2); PG8_BAR;
        PG8_STAGE(PG8_SB(1, 0), cB + kstep, voffB); PG8_STAGE(PG8_SA(1, 0), cA + kstep, voffA); PG8_STAGE(PG8_SB(1, 1), cB + hstep + kstep, voffB);
        PG8_WAIT_V(6); PG8_BAR;
    } else {
        PG8_STAGE(PG8_SB(0, 0), cB, voffB); PG8_STAGE(PG8_SA(0, 0), cA, voffA); PG8_STAGE(PG8_SB(0, 1), cB + hstep, voffB); PG8_STAGE(PG8_SA(0, 1), cA + hstep, voffA);
        if (wr == 1) PG8_BAR;
        PG8_WAIT_V(4); PG8_BAR;
        PG8_STAGE(PG8_SB(1, 0), cB + kstep, voffB); PG8_STAGE(PG8_SA(1, 0), cA + kstep, voffA); PG8_STAGE(PG8_SB(1, 1), cB + hstep + kstep, voffB);
        PG8_WAIT_V(6); PG8_BAR;
    }
    for (;;) {
        const bool has_next = S.next(ui + 1, nxt);
        const char* nA = has_next ? (const char*)g.A + (size_t)nxt.pm * tstep + (size_t)nxt.g * segb : cA; const char* nB = has_next ? (const char*)g.Bt + (size_t)nxt.pn * tstep + (size_t)nxt.g * segb : cB;
        for (int t = 0; t < nt; t += 2) {
            const bool last = (t == nt - 2);
            const char* a1 = cA + (size_t)(t + 1) * kstep;
            const char* a2 = last ? nA : cA + (size_t)(t + 2) * kstep; const char* b2 = last ? nB : cB + (size_t)(t + 2) * kstep;
            const char* a3 = a2 + kstep; const char* b3 = b2 + kstep;
            if (last && has_next) S.a_ready(nxt);
            if constexpr (SP2) {
            PG8_LDB(B0, 0, 0); PG8_LDB(B1, 0, 1); PG8_SCHED; PG8_LDA(At, 0, 0); PG8_STAGE(PG8_SA(1, 1), a1 + hstep, voffA);
            PG8_WAIT_V(8); PG8_WAIT_L(0); PG8_BAR; PG8_MMA(0, 0, At, B0); PG8_MMA(0, 1, At, B1); PG8_BAR; PG8_SCHED;
            PG8_LDA(At, 0, 1); PG8_STAGE(PG8_SB(0, 0), b2, voffB); PG8_STAGE(PG8_SB(0, 1), b2 + hstep, voffB); PG8_STAGE(PG8_SA(0, 0), a2, voffA);
            PG8_WAIT_V(8); PG8_WAIT_L(0); PG8_BAR; PG8_MMA(1, 0, At, B0); PG8_MMA(1, 1, At, B1); PG8_BAR; PG8_SCHED;
            PG8_LDB(B0, 1, 0); PG8_LDB(B1, 1, 1); PG8_SCHED; PG8_LDA(At, 1, 0); PG8_STAGE(PG8_SA(0, 1), a2 + hstep, voffA);
            PG8_WAIT_V(8); PG8_WAIT_L(0); PG8_BAR; PG8_MMA(0, 0, At, B0); PG8_MMA(0, 1, At, B1); PG8_BAR; PG8_SCHED;
            PG8_LDA(At, 1, 1); PG8_STAGE(PG8_SB(1, 0), b3, voffB); PG8_STAGE(PG8_SB(1, 1), b3 + hstep, voffB); PG8_STAGE(PG8_SA(1, 0), a3, voffA);
            PG8_WAIT_V(8); PG8_WAIT_L(0); PG8_BAR; PG8_MMA(1, 0, At, B0); PG8_MMA(1, 1, At, B1); PG8_BAR; PG8_SCHED;
            } else {
            PG8_LDB(B0, 0, 0); PG8_SCHED; PG8_LDA(At, 0, 0); PG8_STAGE(PG8_SA(1, 1), a1 + hstep, voffA);
            PG8_WAIT_L(8); PG8_BAR; PG8_WAIT_L(0); PG8_MMA(0, 0, At, B0); PG8_BAR; PG8_SCHED;
            PG8_LDB(B1, 0, 1); PG8_STAGE(PG8_SB(0, 0), b2, voffB);
            PG8_BAR; PG8_WAIT_L(0); PG8_MMA(0, 1, At, B1); PG8_BAR;
            PG8_LDA(At, 0, 1); PG8_STAGE(PG8_SA(0, 0), a2, voffA);
            PG8_BAR; PG8_WAIT_L(0); PG8_MMA(1, 0, At, B0); PG8_BAR; PG8_SCHED;
            PG8_STAGE(PG8_SB(0, 1), b2 + hstep, voffB);
            PG8_WAIT_V(6); PG8_BAR; PG8_MMA(1, 1, At, B1); PG8_BAR;
            PG8_LDB(B0, 1, 0); PG8_SCHED; PG8_LDA(At, 1, 0); PG8_STAGE(PG8_SA(0, 1), a2 + hstep, voffA);
            PG8_WAIT_L(8); PG8_BAR; PG8_WAIT_L(0); PG8_MMA(0, 0, At, B0); PG8_BAR; PG8_SCHED;
            PG8_LDB(B1, 1, 1); PG8_STAGE(PG8_SB(1, 0), b3, voffB);
            PG8_BAR; PG8_WAIT_L(0); PG8_MMA(0, 1, At, B1); PG8_BAR;
            PG8_LDA(At, 1, 1); PG8_STAGE(PG8_SA(1, 0), a3, voffA);
            PG8_BAR; PG8_WAIT_L(0); PG8_MMA(1, 0, At, B0); PG8_BAR; PG8_SCHED;
            PG8_STAGE(PG8_SB(1, 1), b3 + hstep, voffB);
            PG8_WAIT_V(6); PG8_BAR; PG8_MMA(1, 1, At, B1); PG8_BAR;
            }
        }
        if constexpr (ALIGN_EPI) { if (wr == 0) PG8_BAR; }
        E(acc, cur, wr, wc, fr, fq); S.done(cur);
        if (!has_next) break;
        if (!(Epi::KSEG && nxt.g != 0))
#pragma unroll
        for (int a = 0; a < 2; ++a)
#pragma unroll
            for (int b = 0; b < 2; ++b)
#pragma unroll
                for (int m = 0; m < 4; ++m)
#pragma unroll
                    for (int n = 0; n < 2; ++n) acc[a][b][m][n] = (f32x4){0.f, 0.f, 0.f, 0.f};
        cur = nxt; cA = nA; cB = nB; ++ui;
        if constexpr (ALIGN_EPI) { if (wr == 1) PG8_BAR; }
    }
    PG8_WAIT_V(0);
    if constexpr (!ALIGN_EPI) { if (wr == 0) PG8_BAR; }
    PG8_BAR;
#undef PG8_SA
#undef PG8_SB
#undef PG8_STAGE
#undef PG8_LDA
#undef PG8_LDB
#undef PG8_MMA
#undef PG8_WAIT_V
#undef PG8_WAIT_L
#undef PG8_BAR
#undef PG8_SCHED
}
}

#define LAS __attribute__((address_space(3)))
typedef unsigned short bf16_t;
typedef _Float16 h16;
typedef _Float16 h16x4 __attribute__((ext_vector_type(4)));
typedef _Float16 h16x8 __attribute__((ext_vector_type(8)));
typedef float f32x4 __attribute__((ext_vector_type(4)));
typedef float f32x2 __attribute__((ext_vector_type(2)));
typedef unsigned u32x4 __attribute__((ext_vector_type(4)));
typedef unsigned u32x2 __attribute__((ext_vector_type(2)));

#ifndef ONE_LAUNCH
#define ONE_LAUNCH 1
#endif
constexpr int NWAVES = 8, NTHR = 512;
constexpr int TT = 16384, SEQ = 8192, DM = 1024, FF = 2816, MW = 256, INW = 6144;
constexpr int LDS_BYTES = 147456;
constexpr size_t MiB = 1u << 20;
constexpr size_t WS_CTL = 0, CTL_ZERO_BYTES = 16384, WS_SS = 1 * MiB, WS_E = 2 * MiB, WS_W = 4 * MiB, WS_B1 = 34 * MiB, WS_B2 = 66 * MiB, WS_Z = 98 * MiB, WS_END = 262 * MiB;
constexpr size_t W_GU1 = 0, W_D1 = W_GU1 + (size_t)2 * FF * DM * 2, W_INA = W_D1 + (size_t)DM * FF * 2;
constexpr size_t W_ING = 0, W_BR = W_ING + (size_t)4096 * DM * 2, W_O = W_BR + (size_t)DM * DM * 2, W_GU2 = W_O + (size_t)DM * DM * 2, W_D2 = W_GU2 + (size_t)2 * FF * DM * 2, W_GLU = W_D2 + (size_t)DM * FF * 2, W_END2 = W_GLU + 256 * 256 * 2;
static_assert(W_END2 <= 30 * MiB && W_INA + (size_t)2560 * DM * 2 <= 30 * MiB, "W region");
constexpr size_t Z_RW = 0, Z_G16 = 56 * MiB, Z_U5 = 64 * MiB, Z_L16 = 72 * MiB, Z_PP = 88 * MiB, Z_O = 72 * MiB, Z_GL = 144 * MiB, Z_PB = 152 * MiB, Z_LB = 156 * MiB, Z_SB = 160 * MiB;
constexpr size_t Z_HID = 0, Z_R = 0;
static_assert((size_t)TT * 4 * 896 <= 56 * MiB && (size_t)TT * 1792 * 2 <= 56 * MiB && (size_t)TT * FF * 2 <= 144 * MiB && (size_t)TT * 4096 * 2 <= 144 * MiB, "Z region");

typedef const float* cfp_t;
typedef const __attribute__((address_space(4))) cfp_t* in_t;
struct Args { const float* in[41]; float* out; unsigned char* ws; int ph_lo, ph_hi; };

struct Frame {
    LAS unsigned char* lds;
    int tid, lane, wave, G, bx;
    in_t in;
    float* X; unsigned char* ws;
    float* SS; float* E;
    bf16_t *B1, *B2, *HID, *GL;
    h16 *U5, *PP, *L16, *G16, *R;
    float* O; unsigned char* RW;
    float *PB, *LB, *SB;
};

__device__ __forceinline__ unsigned f2bf(float f) { unsigned u = __builtin_bit_cast(unsigned, f); return (u + 0x7fffu + ((u >> 16) & 1u)) >> 16; }
__device__ __forceinline__ unsigned pk2(float lo, float hi) { return f2bf(lo) | (f2bf(hi) << 16); }
#define LDS_WAIT() asm volatile("s_waitcnt lgkmcnt(0)" ::: "memory")
template <int CTRL> __device__ __forceinline__ float dppx(float x) { return __builtin_bit_cast(float, __builtin_amdgcn_update_dpp(0, __builtin_bit_cast(int, x), CTRL, 0xf, 0xf, true)); }
__device__ __forceinline__ float allreduce16(float x) { x += dppx<0xB1>(x); x += dppx<0x4E>(x); x += dppx<0x141>(x); x += dppx<0x140>(x); return x; }
__device__ __forceinline__ float wave_sum(float x) { x = allreduce16(x); x += __shfl_xor(x, 16); x += __shfl_xor(x, 32); return x; }
__device__ __forceinline__ float sigmoidf_(float x) { return __builtin_amdgcn_rcpf(1.0f + __expf(-x)); }

__device__ __forceinline__ int tr_rowmap(int mode, int j, int row0) {
    if (mode == 0) return row0 + j;
    if (mode == 1) return 8 * (j >> 2) + (j & 3);
    if (mode == 2) return 8 * (j >> 2) + 4 + (j & 3);
    const int g = j >> 10, d = j & 1023;
    const int pn = 4 * (d >> 8) + 2 * ((d >> 7) & 1) + ((d >> 4) & 1);
    return 256 * pn + 128 * (g >> 1) + 32 * ((d >> 5) & 3) + 16 * (g & 1) + 4 * ((d >> 2) & 3) + (d & 3);
}
__device__ __forceinline__ void tr_item(const float* W, int ldw, int K, int N, bf16_t* WT, int mode, int row0, const float* s1, const float* s2, int smode, LAS float* scr, int item, int lane) {
    const int nblk = N / 32, kb = item / nblk, nb = item % nblk, k0 = 64 * kb, n0 = 32 * nb;
#pragma unroll 8
    for (int i = 0; i < 32; ++i) { const int kk = 2 * i + (lane >> 5); const int k = k0 + kk; float sc = 1.0f;
        if (s1) sc = s1[k];
        if (smode == 1) sc *= s2[k]; else if (smode == 2) sc *= (1.0f - s2[k]);
        scr[kk * 33 + (lane & 31)] = W[(size_t)k * ldw + n0 + (lane & 31)] * sc; }
    LDS_WAIT(); asm volatile("" ::: "memory");
    const int c = lane & 7;
#pragma unroll
    for (int j = 0; j < 4; ++j) { const int n = (lane >> 3) + 8 * j; const LAS float* s = scr + (8 * c) * 33 + n;
        u32x4 o; o.x = pk2(s[0 * 33], s[1 * 33]); o.y = pk2(s[2 * 33], s[3 * 33]); o.z = pk2(s[4 * 33], s[5 * 33]); o.w = pk2(s[6 * 33], s[7 * 33]);
        *(u32x4*)(WT + (size_t)tr_rowmap(mode, n0 + n, row0) * K + k0 + 8 * c) = o; }
    LDS_WAIT(); asm volatile("" ::: "memory");
}
#define TRJ(W_, ldw_, K_, N_, dst_, mode_, row0_, s1_, s2_, smode_) { const int ni_ = ((K_) / 64) * ((N_) / 32); if (r >= 0 && r < ni_) tr_item(W_, ldw_, K_, N_, dst_, mode_, row0_, s1_, s2_, smode_, scr, r, F.lane); r -= ni_; }
__device__ __forceinline__ void conv_first_half(Frame& F, int l) {
    LAS float* scr = (LAS float*)(F.lds + F.wave * 16384);
    const int gw = F.bx * NWAVES + F.wave, NGW = F.G * NWAVES;
    unsigned char* wb = F.ws + WS_W;
    const float* n1 = F.in[1] + (size_t)l * DM; const float* nm = F.in[5] + (size_t)l * DM; const float* mu = F.in[19] + (size_t)l * 3 * DM;
    const float* w1 = F.in[21] + (size_t)l * DM * 64; const float* a1 = F.in[24] + (size_t)l * DM * 64; const float* g1 = F.in[26] + (size_t)l * DM * 128;
    bf16_t* ina = (bf16_t*)(wb + W_INA);
    for (int it = gw;; it += NGW) { int r = it;
        TRJ(F.in[2] + (size_t)l * DM * FF, FF, DM, FF, (bf16_t*)(wb + W_GU1), 1, 0, n1, nullptr, 0)
        TRJ(F.in[3] + (size_t)l * DM * FF, FF, DM, FF, (bf16_t*)(wb + W_GU1), 2, 0, n1, nullptr, 0)
        TRJ(F.in[4] + (size_t)l * FF * DM, DM, FF, DM, (bf16_t*)(wb + W_D1), 0, 0, nullptr, nullptr, 0)
        TRJ(F.in[6] + (size_t)l * DM * INW, INW, DM, 2048, ina, 0, 0, nm, nullptr, 0)
        TRJ(w1, 64, DM, 64, ina, 0, 2048, nm, mu, 2)
        TRJ(a1, 64, DM, 64, ina, 0, 2112, nm, mu + DM, 2)
        TRJ(g1, 128, DM, 128, ina, 0, 2176, nm, mu + 2 * DM, 2)
        TRJ(w1, 64, DM, 64, ina, 0, 2304, nm, mu, 1)
        TRJ(a1, 64, DM, 64, ina, 0, 2368, nm, mu + DM, 1)
        TRJ(g1, 128, DM, 128, ina, 0, 2432, nm, mu + 2 * DM, 1)
        if (r >= 0) break; }
}
__device__ __forceinline__ void conv_second_half(Frame& F, int l, int b0) {
    LAS float* scr = (LAS float*)(F.lds + F.wave * 16384);
    const int gw = (F.bx - b0) * NWAVES + F.wave, NGW = (F.G - b0) * NWAVES;
    unsigned char* wb = F.ws + WS_W;
    const float* nm = F.in[5] + (size_t)l * DM; const float* n2 = F.in[36] + (size_t)l * DM;
    for (int it = gw;; it += NGW) { int r = it;
        TRJ(F.in[6] + (size_t)l * DM * INW + 2048, INW, DM, 4096, (bf16_t*)(wb + W_ING), 3, 0, nm, nullptr, 0)
        TRJ(F.in[34] + (size_t)l * DM * DM, DM, DM, DM, (bf16_t*)(wb + W_BR), 0, 0, nullptr, nullptr, 0)
        TRJ(F.in[35] + (size_t)l * DM * DM, DM, DM, DM, (bf16_t*)(wb + W_O), 0, 0, nullptr, nullptr, 0)
        TRJ(F.in[37] + (size_t)l * DM * FF, FF, DM, FF, (bf16_t*)(wb + W_GU2), 1, 0, n2, nullptr, 0)
        TRJ(F.in[38] + (size_t)l * DM * FF, FF, DM, FF, (bf16_t*)(wb + W_GU2), 2, 0, n2, nullptr, 0)
        TRJ(F.in[39] + (size_t)l * FF * DM, DM, FF, DM, (bf16_t*)(wb + W_D2), 0, 0, nullptr, nullptr, 0)
        TRJ(F.in[15] + (size_t)l * 256 * 256, 256, 256, 256, (bf16_t*)(wb + W_GLU), 0, 0, nullptr, nullptr, 0)
        if (r >= 0) break; }
}
__device__ __forceinline__ void prep_x(Frame& F) {
    const int gw = F.bx * NWAVES + F.wave, NGW = F.G * NWAVES;
    const float* x = F.in[0];
    for (int m = gw; m < TT; m += NGW) {
        const f32x4* xr = (const f32x4*)(x + (size_t)m * DM) + F.lane; float s = 0.f;
        unsigned long long* o8 = (unsigned long long*)(F.B1 + (size_t)m * DM) + F.lane;
#pragma unroll
        for (int j = 0; j < 4; ++j) { const f32x4 v = xr[64 * j]; s += (v[0] * v[0] + v[1] * v[1]) + (v[2] * v[2] + v[3] * v[3]);
            o8[64 * j] = (unsigned long long)pk2(v[0], v[1]) | ((unsigned long long)pk2(v[2], v[3]) << 32); }
        s += __shfl_xor(s, 1); s += __shfl_xor(s, 2);
        if ((F.lane & 3) == 0) F.SS[(size_t)m * 16 + (F.lane >> 2)] = s;
    }
}
__device__ __forceinline__ void final_norm(Frame& F) {
    const int gw = F.bx * NWAVES + F.wave, NGW = F.G * NWAVES;
    const f32x4* gn = (const f32x4*)F.in[40] + F.lane;
    for (int m = gw; m < TT; m += NGW) {
        const float rs = pg8::row_rstd(F.SS, m);
        f32x4* xr = (f32x4*)(F.X + (size_t)m * DM) + F.lane;
#pragma unroll
        for (int j = 0; j < 4; ++j) { const f32x4 v = xr[64 * j]; xr[64 * j] = v * rs * gn[64 * j]; }
    }
}

struct S5Par { float ar, ai; float bbr[16], bbi[16]; };
__device__ __forceinline__ void s5_params(Frame& F, int l, int g, int p, S5Par& P) {
    asm volatile("" : "+v"(p));
    const float lr = F.in[7][((size_t)l * 16 + g) * 64 + p], li = F.in[8][((size_t)l * 16 + g) * 64 + p], dt = expf(F.in[9][l * 16 + g]);
    const float mag = expf(lr * dt); P.ar = mag * cosf(li * dt); P.ai = mag * sinf(li * dt);
    const float inv = 1.0f / (lr * lr + li * li); const float qr = lr * inv, qi = -li * inv;
    const float cr = (P.ar - 1.0f) * qr - P.ai * qi, ci = (P.ar - 1.0f) * qi + P.ai * qr;
    const f32x4* br = (const f32x4*)(F.in[10] + (((size_t)l * 16 + g) * 64 + p) * 16); const f32x4* bi = (const f32x4*)(F.in[11] + (((size_t)l * 16 + g) * 64 + p) * 16);
#pragma unroll
    for (int q = 0; q < 4; ++q) { const f32x4 a = br[q], b = bi[q];
#pragma unroll
        for (int i = 0; i < 4; ++i) { P.bbr[4 * q + i] = cr * a[i] - ci * b[i]; P.bbi[4 * q + i] = cr * b[i] + ci * a[i]; } }
}
__device__ __forceinline__ void s5_step(const S5Par& P, const LAS float* urow, float& hr, float& hi) {
    const LAS f32x4* u4 = (const LAS f32x4*)urow; float bur = 0.f, bui = 0.f;
#pragma unroll
    for (int q = 0; q < 4; ++q) { const f32x4 u = u4[q];
#pragma unroll
        for (int i = 0; i < 4; ++i) { bur += P.bbr[4 * q + i] * u[i]; bui += P.bbi[4 * q + i] * u[i]; } }
    const float nr = P.ar * hr - P.ai * hi + bur, ni = P.ar * hi + P.ai * hr + bui; hr = nr; hi = ni;
}
__device__ __forceinline__ void load_u5_tile(Frame& F, int t0, LAS float* ubuf) {
    for (int i = F.tid; i < 64 * 64; i += NTHR) { const int t = i >> 6, q = i & 63; const h16x4 v = *(const h16x4*)(F.U5 + (size_t)(t0 + t) * 256 + 4 * q);
        f32x4 f; f[0] = (float)v[0]; f[1] = (float)v[1]; f[2] = (float)v[2]; f[3] = (float)v[3]; *(LAS f32x4*)(ubuf + t * 256 + 4 * q) = f; }
}


template <bool FIRST> __device__ __forceinline__ void mv32(LAS float* accp, float init, const LAS float* hb, const float* wsrc, int ldw) {
    float w[32];
    asm volatile("" : "+v"(wsrc));
#pragma unroll
    for (int j = 0; j < 32; ++j) w[j] = wsrc[(size_t)j * ldw];
#pragma unroll 2
    for (int tt = 0; tt < 32; ++tt) { const LAS f32x4* h4 = (const LAS f32x4*)(hb + tt * 256); float a = FIRST ? init : accp[tt * 256];
#pragma unroll
        for (int q = 0; q < 8; ++q) { const f32x4 v = h4[q]; a += v[0] * w[4 * q] + v[1] * w[4 * q + 1] + v[2] * w[4 * q + 2] + v[3] * w[4 * q + 3]; }
        accp[tt * 256] = a; }
}
__device__ __forceinline__ void m1_phase(Frame& F, int l) {
    LAS float* ubuf = (LAS float*)F.lds;
    LAS float* pl = (LAS float*)(F.lds + 65536);
    const int tid = F.tid, lane = F.lane, wave = F.wave;
    const int ch = tid & 255, half = tid >> 8;
    for (int c = F.bx; c < TT / 64; c += F.G) {
        const int t0 = c * 64, tb = t0 + half * 32, sb = tb & (SEQ - 1);
        load_u5_tile(F, t0, ubuf);
        __syncthreads();
#pragma unroll 1
        for (int gi = 0; gi < 2; ++gi) { const int g = wave + 8 * gi; S5Par P; s5_params(F, l, g, lane, P); float hr = 0.f, hi = 0.f;
#pragma unroll 2
            for (int j = 0; j < 64; ++j) s5_step(P, ubuf + j * 256 + g * 16, hr, hi);
            *(f32x2*)(F.E + (((size_t)c * 16 + g) * 64 + lane) * 2) = (f32x2){hr, hi}; }
        __syncthreads();
        LAS float* accp = pl + half * 32 * 256 + ch;
        h16 la[32], lb[32];
#pragma unroll
        for (int tt = 0; tt < 32; ++tt) { const int t = tb + tt; la[tt] = F.L16[(size_t)t * 512 + ch]; lb[tt] = (sb + tt > 0) ? F.L16[(size_t)(t - 1) * 512 + 256 + ch] : (h16)0.f; }
#pragma unroll
        for (int tt = 0; tt < 32; ++tt) { float pre = (float)la[tt] + (float)lb[tt];
            float a = pre; if (ch < 64) a = 1.0f - 2.0f * __builtin_amdgcn_rcpf(1.0f + __expf(2.0f * pre)); else if (ch >= 128) a = sigmoidf_(pre);
            ubuf[(half * 32 + tt) * 256 + ch] = a; }
        __syncthreads();
        const int hb = (t0 / SEQ) * 4 + (ch >> 6);
        unsigned char* rwb = F.RW + ((size_t)hb * SEQ + sb) * 896;
        const int cl = ch & 63;
        const LAS float* hrow = ubuf + half * 32 * 256;
        {
            const float* wp = F.in[22] + (size_t)l * 64 * 256 + ch;
            mv32<true>(accp, F.in[20][(size_t)l * 256 + ch], hrow, wp, 256);
            mv32<false>(accp, 0.f, hrow + 32, wp + 32 * 256, 256);
#pragma unroll 2
            for (int tt = 0; tt < 32; ++tt) { const float z = -accp[tt * 256]; const float sp = fmaxf(z, 0.f) + __logf(1.0f + __expf(-fabsf(z)));
                const float wlog = -sp - 0.5f; const float dec = __expf(-__expf(wlog));
                *(float*)(rwb + (size_t)tt * 896 + cl * 4) = dec; }
        }
        {
            const float* gp = F.in[27] + (size_t)l * 128 * 256 + ch;
            mv32<true>(accp, 0.f, hrow + 128, gp, 256);
#pragma unroll 1
            for (int kc = 1; kc < 4; ++kc) mv32<false>(accp, 0.f, hrow + 128 + kc * 32, gp + (size_t)kc * 32 * 256, 256);
#pragma unroll 4
            for (int tt = 0; tt < 32; ++tt) F.G16[(size_t)(tb + tt) * 256 + ch] = (h16)accp[tt * 256];
        }
        {
            const float* ap = F.in[25] + (size_t)l * 64 * 256 + ch;
            mv32<true>(accp, F.in[23][(size_t)l * 256 + ch], hrow + 64, ap, 256);
            mv32<false>(accp, 0.f, hrow + 96, ap + 32 * 256, 256);
            const float mur = F.in[18][((size_t)l * 3 + 0) * 256 + ch], muk = F.in[18][((size_t)l * 3 + 1) * 256 + ch], muv = F.in[18][((size_t)l * 3 + 2) * 256 + ch];
            const float kkw = F.in[28][(size_t)l * 256 + ch], kaw = F.in[29][(size_t)l * 256 + ch];
            const h16* pp = F.PP + (size_t)tb * 1792 + 256 + ch;
            float rprev = 0.f, kprev = 0.f, vprev = 0.f;
            if (sb > 0) { rprev = (float)pp[-(ptrdiff_t)1792]; kprev = (float)pp[-(ptrdiff_t)1792 + 256]; vprev = (float)pp[-(ptrdiff_t)1792 + 512]; }
#pragma unroll 1
            for (int t16 = 0; t16 < 32; t16 += 16) {
                h16 rq[16], kq[16], vq[16];
#pragma unroll
                for (int tt = 0; tt < 16; ++tt) { const h16* q = pp + (size_t)(t16 + tt) * 1792; rq[tt] = q[0]; kq[tt] = q[256]; vq[tt] = q[512]; }
#pragma unroll
                for (int tt = 0; tt < 16; ++tt) { const float a = sigmoidf_(accp[(t16 + tt) * 256]);
                    const float rp = (float)rq[tt], kp = (float)kq[tt], vp = (float)vq[tt];
                    const float r = rp + (rprev - rp) * mur, k = kp + (kprev - kp) * muk, v = vp + (vprev - vp) * muv;
                    rprev = rp; kprev = kp; vprev = vp;
                    const float kkv = k * kkw; const float kk = kkv * rsqrtf(fmaxf(wave_sum(kkv * kkv), 1e-24f));
                    const float kt = k * (1.0f + (a - 1.0f) * kaw); const float bb = kk * a;
                    h16* o = (h16*)(rwb + (size_t)(t16 + tt) * 896 + 256) + cl;
                    o[0] = (h16)r; o[64] = (h16)kt; o[128] = (h16)v; o[192] = (h16)kk; o[256] = (h16)bb; } }
        }
        __syncthreads();
    }
}

__device__ __forceinline__ void pool_conv_chunk(Frame& F, int l, int c) {
    LAS float* ubuf = (LAS float*)F.lds;
    LAS float* pl = (LAS float*)(F.lds + 65536);
    const int tid = F.tid; const int ch = tid & 255, half = tid >> 8;
    const int t0 = c * 64, tb = t0 + half * 32, sb = tb & (SEQ - 1);
    {
    {
        const int grp = ch >> 6, win = 2 << grp;
        const h16* up = F.PP + (size_t)tb * 1792 + ch;
        float s = 0.f;
        for (int j = 1; j <= win; ++j) if (sb - j >= 0) s += (float)up[-(ptrdiff_t)j * 1792];
#pragma unroll 1
        for (int t16 = 0; t16 < 32; t16 += 16) {
            h16 uq[16], ul[16];
#pragma unroll
            for (int tt = 0; tt < 16; ++tt) { uq[tt] = up[(size_t)(t16 + tt) * 1792]; ul[tt] = (sb + t16 + tt - win >= 0) ? up[(ptrdiff_t)(t16 + tt - win) * 1792] : (h16)0.f; }
#pragma unroll
            for (int tt = 0; tt < 16; ++tt) { const float u = (float)uq[tt]; s += u; const int pos = sb + t16 + tt;
                s -= (float)ul[tt];
                const float cnt = (float)((pos + 1 < win) ? (pos + 1) : win);
                pl[(half * 32 + t16 + tt) * 256 + ch] = s / cnt - u; } }
    }
    {
        const h16* zp = F.PP + (size_t)tb * 1792 + 1024 + ch;
        const float cw0 = F.in[33][((size_t)l * 3 + 0) * 256 + ch], cw1 = F.in[33][((size_t)l * 3 + 1) * 256 + ch], cw2 = F.in[33][((size_t)l * 3 + 2) * 256 + ch];
        float z2 = 0.f, z1 = 0.f;
        if (sb >= 1) z1 = (float)zp[-(ptrdiff_t)1792 + 512] * (float)zp[-(ptrdiff_t)1792];
        if (sb >= 2) z2 = (float)zp[-(ptrdiff_t)2 * 1792 + 512] * (float)zp[-(ptrdiff_t)2 * 1792];
#pragma unroll 1
        for (int t16 = 0; t16 < 32; t16 += 16) {
            h16 zx[16], zb[16], zc[16];
#pragma unroll
            for (int tt = 0; tt < 16; ++tt) { const h16* q = zp + (size_t)(t16 + tt) * 1792; zx[tt] = q[0]; zb[tt] = q[256]; zc[tt] = q[512]; }
#pragma unroll
            for (int tt = 0; tt < 16; ++tt) { const float z0 = (float)zc[tt] * (float)zx[tt];
                const float y = (float)zb[tt] * (cw0 * z2 + cw1 * z1 + cw2 * z0);
                F.B2[(size_t)(tb + t16 + tt) * 1024 + 768 + ch] = (bf16_t)f2bf(y); z2 = z1; z1 = z0; } }
    }
    __syncthreads();
    LAS float* accu = ubuf + half * 32 * 256 + ch;
    {
        const int grp = ch >> 6, d = ch & 63;
        const float* pw = F.in[16] + (((size_t)l * 4 + grp) * 64) * 64 + d;
        mv32<true>(accu, 0.f, pl + half * 32 * 256 + grp * 64, pw, 64);
        mv32<false>(accu, 0.f, pl + half * 32 * 256 + grp * 64 + 32, pw + 32 * 64, 64);
        const float sc = F.in[17][(size_t)l * 256 + ch];
#pragma unroll 4
        for (int tt = 0; tt < 32; ++tt) F.B2[(size_t)(tb + tt) * 1024 + 256 + ch] = (bf16_t)f2bf(accu[tt * 256] * sc);
    }
    __syncthreads();
    }
}

#define XB_TMO      128
#define XB_XCNT(j)  (256  + 64 * (j))
#define XB_XSUB(j)  (1280 + 64 * (j))
#define XB_XGEN(j)  (2304 + 64 * (j))
#define XB_TOP      3328
#define XB_TOPGEN   3392
#define XCD_BAR_WORDS 3456
#define XB_SPIN_CAP (1u << 18)

__device__ __forceinline__ unsigned xb_ld(unsigned* p)              { return __hip_atomic_load(p, __ATOMIC_RELAXED, __HIP_MEMORY_SCOPE_AGENT); }
__device__ __forceinline__ unsigned xb_add(unsigned* p, unsigned v) { return __hip_atomic_fetch_add(p, v, __ATOMIC_RELAXED, __HIP_MEMORY_SCOPE_AGENT); }
__device__ __forceinline__ unsigned xb_xcc_id() { return (unsigned)__builtin_amdgcn_s_getreg((3 << 11) | 20) & 0xFu; }
#define XB_SPIN(cond, bar) do { unsigned _sp = 0; while (cond) { __builtin_amdgcn_s_sleep(1); \
    if ((++_sp & 255u) == 0u) { if (xb_ld(&(bar)[XB_TMO])) break; if (_sp > XB_SPIN_CAP) { atomicAdd(&(bar)[XB_TMO], 1u); break; } } } } while (0)

struct XcdBarrier {
    unsigned* bar; unsigned x;
    volatile LAS unsigned* st;
};

__device__ __forceinline__ XcdBarrier xcd_barrier_post(unsigned* bar, volatile LAS unsigned* st) {
    XcdBarrier b; b.bar = bar; b.x = xb_xcc_id(); b.st = st;
    if (threadIdx.x == 0) (void)xb_add(&bar[XB_XCNT(b.x)], 1u);
    return b;
}
__device__ __forceinline__ void xcd_barrier_complete(unsigned* bar, unsigned x, unsigned& nloc, unsigned& nx) {
    const unsigned G = gridDim.x * gridDim.y * gridDim.z;
    unsigned sum, cnt, mine, sp = 0u;
    for (;;) {
        sum = 0u; cnt = 0u; mine = 0u;
#pragma unroll
        for (unsigned j = 0; j < 16; ++j) { const unsigned c = xb_ld(&bar[XB_XCNT(j)]); sum += c; cnt += (c > 0u) ? 1u : 0u; mine = (j == x) ? c : mine; }
        if (sum == G) break;
        __builtin_amdgcn_s_sleep(1);
        if ((++sp & 255u) == 0u) { if (xb_ld(&bar[XB_TMO])) break; if (sp > XB_SPIN_CAP) { atomicAdd(&bar[XB_TMO], 1u); break; } }
    }
    nloc = mine > 0u ? mine : 1u; nx = cnt > 0u ? cnt : 1u;
}

__device__ __forceinline__ void xcd_barrier(const XcdBarrier& b) {
    asm volatile("s_waitcnt vmcnt(0)" ::: "memory");
    __syncthreads();
    if (threadIdx.x == 0) {
        unsigned* bar = b.bar;
        __builtin_amdgcn_s_waitcnt(0);
        unsigned nloc = b.st[0], nx = b.st[1];
        if (nloc == 0u) { xcd_barrier_complete(bar, b.x, nloc, nx); b.st[0] = nloc; b.st[1] = nx; }
        const unsigned old = xb_add(&bar[XB_XSUB(b.x)], 1u);
        const unsigned gen = old / nloc;
        if (old + 1u == (gen + 1u) * nloc) {
            __builtin_amdgcn_fence(__ATOMIC_RELEASE, "agent");
            asm volatile("s_waitcnt vmcnt(0)" ::: "memory");
            const unsigned og = xb_add(&bar[XB_TOP], 1u);
            const unsigned tg = og / nx;
            if (og + 1u == (tg + 1u) * nx) xb_add(&bar[XB_TOPGEN], 1u);
            else XB_SPIN(xb_ld(&bar[XB_TOPGEN]) == tg, bar);
            __builtin_amdgcn_fence(__ATOMIC_ACQUIRE, "agent");
            xb_add(&bar[XB_XGEN(b.x)], 1u);
            asm volatile("s_waitcnt vmcnt(0)" ::: "memory");
        } else {
            XB_SPIN(xb_ld(&bar[XB_XGEN(b.x)]) == gen, bar);
            __builtin_amdgcn_fence(__ATOMIC_ACQUIRE, "agent");
            asm volatile("s_waitcnt vmcnt(0)" ::: "memory");
        }
    }
    __syncthreads();
}

__device__ __forceinline__ float a_fma(float a, float b, float c) { float d; asm("v_fma_f32 %0, %1, %2, %3" : "=v"(d) : "v"(a), "v"(b), "v"(c)); return d; }
__device__ __forceinline__ float a_fnma(float a, float b, float c) { float d; asm("v_fma_f32 %0, -%1, %2, %3" : "=v"(d) : "v"(a), "v"(b), "v"(c)); return d; }
__device__ __forceinline__ float a_mul(float a, float b) { float d; asm("v_mul_f32 %0, %1, %2" : "=v"(d) : "v"(a), "v"(b)); return d; }
__device__ __forceinline__ float a_add(float a, float b) { float d; asm("v_add_f32 %0, %1, %2" : "=v"(d) : "v"(a), "v"(b)); return d; }
constexpr int RC_LEN = 256, RC_N = SEQ / RC_LEN;
constexpr int ST_STEPS = 16, ST_FL = ST_STEPS * 384, ST_NPC = ST_STEPS * 56, ST_OB = ST_STEPS * 32 * 16, ST_NSUB = RC_LEN / ST_STEPS;
__device__ __forceinline__ void st_load(const unsigned char* src, int sub, int tid, u32x4 (&rg)[2]) {
#pragma unroll
    for (int n = 0; n < 2; ++n) { const int i = tid + NTHR * n; if (i < ST_NPC) { const int step = i / 56, j = i % 56;
        rg[n] = *(const u32x4*)(src + ((size_t)sub * ST_STEPS + step) * 896 + (j < 16 ? j * 16 : 256 + (j - 16) * 16)); } }
}
__device__ __forceinline__ void st_store(LAS float* buf, int tid, const u32x4 (&rg)[2]) {
#pragma unroll
    for (int n = 0; n < 2; ++n) { const int i = tid + NTHR * n; if (i < ST_NPC) { const int step = i / 56, j = i % 56;
        if (j < 16) { *(LAS u32x4*)(buf + step * 384 + j * 4) = rg[n]; }
        else { const int a = (j - 16) >> 3, e = (j - 16) & 7; const h16x8 h = __builtin_bit_cast(h16x8, rg[n]); f32x4 lo, hi;
            lo[0] = (float)h[0]; lo[1] = (float)h[1]; lo[2] = (float)h[2]; lo[3] = (float)h[3]; hi[0] = (float)h[4]; hi[1] = (float)h[5]; hi[2] = (float)h[6]; hi[3] = (float)h[7];
            LAS f32x4* d = (LAS f32x4*)(buf + step * 384 + 64 + a * 64 + e * 8); d[0] = lo; d[1] = hi; } } }
}
#define RAW_BAR() do { asm volatile("s_waitcnt lgkmcnt(0)" ::: "memory"); __builtin_amdgcn_s_barrier(); asm volatile("" ::: "memory"); } while (0)
#define DPP_ADD(x_, ctl_) "v_add_f32_dpp %[" x_ "], %[" x_ "], %[" x_ "] " ctl_ " row_mask:0xf bank_mask:0xf bound_ctrl:1\n\t"
template <bool OUT> __device__ __forceinline__ void scan_task(Frame& F, const unsigned char* src, const float* initS, bool ident, bool use_v, float* endS, float* Og) {
    constexpr int STS = OUT ? 8 : 16, NSUB = RC_LEN / STS, FL = STS * 384, NPC = STS * 56, PT = (NPC + NTHR - 1) / NTHR, OB = STS * 64 * 16;
    LAS float* buf = (LAS float*)F.lds;
    LAS float* obuf = (LAS float*)(F.lds + 2 * FL * 4);
    const int tid = F.tid, wave = F.wave, lane = F.lane, ks = lane & 15;
    int rowr[2]; float S[2][4];
#pragma unroll
    for (int r = 0; r < 2; ++r) { rowr[r] = (wave * 2 + r) * 4 + (lane >> 4);
        if (initS) { const f32x4 i4 = *(const f32x4*)(initS + (size_t)rowr[r] * 64 + 4 * ks); S[r][0] = i4[0]; S[r][1] = i4[1]; S[r][2] = i4[2]; S[r][3] = i4[3]; }
        else {
#pragma unroll
            for (int e = 0; e < 4; ++e) S[r][e] = (ident && 4 * ks + e == rowr[r]) ? 1.f : 0.f; } }
    u32x4 rg[2][PT];
#define ST_LOAD(sub_, rg_) do { _Pragma("unroll") for (int n_ = 0; n_ < PT; ++n_) { const int i_ = tid + NTHR * n_; if (i_ < NPC) { const int step_ = i_ / 56, j_ = i_ % 56; \
        rg_[n_] = *(const u32x4*)(src + ((size_t)(sub_) * STS + step_) * 896 + (j_ < 16 ? j_ * 16 : 256 + (j_ - 16) * 16)); } } } while (0)
#define ST_STORE(buf_, rg_) do { _Pragma("unroll") for (int n_ = 0; n_ < PT; ++n_) { const int i_ = tid + NTHR * n_; if (i_ < NPC) { const int step_ = i_ / 56, j_ = i_ % 56; \
        if (j_ < 16) { *(LAS u32x4*)((buf_) + step_ * 384 + j_ * 4) = rg_[n_]; } \
        else { const int a_ = (j_ - 16) >> 3, e_ = (j_ - 16) & 7; const h16x8 h_ = __builtin_bit_cast(h16x8, rg_[n_]); f32x4 lo_, hi_; \
            lo_[0] = (float)h_[0]; lo_[1] = (float)h_[1]; lo_[2] = (float)h_[2]; lo_[3] = (float)h_[3]; hi_[0] = (float)h_[4]; hi_[1] = (float)h_[5]; hi_[2] = (float)h_[6]; hi_[3] = (float)h_[7]; \
            LAS f32x4* d_ = (LAS f32x4*)((buf_) + step_ * 384 + 64 + a_ * 64 + e_ * 8); d_[0] = lo_; d_[1] = hi_; } } } } while (0)
    ST_LOAD(0, rg[0]); ST_STORE(buf, rg[0]); ST_LOAD(1, rg[1]); ST_LOAD(2, rg[0]);
    RAW_BAR();
#pragma unroll 1
    for (int sc2 = 0; sc2 < NSUB; sc2 += 2) {
#pragma unroll
      for (int u = 0; u < 2; ++u) { const int sc = sc2 + u;
        if (sc + 1 < NSUB) { ST_STORE(buf + ((sc + 1) & 1) * FL, rg[(u + 1) & 1]); if (sc + 3 < NSUB) ST_LOAD(sc + 3, rg[(u + 1) & 1]); }
        {
            const LAS float* bb = buf + (sc & 1) * FL + 4 * ks; const LAS float* vb0 = buf + (sc & 1) * FL + 192 + rowr[0]; const LAS float* vb1 = buf + (sc & 1) * FL + 192 + rowr[1];
            LAS float* ob0 = obuf + (sc & 1) * OB + rowr[0] * 16 + ks; LAS float* ob1 = obuf + (sc & 1) * OB + rowr[1] * 16 + ks;
            f32x4 w_[2], r_[2], k_[2], kk_[2], b_[2]; float v_[2][2];
#define SC_LD(s_, j_) do { const LAS float* p_ = bb + (s_) * 384; w_[j_] = *(const LAS f32x4*)(p_); if (OUT) r_[j_] = *(const LAS f32x4*)(p_ + 64); k_[j_] = *(const LAS f32x4*)(p_ + 128); \
                kk_[j_] = *(const LAS f32x4*)(p_ + 256); b_[j_] = *(const LAS f32x4*)(p_ + 320); v_[j_][0] = vb0[(s_) * 384]; v_[j_][1] = vb1[(s_) * 384]; } while (0)
            SC_LD(0, 0);
#pragma unroll
            for (int s = 0; s < STS; ++s) { const int j = s & 1;
                f32x4 rp; if (OUT) rp = r_[j ^ 1];
                if (s + 1 < STS) SC_LD(s + 1, j ^ 1);
                const f32x4 w = w_[j], k = k_[j], kk = kk_[j], bv = b_[j];
#pragma unroll
                for (int r = 0; r < 2; ++r) { const float v = use_v ? v_[j][r] : 0.f;
                    float sa, op, u0, u1, u2, u3;
                    if (OUT && s > 0) {
                        asm volatile(
                            "v_mul_f32 %[sa], %[Sa], %[kk0]\n\t" "v_fma_f32 %[sa], %[Sb], %[kk1], %[sa]\n\t" "v_fma_f32 %[sa], %[Sc], %[kk2], %[sa]\n\t" "v_fma_f32 %[sa], %[Sd], %[kk3], %[sa]\n\t"
                            "v_mul_f32 %[op], %[Sa], %[r0]\n\t" "v_fma_f32 %[op], %[Sb], %[r1], %[op]\n\t"
                            DPP_ADD("sa", "quad_perm:[1,0,3,2]") "v_fma_f32 %[op], %[Sc], %[r2], %[op]\n\t" "v_fma_f32 %[op], %[Sd], %[r3], %[op]\n\t"
                            DPP_ADD("sa", "quad_perm:[2,3,0,1]") "v_mul_f32 %[u0], %[v], %[k0]\n\t" "v_mul_f32 %[u1], %[v], %[k1]\n\t"
                            DPP_ADD("sa", "row_half_mirror") "v_mul_f32 %[u2], %[v], %[k2]\n\t" "v_mul_f32 %[u3], %[v], %[k3]\n\t"
                            DPP_ADD("sa", "row_mirror")
                            : [sa] "=&v"(sa), [op] "=&v"(op), [u0] "=&v"(u0), [u1] "=&v"(u1), [u2] "=&v"(u2), [u3] "=&v"(u3)
                            : [Sa] "v"(S[r][0]), [Sb] "v"(S[r][1]), [Sc] "v"(S[r][2]), [Sd] "v"(S[r][3]), [kk0] "v"(kk[0]), [kk1] "v"(kk[1]), [kk2] "v"(kk[2]), [kk3] "v"(kk[3]),
                              [r0] "v"(rp[0]), [r1] "v"(rp[1]), [r2] "v"(rp[2]), [r3] "v"(rp[3]), [v] "v"(v), [k0] "v"(k[0]), [k1] "v"(k[1]), [k2] "v"(k[2]), [k3] "v"(k[3]));
                        (r == 0 ? ob0 : ob1)[(s - 1) * 1024] = op;
                    } else {
                        asm volatile(
                            "v_mul_f32 %[sa], %[Sa], %[kk0]\n\t" "v_fma_f32 %[sa], %[Sb], %[kk1], %[sa]\n\t" "v_fma_f32 %[sa], %[Sc], %[kk2], %[sa]\n\t" "v_fma_f32 %[sa], %[Sd], %[kk3], %[sa]\n\t"
                            "v_mul_f32 %[u0], %[v], %[k0]\n\t" "v_mul_f32 %[u1], %[v], %[k1]\n\t"
                            DPP_ADD("sa", "quad_perm:[1,0,3,2]") "v_mul_f32 %[u2], %[v], %[k2]\n\t" "v_mul_f32 %[u3], %[v], %[k3]\n\t"
                            DPP_ADD("sa", "quad_perm:[2,3,0,1]") "s_nop 1\n\t"
                            DPP_ADD("sa", "row_half_mirror") "s_nop 1\n\t"
                            DPP_ADD("sa", "row_mirror")
                            : [sa] "=&v"(sa), [u0] "=&v"(u0), [u1] "=&v"(u1), [u2] "=&v"(u2), [u3] "=&v"(u3)
                            : [Sa] "v"(S[r][0]), [Sb] "v"(S[r][1]), [Sc] "v"(S[r][2]), [Sd] "v"(S[r][3]), [kk0] "v"(kk[0]), [kk1] "v"(kk[1]), [kk2] "v"(kk[2]), [kk3] "v"(kk[3]),
                              [v] "v"(v), [k0] "v"(k[0]), [k1] "v"(k[1]), [k2] "v"(k[2]), [k3] "v"(k[3]));
                    }
                    asm volatile(
                        "v_fma_f32 %[u0], -%[sa], %[b0], %[u0]\n\t" "v_fma_f32 %[u1], -%[sa], %[b1], %[u1]\n\t" "v_fma_f32 %[u2], -%[sa], %[b2], %[u2]\n\t" "v_fma_f32 %[u3], -%[sa], %[b3], %[u3]\n\t"
                        "v_fma_f32 %[Sa], %[Sa], %[w0], %[u0]\n\t" "v_fma_f32 %[Sb], %[Sb], %[w1], %[u1]\n\t" "v_fma_f32 %[Sc], %[Sc], %[w2], %[u2]\n\t" "v_fma_f32 %[Sd], %[Sd], %[w3], %[u3]\n\t"
                        : [Sa] "+v"(S[r][0]), [Sb] "+v"(S[r][1]), [Sc] "+v"(S[r][2]), [Sd] "+v"(S[r][3]), [u0] "+v"(u0), [u1] "+v"(u1), [u2] "+v"(u2), [u3] "+v"(u3)
                        : [sa] "v"(sa), [b0] "v"(bv[0]), [b1] "v"(bv[1]), [b2] "v"(bv[2]), [b3] "v"(bv[3]), [w0] "v"(w[0]), [w1] "v"(w[1]), [w2] "v"(w[2]), [w3] "v"(w[3])); }
                __builtin_amdgcn_sched_barrier(0); }
            if (OUT) { const f32x4 r4 = r_[(STS - 1) & 1];
              ob0[(STS - 1) * 1024] = a_fma(S[0][3], r4[3], a_fma(S[0][2], r4[2], a_fma(S[0][1], r4[1], a_mul(S[0][0], r4[0]))));
              ob1[(STS - 1) * 1024] = a_fma(S[1][3], r4[3], a_fma(S[1][2], r4[2], a_fma(S[1][1], r4[1], a_mul(S[1][0], r4[0])))); }
#undef SC_LD
        }
        RAW_BAR();
        if (OUT) {
            const LAS f32x4* p = (const LAS f32x4*)(obuf + (sc & 1) * OB + tid * 16); const f32x4 a = p[0], b = p[1], c = p[2], d = p[3];
            const float o = (((a[0] + a[1]) + (a[2] + a[3])) + ((b[0] + b[1]) + (b[2] + b[3]))) + (((c[0] + c[1]) + (c[2] + c[3])) + ((d[0] + d[1]) + (d[2] + d[3])));
            Og[((size_t)sc * STS + (tid >> 6)) * 256 + (tid & 63)] = o; }
      }
    }
#undef ST_LOAD
#undef ST_STORE
    if (endS) {
#pragma unroll
        for (int r = 0; r < 2; ++r) *(f32x4*)(endS + (size_t)rowr[r] * 64 + 4 * ks) = (f32x4){S[r][0], S[r][1], S[r][2], S[r][3]}; }
    RAW_BAR();
}
#undef DPP_ADD
__device__ __forceinline__ void rwkv_carry(Frame& F) {
    const int hb = F.bx >> 3, row = (F.bx & 7) * 8 + F.wave, lane = F.lane, tid = F.tid;
    LAS float* Pl = (LAS float*)F.lds;
    LAS float* Sl = (LAS float*)(F.lds + 16384) + F.wave * 64;
    float S = 0.f;
    const size_t m0 = (size_t)hb * RC_N * 4096;
    f32x4 p0 = *(const f32x4*)(F.PB + m0 + (size_t)tid * 8), p1 = *(const f32x4*)(F.PB + m0 + (size_t)tid * 8 + 4);
    float lc = F.LB[m0 + (size_t)row * 64 + lane];
#pragma unroll 1
    for (int c = 0; c < RC_N; ++c) { const size_t mo = m0 + (size_t)c * 4096;
        F.SB[mo + (size_t)row * 64 + lane] = S;
        if (c + 1 == RC_N) break;
        float acc = lc;
        *(LAS f32x4*)(Pl + tid * 8) = p0; *(LAS f32x4*)(Pl + tid * 8 + 4) = p1; Sl[lane] = S;
        if (c + 2 < RC_N) { p0 = *(const f32x4*)(F.PB + mo + 4096 + (size_t)tid * 8); p1 = *(const f32x4*)(F.PB + mo + 4096 + (size_t)tid * 8 + 4); lc = F.LB[mo + 4096 + (size_t)row * 64 + lane]; }
        RAW_BAR();
        float a0 = 0.f, a1 = 0.f, a2 = 0.f, a3 = 0.f;
#pragma unroll 4
        for (int j = 0; j < 64; j += 4) { const f32x4 s4 = *(const LAS f32x4*)(Sl + j);
            a0 += s4[0] * Pl[(j + 0) * 64 + lane]; a1 += s4[1] * Pl[(j + 1) * 64 + lane]; a2 += s4[2] * Pl[(j + 2) * 64 + lane]; a3 += s4[3] * Pl[(j + 3) * 64 + lane]; }
        S = acc + ((a0 + a1) + (a2 + a3));
        RAW_BAR();
    }
}
__device__ __forceinline__ float gelu_tanh(float x) { const float u = 0.7978845608028654f * (x + 0.044715f * x * x * x); return 0.5f * x * (1.0f + tanhf(u)); }
__device__ __forceinline__ void s5_pass2(Frame& F, int l, int c) {
    LAS float* ubuf = (LAS float*)F.lds;
    LAS float* ybuf = (LAS float*)(F.lds + 65536);
    const int t0 = c * 64, lane = F.lane, wave = F.wave, cb0 = c & ~127;
    load_u5_tile(F, t0, ubuf);
    __syncthreads();
#pragma unroll 1
    for (int gi = 0; gi < 2; ++gi) { const int g = wave + 8 * gi; S5Par P; s5_params(F, l, g, lane, P);
        float cr[16], ci[16]; int lane_l = lane; asm volatile("" : "+v"(lane_l));
#pragma unroll
        for (int hh = 0; hh < 16; ++hh) { cr[hh] = F.in[12][(((size_t)l * 16 + g) * 16 + hh) * 64 + lane_l]; ci[hh] = F.in[13][(((size_t)l * 16 + g) * 16 + hh) * 64 + lane_l]; }
        float pr = P.ar, pi = P.ai;
#pragma unroll
        for (int s = 0; s < 6; ++s) { const float nr = pr * pr - pi * pi, ni = 2.0f * pr * pi; pr = nr; pi = ni; }
        float hr = 0.f, hi = 0.f;
#pragma unroll 1
        for (int c2 = cb0; c2 < c; c2 += 16) {
            f32x2 e[16];
#pragma unroll
            for (int q = 0; q < 16; ++q) { const int cq = (c2 + q < c) ? c2 + q : c2; e[q] = *(const f32x2*)(F.E + (((size_t)cq * 16 + g) * 64 + lane_l) * 2); }
#pragma unroll
            for (int q = 0; q < 16; ++q) if (c2 + q < c) { const float nr = pr * hr - pi * hi + e[q][0], ni = pr * hi + pi * hr + e[q][1]; hr = nr; hi = ni; } }
        const bool b3 = (lane & 8) != 0, b2 = (lane & 4) != 0, b1 = (lane & 2) != 0, b0 = (lane & 1) != 0;
#pragma unroll 1
        for (int j = 0; j < 64; ++j) { s5_step(P, ubuf + j * 256 + g * 16, hr, hi);
            float v8[8], v4[4], v2[2];
#pragma unroll
            for (int i = 0; i < 8; ++i) { const float lo = hr * cr[i] - hi * ci[i], hv = hr * cr[i + 8] - hi * ci[i + 8];
                const float keep = b3 ? hv : lo, send = b3 ? lo : hv; v8[i] = keep + dppx<0x140>(send); }
#pragma unroll
            for (int i = 0; i < 4; ++i) { const float keep = b2 ? v8[i + 4] : v8[i], send = b2 ? v8[i] : v8[i + 4]; v4[i] = keep + dppx<0x141>(send); }
#pragma unroll
            for (int i = 0; i < 2; ++i) { const float keep = b1 ? v4[i + 2] : v4[i], send = b1 ? v4[i] : v4[i + 2]; v2[i] = keep + dppx<0x4E>(send); }
            float y = (b0 ? v2[1] : v2[0]) + dppx<0xB1>(b0 ? v2[0] : v2[1]);
            y += __shfl_xor(y, 16); y += __shfl_xor(y, 32);
            if (lane < 16) ybuf[j * 256 + g * 16 + lane] = y; }
    }
    __syncthreads();
    { const int ch = F.tid & 255, half = F.tid >> 8; const float dd = F.in[14][(size_t)l * 256 + ch];
        for (int tt = 0; tt < 32; ++tt) { const int tl = half * 32 + tt; const float y = ybuf[tl * 256 + ch] + dd * ubuf[tl * 256 + ch];
            F.GL[(size_t)(t0 + tl) * 256 + ch] = (bf16_t)f2bf(gelu_tanh(y)); } }
    __syncthreads();
}
template <int PART> __device__ __forceinline__ void m2_phase(Frame& F, int l, const XcdBarrier& xbar) {
    if (PART == 0 || PART == 1)
#pragma unroll 1
    for (int id = F.bx; id < 8 * RC_N * 2; id += F.G) { const int hb = id >> 6, c = (id >> 1) & (RC_N - 1), tk = id & 1; const size_t mo = ((size_t)hb * RC_N + c) * 4096;
        if (c == RC_N - 1) continue;
        const unsigned char* src = F.RW + ((size_t)hb * SEQ + (size_t)c * RC_LEN) * 896;
        scan_task<false>(F, src, nullptr, tk == 1, tk == 0, (tk == 0 ? F.LB : F.PB) + mo, nullptr); }
    if (PART == 0 || PART == 2)
#pragma unroll 1
    for (int c = F.bx; c < TT / 64; c += F.G) pool_conv_chunk(F, l, c);
    xcd_barrier(xbar);
    if (PART == 0 || PART == 3) { int bxs = F.bx; asm volatile("" : "+s"(bxs));
      if (bxs < 64) rwkv_carry(F);
      else conv_second_half(F, l, 64); }
    xcd_barrier(xbar);
    if (PART == 0 || PART == 4)
#pragma unroll 1
    for (int id = F.bx; id < 8 * RC_N; id += F.G) { const int hb = id >> 5, c = id & (RC_N - 1); const size_t mo = ((size_t)hb * RC_N + c) * 4096;
        const unsigned char* src = F.RW + ((size_t)hb * SEQ + (size_t)c * RC_LEN) * 896;
        float* Og = F.O + ((size_t)(hb >> 2) * SEQ + (size_t)c * RC_LEN) * 256 + (hb & 3) * 64;
        scan_task<true>(F, src, F.SB + mo, false, true, nullptr, Og); }
    if (PART == 0 || PART == 5)
#pragma unroll 1
    for (int c = F.bx; c < TT / 64; c += F.G) s5_pass2(F, l, c);
}
__device__ __forceinline__ void rwkv_post(Frame& F, int l) {
    const int gw = F.bx * NWAVES + F.wave, NGW = F.G * NWAVES, lane = F.lane;
    for (int it0 = gw * 4; it0 < TT * 4; it0 += NGW * 4) {
        const int t = it0 >> 2, b = t / SEQ, pos = t & (SEQ - 1);
        float o[4], r[4], k[4], v[4], g[4];
#pragma unroll
        for (int hh = 0; hh < 4; ++hh) { const int c = hh * 64 + lane; o[hh] = F.O[(size_t)t * 256 + c]; g[hh] = (float)F.G16[(size_t)t * 256 + c];
            const h16* rw = (const h16*)(F.RW + ((size_t)(b * 4 + hh) * SEQ + pos) * 896 + 256) + lane; r[hh] = (float)rw[0]; k[hh] = (float)rw[64]; v[hh] = (float)rw[128]; }
#pragma unroll
        for (int hh = 0; hh < 4; ++hh) { const int c = hh * 64 + lane;
            const float mu = wave_sum(o[hh]) * (1.0f / 64.0f); const float d = o[hh] - mu; const float var = wave_sum(d * d) * (1.0f / 64.0f);
            const float on = d * rsqrtf(var + 64e-5f) * F.in[31][(size_t)l * 256 + c] + F.in[32][(size_t)l * 256 + c];
            const float bs = wave_sum(r[hh] * k[hh] * F.in[30][(size_t)l * 256 + c]);
            F.B2[(size_t)t * 1024 + 512 + c] = (bf16_t)f2bf((on + bs * v[hh]) * g[hh]); }
    }
}

constexpr int NPH = 25;
#ifndef PHMASK
#define PHMASK 0xFFFF
#endif
#define PHON(k) (((PHMASK) >> (k)) & 1)
#ifndef REP_PART
#define REP_PART 0
#endif
template <int PH, int PART = 0> __device__ __forceinline__ void run_phase(const int wave_s, unsigned char* lds_raw, const XcdBarrier& xbar) {
    typedef pg8::StaticOrder SO;
    int tid = wave_s * 64 + (int)__builtin_amdgcn_mbcnt_hi(~0u, __builtin_amdgcn_mbcnt_lo(~0u, 0u)); asm volatile("" : "+v"(tid));
    int G = gridDim.x, bx = blockIdx.x; asm volatile("" : "+s"(G), "+s"(bx));
    const __attribute__((address_space(4))) unsigned char* ka = (const __attribute__((address_space(4))) unsigned char*)__builtin_amdgcn_kernarg_segment_ptr();
    asm volatile("" : "+s"(ka));
    const __attribute__((address_space(4))) Args* ap = (const __attribute__((address_space(4))) Args*)ka;
    Frame F;
    F.lds = (LAS unsigned char*)lds_raw;
    F.tid = tid; F.lane = tid & 63; F.wave = __builtin_amdgcn_readfirstlane(tid >> 6); F.G = G; F.bx = bx;
    F.in = (in_t)ka; F.X = ap->out; F.ws = ap->ws;
    unsigned char* ws = F.ws;
    F.SS = (float*)(ws + WS_SS); F.E = (float*)(ws + WS_E); F.B1 = (bf16_t*)(ws + WS_B1); F.B2 = (bf16_t*)(ws + WS_B2);
    unsigned char* z = ws + WS_Z;
    F.HID = (bf16_t*)(z + Z_HID); F.GL = (bf16_t*)(z + Z_GL); F.U5 = (h16*)(z + Z_U5); F.PP = (h16*)(z + Z_PP); F.L16 = (h16*)(z + Z_L16); F.G16 = (h16*)(z + Z_G16); F.R = (h16*)(z + Z_R);
    F.O = (float*)(z + Z_O); F.RW = z + Z_RW; F.PB = (float*)(z + Z_PB); F.LB = (float*)(z + Z_LB); F.SB = (float*)(z + Z_SB);
    if constexpr (PH == 0) { conv_first_half(F, 0); prep_x(F); }
    else { constexpr int l = (PH - 1) / 12, k = (PH - 1) % 12;
        if constexpr (k == 0) { pg8::Gemm g{F.B1, (const bf16_t*)(ws + WS_W + W_GU1), TT, 2 * FF, DM, 1}; SO S; S.init(TT, 2 * FF, G, bx); pg8::EpiGU E{F.HID, F.SS}; pg8::gemm_phase<pg8::EpiGU, SO, true, true>(F.lds, g, S, E, tid); }
        else if constexpr (k == 1) { pg8::Gemm g{F.HID, (const bf16_t*)(ws + WS_W + W_D1), TT, DM, FF, 1}; SO S; S.init(TT, DM, G, bx); pg8::EpiDown E{l == 0 ? F.in[0] : F.X, F.X, F.B1, F.SS, 0.5f}; pg8::gemm_phase<pg8::EpiDown, SO, true, true>(F.lds, g, S, E, tid); }
        else if constexpr (k == 2) { pg8::Gemm g{F.B1, (const bf16_t*)(ws + WS_W + W_INA), TT, 2560, DM, 1}; SO S; S.init(TT, 2560, G, bx); pg8::EpiInA E{F.U5, F.PP, F.L16, F.SS}; pg8::gemm_phase<pg8::EpiInA, SO, true, true>(F.lds, g, S, E, tid); }
        else if constexpr (k == 3) { m1_phase(F, l); }
        else if constexpr (k == 4) { m2_phase<PART>(F, l, xbar); }
        else if constexpr (k == 5) { { pg8::Gemm g{F.GL, (const bf16_t*)(ws + WS_W + W_GLU), TT, 256, 256, 1}; SO S; S.init(TT, 256, G, bx); pg8::EpiGlu E{F.GL, F.B2}; pg8::gemm_phase<pg8::EpiGlu, SO, true, true>(F.lds, g, S, E, tid); } rwkv_post(F, l); }
        else if constexpr (k == 6) { pg8::Gemm g{F.B1, (const bf16_t*)(ws + WS_W + W_ING), TT, 4096, DM, 1}; SO S; S.init(TT, 4096, G, bx); pg8::EpiGate E{F.R, F.SS}; pg8::gemm_phase<pg8::EpiGate, SO, true, true>(F.lds, g, S, E, tid); }
        else if constexpr (k == 7) { pg8::Gemm g{F.B2, (const bf16_t*)(ws + WS_W + W_BR), TT, DM, DM, 4}; pg8::SegOrder4 S; S.so.init(TT, DM, G, bx); pg8::EpiBranch E{F.R, F.B1}; pg8::gemm_phase<pg8::EpiBranch, pg8::SegOrder4, true, true>(F.lds, g, S, E, tid); }
        else if constexpr (k == 8) { pg8::Gemm g{F.B1, (const bf16_t*)(ws + WS_W + W_O), TT, DM, DM, 1}; SO S; S.init(TT, DM, G, bx); pg8::EpiDown E{F.X, F.X, F.B2, F.SS, 1.0f}; pg8::gemm_phase<pg8::EpiDown, SO, true, true>(F.lds, g, S, E, tid); }
        else if constexpr (k == 9) { pg8::Gemm g{F.B2, (const bf16_t*)(ws + WS_W + W_GU2), TT, 2 * FF, DM, 1}; SO S; S.init(TT, 2 * FF, G, bx); pg8::EpiGU E{F.HID, F.SS}; pg8::gemm_phase<pg8::EpiGU, SO, true, true>(F.lds, g, S, E, tid); }
        else if constexpr (k == 10) { pg8::Gemm g{F.HID, (const bf16_t*)(ws + WS_W + W_D2), TT, DM, FF, 1}; SO S; S.init(TT, DM, G, bx); pg8::EpiDown E{F.X, F.X, F.B1, F.SS, 0.5f}; pg8::gemm_phase<pg8::EpiDown, SO, true, true>(F.lds, g, S, E, tid); }
        else { if constexpr (l == 0) conv_first_half(F, 1); else final_norm(F); }
    }
}
#ifndef REPMASK
#define REPMASK 0
#endif
#define SEAM(k_) do { if ((k_) == 0) { __syncthreads(); cg::this_grid().sync(); } else xcd_barrier(xbar); } while (0)
#define PHASE(k) if (ph_lo <= (k) && (k) < ph_hi) { run_phase<(k)>(wave_s, lds_raw, xbar); \
    if ((k) >= 1 && ((REPMASK >> (((k) - 1) % 12)) & 1)) { SEAM(k); run_phase<(k), REP_PART>(wave_s, lds_raw, xbar); } \
    if ((k) + 1 < ph_hi) SEAM(k); }
__global__ void __launch_bounds__(NTHR, 2) mk_fwd(Args args) {
    extern __shared__ __attribute__((aligned(16))) unsigned char lds_raw[];
    const int ph_lo = args.ph_lo, ph_hi = args.ph_hi;
    volatile LAS unsigned* xst = (volatile LAS unsigned*)((LAS unsigned char*)lds_raw + (LDS_BYTES - 64));
    if (threadIdx.x == 0) { xst[0] = 0u; xst[1] = 0u; }
    __syncthreads();
    const XcdBarrier xbar = xcd_barrier_post((unsigned*)(args.ws + WS_CTL), xst);
    const int wave_s = __builtin_amdgcn_readfirstlane((int)threadIdx.x >> 6);
    PHASE(0) PHASE(1) PHASE(2) PHASE(3) PHASE(4) PHASE(5) PHASE(6) PHASE(7) PHASE(8) PHASE(9) PHASE(10) PHASE(11) PHASE(12)
    PHASE(13) PHASE(14) PHASE(15) PHASE(16) PHASE(17) PHASE(18) PHASE(19) PHASE(20) PHASE(21) PHASE(22) PHASE(23) PHASE(24)
}

extern "C" void kernel_launch(void* const* d_in, const int* in_sizes, int n_in, void* d_out, int out_size, void* d_ws, size_t ws_size, hipStream_t stream) {
    static int grid = 0;
    if (grid == 0) {
        if (n_in != 41 || out_size != TT * DM || ws_size < WS_END) { fprintf(stderr, "kernel_launch: unexpected shapes (n_in %d out %d ws %zu)\n", n_in, out_size, ws_size); grid = -1; return; }
        int dev = 0, cus = 0, per_cu = 0;
        (void)hipGetDevice(&dev); (void)hipDeviceGetAttribute(&cus, hipDeviceAttributeMultiprocessorCount, dev);
        if (hipFuncSetAttribute((const void*)mk_fwd, hipFuncAttributeMaxDynamicSharedMemorySize, LDS_BYTES) != hipSuccess) { fprintf(stderr, "kernel_launch: hipFuncSetAttribute failed\n"); grid = -1; return; }
        if (hipOccupancyMaxActiveBlocksPerMultiprocessor(&per_cu, (const void*)mk_fwd, NTHR, LDS_BYTES) != hipSuccess || per_cu < 1) { fprintf(stderr, "kernel_launch: occupancy query says %d\n", per_cu); per_cu = 1; }
        (void)hipGetLastError();
        grid = cus * (per_cu >= 1 ? 1 : 1);
        if (grid < 64) { fprintf(stderr, "kernel_launch: grid %d too small\n", grid); }
    }
    if (grid < 0) return;
    if (hipMemsetAsync((char*)d_ws + WS_CTL, 0, CTL_ZERO_BYTES, stream) != hipSuccess) { fprintf(stderr, "kernel_launch: hipMemsetAsync failed\n"); return; }
    Args a{};
    for (int i = 0; i < 41; ++i) a.in[i] = (const float*)d_in[i];
    a.out = (float*)d_out; a.ws = (unsigned char*)d_ws;
#if ONE_LAUNCH
    a.ph_lo = 0; a.ph_hi = NPH;
    void* kargs[] = {&a};
    hipError_t e = hipLaunchCooperativeKernel((const void*)mk_fwd, dim3(grid), dim3(NTHR), kargs, LDS_BYTES, stream);
    if (e != hipSuccess) fprintf(stderr, "cooperative launch failed: %s (grid %d)\n", hipGetErrorString(e), grid);
#else
    for (int ph = 0; ph < NPH; ++ph) { a.ph_lo = ph; a.ph_hi = ph + 1; hipLaunchKernelGGL(mk_fwd, dim3(grid), dim3(NTHR), LDS_BYTES, stream, a); }
#endif
}
```

```cpp
#include <hip/hip_runtime.h>
#include <hip/hip_cooperative_groups.h>
#include <cstdio>
#include <cstdint>
#include <cstddef>
namespace cg = cooperative_groups;
namespace pg8 {
#define PG8_LAS __attribute__((address_space(3)))
typedef unsigned short bf16_t;
typedef short bf16x8 __attribute__((ext_vector_type(8)));
typedef float f32x4 __attribute__((ext_vector_type(4)));
typedef unsigned u32x4 __attribute__((ext_vector_type(4)));
constexpr int BM = 256, BK = 64, HALF = 128, HTB = HALF * BK * 2  , STAGE_BYTES = 8 * HTB, NXCD = 8, WGM = 8;

__host__ __device__ __forceinline__ int lds_byte(int r, int c) { const int st = (r >> 4) * 2 + (c >> 5), rr = r & 15, cc = c & 31, ob = rr * 64 + cc * 2; return st * 1024 + (ob ^ (((ob >> 9) & 1) << 5)); }
__host__ __device__ __forceinline__ void stage_rc(int b, int& R, int& C) { const int st = b / 1024, sb = b % 1024, swz = sb ^ (((sb >> 9) & 1) << 5); R = (st >> 1) * 16 + swz / 64; C = (st & 1) * 32 + (swz % 64) / 2; }
__host__ __device__ __forceinline__ int perm32(int rho) { const int n = rho >> 4, i = rho & 15; return 8 * (i >> 2) + 4 * n + (i & 3); }

struct Unit { int pm, pn, g; };
struct Gemm { const bf16_t* A; const bf16_t* Bt; int M, N, K, nseg; };

struct StaticOrder {
    int nM, nN, nwg, G, c;
    __host__ __device__ void init(int M, int N, int G_, int c_) { nM = M / BM; nN = N / BM; nwg = nM * nN; G = G_; c = c_; }
    __host__ __device__ bool next(int i, Unit& u) const {
        const long L = (long)i * G + c; if (L >= nwg) return false;
        int wgid = (int)L; { const int q = nwg / NXCD, r = nwg % NXCD, xcd = wgid % NXCD, off = wgid / NXCD; wgid = (xcd < r ? xcd * (q + 1) : r * (q + 1) + (xcd - r) * q) + off; }
        const int nig = WGM * nN, gid = wgid / nig, fm = gid * WGM, gsz = (nM - fm) < WGM ? (nM - fm) : WGM;
        u.pm = fm + ((wgid % nig) % gsz); u.pn = (wgid % nig) / gsz; u.g = 0; return true;
    }
    __device__ __forceinline__ void a_ready(const Unit&) const {}
    __device__ __forceinline__ void done(const Unit&) const {}
};


struct SegOrder4 {
    StaticOrder so;
    __host__ __device__ bool next(int i, Unit& u) const { if (!so.next(i >> 2, u)) return false; u.g = i & 3; return true; }
    __device__ __forceinline__ void a_ready(const Unit&) const {}
    __device__ __forceinline__ void done(const Unit&) const {}
};

typedef _Float16 h16;
typedef _Float16 h16x4 __attribute__((ext_vector_type(4)));
typedef unsigned u32x2 __attribute__((ext_vector_type(2)));
__device__ __forceinline__ unsigned cvt_pk_bf16(float lo, float hi) { unsigned r; asm volatile("v_cvt_pk_bf16_f32 %0, %1, %2" : "=v"(r) : "v"(lo), "v"(hi)); return r; }
__device__ __forceinline__ u32x2 pack_bf16x4(f32x4 v) { u32x2 w; w.x = cvt_pk_bf16(v[0], v[1]); w.y = cvt_pk_bf16(v[2], v[3]); return w; }
__device__ __forceinline__ h16x4 pack_h16x4(f32x4 v) { h16x4 w; w[0] = (h16)v[0]; w[1] = (h16)v[1]; w[2] = (h16)v[2]; w[3] = (h16)v[3]; return w; }
__device__ __forceinline__ float fast_sigmoid(float x) { return __builtin_amdgcn_rcpf(1.0f + __expf(-x)); }
__device__ __forceinline__ float row_rstd(const float* SS, int row) {
    const f32x4* p = (const f32x4*)(SS + (size_t)row * 16);
    const f32x4 a = p[0], b = p[1], c = p[2], d = p[3];
    const float s = ((a[0] + a[1]) + (a[2] + a[3])) + ((b[0] + b[1]) + (b[2] + b[3])) + ((c[0] + c[1]) + (c[2] + c[3])) + ((d[0] + d[1]) + (d[2] + d[3]));
    return rsqrtf(s * (1.0f / 1024.0f) + 1e-6f);
}

__device__ __forceinline__ void rows_rstd(const float* SS, int row0, int fq, float (&rs)[8]) {
    f32x4 q[8];
#pragma unroll
    for (int sl = 0; sl < 8; ++sl) q[sl] = *(const f32x4*)(SS + (size_t)(row0 + (sl >> 2) * HALF + (sl & 3) * 16) * 16 + 4 * fq);
#pragma unroll
    for (int sl = 0; sl < 8; ++sl) { float s = (q[sl][0] + q[sl][1]) + (q[sl][2] + q[sl][3]); s += __shfl_xor(s, 16); s += __shfl_xor(s, 32); rs[sl] = rsqrtf(s * (1.0f / 1024.0f) + 1e-6f); }
}

struct EpiGU {
    static constexpr bool PERM = true, KSEG = false;
    bf16_t* hid; const float* SS;
    __device__ __forceinline__ void operator()(const f32x4 (&acc)[2][2][4][2], const Unit& u, int wr, int wc, int fr, int fq) const {
        int row0 = u.pm * BM + wr * 64 + fr; asm volatile("" : "+v"(row0)); const int j0 = u.pn * 128 + wc * 16 + fq * 4;
        float rsv[8]; rows_rstd(SS, row0, fq, rsv);
#pragma unroll
        for (int ai = 0; ai < 2; ++ai)
#pragma unroll
            for (int m = 0; m < 4; ++m) { const int row = row0 + ai * HALF + m * 16; const float rs = rsv[ai * 4 + m];
#pragma unroll
                for (int bj = 0; bj < 2; ++bj) { const f32x4 g = acc[ai][bj][m][0] * rs, up = acc[ai][bj][m][1] * rs; f32x4 h;
#pragma unroll
                    for (int i = 0; i < 4; ++i) h[i] = g[i] * fast_sigmoid(g[i]) * up[i];
                    *(u32x2*)(hid + (size_t)row * 2816 + j0 + bj * 64) = pack_bf16x4(h); } }
    }
};
struct EpiDown {
    static constexpr bool PERM = false, KSEG = false;
    const float* res; float* X; bf16_t* xb; float* SS; float alpha;
    __device__ __forceinline__ void operator()(const f32x4 (&acc)[2][2][4][2], const Unit& u, int wr, int wc, int fr, int fq) const {
        int row0 = u.pm * BM + wr * 64 + fr; asm volatile("" : "+v"(row0)); const int c0 = u.pn * BM + wc * 32 + fq * 4;
#pragma unroll
        for (int ai = 0; ai < 2; ++ai) {
            f32x4 rv[4][2][2];
#pragma unroll
            for (int m = 0; m < 4; ++m)
#pragma unroll
                for (int bj = 0; bj < 2; ++bj)
#pragma unroll
                    for (int n = 0; n < 2; ++n) rv[m][bj][n] = *(const f32x4*)(res + (size_t)(row0 + ai * HALF + m * 16) * 1024 + c0 + bj * HALF + n * 16);
#pragma unroll
            for (int m = 0; m < 4; ++m) { const int row = row0 + ai * HALF + m * 16; float ss = 0.f;
#pragma unroll
                for (int bj = 0; bj < 2; ++bj)
#pragma unroll
                    for (int n = 0; n < 2; ++n) { const size_t off = (size_t)row * 1024 + c0 + bj * HALF + n * 16;
                        const f32x4 o = rv[m][bj][n] + acc[ai][bj][m][n] * alpha;
                        *(f32x4*)(X + off) = o; *(u32x2*)(xb + off) = pack_bf16x4(o);
                        ss += (o[0] * o[0] + o[1] * o[1]) + (o[2] * o[2] + o[3] * o[3]); }
                ss += __shfl_xor(ss, 16); ss += __shfl_xor(ss, 32);
                if (fq == 0) SS[(size_t)row * 16 + u.pn * 4 + wc] = ss; }
            asm volatile("" ::: "memory"); }
    }
};
struct EpiInA {
    static constexpr bool PERM = false, KSEG = false;
    h16* U5; h16* PP; h16* L16; const float* SS;
    __device__ __forceinline__ void operator()(const f32x4 (&acc)[2][2][4][2], const Unit& u, int wr, int wc, int fr, int fq) const {
        int row0 = u.pm * BM + wr * 64 + fr; asm volatile("" : "+v"(row0)); const int cl = wc * 32 + fq * 4;
        float rsv[8]; rows_rstd(SS, row0, fq, rsv);
        h16* base; int ld, cb;
        if (u.pn == 0) { base = U5; ld = 256; cb = 0; } else if (u.pn < 8) { base = PP; ld = 1792; cb = (u.pn - 1) * 256; } else { base = L16; ld = 512; cb = (u.pn - 8) * 256; }
#pragma unroll
        for (int ai = 0; ai < 2; ++ai)
#pragma unroll
            for (int m = 0; m < 4; ++m) { const int row = row0 + ai * HALF + m * 16; const float rs = rsv[ai * 4 + m];
#pragma unroll
                for (int bj = 0; bj < 2; ++bj)
#pragma unroll
                    for (int n = 0; n < 2; ++n) *(h16x4*)(base + (size_t)row * ld + cb + cl + bj * HALF + n * 16) = pack_h16x4(acc[ai][bj][m][n] * rs); }
    }
};
struct EpiGate {
    static constexpr bool PERM = false, KSEG = false;
    h16* R; const float* SS;
    __device__ __forceinline__ void operator()(const f32x4 (&acc)[2][2][4][2], const Unit& u, int wr, int wc, int fr, int fq) const {
        float rsv[8]; int row0 = u.pm * BM + wr * 64 + fr; asm volatile("" : "+v"(row0)); rows_rstd(SS, row0, fq, rsv); const int d0 = 256 * (u.pn >> 2) + 128 * ((u.pn >> 1) & 1) + 16 * (u.pn & 1) + 32 * wc + 4 * fq;
#pragma unroll
        for (int ai = 0; ai < 2; ++ai)
#pragma unroll
            for (int m = 0; m < 4; ++m) { const int row = row0 + ai * HALF + m * 16; const float rs = rsv[ai * 4 + m];
                f32x4 e[4];
#pragma unroll
                for (int g = 0; g < 4; ++g)
#pragma unroll
                    for (int i = 0; i < 4; ++i) e[g][i] = 1.0f + __expf(-fminf(fmaxf(acc[ai][g >> 1][m][g & 1][i] * rs, -10.f), 30.f));
                f32x4 r[4];
#pragma unroll
                for (int i = 0; i < 4; ++i) { const float i0 = __builtin_amdgcn_rcpf(e[0][i]), i1 = __builtin_amdgcn_rcpf(e[1][i]), i2 = __builtin_amdgcn_rcpf(e[2][i]), i3 = __builtin_amdgcn_rcpf(e[3][i]);
                    r[0][i] = e[1][i] * i0; r[1][i] = e[2][i] * i1; r[2][i] = e[3][i] * i2; r[3][i] = i3; }
#pragma unroll
                for (int g = 0; g < 4; ++g) *(h16x4*)(R + ((size_t)row * 4 + g) * 1024 + d0) = pack_h16x4(r[g]); }
    }
};
struct EpiBranch {
    static constexpr bool PERM = false, KSEG = true;
    const h16* R; bf16_t* out;
    __device__ __forceinline__ void operator()(f32x4 (&acc)[2][2][4][2], const Unit& u, int wr, int wc, int fr, int fq) const {
        unsigned q0 = (unsigned)(u.pm * BM + wr * 64 + fr) * 1024u + (unsigned)(u.pn * BM + wc * 32 + fq * 4); asm volatile("" : "+v"(q0));
        const unsigned r0 = (q0 - (q0 & 1023u)) * 4u + (unsigned)u.g * 1024u + (q0 & 1023u);
        const bool last = u.g == 3;
        h16x4 rr[2][4][2][2];
#pragma unroll
        for (int ai = 0; ai < 2; ++ai)
#pragma unroll
            for (int m = 0; m < 4; ++m)
#pragma unroll
                for (int bj = 0; bj < 2; ++bj)
#pragma unroll
                    for (int n = 0; n < 2; ++n) rr[ai][m][bj][n] = *(const h16x4*)(R + (r0 + (unsigned)((ai * HALF + m * 16) * 4096 + bj * HALF + n * 16)));
#pragma unroll
        for (int ai = 0; ai < 2; ++ai)
#pragma unroll
            for (int m = 0; m < 4; ++m) {
#pragma unroll
                for (int bj = 0; bj < 2; ++bj)
#pragma unroll
                    for (int n = 0; n < 2; ++n) { const unsigned off = q0 + (unsigned)((ai * HALF + m * 16) * 1024 + bj * HALF + n * 16);
                        const h16x4 r = rr[ai][m][bj][n];
                        f32x4 rf; rf[0] = (float)r[0]; rf[1] = (float)r[1]; rf[2] = (float)r[2]; rf[3] = (float)r[3];
                        acc[ai][bj][m][n] = acc[ai][bj][m][n] * rf;
                        if (last) *(u32x2*)(out + off) = pack_bf16x4(acc[ai][bj][m][n]); } }
    }
};
struct EpiGlu {
    static constexpr bool PERM = false, KSEG = false;
    const bf16_t* gl; bf16_t* ys;
    __device__ __forceinline__ void operator()(const f32x4 (&acc)[2][2][4][2], const Unit& u, int wr, int wc, int fr, int fq) const {
        int row0 = u.pm * BM + wr * 64 + fr; asm volatile("" : "+v"(row0)); const int c0 = wc * 32 + fq * 4;
        u32x2 gv[2][4][2][2];
#pragma unroll
        for (int ai = 0; ai < 2; ++ai)
#pragma unroll
            for (int m = 0; m < 4; ++m)
#pragma unroll
                for (int bj = 0; bj < 2; ++bj)
#pragma unroll
                    for (int n = 0; n < 2; ++n) gv[ai][m][bj][n] = *(const u32x2*)(gl + (size_t)(row0 + ai * HALF + m * 16) * 256 + c0 + bj * HALF + n * 16);
#pragma unroll
        for (int ai = 0; ai < 2; ++ai)
#pragma unroll
            for (int m = 0; m < 4; ++m) { const int row = row0 + ai * HALF + m * 16;
#pragma unroll
                for (int bj = 0; bj < 2; ++bj)
#pragma unroll
                    for (int n = 0; n < 2; ++n) { const int c = c0 + bj * HALF + n * 16; const u32x2 g2 = gv[ai][m][bj][n];
                        f32x4 g; g[0] = __uint_as_float(g2.x << 16); g[1] = __uint_as_float(g2.x & 0xffff0000u); g[2] = __uint_as_float(g2.y << 16); g[3] = __uint_as_float(g2.y & 0xffff0000u);
                        f32x4 o;
#pragma unroll
                        for (int i = 0; i < 4; ++i) o[i] = g[i] * fast_sigmoid(acc[ai][bj][m][n][i]);
                        *(u32x2*)(ys + (size_t)row * 1024 + c) = pack_bf16x4(o); } }
    }
};

template <class Epi, class Sched, bool ALIGN_EPI = false, bool SP2 = false>
__device__ __forceinline__ void gemm_phase(PG8_LAS unsigned char* lds, const Gemm g, const Sched& S, const Epi& E, const int tid) {
    const int wid = __builtin_amdgcn_readfirstlane(tid >> 6), lane = tid & 63, wr = wid >> 2, wc = wid & 3, fr = lane & 15, fq = lane >> 4;
    const int K = g.K, nt = K / BK / g.nseg; const size_t segb = (size_t)(K / g.nseg) * 2;
    unsigned voffA[2], voffB[2];
#pragma unroll
    for (int i = 0; i < 2; ++i) { int R, C; stage_rc(tid * 16 + i * 8192, R, C); const int Rb = Epi::PERM ? ((R & ~31) + perm32(R & 31)) : R;
        voffA[i] = (unsigned)(R * K + C) * 2u; voffB[i] = (unsigned)(Rb * K + C) * 2u; }
    const size_t kstep = (size_t)(BK * 2);
    const size_t hstep = (size_t)HALF * K * 2;
    const size_t tstep = 2 * hstep;
    const unsigned ldsw = (unsigned)wid * 1024u;
    const int aoff = lds_byte(wr * 64 + fr, fq * 8), boff = lds_byte(wc * 32 + fr, fq * 8);
#define PG8_SA(b, h) (((b) * 2 + (h)) * HTB)
#define PG8_SB(b, h) ((4 + (b) * 2 + (h)) * HTB)
#define PG8_STAGE(bufoff, gbase, voff) do { _Pragma("unroll") for (int _i = 0; _i < 2; ++_i) \
        __builtin_amdgcn_global_load_lds((const unsigned*)((const char*)(gbase) + (voff)[_i]), (PG8_LAS unsigned*)(lds + (bufoff) + ldsw + _i * 8192), 16, 0, 0); } while (0)
#define PG8_LDA(dst, b, h) do { _Pragma("unroll") for (int m = 0; m < 4; ++m) _Pragma("unroll") for (int k = 0; k < 2; ++k) dst[m][k] = *(const PG8_LAS bf16x8*)(lds + PG8_SA(b, h) + aoff + m * 2048 + k * 1024); } while (0)
#define PG8_LDB(dst, b, h) do { _Pragma("unroll") for (int n = 0; n < 2; ++n) _Pragma("unroll") for (int k = 0; k < 2; ++k) dst[n][k] = *(const PG8_LAS bf16x8*)(lds + PG8_SB(b, h) + boff + n * 2048 + k * 1024); } while (0)
#define PG8_MMA(ai, bj, At, Bt) do { __builtin_amdgcn_s_setprio(1); _Pragma("unroll") for (int m = 0; m < 4; ++m) _Pragma("unroll") for (int n = 0; n < 2; ++n) _Pragma("unroll") for (int k = 0; k < 2; ++k) \
        acc[ai][bj][m][n] = __builtin_amdgcn_mfma_f32_16x16x32_bf16(Bt[n][k], At[m][k], acc[ai][bj][m][n], 0, 0, 0); __builtin_amdgcn_s_setprio(0); } while (0)
#define PG8_WAIT_V(n) asm volatile("s_waitcnt vmcnt(" #n ")" ::: "memory")
#define PG8_WAIT_L(n) asm volatile("s_waitcnt lgkmcnt(" #n ")" ::: "memory")
#define PG8_BAR __builtin_amdgcn_s_barrier()
#define PG8_SCHED __builtin_amdgcn_sched_barrier(0)
    Unit cur, nxt; int ui = 0;
    if (!S.next(0, cur)) return;
    f32x4 acc[2][2][4][2];
#pragma unroll
    for (int a = 0; a < 2; ++a)
#pragma unroll
        for (int b = 0; b < 2; ++b)
#pragma unroll
            for (int m = 0; m < 4; ++m)
#pragma unroll
                for (int n = 0; n < 2; ++n) acc[a][b][m][n] = (f32x4){0.f, 0.f, 0.f, 0.f};
    bf16x8 At[4][2], B0[2][2], B1[2][2];
    const char* cA = (const char*)g.A + (size_t)cur.pm * tstep + (size_t)cur.g * segb; const char* cB = (const char*)g.Bt + (size_t)cur.pn * tstep + (size_t)cur.g * segb;
    S.a_ready(cur);
    if constexpr (SP2) {
        PG8_STAGE(PG8_SB(0, 0), cB, voffB); PG8_STAGE(PG8_SB(0, 1), cB + hstep, voffB); PG8_STAGE(PG8_SA(0, 0), cA, voffA); PG8_STAGE(PG8_SA(0, 1), cA + hstep, voffA);
        if (wr == 1) PG8_BAR;
        PG8_WAIT_V(2); PG8_BAR;
        PG8_STAGE(PG8_SB(1, 0), cB + kstep, voffB); PG8_STAGE(PG8_SA(1, 0), cA + kstep, voffA); PG8_STAGE(PG8_SB(1, 1), cB + hstep + kstep, voffB);
        PG8_WAIT_V(6); PG8_BAR;
    } else {
        PG8_STAGE(PG8_SB(0, 0), cB, voffB); PG8_STAGE(PG8_SA(0, 0), cA, voffA); PG8_STAGE(PG8_SB(0, 1), cB + hstep, voffB); PG8_STAGE(PG8_SA(0, 1), cA + hstep, voffA);
        if (wr == 1) PG8_BAR;
        PG8_WAIT_V(4); PG8_BAR;
        PG8_STAGE(PG8_SB(1, 0), cB + kstep, voffB); PG8_STAGE(PG8_SA(1, 0), cA + kstep, voffA); PG8_STAGE(PG8_SB(1, 1), cB + hstep + kstep, voffB);
        PG8_WAIT_V(6); PG8_BAR;
    }
    for (;;) {
        const bool has_next = S.next(ui + 1, nxt);
        const char* nA = has_next ? (const char*)g.A + (size_t)nxt.pm * tstep + (size_t)nxt.g * segb : cA; const char* nB = has_next ? (const char*)g.Bt + (size_t)nxt.pn * tstep + (size_t)nxt.g * segb : cB;
        for (int t = 0; t < nt; t += 2) {
            const bool last = (t == nt - 2);
            const char* a1 = cA + (size_t)(t + 1) * kstep;
            const char* a2 = last ? nA : cA + (size_t)(t + 2) * kstep; const char* b2 = last ? nB : cB + (size_t)(t + 2) * kstep;
            const char* a3 = a2 + kstep; const char* b3 = b2 + kstep;
            if (last && has_next) S.a_ready(nxt);
            if constexpr (SP2) {
            PG8_LDB(B0, 0, 0); PG8_LDB(B1, 0, 1); PG8_SCHED; PG8_LDA(At, 0, 0); PG8_STAGE(PG8_SA(1, 1), a1 + hstep, voffA);
            PG8_WAIT_V(8); PG8_WAIT_L(0); PG8_BAR; PG8_MMA(0, 0, At, B0); PG8_MMA(0, 1, At, B1); PG8_BAR; PG8_SCHED;
            PG8_LDA(At, 0, 1); PG8_STAGE(PG8_SB(0, 0), b2, voffB); PG8_STAGE(PG8_SB(0, 1), b2 + hstep, voffB); PG8_STAGE(PG8_SA(0, 0), a2, voffA);
            PG8_WAIT_V(8); PG8_WAIT_L(0); PG8_BAR; PG8_MMA(1, 0, At, B0); PG8_MMA(1, 1, At, B1); PG8_BAR; PG8_SCHED;
            PG8_LDB(B0, 1, 0); PG8_LDB(B1, 1, 1); PG8_SCHED; PG8_LDA(At, 1, 0); PG8_STAGE(PG8_SA(0, 1), a2 + hstep, voffA);
            PG8_WAIT_V(8); PG8_WAIT_L(0); PG8_BAR; PG8_MMA(0, 0, At, B0); PG8_MMA(0, 1, At, B1); PG8_BAR; PG8_SCHED;
            PG8_LDA(At, 1, 1); PG8_STAGE(PG8_SB(1, 0), b3, voffB); PG8_STAGE(PG8_SB(1, 1), b3 + hstep, voffB); PG8_STAGE(PG8_SA(1, 0), a3, voffA);
            PG8_WAIT_V(8); PG8_WAIT_L(0); PG8_BAR; PG8_MMA(1, 0, At, B0); PG8_MMA(1, 1, At, B1); PG8_BAR; PG8_SCHED;
            } else {
            PG8_LDB(B0, 0, 0); PG8_SCHED; PG8_LDA(At, 0, 0); PG8_STAGE(PG8_SA(1, 1), a1 + hstep, voffA);
            PG8_WAIT_L(8); PG8_BAR; PG8_WAIT_L(0); PG8_MMA(0, 0, At, B0); PG8_BAR; PG8_SCHED;
            PG8_LDB(B1, 0, 1); PG8_STAGE(PG8_SB(0, 0), b2, voffB);
            PG8_BAR; PG8_WAIT_L(0); PG8_MMA(0, 1, At, B1); PG8_BAR;
            PG8_LDA(At, 0, 1); PG8_STAGE(PG8_SA(0, 0), a2, voffA);
            PG8_BAR; PG8_WAIT_L(0); PG8_MMA(1, 0, At, B0); PG8_BAR; PG8_SCHED;
            PG8_STAGE(PG8_SB(0, 1), b2 + hstep, voffB);
            PG8_WAIT_V(6); PG8_BAR; PG8_MMA(1, 1, At, B1); PG8_BAR;
            PG8_LDB(B0, 1, 0); PG8_SCHED; PG8_LDA(At, 1, 0); PG8_STAGE(PG8_SA(0, 1), a2 + hstep, voffA);
            PG8_WAIT_L(8); PG8_BAR; PG8_WAIT_L(0); PG8_MMA(0, 0, At, B0); PG8_BAR; PG8_SCHED;
            PG8_LDB(B1, 1, 1); PG8_STAGE(PG8_SB(1, 0), b3, voffB);
            PG8_BAR; PG8_WAIT_L(0); PG8_MMA(0, 1, At, B1); PG8_BAR;
            PG8_LDA(At, 1, 1); PG8_STAGE(PG8_SA(1, 0), a3, voffA);
            PG8_BAR; PG8_WAIT_L(0); PG8_MMA(1, 0, At, B0); PG8_BAR; PG8_SCHED;
            PG8_STAGE(PG8_SB(1, 1), b3 + hstep, voffB);
            PG8_WAIT_V(6); PG8_BAR; PG8_MMA(1, 1, At, B1); PG8_BAR;
            }
        }
        if constexpr (ALIGN_EPI) { if (wr == 0) PG8_BAR; }
        E(acc, cur, wr, wc, fr, fq); S.done(cur);
        if (!has_next) break;
        if (!(Epi::KSEG && nxt.g != 0))
#pragma unroll
        for (int a = 0; a < 2; ++a)
#pragma unroll
            for (int b = 0; b < 2; ++b)
#pragma unroll
                for (int m = 0; m < 4; ++m)
#pragma unroll
                    for (int n = 0; n < 2; ++n) acc[a][b][m][n] = (f32x4){0.f, 0.f, 0.f, 0.f};
        cur = nxt; cA = nA; cB = nB; ++ui;
        if constexpr (ALIGN_EPI) { if (wr == 1) PG8_BAR; }
    }
    PG8_WAIT_V(0);
    if constexpr (!ALIGN_EPI) { if (wr == 0) PG8_BAR; }
    PG8_BAR;
#undef PG8_SA
#undef PG8_SB
#undef PG8_STAGE
#undef PG8_LDA
#undef PG8_LDB
#undef PG8_MMA
#undef PG8_WAIT_V
#undef PG8_WAIT_L
#undef PG8_BAR
#undef PG8_SCHED
}
}

#define LAS __attribute__((address_space(3)))
typedef unsigned short bf16_t;
typedef _Float16 h16;
typedef _Float16 h16x4 __attribute__((ext_vector_type(4)));
typedef _Float16 h16x8 __attribute__((ext_vector_type(8)));
typedef float f32x4 __attribute__((ext_vector_type(4)));
typedef float f32x2 __attribute__((ext_vector_type(2)));
typedef unsigned u32x4 __attribute__((ext_vector_type(4)));
typedef unsigned u32x2 __attribute__((ext_vector_type(2)));

#ifndef ONE_LAUNCH
#define ONE_LAUNCH 1
#endif
constexpr int NWAVES = 8, NTHR = 512;
constexpr int TT = 16384, SEQ = 8192, DM = 1024, FF = 2816, MW = 256, INW = 6144;
constexpr int LDS_BYTES = 147456;
constexpr size_t MiB = 1u << 20;
constexpr size_t WS_CTL = 0, CTL_ZERO_BYTES = 16384, WS_SS = 1 * MiB, WS_E = 2 * MiB, WS_W = 4 * MiB, WS_B1 = 34 * MiB, WS_B2 = 66 * MiB, WS_Z = 98 * MiB, WS_END = 262 * MiB;
constexpr size_t W_GU1 = 0, W_D1 = W_GU1 + (size_t)2 * FF * DM * 2, W_INA = W_D1 + (size_t)DM * FF * 2;
constexpr size_t W_ING = 0, W_BR = W_ING + (size_t)4096 * DM * 2, W_O = W_BR + (size_t)DM * DM * 2, W_GU2 = W_O + (size_t)DM * DM * 2, W_D2 = W_GU2 + (size_t)2 * FF * DM * 2, W_GLU = W_D2 + (size_t)DM * FF * 2, W_END2 = W_GLU + 256 * 256 * 2;
static_assert(W_END2 <= 30 * MiB && W_INA + (size_t)2560 * DM * 2 <= 30 * MiB, "W region");
constexpr size_t Z_RW = 0, Z_G16 = 56 * MiB, Z_U5 = 64 * MiB, Z_L16 = 72 * MiB, Z_PP = 88 * MiB, Z_O = 72 * MiB, Z_GL = 144 * MiB, Z_PB = 152 * MiB, Z_LB = 156 * MiB, Z_SB = 160 * MiB;
constexpr size_t Z_HID = 0, Z_R = 0;
static_assert((size_t)TT * 4 * 896 <= 56 * MiB && (size_t)TT * 1792 * 2 <= 56 * MiB && (size_t)TT * FF * 2 <= 144 * MiB && (size_t)TT * 4096 * 2 <= 144 * MiB, "Z region");

typedef const float* cfp_t;
typedef const __attribute__((address_space(4))) cfp_t* in_t;
struct Args { const float* in[41]; float* out; unsigned char* ws; int ph_lo, ph_hi; };

struct Frame {
    LAS unsigned char* lds;
    int tid, lane, wave, G, bx;
    in_t in;
    float* X; unsigned char* ws;
    float* SS; float* E;
    bf16_t *B1, *B2, *HID, *GL;
    h16 *U5, *PP, *L16, *G16, *R;
    float* O; unsigned char* RW;
    float *PB, *LB, *SB;
};

__device__ __forceinline__ unsigned f2bf(float f) { unsigned u = __builtin_bit_cast(unsigned, f); return (u + 0x7fffu + ((u >> 16) & 1u)) >> 16; }
__device__ __forceinline__ unsigned pk2(float lo, float hi) { return f2bf(lo) | (f2bf(hi) << 16); }
#define LDS_WAIT() asm volatile("s_waitcnt lgkmcnt(0)" ::: "memory")
template <int CTRL> __device__ __forceinline__ float dppx(float x) { return __builtin_bit_cast(float, __builtin_amdgcn_update_dpp(0, __builtin_bit_cast(int, x), CTRL, 0xf, 0xf, true)); }
__device__ __forceinline__ float allreduce16(float x) { x += dppx<0xB1>(x); x += dppx<0x4E>(x); x += dppx<0x141>(x); x += dppx<0x140>(x); return x; }
__device__ __forceinline__ float wave_sum(float x) { x = allreduce16(x); x += __shfl_xor(x, 16); x += __shfl_xor(x, 32); return x; }
__device__ __forceinline__ float sigmoidf_(float x) { return __builtin_amdgcn_rcpf(1.0f + __expf(-x)); }

__device__ __forceinline__ int tr_rowmap(int mode, int j, int row0) {
    if (mode == 0) return row0 + j;
    if (mode == 1) return 8 * (j >> 2) + (j & 3);
    if (mode == 2) return 8 * (j >> 2) + 4 + (j & 3);
    const int g = j >> 10, d = j & 1023;
    const int pn = 4 * (d >> 8) + 2 * ((d >> 7) & 1) + ((d >> 4) & 1);
    return 256 * pn + 128 * (g >> 1) + 32 * ((d >> 5) & 3) + 16 * (g & 1) + 4 * ((d >> 2) & 3) + (d & 3);
}
__device__ __forceinline__ void tr_item(const float* W, int ldw, int K, int N, bf16_t* WT, int mode, int row0, const float* s1, const float* s2, int smode, LAS float* scr, int item, int lane) {
    const int nblk = N / 32, kb = item / nblk, nb = item % nblk, k0 = 64 * kb, n0 = 32 * nb;
#pragma unroll 8
    for (int i = 0; i < 32; ++i) { const int kk = 2 * i + (lane >> 5); const int k = k0 + kk; float sc = 1.0f;
        if (s1) sc = s1[k];
        if (smode == 1) sc *= s2[k]; else if (smode == 2) sc *= (1.0f - s2[k]);
        scr[kk * 33 + (lane & 31)] = W[(size_t)k * ldw + n0 + (lane & 31)] * sc; }
    LDS_WAIT(); asm volatile("" ::: "memory");
    const int c = lane & 7;
#pragma unroll
    for (int j = 0; j < 4; ++j) { const int n = (lane >> 3) + 8 * j; const LAS float* s = scr + (8 * c) * 33 + n;
        u32x4 o; o.x = pk2(s[0 * 33], s[1 * 33]); o.y = pk2(s[2 * 33], s[3 * 33]); o.z = pk2(s[4 * 33], s[5 * 33]); o.w = pk2(s[6 * 33], s[7 * 33]);
        *(u32x4*)(WT + (size_t)tr_rowmap(mode, n0 + n, row0) * K + k0 + 8 * c) = o; }
    LDS_WAIT(); asm volatile("" ::: "memory");
}
#define TRJ(W_, ldw_, K_, N_, dst_, mode_, row0_, s1_, s2_, smode_) { const int ni_ = ((K_) / 64) * ((N_) / 32); if (r >= 0 && r < ni_) tr_item(W_, ldw_, K_, N_, dst_, mode_, row0_, s1_, s2_, smode_, scr, r, F.lane); r -= ni_; }
__device__ __forceinline__ void conv_first_half(Frame& F, int l) {
    LAS float* scr = (LAS float*)(F.lds + F.wave * 16384);
    const int gw = F.bx * NWAVES + F.wave, NGW = F.G * NWAVES;
    unsigned char* wb = F.ws + WS_W;
    const float* n1 = F.in[1] + (size_t)l * DM; const float* nm = F.in[5] + (size_t)l * DM; const float* mu = F.in[19] + (size_t)l * 3 * DM;
    const float* w1 = F.in[21] + (size_t)l * DM * 64; const float* a1 = F.in[24] + (size_t)l * DM * 64; const float* g1 = F.in[26] + (size_t)l * DM * 128;
    bf16_t* ina = (bf16_t*)(wb + W_INA);
    for (int it = gw;; it += NGW) { int r = it;
        TRJ(F.in[2] + (size_t)l * DM * FF, FF, DM, FF, (bf16_t*)(wb + W_GU1), 1, 0, n1, nullptr, 0)
        TRJ(F.in[3] + (size_t)l * DM * FF, FF, DM, FF, (bf16_t*)(wb + W_GU1), 2, 0, n1, nullptr, 0)
        TRJ(F.in[4] + (size_t)l * FF * DM, DM, FF, DM, (bf16_t*)(wb + W_D1), 0, 0, nullptr, nullptr, 0)
        TRJ(F.in[6] + (size_t)l * DM * INW, INW, DM, 2048, ina, 0, 0, nm, nullptr, 0)
        TRJ(w1, 64, DM, 64, ina, 0, 2048, nm, mu, 2)
        TRJ(a1, 64, DM, 64, ina, 0, 2112, nm, mu + DM, 2)
        TRJ(g1, 128, DM, 128, ina, 0, 2176, nm, mu + 2 * DM, 2)
        TRJ(w1, 64, DM, 64, ina, 0, 2304, nm, mu, 1)
        TRJ(a1, 64, DM, 64, ina, 0, 2368, nm, mu + DM, 1)
        TRJ(g1, 128, DM, 128, ina, 0, 2432, nm, mu + 2 * DM, 1)
        if (r >= 0) break; }
}
__device__ __forceinline__ void conv_second_half(Frame& F, int l, int b0) {
    LAS float* scr = (LAS float*)(F.lds + F.wave * 16384);
    const int gw = (F.bx - b0) * NWAVES + F.wave, NGW = (F.G - b0) * NWAVES;
    unsigned char* wb = F.ws + WS_W;
    const float* nm = F.in[5] + (size_t)l * DM; const float* n2 = F.in[36] + (size_t)l * DM;
    for (int it = gw;; it += NGW) { int r = it;
        TRJ(F.in[6] + (size_t)l * DM * INW + 2048, INW, DM, 4096, (bf16_t*)(wb + W_ING), 3, 0, nm, nullptr, 0)
        TRJ(F.in[34] + (size_t)l * DM * DM, DM, DM, DM, (bf16_t*)(wb + W_BR), 0, 0, nullptr, nullptr, 0)
        TRJ(F.in[35] + (size_t)l * DM * DM, DM, DM, DM, (bf16_t*)(wb + W_O), 0, 0, nullptr, nullptr, 0)
        TRJ(F.in[37] + (size_t)l * DM * FF, FF, DM, FF, (bf16_t*)(wb + W_GU2), 1, 0, n2, nullptr, 0)
        TRJ(F.in[38] + (size_t)l * DM * FF, FF, DM, FF, (bf16_t*)(wb + W_GU2), 2, 0, n2, nullptr, 0)
        TRJ(F.in[39] + (size_t)l * FF * DM, DM, FF, DM, (bf16_t*)(wb + W_D2), 0, 0, nullptr, nullptr, 0)
        TRJ(F.in[15] + (size_t)l * 256 * 256, 256, 256, 256, (bf16_t*)(wb + W_GLU), 0, 0, nullptr, nullptr, 0)
        if (r >= 0) break; }
}
__device__ __forceinline__ void prep_x(Frame& F) {
    const int gw = F.bx * NWAVES + F.wave, NGW = F.G * NWAVES;
    const float* x = F.in[0];
    for (int m = gw; m < TT; m += NGW) {
        const f32x4* xr = (const f32x4*)(x + (size_t)m * DM) + F.lane; float s = 0.f;
        unsigned long long* o8 = (unsigned long long*)(F.B1 + (size_t)m * DM) + F.lane;
#pragma unroll
        for (int j = 0; j < 4; ++j) { const f32x4 v = xr[64 * j]; s += (v[0] * v[0] + v[1] * v[1]) + (v[2] * v[2] + v[3] * v[3]);
            o8[64 * j] = (unsigned long long)pk2(v[0], v[1]) | ((unsigned long long)pk2(v[2], v[3]) << 32); }
        s += __shfl_xor(s, 1); s += __shfl_xor(s, 2);
        if ((F.lane & 3) == 0) F.SS[(size_t)m * 16 + (F.lane >> 2)] = s;
    }
}
__device__ __forceinline__ void final_norm(Frame& F) {
    const int gw = F.bx * NWAVES + F.wave, NGW = F.G * NWAVES;
    const f32x4* gn = (const f32x4*)F.in[40] + F.lane;
    for (int m = gw; m < TT; m += NGW) {
        const float rs = pg8::row_rstd(F.SS, m);
        f32x4* xr = (f32x4*)(F.X + (size_t)m * DM) + F.lane;
#pragma unroll
        for (int j = 0; j < 4; ++j) { const f32x4 v = xr[64 * j]; xr[64 * j] = v * rs * gn[64 * j]; }
    }
}

struct S5Par { float ar, ai; float bbr[16], bbi[16]; };
__device__ __forceinline__ void s5_params(Frame& F, int l, int g, int p, S5Par& P) {
    asm volatile("" : "+v"(p));
    const float lr = F.in[7][((size_t)l * 16 + g) * 64 + p], li = F.in[8][((size_t)l * 16 + g) * 64 + p], dt = expf(F.in[9][l * 16 + g]);
    const float mag = expf(lr * dt); P.ar = mag * cosf(li * dt); P.ai = mag * sinf(li * dt);
    const float inv = 1.0f / (lr * lr + li * li); const float qr = lr * inv, qi = -li * inv;
    const float cr = (P.ar - 1.0f) * qr - P.ai * qi, ci = (P.ar - 1.0f) * qi + P.ai * qr;
    const f32x4* br = (const f32x4*)(F.in[10] + (((size_t)l * 16 + g) * 64 + p) * 16); const f32x4* bi = (const f32x4*)(F.in[11] + (((size_t)l * 16 + g) * 64 + p) * 16);
#pragma unroll
    for (int q = 0; q < 4; ++q) { const f32x4 a = br[q], b = bi[q];
#pragma unroll
        for (int i = 0; i < 4; ++i) { P.bbr[4 * q + i] = cr * a[i] - ci * b[i]; P.bbi[4 * q + i] = cr * b[i] + ci * a[i]; } }
}
__device__ __forceinline__ void s5_step(const S5Par& P, const LAS float* urow, float& hr, float& hi) {
    const LAS f32x4* u4 = (const LAS f32x4*)urow; float bur = 0.f, bui = 0.f;
#pragma unroll
    for (int q = 0; q < 4; ++q) { const f32x4 u = u4[q];
#pragma unroll
        for (int i = 0; i < 4; ++i) { bur += P.bbr[4 * q + i] * u[i]; bui += P.bbi[4 * q + i] * u[i]; } }
    const float nr = P.ar * hr - P.ai * hi + bur, ni = P.ar * hi + P.ai * hr + bui; hr = nr; hi = ni;
}
__device__ __forceinline__ void load_u5_tile(Frame& F, int t0, LAS float* ubuf) {
    for (int i = F.tid; i < 64 * 64; i += NTHR) { const int t = i >> 6, q = i & 63; const h16x4 v = *(const h16x4*)(F.U5 + (size_t)(t0 + t) * 256 + 4 * q);
        f32x4 f; f[0] = (float)v[0]; f[1] = (float)v[1]; f[2] = (float)v[2]; f[3] = (float)v[3]; *(LAS f32x4*)(ubuf + t * 256 + 4 * q) = f; }
}


template <bool FIRST> __device__ __forceinline__ void mv32(LAS float* accp, float init, const LAS float* hb, const float* wsrc, int ldw) {
    float w[32];
    asm volatile("" : "+v"(wsrc));
#pragma unroll
    for (int j = 0; j < 32; ++j) w[j] = wsrc[(size_t)j * ldw];
#pragma unroll 2
    for (int tt = 0; tt < 32; ++tt) { const LAS f32x4* h4 = (const LAS f32x4*)(hb + tt * 256); float a = FIRST ? init : accp[tt * 256];
#pragma unroll
        for (int q = 0; q < 8; ++q) { const f32x4 v = h4[q]; a += v[0] * w[4 * q] + v[1] * w[4 * q + 1] + v[2] * w[4 * q + 2] + v[3] * w[4 * q + 3]; }
        accp[tt * 256] = a; }
}
__device__ __forceinline__ void m1_phase(Frame& F, int l) {
    LAS float* ubuf = (LAS float*)F.lds;
    LAS float* pl = (LAS float*)(F.lds + 65536);
    const int tid = F.tid, lane = F.lane, wave = F.wave;
    const int ch = tid & 255, half = tid >> 8;
    for (int c = F.bx; c < TT / 64; c += F.G) {
        const int t0 = c * 64, tb = t0 + half * 32, sb = tb & (SEQ - 1);
        load_u5_tile(F, t0, ubuf);
        __syncthreads();
#pragma unroll 1
        for (int gi = 0; gi < 2; ++gi) { const int g = wave + 8 * gi; S5Par P; s5_params(F, l, g, lane, P); float hr = 0.f, hi = 0.f;
#pragma unroll 2
            for (int j = 0; j < 64; ++j) s5_step(P, ubuf + j * 256 + g * 16, hr, hi);
            *(f32x2*)(F.E + (((size_t)c * 16 + g) * 64 + lane) * 2) = (f32x2){hr, hi}; }
        __syncthreads();
        LAS float* accp = pl + half * 32 * 256 + ch;
        h16 la[32], lb[32];
#pragma unroll
        for (int tt = 0; tt < 32; ++tt) { const int t = tb + tt; la[tt] = F.L16[(size_t)t * 512 + ch]; lb[tt] = (sb + tt > 0) ? F.L16[(size_t)(t - 1) * 512 + 256 + ch] : (h16)0.f; }
#pragma unroll
        for (int tt = 0; tt < 32; ++tt) { float pre = (float)la[tt] + (float)lb[tt];
            float a = pre; if (ch < 64) a = 1.0f - 2.0f * __builtin_amdgcn_rcpf(1.0f + __expf(2.0f * pre)); else if (ch >= 128) a = sigmoidf_(pre);
            ubuf[(half * 32 + tt) * 256 + ch] = a; }
        __syncthreads();
        const int hb = (t0 / SEQ) * 4 + (ch >> 6);
        unsigned char* rwb = F.RW + ((size_t)hb * SEQ + sb) * 896;
        const int cl = ch & 63;
        const LAS float* hrow = ubuf + half * 32 * 256;
        {
            const float* wp = F.in[22] + (size_t)l * 64 * 256 + ch;
            mv32<true>(accp, F.in[20][(size_t)l * 256 + ch], hrow, wp, 256);
            mv32<false>(accp, 0.f, hrow + 32, wp + 32 * 256, 256);
#pragma unroll 2
            for (int tt = 0; tt < 32; ++tt) { const float z = -accp[tt * 256]; const float sp = fmaxf(z, 0.f) + __logf(1.0f + __expf(-fabsf(z)));
                const float wlog = -sp - 0.5f; const float dec = __expf(-__expf(wlog));
                *(float*)(rwb + (size_t)tt * 896 + cl * 4) = dec; }
        }
        {
            const float* gp = F.in[27] + (size_t)l * 128 * 256 + ch;
            mv32<true>(accp, 0.f, hrow + 128, gp, 256);
#pragma unroll 1
            for (int kc = 1; kc < 4; ++kc) mv32<false>(accp, 0.f, hrow + 128 + kc * 32, gp + (size_t)kc * 32 * 256, 256);
#pragma unroll 4
            for (int tt = 0; tt < 32; ++tt) F.G16[(size_t)(tb + tt) * 256 + ch] = (h16)accp[tt * 256];
        }
        {
            const float* ap = F.in[25] + (size_t)l * 64 * 256 + ch;
            mv32<true>(accp, F.in[23][(size_t)l * 256 + ch], hrow + 64, ap, 256);
            mv32<false>(accp, 0.f, hrow + 96, ap + 32 * 256, 256);
            const float mur = F.in[18][((size_t)l * 3 + 0) * 256 + ch], muk = F.in[18][((size_t)l * 3 + 1) * 256 + ch], muv = F.in[18][((size_t)l * 3 + 2) * 256 + ch];
            const float kkw = F.in[28][(size_t)l * 256 + ch], kaw = F.in[29][(size_t)l * 256 + ch];
            const h16* pp = F.PP + (size_t)tb * 1792 + 256 + ch;
            float rprev = 0.f, kprev = 0.f, vprev = 0.f;
            if (sb > 0) { rprev = (float)pp[-(ptrdiff_t)1792]; kprev = (float)pp[-(ptrdiff_t)1792 + 256]; vprev = (float)pp[-(ptrdiff_t)1792 + 512]; }
#pragma unroll 1
            for (int t16 = 0; t16 < 32; t16 += 16) {
                h16 rq[16], kq[16], vq[16];
#pragma unroll
                for (int tt = 0; tt < 16; ++tt) { const h16* q = pp + (size_t)(t16 + tt) * 1792; rq[tt] = q[0]; kq[tt] = q[256]; vq[tt] = q[512]; }
#pragma unroll
                for (int tt = 0; tt < 16; ++tt) { const float a = sigmoidf_(accp[(t16 + tt) * 256]);
                    const float rp = (float)rq[tt], kp = (float)kq[tt], vp = (float)vq[tt];
                    const float r = rp + (rprev - rp) * mur, k = kp + (kprev - kp) * muk, v = vp + (vprev - vp) * muv;
                    rprev = rp; kprev = kp; vprev = vp;
                    const float kkv = k * kkw; const float kk = kkv * rsqrtf(fmaxf(wave_sum(kkv * kkv), 1e-24f));
                    const float kt = k * (1.0f + (a - 1.0f) * kaw); const float bb = kk * a;
                    h16* o = (h16*)(rwb + (size_t)(t16 + tt) * 896 + 256) + cl;
                    o[0] = (h16)r; o[64] = (h16)kt; o[128] = (h16)v; o[192] = (h16)kk; o[256] = (h16)bb; } }
        }
        __syncthreads();
    }
}

__device__ __forceinline__ void pool_conv_chunk(Frame& F, int l, int c) {
    LAS float* ubuf = (LAS float*)F.lds;
    LAS float* pl = (LAS float*)(F.lds + 65536);
    const int tid = F.tid; const int ch = tid & 255, half = tid >> 8;
    const int t0 = c * 64, tb = t0 + half * 32, sb = tb & (SEQ - 1);
    {
    {
        const int grp = ch >> 6, win = 2 << grp;
        const h16* up = F.PP + (size_t)tb * 1792 + ch;
        float s = 0.f;
        for (int j = 1; j <= win; ++j) if (sb - j >= 0) s += (float)up[-(ptrdiff_t)j * 1792];
#pragma unroll 1
        for (int t16 = 0; t16 < 32; t16 += 16) {
            h16 uq[16], ul[16];
#pragma unroll
            for (int tt = 0; tt < 16; ++tt) { uq[tt] = up[(size_t)(t16 + tt) * 1792]; ul[tt] = (sb + t16 + tt - win >= 0) ? up[(ptrdiff_t)(t16 + tt - win) * 1792] : (h16)0.f; }
#pragma unroll
            for (int tt = 0; tt < 16; ++tt) { const float u = (float)uq[tt]; s += u; const int pos = sb + t16 + tt;
                s -= (float)ul[tt];
                const float cnt = (float)((pos + 1 < win) ? (pos + 1) : win);
                pl[(half * 32 + t16 + tt) * 256 + ch] = s / cnt - u; } }
    }
    {
        const h16* zp = F.PP + (size_t)tb * 1792 + 1024 + ch;
        const float cw0 = F.in[33][((size_t)l * 3 + 0) * 256 + ch], cw1 = F.in[33][((size_t)l * 3 + 1) * 256 + ch], cw2 = F.in[33][((size_t)l * 3 + 2) * 256 + ch];
        float z2 = 0.f, z1 = 0.f;
        if (sb >= 1) z1 = (float)zp[-(ptrdiff_t)1792 + 512] * (float)zp[-(ptrdiff_t)1792];
        if (sb >= 2) z2 = (float)zp[-(ptrdiff_t)2 * 1792 + 512] * (float)zp[-(ptrdiff_t)2 * 1792];
#pragma unroll 1
        for (int t16 = 0; t16 < 32; t16 += 16) {
            h16 zx[16], zb[16], zc[16];
#pragma unroll
            for (int tt = 0; tt < 16; ++tt) { const h16* q = zp + (size_t)(t16 + tt) * 1792; zx[tt] = q[0]; zb[tt] = q[256]; zc[tt] = q[512]; }
#pragma unroll
            for (int tt = 0; tt < 16; ++tt) { const float z0 = (float)zc[tt] * (float)zx[tt];
                const float y = (float)zb[tt] * (cw0 * z2 + cw1 * z1 + cw2 * z0);
                F.B2[(size_t)(tb + t16 + tt) * 1024 + 768 + ch] = (bf16_t)f2bf(y); z2 = z1; z1 = z0; } }
    }
    __syncthreads();
    LAS float* accu = ubuf + half * 32 * 256 + ch;
    {
        const int grp = ch >> 6, d = ch & 63;
        const float* pw = F.in[16] + (((size_t)l * 4 + grp) * 64) * 64 + d;
        mv32<true>(accu, 0.f, pl + half * 32 * 256 + grp * 64, pw, 64);
        mv32<false>(accu, 0.f, pl + half * 32 * 256 + grp * 64 + 32, pw + 32 * 64, 64);
        const float sc = F.in[17][(size_t)l * 256 + ch];
#pragma unroll 4
        for (int tt = 0; tt < 32; ++tt) F.B2[(size_t)(tb + tt) * 1024 + 256 + ch] = (bf16_t)f2bf(accu[tt * 256] * sc);
    }
    __syncthreads();
    }
}

#define XB_TMO      128
#define XB_XCNT(j)  (256  + 64 * (j))
#define XB_XSUB(j)  (1280 + 64 * (j))
#define XB_XGEN(j)  (2304 + 64 * (j))
#define XB_TOP      3328
#define XB_TOPGEN   3392
#define XCD_BAR_WORDS 3456
#define XB_SPIN_CAP (1u << 18)

__device__ __forceinline__ unsigned xb_ld(unsigned* p)              { return __hip_atomic_load(p, __ATOMIC_RELAXED, __HIP_MEMORY_SCOPE_AGENT); }
__device__ __forceinline__ unsigned xb_add(unsigned* p, unsigned v) { return __hip_atomic_fetch_add(p, v, __ATOMIC_RELAXED, __HIP_MEMORY_SCOPE_AGENT); }
__device__ __forceinline__ unsigned xb_xcc_id() { return (unsigned)__builtin_amdgcn_s_getreg((3 << 11) | 20) & 0xFu; }
#define XB_SPIN(cond, bar) do { unsigned _sp = 0; while (cond) { __builtin_amdgcn_s_sleep(1); \
    if ((++_sp & 255u) == 0u) { if (xb_ld(&(bar)[XB_TMO])) break; if (_sp > XB_SPIN_CAP) { atomicAdd(&(bar)[XB_TMO], 1u); break; } } } } while (0)

struct XcdBarrier {
    unsigned* bar; unsigned x;
    volatile LAS unsigned* st;
};

__device__ __forceinline__ XcdBarrier xcd_barrier_post(unsigned* bar, volatile LAS unsigned* st) {
    XcdBarrier b; b.bar = bar; b.x = xb_xcc_id(); b.st = st;
    if (threadIdx.x == 0) (void)xb_add(&bar[XB_XCNT(b.x)], 1u);
    return b;
}
__device__ __forceinline__ void xcd_barrier_complete(unsigned* bar, unsigned x, unsigned& nloc, unsigned& nx) {
    const unsigned G = gridDim.x * gridDim.y * gridDim.z;
    unsigned sum, cnt, mine, sp = 0u;
    for (;;) {
        sum = 0u; cnt = 0u; mine = 0u;
#pragma unroll
        for (unsigned j = 0; j < 16; ++j) { const unsigned c = xb_ld(&bar[XB_XCNT(j)]); sum += c; cnt += (c > 0u) ? 1u : 0u; mine = (j == x) ? c : mine; }
        if (sum == G) break;
        __builtin_amdgcn_s_sleep(1);
        if ((++sp & 255u) == 0u) { if (xb_ld(&bar[XB_TMO])) break; if (sp > XB_SPIN_CAP) { atomicAdd(&bar[XB_TMO], 1u); break; } }
    }
    nloc = mine > 0u ? mine : 1u; nx = cnt > 0u ? cnt : 1u;
}

__device__ __forceinline__ void xcd_barrier(const XcdBarrier& b) {
    asm volatile("s_waitcnt vmcnt(0)" ::: "memory");
    __syncthreads();
    if (threadIdx.x == 0) {
        unsigned* bar = b.bar;
        __builtin_amdgcn_s_waitcnt(0);
        unsigned nloc = b.st[0], nx = b.st[1];
        if (nloc == 0u) { xcd_barrier_complete(bar, b.x, nloc, nx); b.st[0] = nloc; b.st[1] = nx; }
        const unsigned old = xb_add(&bar[XB_XSUB(b.x)], 1u);
        const unsigned gen = old / nloc;
        if (old + 1u == (gen + 1u) * nloc) {
            __builtin_amdgcn_fence(__ATOMIC_RELEASE, "agent");
            asm volatile("s_waitcnt vmcnt(0)" ::: "memory");
            const unsigned og = xb_add(&bar[XB_TOP], 1u);
            const unsigned tg = og / nx;
            if (og + 1u == (tg + 1u) * nx) xb_add(&bar[XB_TOPGEN], 1u);
            else XB_SPIN(xb_ld(&bar[XB_TOPGEN]) == tg, bar);
            __builtin_amdgcn_fence(__ATOMIC_ACQUIRE, "agent");
            xb_add(&bar[XB_XGEN(b.x)], 1u);
            asm volatile("s_waitcnt vmcnt(0)" ::: "memory");
        } else {
            XB_SPIN(xb_ld(&bar[XB_XGEN(b.x)]) == gen, bar);
            __builtin_amdgcn_fence(__ATOMIC_ACQUIRE, "agent");
            asm volatile("s_waitcnt vmcnt(0)" ::: "memory");
        }
    }
    __syncthreads();
}

__device__ __forceinline__ float a_fma(float a, float b, float c) { float d; asm("v_fma_f32 %0, %1, %2, %3" : "=v"(d) : "v"(a), "v"(b), "v"(c)); return d; }
__device__ __forceinline__ float a_fnma(float a, float b, float c) { float d; asm("v_fma_f32 %0, -%1, %2, %3" : "=v"(d) : "v"(a), "v"(b), "v"(c)); return d; }
__device__ __forceinline__ float a_mul(float a, float b) { float d; asm("v_mul_f32 %0, %1, %2" : "=v"(d) : "v"(a), "v"(b)); return d; }
__device__ __forceinline__ float a_add(float a, float b) { float d; asm("v_add_f32 %0, %1, %2" : "=v"(d) : "v"(a), "v"(b)); return d; }
constexpr int RC_LEN = 256, RC_N = SEQ / RC_LEN;
constexpr int ST_STEPS = 16, ST_FL = ST_STEPS * 384, ST_NPC = ST_STEPS * 56, ST_OB = ST_STEPS * 32 * 16, ST_NSUB = RC_LEN / ST_STEPS;
__device__ __forceinline__ void st_load(const unsigned char* src, int sub, int tid, u32x4 (&rg)[2]) {
#pragma unroll
    for (int n = 0; n < 2; ++n) { const int i = tid + NTHR * n; if (i < ST_NPC) { const int step = i / 56, j = i % 56;
        rg[n] = *(const u32x4*)(src + ((size_t)sub * ST_STEPS + step) * 896 + (j < 16 ? j * 16 : 256 + (j - 16) * 16)); } }
}
__device__ __forceinline__ void st_store(LAS float* buf, int tid, const u32x4 (&rg)[2]) {
#pragma unroll
    for (int n = 0; n < 2; ++n) { const int i = tid + NTHR * n; if (i < ST_NPC) { const int step = i / 56, j = i % 56;
        if (j < 16) { *(LAS u32x4*)(buf + step * 384 + j * 4) = rg[n]; }
        else { const int a = (j - 16) >> 3, e = (j - 16) & 7; const h16x8 h = __builtin_bit_cast(h16x8, rg[n]); f32x4 lo, hi;
            lo[0] = (float)h[0]; lo[1] = (float)h[1]; lo[2] = (float)h[2]; lo[3] = (float)h[3]; hi[0] = (float)h[4]; hi[1] = (float)h[5]; hi[2] = (float)h[6]; hi[3] = (float)h[7];
            LAS f32x4* d = (LAS f32x4*)(buf + step * 384 + 64 + a * 64 + e * 8); d[0] = lo; d[1] = hi; } } }
}
#define RAW_BAR() do { asm volatile("s_waitcnt lgkmcnt(0)" ::: "memory"); __builtin_amdgcn_s_barrier(); asm volatile("" ::: "memory"); } while (0)
#define DPP_ADD(x_, ctl_) "v_add_f32_dpp %[" x_ "], %[" x_ "], %[" x_ "] " ctl_ " row_mask:0xf bank_mask:0xf bound_ctrl:1\n\t"
template <bool OUT> __device__ __forceinline__ void scan_task(Frame& F, const unsigned char* src, const float* initS, bool ident, bool use_v, float* endS, float* Og) {
    constexpr int STS = OUT ? 8 : 16, NSUB = RC_LEN / STS, FL = STS * 384, NPC = STS * 56, PT = (NPC + NTHR - 1) / NTHR, OB = STS * 64 * 16;
    LAS float* buf = (LAS float*)F.lds;
    LAS float* obuf = (LAS float*)(F.lds + 2 * FL * 4);
    const int tid = F.tid, wave = F.wave, lane = F.lane, ks = lane & 15;
    int rowr[2]; float S[2][4];
#pragma unroll
    for (int r = 0; r < 2; ++r) { rowr[r] = (wave * 2 + r) * 4 + (lane >> 4);
        if (initS) { const f32x4 i4 = *(const f32x4*)(initS + (size_t)rowr[r] * 64 + 4 * ks); S[r][0] = i4[0]; S[r][1] = i4[1]; S[r][2] = i4[2]; S[r][3] = i4[3]; }
        else {
#pragma unroll
            for (int e = 0; e < 4; ++e) S[r][e] = (ident && 4 * ks + e == rowr[r]) ? 1.f : 0.f; } }
    u32x4 rg[2][PT];
#define ST_LOAD(sub_, rg_) do { _Pragma("unroll") for (int n_ = 0; n_ < PT; ++n_) { const int i_ = tid + NTHR * n_; if (i_ < NPC) { const int step_ = i_ / 56, j_ = i_ % 56; \
        rg_[n_] = *(const u32x4*)(src + ((size_t)(sub_) * STS + step_) * 896 + (j_ < 16 ? j_ * 16 : 256 + (j_ - 16) * 16)); } } } while (0)
#define ST_STORE(buf_, rg_) do { _Pragma("unroll") for (int n_ = 0; n_ < PT; ++n_) { const int i_ = tid + NTHR * n_; if (i_ < NPC) { const int step_ = i_ / 56, j_ = i_ % 56; \
        if (j_ < 16) { *(LAS u32x4*)((buf_) + step_ * 384 + j_ * 4) = rg_[n_]; } \
        else { const int a_ = (j_ - 16) >> 3, e_ = (j_ - 16) & 7; const h16x8 h_ = __builtin_bit_cast(h16x8, rg_[n_]); f32x4 lo_, hi_; \
            lo_[0] = (float)h_[0]; lo_[1] = (float)h_[1]; lo_[2] = (float)h_[2]; lo_[3] = (float)h_[3]; hi_[0] = (float)h_[4]; hi_[1] = (float)h_[5]; hi_[2] = (float)h_[6]; hi_[3] = (float)h_[7]; \
            LAS f32x4* d_ = (LAS f32x4*)((buf_) + step_ * 384 + 64 + a_ * 64 + e_ * 8); d_[0] = lo_; d_[1] = hi_; } } } } while (0)
    ST_LOAD(0, rg[0]); ST_STORE(buf, rg[0]); ST_LOAD(1, rg[1]); ST_LOAD(2, rg[0]);
    RAW_BAR();
#pragma unroll 1
    for (int sc2 = 0; sc2 < NSUB; sc2 += 2) {
#pragma unroll
      for (int u = 0; u < 2; ++u) { const int sc = sc2 + u;
        if (sc + 1 < NSUB) { ST_STORE(buf + ((sc + 1) & 1) * FL, rg[(u + 1) & 1]); if (sc + 3 < NSUB) ST_LOAD(sc + 3, rg[(u + 1) & 1]); }
        {
            const LAS float* bb = buf + (sc & 1) * FL + 4 * ks; const LAS float* vb0 = buf + (sc & 1) * FL + 192 + rowr[0]; const LAS float* vb1 = buf + (sc & 1) * FL + 192 + rowr[1];
            LAS float* ob0 = obuf + (sc & 1) * OB + rowr[0] * 16 + ks; LAS float* ob1 = obuf + (sc & 1) * OB + rowr[1] * 16 + ks;
            f32x4 w_[2], r_[2], k_[2], kk_[2], b_[2]; float v_[2][2];
#define SC_LD(s_, j_) do { const LAS float* p_ = bb + (s_) * 384; w_[j_] = *(const LAS f32x4*)(p_); if (OUT) r_[j_] = *(const LAS f32x4*)(p_ + 64); k_[j_] = *(const LAS f32x4*)(p_ + 128); \
                kk_[j_] = *(const LAS f32x4*)(p_ + 256); b_[j_] = *(const LAS f32x4*)(p_ + 320); v_[j_][0] = vb0[(s_) * 384]; v_[j_][1] = vb1[(s_) * 384]; } while (0)
            SC_LD(0, 0);
#pragma unroll
            for (int s = 0; s < STS; ++s) { const int j = s & 1;
                f32x4 rp; if (OUT) rp = r_[j ^ 1];
                if (s + 1 < STS) SC_LD(s + 1, j ^ 1);
                const f32x4 w = w_[j], k = k_[j], kk = kk_[j], bv = b_[j];
#pragma unroll
                for (int r = 0; r < 2; ++r) { const float v = use_v ? v_[j][r] : 0.f;
                    float sa, op, u0, u1, u2, u3;
                    if (OUT && s > 0) {
                        asm volatile(
                            "v_mul_f32 %[sa], %[Sa], %[kk0]\n\t" "v_fma_f32 %[sa], %[Sb], %[kk1], %[sa]\n\t" "v_fma_f32 %[sa], %[Sc], %[kk2], %[sa]\n\t" "v_fma_f32 %[sa], %[Sd], %[kk3], %[sa]\n\t"
                            "v_mul_f32 %[op], %[Sa], %[r0]\n\t" "v_fma_f32 %[op], %[Sb], %[r1], %[op]\n\t"
                            DPP_ADD("sa", "quad_perm:[1,0,3,2]") "v_fma_f32 %[op], %[Sc], %[r2], %[op]\n\t" "v_fma_f32 %[op], %[Sd], %[r3], %[op]\n\t"
                            DPP_ADD("sa", "quad_perm:[2,3,0,1]") "v_mul_f32 %[u0], %[v], %[k0]\n\t" "v_mul_f32 %[u1], %[v], %[k1]\n\t"
                            DPP_ADD("sa", "row_half_mirror") "v_mul_f32 %[u2], %[v], %[k2]\n\t" "v_mul_f32 %[u3], %[v], %[k3]\n\t"
                            DPP_ADD("sa", "row_mirror")
                            : [sa] "=&v"(sa), [op] "=&v"(op), [u0] "=&v"(u0), [u1] "=&v"(u1), [u2] "=&v"(u2), [u3] "=&v"(u3)
                            : [Sa] "v"(S[r][0]), [Sb] "v"(S[r][1]), [Sc] "v"(S[r][2]), [Sd] "v"(S[r][3]), [kk0] "v"(kk[0]), [kk1] "v"(kk[1]), [kk2] "v"(kk[2]), [kk3] "v"(kk[3]),
                              [r0] "v"(rp[0]), [r1] "v"(rp[1]), [r2] "v"(rp[2]), [r3] "v"(rp[3]), [v] "v"(v), [k0] "v"(k[0]), [k1] "v"(k[1]), [k2] "v"(k[2]), [k3] "v"(k[3]));
                        (r == 0 ? ob0 : ob1)[(s - 1) * 1024] = op;
                    } else {
                        asm volatile(
                            "v_mul_f32 %[sa], %[Sa], %[kk0]\n\t" "v_fma_f32 %[sa], %[Sb], %[kk1], %[sa]\n\t" "v_fma_f32 %[sa], %[Sc], %[kk2], %[sa]\n\t" "v_fma_f32 %[sa], %[Sd], %[kk3], %[sa]\n\t"
                            "v_mul_f32 %[u0], %[v], %[k0]\n\t" "v_mul_f32 %[u1], %[v], %[k1]\n\t"
                            DPP_ADD("sa", "quad_perm:[1,0,3,2]") "v_mul_f32 %[u2], %[v], %[k2]\n\t" "v_mul_f32 %[u3], %[v], %[k3]\n\t"
                            DPP_ADD("sa", "quad_perm:[2,3,0,1]") "s_nop 1\n\t"
                            DPP_ADD("sa", "row_half_mirror") "s_nop 1\n\t"
                            DPP_ADD("sa", "row_mirror")
                            : [sa] "=&v"(sa), [u0] "=&v"(u0), [u1] "=&v"(u1), [u2] "=&v"(u2), [u3] "=&v"(u3)
                            : [Sa] "v"(S[r][0]), [Sb] "v"(S[r][1]), [Sc] "v"(S[r][2]), [Sd] "v"(S[r][3]), [kk0] "v"(kk[0]), [kk1] "v"(kk[1]), [kk2] "v"(kk[2]), [kk3] "v"(kk[3]),
                              [v] "v"(v), [k0] "v"(k[0]), [k1] "v"(k[1]), [k2] "v"(k[2]), [k3] "v"(k[3]));
                    }
                    asm volatile(
                        "v_fma_f32 %[u0], -%[sa], %[b0], %[u0]\n\t" "v_fma_f32 %[u1], -%[sa], %[b1], %[u1]\n\t" "v_fma_f32 %[u2], -%[sa], %[b2], %[u2]\n\t" "v_fma_f32 %[u3], -%[sa], %[b3], %[u3]\n\t"
                        "v_fma_f32 %[Sa], %[Sa], %[w0], %[u0]\n\t" "v_fma_f32 %[Sb], %[Sb], %[w1], %[u1]\n\t" "v_fma_f32 %[Sc], %[Sc], %[w2], %[u2]\n\t" "v_fma_f32 %[Sd], %[Sd], %[w3], %[u3]\n\t"
                        : [Sa] "+v"(S[r][0]), [Sb] "+v"(S[r][1]), [Sc] "+v"(S[r][2]), [Sd] "+v"(S[r][3]), [u0] "+v"(u0), [u1] "+v"(u1), [u2] "+v"(u2), [u3] "+v"(u3)
                        : [sa] "v"(sa), [b0] "v"(bv[0]), [b1] "v"(bv[1]), [b2] "v"(bv[2]), [b3] "v"(bv[3]), [w0] "v"(w[0]), [w1] "v"(w[1]), [w2] "v"(w[2]), [w3] "v"(w[3])); }
                __builtin_amdgcn_sched_barrier(0); }
            if (OUT) { const f32x4 r4 = r_[(STS - 1) & 1];
              ob0[(STS - 1) * 1024] = a_fma(S[0][3], r4[3], a_fma(S[0][2], r4[2], a_fma(S[0][1], r4[1], a_mul(S[0][0], r4[0]))));
              ob1[(STS - 1) * 1024] = a_fma(S[1][3], r4[3], a_fma(S[1][2], r4[2], a_fma(S[1][1], r4[1], a_mul(S[1][0], r4[0])))); }
#undef SC_LD
        }
        RAW_BAR();
        if (OUT) {
            const LAS f32x4* p = (const LAS f32x4*)(obuf + (sc & 1) * OB + tid * 16); const f32x4 a = p[0], b = p[1], c = p[2], d = p[3];
            const float o = (((a[0] + a[1]) + (a[2] + a[3])) + ((b[0] + b[1]) + (b[2] + b[3]))) + (((c[0] + c[1]) + (c[2] + c[3])) + ((d[0] + d[1]) + (d[2] + d[3])));
            Og[((size_t)sc * STS + (tid >> 6)) * 256 + (tid & 63)] = o; }
      }
    }
#undef ST_LOAD
#undef ST_STORE
    if (endS) {
#pragma unroll
        for (int r = 0; r < 2; ++r) *(f32x4*)(endS + (size_t)rowr[r] * 64 + 4 * ks) = (f32x4){S[r][0], S[r][1], S[r][2], S[r][3]}; }
    RAW_BAR();
}
#undef DPP_ADD
__device__ __forceinline__ void rwkv_carry(Frame& F) {
    const int hb = F.bx >> 3, row = (F.bx & 7) * 8 + F.wave, lane = F.lane, tid = F.tid;
    LAS float* Pl = (LAS float*)F.lds;
    LAS float* Sl = (LAS float*)(F.lds + 16384) + F.wave * 64;
    float S = 0.f;
    const size_t m0 = (size_t)hb * RC_N * 4096;
    f32x4 p0 = *(const f32x4*)(F.PB + m0 + (size_t)tid * 8), p1 = *(const f32x4*)(F.PB + m0 + (size_t)tid * 8 + 4);
    float lc = F.LB[m0 + (size_t)row * 64 + lane];
#pragma unroll 1
    for (int c = 0; c < RC_N; ++c) { const size_t mo = m0 + (size_t)c * 4096;
        F.SB[mo + (size_t)row * 64 + lane] = S;
        if (c + 1 == RC_N) break;
        float acc = lc;
        *(LAS f32x4*)(Pl + tid * 8) = p0; *(LAS f32x4*)(Pl + tid * 8 + 4) = p1; Sl[lane] = S;
        if (c + 2 < RC_N) { p0 = *(const f32x4*)(F.PB + mo + 4096 + (size_t)tid * 8); p1 = *(const f32x4*)(F.PB + mo + 4096 + (size_t)tid * 8 + 4); lc = F.LB[mo + 4096 + (size_t)row * 64 + lane]; }
        RAW_BAR();
        float a0 = 0.f, a1 = 0.f, a2 = 0.f, a3 = 0.f;
#pragma unroll 4
        for (int j = 0; j < 64; j += 4) { const f32x4 s4 = *(const LAS f32x4*)(Sl + j);
            a0 += s4[0] * Pl[(j + 0) * 64 + lane]; a1 += s4[1] * Pl[(j + 1) * 64 + lane]; a2 += s4[2] * Pl[(j + 2) * 64 + lane]; a3 += s4[3] * Pl[(j + 3) * 64 + lane]; }
        S = acc + ((a0 + a1) + (a2 + a3));
        RAW_BAR();
    }
}
__device__ __forceinline__ float gelu_tanh(float x) { const float u = 0.7978845608028654f * (x + 0.044715f * x * x * x); return 0.5f * x * (1.0f + tanhf(u)); }
__device__ __forceinline__ void s5_pass2(Frame& F, int l, int c) {
    LAS float* ubuf = (LAS float*)F.lds;
    LAS float* ybuf = (LAS float*)(F.lds + 65536);
    const int t0 = c * 64, lane = F.lane, wave = F.wave, cb0 = c & ~127;
    load_u5_tile(F, t0, ubuf);
    __syncthreads();
#pragma unroll 1
    for (int gi = 0; gi < 2; ++gi) { const int g = wave + 8 * gi; S5Par P; s5_params(F, l, g, lane, P);
        float cr[16], ci[16]; int lane_l = lane; asm volatile("" : "+v"(lane_l));
#pragma unroll
        for (int hh = 0; hh < 16; ++hh) { cr[hh] = F.in[12][(((size_t)l * 16 + g) * 16 + hh) * 64 + lane_l]; ci[hh] = F.in[13][(((size_t)l * 16 + g) * 16 + hh) * 64 + lane_l]; }
        float pr = P.ar, pi = P.ai;
#pragma unroll
        for (int s = 0; s < 6; ++s) { const float nr = pr * pr - pi * pi, ni = 2.0f * pr * pi; pr = nr; pi = ni; }
        float hr = 0.f, hi = 0.f;
#pragma unroll 1
        for (int c2 = cb0; c2 < c; c2 += 16) {
            f32x2 e[16];
#pragma unroll
            for (int q = 0; q < 16; ++q) { const int cq = (c2 + q < c) ? c2 + q : c2; e[q] = *(const f32x2*)(F.E + (((size_t)cq * 16 + g) * 64 + lane_l) * 2); }
#pragma unroll
            for (int q = 0; q < 16; ++q) if (c2 + q < c) { const float nr = pr * hr - pi * hi + e[q][0], ni = pr * hi + pi * hr + e[q][1]; hr = nr; hi = ni; } }
        const bool b3 = (lane & 8) != 0, b2 = (lane & 4) != 0, b1 = (lane & 2) != 0, b0 = (lane & 1) != 0;
#pragma unroll 1
        for (int j = 0; j < 64; ++j) { s5_step(P, ubuf + j * 256 + g * 16, hr, hi);
            float v8[8], v4[4], v2[2];
#pragma unroll
            for (int i = 0; i < 8; ++i) { const float lo = hr * cr[i] - hi * ci[i], hv = hr * cr[i + 8] - hi * ci[i + 8];
                const float keep = b3 ? hv : lo, send = b3 ? lo : hv; v8[i] = keep + dppx<0x140>(send); }
#pragma unroll
            for (int i = 0; i < 4; ++i) { const float keep = b2 ? v8[i + 4] : v8[i], send = b2 ? v8[i] : v8[i + 4]; v4[i] = keep + dppx<0x141>(send); }
#pragma unroll
            for (int i = 0; i < 2; ++i) { const float keep = b1 ? v4[i + 2] : v4[i], send = b1 ? v4[i] : v4[i + 2]; v2[i] = keep + dppx<0x4E>(send); }
            float y = (b0 ? v2[1] : v2[0]) + dppx<0xB1>(b0 ? v2[0] : v2[1]);
            y += __shfl_xor(y, 16); y += __shfl_xor(y, 32);
            if (lane < 16) ybuf[j * 256 + g * 16 + lane] = y; }
    }
    __syncthreads();
    { const int ch = F.tid & 255, half = F.tid >> 8; const float dd = F.in[14][(size_t)l * 256 + ch];
        for (int tt = 0; tt < 32; ++tt) { const int tl = half * 32 + tt; const float y = ybuf[tl * 256 + ch] + dd * ubuf[tl * 256 + ch];
            F.GL[(size_t)(t0 + tl) * 256 + ch] = (bf16_t)f2bf(gelu_tanh(y)); } }
    __syncthreads();
}
template <int PART> __device__ __forceinline__ void m2_phase(Frame& F, int l, const XcdBarrier& xbar) {
    if (PART == 0 || PART == 1)
#pragma unroll 1
    for (int id = F.bx; id < 8 * RC_N * 2; id += F.G) { const int hb = id >> 6, c = (id >> 1) & (RC_N - 1), tk = id & 1; const size_t mo = ((size_t)hb * RC_N + c) * 4096;
        if (c == RC_N - 1) continue;
        const unsigned char* src = F.RW + ((size_t)hb * SEQ + (size_t)c * RC_LEN) * 896;
        scan_task<false>(F, src, nullptr, tk == 1, tk == 0, (tk == 0 ? F.LB : F.PB) + mo, nullptr); }
    if (PART == 0 || PART == 2)
#pragma unroll 1
    for (int c = F.bx; c < TT / 64; c += F.G) pool_conv_chunk(F, l, c);
    xcd_barrier(xbar);
    if (PART == 0 || PART == 3) { int bxs = F.bx; asm volatile("" : "+s"(bxs));
      if (bxs < 64) rwkv_carry(F);
      else conv_second_half(F, l, 64); }
    xcd_barrier(xbar);
    if (PART == 0 || PART == 4)
#pragma unroll 1
    for (int id = F.bx; id < 8 * RC_N; id += F.G) { const int hb = id >> 5, c = id & (RC_N - 1); const size_t mo = ((size_t)hb * RC_N + c) * 4096;
        const unsigned char* src = F.RW + ((size_t)hb * SEQ + (size_t)c * RC_LEN) * 896;
        float* Og = F.O + ((size_t)(hb >> 2) * SEQ + (size_t)c * RC_LEN) * 256 + (hb & 3) * 64;
        scan_task<true>(F, src, F.SB + mo, false, true, nullptr, Og); }
    if (PART == 0 || PART == 5)
#pragma unroll 1
    for (int c = F.bx; c < TT / 64; c += F.G) s5_pass2(F, l, c);
}
__device__ __forceinline__ void rwkv_post(Frame& F, int l) {
    const int gw = F.bx * NWAVES + F.wave, NGW = F.G * NWAVES, lane = F.lane;
    for (int it0 = gw * 4; it0 < TT * 4; it0 += NGW * 4) {
        const int t = it0 >> 2, b = t / SEQ, pos = t & (SEQ - 1);
        float o[4], r[4], k[4], v[4], g[4];
#pragma unroll
        for (int hh = 0; hh < 4; ++hh) { const int c = hh * 64 + lane; o[hh] = F.O[(size_t)t * 256 + c]; g[hh] = (float)F.G16[(size_t)t * 256 + c];
            const h16* rw = (const h16*)(F.RW + ((size_t)(b * 4 + hh) * SEQ + pos) * 896 + 256) + lane; r[hh] = (float)rw[0]; k[hh] = (float)rw[64]; v[hh] = (float)rw[128]; }
#pragma unroll
        for (int hh = 0; hh < 4; ++hh) { const int c = hh * 64 + lane;
            const float mu = wave_sum(o[hh]) * (1.0f / 64.0f); const float d = o[hh] - mu; const float var = wave_sum(d * d) * (1.0f / 64.0f);
            const float on = d * rsqrtf(var + 64e-5f) * F.in[31][(size_t)l * 256 + c] + F.in[32][(size_t)l * 256 + c];
            const float bs = wave_sum(r[hh] * k[hh] * F.in[30][(size_t)l * 256 + c]);
            F.B2[(size_t)t * 1024 + 512 + c] = (bf16_t)f2bf((on + bs * v[hh]) * g[hh]); }
    }
}

constexpr int NPH = 25;
#ifndef PHMASK
#define PHMASK 0xFFFF
#endif
#define PHON(k) (((PHMASK) >> (k)) & 1)
#ifndef REP_PART
#define REP_PART 0
#endif
template <int PH, int PART = 0> __device__ __forceinline__ void run_phase(const int wave_s, unsigned char* lds_raw, const XcdBarrier& xbar) {
    typedef pg8::StaticOrder SO;
    int tid = wave_s * 64 + (int)__builtin_amdgcn_mbcnt_hi(~0u, __builtin_amdgcn_mbcnt_lo(~0u, 0u)); asm volatile("" : "+v"(tid));
    int G = gridDim.x, bx = blockIdx.x; asm volatile("" : "+s"(G), "+s"(bx));
    const __attribute__((address_space(4))) unsigned char* ka = (const __attribute__((address_space(4))) unsigned char*)__builtin_amdgcn_kernarg_segment_ptr();
    asm volatile("" : "+s"(ka));
    const __attribute__((address_space(4))) Args* ap = (const __attribute__((address_space(4))) Args*)ka;
    Frame F;
    F.lds = (LAS unsigned char*)lds_raw;
    F.tid = tid; F.lane = tid & 63; F.wave = __builtin_amdgcn_readfirstlane(tid >> 6); F.G = G; F.bx = bx;
    F.in = (in_t)ka; F.X = ap->out; F.ws = ap->ws;
    unsigned char* ws = F.ws;
    F.SS = (float*)(ws + WS_SS); F.E = (float*)(ws + WS_E); F.B1 = (bf16_t*)(ws + WS_B1); F.B2 = (bf16_t*)(ws + WS_B2);
    unsigned char* z = ws + WS_Z;
    F.HID = (bf16_t*)(z + Z_HID); F.GL = (bf16_t*)(z + Z_GL); F.U5 = (h16*)(z + Z_U5); F.PP = (h16*)(z + Z_PP); F.L16 = (h16*)(z + Z_L16); F.G16 = (h16*)(z + Z_G16); F.R = (h16*)(z + Z_R);
    F.O = (float*)(z + Z_O); F.RW = z + Z_RW; F.PB = (float*)(z + Z_PB); F.LB = (float*)(z + Z_LB); F.SB = (float*)(z + Z_SB);
    if constexpr (PH == 0) { conv_first_half(F, 0); prep_x(F); }
    else { constexpr int l = (PH - 1) / 12, k = (PH - 1) % 12;
        if constexpr (k == 0) { pg8::Gemm g{F.B1, (const bf16_t*)(ws + WS_W + W_GU1), TT, 2 * FF, DM, 1}; SO S; S.init(TT, 2 * FF, G, bx); pg8::EpiGU E{F.HID, F.SS}; pg8::gemm_phase<pg8::EpiGU, SO, true, true>(F.lds, g, S, E, tid); }
        else if constexpr (k == 1) { pg8::Gemm g{F.HID, (const bf16_t*)(ws + WS_W + W_D1), TT, DM, FF, 1}; SO S; S.init(TT, DM, G, bx); pg8::EpiDown E{l == 0 ? F.in[0] : F.X, F.X, F.B1, F.SS, 0.5f}; pg8::gemm_phase<pg8::EpiDown, SO, true, true>(F.lds, g, S, E, tid); }
        else if constexpr (k == 2) { pg8::Gemm g{F.B1, (const bf16_t*)(ws + WS_W + W_INA), TT, 2560, DM, 1}; SO S; S.init(TT, 2560, G, bx); pg8::EpiInA E{F.U5, F.PP, F.L16, F.SS}; pg8::gemm_phase<pg8::EpiInA, SO, true, true>(F.lds, g, S, E, tid); }
        else if constexpr (k == 3) { m1_phase(F, l); }
        else if constexpr (k == 4) { m2_phase<PART>(F, l, xbar); }
        else if constexpr (k == 5) { { pg8::Gemm g{F.GL, (const bf16_t*)(ws + WS_W + W_GLU), TT, 256, 256, 1}; SO S; S.init(TT, 256, G, bx); pg8::EpiGlu E{F.GL, F.B2}; pg8::gemm_phase<pg8::EpiGlu, SO, true, true>(F.lds, g, S, E, tid); } rwkv_post(F, l); }
        else if constexpr (k == 6) { pg8::Gemm g{F.B1, (const bf16_t*)(ws + WS_W + W_ING), TT, 4096, DM, 1}; SO S; S.init(TT, 4096, G, bx); pg8::EpiGate E{F.R, F.SS}; pg8::gemm_phase<pg8::EpiGate, SO, true, true>(F.lds, g, S, E, tid); }
        else if constexpr (k == 7) { pg8::Gemm g{F.B2, (const bf16_t*)(ws + WS_W + W_BR), TT, DM, DM, 4}; pg8::SegOrder4 S; S.so.init(TT, DM, G, bx); pg8::EpiBranch E{F.R, F.B1}; pg8::gemm_phase<pg8::EpiBranch, pg8::SegOrder4, true, true>(F.lds, g, S, E, tid); }
        else if constexpr (k == 8) { pg8::Gemm g{F.B1, (const bf16_t*)(ws + WS_W + W_O), TT, DM, DM, 1}; SO S; S.init(TT, DM, G, bx); pg8::EpiDown E{F.X, F.X, F.B2, F.SS, 1.0f}; pg8::gemm_phase<pg8::EpiDown, SO, true, true>(F.lds, g, S, E, tid); }
        else if constexpr (k == 9) { pg8::Gemm g{F.B2, (const bf16_t*)(ws + WS_W + W_GU2), TT, 2 * FF, DM, 1}; SO S; S.init(TT, 2 * FF, G, bx); pg8::EpiGU E{F.HID, F.SS}; pg8::gemm_phase<pg8::EpiGU, SO, true, true>(F.lds, g, S, E, tid); }
        else if constexpr (k == 10) { pg8::Gemm g{F.HID, (const bf16_t*)(ws + WS_W + W_D2), TT, DM, FF, 1}; SO S; S.init(TT, DM, G, bx); pg8::EpiDown E{F.X, F.X, F.B1, F.SS, 0.5f}; pg8::gemm_phase<pg8::EpiDown, SO, true, true>(F.lds, g, S, E, tid); }
        else { if constexpr (l == 0) conv_first_half(F, 1); else final_norm(F); }
    }
}
#ifndef REPMASK
#define REPMASK 0
#endif
#define SEAM(k_) do { if ((k_) == 0) { __syncthreads(); cg::this_grid().sync(); } else xcd_barrier(xbar); } while (0)
#define PHASE(k) if (ph_lo <= (k) && (k) < ph_hi) { run_phase<(k)>(wave_s, lds_raw, xbar); \
    if ((k) >= 1 && ((REPMASK >> (((k) - 1) % 12)) & 1)) { SEAM(k); run_phase<(k), REP_PART>(wave_s, lds_raw, xbar); } \
    if ((k) + 1 < ph_hi) SEAM(k); }
__global__ void __launch_bounds__(NTHR, 2) mk_fwd(Args args) {
    extern __shared__ __attribute__((aligned(16))) unsigned char lds_raw[];
    const int ph_lo = args.ph_lo, ph_hi = args.ph_hi;
    volatile LAS unsigned* xst = (volatile LAS unsigned*)((LAS unsigned char*)lds_raw + (LDS_BYTES - 64));
    if (threadIdx.x == 0) { xst[0] = 0u; xst[1] = 0u; }
    __syncthreads();
    const XcdBarrier xbar = xcd_barrier_post((unsigned*)(args.ws + WS_CTL), xst);
    const int wave_s = __builtin_amdgcn_readfirstlane((int)threadIdx.x >> 6);
    PHASE(0) PHASE(1) PHASE(2) PHASE(3) PHASE(4) PHASE(5) PHASE(6) PHASE(7) PHASE(8) PHASE(9) PHASE(10) PHASE(11) PHASE(12)
    PHASE(13) PHASE(14) PHASE(15) PHASE(16) PHASE(17) PHASE(18) PHASE(19) PHASE(20) PHASE(21) PHASE(22) PHASE(23) PHASE(24)
}

extern "C" void kernel_launch(void* const* d_in, const int* in_sizes, int n_in, void* d_out, int out_size, void* d_ws, size_t ws_size, hipStream_t stream) {
    static int grid = 0;
    if (grid == 0) {
        if (n_in != 41 || out_size != TT * DM || ws_size < WS_END) { fprintf(stderr, "kernel_launch: unexpected shapes (n_in %d out %d ws %zu)\n", n_in, out_size, ws_size); grid = -1; return; }
        int dev = 0, cus = 0, per_cu = 0;
        (void)hipGetDevice(&dev); (void)hipDeviceGetAttribute(&cus, hipDeviceAttributeMultiprocessorCount, dev);
        if (hipFuncSetAttribute((const void*)mk_fwd, hipFuncAttributeMaxDynamicSharedMemorySize, LDS_BYTES) != hipSuccess) { fprintf(stderr, "kernel_launch: hipFuncSetAttribute failed\n"); grid = -1; return; }
        if (hipOccupancyMaxActiveBlocksPerMultiprocessor(&per_cu, (const void*)mk_fwd, NTHR, LDS_BYTES) != hipSuccess || per_cu < 1) { fprintf(stderr, "kernel_launch: occupancy query says %d\n", per_cu); per_cu = 1; }
        (void)hipGetLastError();
        grid = cus * (per_cu >= 1 ? 1 : 1);
        if (grid < 64) { fprintf(stderr, "kernel_launch: grid %d too small\n", grid); }
    }
    if (grid < 0) return;
    if (hipMemsetAsync((char*)d_ws + WS_CTL, 0, CTL_ZERO_BYTES, stream) != hipSuccess) { fprintf(stderr, "kernel_launch: hipMemsetAsync failed\n"); return; }
    Args a{};
    for (int i = 0; i < 41; ++i) a.in[i] = (const float*)d_in[i];
    a.out = (float*)d_out; a.ws = (unsigned char*)d_ws;
#if ONE_LAUNCH
    a.ph_lo = 0; a.ph_hi = NPH;
    void* kargs[] = {&a};
    hipError_t e = hipLaunchCooperativeKernel((const void*)mk_fwd, dim3(grid), dim3(NTHR), kargs, LDS_BYTES, stream);
    if (e != hipSuccess) fprintf(stderr, "cooperative launch failed: %s (grid %d)\n", hipGetErrorString(e), grid);
#else
    for (int ph = 0; ph < NPH; ++ph) { a.ph_lo = ph; a.ph_hi = ph + 1; hipLaunchKernelGGL(mk_fwd, dim3(grid), dim3(NTHR), LDS_BYTES, stream, a); }
#endif
}
```

```cpp
#include <hip/hip_runtime.h>
#include <hip/hip_cooperative_groups.h>
#include <cstdio>
#include <cstdint>
#include <cstddef>
namespace cg = cooperative_groups;
namespace pg8 {
#define PG8_LAS __attribute__((address_space(3)))
typedef unsigned short bf16_t;
typedef short bf16x8 __attribute__((ext_vector_type(8)));
typedef float f32x4 __attribute__((ext_vector_type(4)));
typedef unsigned u32x4 __attribute__((ext_vector_type(4)));
constexpr int BM = 256, BK = 64, HALF = 128, HTB = HALF * BK * 2  , STAGE_BYTES = 8 * HTB, NXCD = 8, WGM = 8;

__host__ __device__ __forceinline__ int lds_byte(int r, int c) { const int st = (r >> 4) * 2 + (c >> 5), rr = r & 15, cc = c & 31, ob = rr * 64 + cc * 2; return st * 1024 + (ob ^ (((ob >> 9) & 1) << 5)); }
__host__ __device__ __forceinline__ void stage_rc(int b, int& R, int& C) { const int st = b / 1024, sb = b % 1024, swz = sb ^ (((sb >> 9) & 1) << 5); R = (st >> 1) * 16 + swz / 64; C = (st & 1) * 32 + (swz % 64) / 2; }
__host__ __device__ __forceinline__ int perm32(int rho) { const int n = rho >> 4, i = rho & 15; return 8 * (i >> 2) + 4 * n + (i & 3); }

struct Unit { int pm, pn, g; };
struct Gemm { const bf16_t* A; const bf16_t* Bt; int M, N, K, nseg; };

struct StaticOrder {
    int nM, nN, nwg, G, c;
    __host__ __device__ void init(int M, int N, int G_, int c_) { nM = M / BM; nN = N / BM; nwg = nM * nN; G = G_; c = c_; }
    __host__ __device__ bool next(int i, Unit& u) const {
        const long L = (long)i * G + c; if (L >= nwg) return false;
        int wgid = (int)L; { const int q = nwg / NXCD, r = nwg % NXCD, xcd = wgid % NXCD, off = wgid / NXCD; wgid = (xcd < r ? xcd * (q + 1) : r * (q + 1) + (xcd - r) * q) + off; }
        const int nig = WGM * nN, gid = wgid / nig, fm = gid * WGM, gsz = (nM - fm) < WGM ? (nM - fm) : WGM;
        u.pm = fm + ((wgid % nig) % gsz); u.pn = (wgid % nig) / gsz; u.g = 0; return true;
    }
    __device__ __forceinline__ void a_ready(const Unit&) const {}
    __device__ __forceinline__ void done(const Unit&) const {}
};


struct SegOrder4 {
    StaticOrder so;
    __host__ __device__ bool next(int i, Unit& u) const { if (!so.next(i >> 2, u)) return false; u.g = i & 3; return true; }
    __device__ __forceinline__ void a_ready(const Unit&) const {}
    __device__ __forceinline__ void done(const Unit&) const {}
};

typedef _Float16 h16;
typedef _Float16 h16x4 __attribute__((ext_vector_type(4)));
typedef unsigned u32x2 __attribute__((ext_vector_type(2)));
__device__ __forceinline__ unsigned cvt_pk_bf16(float lo, float hi) { unsigned r; asm volatile("v_cvt_pk_bf16_f32 %0, %1, %2" : "=v"(r) : "v"(lo), "v"(hi)); return r; }
__device__ __forceinline__ u32x2 pack_bf16x4(f32x4 v) { u32x2 w; w.x = cvt_pk_bf16(v[0], v[1]); w.y = cvt_pk_bf16(v[2], v[3]); return w; }
__device__ __forceinline__ h16x4 pack_h16x4(f32x4 v) { h16x4 w; w[0] = (h16)v[0]; w[1] = (h16)v[1]; w[2] = (h16)v[2]; w[3] = (h16)v[3]; return w; }
__device__ __forceinline__ float fast_sigmoid(float x) { return __builtin_amdgcn_rcpf(1.0f + __expf(-x)); }
__device__ __forceinline__ float row_rstd(const float* SS, int row) {
    const f32x4* p = (const f32x4*)(SS + (size_t)row * 16);
    const f32x4 a = p[0], b = p[1], c = p[2], d = p[3];
    const float s = ((a[0] + a[1]) + (a[2] + a[3])) + ((b[0] + b[1]) + (b[2] + b[3])) + ((c[0] + c[1]) + (c[2] + c[3])) + ((d[0] + d[1]) + (d[2] + d[3]));
    return rsqrtf(s * (1.0f / 1024.0f) + 1e-6f);
}

__device__ __forceinline__ void rows_rstd(const float* SS, int row0, int fq, float (&rs)[8]) {
    f32x4 q[8];
#pragma unroll
    for (int sl = 0; sl < 8; ++sl) q[sl] = *(const f32x4*)(SS + (size_t)(row0 + (sl >> 2) * HALF + (sl & 3) * 16) * 16 + 4 * fq);
#pragma unroll
    for (int sl = 0; sl < 8; ++sl) { float s = (q[sl][0] + q[sl][1]) + (q[sl][2] + q[sl][3]); s += __shfl_xor(s, 16); s += __shfl_xor(s, 32); rs[sl] = rsqrtf(s * (1.0f / 1024.0f) + 1e-6f); }
}

struct EpiGU {
    static constexpr bool PERM = true, KSEG = false;
    bf16_t* hid; const float* SS;
    __device__ __forceinline__ void operator()(const f32x4 (&acc)[2][2][4][2], const Unit& u, int wr, int wc, int fr, int fq) const {
        int row0 = u.pm * BM + wr * 64 + fr; asm volatile("" : "+v"(row0)); const int j0 = u.pn * 128 + wc * 16 + fq * 4;
        float rsv[8]; rows_rstd(SS, row0, fq, rsv);
#pragma unroll
        for (int ai = 0; ai < 2; ++ai)
#pragma unroll
            for (int m = 0; m < 4; ++m) { const int row = row0 + ai * HALF + m * 16; const float rs = rsv[ai * 4 + m];
#pragma unroll
                for (int bj = 0; bj < 2; ++bj) { const f32x4 g = acc[ai][bj][m][0] * rs, up = acc[ai][bj][m][1] * rs; f32x4 h;
#pragma unroll
                    for (int i = 0; i < 4; ++i) h[i] = g[i] * fast_sigmoid(g[i]) * up[i];
                    *(u32x2*)(hid + (size_t)row * 2816 + j0 + bj * 64) = pack_bf16x4(h); } }
    }
};
struct EpiDown {
    static constexpr bool PERM = false, KSEG = false;
    const float* res; float* X; bf16_t* xb; float* SS; float alpha;
    __device__ __forceinline__ void operator()(const f32x4 (&acc)[2][2][4][2], const Unit& u, int wr, int wc, int fr, int fq) const {
        int row0 = u.pm * BM + wr * 64 + fr; asm volatile("" : "+v"(row0)); const int c0 = u.pn * BM + wc * 32 + fq * 4;
#pragma unroll
        for (int ai = 0; ai < 2; ++ai) {
            f32x4 rv[4][2][2];
#pragma unroll
            for (int m = 0; m < 4; ++m)
#pragma unroll
                for (int bj = 0; bj < 2; ++bj)
#pragma unroll
                    for (int n = 0; n < 2; ++n) rv[m][bj][n] = *(const f32x4*)(res + (size_t)(row0 + ai * HALF + m * 16) * 1024 + c0 + bj * HALF + n * 16);
#pragma unroll
            for (int m = 0; m < 4; ++m) { const int row = row0 + ai * HALF + m * 16; float ss = 0.f;
#pragma unroll
                for (int bj = 0; bj < 2; ++bj)
#pragma unroll
                    for (int n = 0; n < 2; ++n) { const size_t off = (size_t)row * 1024 + c0 + bj * HALF + n * 16;
                        const f32x4 o = rv[m][bj][n] + acc[ai][bj][m][n] * alpha;
                        *(f32x4*)(X + off) = o; *(u32x2*)(xb + off) = pack_bf16x4(o);
                        ss += (o[0] * o[0] + o[1] * o[1]) + (o[2] * o[2] + o[3] * o[3]); }
                ss += __shfl_xor(ss, 16); ss += __shfl_xor(ss, 32);
                if (fq == 0) SS[(size_t)row * 16 + u.pn * 4 + wc] = ss; }
            asm volatile("" ::: "memory"); }
    }
};
struct EpiInA {
    static constexpr bool PERM = false, KSEG = false;
    h16* U5; h16* PP; h16* L16; const float* SS;
    __device__ __forceinline__ void operator()(const f32x4 (&acc)[2][2][4][2], const Unit& u, int wr, int wc, int fr, int fq) const {
        int row0 = u.pm * BM + wr * 64 + fr; asm volatile("" : "+v"(row0)); const int cl = wc * 32 + fq * 4;
        float rsv[8]; rows_rstd(SS, row0, fq, rsv);
        h16* base; int ld, cb;
        if (u.pn == 0) { base = U5; ld = 256; cb = 0; } else if (u.pn < 8) { base = PP; ld = 1792; cb = (u.pn - 1) * 256; } else { base = L16; ld = 512; cb = (u.pn - 8) * 256; }
#pragma unroll
        for (int ai = 0; ai < 2; ++ai)
#pragma unroll
            for (int m = 0; m < 4; ++m) { const int row = row0 + ai * HALF + m * 16; const float rs = rsv[ai * 4 + m];
#pragma unroll
                for (int bj = 0; bj < 2; ++bj)
#pragma unroll
                    for (int n = 0; n < 2; ++n) *(h16x4*)(base + (size_t)row * ld + cb + cl + bj * HALF + n * 16) = pack_h16x4(acc[ai][bj][m][n] * rs); }
    }
};
struct EpiGate {
    static constexpr bool PERM = false, KSEG = false;
    h16* R; const float* SS;
    __device__ __forceinline__ void operator()(const f32x4 (&acc)[2][2][4][2], const Unit& u, int wr, int wc, int fr, int fq) const {
        float rsv[8]; int row0 = u.pm * BM + wr * 64 + fr; asm volatile("" : "+v"(row0)); rows_rstd(SS, row0, fq, rsv); const int d0 = 256 * (u.pn >> 2) + 128 * ((u.pn >> 1) & 1) + 16 * (u.pn & 1) + 32 * wc + 4 * fq;
#pragma unroll
        for (int ai = 0; ai < 2; ++ai)
#pragma unroll
            for (int m = 0; m < 4; ++m) { const int row = row0 + ai * HALF + m * 16; const float rs = rsv[ai * 4 + m];
                f32x4 e[4];
#pragma unroll
                for (int g = 0; g < 4; ++g)
#pragma unroll
                    for (int i = 0; i < 4; ++i) e[g][i] = 1.0f + __expf(-fminf(fmaxf(acc[ai][g >> 1][m][g & 1][i] * rs, -10.f), 30.f));
                f32x4 r[4];
#pragma unroll
                for (int i = 0; i < 4; ++i) { const float i0 = __builtin_amdgcn_rcpf(e[0][i]), i1 = __builtin_amdgcn_rcpf(e[1][i]), i2 = __builtin_amdgcn_rcpf(e[2][i]), i3 = __builtin_amdgcn_rcpf(e[3][i]);
                    r[0][i] = e[1][i] * i0; r[1][i] = e[2][i] * i1; r[2][i] = e[3][i] * i2; r[3][i] = i3; }
#pragma unroll
                for (int g = 0; g < 4; ++g) *(h16x4*)(R + ((size_t)row * 4 + g) * 1024 + d0) = pack_h16x4(r[g]); }
    }
};
struct EpiBranch {
    static constexpr bool PERM = false, KSEG = true;
    const h16* R; bf16_t* out;
    __device__ __forceinline__ void operator()(f32x4 (&acc)[2][2][4][2], const Unit& u, int wr, int wc, int fr, int fq) const {
        unsigned q0 = (unsigned)(u.pm * BM + wr * 64 + fr) * 1024u + (unsigned)(u.pn * BM + wc * 32 + fq * 4); asm volatile("" : "+v"(q0));
        const unsigned r0 = (q0 - (q0 & 1023u)) * 4u + (unsigned)u.g * 1024u + (q0 & 1023u);
        const bool last = u.g == 3;
        h16x4 rr[2][4][2][2];
#pragma unroll
        for (int ai = 0; ai < 2; ++ai)
#pragma unroll
            for (int m = 0; m < 4; ++m)
#pragma unroll
                for (int bj = 0; bj < 2; ++bj)
#pragma unroll
                    for (int n = 0; n < 2; ++n) rr[ai][m][bj][n] = *(const h16x4*)(R + (r0 + (unsigned)((ai * HALF + m * 16) * 4096 + bj * HALF + n * 16)));
#pragma unroll
        for (int ai = 0; ai < 2; ++ai)
#pragma unroll
            for (int m = 0; m < 4; ++m) {
#pragma unroll
                for (int bj = 0; bj < 2; ++bj)
#pragma unroll
                    for (int n = 0; n < 2; ++n) { const unsigned off = q0 + (unsigned)((ai * HALF + m * 16) * 1024 + bj * HALF + n * 16);
                        const h16x4 r = rr[ai][m][bj][n];
                        f32x4 rf; rf[0] = (float)r[0]; rf[1] = (float)r[1]; rf[2] = (float)r[2]; rf[3] = (float)r[3];
                        acc[ai][bj][m][n] = acc[ai][bj][m][n] * rf;
                        if (last) *(u32x2*)(out + off) = pack_bf16x4(acc[ai][bj][m][n]); } }
    }
};
struct EpiGlu {
    static constexpr bool PERM = false, KSEG = false;
    const bf16_t* gl; bf16_t* ys;
    __device__ __forceinline__ void operator()(const f32x4 (&acc)[2][2][4][2], const Unit& u, int wr, int wc, int fr, int fq) const {
        int row0 = u.pm * BM + wr * 64 + fr; asm volatile("" : "+v"(row0)); const int c0 = wc * 32 + fq * 4;
        u32x2 gv[2][4][2][2];
#pragma unroll
        for (int ai = 0; ai < 2; ++ai)
#pragma unroll
            for (int m = 0; m < 4; ++m)
#pragma unroll
                for (int bj = 0; bj < 2; ++bj)
#pragma unroll
                    for (int n = 0; n < 2; ++n) gv[ai][m][bj][n] = *(const u32x2*)(gl + (size_t)(row0 + ai * HALF + m * 16) * 256 + c0 + bj * HALF + n * 16);
#pragma unroll
        for (int ai = 0; ai < 2; ++ai)
#pragma unroll
            for (int m = 0; m < 4; ++m) { const int row = row0 + ai * HALF + m * 16;
#pragma unroll
                for (int bj = 0; bj < 2; ++bj)
#pragma unroll
                    for (int n = 0; n < 2; ++n) { const int c = c0 + bj * HALF + n * 16; const u32x2 g2 = gv[ai][m][bj][n];
                        f32x4 g; g[0] = __uint_as_float(g2.x << 16); g[1] = __uint_as_float(g2.x & 0xffff0000u); g[2] = __uint_as_float(g2.y << 16); g[3] = __uint_as_float(g2.y & 0xffff0000u);
                        f32x4 o;
#pragma unroll
                        for (int i = 0; i < 4; ++i) o[i] = g[i] * fast_sigmoid(acc[ai][bj][m][n][i]);
                        *(u32x2*)(ys + (size_t)row * 1024 + c) = pack_bf16x4(o); } }
    }
};

template <class Epi, class Sched, bool ALIGN_EPI = false, bool SP2 = false>
__device__ __forceinline__ void gemm_phase(PG8_LAS unsigned char* lds, const Gemm g, const Sched& S, const Epi& E, const int tid) {
    const int wid = __builtin_amdgcn_readfirstlane(tid >> 6), lane = tid & 63, wr = wid >> 2, wc = wid & 3, fr = lane & 15, fq = lane >> 4;
    const int K = g.K, nt = K / BK / g.nseg; const size_t segb = (size_t)(K / g.nseg) * 2;
    unsigned voffA[2], voffB[2];
#pragma unroll
    for (int i = 0; i < 2; ++i) { int R, C; stage_rc(tid * 16 + i * 8192, R, C); const int Rb = Epi::PERM ? ((R & ~31) + perm32(R & 31)) : R;
        voffA[i] = (unsigned)(R * K + C) * 2u; voffB[i] = (unsigned)(Rb * K + C) * 2u; }
    const size_t kstep = (size_t)(BK * 2);
    const size_t hstep = (size_t)HALF * K * 2;
    const size_t tstep = 2 * hstep;
    const unsigned ldsw = (unsigned)wid * 1024u;
    const int aoff = lds_byte(wr * 64 + fr, fq * 8), boff = lds_byte(wc * 32 + fr, fq * 8);
#define PG8_SA(b, h) (((b) * 2 + (h)) * HTB)
#define PG8_SB(b, h) ((4 + (b) * 2 + (h)) * HTB)
#define PG8_STAGE(bufoff, gbase, voff) do { _Pragma("unroll") for (int _i = 0; _i < 2; ++_i) \
        __builtin_amdgcn_global_load_lds((const unsigned*)((const char*)(gbase) + (voff)[_i]), (PG8_LAS unsigned*)(lds + (bufoff) + ldsw + _i * 8192), 16, 0, 0); } while (0)
#define PG8_LDA(dst, b, h) do { _Pragma("unroll") for (int m = 0; m < 4; ++m) _Pragma("unroll") for (int k = 0; k < 2; ++k) dst[m][k] = *(const PG8_LAS bf16x8*)(lds + PG8_SA(b, h) + aoff + m * 2048 + k * 1024); } while (0)
#define PG8_LDB(dst, b, h) do { _Pragma("unroll") for (int n = 0; n < 2; ++n) _Pragma("unroll") for (int k = 0; k < 2; ++k) dst[n][k] = *(const PG8_LAS bf16x8*)(lds + PG8_SB(b, h) + boff + n * 2048 + k * 1024); } while (0)
#define PG8_MMA(ai, bj, At, Bt) do { __builtin_amdgcn_s_setprio(1); _Pragma("unroll") for (int m = 0; m < 4; ++m) _Pragma("unroll") for (int n = 0; n < 2; ++n) _Pragma("unroll") for (int k = 0; k < 2; ++k) \
        acc[ai][bj][m][n] = __builtin_amdgcn_mfma_f32_16x16x32_bf16(Bt[n][k], At[m][k], acc[ai][bj][m][n], 0, 0, 0); __builtin_amdgcn_s_setprio(0); } while (0)
#define PG8_WAIT_V(n) asm volatile("s_waitcnt vmcnt(" #n ")" ::: "memory")
#define PG8_WAIT_L(n) asm volatile("s_waitcnt lgkmcnt(" #n ")" ::: "memory")
#define PG8_BAR __builtin_amdgcn_s_barrier()
#define PG8_SCHED __builtin_amdgcn_sched_barrier(0)
    Unit cur, nxt; int ui = 0;
    if (!S.next(0, cur)) return;
    f32x4 acc[2][2][4][2];
#pragma unroll
    for (int a = 0; a < 2; ++a)
#pragma unroll
        for (int b = 0; b < 2; ++b)
#pragma unroll
            for (int m = 0; m < 4; ++m)
#pragma unroll
                for (int n = 0; n < 2; ++n) acc[a][b][m][n] = (f32x4){0.f, 0.f, 0.f, 0.f};
    bf16x8 At[4][2], B0[2][2], B1[2][2];
    const char* cA = (const char*)g.A + (size_t)cur.pm * tstep + (size_t)cur.g * segb; const char* cB = (const char*)g.Bt + (size_t)cur.pn * tstep + (size_t)cur.g * segb;
    S.a_ready(cur);
    if constexpr (SP2) {
        PG8_STAGE(PG8_SB(0, 0), cB, voffB); PG8_STAGE(PG8_SB(0, 1), cB + hstep, voffB); PG8_STAGE(PG8_SA(0, 0), cA, voffA); PG8_STAGE(PG8_SA(0, 1), cA + hstep, voffA);
        if (wr == 1) PG8_BAR;
        PG8_WAIT_V(2); PG8_BAR;
        PG8_STAGE(PG8_SB(1, 0), cB + kstep, voffB); PG8_STAGE(PG8_SA(1, 0), cA + kstep, voffA); PG8_STAGE(PG8_SB(1, 1), cB + hstep + kstep, voffB);
        PG8_WAIT_V(6); PG8_BAR;
    } else {
        PG8_STAGE(PG8_SB(0, 0), cB, voffB); PG8_STAGE(PG8_SA(0, 0), cA, voffA); PG8_STAGE(PG8_SB(0, 1), cB + hstep, voffB); PG8_STAGE(PG8_SA(0, 1), cA + hstep, voffA);
        if (wr == 1) PG8_BAR;
        PG8_WAIT_V(4); PG8_BAR;
        PG8_STAGE(PG8_SB(1, 0), cB + kstep, voffB); PG8_STAGE(PG8_SA(1, 0), cA + kstep, voffA); PG8_STAGE(PG8_SB(1, 1), cB + hstep + kstep, voffB);
        PG8_WAIT_V(6); PG8_BAR;
    }
    for (;;) {
        const bool has_next = S.next(ui + 1, nxt);
        const char* nA = has_next ? (const char*)g.A + (size_t)nxt.pm * tstep + (size_t)nxt.g * segb : cA; const char* nB = has_next ? (const char*)g.Bt + (size_t)nxt.pn * tstep + (size_t)nxt.g * segb : cB;
        for (int t = 0; t < nt; t += 2) {
            const bool last = (t == nt - 2);
            const char* a1 = cA + (size_t)(t + 1) * kstep;
            const char* a2 = last ? nA : cA + (size_t)(t + 2) * kstep; const char* b2 = last ? nB : cB + (size_t)(t + 2) * kstep;
            const char* a3 = a2 + kstep; const char* b3 = b2 + kstep;
            if (last && has_next) S.a_ready(nxt);
            if constexpr (SP2) {
            PG8_LDB(B0, 0, 0); PG8_LDB(B1, 0, 1); PG8_SCHED; PG8_LDA(At, 0, 0); PG8_STAGE(PG8_SA(1, 1), a1 + hstep, voffA);
            PG8_WAIT_V(8); PG8_WAIT_L(0); PG8_BAR; PG8_MMA(0, 0, At, B0); PG8_MMA(0, 1, At, B1); PG8_BAR; PG8_SCHED;
            PG8_LDA(At, 0, 1); PG8_STAGE(PG8_SB(0, 0), b2, voffB); PG8_STAGE(PG8_SB(0, 1), b2 + hstep, voffB); PG8_STAGE(PG8_SA(0, 0), a2, voffA);
            PG8_WAIT_V(8); PG8_WAIT_L(0); PG8_BAR; PG8_MMA(1, 0, At, B0); PG8_MMA(1, 1, At, B1); PG8_BAR; PG8_SCHED;
            PG8_LDB(B0, 1, 0); PG8_LDB(B1, 1, 1); PG8_SCHED; PG8_LDA(At, 1, 0); PG8_STAGE(PG8_SA(0, 1), a2 + hstep, voffA);
            PG8_WAIT_V(8); PG8_WAIT_L(0); PG8_BAR; PG8_MMA(0, 0, At, B0); PG8_MMA(0, 1, At, B1); PG8_BAR; PG8_SCHED;
            PG8_LDA(At, 1, 1); PG8_STAGE(PG8_SB(1, 0), b3, voffB); PG8_STAGE(PG8_SB(1, 1), b3 + hstep, voffB); PG8_STAGE(PG8_SA(1, 0), a3, voffA);
            PG8_WAIT_V(8); PG8_WAIT_L(0); PG8_BAR; PG8_MMA(1, 0, At, B0); PG8_MMA(1, 1, At, B1); PG8_BAR; PG8_SCHED;
            } else {
            PG8_LDB(B0, 0, 0); PG8_SCHED; PG8_LDA(At, 0, 0); PG8_STAGE(PG8_SA(1, 1), a1 + hstep, voffA);
            PG8_WAIT_L(8); PG8_BAR; PG8_WAIT_L(0); PG8_MMA(0, 0, At, B0); PG8_BAR; PG8_SCHED;
            PG8_LDB(B1, 0, 1); PG8_STAGE(PG8_SB(0, 0), b2, voffB);
            PG8_BAR; PG8_WAIT_L(0); PG8_MMA(0, 1, At, B1); PG8_BAR;
            PG8_LDA(At, 0, 1); PG8_STAGE(PG8_SA(0, 0), a2, voffA);
            PG8_BAR; PG8_WAIT_L(0); PG8_MMA(1, 0, At, B0); PG8_BAR; PG8_SCHED;
            PG8_STAGE(PG8_SB(0, 1), b2 + hstep, voffB);
            PG8_WAIT_V(6); PG8_BAR; PG8_MMA(1, 1, At, B1); PG8_BAR;
            PG8_LDB(B0, 1, 0); PG8_SCHED; PG8_LDA(At, 1, 0); PG8_STAGE(PG8_SA(0, 1), a2 + hstep, voffA);
            PG8_WAIT_L(8); PG8_BAR; PG8_WAIT_L(0); PG8_MMA(0, 0, At, B0); PG8_BAR; PG8_SCHED;
            PG8_LDB(B1, 1, 1); PG8_STAGE(PG8_SB(1, 0), b3, voffB);
            PG8_BAR; PG8_WAIT_L(0); PG8_MMA(0, 1, At, B1); PG8_BAR;
            PG8_LDA(At, 1, 1); PG8_STAGE(PG8_SA(1, 0), a3, voffA);
            PG8_BAR; PG8_WAIT_L(0); PG8_MMA(1, 0, At, B0); PG8_BAR; PG8_SCHED;
            PG8_STAGE(PG8_SB(1, 1), b3 + hstep, voffB);
            PG8_WAIT_V(6); PG8_BAR; PG8_MMA(1, 1, At, B1); PG8_BAR;
            }
        }
        if constexpr (ALIGN_EPI) { if (wr == 0) PG8_BAR; }
        E(acc, cur, wr, wc, fr, fq); S.done(cur);
        if (!has_next) break;
        if (!(Epi::KSEG && nxt.g != 0))
#pragma unroll
        for (int a = 0; a < 2; ++a)
#pragma unroll
            for (int b = 0; b < 2; ++b)
#pragma unroll
                for (int m = 0; m < 4; ++m)
#pragma unroll
                    for (int n = 0; n < 2; ++n) acc[a][b][m][n] = (f32x4){0.f, 0.f, 0.f, 0.f};
        cur = nxt; cA = nA; cB = nB; ++ui;
        if constexpr (ALIGN_EPI) { if (wr == 1) PG8_BAR; }
    }
    PG8_WAIT_V(0);
    if constexpr (!ALIGN_EPI) { if (wr == 0) PG8_BAR; }
    PG8_BAR;
#undef PG8_SA
#undef PG8_SB
#undef PG8_STAGE
#undef PG8_LDA
#undef PG8_LDB
#undef PG8_MMA
#undef PG8_WAIT_V
#undef PG8_WAIT_L
#undef PG8_BAR
#undef PG8_SCHED
}
}

#define LAS __attribute__((address_space(3)))
typedef unsigned short bf16_t;
typedef _Float16 h16;
typedef _Float16 h16x4 __attribute__((ext_vector_type(4)));
typedef _Float16 h16x8 __attribute__((ext_vector_type(8)));
typedef float f32x4 __attribute__((ext_vector_type(4)));
typedef float f32x2 __attribute__((ext_vector_type(2)));
typedef unsigned u32x4 __attribute__((ext_vector_type(4)));
typedef unsigned u32x2 __attribute__((ext_vector_type(2)));

#ifndef ONE_LAUNCH
#define ONE_LAUNCH 1
#endif
constexpr int NWAVES = 8, NTHR = 512;
constexpr int TT = 16384, SEQ = 8192, DM = 1024, FF = 2816, MW = 256, INW = 6144;
constexpr int LDS_BYTES = 147456;
constexpr size_t MiB = 1u << 20;
constexpr size_t WS_CTL = 0, CTL_ZERO_BYTES = 16384, WS_SS = 1 * MiB, WS_E = 2 * MiB, WS_W = 4 * MiB, WS_B1 = 34 * MiB, WS_B2 = 66 * MiB, WS_Z = 98 * MiB, WS_END = 262 * MiB;
constexpr size_t W_GU1 = 0, W_D1 = W_GU1 + (size_t)2 * FF * DM * 2, W_INA = W_D1 + (size_t)DM * FF * 2;
constexpr size_t W_ING = 0, W_BR = W_ING + (size_t)4096 * DM * 2, W_O = W_BR + (size_t)DM * DM * 2, W_GU2 = W_O + (size_t)DM * DM * 2, W_D2 = W_GU2 + (size_t)2 * FF * DM * 2, W_GLU = W_D2 + (size_t)DM * FF * 2, W_END2 = W_GLU + 256 * 256 * 2;
constexpr size_t W_L2 = 23 * MiB;
static_assert(W_END2 <= 30 * MiB && W_INA + (size_t)2560 * DM * 2 <= 30 * MiB, "W region");
constexpr size_t Z_RW = 0, Z_G16 = 56 * MiB, Z_U5 = 64 * MiB, Z_L16 = 72 * MiB, Z_PP = 88 * MiB, Z_O = 72 * MiB, Z_GL = 144 * MiB, Z_PB = 152 * MiB, Z_LB = 156 * MiB, Z_SB = 160 * MiB;
constexpr size_t Z_HID = 0, Z_R = 0;
static_assert((size_t)TT * 4 * 896 <= 56 * MiB && (size_t)TT * 1792 * 2 <= 56 * MiB && (size_t)TT * FF * 2 <= 144 * MiB && (size_t)TT * 4096 * 2 <= 144 * MiB, "Z region");

typedef const float* cfp_t;
typedef const __attribute__((address_space(4))) cfp_t* in_t;
struct Args { const float* in[41]; float* out; unsigned char* ws; int ph_lo, ph_hi; };

struct Frame {
    LAS unsigned char* lds;
    int tid, lane, wave, G, bx;
    in_t in;
    float* X; unsigned char* ws;
    float* SS; float* E;
    bf16_t *B1, *B2, *HID, *GL;
    h16 *U5, *PP, *L16, *G16, *R;
    float* O; unsigned char* RW;
    float *PB, *LB, *SB;
};

__device__ __forceinline__ unsigned f2bf(float f) { unsigned u = __builtin_bit_cast(unsigned, f); return (u + 0x7fffu + ((u >> 16) & 1u)) >> 16; }
__device__ __forceinline__ unsigned pk2(float lo, float hi) { return f2bf(lo) | (f2bf(hi) << 16); }
#define LDS_WAIT() asm volatile("s_waitcnt lgkmcnt(0)" ::: "memory")
template <int CTRL> __device__ __forceinline__ float dppx(float x) { return __builtin_bit_cast(float, __builtin_amdgcn_update_dpp(0, __builtin_bit_cast(int, x), CTRL, 0xf, 0xf, true)); }
__device__ __forceinline__ float allreduce16(float x) { x += dppx<0xB1>(x); x += dppx<0x4E>(x); x += dppx<0x141>(x); x += dppx<0x140>(x); return x; }
__device__ __forceinline__ float wave_sum(float x) { x = allreduce16(x); x += __shfl_xor(x, 16); x += __shfl_xor(x, 32); return x; }
__device__ __forceinline__ float sigmoidf_(float x) { return __builtin_amdgcn_rcpf(1.0f + __expf(-x)); }

__device__ __forceinline__ int tr_rowmap(int mode, int j, int row0) {
    if (mode == 0) return row0 + j;
    if (mode == 1) return 8 * (j >> 2) + (j & 3);
    if (mode == 2) return 8 * (j >> 2) + 4 + (j & 3);
    const int g = j >> 10, d = j & 1023;
    const int pn = 4 * (d >> 8) + 2 * ((d >> 7) & 1) + ((d >> 4) & 1);
    return 256 * pn + 128 * (g >> 1) + 32 * ((d >> 5) & 3) + 16 * (g & 1) + 4 * ((d >> 2) & 3) + (d & 3);
}
__device__ __forceinline__ void tr_item(const float* W, int ldw, int K, int N, bf16_t* WT, int mode, int row0, const float* s1, const float* s2, int smode, LAS float* scr, int item, int lane) {
    const int nblk = N / 32, kb = item / nblk, nb = item % nblk, k0 = 64 * kb, n0 = 32 * nb;
#pragma unroll
    for (int i = 0; i < 32; ++i) { const int kk = 2 * i + (lane >> 5); const int k = k0 + kk; float sc = 1.0f;
        if (s1) sc = s1[k];
        if (smode == 1) sc *= s2[k]; else if (smode == 2) sc *= (1.0f - s2[k]);
        scr[kk * 33 + (lane & 31)] = W[(size_t)k * ldw + n0 + (lane & 31)] * sc; }
    LDS_WAIT(); asm volatile("" ::: "memory");
    const int c = lane & 7;
#pragma unroll
    for (int j = 0; j < 4; ++j) { const int n = (lane >> 3) + 8 * j; const LAS float* s = scr + (8 * c) * 33 + n;
        u32x4 o; o.x = pk2(s[0 * 33], s[1 * 33]); o.y = pk2(s[2 * 33], s[3 * 33]); o.z = pk2(s[4 * 33], s[5 * 33]); o.w = pk2(s[6 * 33], s[7 * 33]);
        *(u32x4*)(WT + (size_t)tr_rowmap(mode, n0 + n, row0) * K + k0 + 8 * c) = o; }
    LDS_WAIT(); asm volatile("" ::: "memory");
}
#define TRJ(W_, ldw_, K_, N_, dst_, mode_, row0_, s1_, s2_, smode_) { const int ni_ = ((K_) / 64) * ((N_) / 32); if (r >= 0 && r < ni_) tr_item(W_, ldw_, K_, N_, dst_, mode_, row0_, s1_, s2_, smode_, scr, r, F.lane); r -= ni_; }
__device__ __forceinline__ void conv_first_half(Frame& F, int l) {
    LAS float* scr = (LAS float*)(F.lds + F.wave * 16384);
    const int gw = F.bx * NWAVES + F.wave, NGW = F.G * NWAVES;
    unsigned char* wb = F.ws + WS_W;
    const float* n1 = F.in[1] + (size_t)l * DM; const float* nm = F.in[5] + (size_t)l * DM; const float* mu = F.in[19] + (size_t)l * 3 * DM;
    const float* w1 = F.in[21] + (size_t)l * DM * 64; const float* a1 = F.in[24] + (size_t)l * DM * 64; const float* g1 = F.in[26] + (size_t)l * DM * 128;
    bf16_t* ina = (bf16_t*)(wb + W_INA);
    for (int it = gw;; it += NGW) { int r = it;
        TRJ(F.in[2] + (size_t)l * DM * FF, FF, DM, FF, (bf16_t*)(wb + W_GU1), 1, 0, n1, nullptr, 0)
        TRJ(F.in[3] + (size_t)l * DM * FF, FF, DM, FF, (bf16_t*)(wb + W_GU1), 2, 0, n1, nullptr, 0)
        TRJ(F.in[4] + (size_t)l * FF * DM, DM, FF, DM, (bf16_t*)(wb + W_D1), 0, 0, nullptr, nullptr, 0)
        TRJ(F.in[6] + (size_t)l * DM * INW, INW, DM, 2048, ina, 0, 0, nm, nullptr, 0)
        TRJ(w1, 64, DM, 64, ina, 0, 2048, nm, mu, 2)
        TRJ(a1, 64, DM, 64, ina, 0, 2112, nm, mu + DM, 2)
        TRJ(g1, 128, DM, 128, ina, 0, 2176, nm, mu + 2 * DM, 2)
        TRJ(w1, 64, DM, 64, ina, 0, 2304, nm, mu, 1)
        TRJ(a1, 64, DM, 64, ina, 0, 2368, nm, mu + DM, 1)
        TRJ(g1, 128, DM, 128, ina, 0, 2432, nm, mu + 2 * DM, 1)
        TRJ(F.in[22] + (size_t)l * 64 * 256, 256, 64, 256, (bf16_t*)(wb + W_L2), 0, 0, nullptr, nullptr, 0)
        TRJ(F.in[25] + (size_t)l * 64 * 256, 256, 64, 256, (bf16_t*)(wb + W_L2) + 256 * 64, 0, 0, nullptr, nullptr, 0)
        TRJ(F.in[27] + (size_t)l * 128 * 256, 256, 128, 256, (bf16_t*)(wb + W_L2) + 2 * 256 * 64, 0, 0, nullptr, nullptr, 0)
        if (r >= 0) break; }
}
__device__ __forceinline__ void conv_second_half(Frame& F, int l, int b0) {
    LAS float* scr = (LAS float*)(F.lds + F.wave * 16384);
    const int gw = (F.bx - b0) * NWAVES + F.wave, NGW = (F.G - b0) * NWAVES;
    unsigned char* wb = F.ws + WS_W;
    const float* nm = F.in[5] + (size_t)l * DM; const float* n2 = F.in[36] + (size_t)l * DM;
    for (int it = gw;; it += NGW) { int r = it;
        TRJ(F.in[6] + (size_t)l * DM * INW + 2048, INW, DM, 4096, (bf16_t*)(wb + W_ING), 3, 0, nm, nullptr, 0)
        TRJ(F.in[34] + (size_t)l * DM * DM, DM, DM, DM, (bf16_t*)(wb + W_BR), 0, 0, nullptr, nullptr, 0)
        TRJ(F.in[35] + (size_t)l * DM * DM, DM, DM, DM, (bf16_t*)(wb + W_O), 0, 0, nullptr, nullptr, 0)
        TRJ(F.in[37] + (size_t)l * DM * FF, FF, DM, FF, (bf16_t*)(wb + W_GU2), 1, 0, n2, nullptr, 0)
        TRJ(F.in[38] + (size_t)l * DM * FF, FF, DM, FF, (bf16_t*)(wb + W_GU2), 2, 0, n2, nullptr, 0)
        TRJ(F.in[39] + (size_t)l * FF * DM, DM, FF, DM, (bf16_t*)(wb + W_D2), 0, 0, nullptr, nullptr, 0)
        TRJ(F.in[15] + (size_t)l * 256 * 256, 256, 256, 256, (bf16_t*)(wb + W_GLU), 0, 0, nullptr, nullptr, 0)
        if (r >= 0) break; }
}
__device__ __forceinline__ void prep_x(Frame& F) {
    const int gw = F.bx * NWAVES + F.wave, NGW = F.G * NWAVES;
    const float* x = F.in[0];
    for (int m = gw; m < TT; m += NGW) {
        const f32x4* xr = (const f32x4*)(x + (size_t)m * DM) + F.lane; float s = 0.f;
        unsigned long long* o8 = (unsigned long long*)(F.B1 + (size_t)m * DM) + F.lane;
#pragma unroll
        for (int j = 0; j < 4; ++j) { const f32x4 v = xr[64 * j]; s += (v[0] * v[0] + v[1] * v[1]) + (v[2] * v[2] + v[3] * v[3]);
            o8[64 * j] = (unsigned long long)pk2(v[0], v[1]) | ((unsigned long long)pk2(v[2], v[3]) << 32); }
        s += __shfl_xor(s, 1); s += __shfl_xor(s, 2);
        if ((F.lane & 3) == 0) F.SS[(size_t)m * 16 + (F.lane >> 2)] = s;
    }
}
__device__ __forceinline__ void final_norm(Frame& F) {
    const int gw = F.bx * NWAVES + F.wave, NGW = F.G * NWAVES;
    const f32x4* gn = (const f32x4*)F.in[40] + F.lane;
    for (int m = gw; m < TT; m += NGW) {
        const float rs = pg8::row_rstd(F.SS, m);
        f32x4* xr = (f32x4*)(F.X + (size_t)m * DM) + F.lane;
#pragma unroll
        for (int j = 0; j < 4; ++j) { const f32x4 v = xr[64 * j]; xr[64 * j] = v * rs * gn[64 * j]; }
    }
}

struct S5Par { float ar, ai; float bbr[16], bbi[16]; };
__device__ __forceinline__ void s5_params(Frame& F, int l, int g, int p, S5Par& P) {
    asm volatile("" : "+v"(p));
    const float lr = F.in[7][((size_t)l * 16 + g) * 64 + p], li = F.in[8][((size_t)l * 16 + g) * 64 + p], dt = expf(F.in[9][l * 16 + g]);
    const float mag = expf(lr * dt); P.ar = mag * cosf(li * dt); P.ai = mag * sinf(li * dt);
    const float inv = 1.0f / (lr * lr + li * li); const float qr = lr * inv, qi = -li * inv;
    const float cr = (P.ar - 1.0f) * qr - P.ai * qi, ci = (P.ar - 1.0f) * qi + P.ai * qr;
    const f32x4* br = (const f32x4*)(F.in[10] + (((size_t)l * 16 + g) * 64 + p) * 16); const f32x4* bi = (const f32x4*)(F.in[11] + (((size_t)l * 16 + g) * 64 + p) * 16);
#pragma unroll
    for (int q = 0; q < 4; ++q) { const f32x4 a = br[q], b = bi[q];
#pragma unroll
        for (int i = 0; i < 4; ++i) { P.bbr[4 * q + i] = cr * a[i] - ci * b[i]; P.bbi[4 * q + i] = cr * b[i] + ci * a[i]; } }
}
__device__ __forceinline__ void s5_step(const S5Par& P, const LAS float* urow, float& hr, float& hi) {
    const LAS f32x4* u4 = (const LAS f32x4*)urow; float bur = 0.f, bui = 0.f;
#pragma unroll
    for (int q = 0; q < 4; ++q) { const f32x4 u = u4[q];
#pragma unroll
        for (int i = 0; i < 4; ++i) { bur += P.bbr[4 * q + i] * u[i]; bui += P.bbi[4 * q + i] * u[i]; } }
    const float nr = P.ar * hr - P.ai * hi + bur, ni = P.ar * hi + P.ai * hr + bui; hr = nr; hi = ni;
}
__device__ __forceinline__ void load_u5_tile(Frame& F, int t0, LAS float* ubuf) {
    for (int i = F.tid; i < 64 * 64; i += NTHR) { const int t = i >> 6, q = i & 63; const h16x4 v = *(const h16x4*)(F.U5 + (size_t)(t0 + t) * 256 + 4 * q);
        f32x4 f; f[0] = (float)v[0]; f[1] = (float)v[1]; f[2] = (float)v[2]; f[3] = (float)v[3]; *(LAS f32x4*)(ubuf + t * 256 + 4 * q) = f; }
}


template <bool FIRST> __device__ __forceinline__ void mv32(LAS float* accp, float init, const LAS float* hb, const float* wsrc, int ldw) {
    float w[32];
    asm volatile("" : "+v"(wsrc));
#pragma unroll
    for (int j = 0; j < 32; ++j) w[j] = wsrc[(size_t)j * ldw];
#pragma unroll 2
    for (int tt = 0; tt < 32; ++tt) { const LAS f32x4* h4 = (const LAS f32x4*)(hb + tt * 256); float a = FIRST ? init : accp[tt * 256];
#pragma unroll
        for (int q = 0; q < 8; ++q) { const f32x4 v = h4[q]; a += v[0] * w[4 * q] + v[1] * w[4 * q + 1] + v[2] * w[4 * q + 2] + v[3] * w[4 * q + 3]; }
        accp[tt * 256] = a; }
}
template <int K> __device__ __forceinline__ void lora_mfma(const LAS unsigned short* hb16, int kofs, const bf16_t* Wt, LAS float* outb, int wave, int lane) {
    typedef short bf16x8_t __attribute__((ext_vector_type(8)));
    const int r16 = lane & 15, quad = lane >> 4;
    f32x4 acc[4][2];
#pragma unroll
    for (int rt = 0; rt < 4; ++rt)
#pragma unroll
        for (int ct = 0; ct < 2; ++ct) acc[rt][ct] = (f32x4){0.f, 0.f, 0.f, 0.f};
    bf16x8_t bfr[K / 32][2];
#pragma unroll
    for (int ks = 0; ks < K / 32; ++ks)
#pragma unroll
        for (int ct = 0; ct < 2; ++ct) bfr[ks][ct] = *(const bf16x8_t*)(Wt + (size_t)(wave * 32 + ct * 16 + r16) * K + ks * 32 + quad * 8);
#pragma unroll
    for (int ks = 0; ks < K / 32; ++ks)
#pragma unroll
        for (int rt = 0; rt < 4; ++rt) { const bf16x8_t a = *(const LAS bf16x8_t*)(hb16 + (rt * 16 + r16) * 264 + kofs + ks * 32 + quad * 8);
#pragma unroll
            for (int ct = 0; ct < 2; ++ct) acc[rt][ct] = __builtin_amdgcn_mfma_f32_16x16x32_bf16(a, bfr[ks][ct], acc[rt][ct], 0, 0, 0); }
#pragma unroll
    for (int rt = 0; rt < 4; ++rt)
#pragma unroll
        for (int ct = 0; ct < 2; ++ct)
#pragma unroll
            for (int j = 0; j < 4; ++j) outb[(rt * 16 + quad * 4 + j) * 256 + wave * 32 + ct * 16 + r16] = acc[rt][ct][j];
}
__device__ __forceinline__ void m1_phase(Frame& F, int l) {
    LAS float* ubuf = (LAS float*)F.lds;
    LAS float* pl = (LAS float*)(F.lds + 65536);
    const int tid = F.tid, lane = F.lane, wave = F.wave;
    const int ch = tid & 255, half = tid >> 8;
    for (int c = F.bx; c < TT / 64; c += F.G) {
        const int t0 = c * 64, tb = t0 + half * 32, sb = tb & (SEQ - 1);
        load_u5_tile(F, t0, ubuf);
        __syncthreads();
#pragma unroll 1
        for (int gi = 0; gi < 2; ++gi) { const int g = wave + 8 * gi; S5Par P; s5_params(F, l, g, lane, P); float hr = 0.f, hi = 0.f;
#pragma unroll 2
            for (int j = 0; j < 64; ++j) s5_step(P, ubuf + j * 256 + g * 16, hr, hi);
            *(f32x2*)(F.E + (((size_t)c * 16 + g) * 64 + lane) * 2) = (f32x2){hr, hi}; }
        __syncthreads();
        LAS float* accp = pl + half * 32 * 256 + ch;
        LAS unsigned short* hb16 = (LAS unsigned short*)F.lds;
        const bf16_t* l2w = (const bf16_t*)(F.ws + WS_W + W_L2);
        h16 la[32], lb[32];
#pragma unroll
        for (int tt = 0; tt < 32; ++tt) { const int t = tb + tt; la[tt] = F.L16[(size_t)t * 512 + ch]; lb[tt] = (sb + tt > 0) ? F.L16[(size_t)(t - 1) * 512 + 256 + ch] : (h16)0.f; }
#pragma unroll
        for (int tt = 0; tt < 32; ++tt) { float pre = (float)la[tt] + (float)lb[tt];
            float a = pre; if (ch < 64) a = 1.0f - 2.0f * __builtin_amdgcn_rcpf(1.0f + __expf(2.0f * pre)); else if (ch >= 128) a = sigmoidf_(pre);
            hb16[(half * 32 + tt) * 264 + ch] = (unsigned short)f2bf(a); }
        __syncthreads();
        const int hb = (t0 / SEQ) * 4 + (ch >> 6);
        unsigned char* rwb = F.RW + ((size_t)hb * SEQ + sb) * 896;
        const int cl = ch & 63;
        {
            lora_mfma<64>(hb16, 0, l2w, pl, wave, lane);
            __syncthreads();
            const float w0 = F.in[20][(size_t)l * 256 + ch];
#pragma unroll 2
            for (int tt = 0; tt < 32; ++tt) { const float z = -(accp[tt * 256] + w0); const float sp = fmaxf(z, 0.f) + __logf(1.0f + __expf(-fabsf(z)));
                const float wlog = -sp - 0.5f; const float dec = __expf(-__expf(wlog));
                *(float*)(rwb + (size_t)tt * 896 + cl * 4) = dec; }
        }
        {
            __syncthreads();
            lora_mfma<128>(hb16, 128, l2w + 2 * 256 * 64, pl, wave, lane);
            __syncthreads();
#pragma unroll 4
            for (int tt = 0; tt < 32; ++tt) F.G16[(size_t)(tb + tt) * 256 + ch] = (h16)accp[tt * 256];
        }
        {
            __syncthreads();
            lora_mfma<64>(hb16, 64, l2w + 256 * 64, pl, wave, lane);
            __syncthreads();
            const float a0 = F.in[23][(size_t)l * 256 + ch];
            const float mur = F.in[18][((size_t)l * 3 + 0) * 256 + ch], muk = F.in[18][((size_t)l * 3 + 1) * 256 + ch], muv = F.in[18][((size_t)l * 3 + 2) * 256 + ch];
            const float kkw = F.in[28][(size_t)l * 256 + ch], kaw = F.in[29][(size_t)l * 256 + ch];
            const h16* pp = F.PP + (size_t)tb * 1792 + 256 + ch;
            float rprev = 0.f, kprev = 0.f, vprev = 0.f;
            if (sb > 0) { rprev = (float)pp[-(ptrdiff_t)1792]; kprev = (float)pp[-(ptrdiff_t)1792 + 256]; vprev = (float)pp[-(ptrdiff_t)1792 + 512]; }
#pragma unroll 1
            for (int t16 = 0; t16 < 32; t16 += 16) {
                h16 rq[16], kq[16], vq[16];
#pragma unroll
                for (int tt = 0; tt < 16; ++tt) { const h16* q = pp + (size_t)(t16 + tt) * 1792; rq[tt] = q[0]; kq[tt] = q[256]; vq[tt] = q[512]; }
#pragma unroll
                for (int tt = 0; tt < 16; ++tt) { const float a = sigmoidf_(accp[(t16 + tt) * 256] + a0);
                    const float rp = (float)rq[tt], kp = (float)kq[tt], vp = (float)vq[tt];
                    const float r = rp + (rprev - rp) * mur, k = kp + (kprev - kp) * muk, v = vp + (vprev - vp) * muv;
                    rprev = rp; kprev = kp; vprev = vp;
                    const float kkv = k * kkw; const float kk = kkv * rsqrtf(fmaxf(wave_sum(kkv * kkv), 1e-24f));
                    const float kt = k * (1.0f + (a - 1.0f) * kaw); const float bb = kk * a;
                    h16* o = (h16*)(rwb + (size_t)(t16 + tt) * 896 + 256) + cl;
                    o[0] = (h16)r; o[64] = (h16)kt; o[128] = (h16)v; o[192] = (h16)kk; o[256] = (h16)bb; } }
        }
        __syncthreads();
    }
}

__device__ __forceinline__ void pool_conv_chunk(Frame& F, int l, int c) {
    LAS float* ubuf = (LAS float*)F.lds;
    LAS float* pl = (LAS float*)(F.lds + 65536);
    const int tid = F.tid; const int ch = tid & 255, half = tid >> 8;
    const int t0 = c * 64, tb = t0 + half * 32, sb = tb & (SEQ - 1);
    {
    {
        const int grp = ch >> 6, win = 2 << grp;
        const h16* up = F.PP + (size_t)tb * 1792 + ch;
        float s = 0.f;
        for (int j = 1; j <= win; ++j) if (sb - j >= 0) s += (float)up[-(ptrdiff_t)j * 1792];
#pragma unroll 1
        for (int t16 = 0; t16 < 32; t16 += 16) {
            h16 uq[16], ul[16];
#pragma unroll
            for (int tt = 0; tt < 16; ++tt) { uq[tt] = up[(size_t)(t16 + tt) * 1792]; ul[tt] = (sb + t16 + tt - win >= 0) ? up[(ptrdiff_t)(t16 + tt - win) * 1792] : (h16)0.f; }
#pragma unroll
            for (int tt = 0; tt < 16; ++tt) { const float u = (float)uq[tt]; s += u; const int pos = sb + t16 + tt;
                s -= (float)ul[tt];
                const float cnt = (float)((pos + 1 < win) ? (pos + 1) : win);
                pl[(half * 32 + t16 + tt) * 256 + ch] = s / cnt - u; } }
    }
    {
        const h16* zp = F.PP + (size_t)tb * 1792 + 1024 + ch;
        const float cw0 = F.in[33][((size_t)l * 3 + 0) * 256 + ch], cw1 = F.in[33][((size_t)l * 3 + 1) * 256 + ch], cw2 = F.in[33][((size_t)l * 3 + 2) * 256 + ch];
        float z2 = 0.f, z1 = 0.f;
        if (sb >= 1) z1 = (float)zp[-(ptrdiff_t)1792 + 512] * (float)zp[-(ptrdiff_t)1792];
        if (sb >= 2) z2 = (float)zp[-(ptrdiff_t)2 * 1792 + 512] * (float)zp[-(ptrdiff_t)2 * 1792];
#pragma unroll 1
        for (int t16 = 0; t16 < 32; t16 += 16) {
            h16 zx[16], zb[16], zc[16];
#pragma unroll
            for (int tt = 0; tt < 16; ++tt) { const h16* q = zp + (size_t)(t16 + tt) * 1792; zx[tt] = q[0]; zb[tt] = q[256]; zc[tt] = q[512]; }
#pragma unroll
            for (int tt = 0; tt < 16; ++tt) { const float z0 = (float)zc[tt] * (float)zx[tt];
                const float y = (float)zb[tt] * (cw0 * z2 + cw1 * z1 + cw2 * z0);
                F.B2[(size_t)(tb + t16 + tt) * 1024 + 768 + ch] = (bf16_t)f2bf(y); z2 = z1; z1 = z0; } }
    }
    __syncthreads();
    LAS float* accu = ubuf + half * 32 * 256 + ch;
    {
        const int grp = ch >> 6, d = ch & 63;
        const float* pw = F.in[16] + (((size_t)l * 4 + grp) * 64) * 64 + d;
        mv32<true>(accu, 0.f, pl + half * 32 * 256 + grp * 64, pw, 64);
        mv32<false>(accu, 0.f, pl + half * 32 * 256 + grp * 64 + 32, pw + 32 * 64, 64);
        const float sc = F.in[17][(size_t)l * 256 + ch];
#pragma unroll 4
        for (int tt = 0; tt < 32; ++tt) F.B2[(size_t)(tb + tt) * 1024 + 256 + ch] = (bf16_t)f2bf(accu[tt * 256] * sc);
    }
    __syncthreads();
    }
}

#define XB_TMO      128
#define XB_XCNT(j)  (256  + 64 * (j))
#define XB_XSUB(j)  (1280 + 64 * (j))
#define XB_XGEN(j)  (2304 + 64 * (j))
#define XB_TOP      3328
#define XB_TOPGEN   3392
#define XCD_BAR_WORDS 3456
#define XB_SPIN_CAP (1u << 18)

__device__ __forceinline__ unsigned xb_ld(unsigned* p)              { return __hip_atomic_load(p, __ATOMIC_RELAXED, __HIP_MEMORY_SCOPE_AGENT); }
__device__ __forceinline__ unsigned xb_add(unsigned* p, unsigned v) { return __hip_atomic_fetch_add(p, v, __ATOMIC_RELAXED, __HIP_MEMORY_SCOPE_AGENT); }
__device__ __forceinline__ unsigned xb_xcc_id() { return (unsigned)__builtin_amdgcn_s_getreg((3 << 11) | 20) & 0xFu; }
#define XB_SPIN(cond, bar) do { unsigned _sp = 0; while (cond) { __builtin_amdgcn_s_sleep(1); \
    if ((++_sp & 255u) == 0u) { if (xb_ld(&(bar)[XB_TMO])) break; if (_sp > XB_SPIN_CAP) { atomicAdd(&(bar)[XB_TMO], 1u); break; } } } } while (0)

struct XcdBarrier {
    unsigned* bar; unsigned x;
    volatile LAS unsigned* st;
};

__device__ __forceinline__ XcdBarrier xcd_barrier_post(unsigned* bar, volatile LAS unsigned* st) {
    XcdBarrier b; b.bar = bar; b.x = xb_xcc_id(); b.st = st;
    if (threadIdx.x == 0) (void)xb_add(&bar[XB_XCNT(b.x)], 1u);
    return b;
}
__device__ __forceinline__ void xcd_barrier_complete(unsigned* bar, unsigned x, unsigned& nloc, unsigned& nx) {
    const unsigned G = gridDim.x * gridDim.y * gridDim.z;
    unsigned sum, cnt, mine, sp = 0u;
    for (;;) {
        sum = 0u; cnt = 0u; mine = 0u;
#pragma unroll
        for (unsigned j = 0; j < 16; ++j) { const unsigned c = xb_ld(&bar[XB_XCNT(j)]); sum += c; cnt += (c > 0u) ? 1u : 0u; mine = (j == x) ? c : mine; }
        if (sum == G) break;
        __builtin_amdgcn_s_sleep(1);
        if ((++sp & 255u) == 0u) { if (xb_ld(&bar[XB_TMO])) break; if (sp > XB_SPIN_CAP) { atomicAdd(&bar[XB_TMO], 1u); break; } }
    }
    nloc = mine > 0u ? mine : 1u; nx = cnt > 0u ? cnt : 1u;
}

__device__ __forceinline__ void xcd_barrier(const XcdBarrier& b) {
    asm volatile("s_waitcnt vmcnt(0)" ::: "memory");
    __syncthreads();
    if (threadIdx.x == 0) {
        unsigned* bar = b.bar;
        __builtin_amdgcn_s_waitcnt(0);
        unsigned nloc = b.st[0], nx = b.st[1];
        if (nloc == 0u) { xcd_barrier_complete(bar, b.x, nloc, nx); b.st[0] = nloc; b.st[1] = nx; }
        const unsigned old = xb_add(&bar[XB_XSUB(b.x)], 1u);
        const unsigned gen = old / nloc;
        if (old + 1u == (gen + 1u) * nloc) {
            __builtin_amdgcn_fence(__ATOMIC_RELEASE, "agent");
            asm volatile("s_waitcnt vmcnt(0)" ::: "memory");
            const unsigned og = xb_add(&bar[XB_TOP], 1u);
            const unsigned tg = og / nx;
            if (og + 1u == (tg + 1u) * nx) xb_add(&bar[XB_TOPGEN], 1u);
            else XB_SPIN(xb_ld(&bar[XB_TOPGEN]) == tg, bar);
            __builtin_amdgcn_fence(__ATOMIC_ACQUIRE, "agent");
            xb_add(&bar[XB_XGEN(b.x)], 1u);
            asm volatile("s_waitcnt vmcnt(0)" ::: "memory");
        } else {
            XB_SPIN(xb_ld(&bar[XB_XGEN(b.x)]) == gen, bar);
            __builtin_amdgcn_fence(__ATOMIC_ACQUIRE, "agent");
            asm volatile("s_waitcnt vmcnt(0)" ::: "memory");
        }
    }
    __syncthreads();
}

__device__ __forceinline__ float a_fma(float a, float b, float c) { float d; asm("v_fma_f32 %0, %1, %2, %3" : "=v"(d) : "v"(a), "v"(b), "v"(c)); return d; }
__device__ __forceinline__ float a_fnma(float a, float b, float c) { float d; asm("v_fma_f32 %0, -%1, %2, %3" : "=v"(d) : "v"(a), "v"(b), "v"(c)); return d; }
__device__ __forceinline__ float a_mul(float a, float b) { float d; asm("v_mul_f32 %0, %1, %2" : "=v"(d) : "v"(a), "v"(b)); return d; }
__device__ __forceinline__ float a_add(float a, float b) { float d; asm("v_add_f32 %0, %1, %2" : "=v"(d) : "v"(a), "v"(b)); return d; }
constexpr int RC_LEN = 256, RC_N = SEQ / RC_LEN;
constexpr int ST_STEPS = 16, ST_FL = ST_STEPS * 384, ST_NPC = ST_STEPS * 56, ST_OB = ST_STEPS * 32 * 16, ST_NSUB = RC_LEN / ST_STEPS;
__device__ __forceinline__ void st_load(const unsigned char* src, int sub, int tid, u32x4 (&rg)[2]) {
#pragma unroll
    for (int n = 0; n < 2; ++n) { const int i = tid + NTHR * n; if (i < ST_NPC) { const int step = i / 56, j = i % 56;
        rg[n] = *(const u32x4*)(src + ((size_t)sub * ST_STEPS + step) * 896 + (j < 16 ? j * 16 : 256 + (j - 16) * 16)); } }
}
__device__ __forceinline__ void st_store(LAS float* buf, int tid, const u32x4 (&rg)[2]) {
#pragma unroll
    for (int n = 0; n < 2; ++n) { const int i = tid + NTHR * n; if (i < ST_NPC) { const int step = i / 56, j = i % 56;
        if (j < 16) { *(LAS u32x4*)(buf + step * 384 + j * 4) = rg[n]; }
        else { const int a = (j - 16) >> 3, e = (j - 16) & 7; const h16x8 h = __builtin_bit_cast(h16x8, rg[n]); f32x4 lo, hi;
            lo[0] = (float)h[0]; lo[1] = (float)h[1]; lo[2] = (float)h[2]; lo[3] = (float)h[3]; hi[0] = (float)h[4]; hi[1] = (float)h[5]; hi[2] = (float)h[6]; hi[3] = (float)h[7];
            LAS f32x4* d = (LAS f32x4*)(buf + step * 384 + 64 + a * 64 + e * 8); d[0] = lo; d[1] = hi; } } }
}
#define RAW_BAR() do { asm volatile("s_waitcnt lgkmcnt(0)" ::: "memory"); __builtin_amdgcn_s_barrier(); asm volatile("" ::: "memory"); } while (0)
#define DPP_ADD(x_, ctl_) "v_add_f32_dpp %[" x_ "], %[" x_ "], %[" x_ "] " ctl_ " row_mask:0xf bank_mask:0xf bound_ctrl:1\n\t"
template <bool OUT> __device__ __forceinline__ void scan_task(Frame& F, const unsigned char* src, const float* initS, bool ident, bool use_v, float* endS, float* Og) {
    constexpr int STS = OUT ? 8 : 16, NSUB = RC_LEN / STS, FL = STS * 384, NPC = STS * 56, PT = (NPC + NTHR - 1) / NTHR, OB = STS * 64 * 16;
    LAS float* buf = (LAS float*)F.lds;
    LAS float* obuf = (LAS float*)(F.lds + 2 * FL * 4);
    const int tid = F.tid, wave = F.wave, lane = F.lane, ks = lane & 15;
    int rowr[2]; float S[2][4];
#pragma unroll
    for (int r = 0; r < 2; ++r) { rowr[r] = (wave * 2 + r) * 4 + (lane >> 4);
        if (initS) { const f32x4 i4 = *(const f32x4*)(initS + (size_t)rowr[r] * 64 + 4 * ks); S[r][0] = i4[0]; S[r][1] = i4[1]; S[r][2] = i4[2]; S[r][3] = i4[3]; }
        else {
#pragma unroll
            for (int e = 0; e < 4; ++e) S[r][e] = (ident && 4 * ks + e == rowr[r]) ? 1.f : 0.f; } }
    u32x4 rg[2][PT];
#define ST_LOAD(sub_, rg_) do { _Pragma("unroll") for (int n_ = 0; n_ < PT; ++n_) { const int i_ = tid + NTHR * n_; if (i_ < NPC) { const int step_ = i_ / 56, j_ = i_ % 56; \
        rg_[n_] = *(const u32x4*)(src + ((size_t)(sub_) * STS + step_) * 896 + (j_ < 16 ? j_ * 16 : 256 + (j_ - 16) * 16)); } } } while (0)
#define ST_STORE(buf_, rg_) do { _Pragma("unroll") for (int n_ = 0; n_ < PT; ++n_) { const int i_ = tid + NTHR * n_; if (i_ < NPC) { const int step_ = i_ / 56, j_ = i_ % 56; \
        if (j_ < 16) { *(LAS u32x4*)((buf_) + step_ * 384 + j_ * 4) = rg_[n_]; } \
        else { const int a_ = (j_ - 16) >> 3, e_ = (j_ - 16) & 7; const h16x8 h_ = __builtin_bit_cast(h16x8, rg_[n_]); f32x4 lo_, hi_; \
            lo_[0] = (float)h_[0]; lo_[1] = (float)h_[1]; lo_[2] = (float)h_[2]; lo_[3] = (float)h_[3]; hi_[0] = (float)h_[4]; hi_[1] = (float)h_[5]; hi_[2] = (float)h_[6]; hi_[3] = (float)h_[7]; \
            LAS f32x4* d_ = (LAS f32x4*)((buf_) + step_ * 384 + 64 + a_ * 64 + e_ * 8); d_[0] = lo_; d_[1] = hi_; } } } } while (0)
    ST_LOAD(0, rg[0]); ST_STORE(buf, rg[0]); ST_LOAD(1, rg[1]); ST_LOAD(2, rg[0]);
    RAW_BAR();
#pragma unroll 1
    for (int sc2 = 0; sc2 < NSUB; sc2 += 2) {
#pragma unroll
      for (int u = 0; u < 2; ++u) { const int sc = sc2 + u;
        if (sc + 1 < NSUB) { ST_STORE(buf + ((sc + 1) & 1) * FL, rg[(u + 1) & 1]); if (sc + 3 < NSUB) ST_LOAD(sc + 3, rg[(u + 1) & 1]); }
        {
            const LAS float* bb = buf + (sc & 1) * FL + 4 * ks; const LAS float* vb0 = buf + (sc & 1) * FL + 192 + rowr[0]; const LAS float* vb1 = buf + (sc & 1) * FL + 192 + rowr[1];
            LAS float* ob0 = obuf + (sc & 1) * OB + rowr[0] * 16 + ks; LAS float* ob1 = obuf + (sc & 1) * OB + rowr[1] * 16 + ks;
            f32x4 w_[2], r_[2], k_[2], kk_[2], b_[2]; float v_[2][2];
#define SC_LD(s_, j_) do { const LAS float* p_ = bb + (s_) * 384; w_[j_] = *(const LAS f32x4*)(p_); if (OUT) r_[j_] = *(const LAS f32x4*)(p_ + 64); k_[j_] = *(const LAS f32x4*)(p_ + 128); \
                kk_[j_] = *(const LAS f32x4*)(p_ + 256); b_[j_] = *(const LAS f32x4*)(p_ + 320); v_[j_][0] = vb0[(s_) * 384]; v_[j_][1] = vb1[(s_) * 384]; } while (0)
            SC_LD(0, 0);
#pragma unroll
            for (int s = 0; s < STS; ++s) { const int j = s & 1;
                f32x4 rp; if (OUT) rp = r_[j ^ 1];
                if (s + 1 < STS) SC_LD(s + 1, j ^ 1);
                const f32x4 w = w_[j], k = k_[j], kk = kk_[j], bv = b_[j];
#pragma unroll
                for (int r = 0; r < 2; ++r) { const float v = use_v ? v_[j][r] : 0.f;
                    float sa, op, u0, u1, u2, u3;
                    if (OUT && s > 0) {
                        asm volatile(
                            "v_mul_f32 %[sa], %[Sa], %[kk0]\n\t" "v_fma_f32 %[sa], %[Sb], %[kk1], %[sa]\n\t" "v_fma_f32 %[sa], %[Sc], %[kk2], %[sa]\n\t" "v_fma_f32 %[sa], %[Sd], %[kk3], %[sa]\n\t"
                            "v_mul_f32 %[op], %[Sa], %[r0]\n\t" "v_fma_f32 %[op], %[Sb], %[r1], %[op]\n\t"
                            DPP_ADD("sa", "quad_perm:[1,0,3,2]") "v_fma_f32 %[op], %[Sc], %[r2], %[op]\n\t" "v_fma_f32 %[op], %[Sd], %[r3], %[op]\n\t"
                            DPP_ADD("sa", "quad_perm:[2,3,0,1]") "v_mul_f32 %[u0], %[v], %[k0]\n\t" "v_mul_f32 %[u1], %[v], %[k1]\n\t"
                            DPP_ADD("sa", "row_half_mirror") "v_mul_f32 %[u2], %[v], %[k2]\n\t" "v_mul_f32 %[u3], %[v], %[k3]\n\t"
                            DPP_ADD("sa", "row_mirror")
                            : [sa] "=&v"(sa), [op] "=&v"(op), [u0] "=&v"(u0), [u1] "=&v"(u1), [u2] "=&v"(u2), [u3] "=&v"(u3)
                            : [Sa] "v"(S[r][0]), [Sb] "v"(S[r][1]), [Sc] "v"(S[r][2]), [Sd] "v"(S[r][3]), [kk0] "v"(kk[0]), [kk1] "v"(kk[1]), [kk2] "v"(kk[2]), [kk3] "v"(kk[3]),
                              [r0] "v"(rp[0]), [r1] "v"(rp[1]), [r2] "v"(rp[2]), [r3] "v"(rp[3]), [v] "v"(v), [k0] "v"(k[0]), [k1] "v"(k[1]), [k2] "v"(k[2]), [k3] "v"(k[3]));
                        (r == 0 ? ob0 : ob1)[(s - 1) * 1024] = op;
                    } else {
                        asm volatile(
                            "v_mul_f32 %[sa], %[Sa], %[kk0]\n\t" "v_fma_f32 %[sa], %[Sb], %[kk1], %[sa]\n\t" "v_fma_f32 %[sa], %[Sc], %[kk2], %[sa]\n\t" "v_fma_f32 %[sa], %[Sd], %[kk3], %[sa]\n\t"
                            "v_mul_f32 %[u0], %[v], %[k0]\n\t" "v_mul_f32 %[u1], %[v], %[k1]\n\t"
                            DPP_ADD("sa", "quad_perm:[1,0,3,2]") "v_mul_f32 %[u2], %[v], %[k2]\n\t" "v_mul_f32 %[u3], %[v], %[k3]\n\t"
                            DPP_ADD("sa", "quad_perm:[2,3,0,1]") "s_nop 1\n\t"
                            DPP_ADD("sa", "row_half_mirror") "s_nop 1\n\t"
                            DPP_ADD("sa", "row_mirror")
                            : [sa] "=&v"(sa), [u0] "=&v"(u0), [u1] "=&v"(u1), [u2] "=&v"(u2), [u3] "=&v"(u3)
                            : [Sa] "v"(S[r][0]), [Sb] "v"(S[r][1]), [Sc] "v"(S[r][2]), [Sd] "v"(S[r][3]), [kk0] "v"(kk[0]), [kk1] "v"(kk[1]), [kk2] "v"(kk[2]), [kk3] "v"(kk[3]),
                              [v] "v"(v), [k0] "v"(k[0]), [k1] "v"(k[1]), [k2] "v"(k[2]), [k3] "v"(k[3]));
                    }
                    asm volatile(
                        "v_fma_f32 %[u0], -%[sa], %[b0], %[u0]\n\t" "v_fma_f32 %[u1], -%[sa], %[b1], %[u1]\n\t" "v_fma_f32 %[u2], -%[sa], %[b2], %[u2]\n\t" "v_fma_f32 %[u3], -%[sa], %[b3], %[u3]\n\t"
                        "v_fma_f32 %[Sa], %[Sa], %[w0], %[u0]\n\t" "v_fma_f32 %[Sb], %[Sb], %[w1], %[u1]\n\t" "v_fma_f32 %[Sc], %[Sc], %[w2], %[u2]\n\t" "v_fma_f32 %[Sd], %[Sd], %[w3], %[u3]\n\t"
                        : [Sa] "+v"(S[r][0]), [Sb] "+v"(S[r][1]), [Sc] "+v"(S[r][2]), [Sd] "+v"(S[r][3]), [u0] "+v"(u0), [u1] "+v"(u1), [u2] "+v"(u2), [u3] "+v"(u3)
                        : [sa] "v"(sa), [b0] "v"(bv[0]), [b1] "v"(bv[1]), [b2] "v"(bv[2]), [b3] "v"(bv[3]), [w0] "v"(w[0]), [w1] "v"(w[1]), [w2] "v"(w[2]), [w3] "v"(w[3])); }
                __builtin_amdgcn_sched_barrier(0); }
            if (OUT) { const f32x4 r4 = r_[(STS - 1) & 1];
              ob0[(STS - 1) * 1024] = a_fma(S[0][3], r4[3], a_fma(S[0][2], r4[2], a_fma(S[0][1], r4[1], a_mul(S[0][0], r4[0]))));
              ob1[(STS - 1) * 1024] = a_fma(S[1][3], r4[3], a_fma(S[1][2], r4[2], a_fma(S[1][1], r4[1], a_mul(S[1][0], r4[0])))); }
#undef SC_LD
        }
        RAW_BAR();
        if (OUT) {
            const LAS f32x4* p = (const LAS f32x4*)(obuf + (sc & 1) * OB + tid * 16); const f32x4 a = p[0], b = p[1], c = p[2], d = p[3];
            const float o = (((a[0] + a[1]) + (a[2] + a[3])) + ((b[0] + b[1]) + (b[2] + b[3]))) + (((c[0] + c[1]) + (c[2] + c[3])) + ((d[0] + d[1]) + (d[2] + d[3])));
            Og[((size_t)sc * STS + (tid >> 6)) * 256 + (tid & 63)] = o; }
      }
    }
#undef ST_LOAD
#undef ST_STORE
    if (endS) {
#pragma unroll
        for (int r = 0; r < 2; ++r) *(f32x4*)(endS + (size_t)rowr[r] * 64 + 4 * ks) = (f32x4){S[r][0], S[r][1], S[r][2], S[r][3]}; }
    RAW_BAR();
}
#undef DPP_ADD
__device__ __forceinline__ void rwkv_carry(Frame& F) {
    const int hb = F.bx >> 3, row = (F.bx & 7) * 8 + F.wave, lane = F.lane, tid = F.tid;
    LAS float* Pl = (LAS float*)F.lds;
    LAS float* Sl = (LAS float*)(F.lds + 16384) + F.wave * 64;
    float S = 0.f;
    const size_t m0 = (size_t)hb * RC_N * 4096;
    f32x4 p0 = *(const f32x4*)(F.PB + m0 + (size_t)tid * 8), p1 = *(const f32x4*)(F.PB + m0 + (size_t)tid * 8 + 4);
    float lc = F.LB[m0 + (size_t)row * 64 + lane];
#pragma unroll 1
    for (int c = 0; c < RC_N; ++c) { const size_t mo = m0 + (size_t)c * 4096;
        F.SB[mo + (size_t)row * 64 + lane] = S;
        if (c + 1 == RC_N) break;
        float acc = lc;
        *(LAS f32x4*)(Pl + tid * 8) = p0; *(LAS f32x4*)(Pl + tid * 8 + 4) = p1; Sl[lane] = S;
        if (c + 2 < RC_N) { p0 = *(const f32x4*)(F.PB + mo + 4096 + (size_t)tid * 8); p1 = *(const f32x4*)(F.PB + mo + 4096 + (size_t)tid * 8 + 4); lc = F.LB[mo + 4096 + (size_t)row * 64 + lane]; }
        RAW_BAR();
        float a0 = 0.f, a1 = 0.f, a2 = 0.f, a3 = 0.f;
#pragma unroll 4
        for (int j = 0; j < 64; j += 4) { const f32x4 s4 = *(const LAS f32x4*)(Sl + j);
            a0 += s4[0] * Pl[(j + 0) * 64 + lane]; a1 += s4[1] * Pl[(j + 1) * 64 + lane]; a2 += s4[2] * Pl[(j + 2) * 64 + lane]; a3 += s4[3] * Pl[(j + 3) * 64 + lane]; }
        S = acc + ((a0 + a1) + (a2 + a3));
        RAW_BAR();
    }
}
__device__ __forceinline__ float gelu_tanh(float x) { const float u = 0.7978845608028654f * (x + 0.044715f * x * x * x); return 0.5f * x * (1.0f + tanhf(u)); }
__device__ __forceinline__ void s5_pass2(Frame& F, int l, int c) {
    LAS float* ubuf = (LAS float*)F.lds;
    LAS float* ybuf = (LAS float*)(F.lds + 65536);
    const int t0 = c * 64, lane = F.lane, wave = F.wave, cb0 = c & ~127;
    load_u5_tile(F, t0, ubuf);
    __syncthreads();
#pragma unroll 1
    for (int gi = 0; gi < 2; ++gi) { const int g = wave + 8 * gi; S5Par P; s5_params(F, l, g, lane, P);
        float cr[16], ci[16]; int lane_l = lane; asm volatile("" : "+v"(lane_l));
#pragma unroll
        for (int hh = 0; hh < 16; ++hh) { cr[hh] = F.in[12][(((size_t)l * 16 + g) * 16 + hh) * 64 + lane_l]; ci[hh] = F.in[13][(((size_t)l * 16 + g) * 16 + hh) * 64 + lane_l]; }
        float pr = P.ar, pi = P.ai;
#pragma unroll
        for (int s = 0; s < 6; ++s) { const float nr = pr * pr - pi * pi, ni = 2.0f * pr * pi; pr = nr; pi = ni; }
        float hr = 0.f, hi = 0.f;
#pragma unroll 1
        for (int c2 = cb0; c2 < c; c2 += 16) {
            f32x2 e[16];
#pragma unroll
            for (int q = 0; q < 16; ++q) { const int cq = (c2 + q < c) ? c2 + q : c2; e[q] = *(const f32x2*)(F.E + (((size_t)cq * 16 + g) * 64 + lane_l) * 2); }
#pragma unroll
            for (int q = 0; q < 16; ++q) if (c2 + q < c) { const float nr = pr * hr - pi * hi + e[q][0], ni = pr * hi + pi * hr + e[q][1]; hr = nr; hi = ni; } }
        const bool b3 = (lane & 8) != 0, b2 = (lane & 4) != 0, b1 = (lane & 2) != 0, b0 = (lane & 1) != 0;
#pragma unroll 1
        for (int j = 0; j < 64; ++j) { s5_step(P, ubuf + j * 256 + g * 16, hr, hi);
            float v8[8], v4[4], v2[2];
#pragma unroll
            for (int i = 0; i < 8; ++i) { const float lo = hr * cr[i] - hi * ci[i], hv = hr * cr[i + 8] - hi * ci[i + 8];
                const float keep = b3 ? hv : lo, send = b3 ? lo : hv; v8[i] = keep + dppx<0x140>(send); }
#pragma unroll
            for (int i = 0; i < 4; ++i) { const float keep = b2 ? v8[i + 4] : v8[i], send = b2 ? v8[i] : v8[i + 4]; v4[i] = keep + dppx<0x141>(send); }
#pragma unroll
            for (int i = 0; i < 2; ++i) { const float keep = b1 ? v4[i + 2] : v4[i], send = b1 ? v4[i] : v4[i + 2]; v2[i] = keep + dppx<0x4E>(send); }
            float y = (b0 ? v2[1] : v2[0]) + dppx<0xB1>(b0 ? v2[0] : v2[1]);
            y += __shfl_xor(y, 16); y += __shfl_xor(y, 32);
            if (lane < 16) ybuf[j * 256 + g * 16 + lane] = y; }
    }
    __syncthreads();
    { const int ch = F.tid & 255, half = F.tid >> 8; const float dd = F.in[14][(size_t)l * 256 + ch];
        for (int tt = 0; tt < 32; ++tt) { const int tl = half * 32 + tt; const float y = ybuf[tl * 256 + ch] + dd * ubuf[tl * 256 + ch];
            F.GL[(size_t)(t0 + tl) * 256 + ch] = (bf16_t)f2bf(gelu_tanh(y)); } }
    __syncthreads();
}
template <int PART> __device__ __forceinline__ void m2_phase(Frame& F, int l, const XcdBarrier& xbar) {
    if (PART == 0 || PART == 1)
#pragma unroll 1
    for (int id = F.bx; id < 8 * RC_N * 2; id += F.G) { const int hb = id >> 6, c = (id >> 1) & (RC_N - 1), tk = id & 1; const size_t mo = ((size_t)hb * RC_N + c) * 4096;
        if (c == RC_N - 1) continue;
        const unsigned char* src = F.RW + ((size_t)hb * SEQ + (size_t)c * RC_LEN) * 896;
        scan_task<false>(F, src, nullptr, tk == 1, tk == 0, (tk == 0 ? F.LB : F.PB) + mo, nullptr); }
    if (PART == 0 || PART == 2)
#pragma unroll 1
    for (int c = F.bx; c < TT / 64; c += F.G) pool_conv_chunk(F, l, c);
    xcd_barrier(xbar);
    if (PART == 0 || PART == 3) { int bxs = F.bx; asm volatile("" : "+s"(bxs));
      if (bxs < 64) rwkv_carry(F);
      else conv_second_half(F, l, 64); }
    xcd_barrier(xbar);
    if (PART == 0 || PART == 4)
#pragma unroll 1
    for (int id = F.bx; id < 8 * RC_N; id += F.G) { const int hb = id >> 5, c = id & (RC_N - 1); const size_t mo = ((size_t)hb * RC_N + c) * 4096;
        const unsigned char* src = F.RW + ((size_t)hb * SEQ + (size_t)c * RC_LEN) * 896;
        float* Og = F.O + ((size_t)(hb >> 2) * SEQ + (size_t)c * RC_LEN) * 256 + (hb & 3) * 64;
        scan_task<true>(F, src, F.SB + mo, false, true, nullptr, Og); }
    if (PART == 0 || PART == 5)
#pragma unroll 1
    for (int c = F.bx; c < TT / 64; c += F.G) s5_pass2(F, l, c);
}
__device__ __forceinline__ void rwkv_post(Frame& F, int l) {
    const int gw = F.bx * NWAVES + F.wave, NGW = F.G * NWAVES, lane = F.lane;
    for (int it0 = gw * 4; it0 < TT * 4; it0 += NGW * 4) {
        const int t = it0 >> 2, b = t / SEQ, pos = t & (SEQ - 1);
        float o[4], r[4], k[4], v[4], g[4];
#pragma unroll
        for (int hh = 0; hh < 4; ++hh) { const int c = hh * 64 + lane; o[hh] = F.O[(size_t)t * 256 + c]; g[hh] = (float)F.G16[(size_t)t * 256 + c];
            const h16* rw = (const h16*)(F.RW + ((size_t)(b * 4 + hh) * SEQ + pos) * 896 + 256) + lane; r[hh] = (float)rw[0]; k[hh] = (float)rw[64]; v[hh] = (float)rw[128]; }
#pragma unroll
        for (int hh = 0; hh < 4; ++hh) { const int c = hh * 64 + lane;
            const float mu = wave_sum(o[hh]) * (1.0f / 64.0f); const float d = o[hh] - mu; const float var = wave_sum(d * d) * (1.0f / 64.0f);
            const float on = d * rsqrtf(var + 64e-5f) * F.in[31][(size_t)l * 256 + c] + F.in[32][(size_t)l * 256 + c];
            const float bs = wave_sum(r[hh] * k[hh] * F.in[30][(size_t)l * 256 + c]);
            F.B2[(size_t)t * 1024 + 512 + c] = (bf16_t)f2bf((on + bs * v[hh]) * g[hh]); }
    }
}

constexpr int NPH = 25;
#ifndef PHMASK
#define PHMASK 0xFFFF
#endif
#define PHON(k) (((PHMASK) >> (k)) & 1)
#ifndef REP_PART
#define REP_PART 0
#endif
template <int PH, int PART = 0> __device__ __forceinline__ void run_phase(const int wave_s, unsigned char* lds_raw, const XcdBarrier& xbar) {
    typedef pg8::StaticOrder SO;
    int tid = wave_s * 64 + (int)__builtin_amdgcn_mbcnt_hi(~0u, __builtin_amdgcn_mbcnt_lo(~0u, 0u)); asm volatile("" : "+v"(tid));
    int G = gridDim.x, bx = blockIdx.x; asm volatile("" : "+s"(G), "+s"(bx));
    const __attribute__((address_space(4))) unsigned char* ka = (const __attribute__((address_space(4))) unsigned char*)__builtin_amdgcn_kernarg_segment_ptr();
    asm volatile("" : "+s"(ka));
    const __attribute__((address_space(4))) Args* ap = (const __attribute__((address_space(4))) Args*)ka;
    Frame F;
    F.lds = (LAS unsigned char*)lds_raw;
    F.tid = tid; F.lane = tid & 63; F.wave = __builtin_amdgcn_readfirstlane(tid >> 6); F.G = G; F.bx = bx;
    F.in = (in_t)ka; F.X = ap->out; F.ws = ap->ws;
    unsigned char* ws = F.ws;
    F.SS = (float*)(ws + WS_SS); F.E = (float*)(ws + WS_E); F.B1 = (bf16_t*)(ws + WS_B1); F.B2 = (bf16_t*)(ws + WS_B2);
    unsigned char* z = ws + WS_Z;
    F.HID = (bf16_t*)(z + Z_HID); F.GL = (bf16_t*)(z + Z_GL); F.U5 = (h16*)(z + Z_U5); F.PP = (h16*)(z + Z_PP); F.L16 = (h16*)(z + Z_L16); F.G16 = (h16*)(z + Z_G16); F.R = (h16*)(z + Z_R);
    F.O = (float*)(z + Z_O); F.RW = z + Z_RW; F.PB = (float*)(z + Z_PB); F.LB = (float*)(z + Z_LB); F.SB = (float*)(z + Z_SB);
    if constexpr (PH == 0) { conv_first_half(F, 0); prep_x(F); }
    else { constexpr int l = (PH - 1) / 12, k = (PH - 1) % 12;
        if constexpr (k == 0) { pg8::Gemm g{F.B1, (const bf16_t*)(ws + WS_W + W_GU1), TT, 2 * FF, DM, 1}; SO S; S.init(TT, 2 * FF, G, bx); pg8::EpiGU E{F.HID, F.SS}; pg8::gemm_phase<pg8::EpiGU, SO, true, true>(F.lds, g, S, E, tid); }
        else if constexpr (k == 1) { pg8::Gemm g{F.HID, (const bf16_t*)(ws + WS_W + W_D1), TT, DM, FF, 1}; SO S; S.init(TT, DM, G, bx); pg8::EpiDown E{l == 0 ? F.in[0] : F.X, F.X, F.B1, F.SS, 0.5f}; pg8::gemm_phase<pg8::EpiDown, SO, true, true>(F.lds, g, S, E, tid); }
        else if constexpr (k == 2) { pg8::Gemm g{F.B1, (const bf16_t*)(ws + WS_W + W_INA), TT, 2560, DM, 1}; SO S; S.init(TT, 2560, G, bx); pg8::EpiInA E{F.U5, F.PP, F.L16, F.SS}; pg8::gemm_phase<pg8::EpiInA, SO, true, true>(F.lds, g, S, E, tid); }
        else if constexpr (k == 3) { m1_phase(F, l); }
        else if constexpr (k == 4) { m2_phase<PART>(F, l, xbar); }
        else if constexpr (k == 5) { { pg8::Gemm g{F.GL, (const bf16_t*)(ws + WS_W + W_GLU), TT, 256, 256, 1}; SO S; S.init(TT, 256, G, bx); pg8::EpiGlu E{F.GL, F.B2}; pg8::gemm_phase<pg8::EpiGlu, SO, true, true>(F.lds, g, S, E, tid); } rwkv_post(F, l); }
        else if constexpr (k == 6) { pg8::Gemm g{F.B1, (const bf16_t*)(ws + WS_W + W_ING), TT, 4096, DM, 1}; SO S; S.init(TT, 4096, G, bx); pg8::EpiGate E{F.R, F.SS}; pg8::gemm_phase<pg8::EpiGate, SO, true, true>(F.lds, g, S, E, tid); }
        else if constexpr (k == 7) { pg8::Gemm g{F.B2, (const bf16_t*)(ws + WS_W + W_BR), TT, DM, DM, 4}; pg8::SegOrder4 S; S.so.init(TT, DM, G, bx); pg8::EpiBranch E{F.R, F.B1}; pg8::gemm_phase<pg8::EpiBranch, pg8::SegOrder4, true, true>(F.lds, g, S, E, tid); }
        else if constexpr (k == 8) { pg8::Gemm g{F.B1, (const bf16_t*)(ws + WS_W + W_O), TT, DM, DM, 1}; SO S; S.init(TT, DM, G, bx); pg8::EpiDown E{F.X, F.X, F.B2, F.SS, 1.0f}; pg8::gemm_phase<pg8::EpiDown, SO, true, true>(F.lds, g, S, E, tid); }
        else if constexpr (k == 9) { pg8::Gemm g{F.B2, (const bf16_t*)(ws + WS_W + W_GU2), TT, 2 * FF, DM, 1}; SO S; S.init(TT, 2 * FF, G, bx); pg8::EpiGU E{F.HID, F.SS}; pg8::gemm_phase<pg8::EpiGU, SO, true, true>(F.lds, g, S, E, tid); }
        else if constexpr (k == 10) { pg8::Gemm g{F.HID, (const bf16_t*)(ws + WS_W + W_D2), TT, DM, FF, 1}; SO S; S.init(TT, DM, G, bx); pg8::EpiDown E{F.X, F.X, F.B1, F.SS, 0.5f}; pg8::gemm_phase<pg8::EpiDown, SO, true, true>(F.lds, g, S, E, tid); }
        else { if constexpr (l == 0) conv_first_half(F, 1); else final_norm(F); }
    }
}
#ifndef REPMASK
#define REPMASK 0
#endif
#define SEAM(k_) do { if ((k_) == 0) { __syncthreads(); cg::this_grid().sync(); } else xcd_barrier(xbar); } while (0)
#define PHASE(k) if (ph_lo <= (k) && (k) < ph_hi) { run_phase<(k)>(wave_s, lds_raw, xbar); \
    if ((k) >= 1 && ((REPMASK >> (((k) - 1) % 12)) & 1)) { SEAM(k); run_phase<(k), REP_PART>(wave_s, lds_raw, xbar); } \
    if ((k) + 1 < ph_hi) SEAM(k); }
__global__ void __launch_bounds__(NTHR, 2) mk_fwd(Args args) {
    extern __shared__ __attribute__((aligned(16))) unsigned char lds_raw[];
    const int ph_lo = args.ph_lo, ph_hi = args.ph_hi;
    volatile LAS unsigned* xst = (volatile LAS unsigned*)((LAS unsigned char*)lds_raw + (LDS_BYTES - 64));
    if (threadIdx.x == 0) { xst[0] = 0u; xst[1] = 0u; }
    __syncthreads();
    const XcdBarrier xbar = xcd_barrier_post((unsigned*)(args.ws + WS_CTL), xst);
    const int wave_s = __builtin_amdgcn_readfirstlane((int)threadIdx.x >> 6);
    PHASE(0) PHASE(1) PHASE(2) PHASE(3) PHASE(4) PHASE(5) PHASE(6) PHASE(7) PHASE(8) PHASE(9) PHASE(10) PHASE(11) PHASE(12)
    PHASE(13) PHASE(14) PHASE(15) PHASE(16) PHASE(17) PHASE(18) PHASE(19) PHASE(20) PHASE(21) PHASE(22) PHASE(23) PHASE(24)
}

extern "C" void kernel_launch(void* const* d_in, const int* in_sizes, int n_in, void* d_out, int out_size, void* d_ws, size_t ws_size, hipStream_t stream) {
    static int grid = 0;
    if (grid == 0) {
        if (n_in != 41 || out_size != TT * DM || ws_size < WS_END) { fprintf(stderr, "kernel_launch: unexpected shapes (n_in %d out %d ws %zu)\n", n_in, out_size, ws_size); grid = -1; return; }
        int dev = 0, cus = 0, per_cu = 0;
        (void)hipGetDevice(&dev); (void)hipDeviceGetAttribute(&cus, hipDeviceAttributeMultiprocessorCount, dev);
        if (hipFuncSetAttribute((const void*)mk_fwd, hipFuncAttributeMaxDynamicSharedMemorySize, LDS_BYTES) != hipSuccess) { fprintf(stderr, "kernel_launch: hipFuncSetAttribute failed\n"); grid = -1; return; }
        if (hipOccupancyMaxActiveBlocksPerMultiprocessor(&per_cu, (const void*)mk_fwd, NTHR, LDS_BYTES) != hipSuccess || per_cu < 1) { fprintf(stderr, "kernel_launch: occupancy query says %d\n", per_cu); per_cu = 1; }
        (void)hipGetLastError();
        grid = cus * (per_cu >= 1 ? 1 : 1);
        if (grid < 64) { fprintf(stderr, "kernel_launch: grid %d too small\n", grid); }
    }
    if (grid < 0) return;
    if (hipMemsetAsync((char*)d_ws + WS_CTL, 0, CTL_ZERO_BYTES, stream) != hipSuccess) { fprintf(stderr, "kernel_launch: hipMemsetAsync failed\n"); return; }
    Args a{};
    for (int i = 0; i < 41; ++i) a.in[i] = (const float*)d_in[i];
    a.out = (float*)d_out; a.ws = (unsigned char*)d_ws;
#if ONE_LAUNCH
    a.ph_lo = 0; a.ph_hi = NPH;
    void* kargs[] = {&a};
    hipError_t e = hipLaunchCooperativeKernel((const void*)mk_fwd, dim3(grid), dim3(NTHR), kargs, LDS_BYTES, stream);
    if (e != hipSuccess) fprintf(stderr, "cooperative launch failed: %s (grid %d)\n", hipGetErrorString(e), grid);
#else
    for (int ph = 0; ph < NPH; ++ph) { a.ph_lo = ph; a.ph_hi = ph + 1; hipLaunchKernelGGL(mk_fwd, dim3(grid), dim3(NTHR), LDS_BYTES, stream, a); }
#endif
}
```

```cpp
#include <hip/hip_runtime.h>
#include <hip/hip_cooperative_groups.h>
#include <cstdio>
#include <cstdint>
#include <cstddef>
namespace cg = cooperative_groups;
namespace pg8 {
#define PG8_LAS __attribute__((address_space(3)))
typedef unsigned short bf16_t;
typedef short bf16x8 __attribute__((ext_vector_type(8)));
typedef float f32x4 __attribute__((ext_vector_type(4)));
typedef unsigned u32x4 __attribute__((ext_vector_type(4)));
constexpr int BM = 256, BK = 64, HALF = 128, HTB = HALF * BK * 2  , STAGE_BYTES = 8 * HTB, NXCD = 8, WGM = 8;

__host__ __device__ __forceinline__ int lds_byte(int r, int c) { const int st = (r >> 4) * 2 + (c >> 5), rr = r & 15, cc = c & 31, ob = rr * 64 + cc * 2; return st * 1024 + (ob ^ (((ob >> 9) & 1) << 5)); }
__host__ __device__ __forceinline__ void stage_rc(int b, int& R, int& C) { const int st = b / 1024, sb = b % 1024, swz = sb ^ (((sb >> 9) & 1) << 5); R = (st >> 1) * 16 + swz / 64; C = (st & 1) * 32 + (swz % 64) / 2; }
__host__ __device__ __forceinline__ int perm32(int rho) { const int n = rho >> 4, i = rho & 15; return 8 * (i >> 2) + 4 * n + (i & 3); }

struct Unit { int pm, pn, g; };
struct Gemm { const bf16_t* A; const bf16_t* Bt; int M, N, K, nseg; };

struct StaticOrder {
    int nM, nN, nwg, G, c;
    __host__ __device__ void init(int M, int N, int G_, int c_) { nM = M / BM; nN = N / BM; nwg = nM * nN; G = G_; c = c_; }
    __host__ __device__ bool next(int i, Unit& u) const {
        const long L = (long)i * G + c; if (L >= nwg) return false;
        int wgid = (int)L; { const int q = nwg / NXCD, r = nwg % NXCD, xcd = wgid % NXCD, off = wgid / NXCD; wgid = (xcd < r ? xcd * (q + 1) : r * (q + 1) + (xcd - r) * q) + off; }
        const int nig = WGM * nN, gid = wgid / nig, fm = gid * WGM, gsz = (nM - fm) < WGM ? (nM - fm) : WGM;
        u.pm = fm + ((wgid % nig) % gsz); u.pn = (wgid % nig) / gsz; u.g = 0; return true;
    }
    __device__ __forceinline__ void a_ready(const Unit&) const {}
    __device__ __forceinline__ void done(const Unit&) const {}
};


struct SegOrder4 {
    StaticOrder so;
    __host__ __device__ bool next(int i, Unit& u) const { if (!so.next(i >> 2, u)) return false; u.g = i & 3; return true; }
    __device__ __forceinline__ void a_ready(const Unit&) const {}
    __device__ __forceinline__ void done(const Unit&) const {}
};

typedef _Float16 h16;
typedef _Float16 h16x4 __attribute__((ext_vector_type(4)));
typedef unsigned u32x2 __attribute__((ext_vector_type(2)));
__device__ __forceinline__ unsigned cvt_pk_bf16(float lo, float hi) { unsigned r; asm volatile("v_cvt_pk_bf16_f32 %0, %1, %2" : "=v"(r) : "v"(lo), "v"(hi)); return r; }
__device__ __forceinline__ u32x2 pack_bf16x4(f32x4 v) { u32x2 w; w.x = cvt_pk_bf16(v[0], v[1]); w.y = cvt_pk_bf16(v[2], v[3]); return w; }
__device__ __forceinline__ h16x4 pack_h16x4(f32x4 v) { h16x4 w; w[0] = (h16)v[0]; w[1] = (h16)v[1]; w[2] = (h16)v[2]; w[3] = (h16)v[3]; return w; }
__device__ __forceinline__ float fast_sigmoid(float x) { return __builtin_amdgcn_rcpf(1.0f + __expf(-x)); }
__device__ __forceinline__ float row_rstd(const float* SS, int row) {
    const f32x4* p = (const f32x4*)(SS + (size_t)row * 16);
    const f32x4 a = p[0], b = p[1], c = p[2], d = p[3];
    const float s = ((a[0] + a[1]) + (a[2] + a[3])) + ((b[0] + b[1]) + (b[2] + b[3])) + ((c[0] + c[1]) + (c[2] + c[3])) + ((d[0] + d[1]) + (d[2] + d[3]));
    return rsqrtf(s * (1.0f / 1024.0f) + 1e-6f);
}

__device__ __forceinline__ void rows_rstd(const float* SS, int row0, int fq, float (&rs)[8]) {
    f32x4 q[8];
#pragma unroll
    for (int sl = 0; sl < 8; ++sl) q[sl] = *(const f32x4*)(SS + (size_t)(row0 + (sl >> 2) * HALF + (sl & 3) * 16) * 16 + 4 * fq);
#pragma unroll
    for (int sl = 0; sl < 8; ++sl) { float s = (q[sl][0] + q[sl][1]) + (q[sl][2] + q[sl][3]); s += __shfl_xor(s, 16); s += __shfl_xor(s, 32); rs[sl] = rsqrtf(s * (1.0f / 1024.0f) + 1e-6f); }
}

struct EpiGU {
    static constexpr bool PERM = true, KSEG = false;
    bf16_t* hid; const float* SS;
    __device__ __forceinline__ void operator()(const f32x4 (&acc)[2][2][4][2], const Unit& u, int wr, int wc, int fr, int fq) const {
        int row0 = u.pm * BM + wr * 64 + fr; asm volatile("" : "+v"(row0)); const int j0 = u.pn * 128 + wc * 16 + fq * 4;
        float rsv[8]; rows_rstd(SS, row0, fq, rsv);
#pragma unroll
        for (int ai = 0; ai < 2; ++ai)
#pragma unroll
            for (int m = 0; m < 4; ++m) { const int row = row0 + ai * HALF + m * 16; const float rs = rsv[ai * 4 + m];
#pragma unroll
                for (int bj = 0; bj < 2; ++bj) { const f32x4 g = acc[ai][bj][m][0] * rs, up = acc[ai][bj][m][1] * rs; f32x4 h;
#pragma unroll
                    for (int i = 0; i < 4; ++i) h[i] = g[i] * fast_sigmoid(g[i]) * up[i];
                    *(u32x2*)(hid + (size_t)row * 2816 + j0 + bj * 64) = pack_bf16x4(h); } }
    }
};
struct EpiDown {
    static constexpr bool PERM = false, KSEG = false;
    const float* res; float* X; bf16_t* xb; float* SS; float alpha;
    __device__ __forceinline__ void operator()(const f32x4 (&acc)[2][2][4][2], const Unit& u, int wr, int wc, int fr, int fq) const {
        int row0 = u.pm * BM + wr * 64 + fr; asm volatile("" : "+v"(row0)); const int c0 = u.pn * BM + wc * 32 + fq * 4;
#pragma unroll
        for (int ai = 0; ai < 2; ++ai) {
            f32x4 rv[4][2][2];
#pragma unroll
            for (int m = 0; m < 4; ++m)
#pragma unroll
                for (int bj = 0; bj < 2; ++bj)
#pragma unroll
                    for (int n = 0; n < 2; ++n) rv[m][bj][n] = *(const f32x4*)(res + (size_t)(row0 + ai * HALF + m * 16) * 1024 + c0 + bj * HALF + n * 16);
#pragma unroll
            for (int m = 0; m < 4; ++m) { const int row = row0 + ai * HALF + m * 16; float ss = 0.f;
#pragma unroll
                for (int bj = 0; bj < 2; ++bj)
#pragma unroll
                    for (int n = 0; n < 2; ++n) { const size_t off = (size_t)row * 1024 + c0 + bj * HALF + n * 16;
                        const f32x4 o = rv[m][bj][n] + acc[ai][bj][m][n] * alpha;
                        *(f32x4*)(X + off) = o; *(u32x2*)(xb + off) = pack_bf16x4(o);
                        ss += (o[0] * o[0] + o[1] * o[1]) + (o[2] * o[2] + o[3] * o[3]); }
                ss += __shfl_xor(ss, 16); ss += __shfl_xor(ss, 32);
                if (fq == 0) SS[(size_t)row * 16 + u.pn * 4 + wc] = ss; }
            asm volatile("" ::: "memory"); }
    }
};
struct EpiInA {
    static constexpr bool PERM = false, KSEG = false;
    h16* U5; h16* PP; h16* L16; const float* SS;
    __device__ __forceinline__ void operator()(const f32x4 (&acc)[2][2][4][2], const Unit& u, int wr, int wc, int fr, int fq) const {
        int row0 = u.pm * BM + wr * 64 + fr; asm volatile("" : "+v"(row0)); const int cl = wc * 32 + fq * 4;
        float rsv[8]; rows_rstd(SS, row0, fq, rsv);
        h16* base; int ld, cb;
        if (u.pn == 0) { base = U5; ld = 256; cb = 0; } else if (u.pn < 8) { base = PP; ld = 1792; cb = (u.pn - 1) * 256; } else { base = L16; ld = 512; cb = (u.pn - 8) * 256; }
#pragma unroll
        for (int ai = 0; ai < 2; ++ai)
#pragma unroll
            for (int m = 0; m < 4; ++m) { const int row = row0 + ai * HALF + m * 16; const float rs = rsv[ai * 4 + m];
#pragma unroll
                for (int bj = 0; bj < 2; ++bj)
#pragma unroll
                    for (int n = 0; n < 2; ++n) *(h16x4*)(base + (size_t)row * ld + cb + cl + bj * HALF + n * 16) = pack_h16x4(acc[ai][bj][m][n] * rs); }
    }
};
struct EpiGate {
    static constexpr bool PERM = false, KSEG = false;
    h16* R; const float* SS;
    __device__ __forceinline__ void operator()(const f32x4 (&acc)[2][2][4][2], const Unit& u, int wr, int wc, int fr, int fq) const {
        float rsv[8]; int row0 = u.pm * BM + wr * 64 + fr; asm volatile("" : "+v"(row0)); rows_rstd(SS, row0, fq, rsv); const int d0 = 256 * (u.pn >> 2) + 128 * ((u.pn >> 1) & 1) + 16 * (u.pn & 1) + 32 * wc + 4 * fq;
#pragma unroll
        for (int ai = 0; ai < 2; ++ai)
#pragma unroll
            for (int m = 0; m < 4; ++m) { const int row = row0 + ai * HALF + m * 16; const float rs = rsv[ai * 4 + m];
                f32x4 e[4];
#pragma unroll
                for (int g = 0; g < 4; ++g)
#pragma unroll
                    for (int i = 0; i < 4; ++i) e[g][i] = 1.0f + __expf(-fminf(fmaxf(acc[ai][g >> 1][m][g & 1][i] * rs, -10.f), 30.f));
                f32x4 r[4];
#pragma unroll
                for (int i = 0; i < 4; ++i) { const float i0 = __builtin_amdgcn_rcpf(e[0][i]), i1 = __builtin_amdgcn_rcpf(e[1][i]), i2 = __builtin_amdgcn_rcpf(e[2][i]), i3 = __builtin_amdgcn_rcpf(e[3][i]);
                    r[0][i] = e[1][i] * i0; r[1][i] = e[2][i] * i1; r[2][i] = e[3][i] * i2; r[3][i] = i3; }
#pragma unroll
                for (int g = 0; g < 4; ++g) *(h16x4*)(R + ((size_t)row * 4 + g) * 1024 + d0) = pack_h16x4(r[g]); }
    }
};
struct EpiBranch {
    static constexpr bool PERM = false, KSEG = true;
    const h16* R; bf16_t* out;
    __device__ __forceinline__ void operator()(f32x4 (&acc)[2][2][4][2], const Unit& u, int wr, int wc, int fr, int fq) const {
        unsigned q0 = (unsigned)(u.pm * BM + wr * 64 + fr) * 1024u + (unsigned)(u.pn * BM + wc * 32 + fq * 4); asm volatile("" : "+v"(q0));
        const unsigned r0 = (q0 - (q0 & 1023u)) * 4u + (unsigned)u.g * 1024u + (q0 & 1023u);
        const bool last = u.g == 3;
        h16x4 rr[2][4][2][2];
#pragma unroll
        for (int ai = 0; ai < 2; ++ai)
#pragma unroll
            for (int m = 0; m < 4; ++m)
#pragma unroll
                for (int bj = 0; bj < 2; ++bj)
#pragma unroll
                    for (int n = 0; n < 2; ++n) rr[ai][m][bj][n] = *(const h16x4*)(R + (r0 + (unsigned)((ai * HALF + m * 16) * 4096 + bj * HALF + n * 16)));
#pragma unroll
        for (int ai = 0; ai < 2; ++ai)
#pragma unroll
            for (int m = 0; m < 4; ++m) {
#pragma unroll
                for (int bj = 0; bj < 2; ++bj)
#pragma unroll
                    for (int n = 0; n < 2; ++n) { const unsigned off = q0 + (unsigned)((ai * HALF + m * 16) * 1024 + bj * HALF + n * 16);
                        const h16x4 r = rr[ai][m][bj][n];
                        f32x4 rf; rf[0] = (float)r[0]; rf[1] = (float)r[1]; rf[2] = (float)r[2]; rf[3] = (float)r[3];
                        acc[ai][bj][m][n] = acc[ai][bj][m][n] * rf;
                        if (last) *(u32x2*)(out + off) = pack_bf16x4(acc[ai][bj][m][n]); } }
    }
};
struct EpiGlu {
    static constexpr bool PERM = false, KSEG = false;
    const bf16_t* gl; bf16_t* ys;
    __device__ __forceinline__ void operator()(const f32x4 (&acc)[2][2][4][2], const Unit& u, int wr, int wc, int fr, int fq) const {
        int row0 = u.pm * BM + wr * 64 + fr; asm volatile("" : "+v"(row0)); const int c0 = wc * 32 + fq * 4;
        u32x2 gv[2][4][2][2];
#pragma unroll
        for (int ai = 0; ai < 2; ++ai)
#pragma unroll
            for (int m = 0; m < 4; ++m)
#pragma unroll
                for (int bj = 0; bj < 2; ++bj)
#pragma unroll
                    for (int n = 0; n < 2; ++n) gv[ai][m][bj][n] = *(const u32x2*)(gl + (size_t)(row0 + ai * HALF + m * 16) * 256 + c0 + bj * HALF + n * 16);
#pragma unroll
        for (int ai = 0; ai < 2; ++ai)
#pragma unroll
            for (int m = 0; m < 4; ++m) { const int row = row0 + ai * HALF + m * 16;
#pragma unroll
                for (int bj = 0; bj < 2; ++bj)
#pragma unroll
                    for (int n = 0; n < 2; ++n) { const int c = c0 + bj * HALF + n * 16; const u32x2 g2 = gv[ai][m][bj][n];
                        f32x4 g; g[0] = __uint_as_float(g2.x << 16); g[1] = __uint_as_float(g2.x & 0xffff0000u); g[2] = __uint_as_float(g2.y << 16); g[3] = __uint_as_float(g2.y & 0xffff0000u);
                        f32x4 o;
#pragma unroll
                        for (int i = 0; i < 4; ++i) o[i] = g[i] * fast_sigmoid(acc[ai][bj][m][n][i]);
                        *(u32x2*)(ys + (size_t)row * 1024 + c) = pack_bf16x4(o); } }
    }
};

template <class Epi, class Sched, bool ALIGN_EPI = false, bool SP2 = false>
__device__ __forceinline__ void gemm_phase(PG8_LAS unsigned char* lds, const Gemm g, const Sched& S, const Epi& E, const int tid) {
    const int wid = __builtin_amdgcn_readfirstlane(tid >> 6), lane = tid & 63, wr = wid >> 2, wc = wid & 3, fr = lane & 15, fq = lane >> 4;
    const int K = g.K, nt = K / BK / g.nseg; const size_t segb = (size_t)(K / g.nseg) * 2;
    unsigned voffA[2], voffB[2];
#pragma unroll
    for (int i = 0; i < 2; ++i) { int R, C; stage_rc(tid * 16 + i * 8192, R, C); const int Rb = Epi::PERM ? ((R & ~31) + perm32(R & 31)) : R;
        voffA[i] = (unsigned)(R * K + C) * 2u; voffB[i] = (unsigned)(Rb * K + C) * 2u; }
    const size_t kstep = (size_t)(BK * 2);
    const size_t hstep = (size_t)HALF * K * 2;
    const size_t tstep = 2 * hstep;
    const unsigned ldsw = (unsigned)wid * 1024u;
    const int aoff = lds_byte(wr * 64 + fr, fq * 8), boff = lds_byte(wc * 32 + fr, fq * 8);
#define PG8_SA(b, h) (((b) * 2 + (h)) * HTB)
#define PG8_SB(b, h) ((4 + (b) * 2 + (h)) * HTB)
#define PG8_STAGE(bufoff, gbase, voff) do { _Pragma("unroll") for (int _i = 0; _i < 2; ++_i) \
        __builtin_amdgcn_global_load_lds((const unsigned*)((const char*)(gbase) + (voff)[_i]), (PG8_LAS unsigned*)(lds + (bufoff) + ldsw + _i * 8192), 16, 0, 0); } while (0)
#define PG8_LDA(dst, b, h) do { _Pragma("unroll") for (int m = 0; m < 4; ++m) _Pragma("unroll") for (int k = 0; k < 2; ++k) dst[m][k] = *(const PG8_LAS bf16x8*)(lds + PG8_SA(b, h) + aoff + m * 2048 + k * 1024); } while (0)
#define PG8_LDB(dst, b, h) do { _Pragma("unroll") for (int n = 0; n < 2; ++n) _Pragma("unroll") for (int k = 0; k < 2; ++k) dst[n][k] = *(const PG8_LAS bf16x8*)(lds + PG8_SB(b, h) + boff + n * 2048 + k * 1024); } while (0)
#define PG8_MMA(ai, bj, At, Bt) do { __builtin_amdgcn_s_setprio(1); _Pragma("unroll") for (int m = 0; m < 4; ++m) _Pragma("unroll") for (int n = 0; n < 2; ++n) _Pragma("unroll") for (int k = 0; k < 2; ++k) \
        acc[ai][bj][m][n] = __builtin_amdgcn_mfma_f32_16x16x32_bf16(Bt[n][k], At[m][k], acc[ai][bj][m][n], 0, 0, 0); __builtin_amdgcn_s_setprio(0); } while (0)
#define PG8_WAIT_V(n) asm volatile("s_waitcnt vmcnt(" #n ")" ::: "memory")
#define PG8_WAIT_L(n) asm volatile("s_waitcnt lgkmcnt(" #n ")" ::: "memory")
#define PG8_BAR __builtin_amdgcn_s_barrier()
#define PG8_SCHED __builtin_amdgcn_sched_barrier(0)
    Unit cur, nxt; int ui = 0;
    if (!S.next(0, cur)) return;
    f32x4 acc[2][2][4][2];
#pragma unroll
    for (int a = 0; a < 2; ++a)
#pragma unroll
        for (int b = 0; b < 2; ++b)
#pragma unroll
            for (int m = 0; m < 4; ++m)
#pragma unroll
                for (int n = 0; n < 2; ++n) acc[a][b][m][n] = (f32x4){0.f, 0.f, 0.f, 0.f};
    bf16x8 At[4][2], B0[2][2], B1[2][2];
    const char* cA = (const char*)g.A + (size_t)cur.pm * tstep + (size_t)cur.g * segb; const char* cB = (const char*)g.Bt + (size_t)cur.pn * tstep + (size_t)cur.g * segb;
    S.a_ready(cur);
    if constexpr (SP2) {
        PG8_STAGE(PG8_SB(0, 0), cB, voffB); PG8_STAGE(PG8_SB(0, 1), cB + hstep, voffB); PG8_STAGE(PG8_SA(0, 0), cA, voffA); PG8_STAGE(PG8_SA(0, 1), cA + hstep, voffA);
        if (wr == 1) PG8_BAR;
        PG8_WAIT_V(2); PG8_BAR;
        PG8_STAGE(PG8_SB(1, 0), cB + kstep, voffB); PG8_STAGE(PG8_SA(1, 0), cA + kstep, voffA); PG8_STAGE(PG8_SB(1, 1), cB + hstep + kstep, voffB);
        PG8_WAIT_V(6); PG8_BAR;
    } else {
        PG8_STAGE(PG8_SB(0, 0), cB, voffB); PG8_STAGE(PG8_SA(0, 0), cA, voffA); PG8_STAGE(PG8_SB(0, 1), cB + hstep, voffB); PG8_STAGE(PG8_SA(0, 1), cA + hstep, voffA);
        if (wr == 1) PG8_BAR;
        PG8_WAIT_V(4); PG8_BAR;
        PG8_STAGE(PG8_SB(1, 0), cB + kstep, voffB); PG8_STAGE(PG8_SA(1, 0), cA + kstep, voffA); PG8_STAGE(PG8_SB(1, 1), cB + hstep + kstep, voffB);
        PG8_WAIT_V(6); PG8_BAR;
    }
    for (;;) {
        const bool has_next = S.next(ui + 1, nxt);
        const char* nA = has_next ? (const char*)g.A + (size_t)nxt.pm * tstep + (size_t)nxt.g * segb : cA; const char* nB = has_next ? (const char*)g.Bt + (size_t)nxt.pn * tstep + (size_t)nxt.g * segb : cB;
        for (int t = 0; t < nt; t += 2) {
            const bool last = (t == nt - 2);
            const char* a1 = cA + (size_t)(t + 1) * kstep;
            const char* a2 = last ? nA : cA + (size_t)(t + 2) * kstep; const char* b2 = last ? nB : cB + (size_t)(t + 2) * kstep;
            const char* a3 = a2 + kstep; const char* b3 = b2 + kstep;
            if (last && has_next) S.a_ready(nxt);
            if constexpr (SP2) {
            PG8_LDB(B0, 0, 0); PG8_LDB(B1, 0, 1); PG8_SCHED; PG8_LDA(At, 0, 0); PG8_STAGE(PG8_SA(1, 1), a1 + hstep, voffA);
            PG8_WAIT_V(8); PG8_WAIT_L(0); PG8_BAR; PG8_MMA(0, 0, At, B0); PG8_MMA(0, 1, At, B1); PG8_BAR; PG8_SCHED;
            PG8_LDA(At, 0, 1); PG8_STAGE(PG8_SB(0, 0), b2, voffB); PG8_STAGE(PG8_SB(0, 1), b2 + hstep, voffB); PG8_STAGE(PG8_SA(0, 0), a2, voffA);
            PG8_WAIT_V(8); PG8_WAIT_L(0); PG8_BAR; PG8_MMA(1, 0, At, B0); PG8_MMA(1, 1, At, B1); PG8_BAR; PG8_SCHED;
            PG8_LDB(B0, 1, 0); PG8_LDB(B1, 1, 1); PG8_SCHED; PG8_LDA(At, 1, 0); PG8_STAGE(PG8_SA(0, 1), a2 + hstep, voffA);
            PG8_WAIT_V(8); PG8_WAIT_L(0); PG8_BAR; PG8_MMA(0, 0, At, B0); PG8_MMA(0, 1, At, B1); PG8_BAR; PG8_SCHED;
            PG8_LDA(At, 1, 1); PG8_STAGE(PG8_SB(1, 0), b3, voffB); PG8_STAGE(PG8_SB(1, 1), b3 + hstep, voffB); PG8_STAGE(PG8_SA(1, 0), a3, voffA);
            PG8_WAIT_V(8); PG8_WAIT_L(0); PG8_BAR; PG8_MMA(1, 0, At, B0); PG8_MMA(1, 1, At, B1); PG8_BAR; PG8_SCHED;
            } else {
            PG8_LDB(B0, 0, 0); PG8_SCHED; PG8_LDA(At, 0, 0); PG8_STAGE(PG8_SA(1, 1), a1 + hstep, voffA);
            PG8_WAIT_L(8); PG8_BAR; PG8_WAIT_L(0); PG8_MMA(0, 0, At, B0); PG8_BAR; PG8_SCHED;
            PG8_LDB(B1, 0, 1); PG8_STAGE(PG8_SB(0, 0), b2, voffB);
            PG8_BAR; PG8_WAIT_L(0); PG8_MMA(0, 1, At, B1); PG8_BAR;
            PG8_LDA(At, 0, 1); PG8_STAGE(PG8_SA(0, 0), a2, voffA);
            PG8_BAR; PG8_WAIT_L(0); PG8_MMA(1, 0, At, B0); PG8_BAR; PG8_SCHED;
            PG8_STAGE(PG8_SB(0, 1), b2 + hstep, voffB);
            PG8_WAIT_V(6); PG8_BAR; PG8_MMA(1, 1, At, B1); PG8_BAR;
            PG8_LDB(B0, 1, 0); PG8_SCHED; PG8_LDA(At, 1, 0); PG8_STAGE(PG8_SA(0, 1), a2 + hstep, voffA);
            PG8_WAIT_L(8); PG8_BAR; PG8_WAIT_L(0); PG8_MMA(0, 0, At, B0); PG8_BAR; PG8_SCHED;
            PG8_LDB(B1, 1, 1); PG8_STAGE(PG8_SB(1, 0), b3, voffB);
            PG8_BAR; PG8_WAIT_L(0); PG8_MMA(0, 1, At, B1); PG8_BAR;
            PG8_LDA(At, 1, 1); PG8_STAGE(PG8_SA(1, 0), a3, voffA);
            PG8_BAR; PG8_WAIT_L(0); PG8_MMA(1, 0, At, B0); PG8_BAR; PG8_SCHED;
            PG8_STAGE(PG8_SB(1, 1), b3 + hstep, voffB);
            PG8_WAIT_V(6); PG8_BAR; PG8_MMA(1, 1, At, B1); PG8_BAR;
            }
        }
        if constexpr (ALIGN_EPI) { if (wr == 0) PG8_BAR; }
        E(acc, cur, wr, wc, fr, fq); S.done(cur);
        if (!has_next) break;
        if (!(Epi::KSEG && nxt.g != 0))
#pragma unroll
        for (int a = 0; a < 2; ++a)
#pragma unroll
            for (int b = 0; b < 2; ++b)
#pragma unroll
                for (int m = 0; m < 4; ++m)
#pragma unroll
                    for (int n = 0; n < 2; ++n) acc[a][b][m][n] = (f32x4){0.f, 0.f, 0.f, 0.f};
        cur = nxt; cA = nA; cB = nB; ++ui;
        if constexpr (ALIGN_EPI) { if (wr == 1) PG8_BAR; }
    }
    PG8_WAIT_V(0);
    if constexpr (!ALIGN_EPI) { if (wr == 0) PG8_BAR; }
    PG8_BAR;
#undef PG8_SA
#undef PG8_SB
#undef PG8_STAGE
#undef PG8_LDA
#undef PG8_LDB
#undef PG8_MMA
#undef PG8_WAIT_V
#undef PG8_WAIT_L
#undef PG8_BAR
#undef PG8_SCHED
}
}

#define LAS __attribute__((address_space(3)))
typedef unsigned short bf16_t;
typedef _Float16 h16;
typedef _Float16 h16x4 __attribute__((ext_vector_type(4)));
typedef _Float16 h16x8 __attribute__((ext_vector_type(8)));
typedef float f32x4 __attribute__((ext_vector_type(4)));
typedef float f32x2 __attribute__((ext_vector_type(2)));
typedef unsigned u32x4 __attribute__((ext_vector_type(4)));
typedef unsigned u32x2 __attribute__((ext_vector_type(2)));

#ifndef ONE_LAUNCH
#define ONE_LAUNCH 1
#endif
constexpr int NWAVES = 8, NTHR = 512;
constexpr int TT = 16384, SEQ = 8192, DM = 1024, FF = 2816, MW = 256, INW = 6144;
constexpr int LDS_BYTES = 147456;
constexpr size_t MiB = 1u << 20;
constexpr size_t WS_CTL = 0, CTL_ZERO_BYTES = 16384, WS_SS = 1 * MiB, WS_E = 2 * MiB, WS_W = 4 * MiB, WS_B1 = 34 * MiB, WS_B2 = 66 * MiB, WS_Z = 98 * MiB, WS_END = 262 * MiB;
constexpr size_t W_GU1 = 0, W_D1 = W_GU1 + (size_t)2 * FF * DM * 2, W_INA = W_D1 + (size_t)DM * FF * 2;
constexpr size_t W_ING = 0, W_BR = W_ING + (size_t)4096 * DM * 2, W_O = W_BR + (size_t)DM * DM * 2, W_GU2 = W_O + (size_t)DM * DM * 2, W_D2 = W_GU2 + (size_t)2 * FF * DM * 2, W_GLU = W_D2 + (size_t)DM * FF * 2, W_END2 = W_GLU + 256 * 256 * 2;
constexpr size_t W_L2 = 23 * MiB;
static_assert(W_END2 <= 30 * MiB && W_INA + (size_t)2560 * DM * 2 <= 30 * MiB, "W region");
constexpr size_t Z_RW = 0, Z_G16 = 56 * MiB, Z_U5 = 64 * MiB, Z_L16 = 72 * MiB, Z_PP = 88 * MiB, Z_O = 72 * MiB, Z_GL = 144 * MiB, Z_PB = 152 * MiB, Z_LB = 156 * MiB, Z_SB = 160 * MiB;
constexpr size_t Z_HID = 0, Z_R = 0;
static_assert((size_t)TT * 4 * 896 <= 56 * MiB && (size_t)TT * 1792 * 2 <= 56 * MiB && (size_t)TT * FF * 2 <= 144 * MiB && (size_t)TT * 4096 * 2 <= 144 * MiB, "Z region");

typedef const float* cfp_t;
typedef const __attribute__((address_space(4))) cfp_t* in_t;
struct Args { const float* in[41]; float* out; unsigned char* ws; int ph_lo, ph_hi; };

struct Frame {
    LAS unsigned char* lds;
    int tid, lane, wave, G, bx;
    in_t in;
    float* X; unsigned char* ws;
    float* SS; float* E;
    bf16_t *B1, *B2, *HID, *GL;
    h16 *U5, *PP, *L16, *G16, *R;
    float* O; unsigned char* RW;
    float *PB, *LB, *SB;
};

__device__ __forceinline__ unsigned f2bf(float f) { unsigned u = __builtin_bit_cast(unsigned, f); return (u + 0x7fffu + ((u >> 16) & 1u)) >> 16; }
__device__ __forceinline__ unsigned pk2(float lo, float hi) { return f2bf(lo) | (f2bf(hi) << 16); }
#define LDS_WAIT() asm volatile("s_waitcnt lgkmcnt(0)" ::: "memory")
template <int CTRL> __device__ __forceinline__ float dppx(float x) { return __builtin_bit_cast(float, __builtin_amdgcn_update_dpp(0, __builtin_bit_cast(int, x), CTRL, 0xf, 0xf, true)); }
__device__ __forceinline__ float allreduce16(float x) { x += dppx<0xB1>(x); x += dppx<0x4E>(x); x += dppx<0x141>(x); x += dppx<0x140>(x); return x; }
__device__ __forceinline__ float wave_sum(float x) { x = allreduce16(x); x += __shfl_xor(x, 16); x += __shfl_xor(x, 32); return x; }
__device__ __forceinline__ float sigmoidf_(float x) { return __builtin_amdgcn_rcpf(1.0f + __expf(-x)); }

__device__ __forceinline__ int tr_rowmap(int mode, int j, int row0) {
    if (mode == 0) return row0 + j;
    if (mode == 1) return 8 * (j >> 2) + (j & 3);
    if (mode == 2) return 8 * (j >> 2) + 4 + (j & 3);
    const int g = j >> 10, d = j & 1023;
    const int pn = 4 * (d >> 8) + 2 * ((d >> 7) & 1) + ((d >> 4) & 1);
    return 256 * pn + 128 * (g >> 1) + 32 * ((d >> 5) & 3) + 16 * (g & 1) + 4 * ((d >> 2) & 3) + (d & 3);
}
__device__ __forceinline__ void tr_item(const float* W, int ldw, int K, int N, bf16_t* WT, int mode, int row0, const float* s1, const float* s2, int smode, LAS float* scr, int item, int lane) {
    const int nblk = N / 32, kb = item / nblk, nb = item % nblk, k0 = 64 * kb, n0 = 32 * nb;
#pragma unroll
    for (int i = 0; i < 32; ++i) { const int kk = 2 * i + (lane >> 5); const int k = k0 + kk; float sc = 1.0f;
        if (s1) sc = s1[k];
        if (smode == 1) sc *= s2[k]; else if (smode == 2) sc *= (1.0f - s2[k]);
        scr[kk * 33 + (lane & 31)] = W[(size_t)k * ldw + n0 + (lane & 31)] * sc; }
    LDS_WAIT(); asm volatile("" ::: "memory");
    const int c = lane & 7;
#pragma unroll
    for (int j = 0; j < 4; ++j) { const int n = (lane >> 3) + 8 * j; const LAS float* s = scr + (8 * c) * 33 + n;
        u32x4 o; o.x = pk2(s[0 * 33], s[1 * 33]); o.y = pk2(s[2 * 33], s[3 * 33]); o.z = pk2(s[4 * 33], s[5 * 33]); o.w = pk2(s[6 * 33], s[7 * 33]);
        *(u32x4*)(WT + (size_t)tr_rowmap(mode, n0 + n, row0) * K + k0 + 8 * c) = o; }
    LDS_WAIT(); asm volatile("" ::: "memory");
}
#define TRJ(W_, ldw_, K_, N_, dst_, mode_, row0_, s1_, s2_, smode_) { const int ni_ = ((K_) / 64) * ((N_) / 32); if (r >= 0 && r < ni_) tr_item(W_, ldw_, K_, N_, dst_, mode_, row0_, s1_, s2_, smode_, scr, r, F.lane); r -= ni_; }
__device__ __forceinline__ void conv_first_half(Frame& F, int l) {
    LAS float* scr = (LAS float*)(F.lds + F.wave * 16384);
    const int gw = F.bx * NWAVES + F.wave, NGW = F.G * NWAVES;
    unsigned char* wb = F.ws + WS_W;
    const float* n1 = F.in[1] + (size_t)l * DM; const float* nm = F.in[5] + (size_t)l * DM; const float* mu = F.in[19] + (size_t)l * 3 * DM;
    const float* w1 = F.in[21] + (size_t)l * DM * 64; const float* a1 = F.in[24] + (size_t)l * DM * 64; const float* g1 = F.in[26] + (size_t)l * DM * 128;
    bf16_t* ina = (bf16_t*)(wb + W_INA);
    for (int it = gw;; it += NGW) { int r = it;
        TRJ(F.in[2] + (size_t)l * DM * FF, FF, DM, FF, (bf16_t*)(wb + W_GU1), 1, 0, n1, nullptr, 0)
        TRJ(F.in[3] + (size_t)l * DM * FF, FF, DM, FF, (bf16_t*)(wb + W_GU1), 2, 0, n1, nullptr, 0)
        TRJ(F.in[4] + (size_t)l * FF * DM, DM, FF, DM, (bf16_t*)(wb + W_D1), 0, 0, nullptr, nullptr, 0)
        TRJ(F.in[6] + (size_t)l * DM * INW, INW, DM, 2048, ina, 0, 0, nm, nullptr, 0)
        TRJ(w1, 64, DM, 64, ina, 0, 2048, nm, mu, 2)
        TRJ(a1, 64, DM, 64, ina, 0, 2112, nm, mu + DM, 2)
        TRJ(g1, 128, DM, 128, ina, 0, 2176, nm, mu + 2 * DM, 2)
        TRJ(w1, 64, DM, 64, ina, 0, 2304, nm, mu, 1)
        TRJ(a1, 64, DM, 64, ina, 0, 2368, nm, mu + DM, 1)
        TRJ(g1, 128, DM, 128, ina, 0, 2432, nm, mu + 2 * DM, 1)
        TRJ(F.in[22] + (size_t)l * 64 * 256, 256, 64, 256, (bf16_t*)(wb + W_L2), 0, 0, nullptr, nullptr, 0)
        TRJ(F.in[25] + (size_t)l * 64 * 256, 256, 64, 256, (bf16_t*)(wb + W_L2) + 256 * 64, 0, 0, nullptr, nullptr, 0)
        TRJ(F.in[27] + (size_t)l * 128 * 256, 256, 128, 256, (bf16_t*)(wb + W_L2) + 2 * 256 * 64, 0, 0, nullptr, nullptr, 0)
        TRJ(F.in[16] + ((size_t)l * 4 + 0) * 4096, 64, 64, 64, (bf16_t*)(wb + W_L2) + 4 * 256 * 64, 0, 0, nullptr, nullptr, 0)
        TRJ(F.in[16] + ((size_t)l * 4 + 1) * 4096, 64, 64, 64, (bf16_t*)(wb + W_L2) + 4 * 256 * 64, 0, 64, nullptr, nullptr, 0)
        TRJ(F.in[16] + ((size_t)l * 4 + 2) * 4096, 64, 64, 64, (bf16_t*)(wb + W_L2) + 4 * 256 * 64, 0, 128, nullptr, nullptr, 0)
        TRJ(F.in[16] + ((size_t)l * 4 + 3) * 4096, 64, 64, 64, (bf16_t*)(wb + W_L2) + 4 * 256 * 64, 0, 192, nullptr, nullptr, 0)
        if (r >= 0) break; }
}
__device__ __forceinline__ void conv_second_half(Frame& F, int l, int b0) {
    LAS float* scr = (LAS float*)(F.lds + F.wave * 16384);
    const int gw = (F.bx - b0) * NWAVES + F.wave, NGW = (F.G - b0) * NWAVES;
    unsigned char* wb = F.ws + WS_W;
    const float* nm = F.in[5] + (size_t)l * DM; const float* n2 = F.in[36] + (size_t)l * DM;
    for (int it = gw;; it += NGW) { int r = it;
        TRJ(F.in[6] + (size_t)l * DM * INW + 2048, INW, DM, 4096, (bf16_t*)(wb + W_ING), 3, 0, nm, nullptr, 0)
        TRJ(F.in[34] + (size_t)l * DM * DM, DM, DM, DM, (bf16_t*)(wb + W_BR), 0, 0, nullptr, nullptr, 0)
        TRJ(F.in[35] + (size_t)l * DM * DM, DM, DM, DM, (bf16_t*)(wb + W_O), 0, 0, nullptr, nullptr, 0)
        TRJ(F.in[37] + (size_t)l * DM * FF, FF, DM, FF, (bf16_t*)(wb + W_GU2), 1, 0, n2, nullptr, 0)
        TRJ(F.in[38] + (size_t)l * DM * FF, FF, DM, FF, (bf16_t*)(wb + W_GU2), 2, 0, n2, nullptr, 0)
        TRJ(F.in[39] + (size_t)l * FF * DM, DM, FF, DM, (bf16_t*)(wb + W_D2), 0, 0, nullptr, nullptr, 0)
        TRJ(F.in[15] + (size_t)l * 256 * 256, 256, 256, 256, (bf16_t*)(wb + W_GLU), 0, 0, nullptr, nullptr, 0)
        if (r >= 0) break; }
}
__device__ __forceinline__ void prep_x(Frame& F) {
    const int gw = F.bx * NWAVES + F.wave, NGW = F.G * NWAVES;
    const float* x = F.in[0];
    for (int m = gw; m < TT; m += NGW) {
        const f32x4* xr = (const f32x4*)(x + (size_t)m * DM) + F.lane; float s = 0.f;
        unsigned long long* o8 = (unsigned long long*)(F.B1 + (size_t)m * DM) + F.lane;
#pragma unroll
        for (int j = 0; j < 4; ++j) { const f32x4 v = xr[64 * j]; s += (v[0] * v[0] + v[1] * v[1]) + (v[2] * v[2] + v[3] * v[3]);
            o8[64 * j] = (unsigned long long)pk2(v[0], v[1]) | ((unsigned long long)pk2(v[2], v[3]) << 32); }
        s += __shfl_xor(s, 1); s += __shfl_xor(s, 2);
        if ((F.lane & 3) == 0) F.SS[(size_t)m * 16 + (F.lane >> 2)] = s;
    }
}
__device__ __forceinline__ void final_norm(Frame& F) {
    const int gw = F.bx * NWAVES + F.wave, NGW = F.G * NWAVES;
    const f32x4* gn = (const f32x4*)F.in[40] + F.lane;
    for (int m = gw; m < TT; m += NGW) {
        const float rs = pg8::row_rstd(F.SS, m);
        f32x4* xr = (f32x4*)(F.X + (size_t)m * DM) + F.lane;
#pragma unroll
        for (int j = 0; j < 4; ++j) { const f32x4 v = xr[64 * j]; xr[64 * j] = v * rs * gn[64 * j]; }
    }
}

struct S5Par { float ar, ai; float bbr[16], bbi[16]; };
__device__ __forceinline__ void s5_params(Frame& F, int l, int g, int p, S5Par& P) {
    asm volatile("" : "+v"(p));
    const float lr = F.in[7][((size_t)l * 16 + g) * 64 + p], li = F.in[8][((size_t)l * 16 + g) * 64 + p], dt = expf(F.in[9][l * 16 + g]);
    const float mag = expf(lr * dt); P.ar = mag * cosf(li * dt); P.ai = mag * sinf(li * dt);
    const float inv = 1.0f / (lr * lr + li * li); const float qr = lr * inv, qi = -li * inv;
    const float cr = (P.ar - 1.0f) * qr - P.ai * qi, ci = (P.ar - 1.0f) * qi + P.ai * qr;
    const f32x4* br = (const f32x4*)(F.in[10] + (((size_t)l * 16 + g) * 64 + p) * 16); const f32x4* bi = (const f32x4*)(F.in[11] + (((size_t)l * 16 + g) * 64 + p) * 16);
#pragma unroll
    for (int q = 0; q < 4; ++q) { const f32x4 a = br[q], b = bi[q];
#pragma unroll
        for (int i = 0; i < 4; ++i) { P.bbr[4 * q + i] = cr * a[i] - ci * b[i]; P.bbi[4 * q + i] = cr * b[i] + ci * a[i]; } }
}
__device__ __forceinline__ void s5_step(const S5Par& P, const LAS float* urow, float& hr, float& hi) {
    const LAS f32x4* u4 = (const LAS f32x4*)urow; float bur = 0.f, bui = 0.f;
#pragma unroll
    for (int q = 0; q < 4; ++q) { const f32x4 u = u4[q];
#pragma unroll
        for (int i = 0; i < 4; ++i) { bur += P.bbr[4 * q + i] * u[i]; bui += P.bbi[4 * q + i] * u[i]; } }
    const float nr = P.ar * hr - P.ai * hi + bur, ni = P.ar * hi + P.ai * hr + bui; hr = nr; hi = ni;
}
__device__ __forceinline__ void load_u5_tile(Frame& F, int t0, LAS float* ubuf) {
    for (int i = F.tid; i < 64 * 64; i += NTHR) { const int t = i >> 6, q = i & 63; const h16x4 v = *(const h16x4*)(F.U5 + (size_t)(t0 + t) * 256 + 4 * q);
        f32x4 f; f[0] = (float)v[0]; f[1] = (float)v[1]; f[2] = (float)v[2]; f[3] = (float)v[3]; *(LAS f32x4*)(ubuf + t * 256 + 4 * q) = f; }
}


template <bool FIRST> __device__ __forceinline__ void mv32(LAS float* accp, float init, const LAS float* hb, const float* wsrc, int ldw) {
    float w[32];
    asm volatile("" : "+v"(wsrc));
#pragma unroll
    for (int j = 0; j < 32; ++j) w[j] = wsrc[(size_t)j * ldw];
#pragma unroll 2
    for (int tt = 0; tt < 32; ++tt) { const LAS f32x4* h4 = (const LAS f32x4*)(hb + tt * 256); float a = FIRST ? init : accp[tt * 256];
#pragma unroll
        for (int q = 0; q < 8; ++q) { const f32x4 v = h4[q]; a += v[0] * w[4 * q] + v[1] * w[4 * q + 1] + v[2] * w[4 * q + 2] + v[3] * w[4 * q + 3]; }
        accp[tt * 256] = a; }
}
template <int K> __device__ __forceinline__ void lora_mfma(const LAS unsigned short* hb16, int kofs, const bf16_t* Wt, LAS float* outb, int wave, int lane) {
    typedef short bf16x8_t __attribute__((ext_vector_type(8)));
    const int r16 = lane & 15, quad = lane >> 4;
    f32x4 acc[4][2];
#pragma unroll
    for (int rt = 0; rt < 4; ++rt)
#pragma unroll
        for (int ct = 0; ct < 2; ++ct) acc[rt][ct] = (f32x4){0.f, 0.f, 0.f, 0.f};
    bf16x8_t bfr[K / 32][2];
#pragma unroll
    for (int ks = 0; ks < K / 32; ++ks)
#pragma unroll
        for (int ct = 0; ct < 2; ++ct) bfr[ks][ct] = *(const bf16x8_t*)(Wt + (size_t)(wave * 32 + ct * 16 + r16) * K + ks * 32 + quad * 8);
#pragma unroll
    for (int ks = 0; ks < K / 32; ++ks)
#pragma unroll
        for (int rt = 0; rt < 4; ++rt) { const bf16x8_t a = *(const LAS bf16x8_t*)(hb16 + (rt * 16 + r16) * 264 + kofs + ks * 32 + quad * 8);
#pragma unroll
            for (int ct = 0; ct < 2; ++ct) acc[rt][ct] = __builtin_amdgcn_mfma_f32_16x16x32_bf16(a, bfr[ks][ct], acc[rt][ct], 0, 0, 0); }
#pragma unroll
    for (int rt = 0; rt < 4; ++rt)
#pragma unroll
        for (int ct = 0; ct < 2; ++ct)
#pragma unroll
            for (int j = 0; j < 4; ++j) outb[(rt * 16 + quad * 4 + j) * 256 + wave * 32 + ct * 16 + r16] = acc[rt][ct][j];
}
__device__ __forceinline__ void m1_phase(Frame& F, int l) {
    LAS float* ubuf = (LAS float*)F.lds;
    LAS float* pl = (LAS float*)(F.lds + 65536);
    const int tid = F.tid, lane = F.lane, wave = F.wave;
    const int ch = tid & 255, half = tid >> 8;
    for (int c = F.bx; c < TT / 64; c += F.G) {
        const int t0 = c * 64, tb = t0 + half * 32, sb = tb & (SEQ - 1);
        load_u5_tile(F, t0, ubuf);
        __syncthreads();
#pragma unroll 1
        for (int gi = 0; gi < 2; ++gi) { const int g = wave + 8 * gi; S5Par P; s5_params(F, l, g, lane, P); float hr = 0.f, hi = 0.f;
#pragma unroll 2
            for (int j = 0; j < 64; ++j) s5_step(P, ubuf + j * 256 + g * 16, hr, hi);
            *(f32x2*)(F.E + (((size_t)c * 16 + g) * 64 + lane) * 2) = (f32x2){hr, hi}; }
        __syncthreads();
        LAS float* accp = pl + half * 32 * 256 + ch;
        LAS unsigned short* hb16 = (LAS unsigned short*)F.lds;
        const bf16_t* l2w = (const bf16_t*)(F.ws + WS_W + W_L2);
        h16 la[32], lb[32];
#pragma unroll
        for (int tt = 0; tt < 32; ++tt) { const int t = tb + tt; la[tt] = F.L16[(size_t)t * 512 + ch]; lb[tt] = (sb + tt > 0) ? F.L16[(size_t)(t - 1) * 512 + 256 + ch] : (h16)0.f; }
#pragma unroll
        for (int tt = 0; tt < 32; ++tt) { float pre = (float)la[tt] + (float)lb[tt];
            float a = pre; if (ch < 64) a = 1.0f - 2.0f * __builtin_amdgcn_rcpf(1.0f + __expf(2.0f * pre)); else if (ch >= 128) a = sigmoidf_(pre);
            hb16[(half * 32 + tt) * 264 + ch] = (unsigned short)f2bf(a); }
        __syncthreads();
        const int hb = (t0 / SEQ) * 4 + (ch >> 6);
        unsigned char* rwb = F.RW + ((size_t)hb * SEQ + sb) * 896;
        const int cl = ch & 63;
        {
            lora_mfma<64>(hb16, 0, l2w, pl, wave, lane);
            __syncthreads();
            const float w0 = F.in[20][(size_t)l * 256 + ch];
#pragma unroll 2
            for (int tt = 0; tt < 32; ++tt) { const float z = -(accp[tt * 256] + w0); const float sp = fmaxf(z, 0.f) + __logf(1.0f + __expf(-fabsf(z)));
                const float wlog = -sp - 0.5f; const float dec = __expf(-__expf(wlog));
                *(float*)(rwb + (size_t)tt * 896 + cl * 4) = dec; }
        }
        {
            __syncthreads();
            lora_mfma<128>(hb16, 128, l2w + 2 * 256 * 64, pl, wave, lane);
            __syncthreads();
#pragma unroll 4
            for (int tt = 0; tt < 32; ++tt) F.G16[(size_t)(tb + tt) * 256 + ch] = (h16)accp[tt * 256];
        }
        {
            __syncthreads();
            lora_mfma<64>(hb16, 64, l2w + 256 * 64, pl, wave, lane);
            __syncthreads();
            const float a0 = F.in[23][(size_t)l * 256 + ch];
            const float mur = F.in[18][((size_t)l * 3 + 0) * 256 + ch], muk = F.in[18][((size_t)l * 3 + 1) * 256 + ch], muv = F.in[18][((size_t)l * 3 + 2) * 256 + ch];
            const float kkw = F.in[28][(size_t)l * 256 + ch], kaw = F.in[29][(size_t)l * 256 + ch];
            const h16* pp = F.PP + (size_t)tb * 1792 + 256 + ch;
            float rprev = 0.f, kprev = 0.f, vprev = 0.f;
            if (sb > 0) { rprev = (float)pp[-(ptrdiff_t)1792]; kprev = (float)pp[-(ptrdiff_t)1792 + 256]; vprev = (float)pp[-(ptrdiff_t)1792 + 512]; }
#pragma unroll 1
            for (int t16 = 0; t16 < 32; t16 += 16) {
                h16 rq[16], kq[16], vq[16];
#pragma unroll
                for (int tt = 0; tt < 16; ++tt) { const h16* q = pp + (size_t)(t16 + tt) * 1792; rq[tt] = q[0]; kq[tt] = q[256]; vq[tt] = q[512]; }
#pragma unroll
                for (int tt = 0; tt < 16; ++tt) { const float a = sigmoidf_(accp[(t16 + tt) * 256] + a0);
                    const float rp = (float)rq[tt], kp = (float)kq[tt], vp = (float)vq[tt];
                    const float r = rp + (rprev - rp) * mur, k = kp + (kprev - kp) * muk, v = vp + (vprev - vp) * muv;
                    rprev = rp; kprev = kp; vprev = vp;
                    const float kkv = k * kkw; const float kk = kkv * rsqrtf(fmaxf(wave_sum(kkv * kkv), 1e-24f));
                    const float kt = k * (1.0f + (a - 1.0f) * kaw); const float bb = kk * a;
                    h16* o = (h16*)(rwb + (size_t)(t16 + tt) * 896 + 256) + cl;
                    o[0] = (h16)r; o[64] = (h16)kt; o[128] = (h16)v; o[192] = (h16)kk; o[256] = (h16)bb; } }
        }
        __syncthreads();
    }
}

__device__ __forceinline__ void pool_conv_chunk(Frame& F, int l, int c) {
    LAS float* ubuf = (LAS float*)F.lds;
    LAS unsigned short* pb16 = (LAS unsigned short*)(F.lds + 65536);
    const int tid = F.tid; const int ch = tid & 255, half = tid >> 8;
    const int t0 = c * 64, tb = t0 + half * 32, sb = tb & (SEQ - 1);
    {
    {
        const int grp = ch >> 6, win = 2 << grp;
        const h16* up = F.PP + (size_t)tb * 1792 + ch;
        float s = 0.f;
        for (int j = 1; j <= win; ++j) if (sb - j >= 0) s += (float)up[-(ptrdiff_t)j * 1792];
#pragma unroll 1
        for (int t16 = 0; t16 < 32; t16 += 16) {
            h16 uq[16], ul[16];
#pragma unroll
            for (int tt = 0; tt < 16; ++tt) { uq[tt] = up[(size_t)(t16 + tt) * 1792]; ul[tt] = (sb + t16 + tt - win >= 0) ? up[(ptrdiff_t)(t16 + tt - win) * 1792] : (h16)0.f; }
#pragma unroll
            for (int tt = 0; tt < 16; ++tt) { const float u = (float)uq[tt]; s += u; const int pos = sb + t16 + tt;
                s -= (float)ul[tt];
                const float cnt = (float)((pos + 1 < win) ? (pos + 1) : win);
                pb16[(half * 32 + t16 + tt) * 264 + ch] = (unsigned short)f2bf(s / cnt - u); } }
    }
    {
        const h16* zp = F.PP + (size_t)tb * 1792 + 1024 + ch;
        const float cw0 = F.in[33][((size_t)l * 3 + 0) * 256 + ch], cw1 = F.in[33][((size_t)l * 3 + 1) * 256 + ch], cw2 = F.in[33][((size_t)l * 3 + 2) * 256 + ch];
        float z2 = 0.f, z1 = 0.f;
        if (sb >= 1) z1 = (float)zp[-(ptrdiff_t)1792 + 512] * (float)zp[-(ptrdiff_t)1792];
        if (sb >= 2) z2 = (float)zp[-(ptrdiff_t)2 * 1792 + 512] * (float)zp[-(ptrdiff_t)2 * 1792];
#pragma unroll 1
        for (int t16 = 0; t16 < 32; t16 += 16) {
            h16 zx[16], zb[16], zc[16];
#pragma unroll
            for (int tt = 0; tt < 16; ++tt) { const h16* q = zp + (size_t)(t16 + tt) * 1792; zx[tt] = q[0]; zb[tt] = q[256]; zc[tt] = q[512]; }
#pragma unroll
            for (int tt = 0; tt < 16; ++tt) { const float z0 = (float)zc[tt] * (float)zx[tt];
                const float y = (float)zb[tt] * (cw0 * z2 + cw1 * z1 + cw2 * z0);
                F.B2[(size_t)(tb + t16 + tt) * 1024 + 768 + ch] = (bf16_t)f2bf(y); z2 = z1; z1 = z0; } }
    }
    __syncthreads();
    LAS float* accu = ubuf + half * 32 * 256 + ch;
    {
        lora_mfma<64>(pb16, (F.wave >> 1) * 64, (const bf16_t*)(F.ws + WS_W + W_L2) + 4 * 256 * 64, ubuf, F.wave, F.lane);
        __syncthreads();
        const float sc = F.in[17][(size_t)l * 256 + ch];
#pragma unroll 4
        for (int tt = 0; tt < 32; ++tt) F.B2[(size_t)(tb + tt) * 1024 + 256 + ch] = (bf16_t)f2bf(accu[tt * 256] * sc);
    }
    __syncthreads();
    }
}

#define XB_TMO      128
#define XB_XCNT(j)  (256  + 64 * (j))
#define XB_XSUB(j)  (1280 + 64 * (j))
#define XB_XGEN(j)  (2304 + 64 * (j))
#define XB_TOP      3328
#define XB_TOPGEN   3392
#define XCD_BAR_WORDS 3456
#define XB_SPIN_CAP (1u << 18)

__device__ __forceinline__ unsigned xb_ld(unsigned* p)              { return __hip_atomic_load(p, __ATOMIC_RELAXED, __HIP_MEMORY_SCOPE_AGENT); }
__device__ __forceinline__ unsigned xb_add(unsigned* p, unsigned v) { return __hip_atomic_fetch_add(p, v, __ATOMIC_RELAXED, __HIP_MEMORY_SCOPE_AGENT); }
__device__ __forceinline__ unsigned xb_xcc_id() { return (unsigned)__builtin_amdgcn_s_getreg((3 << 11) | 20) & 0xFu; }
#define XB_SPIN(cond, bar) do { unsigned _sp = 0; while (cond) { __builtin_amdgcn_s_sleep(1); \
    if ((++_sp & 255u) == 0u) { if (xb_ld(&(bar)[XB_TMO])) break; if (_sp > XB_SPIN_CAP) { atomicAdd(&(bar)[XB_TMO], 1u); break; } } } } while (0)

struct XcdBarrier {
    unsigned* bar; unsigned x;
    volatile LAS unsigned* st;
};

__device__ __forceinline__ XcdBarrier xcd_barrier_post(unsigned* bar, volatile LAS unsigned* st) {
    XcdBarrier b; b.bar = bar; b.x = xb_xcc_id(); b.st = st;
    if (threadIdx.x == 0) (void)xb_add(&bar[XB_XCNT(b.x)], 1u);
    return b;
}
__device__ __forceinline__ void xcd_barrier_complete(unsigned* bar, unsigned x, unsigned& nloc, unsigned& nx) {
    const unsigned G = gridDim.x * gridDim.y * gridDim.z;
    unsigned sum, cnt, mine, sp = 0u;
    for (;;) {
        sum = 0u; cnt = 0u; mine = 0u;
#pragma unroll
        for (unsigned j = 0; j < 16; ++j) { const unsigned c = xb_ld(&bar[XB_XCNT(j)]); sum += c; cnt += (c > 0u) ? 1u : 0u; mine = (j == x) ? c : mine; }
        if (sum == G) break;
        __builtin_amdgcn_s_sleep(1);
        if ((++sp & 255u) == 0u) { if (xb_ld(&bar[XB_TMO])) break; if (sp > XB_SPIN_CAP) { atomicAdd(&bar[XB_TMO], 1u); break; } }
    }
    nloc = mine > 0u ? mine : 1u; nx = cnt > 0u ? cnt : 1u;
}

__device__ __forceinline__ void xcd_barrier(const XcdBarrier& b) {
    asm volatile("s_waitcnt vmcnt(0)" ::: "memory");
    __syncthreads();
    if (threadIdx.x == 0) {
        unsigned* bar = b.bar;
        __builtin_amdgcn_s_waitcnt(0);
        unsigned nloc = b.st[0], nx = b.st[1];
        if (nloc == 0u) { xcd_barrier_complete(bar, b.x, nloc, nx); b.st[0] = nloc; b.st[1] = nx; }
        const unsigned old = xb_add(&bar[XB_XSUB(b.x)], 1u);
        const unsigned gen = old / nloc;
        if (old + 1u == (gen + 1u) * nloc) {
            __builtin_amdgcn_fence(__ATOMIC_RELEASE, "agent");
            asm volatile("s_waitcnt vmcnt(0)" ::: "memory");
            const unsigned og = xb_add(&bar[XB_TOP], 1u);
            const unsigned tg = og / nx;
            if (og + 1u == (tg + 1u) * nx) xb_add(&bar[XB_TOPGEN], 1u);
            else XB_SPIN(xb_ld(&bar[XB_TOPGEN]) == tg, bar);
            __builtin_amdgcn_fence(__ATOMIC_ACQUIRE, "agent");
            xb_add(&bar[XB_XGEN(b.x)], 1u);
            asm volatile("s_waitcnt vmcnt(0)" ::: "memory");
        } else {
            XB_SPIN(xb_ld(&bar[XB_XGEN(b.x)]) == gen, bar);
            __builtin_amdgcn_fence(__ATOMIC_ACQUIRE, "agent");
            asm volatile("s_waitcnt vmcnt(0)" ::: "memory");
        }
    }
    __syncthreads();
}

__device__ __forceinline__ float a_fma(float a, float b, float c) { float d; asm("v_fma_f32 %0, %1, %2, %3" : "=v"(d) : "v"(a), "v"(b), "v"(c)); return d; }
__device__ __forceinline__ float a_fnma(float a, float b, float c) { float d; asm("v_fma_f32 %0, -%1, %2, %3" : "=v"(d) : "v"(a), "v"(b), "v"(c)); return d; }
__device__ __forceinline__ float a_mul(float a, float b) { float d; asm("v_mul_f32 %0, %1, %2" : "=v"(d) : "v"(a), "v"(b)); return d; }
__device__ __forceinline__ float a_add(float a, float b) { float d; asm("v_add_f32 %0, %1, %2" : "=v"(d) : "v"(a), "v"(b)); return d; }
constexpr int RC_LEN = 256, RC_N = SEQ / RC_LEN;
constexpr int ST_STEPS = 16, ST_FL = ST_STEPS * 384, ST_NPC = ST_STEPS * 56, ST_OB = ST_STEPS * 32 * 16, ST_NSUB = RC_LEN / ST_STEPS;
__device__ __forceinline__ void st_load(const unsigned char* src, int sub, int tid, u32x4 (&rg)[2]) {
#pragma unroll
    for (int n = 0; n < 2; ++n) { const int i = tid + NTHR * n; if (i < ST_NPC) { const int step = i / 56, j = i % 56;
        rg[n] = *(const u32x4*)(src + ((size_t)sub * ST_STEPS + step) * 896 + (j < 16 ? j * 16 : 256 + (j - 16) * 16)); } }
}
__device__ __forceinline__ void st_store(LAS float* buf, int tid, const u32x4 (&rg)[2]) {
#pragma unroll
    for (int n = 0; n < 2; ++n) { const int i = tid + NTHR * n; if (i < ST_NPC) { const int step = i / 56, j = i % 56;
        if (j < 16) { *(LAS u32x4*)(buf + step * 384 + j * 4) = rg[n]; }
        else { const int a = (j - 16) >> 3, e = (j - 16) & 7; const h16x8 h = __builtin_bit_cast(h16x8, rg[n]); f32x4 lo, hi;
            lo[0] = (float)h[0]; lo[1] = (float)h[1]; lo[2] = (float)h[2]; lo[3] = (float)h[3]; hi[0] = (float)h[4]; hi[1] = (float)h[5]; hi[2] = (float)h[6]; hi[3] = (float)h[7];
            LAS f32x4* d = (LAS f32x4*)(buf + step * 384 + 64 + a * 64 + e * 8); d[0] = lo; d[1] = hi; } } }
}
#define RAW_BAR() do { asm volatile("s_waitcnt lgkmcnt(0)" ::: "memory"); __builtin_amdgcn_s_barrier(); asm volatile("" ::: "memory"); } while (0)
#define DPP_ADD(x_, ctl_) "v_add_f32_dpp %[" x_ "], %[" x_ "], %[" x_ "] " ctl_ " row_mask:0xf bank_mask:0xf bound_ctrl:1\n\t"
template <bool OUT> __device__ __forceinline__ void scan_task(Frame& F, const unsigned char* src, const float* initS, bool ident, bool use_v, float* endS, float* Og) {
    constexpr int STS = OUT ? 8 : 16, NSUB = RC_LEN / STS, FL = STS * 384, NPC = STS * 56, PT = (NPC + NTHR - 1) / NTHR, OB = STS * 64 * 16;
    LAS float* buf = (LAS float*)F.lds;
    LAS float* obuf = (LAS float*)(F.lds + 2 * FL * 4);
    const int tid = F.tid, wave = F.wave, lane = F.lane, ks = lane & 15;
    int rowr[2]; float S[2][4];
#pragma unroll
    for (int r = 0; r < 2; ++r) { rowr[r] = (wave * 2 + r) * 4 + (lane >> 4);
        if (initS) { const f32x4 i4 = *(const f32x4*)(initS + (size_t)rowr[r] * 64 + 4 * ks); S[r][0] = i4[0]; S[r][1] = i4[1]; S[r][2] = i4[2]; S[r][3] = i4[3]; }
        else {
#pragma unroll
            for (int e = 0; e < 4; ++e) S[r][e] = (ident && 4 * ks + e == rowr[r]) ? 1.f : 0.f; } }
    u32x4 rg[2][PT];
#define ST_LOAD(sub_, rg_) do { _Pragma("unroll") for (int n_ = 0; n_ < PT; ++n_) { const int i_ = tid + NTHR * n_; if (i_ < NPC) { const int step_ = i_ / 56, j_ = i_ % 56; \
        rg_[n_] = *(const u32x4*)(src + ((size_t)(sub_) * STS + step_) * 896 + (j_ < 16 ? j_ * 16 : 256 + (j_ - 16) * 16)); } } } while (0)
#define ST_STORE(buf_, rg_) do { _Pragma("unroll") for (int n_ = 0; n_ < PT; ++n_) { const int i_ = tid + NTHR * n_; if (i_ < NPC) { const int step_ = i_ / 56, j_ = i_ % 56; \
        if (j_ < 16) { *(LAS u32x4*)((buf_) + step_ * 384 + j_ * 4) = rg_[n_]; } \
        else { const int a_ = (j_ - 16) >> 3, e_ = (j_ - 16) & 7; const h16x8 h_ = __builtin_bit_cast(h16x8, rg_[n_]); f32x4 lo_, hi_; \
            lo_[0] = (float)h_[0]; lo_[1] = (float)h_[1]; lo_[2] = (float)h_[2]; lo_[3] = (float)h_[3]; hi_[0] = (float)h_[4]; hi_[1] = (float)h_[5]; hi_[2] = (float)h_[6]; hi_[3] = (float)h_[7]; \
            LAS f32x4* d_ = (LAS f32x4*)((buf_) + step_ * 384 + 64 + a_ * 64 + e_ * 8); d_[0] = lo_; d_[1] = hi_; } } } } while (0)
    ST_LOAD(0, rg[0]); ST_STORE(buf, rg[0]); ST_LOAD(1, rg[1]); ST_LOAD(2, rg[0]);
    RAW_BAR();
#pragma unroll 1
    for (int sc2 = 0; sc2 < NSUB; sc2 += 2) {
#pragma unroll
      for (int u = 0; u < 2; ++u) { const int sc = sc2 + u;
        if (sc + 1 < NSUB) { ST_STORE(buf + ((sc + 1) & 1) * FL, rg[(u + 1) & 1]); if (sc + 3 < NSUB) ST_LOAD(sc + 3, rg[(u + 1) & 1]); }
        {
            const LAS float* bb = buf + (sc & 1) * FL + 4 * ks; const LAS float* vb0 = buf + (sc & 1) * FL + 192 + rowr[0]; const LAS float* vb1 = buf + (sc & 1) * FL + 192 + rowr[1];
            LAS float* ob0 = obuf + (sc & 1) * OB + rowr[0] * 16 + ks; LAS float* ob1 = obuf + (sc & 1) * OB + rowr[1] * 16 + ks;
            f32x4 w_[2], r_[2], k_[2], kk_[2], b_[2]; float v_[2][2];
#define SC_LD(s_, j_) do { const LAS float* p_ = bb + (s_) * 384; w_[j_] = *(const LAS f32x4*)(p_); if (OUT) r_[j_] = *(const LAS f32x4*)(p_ + 64); k_[j_] = *(const LAS f32x4*)(p_ + 128); \
                kk_[j_] = *(const LAS f32x4*)(p_ + 256); b_[j_] = *(const LAS f32x4*)(p_ + 320); v_[j_][0] = vb0[(s_) * 384]; v_[j_][1] = vb1[(s_) * 384]; } while (0)
            SC_LD(0, 0);
#pragma unroll
            for (int s = 0; s < STS; ++s) { const int j = s & 1;
                f32x4 rp; if (OUT) rp = r_[j ^ 1];
                if (s + 1 < STS) SC_LD(s + 1, j ^ 1);
                const f32x4 w = w_[j], k = k_[j], kk = kk_[j], bv = b_[j];
#pragma unroll
                for (int r = 0; r < 2; ++r) { const float v = use_v ? v_[j][r] : 0.f;
                    float sa, op, u0, u1, u2, u3;
                    if (OUT && s > 0) {
                        asm volatile(
                            "v_mul_f32 %[sa], %[Sa], %[kk0]\n\t" "v_fma_f32 %[sa], %[Sb], %[kk1], %[sa]\n\t" "v_fma_f32 %[sa], %[Sc], %[kk2], %[sa]\n\t" "v_fma_f32 %[sa], %[Sd], %[kk3], %[sa]\n\t"
                            "v_mul_f32 %[op], %[Sa], %[r0]\n\t" "v_fma_f32 %[op], %[Sb], %[r1], %[op]\n\t"
                            DPP_ADD("sa", "quad_perm:[1,0,3,2]") "v_fma_f32 %[op], %[Sc], %[r2], %[op]\n\t" "v_fma_f32 %[op], %[Sd], %[r3], %[op]\n\t"
                            DPP_ADD("sa", "quad_perm:[2,3,0,1]") "v_mul_f32 %[u0], %[v], %[k0]\n\t" "v_mul_f32 %[u1], %[v], %[k1]\n\t"
                            DPP_ADD("sa", "row_half_mirror") "v_mul_f32 %[u2], %[v], %[k2]\n\t" "v_mul_f32 %[u3], %[v], %[k3]\n\t"
                            DPP_ADD("sa", "row_mirror")
                            : [sa] "=&v"(sa), [op] "=&v"(op), [u0] "=&v"(u0), [u1] "=&v"(u1), [u2] "=&v"(u2), [u3] "=&v"(u3)
                            : [Sa] "v"(S[r][0]), [Sb] "v"(S[r][1]), [Sc] "v"(S[r][2]), [Sd] "v"(S[r][3]), [kk0] "v"(kk[0]), [kk1] "v"(kk[1]), [kk2] "v"(kk[2]), [kk3] "v"(kk[3]),
                              [r0] "v"(rp[0]), [r1] "v"(rp[1]), [r2] "v"(rp[2]), [r3] "v"(rp[3]), [v] "v"(v), [k0] "v"(k[0]), [k1] "v"(k[1]), [k2] "v"(k[2]), [k3] "v"(k[3]));
                        (r == 0 ? ob0 : ob1)[(s - 1) * 1024] = op;
                    } else {
                        asm volatile(
                            "v_mul_f32 %[sa], %[Sa], %[kk0]\n\t" "v_fma_f32 %[sa], %[Sb], %[kk1], %[sa]\n\t" "v_fma_f32 %[sa], %[Sc], %[kk2], %[sa]\n\t" "v_fma_f32 %[sa], %[Sd], %[kk3], %[sa]\n\t"
                            "v_mul_f32 %[u0], %[v], %[k0]\n\t" "v_mul_f32 %[u1], %[v], %[k1]\n\t"
                            DPP_ADD("sa", "quad_perm:[1,0,3,2]") "v_mul_f32 %[u2], %[v], %[k2]\n\t" "v_mul_f32 %[u3], %[v], %[k3]\n\t"
                            DPP_ADD("sa", "quad_perm:[2,3,0,1]") "s_nop 1\n\t"
                            DPP_ADD("sa", "row_half_mirror") "s_nop 1\n\t"
                            DPP_ADD("sa", "row_mirror")
                            : [sa] "=&v"(sa), [u0] "=&v"(u0), [u1] "=&v"(u1), [u2] "=&v"(u2), [u3] "=&v"(u3)
                            : [Sa] "v"(S[r][0]), [Sb] "v"(S[r][1]), [Sc] "v"(S[r][2]), [Sd] "v"(S[r][3]), [kk0] "v"(kk[0]), [kk1] "v"(kk[1]), [kk2] "v"(kk[2]), [kk3] "v"(kk[3]),
                              [v] "v"(v), [k0] "v"(k[0]), [k1] "v"(k[1]), [k2] "v"(k[2]), [k3] "v"(k[3]));
                    }
                    asm volatile(
                        "v_fma_f32 %[u0], -%[sa], %[b0], %[u0]\n\t" "v_fma_f32 %[u1], -%[sa], %[b1], %[u1]\n\t" "v_fma_f32 %[u2], -%[sa], %[b2], %[u2]\n\t" "v_fma_f32 %[u3], -%[sa], %[b3], %[u3]\n\t"
                        "v_fma_f32 %[Sa], %[Sa], %[w0], %[u0]\n\t" "v_fma_f32 %[Sb], %[Sb], %[w1], %[u1]\n\t" "v_fma_f32 %[Sc], %[Sc], %[w2], %[u2]\n\t" "v_fma_f32 %[Sd], %[Sd], %[w3], %[u3]\n\t"
                        : [Sa] "+v"(S[r][0]), [Sb] "+v"(S[r][1]), [Sc] "+v"(S[r][2]), [Sd] "+v"(S[r][3]), [u0] "+v"(u0), [u1] "+v"(u1), [u2] "+v"(u2), [u3] "+v"(u3)
                        : [sa] "v"(sa), [b0] "v"(bv[0]), [b1] "v"(bv[1]), [b2] "v"(bv[2]), [b3] "v"(bv[3]), [w0] "v"(w[0]), [w1] "v"(w[1]), [w2] "v"(w[2]), [w3] "v"(w[3])); }
                __builtin_amdgcn_sched_barrier(0); }
            if (OUT) { const f32x4 r4 = r_[(STS - 1) & 1];
              ob0[(STS - 1) * 1024] = a_fma(S[0][3], r4[3], a_fma(S[0][2], r4[2], a_fma(S[0][1], r4[1], a_mul(S[0][0], r4[0]))));
              ob1[(STS - 1) * 1024] = a_fma(S[1][3], r4[3], a_fma(S[1][2], r4[2], a_fma(S[1][1], r4[1], a_mul(S[1][0], r4[0])))); }
#undef SC_LD
        }
        RAW_BAR();
        if (OUT) {
            const LAS f32x4* p = (const LAS f32x4*)(obuf + (sc & 1) * OB + tid * 16); const f32x4 a = p[0], b = p[1], c = p[2], d = p[3];
            const float o = (((a[0] + a[1]) + (a[2] + a[3])) + ((b[0] + b[1]) + (b[2] + b[3]))) + (((c[0] + c[1]) + (c[2] + c[3])) + ((d[0] + d[1]) + (d[2] + d[3])));
            Og[((size_t)sc * STS + (tid >> 6)) * 256 + (tid & 63)] = o; }
      }
    }
#undef ST_LOAD
#undef ST_STORE
    if (endS) {
#pragma unroll
        for (int r = 0; r < 2; ++r) *(f32x4*)(endS + (size_t)rowr[r] * 64 + 4 * ks) = (f32x4){S[r][0], S[r][1], S[r][2], S[r][3]}; }
    RAW_BAR();
}
#undef DPP_ADD
__device__ __forceinline__ void rwkv_carry(Frame& F) {
    const int hb = F.bx >> 3, row = (F.bx & 7) * 8 + F.wave, lane = F.lane, tid = F.tid;
    LAS float* Pl = (LAS float*)F.lds;
    LAS float* Sl = (LAS float*)(F.lds + 16384) + F.wave * 64;
    float S = 0.f;
    const size_t m0 = (size_t)hb * RC_N * 4096;
    f32x4 p0 = *(const f32x4*)(F.PB + m0 + (size_t)tid * 8), p1 = *(const f32x4*)(F.PB + m0 + (size_t)tid * 8 + 4);
    float lc = F.LB[m0 + (size_t)row * 64 + lane];
#pragma unroll 1
    for (int c = 0; c < RC_N; ++c) { const size_t mo = m0 + (size_t)c * 4096;
        F.SB[mo + (size_t)row * 64 + lane] = S;
        if (c + 1 == RC_N) break;
        float acc = lc;
        *(LAS f32x4*)(Pl + tid * 8) = p0; *(LAS f32x4*)(Pl + tid * 8 + 4) = p1; Sl[lane] = S;
        if (c + 2 < RC_N) { p0 = *(const f32x4*)(F.PB + mo + 4096 + (size_t)tid * 8); p1 = *(const f32x4*)(F.PB + mo + 4096 + (size_t)tid * 8 + 4); lc = F.LB[mo + 4096 + (size_t)row * 64 + lane]; }
        RAW_BAR();
        float a0 = 0.f, a1 = 0.f, a2 = 0.f, a3 = 0.f;
#pragma unroll 4
        for (int j = 0; j < 64; j += 4) { const f32x4 s4 = *(const LAS f32x4*)(Sl + j);
            a0 += s4[0] * Pl[(j + 0) * 64 + lane]; a1 += s4[1] * Pl[(j + 1) * 64 + lane]; a2 += s4[2] * Pl[(j + 2) * 64 + lane]; a3 += s4[3] * Pl[(j + 3) * 64 + lane]; }
        S = acc + ((a0 + a1) + (a2 + a3));
        RAW_BAR();
    }
}
__device__ __forceinline__ float gelu_tanh(float x) { const float u = 0.7978845608028654f * (x + 0.044715f * x * x * x); return 0.5f * x * (1.0f + tanhf(u)); }
__device__ __forceinline__ void s5_pass2(Frame& F, int l, int c) {
    LAS float* ubuf = (LAS float*)F.lds;
    LAS float* ybuf = (LAS float*)(F.lds + 65536);
    const int t0 = c * 64, lane = F.lane, wave = F.wave, cb0 = c & ~127;
    load_u5_tile(F, t0, ubuf);
    __syncthreads();
#pragma unroll 1
    for (int gi = 0; gi < 2; ++gi) { const int g = wave + 8 * gi; S5Par P; s5_params(F, l, g, lane, P);
        float cr[16], ci[16]; int lane_l = lane; asm volatile("" : "+v"(lane_l));
#pragma unroll
        for (int hh = 0; hh < 16; ++hh) { cr[hh] = F.in[12][(((size_t)l * 16 + g) * 16 + hh) * 64 + lane_l]; ci[hh] = F.in[13][(((size_t)l * 16 + g) * 16 + hh) * 64 + lane_l]; }
        float pr = P.ar, pi = P.ai;
#pragma unroll
        for (int s = 0; s < 6; ++s) { const float nr = pr * pr - pi * pi, ni = 2.0f * pr * pi; pr = nr; pi = ni; }
        float hr = 0.f, hi = 0.f;
#pragma unroll 1
        for (int c2 = cb0; c2 < c; c2 += 16) {
            f32x2 e[16];
#pragma unroll
            for (int q = 0; q < 16; ++q) { const int cq = (c2 + q < c) ? c2 + q : c2; e[q] = *(const f32x2*)(F.E + (((size_t)cq * 16 + g) * 64 + lane_l) * 2); }
#pragma unroll
            for (int q = 0; q < 16; ++q) if (c2 + q < c) { const float nr = pr * hr - pi * hi + e[q][0], ni = pr * hi + pi * hr + e[q][1]; hr = nr; hi = ni; } }
        const bool b3 = (lane & 8) != 0, b2 = (lane & 4) != 0, b1 = (lane & 2) != 0, b0 = (lane & 1) != 0;
#pragma unroll 1
        for (int j = 0; j < 64; ++j) { s5_step(P, ubuf + j * 256 + g * 16, hr, hi);
            float v8[8], v4[4], v2[2];
#pragma unroll
            for (int i = 0; i < 8; ++i) { const float lo = hr * cr[i] - hi * ci[i], hv = hr * cr[i + 8] - hi * ci[i + 8];
                const float keep = b3 ? hv : lo, send = b3 ? lo : hv; v8[i] = keep + dppx<0x140>(send); }
#pragma unroll
            for (int i = 0; i < 4; ++i) { const float keep = b2 ? v8[i + 4] : v8[i], send = b2 ? v8[i] : v8[i + 4]; v4[i] = keep + dppx<0x141>(send); }
#pragma unroll
            for (int i = 0; i < 2; ++i) { const float keep = b1 ? v4[i + 2] : v4[i], send = b1 ? v4[i] : v4[i + 2]; v2[i] = keep + dppx<0x4E>(send); }
            float y = (b0 ? v2[1] : v2[0]) + dppx<0xB1>(b0 ? v2[0] : v2[1]);
            y += __shfl_xor(y, 16); y += __shfl_xor(y, 32);
            if (lane < 16) ybuf[j * 256 + g * 16 + lane] = y; }
    }
    __syncthreads();
    { const int ch = F.tid & 255, half = F.tid >> 8; const float dd = F.in[14][(size_t)l * 256 + ch];
        for (int tt = 0; tt < 32; ++tt) { const int tl = half * 32 + tt; const float y = ybuf[tl * 256 + ch] + dd * ubuf[tl * 256 + ch];
            F.GL[(size_t)(t0 + tl) * 256 + ch] = (bf16_t)f2bf(gelu_tanh(y)); } }
    __syncthreads();
}
template <int PART> __device__ __forceinline__ void m2_phase(Frame& F, int l, const XcdBarrier& xbar) {
    if (PART == 0 || PART == 1)
#pragma unroll 1
    for (int id = F.bx; id < 8 * RC_N * 2; id += F.G) { const int hb = id >> 6, c = (id >> 1) & (RC_N - 1), tk = id & 1; const size_t mo = ((size_t)hb * RC_N + c) * 4096;
        if (c == RC_N - 1) continue;
        const unsigned char* src = F.RW + ((size_t)hb * SEQ + (size_t)c * RC_LEN) * 896;
        scan_task<false>(F, src, nullptr, tk == 1, tk == 0, (tk == 0 ? F.LB : F.PB) + mo, nullptr); }
    if (PART == 0 || PART == 2)
#pragma unroll 1
    for (int c = F.bx; c < TT / 64; c += F.G) pool_conv_chunk(F, l, c);
    xcd_barrier(xbar);
    if (PART == 0 || PART == 3) { int bxs = F.bx; asm volatile("" : "+s"(bxs));
      if (bxs < 64) rwkv_carry(F);
      else conv_second_half(F, l, 64); }
    xcd_barrier(xbar);
    if (PART == 0 || PART == 4)
#pragma unroll 1
    for (int id = F.bx; id < 8 * RC_N; id += F.G) { const int hb = id >> 5, c = id & (RC_N - 1); const size_t mo = ((size_t)hb * RC_N + c) * 4096;
        const unsigned char* src = F.RW + ((size_t)hb * SEQ + (size_t)c * RC_LEN) * 896;
        float* Og = F.O + ((size_t)(hb >> 2) * SEQ + (size_t)c * RC_LEN) * 256 + (hb & 3) * 64;
        scan_task<true>(F, src, F.SB + mo, false, true, nullptr, Og); }
    if (PART == 0 || PART == 5)
#pragma unroll 1
    for (int c = F.bx; c < TT / 64; c += F.G) s5_pass2(F, l, c);
}
__device__ __forceinline__ void rwkv_post(Frame& F, int l) {
    const int gw = F.bx * NWAVES + F.wave, NGW = F.G * NWAVES, lane = F.lane;
    for (int it0 = gw * 4; it0 < TT * 4; it0 += NGW * 4) {
        const int t = it0 >> 2, b = t / SEQ, pos = t & (SEQ - 1);
        float o[4], r[4], k[4], v[4], g[4];
#pragma unroll
        for (int hh = 0; hh < 4; ++hh) { const int c = hh * 64 + lane; o[hh] = F.O[(size_t)t * 256 + c]; g[hh] = (float)F.G16[(size_t)t * 256 + c];
            const h16* rw = (const h16*)(F.RW + ((size_t)(b * 4 + hh) * SEQ + pos) * 896 + 256) + lane; r[hh] = (float)rw[0]; k[hh] = (float)rw[64]; v[hh] = (float)rw[128]; }
#pragma unroll
        for (int hh = 0; hh < 4; ++hh) { const int c = hh * 64 + lane;
            const float mu = wave_sum(o[hh]) * (1.0f / 64.0f); const float d = o[hh] - mu; const float var = wave_sum(d * d) * (1.0f / 64.0f);
            const float on = d * rsqrtf(var + 64e-5f) * F.in[31][(size_t)l * 256 + c] + F.in[32][(size_t)l * 256 + c];
            const float bs = wave_sum(r[hh] * k[hh] * F.in[30][(size_t)l * 256 + c]);
            F.B2[(size_t)t * 1024 + 512 + c] = (bf16_t)f2bf((on + bs * v[hh]) * g[hh]); }
    }
}

constexpr int NPH = 25;
#ifndef PHMASK
#define PHMASK 0xFFFF
#endif
#define PHON(k) (((PHMASK) >> (k)) & 1)
#ifndef REP_PART
#define REP_PART 0
#endif
template <int PH, int PART = 0> __device__ __forceinline__ void run_phase(const int wave_s, unsigned char* lds_raw, const XcdBarrier& xbar) {
    typedef pg8::StaticOrder SO;
    int tid = wave_s * 64 + (int)__builtin_amdgcn_mbcnt_hi(~0u, __builtin_amdgcn_mbcnt_lo(~0u, 0u)); asm volatile("" : "+v"(tid));
    int G = gridDim.x, bx = blockIdx.x; asm volatile("" : "+s"(G), "+s"(bx));
    const __attribute__((address_space(4))) unsigned char* ka = (const __attribute__((address_space(4))) unsigned char*)__builtin_amdgcn_kernarg_segment_ptr();
    asm volatile("" : "+s"(ka));
    const __attribute__((address_space(4))) Args* ap = (const __attribute__((address_space(4))) Args*)ka;
    Frame F;
    F.lds = (LAS unsigned char*)lds_raw;
    F.tid = tid; F.lane = tid & 63; F.wave = __builtin_amdgcn_readfirstlane(tid >> 6); F.G = G; F.bx = bx;
    F.in = (in_t)ka; F.X = ap->out; F.ws = ap->ws;
    unsigned char* ws = F.ws;
    F.SS = (float*)(ws + WS_SS); F.E = (float*)(ws + WS_E); F.B1 = (bf16_t*)(ws + WS_B1); F.B2 = (bf16_t*)(ws + WS_B2);
    unsigned char* z = ws + WS_Z;
    F.HID = (bf16_t*)(z + Z_HID); F.GL = (bf16_t*)(z + Z_GL); F.U5 = (h16*)(z + Z_U5); F.PP = (h16*)(z + Z_PP); F.L16 = (h16*)(z + Z_L16); F.G16 = (h16*)(z + Z_G16); F.R = (h16*)(z + Z_R);
    F.O = (float*)(z + Z_O); F.RW = z + Z_RW; F.PB = (float*)(z + Z_PB); F.LB = (float*)(z + Z_LB); F.SB = (float*)(z + Z_SB);
    if constexpr (PH == 0) { conv_first_half(F, 0); prep_x(F); }
    else { constexpr int l = (PH - 1) / 12, k = (PH - 1) % 12;
        if constexpr (k == 0) { pg8::Gemm g{F.B1, (const bf16_t*)(ws + WS_W + W_GU1), TT, 2 * FF, DM, 1}; SO S; S.init(TT, 2 * FF, G, bx); pg8::EpiGU E{F.HID, F.SS}; pg8::gemm_phase<pg8::EpiGU, SO, true, true>(F.lds, g, S, E, tid); }
        else if constexpr (k == 1) { pg8::Gemm g{F.HID, (const bf16_t*)(ws + WS_W + W_D1), TT, DM, FF, 1}; SO S; S.init(TT, DM, G, bx); pg8::EpiDown E{l == 0 ? F.in[0] : F.X, F.X, F.B1, F.SS, 0.5f}; pg8::gemm_phase<pg8::EpiDown, SO, true, true>(F.lds, g, S, E, tid); }
        else if constexpr (k == 2) { pg8::Gemm g{F.B1, (const bf16_t*)(ws + WS_W + W_INA), TT, 2560, DM, 1}; SO S; S.init(TT, 2560, G, bx); pg8::EpiInA E{F.U5, F.PP, F.L16, F.SS}; pg8::gemm_phase<pg8::EpiInA, SO, true, true>(F.lds, g, S, E, tid); }
        else if constexpr (k == 3) { m1_phase(F, l); }
        else if constexpr (k == 4) { m2_phase<PART>(F, l, xbar); }
        else if constexpr (k == 5) { { pg8::Gemm g{F.GL, (const bf16_t*)(ws + WS_W + W_GLU), TT, 256, 256, 1}; SO S; S.init(TT, 256, G, bx); pg8::EpiGlu E{F.GL, F.B2}; pg8::gemm_phase<pg8::EpiGlu, SO, true, true>(F.lds, g, S, E, tid); } rwkv_post(F, l); }
        else if constexpr (k == 6) { pg8::Gemm g{F.B1, (const bf16_t*)(ws + WS_W + W_ING), TT, 4096, DM, 1}; SO S; S.init(TT, 4096, G, bx); pg8::EpiGate E{F.R, F.SS}; pg8::gemm_phase<pg8::EpiGate, SO, true, true>(F.lds, g, S, E, tid); }
        else if constexpr (k == 7) { pg8::Gemm g{F.B2, (const bf16_t*)(ws + WS_W + W_BR), TT, DM, DM, 4}; pg8::SegOrder4 S; S.so.init(TT, DM, G, bx); pg8::EpiBranch E{F.R, F.B1}; pg8::gemm_phase<pg8::EpiBranch, pg8::SegOrder4, true, true>(F.lds, g, S, E, tid); }
        else if constexpr (k == 8) { pg8::Gemm g{F.B1, (const bf16_t*)(ws + WS_W + W_O), TT, DM, DM, 1}; SO S; S.init(TT, DM, G, bx); pg8::EpiDown E{F.X, F.X, F.B2, F.SS, 1.0f}; pg8::gemm_phase<pg8::EpiDown, SO, true, true>(F.lds, g, S, E, tid); }
        else if constexpr (k == 9) { pg8::Gemm g{F.B2, (const bf16_t*)(ws + WS_W + W_GU2), TT, 2 * FF, DM, 1}; SO S; S.init(TT, 2 * FF, G, bx); pg8::EpiGU E{F.HID, F.SS}; pg8::gemm_phase<pg8::EpiGU, SO, true, true>(F.lds, g, S, E, tid); }
        else if constexpr (k == 10) { pg8::Gemm g{F.HID, (const bf16_t*)(ws + WS_W + W_D2), TT, DM, FF, 1}; SO S; S.init(TT, DM, G, bx); pg8::EpiDown E{F.X, F.X, F.B1, F.SS, 0.5f}; pg8::gemm_phase<pg8::EpiDown, SO, true, true>(F.lds, g, S, E, tid); }
        else { if constexpr (l == 0) conv_first_half(F, 1); else final_norm(F); }
    }
}
#ifndef REPMASK
#define REPMASK 0
#endif
#define SEAM(k_) do { if ((k_) == 0) { __syncthreads(); cg::this_grid().sync(); } else xcd_barrier(xbar); } while (0)
#define PHASE(k) if (ph_lo <= (k) && (k) < ph_hi) { run_phase<(k)>(wave_s, lds_raw, xbar); \
    if ((k) >= 1 && ((REPMASK >> (((k) - 1) % 12)) & 1)) { SEAM(k); run_phase<(k), REP_PART>(wave_s, lds_raw, xbar); } \
    if ((k) + 1 < ph_hi) SEAM(k); }
__global__ void __launch_bounds__(NTHR, 2) mk_fwd(Args args) {
    extern __shared__ __attribute__((aligned(16))) unsigned char lds_raw[];
    const int ph_lo = args.ph_lo, ph_hi = args.ph_hi;
    volatile LAS unsigned* xst = (volatile LAS unsigned*)((LAS unsigned char*)lds_raw + (LDS_BYTES - 64));
    if (threadIdx.x == 0) { xst[0] = 0u; xst[1] = 0u; }
    __syncthreads();
    const XcdBarrier xbar = xcd_barrier_post((unsigned*)(args.ws + WS_CTL), xst);
    const int wave_s = __builtin_amdgcn_readfirstlane((int)threadIdx.x >> 6);
    PHASE(0) PHASE(1) PHASE(2) PHASE(3) PHASE(4) PHASE(5) PHASE(6) PHASE(7) PHASE(8) PHASE(9) PHASE(10) PHASE(11) PHASE(12)
    PHASE(13) PHASE(14) PHASE(15) PHASE(16) PHASE(17) PHASE(18) PHASE(19) PHASE(20) PHASE(21) PHASE(22) PHASE(23) PHASE(24)
}

extern "C" void kernel_launch(void* const* d_in, const int* in_sizes, int n_in, void* d_out, int out_size, void* d_ws, size_t ws_size, hipStream_t stream) {
    static int grid = 0;
    if (grid == 0) {
        if (n_in != 41 || out_size != TT * DM || ws_size < WS_END) { fprintf(stderr, "kernel_launch: unexpected shapes (n_in %d out %d ws %zu)\n", n_in, out_size, ws_size); grid = -1; return; }
        int dev = 0, cus = 0, per_cu = 0;
        (void)hipGetDevice(&dev); (void)hipDeviceGetAttribute(&cus, hipDeviceAttributeMultiprocessorCount, dev);
        if (hipFuncSetAttribute((const void*)mk_fwd, hipFuncAttributeMaxDynamicSharedMemorySize, LDS_BYTES) != hipSuccess) { fprintf(stderr, "kernel_launch: hipFuncSetAttribute failed\n"); grid = -1; return; }
        if (hipOccupancyMaxActiveBlocksPerMultiprocessor(&per_cu, (const void*)mk_fwd, NTHR, LDS_BYTES) != hipSuccess || per_cu < 1) { fprintf(stderr, "kernel_launch: occupancy query says %d\n", per_cu); per_cu = 1; }
        (void)hipGetLastError();
        grid = cus * (per_cu >= 1 ? 1 : 1);
        if (grid < 64) { fprintf(stderr, "kernel_launch: grid %d too small\n", grid); }
    }
    if (grid < 0) return;
    if (hipMemsetAsync((char*)d_ws + WS_CTL, 0, CTL_ZERO_BYTES, stream) != hipSuccess) { fprintf(stderr, "kernel_launch: hipMemsetAsync failed\n"); return; }
    Args a{};
    for (int i = 0; i < 41; ++i) a.in[i] = (const float*)d_in[i];
    a.out = (float*)d_out; a.ws = (unsigned char*)d_ws;
#if ONE_LAUNCH
    a.ph_lo = 0; a.ph_hi = NPH;
    void* kargs[] = {&a};
    hipError_t e = hipLaunchCooperativeKernel((const void*)mk_fwd, dim3(grid), dim3(NTHR), kargs, LDS_BYTES, stream);
    if (e != hipSuccess) fprintf(stderr, "cooperative launch failed: %s (grid %d)\n", hipGetErrorString(e), grid);
#else
    for (int ph = 0; ph < NPH; ++ph) { a.ph_lo = ph; a.ph_hi = ph + 1; hipLaunchKernelGGL(mk_fwd, dim3(grid), dim3(NTHR), LDS_BYTES, stream, a); }
#endif
}
```

```cpp
#include <hip/hip_runtime.h>
#include <hip/hip_cooperative_groups.h>
#include <cstdio>
#include <cstdint>
#include <cstddef>
namespace cg = cooperative_groups;
namespace pg8 {
#define PG8_LAS __attribute__((address_space(3)))
typedef unsigned short bf16_t;
typedef short bf16x8 __attribute__((ext_vector_type(8)));
typedef float f32x4 __attribute__((ext_vector_type(4)));
typedef unsigned u32x4 __attribute__((ext_vector_type(4)));
constexpr int BM = 256, BK = 64, HALF = 128, HTB = HALF * BK * 2  , STAGE_BYTES = 8 * HTB, NXCD = 8, WGM = 8;

__host__ __device__ __forceinline__ int lds_byte(int r, int c) { const int st = (r >> 4) * 2 + (c >> 5), rr = r & 15, cc = c & 31, ob = rr * 64 + cc * 2; return st * 1024 + (ob ^ (((ob >> 9) & 1) << 5)); }
__host__ __device__ __forceinline__ void stage_rc(int b, int& R, int& C) { const int st = b / 1024, sb = b % 1024, swz = sb ^ (((sb >> 9) & 1) << 5); R = (st >> 1) * 16 + swz / 64; C = (st & 1) * 32 + (swz % 64) / 2; }
__host__ __device__ __forceinline__ int perm32(int rho) { const int n = rho >> 4, i = rho & 15; return 8 * (i >> 2) + 4 * n + (i & 3); }

struct Unit { int pm, pn, g; };
struct Gemm { const bf16_t* A; const bf16_t* Bt; int M, N, K, nseg; };

struct StaticOrder {
    int nM, nN, nwg, G, c;
    __host__ __device__ void init(int M, int N, int G_, int c_) { nM = M / BM; nN = N / BM; nwg = nM * nN; G = G_; c = c_; }
    __host__ __device__ bool next(int i, Unit& u) const {
        const long L = (long)i * G + c; if (L >= nwg) return false;
        int wgid = (int)L; { const int q = nwg / NXCD, r = nwg % NXCD, xcd = wgid % NXCD, off = wgid / NXCD; wgid = (xcd < r ? xcd * (q + 1) : r * (q + 1) + (xcd - r) * q) + off; }
        const int nig = WGM * nN, gid = wgid / nig, fm = gid * WGM, gsz = (nM - fm) < WGM ? (nM - fm) : WGM;
        u.pm = fm + ((wgid % nig) % gsz); u.pn = (wgid % nig) / gsz; u.g = 0; return true;
    }
    __device__ __forceinline__ void a_ready(const Unit&) const {}
    __device__ __forceinline__ void done(const Unit&) const {}
};


struct SegOrder4 {
    StaticOrder so;
    __host__ __device__ bool next(int i, Unit& u) const { if (!so.next(i >> 2, u)) return false; u.g = i & 3; return true; }
    __device__ __forceinline__ void a_ready(const Unit&) const {}
    __device__ __forceinline__ void done(const Unit&) const {}
};

typedef _Float16 h16;
typedef _Float16 h16x4 __attribute__((ext_vector_type(4)));
typedef unsigned u32x2 __attribute__((ext_vector_type(2)));
__device__ __forceinline__ unsigned cvt_pk_bf16(float lo, float hi) { unsigned r; asm volatile("v_cvt_pk_bf16_f32 %0, %1, %2" : "=v"(r) : "v"(lo), "v"(hi)); return r; }
__device__ __forceinline__ u32x2 pack_bf16x4(f32x4 v) { u32x2 w; w.x = cvt_pk_bf16(v[0], v[1]); w.y = cvt_pk_bf16(v[2], v[3]); return w; }
__device__ __forceinline__ h16x4 pack_h16x4(f32x4 v) { h16x4 w; w[0] = (h16)v[0]; w[1] = (h16)v[1]; w[2] = (h16)v[2]; w[3] = (h16)v[3]; return w; }
__device__ __forceinline__ float fast_sigmoid(float x) { return __builtin_amdgcn_rcpf(1.0f + __expf(-x)); }
__device__ __forceinline__ float row_rstd(const float* SS, int row) {
    const f32x4* p = (const f32x4*)(SS + (size_t)row * 16);
    const f32x4 a = p[0], b = p[1], c = p[2], d = p[3];
    const float s = ((a[0] + a[1]) + (a[2] + a[3])) + ((b[0] + b[1]) + (b[2] + b[3])) + ((c[0] + c[1]) + (c[2] + c[3])) + ((d[0] + d[1]) + (d[2] + d[3]));
    return rsqrtf(s * (1.0f / 1024.0f) + 1e-6f);
}

__device__ __forceinline__ void rows_rstd(const float* SS, int row0, int fq, float (&rs)[8]) {
    f32x4 q[8];
#pragma unroll
    for (int sl = 0; sl < 8; ++sl) q[sl] = *(const f32x4*)(SS + (size_t)(row0 + (sl >> 2) * HALF + (sl & 3) * 16) * 16 + 4 * fq);
#pragma unroll
    for (int sl = 0; sl < 8; ++sl) { float s = (q[sl][0] + q[sl][1]) + (q[sl][2] + q[sl][3]); s += __shfl_xor(s, 16); s += __shfl_xor(s, 32); rs[sl] = rsqrtf(s * (1.0f / 1024.0f) + 1e-6f); }
}

struct EpiGU {
    static constexpr bool PERM = true, KSEG = false;
    bf16_t* hid; const float* SS;
    __device__ __forceinline__ void operator()(const f32x4 (&acc)[2][2][4][2], const Unit& u, int wr, int wc, int fr, int fq) const {
        int row0 = u.pm * BM + wr * 64 + fr; asm volatile("" : "+v"(row0)); const int j0 = u.pn * 128 + wc * 16 + fq * 4;
        float rsv[8]; rows_rstd(SS, row0, fq, rsv);
#pragma unroll
        for (int ai = 0; ai < 2; ++ai)
#pragma unroll
            for (int m = 0; m < 4; ++m) { const int row = row0 + ai * HALF + m * 16; const float rs = rsv[ai * 4 + m];
#pragma unroll
                for (int bj = 0; bj < 2; ++bj) { const f32x4 g = acc[ai][bj][m][0] * rs, up = acc[ai][bj][m][1] * rs; f32x4 h;
#pragma unroll
                    for (int i = 0; i < 4; ++i) h[i] = g[i] * fast_sigmoid(g[i]) * up[i];
                    *(u32x2*)(hid + (size_t)row * 2816 + j0 + bj * 64) = pack_bf16x4(h); } }
    }
};
struct EpiDown {
    static constexpr bool PERM = false, KSEG = false;
    const float* res; float* X; bf16_t* xb; float* SS; float alpha;
    __device__ __forceinline__ void operator()(const f32x4 (&acc)[2][2][4][2], const Unit& u, int wr, int wc, int fr, int fq) const {
        int row0 = u.pm * BM + wr * 64 + fr; asm volatile("" : "+v"(row0)); const int c0 = u.pn * BM + wc * 32 + fq * 4;
#pragma unroll
        for (int ai = 0; ai < 2; ++ai) {
            f32x4 rv[4][2][2];
#pragma unroll
            for (int m = 0; m < 4; ++m)
#pragma unroll
                for (int bj = 0; bj < 2; ++bj)
#pragma unroll
                    for (int n = 0; n < 2; ++n) rv[m][bj][n] = *(const f32x4*)(res + (size_t)(row0 + ai * HALF + m * 16) * 1024 + c0 + bj * HALF + n * 16);
#pragma unroll
            for (int m = 0; m < 4; ++m) { const int row = row0 + ai * HALF + m * 16; float ss = 0.f;
#pragma unroll
                for (int bj = 0; bj < 2; ++bj)
#pragma unroll
                    for (int n = 0; n < 2; ++n) { const size_t off = (size_t)row * 1024 + c0 + bj * HALF + n * 16;
                        const f32x4 o = rv[m][bj][n] + acc[ai][bj][m][n] * alpha;
                        *(f32x4*)(X + off) = o; *(u32x2*)(xb + off) = pack_bf16x4(o);
                        ss += (o[0] * o[0] + o[1] * o[1]) + (o[2] * o[2] + o[3] * o[3]); }
                ss += __shfl_xor(ss, 16); ss += __shfl_xor(ss, 32);
                if (fq == 0) SS[(size_t)row * 16 + u.pn * 4 + wc] = ss; }
            asm volatile("" ::: "memory"); }
    }
};
struct EpiInA {
    static constexpr bool PERM = false, KSEG = false;
    h16* U5; h16* PP; h16* L16; const float* SS;
    __device__ __forceinline__ void operator()(const f32x4 (&acc)[2][2][4][2], const Unit& u, int wr, int wc, int fr, int fq) const {
        int row0 = u.pm * BM + wr * 64 + fr; asm volatile("" : "+v"(row0)); const int cl = wc * 32 + fq * 4;
        float rsv[8]; rows_rstd(SS, row0, fq, rsv);
        h16* base; int ld, cb;
        if (u.pn == 0) { base = U5; ld = 256; cb = 0; } else if (u.pn < 8) { base = PP; ld = 1792; cb = (u.pn - 1) * 256; } else { base = L16; ld = 512; cb = (u.pn - 8) * 256; }
#pragma unroll
        for (int ai = 0; ai < 2; ++ai)
#pragma unroll
            for (int m = 0; m < 4; ++m) { const int row = row0 + ai * HALF + m * 16; const float rs = rsv[ai * 4 + m];
#pragma unroll
                for (int bj = 0; bj < 2; ++bj)
#pragma unroll
                    for (int n = 0; n < 2; ++n) *(h16x4*)(base + (size_t)row * ld + cb + cl + bj * HALF + n * 16) = pack_h16x4(acc[ai][bj][m][n] * rs); }
    }
};
struct EpiGate {
    static constexpr bool PERM = false, KSEG = false;
    h16* R; const float* SS;
    __device__ __forceinline__ void operator()(const f32x4 (&acc)[2][2][4][2], const Unit& u, int wr, int wc, int fr, int fq) const {
        float rsv[8]; int row0 = u.pm * BM + wr * 64 + fr; asm volatile("" : "+v"(row0)); rows_rstd(SS, row0, fq, rsv); const int d0 = 256 * (u.pn >> 2) + 128 * ((u.pn >> 1) & 1) + 16 * (u.pn & 1) + 32 * wc + 4 * fq;
#pragma unroll
        for (int ai = 0; ai < 2; ++ai)
#pragma unroll
            for (int m = 0; m < 4; ++m) { const int row = row0 + ai * HALF + m * 16; const float rs = rsv[ai * 4 + m];
                f32x4 e[4];
#pragma unroll
                for (int g = 0; g < 4; ++g)
#pragma unroll
                    for (int i = 0; i < 4; ++i) e[g][i] = 1.0f + __expf(-fminf(fmaxf(acc[ai][g >> 1][m][g & 1][i] * rs, -10.f), 30.f));
                f32x4 r[4];
#pragma unroll
                for (int i = 0; i < 4; ++i) { const float i0 = __builtin_amdgcn_rcpf(e[0][i]), i1 = __builtin_amdgcn_rcpf(e[1][i]), i2 = __builtin_amdgcn_rcpf(e[2][i]), i3 = __builtin_amdgcn_rcpf(e[3][i]);
                    r[0][i] = e[1][i] * i0; r[1][i] = e[2][i] * i1; r[2][i] = e[3][i] * i2; r[3][i] = i3; }
#pragma unroll
                for (int g = 0; g < 4; ++g) *(h16x4*)(R + ((size_t)row * 4 + g) * 1024 + d0) = pack_h16x4(r[g]); }
    }
};
struct EpiBranch {
    static constexpr bool PERM = false, KSEG = true;
    const h16* R; bf16_t* out;
    __device__ __forceinline__ void operator()(f32x4 (&acc)[2][2][4][2], const Unit& u, int wr, int wc, int fr, int fq) const {
        unsigned q0 = (unsigned)(u.pm * BM + wr * 64 + fr) * 1024u + (unsigned)(u.pn * BM + wc * 32 + fq * 4); asm volatile("" : "+v"(q0));
        const unsigned r0 = (q0 - (q0 & 1023u)) * 4u + (unsigned)u.g * 1024u + (q0 & 1023u);
        const bool last = u.g == 3;
        h16x4 rr[2][4][2][2];
#pragma unroll
        for (int ai = 0; ai < 2; ++ai)
#pragma unroll
            for (int m = 0; m < 4; ++m)
#pragma unroll
                for (int bj = 0; bj < 2; ++bj)
#pragma unroll
                    for (int n = 0; n < 2; ++n) rr[ai][m][bj][n] = *(const h16x4*)(R + (r0 + (unsigned)((ai * HALF + m * 16) * 4096 + bj * HALF + n * 16)));
#pragma unroll
        for (int ai = 0; ai < 2; ++ai)
#pragma unroll
            for (int m = 0; m < 4; ++m) {
#pragma unroll
                for (int bj = 0; bj < 2; ++bj)
#pragma unroll
                    for (int n = 0; n < 2; ++n) { const unsigned off = q0 + (unsigned)((ai * HALF + m * 16) * 1024 + bj * HALF + n * 16);
                        const h16x4 r = rr[ai][m][bj][n];
                        f32x4 rf; rf[0] = (float)r[0]; rf[1] = (float)r[1]; rf[2] = (float)r[2]; rf[3] = (float)r[3];
                        acc[ai][bj][m][n] = acc[ai][bj][m][n] * rf;
                        if (last) *(u32x2*)(out + off) = pack_bf16x4(acc[ai][bj][m][n]); } }
    }
};
struct EpiGlu {
    static constexpr bool PERM = false, KSEG = false;
    const bf16_t* gl; bf16_t* ys;
    __device__ __forceinline__ void operator()(const f32x4 (&acc)[2][2][4][2], const Unit& u, int wr, int wc, int fr, int fq) const {
        int row0 = u.pm * BM + wr * 64 + fr; asm volatile("" : "+v"(row0)); const int c0 = wc * 32 + fq * 4;
        u32x2 gv[2][4][2][2];
#pragma unroll
        for (int ai = 0; ai < 2; ++ai)
#pragma unroll
            for (int m = 0; m < 4; ++m)
#pragma unroll
                for (int bj = 0; bj < 2; ++bj)
#pragma unroll
                    for (int n = 0; n < 2; ++n) gv[ai][m][bj][n] = *(const u32x2*)(gl + (size_t)(row0 + ai * HALF + m * 16) * 256 + c0 + bj * HALF + n * 16);
#pragma unroll
        for (int ai = 0; ai < 2; ++ai)
#pragma unroll
            for (int m = 0; m < 4; ++m) { const int row = row0 + ai * HALF + m * 16;
#pragma unroll
                for (int bj = 0; bj < 2; ++bj)
#pragma unroll
                    for (int n = 0; n < 2; ++n) { const int c = c0 + bj * HALF + n * 16; const u32x2 g2 = gv[ai][m][bj][n];
                        f32x4 g; g[0] = __uint_as_float(g2.x << 16); g[1] = __uint_as_float(g2.x & 0xffff0000u); g[2] = __uint_as_float(g2.y << 16); g[3] = __uint_as_float(g2.y & 0xffff0000u);
                        f32x4 o;
#pragma unroll
                        for (int i = 0; i < 4; ++i) o[i] = g[i] * fast_sigmoid(acc[ai][bj][m][n][i]);
                        *(u32x2*)(ys + (size_t)row * 1024 + c) = pack_bf16x4(o); } }
    }
};

template <class Epi, class Sched, bool ALIGN_EPI = false, bool SP2 = false>
__device__ __forceinline__ void gemm_phase(PG8_LAS unsigned char* lds, const Gemm g, const Sched& S, const Epi& E, const int tid) {
    const int wid = __builtin_amdgcn_readfirstlane(tid >> 6), lane = tid & 63, wr = wid >> 2, wc = wid & 3, fr = lane & 15, fq = lane >> 4;
    const int K = g.K, nt = K / BK / g.nseg; const size_t segb = (size_t)(K / g.nseg) * 2;
    unsigned voffA[2], voffB[2];
#pragma unroll
    for (int i = 0; i < 2; ++i) { int R, C; stage_rc(tid * 16 + i * 8192, R, C); const int Rb = Epi::PERM ? ((R & ~31) + perm32(R & 31)) : R;
        voffA[i] = (unsigned)(R * K + C) * 2u; voffB[i] = (unsigned)(Rb * K + C) * 2u; }
    const size_t kstep = (size_t)(BK * 2);
    const size_t hstep = (size_t)HALF * K * 2;
    const size_t tstep = 2 * hstep;
    const unsigned ldsw = (unsigned)wid * 1024u;
    const int aoff = lds_byte(wr * 64 + fr, fq * 8), boff = lds_byte(wc * 32 + fr, fq * 8);
#define PG8_SA(b, h) (((b) * 2 + (h)) * HTB)
#define PG8_SB(b, h) ((4 + (b) * 2 + (h)) * HTB)
#define PG8_STAGE(bufoff, gbase, voff) do { _Pragma("unroll") for (int _i = 0; _i < 2; ++_i) \
        __builtin_amdgcn_global_load_lds((const unsigned*)((const char*)(gbase) + (voff)[_i]), (PG8_LAS unsigned*)(lds + (bufoff) + ldsw + _i * 8192), 16, 0, 0); } while (0)
#define PG8_LDA(dst, b, h) do { _Pragma("unroll") for (int m = 0; m < 4; ++m) _Pragma("unroll") for (int k = 0; k < 2; ++k) dst[m][k] = *(const PG8_LAS bf16x8*)(lds + PG8_SA(b, h) + aoff + m * 2048 + k * 1024); } while (0)
#define PG8_LDB(dst, b, h) do { _Pragma("unroll") for (int n = 0; n < 2; ++n) _Pragma("unroll") for (int k = 0; k < 2; ++k) dst[n][k] = *(const PG8_LAS bf16x8*)(lds + PG8_SB(b, h) + boff + n * 2048 + k * 1024); } while (0)
#define PG8_MMA(ai, bj, At, Bt) do { __builtin_amdgcn_s_setprio(1); _Pragma("unroll") for (int m = 0; m < 4; ++m) _Pragma("unroll") for (int n = 0; n < 2; ++n) _Pragma("unroll") for (int k = 0; k < 2; ++k) \
        acc[ai][bj][m][n] = __builtin_amdgcn_mfma_f32_16x16x32_bf16(Bt[n][k], At[m][k], acc[ai][bj][m][n], 0, 0, 0); __builtin_amdgcn_s_setprio(0); } while (0)
#define PG8_WAIT_V(n) asm volatile("s_waitcnt vmcnt(" #n ")" ::: "memory")
#define PG8_WAIT_L(n) asm volatile("s_waitcnt lgkmcnt(" #n ")" ::: "memory")
#define PG8_BAR __builtin_amdgcn_s_barrier()
#define PG8_SCHED __builtin_amdgcn_sched_barrier(0)
    Unit cur, nxt; int ui = 0;
    if (!S.next(0, cur)) return;
    f32x4 acc[2][2][4][2];
#pragma unroll
    for (int a = 0; a < 2; ++a)
#pragma unroll
        for (int b = 0; b < 2; ++b)
#pragma unroll
            for (int m = 0; m < 4; ++m)
#pragma unroll
                for (int n = 0; n < 2; ++n) acc[a][b][m][n] = (f32x4){0.f, 0.f, 0.f, 0.f};
    bf16x8 At[4][2], B0[2][2], B1[2][2];
    const char* cA = (const char*)g.A + (size_t)cur.pm * tstep + (size_t)cur.g * segb; const char* cB = (const char*)g.Bt + (size_t)cur.pn * tstep + (size_t)cur.g * segb;
    S.a_ready(cur);
    if constexpr (SP2) {
        PG8_STAGE(PG8_SB(0, 0), cB, voffB); PG8_STAGE(PG8_SB(0, 1), cB + hstep, voffB); PG8_STAGE(PG8_SA(0, 0), cA, voffA); PG8_STAGE(PG8_SA(0, 1), cA + hstep, voffA);
        if (wr == 1) PG8_BAR;
        PG8_WAIT_V(2); PG8_BAR;
        PG8_STAGE(PG8_SB(1, 0), cB + kstep, voffB); PG8_STAGE(PG8_SA(1, 0), cA + kstep, voffA); PG8_STAGE(PG8_SB(1, 1), cB + hstep + kstep, voffB);
        PG8_WAIT_V(6); PG8_BAR;
    } else {
        PG8_STAGE(PG8_SB(0, 0), cB, voffB); PG8_STAGE(PG8_SA(0, 0), cA, voffA); PG8_STAGE(PG8_SB(0, 1), cB + hstep, voffB); PG8_STAGE(PG8_SA(0, 1), cA + hstep, voffA);
        if (wr == 1) PG8_BAR;
        PG8_WAIT_V(4); PG8_BAR;
        PG8_STAGE(PG8_SB(1, 0), cB + kstep, voffB); PG8_STAGE(PG8_SA(1, 0), cA + kstep, voffA); PG8_STAGE(PG8_SB(1, 1), cB + hstep + kstep, voffB);
        PG8_WAIT_V(6); PG8_BAR;
    }
    for (;;) {
        const bool has_next = S.next(ui + 1, nxt);
        const char* nA = has_next ? (const char*)g.A + (size_t)nxt.pm * tstep + (size_t)nxt.g * segb : cA; const char* nB = has_next ? (const char*)g.Bt + (size_t)nxt.pn * tstep + (size_t)nxt.g * segb : cB;
        for (int t = 0; t < nt; t += 2) {
            const bool last = (t == nt - 2);
            const char* a1 = cA + (size_t)(t + 1) * kstep;
            const char* a2 = last ? nA : cA + (size_t)(t + 2) * kstep; const char* b2 = last ? nB : cB + (size_t)(t + 2) * kstep;
            const char* a3 = a2 + kstep; const char* b3 = b2 + kstep;
            if (last && has_next) S.a_ready(nxt);
            if constexpr (SP2) {
            PG8_LDB(B0, 0, 0); PG8_LDB(B1, 0, 1); PG8_SCHED; PG8_LDA(At, 0, 0); PG8_STAGE(PG8_SA(1, 1), a1 + hstep, voffA);
            PG8_WAIT_V(8); PG8_WAIT_L(0); PG8_BAR; PG8_MMA(0, 0, At, B0); PG8_MMA(0, 1, At, B1); PG8_BAR; PG8_SCHED;
            PG8_LDA(At, 0, 1); PG8_STAGE(PG8_SB(0, 0), b2, voffB); PG8_STAGE(PG8_SB(0, 1), b2 + hstep, voffB); PG8_STAGE(PG8_SA(0, 0), a2, voffA);
            PG8_WAIT_V(8); PG8_WAIT_L(0); PG8_BAR; PG8_MMA(1, 0, At, B0); PG8_MMA(1, 1, At, B1); PG8_BAR; PG8_SCHED;
            PG8_LDB(B0, 1, 0); PG8_LDB(B1, 1, 1); PG8_SCHED; PG8_LDA(At, 1, 0); PG8_STAGE(PG8_SA(0, 1), a2 + hstep, voffA);
            PG8_WAIT_V(8); PG8_WAIT_L(0); PG8_BAR; PG8_MMA(0, 0, At, B0); PG8_MMA(0, 1, At, B1); PG8_BAR; PG8_SCHED;
            PG8_LDA(At, 1, 1); PG8_STAGE(PG8_SB(1, 0), b3, voffB); PG8_STAGE(PG8_SB(1, 1), b3 + hstep, voffB); PG8_STAGE(PG8_SA(1, 0), a3, voffA);
            PG8_WAIT_V(8); PG8_WAIT_L(0); PG8_BAR; PG8_MMA(1, 0, At, B0); PG8_MMA(1, 1, At, B1); PG8_BAR; PG8_SCHED;
            } else {
            PG8_LDB(B0, 0, 0); PG8_SCHED; PG8_LDA(At, 0, 0); PG8_STAGE(PG8_SA(1, 1), a1 + hstep, voffA);
            PG8_WAIT_L(8); PG8_BAR; PG8_WAIT_L(0); PG8_MMA(0, 0, At, B0); PG8_BAR; PG8_SCHED;
            PG8_LDB(B1, 0, 1); PG8_STAGE(PG8_SB(0, 0), b2, voffB);
            PG8_BAR; PG8_WAIT_L(0); PG8_MMA(0, 1, At, B1); PG8_BAR;
            PG8_LDA(At, 0, 1); PG8_STAGE(PG8_SA(0, 0), a2, voffA);
            PG8_BAR; PG8_WAIT_L(0); PG8_MMA(1, 0, At, B0); PG8_BAR; PG8_SCHED;
            PG8_STAGE(PG8_SB(0, 1), b2 + hstep, voffB);
            PG8_WAIT_V(6); PG8_BAR; PG8_MMA(1, 1, At, B1); PG8_BAR;
            PG8_LDB(B0, 1, 0); PG8_SCHED; PG8_LDA(At, 1, 0); PG8_STAGE(PG8_SA(0, 1), a2 + hstep, voffA);
            PG8_WAIT_L(8); PG8_BAR; PG8_WAIT_L(0); PG8_MMA(0, 0, At, B0); PG8_BAR; PG8_SCHED;
            PG8_LDB(B1, 1, 1); PG8_STAGE(PG8_SB(1, 0), b3, voffB);
            PG8_BAR; PG8_WAIT_L(0); PG8_MMA(0, 1, At, B1); PG8_BAR;
            PG8_LDA(At, 1, 1); PG8_STAGE(PG8_SA(1, 0), a3, voffA);
            PG8_BAR; PG8_WAIT_L(0); PG8_MMA(1, 0, At, B0); PG8_BAR; PG8_SCHED;
            PG8_STAGE(PG8_SB(1, 1), b3 + hstep, voffB);
            PG8_WAIT_V(6); PG8_BAR; PG8_MMA(1, 1, At, B1); PG8_BAR;
            }
        }
        if constexpr (ALIGN_EPI) { if (wr == 0) PG8_BAR; }
        E(acc, cur, wr, wc, fr, fq); S.done(cur);
        if (!has_next) break;
        if (!(Epi::KSEG && nxt.g != 0))
#pragma unroll
        for (int a = 0; a < 2; ++a)
#pragma unroll
            for (int b = 0; b < 2; ++b)
#pragma unroll
                for (int m = 0; m < 4; ++m)
#pragma unroll
                    for (int n = 0; n < 2; ++n) acc[a][b][m][n] = (f32x4){0.f, 0.f, 0.f, 0.f};
        cur = nxt; cA = nA; cB = nB; ++ui;
        if constexpr (ALIGN_EPI) { if (wr == 1) PG8_BAR; }
    }
    PG8_WAIT_V(0);
    if constexpr (!ALIGN_EPI) { if (wr == 0) PG8_BAR; }
    PG8_BAR;
#undef PG8_SA
#undef PG8_SB
#undef PG8_STAGE
#undef PG8_LDA
#undef PG8_LDB
#undef PG8_MMA
#undef PG8_WAIT_V
#undef PG8_WAIT_L
#undef PG8_BAR
#undef PG8_SCHED
}
}

#define LAS __attribute__((address_space(3)))
typedef unsigned short bf16_t;
typedef _Float16 h16;
typedef _Float16 h16x4 __attribute__((ext_vector_type(4)));
typedef _Float16 h16x8 __attribute__((ext_vector_type(8)));
typedef float f32x4 __attribute__((ext_vector_type(4)));
typedef float f32x2 __attribute__((ext_vector_type(2)));
typedef unsigned u32x4 __attribute__((ext_vector_type(4)));
typedef unsigned u32x2 __attribute__((ext_vector_type(2)));

#ifndef ONE_LAUNCH
#define ONE_LAUNCH 1
#endif
constexpr int NWAVES = 8, NTHR = 512;
constexpr int TT = 16384, SEQ = 8192, DM = 1024, FF = 2816, MW = 256, INW = 6144;
constexpr int LDS_BYTES = 147456;
constexpr size_t MiB = 1u << 20;
constexpr size_t WS_CTL = 0, CTL_ZERO_BYTES = 16384, WS_SS = 1 * MiB, WS_E = 2 * MiB, WS_W = 4 * MiB, WS_B1 = 34 * MiB, WS_B2 = 66 * MiB, WS_Z = 98 * MiB, WS_END = 262 * MiB;
constexpr size_t W_GU1 = 0, W_D1 = W_GU1 + (size_t)2 * FF * DM * 2, W_INA = W_D1 + (size_t)DM * FF * 2;
constexpr size_t W_ING = 0, W_BR = W_ING + (size_t)4096 * DM * 2, W_O = W_BR + (size_t)DM * DM * 2, W_GU2 = W_O + (size_t)DM * DM * 2, W_D2 = W_GU2 + (size_t)2 * FF * DM * 2, W_GLU = W_D2 + (size_t)DM * FF * 2, W_END2 = W_GLU + 256 * 256 * 2;
constexpr size_t W_L2 = 23 * MiB;
static_assert(W_END2 <= 30 * MiB && W_INA + (size_t)2560 * DM * 2 <= 30 * MiB, "W region");
constexpr size_t Z_RW = 0, Z_G16 = 56 * MiB, Z_U5 = 64 * MiB, Z_L16 = 72 * MiB, Z_PP = 88 * MiB, Z_O = 72 * MiB, Z_GL = 144 * MiB, Z_PB = 152 * MiB, Z_LB = 156 * MiB, Z_SB = 160 * MiB;
constexpr size_t Z_HID = 0, Z_R = 0;
static_assert((size_t)TT * 4 * 896 <= 56 * MiB && (size_t)TT * 1792 * 2 <= 56 * MiB && (size_t)TT * FF * 2 <= 144 * MiB && (size_t)TT * 4096 * 2 <= 144 * MiB, "Z region");

typedef const float* cfp_t;
typedef const __attribute__((address_space(4))) cfp_t* in_t;
struct Args { const float* in[41]; float* out; unsigned char* ws; int ph_lo, ph_hi; };

struct Frame {
    LAS unsigned char* lds;
    int tid, lane, wave, G, bx;
    in_t in;
    float* X; unsigned char* ws;
    float* SS; float* E;
    bf16_t *B1, *B2, *HID, *GL;
    h16 *U5, *PP, *L16, *G16, *R;
    float* O; unsigned char* RW;
    float *PB, *LB, *SB;
};

__device__ __forceinline__ unsigned f2bf(float f) { unsigned u = __builtin_bit_cast(unsigned, f); return (u + 0x7fffu + ((u >> 16) & 1u)) >> 16; }
__device__ __forceinline__ unsigned pk2(float lo, float hi) { return f2bf(lo) | (f2bf(hi) << 16); }
#define LDS_WAIT() asm volatile("s_waitcnt lgkmcnt(0)" ::: "memory")
template <int CTRL> __device__ __forceinline__ float dppx(float x) { return __builtin_bit_cast(float, __builtin_amdgcn_update_dpp(0, __builtin_bit_cast(int, x), CTRL, 0xf, 0xf, true)); }
__device__ __forceinline__ float allreduce16(float x) { x += dppx<0xB1>(x); x += dppx<0x4E>(x); x += dppx<0x141>(x); x += dppx<0x140>(x); return x; }
__device__ __forceinline__ float wave_sum(float x) { x = allreduce16(x); x += __shfl_xor(x, 16); x += __shfl_xor(x, 32); return x; }
__device__ __forceinline__ float sigmoidf_(float x) { return __builtin_amdgcn_rcpf(1.0f + __expf(-x)); }

__device__ __forceinline__ int tr_rowmap(int mode, int j, int row0) {
    if (mode == 0) return row0 + j;
    if (mode == 1) return 8 * (j >> 2) + (j & 3);
    if (mode == 2) return 8 * (j >> 2) + 4 + (j & 3);
    const int g = j >> 10, d = j & 1023;
    const int pn = 4 * (d >> 8) + 2 * ((d >> 7) & 1) + ((d >> 4) & 1);
    return 256 * pn + 128 * (g >> 1) + 32 * ((d >> 5) & 3) + 16 * (g & 1) + 4 * ((d >> 2) & 3) + (d & 3);
}
__device__ __forceinline__ void tr_item(const float* W, int ldw, int K, int N, bf16_t* WT, int mode, int row0, const float* s1, const float* s2, int smode, LAS float* scr, int item, int lane) {
    const int nblk = N / 32, kb = item / nblk, nb = item % nblk, k0 = 64 * kb, n0 = 32 * nb;
#pragma unroll
    for (int i = 0; i < 32; ++i) { const int kk = 2 * i + (lane >> 5); const int k = k0 + kk; float sc = 1.0f;
        if (s1) sc = s1[k];
        if (smode == 1) sc *= s2[k]; else if (smode == 2) sc *= (1.0f - s2[k]);
        scr[kk * 33 + (lane & 31)] = W[(size_t)k * ldw + n0 + (lane & 31)] * sc; }
    LDS_WAIT(); asm volatile("" ::: "memory");
    const int c = lane & 7;
#pragma unroll
    for (int j = 0; j < 4; ++j) { const int n = (lane >> 3) + 8 * j; const LAS float* s = scr + (8 * c) * 33 + n;
        u32x4 o; o.x = pk2(s[0 * 33], s[1 * 33]); o.y = pk2(s[2 * 33], s[3 * 33]); o.z = pk2(s[4 * 33], s[5 * 33]); o.w = pk2(s[6 * 33], s[7 * 33]);
        *(u32x4*)(WT + (size_t)tr_rowmap(mode, n0 + n, row0) * K + k0 + 8 * c) = o; }
    LDS_WAIT(); asm volatile("" ::: "memory");
}
#define TRJ(W_, ldw_, K_, N_, dst_, mode_, row0_, s1_, s2_, smode_) { const int ni_ = ((K_) / 64) * ((N_) / 32); if (r >= 0 && r < ni_) tr_item(W_, ldw_, K_, N_, dst_, mode_, row0_, s1_, s2_, smode_, scr, r, F.lane); r -= ni_; }
__device__ __forceinline__ void conv_first_half(Frame& F, int l) {
    LAS float* scr = (LAS float*)(F.lds + F.wave * 16384);
    const int gw = F.bx * NWAVES + F.wave, NGW = F.G * NWAVES;
    unsigned char* wb = F.ws + WS_W;
    const float* n1 = F.in[1] + (size_t)l * DM; const float* nm = F.in[5] + (size_t)l * DM; const float* mu = F.in[19] + (size_t)l * 3 * DM;
    const float* w1 = F.in[21] + (size_t)l * DM * 64; const float* a1 = F.in[24] + (size_t)l * DM * 64; const float* g1 = F.in[26] + (size_t)l * DM * 128;
    bf16_t* ina = (bf16_t*)(wb + W_INA);
    for (int it = gw;; it += NGW) { int r = it;
        TRJ(F.in[2] + (size_t)l * DM * FF, FF, DM, FF, (bf16_t*)(wb + W_GU1), 1, 0, n1, nullptr, 0)
        TRJ(F.in[3] + (size_t)l * DM * FF, FF, DM, FF, (bf16_t*)(wb + W_GU1), 2, 0, n1, nullptr, 0)
        TRJ(F.in[4] + (size_t)l * FF * DM, DM, FF, DM, (bf16_t*)(wb + W_D1), 0, 0, nullptr, nullptr, 0)
        TRJ(F.in[6] + (size_t)l * DM * INW, INW, DM, 2048, ina, 0, 0, nm, nullptr, 0)
        TRJ(w1, 64, DM, 64, ina, 0, 2048, nm, mu, 2)
        TRJ(a1, 64, DM, 64, ina, 0, 2112, nm, mu + DM, 2)
        TRJ(g1, 128, DM, 128, ina, 0, 2176, nm, mu + 2 * DM, 2)
        TRJ(w1, 64, DM, 64, ina, 0, 2304, nm, mu, 1)
        TRJ(a1, 64, DM, 64, ina, 0, 2368, nm, mu + DM, 1)
        TRJ(g1, 128, DM, 128, ina, 0, 2432, nm, mu + 2 * DM, 1)
        TRJ(F.in[22] + (size_t)l * 64 * 256, 256, 64, 256, (bf16_t*)(wb + W_L2), 0, 0, nullptr, nullptr, 0)
        TRJ(F.in[25] + (size_t)l * 64 * 256, 256, 64, 256, (bf16_t*)(wb + W_L2) + 256 * 64, 0, 0, nullptr, nullptr, 0)
        TRJ(F.in[27] + (size_t)l * 128 * 256, 256, 128, 256, (bf16_t*)(wb + W_L2) + 2 * 256 * 64, 0, 0, nullptr, nullptr, 0)
        TRJ(F.in[16] + ((size_t)l * 4 + 0) * 4096, 64, 64, 64, (bf16_t*)(wb + W_L2) + 4 * 256 * 64, 0, 0, nullptr, nullptr, 0)
        TRJ(F.in[16] + ((size_t)l * 4 + 1) * 4096, 64, 64, 64, (bf16_t*)(wb + W_L2) + 4 * 256 * 64, 0, 64, nullptr, nullptr, 0)
        TRJ(F.in[16] + ((size_t)l * 4 + 2) * 4096, 64, 64, 64, (bf16_t*)(wb + W_L2) + 4 * 256 * 64, 0, 128, nullptr, nullptr, 0)
        TRJ(F.in[16] + ((size_t)l * 4 + 3) * 4096, 64, 64, 64, (bf16_t*)(wb + W_L2) + 4 * 256 * 64, 0, 192, nullptr, nullptr, 0)
        if (r >= 0) break; }
}
__device__ __forceinline__ void conv_second_half(Frame& F, int l, int b0) {
    LAS float* scr = (LAS float*)(F.lds + F.wave * 16384);
    const int gw = (F.bx - b0) * NWAVES + F.wave, NGW = (F.G - b0) * NWAVES;
    unsigned char* wb = F.ws + WS_W;
    const float* nm = F.in[5] + (size_t)l * DM; const float* n2 = F.in[36] + (size_t)l * DM;
    for (int it = gw;; it += NGW) { int r = it;
        TRJ(F.in[6] + (size_t)l * DM * INW + 2048, INW, DM, 4096, (bf16_t*)(wb + W_ING), 3, 0, nm, nullptr, 0)
        TRJ(F.in[34] + (size_t)l * DM * DM, DM, DM, DM, (bf16_t*)(wb + W_BR), 0, 0, nullptr, nullptr, 0)
        TRJ(F.in[35] + (size_t)l * DM * DM, DM, DM, DM, (bf16_t*)(wb + W_O), 0, 0, nullptr, nullptr, 0)
        TRJ(F.in[37] + (size_t)l * DM * FF, FF, DM, FF, (bf16_t*)(wb + W_GU2), 1, 0, n2, nullptr, 0)
        TRJ(F.in[38] + (size_t)l * DM * FF, FF, DM, FF, (bf16_t*)(wb + W_GU2), 2, 0, n2, nullptr, 0)
        TRJ(F.in[39] + (size_t)l * FF * DM, DM, FF, DM, (bf16_t*)(wb + W_D2), 0, 0, nullptr, nullptr, 0)
        TRJ(F.in[15] + (size_t)l * 256 * 256, 256, 256, 256, (bf16_t*)(wb + W_GLU), 0, 0, nullptr, nullptr, 0)
        if (r >= 0) break; }
}
__device__ __forceinline__ void prep_x(Frame& F) {
    const int gw = F.bx * NWAVES + F.wave, NGW = F.G * NWAVES;
    const float* x = F.in[0];
    for (int m = gw; m < TT; m += NGW) {
        const f32x4* xr = (const f32x4*)(x + (size_t)m * DM) + F.lane; float s = 0.f;
        unsigned long long* o8 = (unsigned long long*)(F.B1 + (size_t)m * DM) + F.lane;
#pragma unroll
        for (int j = 0; j < 4; ++j) { const f32x4 v = xr[64 * j]; s += (v[0] * v[0] + v[1] * v[1]) + (v[2] * v[2] + v[3] * v[3]);
            o8[64 * j] = (unsigned long long)pk2(v[0], v[1]) | ((unsigned long long)pk2(v[2], v[3]) << 32); }
        s += __shfl_xor(s, 1); s += __shfl_xor(s, 2);
        if ((F.lane & 3) == 0) F.SS[(size_t)m * 16 + (F.lane >> 2)] = s;
    }
}
__device__ __forceinline__ void final_norm(Frame& F) {
    const int gw = F.bx * NWAVES + F.wave, NGW = F.G * NWAVES;
    const f32x4* gn = (const f32x4*)F.in[40] + F.lane;
    for (int m = gw; m < TT; m += NGW) {
        const float rs = pg8::row_rstd(F.SS, m);
        f32x4* xr = (f32x4*)(F.X + (size_t)m * DM) + F.lane;
#pragma unroll
        for (int j = 0; j < 4; ++j) { const f32x4 v = xr[64 * j]; xr[64 * j] = v * rs * gn[64 * j]; }
    }
}

struct S5Par { float ar, ai; float bbr[16], bbi[16]; };
__device__ __forceinline__ void s5_params(Frame& F, int l, int g, int p, S5Par& P) {
    asm volatile("" : "+v"(p));
    const float lr = F.in[7][((size_t)l * 16 + g) * 64 + p], li = F.in[8][((size_t)l * 16 + g) * 64 + p], dt = expf(F.in[9][l * 16 + g]);
    const float mag = expf(lr * dt); P.ar = mag * cosf(li * dt); P.ai = mag * sinf(li * dt);
    const float inv = 1.0f / (lr * lr + li * li); const float qr = lr * inv, qi = -li * inv;
    const float cr = (P.ar - 1.0f) * qr - P.ai * qi, ci = (P.ar - 1.0f) * qi + P.ai * qr;
    const f32x4* br = (const f32x4*)(F.in[10] + (((size_t)l * 16 + g) * 64 + p) * 16); const f32x4* bi = (const f32x4*)(F.in[11] + (((size_t)l * 16 + g) * 64 + p) * 16);
#pragma unroll
    for (int q = 0; q < 4; ++q) { const f32x4 a = br[q], b = bi[q];
#pragma unroll
        for (int i = 0; i < 4; ++i) { P.bbr[4 * q + i] = cr * a[i] - ci * b[i]; P.bbi[4 * q + i] = cr * b[i] + ci * a[i]; } }
}
__device__ __forceinline__ void s5_step(const S5Par& P, const LAS float* urow, float& hr, float& hi) {
    const LAS f32x4* u4 = (const LAS f32x4*)urow; float bur = 0.f, bui = 0.f;
#pragma unroll
    for (int q = 0; q < 4; ++q) { const f32x4 u = u4[q];
#pragma unroll
        for (int i = 0; i < 4; ++i) { bur += P.bbr[4 * q + i] * u[i]; bui += P.bbi[4 * q + i] * u[i]; } }
    const float nr = P.ar * hr - P.ai * hi + bur, ni = P.ar * hi + P.ai * hr + bui; hr = nr; hi = ni;
}
__device__ __forceinline__ void load_u5_tile(Frame& F, int t0, LAS float* ubuf) {
    for (int i = F.tid; i < 64 * 64; i += NTHR) { const int t = i >> 6, q = i & 63; const h16x4 v = *(const h16x4*)(F.U5 + (size_t)(t0 + t) * 256 + 4 * q);
        f32x4 f; f[0] = (float)v[0]; f[1] = (float)v[1]; f[2] = (float)v[2]; f[3] = (float)v[3]; *(LAS f32x4*)(ubuf + t * 256 + 4 * q) = f; }
}


template <bool FIRST> __device__ __forceinline__ void mv32(LAS float* accp, float init, const LAS float* hb, const float* wsrc, int ldw) {
    float w[32];
    asm volatile("" : "+v"(wsrc));
#pragma unroll
    for (int j = 0; j < 32; ++j) w[j] = wsrc[(size_t)j * ldw];
#pragma unroll 2
    for (int tt = 0; tt < 32; ++tt) { const LAS f32x4* h4 = (const LAS f32x4*)(hb + tt * 256); float a = FIRST ? init : accp[tt * 256];
#pragma unroll
        for (int q = 0; q < 8; ++q) { const f32x4 v = h4[q]; a += v[0] * w[4 * q] + v[1] * w[4 * q + 1] + v[2] * w[4 * q + 2] + v[3] * w[4 * q + 3]; }
        accp[tt * 256] = a; }
}
template <int K> __device__ __forceinline__ void lora_mfma(const LAS unsigned short* hb16, int kofs, const bf16_t* Wt, LAS float* outb, int wave, int lane) {
    typedef short bf16x8_t __attribute__((ext_vector_type(8)));
    const int r16 = lane & 15, quad = lane >> 4;
    f32x4 acc[4][2];
#pragma unroll
    for (int rt = 0; rt < 4; ++rt)
#pragma unroll
        for (int ct = 0; ct < 2; ++ct) acc[rt][ct] = (f32x4){0.f, 0.f, 0.f, 0.f};
    bf16x8_t bfr[K / 32][2];
#pragma unroll
    for (int ks = 0; ks < K / 32; ++ks)
#pragma unroll
        for (int ct = 0; ct < 2; ++ct) bfr[ks][ct] = *(const bf16x8_t*)(Wt + (size_t)(wave * 32 + ct * 16 + r16) * K + ks * 32 + quad * 8);
#pragma unroll
    for (int ks = 0; ks < K / 32; ++ks)
#pragma unroll
        for (int rt = 0; rt < 4; ++rt) { const bf16x8_t a = *(const LAS bf16x8_t*)(hb16 + (rt * 16 + r16) * 264 + kofs + ks * 32 + quad * 8);
#pragma unroll
            for (int ct = 0; ct < 2; ++ct) acc[rt][ct] = __builtin_amdgcn_mfma_f32_16x16x32_bf16(a, bfr[ks][ct], acc[rt][ct], 0, 0, 0); }
#pragma unroll
    for (int rt = 0; rt < 4; ++rt)
#pragma unroll
        for (int ct = 0; ct < 2; ++ct)
#pragma unroll
            for (int j = 0; j < 4; ++j) outb[(rt * 16 + quad * 4 + j) * 256 + wave * 32 + ct * 16 + r16] = acc[rt][ct][j];
}
__device__ __forceinline__ void m1_phase(Frame& F, int l) {
    LAS float* ubuf = (LAS float*)F.lds;
    LAS float* pl = (LAS float*)(F.lds + 65536);
    const int tid = F.tid, lane = F.lane, wave = F.wave;
    const int ch = tid & 255, half = tid >> 8;
    for (int c = F.bx; c < TT / 64; c += F.G) {
        const int t0 = c * 64, tb = t0 + half * 32, sb = tb & (SEQ - 1);
        load_u5_tile(F, t0, ubuf);
        __syncthreads();
#pragma unroll 1
        for (int gi = 0; gi < 2; ++gi) { const int g = wave + 8 * gi; S5Par P; s5_params(F, l, g, lane, P); float hr = 0.f, hi = 0.f;
#pragma unroll 2
            for (int j = 0; j < 64; ++j) s5_step(P, ubuf + j * 256 + g * 16, hr, hi);
            *(f32x2*)(F.E + (((size_t)c * 16 + g) * 64 + lane) * 2) = (f32x2){hr, hi}; }
        __syncthreads();
        LAS float* accp = pl + half * 32 * 256 + ch;
        LAS unsigned short* hb16 = (LAS unsigned short*)F.lds;
        const bf16_t* l2w = (const bf16_t*)(F.ws + WS_W + W_L2);
        h16 la[32], lb[32];
#pragma unroll
        for (int tt = 0; tt < 32; ++tt) { const int t = tb + tt; la[tt] = F.L16[(size_t)t * 512 + ch]; lb[tt] = (sb + tt > 0) ? F.L16[(size_t)(t - 1) * 512 + 256 + ch] : (h16)0.f; }
#pragma unroll
        for (int tt = 0; tt < 32; ++tt) { float pre = (float)la[tt] + (float)lb[tt];
            float a = pre; if (ch < 64) a = 1.0f - 2.0f * __builtin_amdgcn_rcpf(1.0f + __expf(2.0f * pre)); else if (ch >= 128) a = sigmoidf_(pre);
            hb16[(half * 32 + tt) * 264 + ch] = (unsigned short)f2bf(a); }
        __syncthreads();
        const int hb = (t0 / SEQ) * 4 + (ch >> 6);
        unsigned char* rwb = F.RW + ((size_t)hb * SEQ + sb) * 896;
        const int cl = ch & 63;
        {
            lora_mfma<64>(hb16, 0, l2w, pl, wave, lane);
            __syncthreads();
            const float w0 = F.in[20][(size_t)l * 256 + ch];
#pragma unroll 2
            for (int tt = 0; tt < 32; ++tt) { const float z = -(accp[tt * 256] + w0); const float sp = fmaxf(z, 0.f) + __logf(1.0f + __expf(-fabsf(z)));
                const float wlog = -sp - 0.5f; const float dec = __expf(-__expf(wlog));
                *(float*)(rwb + (size_t)tt * 896 + cl * 4) = dec; }
        }
        {
            __syncthreads();
            lora_mfma<128>(hb16, 128, l2w + 2 * 256 * 64, pl, wave, lane);
            __syncthreads();
#pragma unroll 4
            for (int tt = 0; tt < 32; ++tt) F.G16[(size_t)(tb + tt) * 256 + ch] = (h16)accp[tt * 256];
        }
        {
            __syncthreads();
            lora_mfma<64>(hb16, 64, l2w + 256 * 64, pl, wave, lane);
            __syncthreads();
            const float a0 = F.in[23][(size_t)l * 256 + ch];
            const float mur = F.in[18][((size_t)l * 3 + 0) * 256 + ch], muk = F.in[18][((size_t)l * 3 + 1) * 256 + ch], muv = F.in[18][((size_t)l * 3 + 2) * 256 + ch];
            const float kkw = F.in[28][(size_t)l * 256 + ch], kaw = F.in[29][(size_t)l * 256 + ch];
            const h16* pp = F.PP + (size_t)tb * 1792 + 256 + ch;
            float rprev = 0.f, kprev = 0.f, vprev = 0.f;
            if (sb > 0) { rprev = (float)pp[-(ptrdiff_t)1792]; kprev = (float)pp[-(ptrdiff_t)1792 + 256]; vprev = (float)pp[-(ptrdiff_t)1792 + 512]; }
#pragma unroll 1
            for (int t16 = 0; t16 < 32; t16 += 16) {
                h16 rq[16], kq[16], vq[16];
#pragma unroll
                for (int tt = 0; tt < 16; ++tt) { const h16* q = pp + (size_t)(t16 + tt) * 1792; rq[tt] = q[0]; kq[tt] = q[256]; vq[tt] = q[512]; }
#pragma unroll
                for (int tt = 0; tt < 16; ++tt) { const float a = sigmoidf_(accp[(t16 + tt) * 256] + a0);
                    const float rp = (float)rq[tt], kp = (float)kq[tt], vp = (float)vq[tt];
                    const float r = rp + (rprev - rp) * mur, k = kp + (kprev - kp) * muk, v = vp + (vprev - vp) * muv;
                    rprev = rp; kprev = kp; vprev = vp;
                    const float kkv = k * kkw; const float kk = kkv * rsqrtf(fmaxf(wave_sum(kkv * kkv), 1e-24f));
                    const float kt = k * (1.0f + (a - 1.0f) * kaw); const float bb = kk * a;
                    h16* o = (h16*)(rwb + (size_t)(t16 + tt) * 896 + 256) + cl;
                    o[0] = (h16)r; o[64] = (h16)kt; o[128] = (h16)v; o[192] = (h16)kk; o[256] = (h16)bb; } }
        }
        __syncthreads();
    }
}

__device__ __forceinline__ void pool_conv_chunk(Frame& F, int l, int c) {
    LAS float* ubuf = (LAS float*)F.lds;
    LAS unsigned short* pb16 = (LAS unsigned short*)(F.lds + 65536);
    const int tid = F.tid; const int ch = tid & 255, half = tid >> 8;
    const int t0 = c * 64, tb = t0 + half * 32, sb = tb & (SEQ - 1);
    {
    {
        const int grp = ch >> 6, win = 2 << grp;
        const h16* up = F.PP + (size_t)tb * 1792 + ch;
        float s = 0.f;
        for (int j = 1; j <= win; ++j) if (sb - j >= 0) s += (float)up[-(ptrdiff_t)j * 1792];
#pragma unroll 1
        for (int t16 = 0; t16 < 32; t16 += 16) {
            h16 uq[16], ul[16];
#pragma unroll
            for (int tt = 0; tt < 16; ++tt) { uq[tt] = up[(size_t)(t16 + tt) * 1792]; ul[tt] = (sb + t16 + tt - win >= 0) ? up[(ptrdiff_t)(t16 + tt - win) * 1792] : (h16)0.f; }
#pragma unroll
            for (int tt = 0; tt < 16; ++tt) { const float u = (float)uq[tt]; s += u; const int pos = sb + t16 + tt;
                s -= (float)ul[tt];
                const float cnt = (float)((pos + 1 < win) ? (pos + 1) : win);
                pb16[(half * 32 + t16 + tt) * 264 + ch] = (unsigned short)f2bf(s / cnt - u); } }
    }
    {
        const h16* zp = F.PP + (size_t)tb * 1792 + 1024 + ch;
        const float cw0 = F.in[33][((size_t)l * 3 + 0) * 256 + ch], cw1 = F.in[33][((size_t)l * 3 + 1) * 256 + ch], cw2 = F.in[33][((size_t)l * 3 + 2) * 256 + ch];
        float z2 = 0.f, z1 = 0.f;
        if (sb >= 1) z1 = (float)zp[-(ptrdiff_t)1792 + 512] * (float)zp[-(ptrdiff_t)1792];
        if (sb >= 2) z2 = (float)zp[-(ptrdiff_t)2 * 1792 + 512] * (float)zp[-(ptrdiff_t)2 * 1792];
#pragma unroll 1
        for (int t16 = 0; t16 < 32; t16 += 16) {
            h16 zx[16], zb[16], zc[16];
#pragma unroll
            for (int tt = 0; tt < 16; ++tt) { const h16* q = zp + (size_t)(t16 + tt) * 1792; zx[tt] = q[0]; zb[tt] = q[256]; zc[tt] = q[512]; }
#pragma unroll
            for (int tt = 0; tt < 16; ++tt) { const float z0 = (float)zc[tt] * (float)zx[tt];
                const float y = (float)zb[tt] * (cw0 * z2 + cw1 * z1 + cw2 * z0);
                F.B2[(size_t)(tb + t16 + tt) * 1024 + 768 + ch] = (bf16_t)f2bf(y); z2 = z1; z1 = z0; } }
    }
    __syncthreads();
    LAS float* accu = ubuf + half * 32 * 256 + ch;
    {
        lora_mfma<64>(pb16, (F.wave >> 1) * 64, (const bf16_t*)(F.ws + WS_W + W_L2) + 4 * 256 * 64, ubuf, F.wave, F.lane);
        __syncthreads();
        const float sc = F.in[17][(size_t)l * 256 + ch];
#pragma unroll 4
        for (int tt = 0; tt < 32; ++tt) F.B2[(size_t)(tb + tt) * 1024 + 256 + ch] = (bf16_t)f2bf(accu[tt * 256] * sc);
    }
    __syncthreads();
    }
}

#define XB_TMO      128
#define XB_XCNT(j)  (256  + 64 * (j))
#define XB_XSUB(j)  (1280 + 64 * (j))
#define XB_XGEN(j)  (2304 + 64 * (j))
#define XB_TOP      3328
#define XB_TOPGEN   3392
#define XCD_BAR_WORDS 3456
#define XB_SPIN_CAP (1u << 18)

__device__ __forceinline__ unsigned xb_ld(unsigned* p)              { return __hip_atomic_load(p, __ATOMIC_RELAXED, __HIP_MEMORY_SCOPE_AGENT); }
__device__ __forceinline__ unsigned xb_add(unsigned* p, unsigned v) { return __hip_atomic_fetch_add(p, v, __ATOMIC_RELAXED, __HIP_MEMORY_SCOPE_AGENT); }
__device__ __forceinline__ unsigned xb_xcc_id() { return (unsigned)__builtin_amdgcn_s_getreg((3 << 11) | 20) & 0xFu; }
#define XB_SPIN(cond, bar) do { unsigned _sp = 0; while (cond) { __builtin_amdgcn_s_sleep(1); \
    if ((++_sp & 255u) == 0u) { if (xb_ld(&(bar)[XB_TMO])) break; if (_sp > XB_SPIN_CAP) { atomicAdd(&(bar)[XB_TMO], 1u); break; } } } } while (0)

struct XcdBarrier {
    unsigned* bar; unsigned x;
    volatile LAS unsigned* st;
};

__device__ __forceinline__ XcdBarrier xcd_barrier_post(unsigned* bar, volatile LAS unsigned* st) {
    XcdBarrier b; b.bar = bar; b.x = xb_xcc_id(); b.st = st;
    if (threadIdx.x == 0) (void)xb_add(&bar[XB_XCNT(b.x)], 1u);
    return b;
}
__device__ __forceinline__ void xcd_barrier_complete(unsigned* bar, unsigned x, unsigned& nloc, unsigned& nx) {
    const unsigned G = gridDim.x * gridDim.y * gridDim.z;
    unsigned sum, cnt, mine, sp = 0u;
    for (;;) {
        sum = 0u; cnt = 0u; mine = 0u;
#pragma unroll
        for (unsigned j = 0; j < 16; ++j) { const unsigned c = xb_ld(&bar[XB_XCNT(j)]); sum += c; cnt += (c > 0u) ? 1u : 0u; mine = (j == x) ? c : mine; }
        if (sum == G) break;
        __builtin_amdgcn_s_sleep(1);
        if ((++sp & 255u) == 0u) { if (xb_ld(&bar[XB_TMO])) break; if (sp > XB_SPIN_CAP) { atomicAdd(&bar[XB_TMO], 1u); break; } }
    }
    nloc = mine > 0u ? mine : 1u; nx = cnt > 0u ? cnt : 1u;
}

__device__ __forceinline__ void xcd_barrier(const XcdBarrier& b) {
    asm volatile("s_waitcnt vmcnt(0)" ::: "memory");
    __syncthreads();
    if (threadIdx.x == 0) {
        unsigned* bar = b.bar;
        __builtin_amdgcn_s_waitcnt(0);
        unsigned nloc = b.st[0], nx = b.st[1];
        if (nloc == 0u) { xcd_barrier_complete(bar, b.x, nloc, nx); b.st[0] = nloc; b.st[1] = nx; }
        const unsigned old = xb_add(&bar[XB_XSUB(b.x)], 1u);
        const unsigned gen = old / nloc;
        if (old + 1u == (gen + 1u) * nloc) {
            __builtin_amdgcn_fence(__ATOMIC_RELEASE, "agent");
            asm volatile("s_waitcnt vmcnt(0)" ::: "memory");
            const unsigned og = xb_add(&bar[XB_TOP], 1u);
            const unsigned tg = og / nx;
            if (og + 1u == (tg + 1u) * nx) xb_add(&bar[XB_TOPGEN], 1u);
            else XB_SPIN(xb_ld(&bar[XB_TOPGEN]) == tg, bar);
            __builtin_amdgcn_fence(__ATOMIC_ACQUIRE, "agent");
            xb_add(&bar[XB_XGEN(b.x)], 1u);
            asm volatile("s_waitcnt vmcnt(0)" ::: "memory");
        } else {
            XB_SPIN(xb_ld(&bar[XB_XGEN(b.x)]) == gen, bar);
            __builtin_amdgcn_fence(__ATOMIC_ACQUIRE, "agent");
            asm volatile("s_waitcnt vmcnt(0)" ::: "memory");
        }
    }
    __syncthreads();
}

__device__ __forceinline__ float a_fma(float a, float b, float c) { float d; asm("v_fma_f32 %0, %1, %2, %3" : "=v"(d) : "v"(a), "v"(b), "v"(c)); return d; }
__device__ __forceinline__ float a_fnma(float a, float b, float c) { float d; asm("v_fma_f32 %0, -%1, %2, %3" : "=v"(d) : "v"(a), "v"(b), "v"(c)); return d; }
__device__ __forceinline__ float a_mul(float a, float b) { float d; asm("v_mul_f32 %0, %1, %2" : "=v"(d) : "v"(a), "v"(b)); return d; }
__device__ __forceinline__ float a_add(float a, float b) { float d; asm("v_add_f32 %0, %1, %2" : "=v"(d) : "v"(a), "v"(b)); return d; }
constexpr int RC_LEN = 256, RC_N = SEQ / RC_LEN;
constexpr int ST_STEPS = 16, ST_FL = ST_STEPS * 384, ST_NPC = ST_STEPS * 56, ST_OB = ST_STEPS * 32 * 16, ST_NSUB = RC_LEN / ST_STEPS;
__device__ __forceinline__ void st_load(const unsigned char* src, int sub, int tid, u32x4 (&rg)[2]) {
#pragma unroll
    for (int n = 0; n < 2; ++n) { const int i = tid + NTHR * n; if (i < ST_NPC) { const int step = i / 56, j = i % 56;
        rg[n] = *(const u32x4*)(src + ((size_t)sub * ST_STEPS + step) * 896 + (j < 16 ? j * 16 : 256 + (j - 16) * 16)); } }
}
__device__ __forceinline__ void st_store(LAS float* buf, int tid, const u32x4 (&rg)[2]) {
#pragma unroll
    for (int n = 0; n < 2; ++n) { const int i = tid + NTHR * n; if (i < ST_NPC) { const int step = i / 56, j = i % 56;
        if (j < 16) { *(LAS u32x4*)(buf + step * 384 + j * 4) = rg[n]; }
        else { const int a = (j - 16) >> 3, e = (j - 16) & 7; const h16x8 h = __builtin_bit_cast(h16x8, rg[n]); f32x4 lo, hi;
            lo[0] = (float)h[0]; lo[1] = (float)h[1]; lo[2] = (float)h[2]; lo[3] = (float)h[3]; hi[0] = (float)h[4]; hi[1] = (float)h[5]; hi[2] = (float)h[6]; hi[3] = (float)h[7];
            LAS f32x4* d = (LAS f32x4*)(buf + step * 384 + 64 + a * 64 + e * 8); d[0] = lo; d[1] = hi; } } }
}
#define RAW_BAR() do { asm volatile("s_waitcnt lgkmcnt(0)" ::: "memory"); __builtin_amdgcn_s_barrier(); asm volatile("" ::: "memory"); } while (0)
#define DPP_ADD(x_, ctl_) "v_add_f32_dpp %[" x_ "], %[" x_ "], %[" x_ "] " ctl_ " row_mask:0xf bank_mask:0xf bound_ctrl:1\n\t"
template <bool OUT> __device__ __forceinline__ void scan_task(Frame& F, const unsigned char* src, const float* initS, bool ident, bool use_v, float* endS, float* Og) {
    constexpr int STS = OUT ? 8 : 16, NSUB = RC_LEN / STS, FL = STS * 384, NPC = STS * 56, PT = (NPC + NTHR - 1) / NTHR, OB = STS * 64 * 16;
    LAS float* buf = (LAS float*)F.lds;
    LAS float* obuf = (LAS float*)(F.lds + 2 * FL * 4);
    const int tid = F.tid, wave = F.wave, lane = F.lane, ks = lane & 15;
    int rowr[2]; float S[2][4];
#pragma unroll
    for (int r = 0; r < 2; ++r) { rowr[r] = (wave * 2 + r) * 4 + (lane >> 4);
        if (initS) { const f32x4 i4 = *(const f32x4*)(initS + (size_t)rowr[r] * 64 + 4 * ks); S[r][0] = i4[0]; S[r][1] = i4[1]; S[r][2] = i4[2]; S[r][3] = i4[3]; }
        else {
#pragma unroll
            for (int e = 0; e < 4; ++e) S[r][e] = (ident && 4 * ks + e == rowr[r]) ? 1.f : 0.f; } }
    u32x4 rg[2][PT];
#define ST_LOAD(sub_, rg_) do { _Pragma("unroll") for (int n_ = 0; n_ < PT; ++n_) { const int i_ = tid + NTHR * n_; if (i_ < NPC) { const int step_ = i_ / 56, j_ = i_ % 56; \
        rg_[n_] = *(const u32x4*)(src + ((size_t)(sub_) * STS + step_) * 896 + (j_ < 16 ? j_ * 16 : 256 + (j_ - 16) * 16)); } } } while (0)
#define ST_STORE(buf_, rg_) do { _Pragma("unroll") for (int n_ = 0; n_ < PT; ++n_) { const int i_ = tid + NTHR * n_; if (i_ < NPC) { const int step_ = i_ / 56, j_ = i_ % 56; \
        if (j_ < 16) { *(LAS u32x4*)((buf_) + step_ * 384 + j_ * 4) = rg_[n_]; } \
        else { const int a_ = (j_ - 16) >> 3, e_ = (j_ - 16) & 7; const h16x8 h_ = __builtin_bit_cast(h16x8, rg_[n_]); f32x4 lo_, hi_; \
            lo_[0] = (float)h_[0]; lo_[1] = (float)h_[1]; lo_[2] = (float)h_[2]; lo_[3] = (float)h_[3]; hi_[0] = (float)h_[4]; hi_[1] = (float)h_[5]; hi_[2] = (float)h_[6]; hi_[3] = (float)h_[7]; \
            LAS f32x4* d_ = (LAS f32x4*)((buf_) + step_ * 384 + 64 + a_ * 64 + e_ * 8); d_[0] = lo_; d_[1] = hi_; } } } } while (0)
    ST_LOAD(0, rg[0]); ST_STORE(buf, rg[0]); ST_LOAD(1, rg[1]); ST_LOAD(2, rg[0]);
    RAW_BAR();
#pragma unroll 1
    for (int sc2 = 0; sc2 < NSUB; sc2 += 2) {
#pragma unroll
      for (int u = 0; u < 2; ++u) { const int sc = sc2 + u;
        if (sc + 1 < NSUB) { ST_STORE(buf + ((sc + 1) & 1) * FL, rg[(u + 1) & 1]); if (sc + 3 < NSUB) ST_LOAD(sc + 3, rg[(u + 1) & 1]); }
        {
            const LAS float* bb = buf + (sc & 1) * FL + 4 * ks; const LAS float* vb0 = buf + (sc & 1) * FL + 192 + rowr[0]; const LAS float* vb1 = buf + (sc & 1) * FL + 192 + rowr[1];
            LAS float* ob0 = obuf + (sc & 1) * OB + rowr[0] * 16 + ks; LAS float* ob1 = obuf + (sc & 1) * OB + rowr[1] * 16 + ks;
            f32x4 w_[2], r_[2], k_[2], kk_[2], b_[2]; float v_[2][2];
#define SC_LD(s_, j_) do { const LAS float* p_ = bb + (s_) * 384; w_[j_] = *(const LAS f32x4*)(p_); if (OUT) r_[j_] = *(const LAS f32x4*)(p_ + 64); k_[j_] = *(const LAS f32x4*)(p_ + 128); \
                kk_[j_] = *(const LAS f32x4*)(p_ + 256); b_[j_] = *(const LAS f32x4*)(p_ + 320); v_[j_][0] = vb0[(s_) * 384]; v_[j_][1] = vb1[(s_) * 384]; } while (0)
            SC_LD(0, 0);
#pragma unroll
            for (int s = 0; s < STS; ++s) { const int j = s & 1;
                f32x4 rp; if (OUT) rp = r_[j ^ 1];
                if (s + 1 < STS) SC_LD(s + 1, j ^ 1);
                const f32x4 w = w_[j], k = k_[j], kk = kk_[j], bv = b_[j];
#pragma unroll
                for (int r = 0; r < 2; ++r) { const float v = use_v ? v_[j][r] : 0.f;
                    float sa, op, u0, u1, u2, u3;
                    if (OUT && s > 0) {
                        asm volatile(
                            "v_mul_f32 %[sa], %[Sa], %[kk0]\n\t" "v_fma_f32 %[sa], %[Sb], %[kk1], %[sa]\n\t" "v_fma_f32 %[sa], %[Sc], %[kk2], %[sa]\n\t" "v_fma_f32 %[sa], %[Sd], %[kk3], %[sa]\n\t"
                            "v_mul_f32 %[op], %[Sa], %[r0]\n\t" "v_fma_f32 %[op], %[Sb], %[r1], %[op]\n\t"
                            DPP_ADD("sa", "quad_perm:[1,0,3,2]") "v_fma_f32 %[op], %[Sc], %[r2], %[op]\n\t" "v_fma_f32 %[op], %[Sd], %[r3], %[op]\n\t"
                            DPP_ADD("sa", "quad_perm:[2,3,0,1]") "v_mul_f32 %[u0], %[v], %[k0]\n\t" "v_mul_f32 %[u1], %[v], %[k1]\n\t"
                            DPP_ADD("sa", "row_half_mirror") "v_mul_f32 %[u2], %[v], %[k2]\n\t" "v_mul_f32 %[u3], %[v], %[k3]\n\t"
                            DPP_ADD("sa", "row_mirror")
                            : [sa] "=&v"(sa), [op] "=&v"(op), [u0] "=&v"(u0), [u1] "=&v"(u1), [u2] "=&v"(u2), [u3] "=&v"(u3)
                            : [Sa] "v"(S[r][0]), [Sb] "v"(S[r][1]), [Sc] "v"(S[r][2]), [Sd] "v"(S[r][3]), [kk0] "v"(kk[0]), [kk1] "v"(kk[1]), [kk2] "v"(kk[2]), [kk3] "v"(kk[3]),
                              [r0] "v"(rp[0]), [r1] "v"(rp[1]), [r2] "v"(rp[2]), [r3] "v"(rp[3]), [v] "v"(v), [k0] "v"(k[0]), [k1] "v"(k[1]), [k2] "v"(k[2]), [k3] "v"(k[3]));
                        (r == 0 ? ob0 : ob1)[(s - 1) * 1024] = op;
                    } else {
                        asm volatile(
                            "v_mul_f32 %[sa], %[Sa], %[kk0]\n\t" "v_fma_f32 %[sa], %[Sb], %[kk1], %[sa]\n\t" "v_fma_f32 %[sa], %[Sc], %[kk2], %[sa]\n\t" "v_fma_f32 %[sa], %[Sd], %[kk3], %[sa]\n\t"
                            "v_mul_f32 %[u0], %[v], %[k0]\n\t" "v_mul_f32 %[u1], %[v], %[k1]\n\t"
                            DPP_ADD("sa", "quad_perm:[1,0,3,2]") "v_mul_f32 %[u2], %[v], %[k2]\n\t" "v_mul_f32 %[u3], %[v], %[k3]\n\t"
                            DPP_ADD("sa", "quad_perm:[2,3,0,1]") "s_nop 1\n\t"
                            DPP_ADD("sa", "row_half_mirror") "s_nop 1\n\t"
                            DPP_ADD("sa", "row_mirror")
                            : [sa] "=&v"(sa), [u0] "=&v"(u0), [u1] "=&v"(u1), [u2] "=&v"(u2), [u3] "=&v"(u3)
                            : [Sa] "v"(S[r][0]), [Sb] "v"(S[r][1]), [Sc] "v"(S[r][2]), [Sd] "v"(S[r][3]), [kk0] "v"(kk[0]), [kk1] "v"(kk[1]), [kk2] "v"(kk[2]), [kk3] "v"(kk[3]),
                              [v] "v"(v), [k0] "v"(k[0]), [k1] "v"(k[1]), [k2] "v"(k[2]), [k3] "v"(k[3]));
                    }
                    asm volatile(
                        "v_fma_f32 %[u0], -%[sa], %[b0], %[u0]\n\t" "v_fma_f32 %[u1], -%[sa], %[b1], %[u1]\n\t" "v_fma_f32 %[u2], -%[sa], %[b2], %[u2]\n\t" "v_fma_f32 %[u3], -%[sa], %[b3], %[u3]\n\t"
                        "v_fma_f32 %[Sa], %[Sa], %[w0], %[u0]\n\t" "v_fma_f32 %[Sb], %[Sb], %[w1], %[u1]\n\t" "v_fma_f32 %[Sc], %[Sc], %[w2], %[u2]\n\t" "v_fma_f32 %[Sd], %[Sd], %[w3], %[u3]\n\t"
                        : [Sa] "+v"(S[r][0]), [Sb] "+v"(S[r][1]), [Sc] "+v"(S[r][2]), [Sd] "+v"(S[r][3]), [u0] "+v"(u0), [u1] "+v"(u1), [u2] "+v"(u2), [u3] "+v"(u3)
                        : [sa] "v"(sa), [b0] "v"(bv[0]), [b1] "v"(bv[1]), [b2] "v"(bv[2]), [b3] "v"(bv[3]), [w0] "v"(w[0]), [w1] "v"(w[1]), [w2] "v"(w[2]), [w3] "v"(w[3])); }
                __builtin_amdgcn_sched_barrier(0); }
            if (OUT) { const f32x4 r4 = r_[(STS - 1) & 1];
              ob0[(STS - 1) * 1024] = a_fma(S[0][3], r4[3], a_fma(S[0][2], r4[2], a_fma(S[0][1], r4[1], a_mul(S[0][0], r4[0]))));
              ob1[(STS - 1) * 1024] = a_fma(S[1][3], r4[3], a_fma(S[1][2], r4[2], a_fma(S[1][1], r4[1], a_mul(S[1][0], r4[0])))); }
#undef SC_LD
        }
        RAW_BAR();
        if (OUT) {
            const LAS f32x4* p = (const LAS f32x4*)(obuf + (sc & 1) * OB + tid * 16); const f32x4 a = p[0], b = p[1], c = p[2], d = p[3];
            const float o = (((a[0] + a[1]) + (a[2] + a[3])) + ((b[0] + b[1]) + (b[2] + b[3]))) + (((c[0] + c[1]) + (c[2] + c[3])) + ((d[0] + d[1]) + (d[2] + d[3])));
            Og[((size_t)sc * STS + (tid >> 6)) * 256 + (tid & 63)] = o; }
      }
    }
#undef ST_LOAD
#undef ST_STORE
    if (endS) {
#pragma unroll
        for (int r = 0; r < 2; ++r) *(f32x4*)(endS + (size_t)rowr[r] * 64 + 4 * ks) = (f32x4){S[r][0], S[r][1], S[r][2], S[r][3]}; }
    RAW_BAR();
}
#undef DPP_ADD
__device__ __forceinline__ void rwkv_carry(Frame& F) {
    const int hb = F.bx >> 3, row = (F.bx & 7) * 8 + F.wave, lane = F.lane, tid = F.tid;
    LAS float* Pl = (LAS float*)F.lds;
    LAS float* Sl = (LAS float*)(F.lds + 16384) + F.wave * 64;
    float S = 0.f;
    const size_t m0 = (size_t)hb * RC_N * 4096;
    f32x4 p0 = *(const f32x4*)(F.PB + m0 + (size_t)tid * 8), p1 = *(const f32x4*)(F.PB + m0 + (size_t)tid * 8 + 4);
    float lc = F.LB[m0 + (size_t)row * 64 + lane];
#pragma unroll 1
    for (int c = 0; c < RC_N; ++c) { const size_t mo = m0 + (size_t)c * 4096;
        F.SB[mo + (size_t)row * 64 + lane] = S;
        if (c + 1 == RC_N) break;
        float acc = lc;
        *(LAS f32x4*)(Pl + tid * 8) = p0; *(LAS f32x4*)(Pl + tid * 8 + 4) = p1; Sl[lane] = S;
        if (c + 2 < RC_N) { p0 = *(const f32x4*)(F.PB + mo + 4096 + (size_t)tid * 8); p1 = *(const f32x4*)(F.PB + mo + 4096 + (size_t)tid * 8 + 4); lc = F.LB[mo + 4096 + (size_t)row * 64 + lane]; }
        RAW_BAR();
        float a0 = 0.f, a1 = 0.f, a2 = 0.f, a3 = 0.f;
#pragma unroll 4
        for (int j = 0; j < 64; j += 4) { const f32x4 s4 = *(const LAS f32x4*)(Sl + j);
            a0 += s4[0] * Pl[(j + 0) * 64 + lane]; a1 += s4[1] * Pl[(j + 1) * 64 + lane]; a2 += s4[2] * Pl[(j + 2) * 64 + lane]; a3 += s4[3] * Pl[(j + 3) * 64 + lane]; }
        S = acc + ((a0 + a1) + (a2 + a3));
        RAW_BAR();
    }
}
__device__ __forceinline__ float gelu_tanh(float x) { const float u = 0.7978845608028654f * (x + 0.044715f * x * x * x); return 0.5f * x * (1.0f + tanhf(u)); }
__device__ __forceinline__ void s5_pass2(Frame& F, int l, int c) {
    typedef short bf16x8_t __attribute__((ext_vector_type(8)));
    LAS float* ubuf = (LAS float*)F.lds;
    const int t0 = c * 64, lane = F.lane, wave = F.wave, cb0 = c & ~127;
    LAS unsigned short* hb = (LAS unsigned short*)(F.lds + 65536) + wave * (16 * 136);
    load_u5_tile(F, t0, ubuf);
    __syncthreads();
    const int r16 = lane & 15, quad = lane >> 4;
#pragma unroll 1
    for (int gi = 0; gi < 2; ++gi) { const int g = wave + 8 * gi; S5Par P; s5_params(F, l, g, lane, P);
        int lane_l = lane; asm volatile("" : "+v"(lane_l));
        bf16x8_t cf[4];
#pragma unroll
        for (int ks = 0; ks < 4; ++ks) { const float* src = (ks < 2 ? F.in[12] : F.in[13]) + (((size_t)l * 16 + g) * 16 + (lane_l & 15)) * 64 + (ks & 1) * 32 + quad * 8;
            const f32x4 a = *(const f32x4*)src, b = *(const f32x4*)(src + 4); const float sg = ks < 2 ? 1.0f : -1.0f;
            cf[ks][0] = (short)f2bf(a[0] * sg); cf[ks][1] = (short)f2bf(a[1] * sg); cf[ks][2] = (short)f2bf(a[2] * sg); cf[ks][3] = (short)f2bf(a[3] * sg);
            cf[ks][4] = (short)f2bf(b[0] * sg); cf[ks][5] = (short)f2bf(b[1] * sg); cf[ks][6] = (short)f2bf(b[2] * sg); cf[ks][7] = (short)f2bf(b[3] * sg); }
        const int chy = g * 16 + r16; const float dd = F.in[14][(size_t)l * 256 + chy];
        float pr = P.ar, pi = P.ai;
#pragma unroll
        for (int s = 0; s < 6; ++s) { const float nr = pr * pr - pi * pi, ni = 2.0f * pr * pi; pr = nr; pi = ni; }
        float hr = 0.f, hi = 0.f;
#pragma unroll 1
        for (int c2 = cb0; c2 < c; c2 += 16) {
            f32x2 e[16];
#pragma unroll
            for (int q = 0; q < 16; ++q) { const int cq = (c2 + q < c) ? c2 + q : c2; e[q] = *(const f32x2*)(F.E + (((size_t)cq * 16 + g) * 64 + lane_l) * 2); }
#pragma unroll
            for (int q = 0; q < 16; ++q) if (c2 + q < c) { const float nr = pr * hr - pi * hi + e[q][0], ni = pr * hi + pi * hr + e[q][1]; hr = nr; hi = ni; } }
#pragma unroll 1
        for (int tb = 0; tb < 4; ++tb) {
#pragma unroll 4
            for (int j = 0; j < 16; ++j) { s5_step(P, ubuf + (tb * 16 + j) * 256 + g * 16, hr, hi);
                hb[j * 136 + lane] = (unsigned short)f2bf(hr); hb[j * 136 + 64 + lane] = (unsigned short)f2bf(hi); }
            f32x4 acc = {0.f, 0.f, 0.f, 0.f};
#pragma unroll
            for (int ks = 0; ks < 4; ++ks) { const bf16x8_t a = *(const LAS bf16x8_t*)(hb + r16 * 136 + ks * 32 + quad * 8);
                acc = __builtin_amdgcn_mfma_f32_16x16x32_bf16(a, cf[ks], acc, 0, 0, 0); }
#pragma unroll
            for (int j = 0; j < 4; ++j) { const int tl = tb * 16 + quad * 4 + j; const float y = acc[j] + dd * ubuf[tl * 256 + chy];
                F.GL[(size_t)(t0 + tl) * 256 + chy] = (bf16_t)f2bf(gelu_tanh(y)); }
        }
    }
    __syncthreads();
}
template <int PART> __device__ __forceinline__ void m2_phase(Frame& F, int l, const XcdBarrier& xbar) {
    if (PART == 0 || PART == 1)
#pragma unroll 1
    for (int id = F.bx; id < 8 * RC_N * 2; id += F.G) { const int hb = id >> 6, c = (id >> 1) & (RC_N - 1), tk = id & 1; const size_t mo = ((size_t)hb * RC_N + c) * 4096;
        if (c == RC_N - 1) continue;
        const unsigned char* src = F.RW + ((size_t)hb * SEQ + (size_t)c * RC_LEN) * 896;
        scan_task<false>(F, src, nullptr, tk == 1, tk == 0, (tk == 0 ? F.LB : F.PB) + mo, nullptr); }
    if (PART == 0 || PART == 2)
#pragma unroll 1
    for (int c = F.bx; c < TT / 64; c += F.G) pool_conv_chunk(F, l, c);
    xcd_barrier(xbar);
    if (PART == 0 || PART == 3) { int bxs = F.bx; asm volatile("" : "+s"(bxs));
      if (bxs < 64) rwkv_carry(F);
      else conv_second_half(F, l, 64); }
    xcd_barrier(xbar);
    if (PART == 0 || PART == 4)
#pragma unroll 1
    for (int id = F.bx; id < 8 * RC_N; id += F.G) { const int hb = id >> 5, c = id & (RC_N - 1); const size_t mo = ((size_t)hb * RC_N + c) * 4096;
        const unsigned char* src = F.RW + ((size_t)hb * SEQ + (size_t)c * RC_LEN) * 896;
        float* Og = F.O + ((size_t)(hb >> 2) * SEQ + (size_t)c * RC_LEN) * 256 + (hb & 3) * 64;
        scan_task<true>(F, src, F.SB + mo, false, true, nullptr, Og); }
    if (PART == 0 || PART == 5)
#pragma unroll 1
    for (int c = F.bx; c < TT / 64; c += F.G) s5_pass2(F, l, c);
}
__device__ __forceinline__ void rwkv_post(Frame& F, int l) {
    const int gw = F.bx * NWAVES + F.wave, NGW = F.G * NWAVES, lane = F.lane;
    for (int it0 = gw * 4; it0 < TT * 4; it0 += NGW * 4) {
        const int t = it0 >> 2, b = t / SEQ, pos = t & (SEQ - 1);
        float o[4], r[4], k[4], v[4], g[4];
#pragma unroll
        for (int hh = 0; hh < 4; ++hh) { const int c = hh * 64 + lane; o[hh] = F.O[(size_t)t * 256 + c]; g[hh] = (float)F.G16[(size_t)t * 256 + c];
            const h16* rw = (const h16*)(F.RW + ((size_t)(b * 4 + hh) * SEQ + pos) * 896 + 256) + lane; r[hh] = (float)rw[0]; k[hh] = (float)rw[64]; v[hh] = (float)rw[128]; }
#pragma unroll
        for (int hh = 0; hh < 4; ++hh) { const int c = hh * 64 + lane;
            const float mu = wave_sum(o[hh]) * (1.0f / 64.0f); const float d = o[hh] - mu; const float var = wave_sum(d * d) * (1.0f / 64.0f);
            const float on = d * rsqrtf(var + 64e-5f) * F.in[31][(size_t)l * 256 + c] + F.in[32][(size_t)l * 256 + c];
            const float bs = wave_sum(r[hh] * k[hh] * F.in[30][(size_t)l * 256 + c]);
            F.B2[(size_t)t * 1024 + 512 + c] = (bf16_t)f2bf((on + bs * v[hh]) * g[hh]); }
    }
}

constexpr int NPH = 25;
#ifndef PHMASK
#define PHMASK 0xFFFF
#endif
#define PHON(k) (((PHMASK) >> (k)) & 1)
#ifndef REP_PART
#define REP_PART 0
#endif
template <int PH, int PART = 0> __device__ __forceinline__ void run_phase(const int wave_s, unsigned char* lds_raw, const XcdBarrier& xbar) {
    typedef pg8::StaticOrder SO;
    int tid = wave_s * 64 + (int)__builtin_amdgcn_mbcnt_hi(~0u, __builtin_amdgcn_mbcnt_lo(~0u, 0u)); asm volatile("" : "+v"(tid));
    int G = gridDim.x, bx = blockIdx.x; asm volatile("" : "+s"(G), "+s"(bx));
    const __attribute__((address_space(4))) unsigned char* ka = (const __attribute__((address_space(4))) unsigned char*)__builtin_amdgcn_kernarg_segment_ptr();
    asm volatile("" : "+s"(ka));
    const __attribute__((address_space(4))) Args* ap = (const __attribute__((address_space(4))) Args*)ka;
    Frame F;
    F.lds = (LAS unsigned char*)lds_raw;
    F.tid = tid; F.lane = tid & 63; F.wave = __builtin_amdgcn_readfirstlane(tid >> 6); F.G = G; F.bx = bx;
    F.in = (in_t)ka; F.X = ap->out; F.ws = ap->ws;
    unsigned char* ws = F.ws;
    F.SS = (float*)(ws + WS_SS); F.E = (float*)(ws + WS_E); F.B1 = (bf16_t*)(ws + WS_B1); F.B2 = (bf16_t*)(ws + WS_B2);
    unsigned char* z = ws + WS_Z;
    F.HID = (bf16_t*)(z + Z_HID); F.GL = (bf16_t*)(z + Z_GL); F.U5 = (h16*)(z + Z_U5); F.PP = (h16*)(z + Z_PP); F.L16 = (h16*)(z + Z_L16); F.G16 = (h16*)(z + Z_G16); F.R = (h16*)(z + Z_R);
    F.O = (float*)(z + Z_O); F.RW = z + Z_RW; F.PB = (float*)(z + Z_PB); F.LB = (float*)(z + Z_LB); F.SB = (float*)(z + Z_SB);
    if constexpr (PH == 0) { conv_first_half(F, 0); prep_x(F); }
    else { constexpr int l = (PH - 1) / 12, k = (PH - 1) % 12;
        if constexpr (k == 0) { pg8::Gemm g{F.B1, (const bf16_t*)(ws + WS_W + W_GU1), TT, 2 * FF, DM, 1}; SO S; S.init(TT, 2 * FF, G, bx); pg8::EpiGU E{F.HID, F.SS}; pg8::gemm_phase<pg8::EpiGU, SO, true, true>(F.lds, g, S, E, tid); }
        else if constexpr (k == 1) { pg8::Gemm g{F.HID, (const bf16_t*)(ws + WS_W + W_D1), TT, DM, FF, 1}; SO S; S.init(TT, DM, G, bx); pg8::EpiDown E{l == 0 ? F.in[0] : F.X, F.X, F.B1, F.SS, 0.5f}; pg8::gemm_phase<pg8::EpiDown, SO, true, true>(F.lds, g, S, E, tid); }
        else if constexpr (k == 2) { pg8::Gemm g{F.B1, (const bf16_t*)(ws + WS_W + W_INA), TT, 2560, DM, 1}; SO S; S.init(TT, 2560, G, bx); pg8::EpiInA E{F.U5, F.PP, F.L16, F.SS}; pg8::gemm_phase<pg8::EpiInA, SO, true, true>(F.lds, g, S, E, tid); }
        else if constexpr (k == 3) { m1_phase(F, l); }
        else if constexpr (k == 4) { m2_phase<PART>(F, l, xbar); }
        else if constexpr (k == 5) { { pg8::Gemm g{F.GL, (const bf16_t*)(ws + WS_W + W_GLU), TT, 256, 256, 1}; SO S; S.init(TT, 256, G, bx); pg8::EpiGlu E{F.GL, F.B2}; pg8::gemm_phase<pg8::EpiGlu, SO, true, true>(F.lds, g, S, E, tid); } rwkv_post(F, l); }
        else if constexpr (k == 6) { pg8::Gemm g{F.B1, (const bf16_t*)(ws + WS_W + W_ING), TT, 4096, DM, 1}; SO S; S.init(TT, 4096, G, bx); pg8::EpiGate E{F.R, F.SS}; pg8::gemm_phase<pg8::EpiGate, SO, true, true>(F.lds, g, S, E, tid); }
        else if constexpr (k == 7) { pg8::Gemm g{F.B2, (const bf16_t*)(ws + WS_W + W_BR), TT, DM, DM, 4}; pg8::SegOrder4 S; S.so.init(TT, DM, G, bx); pg8::EpiBranch E{F.R, F.B1}; pg8::gemm_phase<pg8::EpiBranch, pg8::SegOrder4, true, true>(F.lds, g, S, E, tid); }
        else if constexpr (k == 8) { pg8::Gemm g{F.B1, (const bf16_t*)(ws + WS_W + W_O), TT, DM, DM, 1}; SO S; S.init(TT, DM, G, bx); pg8::EpiDown E{F.X, F.X, F.B2, F.SS, 1.0f}; pg8::gemm_phase<pg8::EpiDown, SO, true, true>(F.lds, g, S, E, tid); }
        else if constexpr (k == 9) { pg8::Gemm g{F.B2, (const bf16_t*)(ws + WS_W + W_GU2), TT, 2 * FF, DM, 1}; SO S; S.init(TT, 2 * FF, G, bx); pg8::EpiGU E{F.HID, F.SS}; pg8::gemm_phase<pg8::EpiGU, SO, true, true>(F.lds, g, S, E, tid); }
        else if constexpr (k == 10) { pg8::Gemm g{F.HID, (const bf16_t*)(ws + WS_W + W_D2), TT, DM, FF, 1}; SO S; S.init(TT, DM, G, bx); pg8::EpiDown E{F.X, F.X, F.B1, F.SS, 0.5f}; pg8::gemm_phase<pg8::EpiDown, SO, true, true>(F.lds, g, S, E, tid); }
        else { if constexpr (l == 0) conv_first_half(F, 1); else final_norm(F); }
    }
}
#ifndef REPMASK
#define REPMASK 0
#endif
#define SEAM(k_) do { if ((k_) == 0) { __syncthreads(); cg::this_grid().sync(); } else xcd_barrier(xbar); } while (0)
#define PHASE(k) if (ph_lo <= (k) && (k) < ph_hi) { run_phase<(k)>(wave_s, lds_raw, xbar); \
    if ((k) >= 1 && ((REPMASK >> (((k) - 1) % 12)) & 1)) { SEAM(k); run_phase<(k), REP_PART>(wave_s, lds_raw, xbar); } \
    if ((k) + 1 < ph_hi) SEAM(k); }
__global__ void __launch_bounds__(NTHR, 2) mk_fwd(Args args) {
    extern __shared__ __attribute__((aligned(16))) unsigned char lds_raw[];
    const int ph_lo = args.ph_lo, ph_hi = args.ph_hi;
    volatile LAS unsigned* xst = (volatile LAS unsigned*)((LAS unsigned char*)lds_raw + (LDS_BYTES - 64));
    if (threadIdx.x == 0) { xst[0] = 0u; xst[1] = 0u; }
    __syncthreads();
    const XcdBarrier xbar = xcd_barrier_post((unsigned*)(args.ws + WS_CTL), xst);
    const int wave_s = __builtin_amdgcn_readfirstlane((int)threadIdx.x >> 6);
    PHASE(0) PHASE(1) PHASE(2) PHASE(3) PHASE(4) PHASE(5) PHASE(6) PHASE(7) PHASE(8) PHASE(9) PHASE(10) PHASE(11) PHASE(12)
    PHASE(13) PHASE(14) PHASE(15) PHASE(16) PHASE(17) PHASE(18) PHASE(19) PHASE(20) PHASE(21) PHASE(22) PHASE(23) PHASE(24)
}

extern "C" void kernel_launch(void* const* d_in, const int* in_sizes, int n_in, void* d_out, int out_size, void* d_ws, size_t ws_size, hipStream_t stream) {
    static int grid = 0;
    if (grid == 0) {
        if (n_in != 41 || out_size != TT * DM || ws_size < WS_END) { fprintf(stderr, "kernel_launch: unexpected shapes (n_in %d out %d ws %zu)\n", n_in, out_size, ws_size); grid = -1; return; }
        int dev = 0, cus = 0, per_cu = 0;
        (void)hipGetDevice(&dev); (void)hipDeviceGetAttribute(&cus, hipDeviceAttributeMultiprocessorCount, dev);
        if (hipFuncSetAttribute((const void*)mk_fwd, hipFuncAttributeMaxDynamicSharedMemorySize, LDS_BYTES) != hipSuccess) { fprintf(stderr, "kernel_launch: hipFuncSetAttribute failed\n"); grid = -1; return; }
        if (hipOccupancyMaxActiveBlocksPerMultiprocessor(&per_cu, (const void*)mk_fwd, NTHR, LDS_BYTES) != hipSuccess || per_cu < 1) { fprintf(stderr, "kernel_launch: occupancy query says %d\n", per_cu); per_cu = 1; }
        (void)hipGetLastError();
        grid = cus * (per_cu >= 1 ? 1 : 1);
        if (grid < 64) { fprintf(stderr, "kernel_launch: grid %d too small\n", grid); }
    }
    if (grid < 0) return;
    if (hipMemsetAsync((char*)d_ws + WS_CTL, 0, CTL_ZERO_BYTES, stream) != hipSuccess) { fprintf(stderr, "kernel_launch: hipMemsetAsync failed\n"); return; }
    Args a{};
    for (int i = 0; i < 41; ++i) a.in[i] = (const float*)d_in[i];
    a.out = (float*)d_out; a.ws = (unsigned char*)d_ws;
#if ONE_LAUNCH
    a.ph_lo = 0; a.ph_hi = NPH;
    void* kargs[] = {&a};
    hipError_t e = hipLaunchCooperativeKernel((const void*)mk_fwd, dim3(grid), dim3(NTHR), kargs, LDS_BYTES, stream);
    if (e != hipSuccess) fprintf(stderr, "cooperative launch failed: %s (grid %d)\n", hipGetErrorString(e), grid);
#else
    for (int ph = 0; ph < NPH; ++ph) { a.ph_lo = ph; a.ph_hi = ph + 1; hipLaunchKernelGGL(mk_fwd, dim3(grid), dim3(NTHR), LDS_BYTES, stream, a); }
#endif
}
```

```cpp
#include <hip/hip_runtime.h>
#include <hip/hip_cooperative_groups.h>
#include <cstdio>
#include <cstdint>
#include <cstddef>
namespace cg = cooperative_groups;
namespace pg8 {
#define PG8_LAS __attribute__((address_space(3)))
typedef unsigned short bf16_t;
typedef short bf16x8 __attribute__((ext_vector_type(8)));
typedef float f32x4 __attribute__((ext_vector_type(4)));
typedef unsigned u32x4 __attribute__((ext_vector_type(4)));
constexpr int BM = 256, BK = 64, HALF = 128, HTB = HALF * BK * 2  , STAGE_BYTES = 8 * HTB, NXCD = 8, WGM = 8;

__host__ __device__ __forceinline__ int lds_byte(int r, int c) { const int st = (r >> 4) * 2 + (c >> 5), rr = r & 15, cc = c & 31, ob = rr * 64 + cc * 2; return st * 1024 + (ob ^ (((ob >> 9) & 1) << 5)); }
__host__ __device__ __forceinline__ void stage_rc(int b, int& R, int& C) { const int st = b / 1024, sb = b % 1024, swz = sb ^ (((sb >> 9) & 1) << 5); R = (st >> 1) * 16 + swz / 64; C = (st & 1) * 32 + (swz % 64) / 2; }
__host__ __device__ __forceinline__ int perm32(int rho) { const int n = rho >> 4, i = rho & 15; return 8 * (i >> 2) + 4 * n + (i & 3); }

struct Unit { int pm, pn, g; };
struct Gemm { const bf16_t* A; const bf16_t* Bt; int M, N, K, nseg; };

struct StaticOrder {
    int nM, nN, nwg, G, c;
    __host__ __device__ void init(int M, int N, int G_, int c_) { nM = M / BM; nN = N / BM; nwg = nM * nN; G = G_; c = c_; }
    __host__ __device__ bool next(int i, Unit& u) const {
        const long L = (long)i * G + c; if (L >= nwg) return false;
        int wgid = (int)L; { const int q = nwg / NXCD, r = nwg % NXCD, xcd = wgid % NXCD, off = wgid / NXCD; wgid = (xcd < r ? xcd * (q + 1) : r * (q + 1) + (xcd - r) * q) + off; }
        const int nig = WGM * nN, gid = wgid / nig, fm = gid * WGM, gsz = (nM - fm) < WGM ? (nM - fm) : WGM;
        u.pm = fm + ((wgid % nig) % gsz); u.pn = (wgid % nig) / gsz; u.g = 0; return true;
    }
    __device__ __forceinline__ void a_ready(const Unit&) const {}
    __device__ __forceinline__ void done(const Unit&) const {}
};


struct SegOrder4 {
    StaticOrder so;
    __host__ __device__ bool next(int i, Unit& u) const { if (!so.next(i >> 2, u)) return false; u.g = i & 3; return true; }
    __device__ __forceinline__ void a_ready(const Unit&) const {}
    __device__ __forceinline__ void done(const Unit&) const {}
};

typedef _Float16 h16;
typedef _Float16 h16x4 __attribute__((ext_vector_type(4)));
typedef unsigned u32x2 __attribute__((ext_vector_type(2)));
__device__ __forceinline__ unsigned cvt_pk_bf16(float lo, float hi) { unsigned r; asm volatile("v_cvt_pk_bf16_f32 %0, %1, %2" : "=v"(r) : "v"(lo), "v"(hi)); return r; }
__device__ __forceinline__ u32x2 pack_bf16x4(f32x4 v) { u32x2 w; w.x = cvt_pk_bf16(v[0], v[1]); w.y = cvt_pk_bf16(v[2], v[3]); return w; }
__device__ __forceinline__ h16x4 pack_h16x4(f32x4 v) { h16x4 w; w[0] = (h16)v[0]; w[1] = (h16)v[1]; w[2] = (h16)v[2]; w[3] = (h16)v[3]; return w; }
__device__ __forceinline__ float fast_sigmoid(float x) { return __builtin_amdgcn_rcpf(1.0f + __expf(-x)); }
__device__ __forceinline__ float row_rstd(const float* SS, int row) {
    const f32x4* p = (const f32x4*)(SS + (size_t)row * 16);
    const f32x4 a = p[0], b = p[1], c = p[2], d = p[3];
    const float s = ((a[0] + a[1]) + (a[2] + a[3])) + ((b[0] + b[1]) + (b[2] + b[3])) + ((c[0] + c[1]) + (c[2] + c[3])) + ((d[0] + d[1]) + (d[2] + d[3]));
    return rsqrtf(s * (1.0f / 1024.0f) + 1e-6f);
}

__device__ __forceinline__ void rows_rstd(const float* SS, int row0, int fq, float (&rs)[8]) {
    f32x4 q[8];
#pragma unroll
    for (int sl = 0; sl < 8; ++sl) q[sl] = *(const f32x4*)(SS + (size_t)(row0 + (sl >> 2) * HALF + (sl & 3) * 16) * 16 + 4 * fq);
#pragma unroll
    for (int sl = 0; sl < 8; ++sl) { float s = (q[sl][0] + q[sl][1]) + (q[sl][2] + q[sl][3]); s += __shfl_xor(s, 16); s += __shfl_xor(s, 32); rs[sl] = rsqrtf(s * (1.0f / 1024.0f) + 1e-6f); }
}

struct EpiGU {
    static constexpr bool PERM = true, KSEG = false;
    bf16_t* hid; const float* SS;
    __device__ __forceinline__ void operator()(const f32x4 (&acc)[2][2][4][2], const Unit& u, int wr, int wc, int fr, int fq) const {
        int row0 = u.pm * BM + wr * 64 + fr; asm volatile("" : "+v"(row0)); const int j0 = u.pn * 128 + wc * 32 + fq * 8;
        float rsv[8]; rows_rstd(SS, row0, fq, rsv);
#pragma unroll
        for (int ai = 0; ai < 2; ++ai)
#pragma unroll
            for (int m = 0; m < 4; ++m) { const int row = row0 + ai * HALF + m * 16; const float rs = rsv[ai * 4 + m]; u32x4 w;
#pragma unroll
                for (int n = 0; n < 2; ++n) { const f32x4 g = acc[ai][0][m][n] * rs, up = acc[ai][1][m][n] * rs; f32x4 h;
#pragma unroll
                    for (int i = 0; i < 4; ++i) h[i] = g[i] * fast_sigmoid(g[i]) * up[i];
                    const u32x2 p = pack_bf16x4(h); if (n == 0) { w.x = p.x; w.y = p.y; } else { w.z = p.x; w.w = p.y; } }
                *(u32x4*)(hid + (size_t)row * 2816 + j0) = w; }
    }
};
struct EpiDown {
    static constexpr bool PERM = false, KSEG = false;
    const float* res; float* X; bf16_t* xb; float* SS; float alpha;
    __device__ __forceinline__ void operator()(const f32x4 (&acc)[2][2][4][2], const Unit& u, int wr, int wc, int fr, int fq) const {
        int row0 = u.pm * BM + wr * 64 + fr; asm volatile("" : "+v"(row0)); const int c0 = u.pn * BM + wc * 32 + fq * 4;
#pragma unroll
        for (int ai = 0; ai < 2; ++ai) {
            f32x4 rv[4][2][2];
#pragma unroll
            for (int m = 0; m < 4; ++m)
#pragma unroll
                for (int bj = 0; bj < 2; ++bj)
#pragma unroll
                    for (int n = 0; n < 2; ++n) rv[m][bj][n] = *(const f32x4*)(res + (size_t)(row0 + ai * HALF + m * 16) * 1024 + c0 + bj * HALF + n * 16);
#pragma unroll
            for (int m = 0; m < 4; ++m) { const int row = row0 + ai * HALF + m * 16; float ss = 0.f;
#pragma unroll
                for (int bj = 0; bj < 2; ++bj)
#pragma unroll
                    for (int n = 0; n < 2; ++n) { const size_t off = (size_t)row * 1024 + c0 + bj * HALF + n * 16;
                        const f32x4 o = rv[m][bj][n] + acc[ai][bj][m][n] * alpha;
                        *(f32x4*)(X + off) = o; *(u32x2*)(xb + off) = pack_bf16x4(o);
                        ss += (o[0] * o[0] + o[1] * o[1]) + (o[2] * o[2] + o[3] * o[3]); }
                ss += __shfl_xor(ss, 16); ss += __shfl_xor(ss, 32);
                if (fq == 0) SS[(size_t)row * 16 + u.pn * 4 + wc] = ss; }
            asm volatile("" ::: "memory"); }
    }
};
struct EpiInA {
    static constexpr bool PERM = false, KSEG = false;
    h16* U5; h16* PP; h16* L16; const float* SS;
    __device__ __forceinline__ void operator()(const f32x4 (&acc)[2][2][4][2], const Unit& u, int wr, int wc, int fr, int fq) const {
        int row0 = u.pm * BM + wr * 64 + fr; asm volatile("" : "+v"(row0)); const int cl = wc * 32 + fq * 4;
        float rsv[8]; rows_rstd(SS, row0, fq, rsv);
        h16* base; int ld, cb;
        if (u.pn == 0) { base = U5; ld = 256; cb = 0; } else if (u.pn < 8) { base = PP; ld = 1792; cb = (u.pn - 1) * 256; } else { base = L16; ld = 512; cb = (u.pn - 8) * 256; }
#pragma unroll
        for (int ai = 0; ai < 2; ++ai)
#pragma unroll
            for (int m = 0; m < 4; ++m) { const int row = row0 + ai * HALF + m * 16; const float rs = rsv[ai * 4 + m];
#pragma unroll
                for (int bj = 0; bj < 2; ++bj)
#pragma unroll
                    for (int n = 0; n < 2; ++n) *(h16x4*)(base + (size_t)row * ld + cb + cl + bj * HALF + n * 16) = pack_h16x4(acc[ai][bj][m][n] * rs); }
    }
};
struct EpiGate {
    static constexpr bool PERM = false, KSEG = false;
    h16* R; const float* SS;
    __device__ __forceinline__ void operator()(const f32x4 (&acc)[2][2][4][2], const Unit& u, int wr, int wc, int fr, int fq) const {
        float rsv[8]; int row0 = u.pm * BM + wr * 64 + fr; asm volatile("" : "+v"(row0)); rows_rstd(SS, row0, fq, rsv); const int d0 = 256 * (u.pn >> 2) + 128 * ((u.pn >> 1) & 1) + 16 * (u.pn & 1) + 32 * wc + 4 * fq;
#pragma unroll
        for (int ai = 0; ai < 2; ++ai)
#pragma unroll
            for (int m = 0; m < 4; ++m) { const int row = row0 + ai * HALF + m * 16; const float rs = rsv[ai * 4 + m];
                f32x4 e[4];
#pragma unroll
                for (int g = 0; g < 4; ++g)
#pragma unroll
                    for (int i = 0; i < 4; ++i) e[g][i] = 1.0f + __expf(-fminf(fmaxf(acc[ai][g >> 1][m][g & 1][i] * rs, -10.f), 30.f));
                f32x4 r[4];
#pragma unroll
                for (int i = 0; i < 4; ++i) { const float i0 = __builtin_amdgcn_rcpf(e[0][i]), i1 = __builtin_amdgcn_rcpf(e[1][i]), i2 = __builtin_amdgcn_rcpf(e[2][i]), i3 = __builtin_amdgcn_rcpf(e[3][i]);
                    r[0][i] = e[1][i] * i0; r[1][i] = e[2][i] * i1; r[2][i] = e[3][i] * i2; r[3][i] = i3; }
#pragma unroll
                for (int g = 0; g < 4; ++g) *(h16x4*)(R + ((size_t)row * 4 + g) * 1024 + d0) = pack_h16x4(r[g]); }
    }
};
struct EpiBranch {
    static constexpr bool PERM = false, KSEG = true;
    const h16* R; bf16_t* out;
    __device__ __forceinline__ void operator()(f32x4 (&acc)[2][2][4][2], const Unit& u, int wr, int wc, int fr, int fq) const {
        unsigned q0 = (unsigned)(u.pm * BM + wr * 64 + fr) * 1024u + (unsigned)(u.pn * BM + wc * 32 + fq * 4); asm volatile("" : "+v"(q0));
        const unsigned r0 = (q0 - (q0 & 1023u)) * 4u + (unsigned)u.g * 1024u + (q0 & 1023u);
        const bool last = u.g == 3;
        h16x4 rr[2][4][2][2];
#pragma unroll
        for (int ai = 0; ai < 2; ++ai)
#pragma unroll
            for (int m = 0; m < 4; ++m)
#pragma unroll
                for (int bj = 0; bj < 2; ++bj)
#pragma unroll
                    for (int n = 0; n < 2; ++n) rr[ai][m][bj][n] = *(const h16x4*)(R + (r0 + (unsigned)((ai * HALF + m * 16) * 4096 + bj * HALF + n * 16)));
#pragma unroll
        for (int ai = 0; ai < 2; ++ai)
#pragma unroll
            for (int m = 0; m < 4; ++m) {
#pragma unroll
                for (int bj = 0; bj < 2; ++bj)
#pragma unroll
                    for (int n = 0; n < 2; ++n) { const unsigned off = q0 + (unsigned)((ai * HALF + m * 16) * 1024 + bj * HALF + n * 16);
                        const h16x4 r = rr[ai][m][bj][n];
                        f32x4 rf; rf[0] = (float)r[0]; rf[1] = (float)r[1]; rf[2] = (float)r[2]; rf[3] = (float)r[3];
                        acc[ai][bj][m][n] = acc[ai][bj][m][n] * rf;
                        if (last) *(u32x2*)(out + off) = pack_bf16x4(acc[ai][bj][m][n]); } }
    }
};
struct EpiGlu {
    static constexpr bool PERM = false, KSEG = false;
    const bf16_t* gl; bf16_t* ys;
    __device__ __forceinline__ void operator()(const f32x4 (&acc)[2][2][4][2], const Unit& u, int wr, int wc, int fr, int fq) const {
        int row0 = u.pm * BM + wr * 64 + fr; asm volatile("" : "+v"(row0)); const int c0 = wc * 32 + fq * 4;
        u32x2 gv[2][4][2][2];
#pragma unroll
        for (int ai = 0; ai < 2; ++ai)
#pragma unroll
            for (int m = 0; m < 4; ++m)
#pragma unroll
                for (int bj = 0; bj < 2; ++bj)
#pragma unroll
                    for (int n = 0; n < 2; ++n) gv[ai][m][bj][n] = *(const u32x2*)(gl + (size_t)(row0 + ai * HALF + m * 16) * 256 + c0 + bj * HALF + n * 16);
#pragma unroll
        for (int ai = 0; ai < 2; ++ai)
#pragma unroll
            for (int m = 0; m < 4; ++m) { const int row = row0 + ai * HALF + m * 16;
#pragma unroll
                for (int bj = 0; bj < 2; ++bj)
#pragma unroll
                    for (int n = 0; n < 2; ++n) { const int c = c0 + bj * HALF + n * 16; const u32x2 g2 = gv[ai][m][bj][n];
                        f32x4 g; g[0] = __uint_as_float(g2.x << 16); g[1] = __uint_as_float(g2.x & 0xffff0000u); g[2] = __uint_as_float(g2.y << 16); g[3] = __uint_as_float(g2.y & 0xffff0000u);
                        f32x4 o;
#pragma unroll
                        for (int i = 0; i < 4; ++i) o[i] = g[i] * fast_sigmoid(acc[ai][bj][m][n][i]);
                        *(u32x2*)(ys + (size_t)row * 1024 + c) = pack_bf16x4(o); } }
    }
};

template <class Epi, class Sched, bool ALIGN_EPI = false, bool SP2 = false>
__device__ __forceinline__ void gemm_phase(PG8_LAS unsigned char* lds, const Gemm g, const Sched& S, const Epi& E, const int tid) {
    const int wid = __builtin_amdgcn_readfirstlane(tid >> 6), lane = tid & 63, wr = wid >> 2, wc = wid & 3, fr = lane & 15, fq = lane >> 4;
    const int K = g.K, nt = K / BK / g.nseg; const size_t segb = (size_t)(K / g.nseg) * 2;
    unsigned voffA[2], voffB[2];
#pragma unroll
    for (int i = 0; i < 2; ++i) { int R, C; stage_rc(tid * 16 + i * 8192, R, C); const int Rb = Epi::PERM ? ((R & ~31) + perm32(R & 31)) : R;
        voffA[i] = (unsigned)(R * K + C) * 2u; voffB[i] = (unsigned)(Rb * K + C) * 2u; }
    const size_t kstep = (size_t)(BK * 2);
    const size_t hstep = (size_t)HALF * K * 2;
    const size_t tstep = 2 * hstep;
    const unsigned ldsw = (unsigned)wid * 1024u;
    const int aoff = lds_byte(wr * 64 + fr, fq * 8), boff = lds_byte(wc * 32 + fr, fq * 8);
#define PG8_SA(b, h) (((b) * 2 + (h)) * HTB)
#define PG8_SB(b, h) ((4 + (b) * 2 + (h)) * HTB)
#define PG8_STAGE(bufoff, gbase, voff) do { _Pragma("unroll") for (int _i = 0; _i < 2; ++_i) \
        __builtin_amdgcn_global_load_lds((const unsigned*)((const char*)(gbase) + (voff)[_i]), (PG8_LAS unsigned*)(lds + (bufoff) + ldsw + _i * 8192), 16, 0, 0); } while (0)
#define PG8_LDA(dst, b, h) do { _Pragma("unroll") for (int m = 0; m < 4; ++m) _Pragma("unroll") for (int k = 0; k < 2; ++k) dst[m][k] = *(const PG8_LAS bf16x8*)(lds + PG8_SA(b, h) + aoff + m * 2048 + k * 1024); } while (0)
#define PG8_LDB(dst, b, h) do { _Pragma("unroll") for (int n = 0; n < 2; ++n) _Pragma("unroll") for (int k = 0; k < 2; ++k) dst[n][k] = *(const PG8_LAS bf16x8*)(lds + PG8_SB(b, h) + boff + n * 2048 + k * 1024); } while (0)
#define PG8_MMA(ai, bj, At, Bt) do { __builtin_amdgcn_s_setprio(1); _Pragma("unroll") for (int m = 0; m < 4; ++m) _Pragma("unroll") for (int n = 0; n < 2; ++n) _Pragma("unroll") for (int k = 0; k < 2; ++k) \
        acc[ai][bj][m][n] = __builtin_amdgcn_mfma_f32_16x16x32_bf16(Bt[n][k], At[m][k], acc[ai][bj][m][n], 0, 0, 0); __builtin_amdgcn_s_setprio(0); } while (0)
#define PG8_WAIT_V(n) asm volatile("s_waitcnt vmcnt(" #n ")" ::: "memory")
#define PG8_WAIT_L(n) asm volatile("s_waitcnt lgkmcnt(" #n ")" ::: "memory")
#define PG8_BAR __builtin_amdgcn_s_barrier()
#define PG8_SCHED __builtin_amdgcn_sched_barrier(0)
    Unit cur, nxt; int ui = 0;
    if (!S.next(0, cur)) return;
    f32x4 acc[2][2][4][2];
#pragma unroll
    for (int a = 0; a < 2; ++a)
#pragma unroll
        for (int b = 0; b < 2; ++b)
#pragma unroll
            for (int m = 0; m < 4; ++m)
#pragma unroll
                for (int n = 0; n < 2; ++n) acc[a][b][m][n] = (f32x4){0.f, 0.f, 0.f, 0.f};
    bf16x8 At[4][2], B0[2][2], B1[2][2];
    const char* cA = (const char*)g.A + (size_t)cur.pm * tstep + (size_t)cur.g * segb; const char* cB = (const char*)g.Bt + (size_t)cur.pn * tstep + (size_t)cur.g * segb;
    S.a_ready(cur);
    if constexpr (SP2) {
        PG8_STAGE(PG8_SB(0, 0), cB, voffB); PG8_STAGE(PG8_SB(0, 1), cB + hstep, voffB); PG8_STAGE(PG8_SA(0, 0), cA, voffA); PG8_STAGE(PG8_SA(0, 1), cA + hstep, voffA);
        if (wr == 1) PG8_BAR;
        PG8_WAIT_V(2); PG8_BAR;
        PG8_STAGE(PG8_SB(1, 0), cB + kstep, voffB); PG8_STAGE(PG8_SA(1, 0), cA + kstep, voffA); PG8_STAGE(PG8_SB(1, 1), cB + hstep + kstep, voffB);
        PG8_WAIT_V(6); PG8_BAR;
    } else {
        PG8_STAGE(PG8_SB(0, 0), cB, voffB); PG8_STAGE(PG8_SA(0, 0), cA, voffA); PG8_STAGE(PG8_SB(0, 1), cB + hstep, voffB); PG8_STAGE(PG8_SA(0, 1), cA + hstep, voffA);
        if (wr == 1) PG8_BAR;
        PG8_WAIT_V(4); PG8_BAR;
        PG8_STAGE(PG8_SB(1, 0), cB + kstep, voffB); PG8_STAGE(PG8_SA(1, 0), cA + kstep, voffA); PG8_STAGE(PG8_SB(1, 1), cB + hstep + kstep, voffB);
        PG8_WAIT_V(6); PG8_BAR;
    }
    for (;;) {
        const bool has_next = S.next(ui + 1, nxt);
        const char* nA = has_next ? (const char*)g.A + (size_t)nxt.pm * tstep + (size_t)nxt.g * segb : cA; const char* nB = has_next ? (const char*)g.Bt + (size_t)nxt.pn * tstep + (size_t)nxt.g * segb : cB;
        for (int t = 0; t < nt; t += 2) {
            const bool last = (t == nt - 2);
            const char* a1 = cA + (size_t)(t + 1) * kstep;
            const char* a2 = last ? nA : cA + (size_t)(t + 2) * kstep; const char* b2 = last ? nB : cB + (size_t)(t + 2) * kstep;
            const char* a3 = a2 + kstep; const char* b3 = b2 + kstep;
            if (last && has_next) S.a_ready(nxt);
            if constexpr (SP2) {
            PG8_LDB(B0, 0, 0); PG8_LDB(B1, 0, 1); PG8_SCHED; PG8_LDA(At, 0, 0); PG8_STAGE(PG8_SA(1, 1), a1 + hstep, voffA);
            PG8_WAIT_V(8); PG8_WAIT_L(0); PG8_BAR; PG8_MMA(0, 0, At, B0); PG8_MMA(0, 1, At, B1); PG8_BAR; PG8_SCHED;
            PG8_LDA(At, 0, 1); PG8_STAGE(PG8_SB(0, 0), b2, voffB); PG8_STAGE(PG8_SB(0, 1), b2 + hstep, voffB); PG8_STAGE(PG8_SA(0, 0), a2, voffA);
            PG8_WAIT_V(8); PG8_WAIT_L(0); PG8_BAR; PG8_MMA(1, 0, At, B0); PG8_MMA(1, 1, At, B1); PG8_BAR; PG8_SCHED;
            PG8_LDB(B0, 1, 0); PG8_LDB(B1, 1, 1); PG8_SCHED; PG8_LDA(At, 1, 0); PG8_STAGE(PG8_SA(0, 1), a2 + hstep, voffA);
            PG8_WAIT_V(8); PG8_WAIT_L(0); PG8_BAR; PG8_MMA(0, 0, At, B0); PG8_MMA(0, 1, At, B1); PG8_BAR; PG8_SCHED;
            PG8_LDA(At, 1, 1); PG8_STAGE(PG8_SB(1, 0), b3, voffB); PG8_STAGE(PG8_SB(1, 1), b3 + hstep, voffB); PG8_STAGE(PG8_SA(1, 0), a3, voffA);
            PG8_WAIT_V(8); PG8_WAIT_L(0); PG8_BAR; PG8_MMA(1, 0, At, B0); PG8_MMA(1, 1, At, B1); PG8_BAR; PG8_SCHED;
            } else {
            PG8_LDB(B0, 0, 0); PG8_SCHED; PG8_LDA(At, 0, 0); PG8_STAGE(PG8_SA(1, 1), a1 + hstep, voffA);
            PG8_WAIT_L(8); PG8_BAR; PG8_WAIT_L(0); PG8_MMA(0, 0, At, B0); PG8_BAR; PG8_SCHED;
            PG8_LDB(B1, 0, 1); PG8_STAGE(PG8_SB(0, 0), b2, voffB);
            PG8_BAR; PG8_WAIT_L(0); PG8_MMA(0, 1, At, B1); PG8_BAR;
            PG8_LDA(At, 0, 1); PG8_STAGE(PG8_SA(0, 0), a2, voffA);
            PG8_BAR; PG8_WAIT_L(0); PG8_MMA(1, 0, At, B0); PG8_BAR; PG8_SCHED;
            PG8_STAGE(PG8_SB(0, 1), b2 + hstep, voffB);
            PG8_WAIT_V(6); PG8_BAR; PG8_MMA(1, 1, At, B1); PG8_BAR;
            PG8_LDB(B0, 1, 0); PG8_SCHED; PG8_LDA(At, 1, 0); PG8_STAGE(PG8_SA(0, 1), a2 + hstep, voffA);
            PG8_WAIT_L(8); PG8_BAR; PG8_WAIT_L(0); PG8_MMA(0, 0, At, B0); PG8_BAR; PG8_SCHED;
            PG8_LDB(B1, 1, 1); PG8_STAGE(PG8_SB(1, 0), b3, voffB);
            PG8_BAR; PG8_WAIT_L(0); PG8_MMA(0, 1, At, B1); PG8_BAR;
            PG8_LDA(At, 1, 1); PG8_STAGE(PG8_SA(1, 0), a3, voffA);
            PG8_BAR; PG8_WAIT_L(0); PG8_MMA(1, 0, At, B0); PG8_BAR; PG8_SCHED;
            PG8_STAGE(PG8_SB(1, 1), b3 + hstep, voffB);
            PG8_WAIT_V(6); PG8_BAR; PG8_MMA(1, 1, At, B1); PG8_BAR;
            }
        }
        if constexpr (ALIGN_EPI) { if (wr == 0) PG8_BAR; }
        E(acc, cur, wr, wc, fr, fq); S.done(cur);
        if (!has_next) break;
        if (!(Epi::KSEG && nxt.g != 0))
#pragma unroll
        for (int a = 0; a < 2; ++a)
#pragma unroll
            for (int b = 0; b < 2; ++b)
#pragma unroll
                for (int m = 0; m < 4; ++m)
#pragma unroll
                    for (int n = 0; n < 2; ++n) acc[a][b][m][n] = (f32x4){0.f, 0.f, 0.f, 0.f};
        cur = nxt; cA = nA; cB = nB; ++ui;
        if constexpr (ALIGN_EPI) { if (wr == 1) PG8_BAR; }
    }
    PG8_WAIT_V(0);
    if constexpr (!ALIGN_EPI) { if (wr == 0) PG8_BAR; }
    PG8_BAR;
#undef PG8_SA
#undef PG8_SB
#undef PG8_STAGE
#undef PG8_LDA
#undef PG8_LDB
#undef PG8_MMA
#undef PG8_WAIT_V
#undef PG8_WAIT_L
#undef PG8_BAR
#undef PG8_SCHED
}
}

#define LAS __attribute__((address_space(3)))
typedef unsigned short bf16_t;
typedef _Float16 h16;
typedef _Float16 h16x4 __attribute__((ext_vector_type(4)));
typedef _Float16 h16x8 __attribute__((ext_vector_type(8)));
typedef float f32x4 __attribute__((ext_vector_type(4)));
typedef float f32x2 __attribute__((ext_vector_type(2)));
typedef unsigned u32x4 __attribute__((ext_vector_type(4)));
typedef unsigned u32x2 __attribute__((ext_vector_type(2)));

#ifndef ONE_LAUNCH
#define ONE_LAUNCH 1
#endif
constexpr int NWAVES = 8, NTHR = 512;
constexpr int TT = 16384, SEQ = 8192, DM = 1024, FF = 2816, MW = 256, INW = 6144;
constexpr int LDS_BYTES = 147456;
constexpr size_t MiB = 1u << 20;
constexpr size_t WS_CTL = 0, CTL_ZERO_BYTES = 16384, WS_SS = 1 * MiB, WS_E = 2 * MiB, WS_W = 4 * MiB, WS_B1 = 34 * MiB, WS_B2 = 66 * MiB, WS_Z = 98 * MiB, WS_END = 262 * MiB;
constexpr size_t W_GU1 = 0, W_D1 = W_GU1 + (size_t)2 * FF * DM * 2, W_INA = W_D1 + (size_t)DM * FF * 2;
constexpr size_t W_ING = 0, W_BR = W_ING + (size_t)4096 * DM * 2, W_O = W_BR + (size_t)DM * DM * 2, W_GU2 = W_O + (size_t)DM * DM * 2, W_D2 = W_GU2 + (size_t)2 * FF * DM * 2, W_GLU = W_D2 + (size_t)DM * FF * 2, W_END2 = W_GLU + 256 * 256 * 2;
constexpr size_t W_L2 = 23 * MiB;
static_assert(W_END2 <= 30 * MiB && W_INA + (size_t)2560 * DM * 2 <= 30 * MiB, "W region");
constexpr size_t Z_RW = 0, Z_G16 = 56 * MiB, Z_U5 = 64 * MiB, Z_L16 = 72 * MiB, Z_PP = 88 * MiB, Z_O = 72 * MiB, Z_GL = 144 * MiB, Z_PB = 152 * MiB, Z_LB = 156 * MiB, Z_SB = 160 * MiB;
constexpr size_t Z_HID = 0, Z_R = 0;
static_assert((size_t)TT * 4 * 896 <= 56 * MiB && (size_t)TT * 1792 * 2 <= 56 * MiB && (size_t)TT * FF * 2 <= 144 * MiB && (size_t)TT * 4096 * 2 <= 144 * MiB, "Z region");

typedef const float* cfp_t;
typedef const __attribute__((address_space(4))) cfp_t* in_t;
struct Args { const float* in[41]; float* out; unsigned char* ws; int ph_lo, ph_hi; };

struct Frame {
    LAS unsigned char* lds;
    int tid, lane, wave, G, bx;
    in_t in;
    float* X; unsigned char* ws;
    float* SS; float* E;
    bf16_t *B1, *B2, *HID, *GL;
    h16 *U5, *PP, *L16, *G16, *R;
    float* O; unsigned char* RW;
    float *PB, *LB, *SB;
};

__device__ __forceinline__ unsigned f2bf(float f) { unsigned u = __builtin_bit_cast(unsigned, f); return (u + 0x7fffu + ((u >> 16) & 1u)) >> 16; }
__device__ __forceinline__ unsigned pk2(float lo, float hi) { return f2bf(lo) | (f2bf(hi) << 16); }
#define LDS_WAIT() asm volatile("s_waitcnt lgkmcnt(0)" ::: "memory")
template <int CTRL> __device__ __forceinline__ float dppx(float x) { return __builtin_bit_cast(float, __builtin_amdgcn_update_dpp(0, __builtin_bit_cast(int, x), CTRL, 0xf, 0xf, true)); }
__device__ __forceinline__ float allreduce16(float x) { x += dppx<0xB1>(x); x += dppx<0x4E>(x); x += dppx<0x141>(x); x += dppx<0x140>(x); return x; }
__device__ __forceinline__ float wave_sum(float x) { x = allreduce16(x); x += __shfl_xor(x, 16); x += __shfl_xor(x, 32); return x; }
__device__ __forceinline__ float sigmoidf_(float x) { return __builtin_amdgcn_rcpf(1.0f + __expf(-x)); }

__device__ __forceinline__ int tr_rowmap(int mode, int j, int row0) {
    if (mode == 0) return row0 + j;
    if (mode == 1) return (j >> 7) * 256 + (j & 127);
    if (mode == 2) return (j >> 7) * 256 + 128 + (j & 127);
    const int g = j >> 10, d = j & 1023;
    const int pn = 4 * (d >> 8) + 2 * ((d >> 7) & 1) + ((d >> 4) & 1);
    return 256 * pn + 128 * (g >> 1) + 32 * ((d >> 5) & 3) + 16 * (g & 1) + 4 * ((d >> 2) & 3) + (d & 3);
}
__device__ __forceinline__ void tr_item(const float* W, int ldw, int K, int N, bf16_t* WT, int mode, int row0, const float* s1, const float* s2, int smode, LAS float* scr, int item, int lane) {
    const int nblk = N / 32, kb = item / nblk, nb = item % nblk, k0 = 64 * kb, n0 = 32 * nb;
#pragma unroll
    for (int i = 0; i < 32; ++i) { const int kk = 2 * i + (lane >> 5); const int k = k0 + kk; float sc = 1.0f;
        if (s1) sc = s1[k];
        if (smode == 1) sc *= s2[k]; else if (smode == 2) sc *= (1.0f - s2[k]);
        scr[kk * 33 + (lane & 31)] = W[(size_t)k * ldw + n0 + (lane & 31)] * sc; }
    LDS_WAIT(); asm volatile("" ::: "memory");
    const int c = lane & 7;
#pragma unroll
    for (int j = 0; j < 4; ++j) { const int n = (lane >> 3) + 8 * j; const LAS float* s = scr + (8 * c) * 33 + n;
        u32x4 o; o.x = pk2(s[0 * 33], s[1 * 33]); o.y = pk2(s[2 * 33], s[3 * 33]); o.z = pk2(s[4 * 33], s[5 * 33]); o.w = pk2(s[6 * 33], s[7 * 33]);
        *(u32x4*)(WT + (size_t)tr_rowmap(mode, n0 + n, row0) * K + k0 + 8 * c) = o; }
    LDS_WAIT(); asm volatile("" ::: "memory");
}
#define TRJ(W_, ldw_, K_, N_, dst_, mode_, row0_, s1_, s2_, smode_) { const int ni_ = ((K_) / 64) * ((N_) / 32); if (r >= 0 && r < ni_) tr_item(W_, ldw_, K_, N_, dst_, mode_, row0_, s1_, s2_, smode_, scr, r, F.lane); r -= ni_; }
__device__ __forceinline__ void conv_first_half(Frame& F, int l) {
    LAS float* scr = (LAS float*)(F.lds + F.wave * 16384);
    const int gw = F.bx * NWAVES + F.wave, NGW = F.G * NWAVES;
    unsigned char* wb = F.ws + WS_W;
    const float* n1 = F.in[1] + (size_t)l * DM; const float* nm = F.in[5] + (size_t)l * DM; const float* mu = F.in[19] + (size_t)l * 3 * DM;
    const float* w1 = F.in[21] + (size_t)l * DM * 64; const float* a1 = F.in[24] + (size_t)l * DM * 64; const float* g1 = F.in[26] + (size_t)l * DM * 128;
    bf16_t* ina = (bf16_t*)(wb + W_INA);
    for (int it = gw;; it += NGW) { int r = it;
        TRJ(F.in[2] + (size_t)l * DM * FF, FF, DM, FF, (bf16_t*)(wb + W_GU1), 1, 0, n1, nullptr, 0)
        TRJ(F.in[3] + (size_t)l * DM * FF, FF, DM, FF, (bf16_t*)(wb + W_GU1), 2, 0, n1, nullptr, 0)
        TRJ(F.in[4] + (size_t)l * FF * DM, DM, FF, DM, (bf16_t*)(wb + W_D1), 0, 0, nullptr, nullptr, 0)
        TRJ(F.in[6] + (size_t)l * DM * INW, INW, DM, 2048, ina, 0, 0, nm, nullptr, 0)
        TRJ(w1, 64, DM, 64, ina, 0, 2048, nm, mu, 2)
        TRJ(a1, 64, DM, 64, ina, 0, 2112, nm, mu + DM, 2)
        TRJ(g1, 128, DM, 128, ina, 0, 2176, nm, mu + 2 * DM, 2)
        TRJ(w1, 64, DM, 64, ina, 0, 2304, nm, mu, 1)
        TRJ(a1, 64, DM, 64, ina, 0, 2368, nm, mu + DM, 1)
        TRJ(g1, 128, DM, 128, ina, 0, 2432, nm, mu + 2 * DM, 1)
        TRJ(F.in[22] + (size_t)l * 64 * 256, 256, 64, 256, (bf16_t*)(wb + W_L2), 0, 0, nullptr, nullptr, 0)
        TRJ(F.in[25] + (size_t)l * 64 * 256, 256, 64, 256, (bf16_t*)(wb + W_L2) + 256 * 64, 0, 0, nullptr, nullptr, 0)
        TRJ(F.in[27] + (size_t)l * 128 * 256, 256, 128, 256, (bf16_t*)(wb + W_L2) + 2 * 256 * 64, 0, 0, nullptr, nullptr, 0)
        TRJ(F.in[16] + ((size_t)l * 4 + 0) * 4096, 64, 64, 64, (bf16_t*)(wb + W_L2) + 4 * 256 * 64, 0, 0, nullptr, nullptr, 0)
        TRJ(F.in[16] + ((size_t)l * 4 + 1) * 4096, 64, 64, 64, (bf16_t*)(wb + W_L2) + 4 * 256 * 64, 0, 64, nullptr, nullptr, 0)
        TRJ(F.in[16] + ((size_t)l * 4 + 2) * 4096, 64, 64, 64, (bf16_t*)(wb + W_L2) + 4 * 256 * 64, 0, 128, nullptr, nullptr, 0)
        TRJ(F.in[16] + ((size_t)l * 4 + 3) * 4096, 64, 64, 64, (bf16_t*)(wb + W_L2) + 4 * 256 * 64, 0, 192, nullptr, nullptr, 0)
        if (r >= 0) break; }
}
__device__ __forceinline__ void conv_second_half(Frame& F, int l, int b0) {
    LAS float* scr = (LAS float*)(F.lds + F.wave * 16384);
    const int gw = (F.bx - b0) * NWAVES + F.wave, NGW = (F.G - b0) * NWAVES;
    unsigned char* wb = F.ws + WS_W;
    const float* nm = F.in[5] + (size_t)l * DM; const float* n2 = F.in[36] + (size_t)l * DM;
    for (int it = gw;; it += NGW) { int r = it;
        TRJ(F.in[6] + (size_t)l * DM * INW + 2048, INW, DM, 4096, (bf16_t*)(wb + W_ING), 3, 0, nm, nullptr, 0)
        TRJ(F.in[34] + (size_t)l * DM * DM, DM, DM, DM, (bf16_t*)(wb + W_BR), 0, 0, nullptr, nullptr, 0)
        TRJ(F.in[35] + (size_t)l * DM * DM, DM, DM, DM, (bf16_t*)(wb + W_O), 0, 0, nullptr, nullptr, 0)
        TRJ(F.in[37] + (size_t)l * DM * FF, FF, DM, FF, (bf16_t*)(wb + W_GU2), 1, 0, n2, nullptr, 0)
        TRJ(F.in[38] + (size_t)l * DM * FF, FF, DM, FF, (bf16_t*)(wb + W_GU2), 2, 0, n2, nullptr, 0)
        TRJ(F.in[39] + (size_t)l * FF * DM, DM, FF, DM, (bf16_t*)(wb + W_D2), 0, 0, nullptr, nullptr, 0)
        TRJ(F.in[15] + (size_t)l * 256 * 256, 256, 256, 256, (bf16_t*)(wb + W_GLU), 0, 0, nullptr, nullptr, 0)
        if (r >= 0) break; }
}
__device__ __forceinline__ void prep_x(Frame& F) {
    const int gw = F.bx * NWAVES + F.wave, NGW = F.G * NWAVES;
    const float* x = F.in[0];
    for (int m = gw; m < TT; m += NGW) {
        const f32x4* xr = (const f32x4*)(x + (size_t)m * DM) + F.lane; float s = 0.f;
        unsigned long long* o8 = (unsigned long long*)(F.B1 + (size_t)m * DM) + F.lane;
#pragma unroll
        for (int j = 0; j < 4; ++j) { const f32x4 v = xr[64 * j]; s += (v[0] * v[0] + v[1] * v[1]) + (v[2] * v[2] + v[3] * v[3]);
            o8[64 * j] = (unsigned long long)pk2(v[0], v[1]) | ((unsigned long long)pk2(v[2], v[3]) << 32); }
        s += __shfl_xor(s, 1); s += __shfl_xor(s, 2);
        if ((F.lane & 3) == 0) F.SS[(size_t)m * 16 + (F.lane >> 2)] = s;
    }
}
__device__ __forceinline__ void final_norm(Frame& F) {
    const int gw = F.bx * NWAVES + F.wave, NGW = F.G * NWAVES;
    const f32x4* gn = (const f32x4*)F.in[40] + F.lane;
    for (int m = gw; m < TT; m += NGW) {
        const float rs = pg8::row_rstd(F.SS, m);
        f32x4* xr = (f32x4*)(F.X + (size_t)m * DM) + F.lane;
#pragma unroll
        for (int j = 0; j < 4; ++j) { const f32x4 v = xr[64 * j]; xr[64 * j] = v * rs * gn[64 * j]; }
    }
}

struct S5Par { float ar, ai; float bbr[16], bbi[16]; };
__device__ __forceinline__ void s5_params(Frame& F, int l, int g, int p, S5Par& P) {
    asm volatile("" : "+v"(p));
    const float lr = F.in[7][((size_t)l * 16 + g) * 64 + p], li = F.in[8][((size_t)l * 16 + g) * 64 + p], dt = expf(F.in[9][l * 16 + g]);
    const float mag = expf(lr * dt); P.ar = mag * cosf(li * dt); P.ai = mag * sinf(li * dt);
    const float inv = 1.0f / (lr * lr + li * li); const float qr = lr * inv, qi = -li * inv;
    const float cr = (P.ar - 1.0f) * qr - P.ai * qi, ci = (P.ar - 1.0f) * qi + P.ai * qr;
    const f32x4* br = (const f32x4*)(F.in[10] + (((size_t)l * 16 + g) * 64 + p) * 16); const f32x4* bi = (const f32x4*)(F.in[11] + (((size_t)l * 16 + g) * 64 + p) * 16);
#pragma unroll
    for (int q = 0; q < 4; ++q) { const f32x4 a = br[q], b = bi[q];
#pragma unroll
        for (int i = 0; i < 4; ++i) { P.bbr[4 * q + i] = cr * a[i] - ci * b[i]; P.bbi[4 * q + i] = cr * b[i] + ci * a[i]; } }
}
__device__ __forceinline__ void s5_step(const S5Par& P, const LAS float* urow, float& hr, float& hi) {
    const LAS f32x4* u4 = (const LAS f32x4*)urow; float bur = 0.f, bui = 0.f;
#pragma unroll
    for (int q = 0; q < 4; ++q) { const f32x4 u = u4[q];
#pragma unroll
        for (int i = 0; i < 4; ++i) { bur += P.bbr[4 * q + i] * u[i]; bui += P.bbi[4 * q + i] * u[i]; } }
    const float nr = P.ar * hr - P.ai * hi + bur, ni = P.ar * hi + P.ai * hr + bui; hr = nr; hi = ni;
}
__device__ __forceinline__ void load_u5_tile(Frame& F, int t0, LAS float* ubuf) {
    for (int i = F.tid; i < 64 * 64; i += NTHR) { const int t = i >> 6, q = i & 63; const h16x4 v = *(const h16x4*)(F.U5 + (size_t)(t0 + t) * 256 + 4 * q);
        f32x4 f; f[0] = (float)v[0]; f[1] = (float)v[1]; f[2] = (float)v[2]; f[3] = (float)v[3]; *(LAS f32x4*)(ubuf + t * 256 + 4 * q) = f; }
}


template <bool FIRST> __device__ __forceinline__ void mv32(LAS float* accp, float init, const LAS float* hb, const float* wsrc, int ldw) {
    float w[32];
    asm volatile("" : "+v"(wsrc));
#pragma unroll
    for (int j = 0; j < 32; ++j) w[j] = wsrc[(size_t)j * ldw];
#pragma unroll 2
    for (int tt = 0; tt < 32; ++tt) { const LAS f32x4* h4 = (const LAS f32x4*)(hb + tt * 256); float a = FIRST ? init : accp[tt * 256];
#pragma unroll
        for (int q = 0; q < 8; ++q) { const f32x4 v = h4[q]; a += v[0] * w[4 * q] + v[1] * w[4 * q + 1] + v[2] * w[4 * q + 2] + v[3] * w[4 * q + 3]; }
        accp[tt * 256] = a; }
}
template <int K> __device__ __forceinline__ void lora_mfma(const LAS unsigned short* hb16, int kofs, const bf16_t* Wt, LAS float* outb, int wave, int lane) {
    typedef short bf16x8_t __attribute__((ext_vector_type(8)));
    const int r16 = lane & 15, quad = lane >> 4;
    f32x4 acc[4][2];
#pragma unroll
    for (int rt = 0; rt < 4; ++rt)
#pragma unroll
        for (int ct = 0; ct < 2; ++ct) acc[rt][ct] = (f32x4){0.f, 0.f, 0.f, 0.f};
    bf16x8_t bfr[K / 32][2];
#pragma unroll
    for (int ks = 0; ks < K / 32; ++ks)
#pragma unroll
        for (int ct = 0; ct < 2; ++ct) bfr[ks][ct] = *(const bf16x8_t*)(Wt + (size_t)(wave * 32 + ct * 16 + r16) * K + ks * 32 + quad * 8);
#pragma unroll
    for (int ks = 0; ks < K / 32; ++ks)
#pragma unroll
        for (int rt = 0; rt < 4; ++rt) { const bf16x8_t a = *(const LAS bf16x8_t*)(hb16 + (rt * 16 + r16) * 264 + kofs + ks * 32 + quad * 8);
#pragma unroll
            for (int ct = 0; ct < 2; ++ct) acc[rt][ct] = __builtin_amdgcn_mfma_f32_16x16x32_bf16(a, bfr[ks][ct], acc[rt][ct], 0, 0, 0); }
#pragma unroll
    for (int rt = 0; rt < 4; ++rt)
#pragma unroll
        for (int ct = 0; ct < 2; ++ct)
#pragma unroll
            for (int j = 0; j < 4; ++j) outb[(rt * 16 + quad * 4 + j) * 256 + wave * 32 + ct * 16 + r16] = acc[rt][ct][j];
}
__device__ __forceinline__ void m1_phase(Frame& F, int l) {
    LAS float* ubuf = (LAS float*)F.lds;
    LAS float* pl = (LAS float*)(F.lds + 65536);
    const int tid = F.tid, lane = F.lane, wave = F.wave;
    const int ch = tid & 255, half = tid >> 8;
    for (int c = F.bx; c < TT / 64; c += F.G) {
        const int t0 = c * 64, tb = t0 + half * 32, sb = tb & (SEQ - 1);
        load_u5_tile(F, t0, ubuf);
        __syncthreads();
#pragma unroll 1
        for (int gi = 0; gi < 2; ++gi) { const int g = wave + 8 * gi; S5Par P; s5_params(F, l, g, lane, P); float hr = 0.f, hi = 0.f;
#pragma unroll 2
            for (int j = 0; j < 64; ++j) s5_step(P, ubuf + j * 256 + g * 16, hr, hi);
            *(f32x2*)(F.E + (((size_t)c * 16 + g) * 64 + lane) * 2) = (f32x2){hr, hi}; }
        __syncthreads();
        LAS float* accp = pl + half * 32 * 256 + ch;
        LAS unsigned short* hb16 = (LAS unsigned short*)F.lds;
        const bf16_t* l2w = (const bf16_t*)(F.ws + WS_W + W_L2);
        h16 la[32], lb[32];
#pragma unroll
        for (int tt = 0; tt < 32; ++tt) { const int t = tb + tt; la[tt] = F.L16[(size_t)t * 512 + ch]; lb[tt] = (sb + tt > 0) ? F.L16[(size_t)(t - 1) * 512 + 256 + ch] : (h16)0.f; }
#pragma unroll
        for (int tt = 0; tt < 32; ++tt) { float pre = (float)la[tt] + (float)lb[tt];
            float a = pre; if (ch < 64) a = 1.0f - 2.0f * __builtin_amdgcn_rcpf(1.0f + __expf(2.0f * pre)); else if (ch >= 128) a = sigmoidf_(pre);
            hb16[(half * 32 + tt) * 264 + ch] = (unsigned short)f2bf(a); }
        __syncthreads();
        const int hb = (t0 / SEQ) * 4 + (ch >> 6);
        unsigned char* rwb = F.RW + ((size_t)hb * SEQ + sb) * 896;
        const int cl = ch & 63;
        {
            lora_mfma<64>(hb16, 0, l2w, pl, wave, lane);
            __syncthreads();
            const float w0 = F.in[20][(size_t)l * 256 + ch];
#pragma unroll 2
            for (int tt = 0; tt < 32; ++tt) { const float z = -(accp[tt * 256] + w0); const float sp = fmaxf(z, 0.f) + __logf(1.0f + __expf(-fabsf(z)));
                const float wlog = -sp - 0.5f; const float dec = __expf(-__expf(wlog));
                *(float*)(rwb + (size_t)tt * 896 + cl * 4) = dec; }
        }
        {
            __syncthreads();
            lora_mfma<128>(hb16, 128, l2w + 2 * 256 * 64, pl, wave, lane);
            __syncthreads();
#pragma unroll 4
            for (int tt = 0; tt < 32; ++tt) F.G16[(size_t)(tb + tt) * 256 + ch] = (h16)accp[tt * 256];
        }
        {
            __syncthreads();
            lora_mfma<64>(hb16, 64, l2w + 256 * 64, pl, wave, lane);
            __syncthreads();
            const float a0 = F.in[23][(size_t)l * 256 + ch];
            const float mur = F.in[18][((size_t)l * 3 + 0) * 256 + ch], muk = F.in[18][((size_t)l * 3 + 1) * 256 + ch], muv = F.in[18][((size_t)l * 3 + 2) * 256 + ch];
            const float kkw = F.in[28][(size_t)l * 256 + ch], kaw = F.in[29][(size_t)l * 256 + ch];
            const h16* pp = F.PP + (size_t)tb * 1792 + 256 + ch;
            float rprev = 0.f, kprev = 0.f, vprev = 0.f;
            if (sb > 0) { rprev = (float)pp[-(ptrdiff_t)1792]; kprev = (float)pp[-(ptrdiff_t)1792 + 256]; vprev = (float)pp[-(ptrdiff_t)1792 + 512]; }
#pragma unroll 1
            for (int t16 = 0; t16 < 32; t16 += 16) {
                h16 rq[16], kq[16], vq[16];
#pragma unroll
                for (int tt = 0; tt < 16; ++tt) { const h16* q = pp + (size_t)(t16 + tt) * 1792; rq[tt] = q[0]; kq[tt] = q[256]; vq[tt] = q[512]; }
#pragma unroll
                for (int tt = 0; tt < 16; ++tt) { const float a = sigmoidf_(accp[(t16 + tt) * 256] + a0);
                    const float rp = (float)rq[tt], kp = (float)kq[tt], vp = (float)vq[tt];
                    const float r = rp + (rprev - rp) * mur, k = kp + (kprev - kp) * muk, v = vp + (vprev - vp) * muv;
                    rprev = rp; kprev = kp; vprev = vp;
                    const float kkv = k * kkw; const float kk = kkv * rsqrtf(fmaxf(wave_sum(kkv * kkv), 1e-24f));
                    const float kt = k * (1.0f + (a - 1.0f) * kaw); const float bb = kk * a;
                    h16* o = (h16*)(rwb + (size_t)(t16 + tt) * 896 + 256) + cl;
                    o[0] = (h16)r; o[64] = (h16)kt; o[128] = (h16)v; o[192] = (h16)kk; o[256] = (h16)bb; } }
        }
        __syncthreads();
    }
}

__device__ __forceinline__ void pool_conv_chunk(Frame& F, int l, int c) {
    LAS float* ubuf = (LAS float*)F.lds;
    LAS unsigned short* pb16 = (LAS unsigned short*)(F.lds + 65536);
    const int tid = F.tid; const int ch = tid & 255, half = tid >> 8;
    const int t0 = c * 64, tb = t0 + half * 32, sb = tb & (SEQ - 1);
    {
    {
        const int grp = ch >> 6, win = 2 << grp;
        const h16* up = F.PP + (size_t)tb * 1792 + ch;
        float s = 0.f;
        for (int j = 1; j <= win; ++j) if (sb - j >= 0) s += (float)up[-(ptrdiff_t)j * 1792];
#pragma unroll 1
        for (int t16 = 0; t16 < 32; t16 += 16) {
            h16 uq[16], ul[16];
#pragma unroll
            for (int tt = 0; tt < 16; ++tt) { uq[tt] = up[(size_t)(t16 + tt) * 1792]; ul[tt] = (sb + t16 + tt - win >= 0) ? up[(ptrdiff_t)(t16 + tt - win) * 1792] : (h16)0.f; }
#pragma unroll
            for (int tt = 0; tt < 16; ++tt) { const float u = (float)uq[tt]; s += u; const int pos = sb + t16 + tt;
                s -= (float)ul[tt];
                const float cnt = (float)((pos + 1 < win) ? (pos + 1) : win);
                pb16[(half * 32 + t16 + tt) * 264 + ch] = (unsigned short)f2bf(s / cnt - u); } }
    }
    {
        const h16* zp = F.PP + (size_t)tb * 1792 + 1024 + ch;
        const float cw0 = F.in[33][((size_t)l * 3 + 0) * 256 + ch], cw1 = F.in[33][((size_t)l * 3 + 1) * 256 + ch], cw2 = F.in[33][((size_t)l * 3 + 2) * 256 + ch];
        float z2 = 0.f, z1 = 0.f;
        if (sb >= 1) z1 = (float)zp[-(ptrdiff_t)1792 + 512] * (float)zp[-(ptrdiff_t)1792];
        if (sb >= 2) z2 = (float)zp[-(ptrdiff_t)2 * 1792 + 512] * (float)zp[-(ptrdiff_t)2 * 1792];
#pragma unroll 1
        for (int t16 = 0; t16 < 32; t16 += 16) {
            h16 zx[16], zb[16], zc[16];
#pragma unroll
            for (int tt = 0; tt < 16; ++tt) { const h16* q = zp + (size_t)(t16 + tt) * 1792; zx[tt] = q[0]; zb[tt] = q[256]; zc[tt] = q[512]; }
#pragma unroll
            for (int tt = 0; tt < 16; ++tt) { const float z0 = (float)zc[tt] * (float)zx[tt];
                const float y = (float)zb[tt] * (cw0 * z2 + cw1 * z1 + cw2 * z0);
                F.B2[(size_t)(tb + t16 + tt) * 1024 + 768 + ch] = (bf16_t)f2bf(y); z2 = z1; z1 = z0; } }
    }
    __syncthreads();
    LAS float* accu = ubuf + half * 32 * 256 + ch;
    {
        lora_mfma<64>(pb16, (F.wave >> 1) * 64, (const bf16_t*)(F.ws + WS_W + W_L2) + 4 * 256 * 64, ubuf, F.wave, F.lane);
        __syncthreads();
        const float sc = F.in[17][(size_t)l * 256 + ch];
#pragma unroll 4
        for (int tt = 0; tt < 32; ++tt) F.B2[(size_t)(tb + tt) * 1024 + 256 + ch] = (bf16_t)f2bf(accu[tt * 256] * sc);
    }
    __syncthreads();
    }
}

#define XB_TMO      128
#define XB_XCNT(j)  (256  + 64 * (j))
#define XB_XSUB(j)  (1280 + 64 * (j))
#define XB_XGEN(j)  (2304 + 64 * (j))
#define XB_TOP      3328
#define XB_TOPGEN   3392
#define XCD_BAR_WORDS 3456
#define XB_SPIN_CAP (1u << 18)

__device__ __forceinline__ unsigned xb_ld(unsigned* p)              { return __hip_atomic_load(p, __ATOMIC_RELAXED, __HIP_MEMORY_SCOPE_AGENT); }
__device__ __forceinline__ unsigned xb_add(unsigned* p, unsigned v) { return __hip_atomic_fetch_add(p, v, __ATOMIC_RELAXED, __HIP_MEMORY_SCOPE_AGENT); }
__device__ __forceinline__ unsigned xb_xcc_id() { return (unsigned)__builtin_amdgcn_s_getreg((3 << 11) | 20) & 0xFu; }
#define XB_SPIN(cond, bar) do { unsigned _sp = 0; while (cond) { __builtin_amdgcn_s_sleep(1); \
    if ((++_sp & 255u) == 0u) { if (xb_ld(&(bar)[XB_TMO])) break; if (_sp > XB_SPIN_CAP) { atomicAdd(&(bar)[XB_TMO], 1u); break; } } } } while (0)

struct XcdBarrier {
    unsigned* bar; unsigned x;
    volatile LAS unsigned* st;
};

__device__ __forceinline__ XcdBarrier xcd_barrier_post(unsigned* bar, volatile LAS unsigned* st) {
    XcdBarrier b; b.bar = bar; b.x = xb_xcc_id(); b.st = st;
    if (threadIdx.x == 0) (void)xb_add(&bar[XB_XCNT(b.x)], 1u);
    return b;
}
__device__ __forceinline__ void xcd_barrier_complete(unsigned* bar, unsigned x, unsigned& nloc, unsigned& nx) {
    const unsigned G = gridDim.x * gridDim.y * gridDim.z;
    unsigned sum, cnt, mine, sp = 0u;
    for (;;) {
        sum = 0u; cnt = 0u; mine = 0u;
#pragma unroll
        for (unsigned j = 0; j < 16; ++j) { const unsigned c = xb_ld(&bar[XB_XCNT(j)]); sum += c; cnt += (c > 0u) ? 1u : 0u; mine = (j == x) ? c : mine; }
        if (sum == G) break;
        __builtin_amdgcn_s_sleep(1);
        if ((++sp & 255u) == 0u) { if (xb_ld(&bar[XB_TMO])) break; if (sp > XB_SPIN_CAP) { atomicAdd(&bar[XB_TMO], 1u); break; } }
    }
    nloc = mine > 0u ? mine : 1u; nx = cnt > 0u ? cnt : 1u;
}

__device__ __forceinline__ void xcd_barrier(const XcdBarrier& b) {
    asm volatile("s_waitcnt vmcnt(0)" ::: "memory");
    __syncthreads();
    if (threadIdx.x == 0) {
        unsigned* bar = b.bar;
        __builtin_amdgcn_s_waitcnt(0);
        unsigned nloc = b.st[0], nx = b.st[1];
        if (nloc == 0u) { xcd_barrier_complete(bar, b.x, nloc, nx); b.st[0] = nloc; b.st[1] = nx; }
        const unsigned old = xb_add(&bar[XB_XSUB(b.x)], 1u);
        const unsigned gen = old / nloc;
        if (old + 1u == (gen + 1u) * nloc) {
            __builtin_amdgcn_fence(__ATOMIC_RELEASE, "agent");
            asm volatile("s_waitcnt vmcnt(0)" ::: "memory");
            const unsigned og = xb_add(&bar[XB_TOP], 1u);
            const unsigned tg = og / nx;
            if (og + 1u == (tg + 1u) * nx) xb_add(&bar[XB_TOPGEN], 1u);
            else XB_SPIN(xb_ld(&bar[XB_TOPGEN]) == tg, bar);
            __builtin_amdgcn_fence(__ATOMIC_ACQUIRE, "agent");
            xb_add(&bar[XB_XGEN(b.x)], 1u);
            asm volatile("s_waitcnt vmcnt(0)" ::: "memory");
        } else {
            XB_SPIN(xb_ld(&bar[XB_XGEN(b.x)]) == gen, bar);
            __builtin_amdgcn_fence(__ATOMIC_ACQUIRE, "agent");
            asm volatile("s_waitcnt vmcnt(0)" ::: "memory");
        }
    }
    __syncthreads();
}

__device__ __forceinline__ float a_fma(float a, float b, float c) { float d; asm("v_fma_f32 %0, %1, %2, %3" : "=v"(d) : "v"(a), "v"(b), "v"(c)); return d; }
__device__ __forceinline__ float a_fnma(float a, float b, float c) { float d; asm("v_fma_f32 %0, -%1, %2, %3" : "=v"(d) : "v"(a), "v"(b), "v"(c)); return d; }
__device__ __forceinline__ float a_mul(float a, float b) { float d; asm("v_mul_f32 %0, %1, %2" : "=v"(d) : "v"(a), "v"(b)); return d; }
__device__ __forceinline__ float a_add(float a, float b) { float d; asm("v_add_f32 %0, %1, %2" : "=v"(d) : "v"(a), "v"(b)); return d; }
constexpr int RC_LEN = 256, RC_N = SEQ / RC_LEN;
constexpr int ST_STEPS = 16, ST_FL = ST_STEPS * 384, ST_NPC = ST_STEPS * 56, ST_OB = ST_STEPS * 32 * 16, ST_NSUB = RC_LEN / ST_STEPS;
__device__ __forceinline__ void st_load(const unsigned char* src, int sub, int tid, u32x4 (&rg)[2]) {
#pragma unroll
    for (int n = 0; n < 2; ++n) { const int i = tid + NTHR * n; if (i < ST_NPC) { const int step = i / 56, j = i % 56;
        rg[n] = *(const u32x4*)(src + ((size_t)sub * ST_STEPS + step) * 896 + (j < 16 ? j * 16 : 256 + (j - 16) * 16)); } }
}
__device__ __forceinline__ void st_store(LAS float* buf, int tid, const u32x4 (&rg)[2]) {
#pragma unroll
    for (int n = 0; n < 2; ++n) { const int i = tid + NTHR * n; if (i < ST_NPC) { const int step = i / 56, j = i % 56;
        if (j < 16) { *(LAS u32x4*)(buf + step * 384 + j * 4) = rg[n]; }
        else { const int a = (j - 16) >> 3, e = (j - 16) & 7; const h16x8 h = __builtin_bit_cast(h16x8, rg[n]); f32x4 lo, hi;
            lo[0] = (float)h[0]; lo[1] = (float)h[1]; lo[2] = (float)h[2]; lo[3] = (float)h[3]; hi[0] = (float)h[4]; hi[1] = (float)h[5]; hi[2] = (float)h[6]; hi[3] = (float)h[7];
            LAS f32x4* d = (LAS f32x4*)(buf + step * 384 + 64 + a * 64 + e * 8); d[0] = lo; d[1] = hi; } } }
}
#define RAW_BAR() do { asm volatile("s_waitcnt lgkmcnt(0)" ::: "memory"); __builtin_amdgcn_s_barrier(); asm volatile("" ::: "memory"); } while (0)
#define DPP_ADD(x_, ctl_) "v_add_f32_dpp %[" x_ "], %[" x_ "], %[" x_ "] " ctl_ " row_mask:0xf bank_mask:0xf bound_ctrl:1\n\t"
template <bool OUT> __device__ __forceinline__ void scan_task(Frame& F, const unsigned char* src, const float* initS, bool ident, bool use_v, float* endS, float* Og) {
    constexpr int STS = OUT ? 8 : 16, NSUB = RC_LEN / STS, FL = STS * 384, NPC = STS * 56, PT = (NPC + NTHR - 1) / NTHR, OB = STS * 64 * 16;
    LAS float* buf = (LAS float*)F.lds;
    LAS float* obuf = (LAS float*)(F.lds + 2 * FL * 4);
    const int tid = F.tid, wave = F.wave, lane = F.lane, ks = lane & 15;
    int rowr[2]; float S[2][4];
#pragma unroll
    for (int r = 0; r < 2; ++r) { rowr[r] = (wave * 2 + r) * 4 + (lane >> 4);
        if (initS) { const f32x4 i4 = *(const f32x4*)(initS + (size_t)rowr[r] * 64 + 4 * ks); S[r][0] = i4[0]; S[r][1] = i4[1]; S[r][2] = i4[2]; S[r][3] = i4[3]; }
        else {
#pragma unroll
            for (int e = 0; e < 4; ++e) S[r][e] = (ident && 4 * ks + e == rowr[r]) ? 1.f : 0.f; } }
    u32x4 rg[2][PT];
#define ST_LOAD(sub_, rg_) do { _Pragma("unroll") for (int n_ = 0; n_ < PT; ++n_) { const int i_ = tid + NTHR * n_; if (i_ < NPC) { const int step_ = i_ / 56, j_ = i_ % 56; \
        rg_[n_] = *(const u32x4*)(src + ((size_t)(sub_) * STS + step_) * 896 + (j_ < 16 ? j_ * 16 : 256 + (j_ - 16) * 16)); } } } while (0)
#define ST_STORE(buf_, rg_) do { _Pragma("unroll") for (int n_ = 0; n_ < PT; ++n_) { const int i_ = tid + NTHR * n_; if (i_ < NPC) { const int step_ = i_ / 56, j_ = i_ % 56; \
        if (j_ < 16) { *(LAS u32x4*)((buf_) + step_ * 384 + j_ * 4) = rg_[n_]; } \
        else { const int a_ = (j_ - 16) >> 3, e_ = (j_ - 16) & 7; const h16x8 h_ = __builtin_bit_cast(h16x8, rg_[n_]); f32x4 lo_, hi_; \
            lo_[0] = (float)h_[0]; lo_[1] = (float)h_[1]; lo_[2] = (float)h_[2]; lo_[3] = (float)h_[3]; hi_[0] = (float)h_[4]; hi_[1] = (float)h_[5]; hi_[2] = (float)h_[6]; hi_[3] = (float)h_[7]; \
            LAS f32x4* d_ = (LAS f32x4*)((buf_) + step_ * 384 + 64 + a_ * 64 + e_ * 8); d_[0] = lo_; d_[1] = hi_; } } } } while (0)
    ST_LOAD(0, rg[0]); ST_STORE(buf, rg[0]); ST_LOAD(1, rg[1]); ST_LOAD(2, rg[0]);
    RAW_BAR();
#pragma unroll 1
    for (int sc2 = 0; sc2 < NSUB; sc2 += 2) {
#pragma unroll
      for (int u = 0; u < 2; ++u) { const int sc = sc2 + u;
        if (sc + 1 < NSUB) { ST_STORE(buf + ((sc + 1) & 1) * FL, rg[(u + 1) & 1]); if (sc + 3 < NSUB) ST_LOAD(sc + 3, rg[(u + 1) & 1]); }
        {
            const LAS float* bb = buf + (sc & 1) * FL + 4 * ks; const LAS float* vb0 = buf + (sc & 1) * FL + 192 + rowr[0]; const LAS float* vb1 = buf + (sc & 1) * FL + 192 + rowr[1];
            LAS float* ob0 = obuf + (sc & 1) * OB + rowr[0] * 16 + ks; LAS float* ob1 = obuf + (sc & 1) * OB + rowr[1] * 16 + ks;
            f32x4 w_[2], r_[2], k_[2], kk_[2], b_[2]; float v_[2][2];
#define SC_LD(s_, j_) do { const LAS float* p_ = bb + (s_) * 384; w_[j_] = *(const LAS f32x4*)(p_); if (OUT) r_[j_] = *(const LAS f32x4*)(p_ + 64); k_[j_] = *(const LAS f32x4*)(p_ + 128); \
                kk_[j_] = *(const LAS f32x4*)(p_ + 256); b_[j_] = *(const LAS f32x4*)(p_ + 320); v_[j_][0] = vb0[(s_) * 384]; v_[j_][1] = vb1[(s_) * 384]; } while (0)
            SC_LD(0, 0);
#pragma unroll
            for (int s = 0; s < STS; ++s) { const int j = s & 1;
                f32x4 rp; if (OUT) rp = r_[j ^ 1];
                if (s + 1 < STS) SC_LD(s + 1, j ^ 1);
                const f32x4 w = w_[j], k = k_[j], kk = kk_[j], bv = b_[j];
#pragma unroll
                for (int r = 0; r < 2; ++r) { const float v = use_v ? v_[j][r] : 0.f;
                    float sa, op, u0, u1, u2, u3;
                    if (OUT && s > 0) {
                        asm volatile(
                            "v_mul_f32 %[sa], %[Sa], %[kk0]\n\t" "v_fma_f32 %[sa], %[Sb], %[kk1], %[sa]\n\t" "v_fma_f32 %[sa], %[Sc], %[kk2], %[sa]\n\t" "v_fma_f32 %[sa], %[Sd], %[kk3], %[sa]\n\t"
                            "v_mul_f32 %[op], %[Sa], %[r0]\n\t" "v_fma_f32 %[op], %[Sb], %[r1], %[op]\n\t"
                            DPP_ADD("sa", "quad_perm:[1,0,3,2]") "v_fma_f32 %[op], %[Sc], %[r2], %[op]\n\t" "v_fma_f32 %[op], %[Sd], %[r3], %[op]\n\t"
                            DPP_ADD("sa", "quad_perm:[2,3,0,1]") "v_mul_f32 %[u0], %[v], %[k0]\n\t" "v_mul_f32 %[u1], %[v], %[k1]\n\t"
                            DPP_ADD("sa", "row_half_mirror") "v_mul_f32 %[u2], %[v], %[k2]\n\t" "v_mul_f32 %[u3], %[v], %[k3]\n\t"
                            DPP_ADD("sa", "row_mirror")
                            : [sa] "=&v"(sa), [op] "=&v"(op), [u0] "=&v"(u0), [u1] "=&v"(u1), [u2] "=&v"(u2), [u3] "=&v"(u3)
                            : [Sa] "v"(S[r][0]), [Sb] "v"(S[r][1]), [Sc] "v"(S[r][2]), [Sd] "v"(S[r][3]), [kk0] "v"(kk[0]), [kk1] "v"(kk[1]), [kk2] "v"(kk[2]), [kk3] "v"(kk[3]),
                              [r0] "v"(rp[0]), [r1] "v"(rp[1]), [r2] "v"(rp[2]), [r3] "v"(rp[3]), [v] "v"(v), [k0] "v"(k[0]), [k1] "v"(k[1]), [k2] "v"(k[2]), [k3] "v"(k[3]));
                        (r == 0 ? ob0 : ob1)[(s - 1) * 1024] = op;
                    } else {
                        asm volatile(
                            "v_mul_f32 %[sa], %[Sa], %[kk0]\n\t" "v_fma_f32 %[sa], %[Sb], %[kk1], %[sa]\n\t" "v_fma_f32 %[sa], %[Sc], %[kk2], %[sa]\n\t" "v_fma_f32 %[sa], %[Sd], %[kk3], %[sa]\n\t"
                            "v_mul_f32 %[u0], %[v], %[k0]\n\t" "v_mul_f32 %[u1], %[v], %[k1]\n\t"
                            DPP_ADD("sa", "quad_perm:[1,0,3,2]") "v_mul_f32 %[u2], %[v], %[k2]\n\t" "v_mul_f32 %[u3], %[v], %[k3]\n\t"
                            DPP_ADD("sa", "quad_perm:[2,3,0,1]") "s_nop 1\n\t"
                            DPP_ADD("sa", "row_half_mirror") "s_nop 1\n\t"
                            DPP_ADD("sa", "row_mirror")
                            : [sa] "=&v"(sa), [u0] "=&v"(u0), [u1] "=&v"(u1), [u2] "=&v"(u2), [u3] "=&v"(u3)
                            : [Sa] "v"(S[r][0]), [Sb] "v"(S[r][1]), [Sc] "v"(S[r][2]), [Sd] "v"(S[r][3]), [kk0] "v"(kk[0]), [kk1] "v"(kk[1]), [kk2] "v"(kk[2]), [kk3] "v"(kk[3]),
                              [v] "v"(v), [k0] "v"(k[0]), [k1] "v"(k[1]), [k2] "v"(k[2]), [k3] "v"(k[3]));
                    }
                    asm volatile(
                        "v_fma_f32 %[u0], -%[sa], %[b0], %[u0]\n\t" "v_fma_f32 %[u1], -%[sa], %[b1], %[u1]\n\t" "v_fma_f32 %[u2], -%[sa], %[b2], %[u2]\n\t" "v_fma_f32 %[u3], -%[sa], %[b3], %[u3]\n\t"
                        "v_fma_f32 %[Sa], %[Sa], %[w0], %[u0]\n\t" "v_fma_f32 %[Sb], %[Sb], %[w1], %[u1]\n\t" "v_fma_f32 %[Sc], %[Sc], %[w2], %[u2]\n\t" "v_fma_f32 %[Sd], %[Sd], %[w3], %[u3]\n\t"
                        : [Sa] "+v"(S[r][0]), [Sb] "+v"(S[r][1]), [Sc] "+v"(S[r][2]), [Sd] "+v"(S[r][3]), [u0] "+v"(u0), [u1] "+v"(u1), [u2] "+v"(u2), [u3] "+v"(u3)
                        : [sa] "v"(sa), [b0] "v"(bv[0]), [b1] "v"(bv[1]), [b2] "v"(bv[2]), [b3] "v"(bv[3]), [w0] "v"(w[0]), [w1] "v"(w[1]), [w2] "v"(w[2]), [w3] "v"(w[3])); }
                __builtin_amdgcn_sched_barrier(0); }
            if (OUT) { const f32x4 r4 = r_[(STS - 1) & 1];
              ob0[(STS - 1) * 1024] = a_fma(S[0][3], r4[3], a_fma(S[0][2], r4[2], a_fma(S[0][1], r4[1], a_mul(S[0][0], r4[0]))));
              ob1[(STS - 1) * 1024] = a_fma(S[1][3], r4[3], a_fma(S[1][2], r4[2], a_fma(S[1][1], r4[1], a_mul(S[1][0], r4[0])))); }
#undef SC_LD
        }
        RAW_BAR();
        if (OUT) {
            const LAS f32x4* p = (const LAS f32x4*)(obuf + (sc & 1) * OB + tid * 16); const f32x4 a = p[0], b = p[1], c = p[2], d = p[3];
            const float o = (((a[0] + a[1]) + (a[2] + a[3])) + ((b[0] + b[1]) + (b[2] + b[3]))) + (((c[0] + c[1]) + (c[2] + c[3])) + ((d[0] + d[1]) + (d[2] + d[3])));
            Og[((size_t)sc * STS + (tid >> 6)) * 256 + (tid & 63)] = o; }
      }
    }
#undef ST_LOAD
#undef ST_STORE
    if (endS) {
#pragma unroll
        for (int r = 0; r < 2; ++r) *(f32x4*)(endS + (size_t)rowr[r] * 64 + 4 * ks) = (f32x4){S[r][0], S[r][1], S[r][2], S[r][3]}; }
    RAW_BAR();
}
#undef DPP_ADD
__device__ __forceinline__ void rwkv_carry(Frame& F) {
    const int hb = F.bx >> 3, row = (F.bx & 7) * 8 + F.wave, lane = F.lane, tid = F.tid;
    LAS float* Pl = (LAS float*)F.lds;
    LAS float* Sl = (LAS float*)(F.lds + 16384) + F.wave * 64;
    float S = 0.f;
    const size_t m0 = (size_t)hb * RC_N * 4096;
    f32x4 p0 = *(const f32x4*)(F.PB + m0 + (size_t)tid * 8), p1 = *(const f32x4*)(F.PB + m0 + (size_t)tid * 8 + 4);
    float lc = F.LB[m0 + (size_t)row * 64 + lane];
#pragma unroll 1
    for (int c = 0; c < RC_N; ++c) { const size_t mo = m0 + (size_t)c * 4096;
        F.SB[mo + (size_t)row * 64 + lane] = S;
        if (c + 1 == RC_N) break;
        float acc = lc;
        *(LAS f32x4*)(Pl + tid * 8) = p0; *(LAS f32x4*)(Pl + tid * 8 + 4) = p1; Sl[lane] = S;
        if (c + 2 < RC_N) { p0 = *(const f32x4*)(F.PB + mo + 4096 + (size_t)tid * 8); p1 = *(const f32x4*)(F.PB + mo + 4096 + (size_t)tid * 8 + 4); lc = F.LB[mo + 4096 + (size_t)row * 64 + lane]; }
        RAW_BAR();
        float a0 = 0.f, a1 = 0.f, a2 = 0.f, a3 = 0.f;
#pragma unroll 4
        for (int j = 0; j < 64; j += 4) { const f32x4 s4 = *(const LAS f32x4*)(Sl + j);
            a0 += s4[0] * Pl[(j + 0) * 64 + lane]; a1 += s4[1] * Pl[(j + 1) * 64 + lane]; a2 += s4[2] * Pl[(j + 2) * 64 + lane]; a3 += s4[3] * Pl[(j + 3) * 64 + lane]; }
        S = acc + ((a0 + a1) + (a2 + a3));
        RAW_BAR();
    }
}
__device__ __forceinline__ float gelu_tanh(float x) { const float u = 0.7978845608028654f * (x + 0.044715f * x * x * x); return 0.5f * x * (1.0f + tanhf(u)); }
__device__ __forceinline__ void s5_pass2(Frame& F, int l, int c) {
    typedef short bf16x8_t __attribute__((ext_vector_type(8)));
    LAS float* ubuf = (LAS float*)F.lds;
    const int t0 = c * 64, lane = F.lane, wave = F.wave, cb0 = c & ~127;
    LAS unsigned short* hb = (LAS unsigned short*)(F.lds + 65536) + wave * (16 * 136);
    load_u5_tile(F, t0, ubuf);
    __syncthreads();
    const int r16 = lane & 15, quad = lane >> 4;
#pragma unroll 1
    for (int gi = 0; gi < 2; ++gi) { const int g = wave + 8 * gi; S5Par P; s5_params(F, l, g, lane, P);
        int lane_l = lane; asm volatile("" : "+v"(lane_l));
        bf16x8_t cf[4];
#pragma unroll
        for (int ks = 0; ks < 4; ++ks) { const float* src = (ks < 2 ? F.in[12] : F.in[13]) + (((size_t)l * 16 + g) * 16 + (lane_l & 15)) * 64 + (ks & 1) * 32 + quad * 8;
            const f32x4 a = *(const f32x4*)src, b = *(const f32x4*)(src + 4); const float sg = ks < 2 ? 1.0f : -1.0f;
            cf[ks][0] = (short)f2bf(a[0] * sg); cf[ks][1] = (short)f2bf(a[1] * sg); cf[ks][2] = (short)f2bf(a[2] * sg); cf[ks][3] = (short)f2bf(a[3] * sg);
            cf[ks][4] = (short)f2bf(b[0] * sg); cf[ks][5] = (short)f2bf(b[1] * sg); cf[ks][6] = (short)f2bf(b[2] * sg); cf[ks][7] = (short)f2bf(b[3] * sg); }
        const int chy = g * 16 + r16; const float dd = F.in[14][(size_t)l * 256 + chy];
        float pr = P.ar, pi = P.ai;
#pragma unroll
        for (int s = 0; s < 6; ++s) { const float nr = pr * pr - pi * pi, ni = 2.0f * pr * pi; pr = nr; pi = ni; }
        float hr = 0.f, hi = 0.f;
#pragma unroll 1
        for (int c2 = cb0; c2 < c; c2 += 16) {
            f32x2 e[16];
#pragma unroll
            for (int q = 0; q < 16; ++q) { const int cq = (c2 + q < c) ? c2 + q : c2; e[q] = *(const f32x2*)(F.E + (((size_t)cq * 16 + g) * 64 + lane_l) * 2); }
#pragma unroll
            for (int q = 0; q < 16; ++q) if (c2 + q < c) { const float nr = pr * hr - pi * hi + e[q][0], ni = pr * hi + pi * hr + e[q][1]; hr = nr; hi = ni; } }
#pragma unroll 1
        for (int tb = 0; tb < 4; ++tb) {
#pragma unroll 4
            for (int j = 0; j < 16; ++j) { s5_step(P, ubuf + (tb * 16 + j) * 256 + g * 16, hr, hi);
                hb[j * 136 + lane] = (unsigned short)f2bf(hr); hb[j * 136 + 64 + lane] = (unsigned short)f2bf(hi); }
            f32x4 acc = {0.f, 0.f, 0.f, 0.f};
#pragma unroll
            for (int ks = 0; ks < 4; ++ks) { const bf16x8_t a = *(const LAS bf16x8_t*)(hb + r16 * 136 + ks * 32 + quad * 8);
                acc = __builtin_amdgcn_mfma_f32_16x16x32_bf16(a, cf[ks], acc, 0, 0, 0); }
#pragma unroll
            for (int j = 0; j < 4; ++j) { const int tl = tb * 16 + quad * 4 + j; const float y = acc[j] + dd * ubuf[tl * 256 + chy];
                F.GL[(size_t)(t0 + tl) * 256 + chy] = (bf16_t)f2bf(gelu_tanh(y)); }
        }
    }
    __syncthreads();
}
template <int PART> __device__ __forceinline__ void m2_phase(Frame& F, int l, const XcdBarrier& xbar) {
    if (PART == 0 || PART == 1)
#pragma unroll 1
    for (int id = F.bx; id < 8 * RC_N * 2; id += F.G) { const int hb = id >> 6, c = (id >> 1) & (RC_N - 1), tk = id & 1; const size_t mo = ((size_t)hb * RC_N + c) * 4096;
        if (c == RC_N - 1) continue;
        const unsigned char* src = F.RW + ((size_t)hb * SEQ + (size_t)c * RC_LEN) * 896;
        scan_task<false>(F, src, nullptr, tk == 1, tk == 0, (tk == 0 ? F.LB : F.PB) + mo, nullptr); }
    if (PART == 0 || PART == 2)
#pragma unroll 1
    for (int c = F.bx; c < TT / 64; c += F.G) pool_conv_chunk(F, l, c);
    xcd_barrier(xbar);
    if (PART == 0 || PART == 3) { int bxs = F.bx; asm volatile("" : "+s"(bxs));
      if (bxs < 64) rwkv_carry(F);
      else conv_second_half(F, l, 64); }
    xcd_barrier(xbar);
    if (PART == 0 || PART == 4)
#pragma unroll 1
    for (int id = F.bx; id < 8 * RC_N; id += F.G) { const int hb = id >> 5, c = id & (RC_N - 1); const size_t mo = ((size_t)hb * RC_N + c) * 4096;
        const unsigned char* src = F.RW + ((size_t)hb * SEQ + (size_t)c * RC_LEN) * 896;
        float* Og = F.O + ((size_t)(hb >> 2) * SEQ + (size_t)c * RC_LEN) * 256 + (hb & 3) * 64;
        scan_task<true>(F, src, F.SB + mo, false, true, nullptr, Og); }
    if (PART == 0 || PART == 5)
#pragma unroll 1
    for (int c = F.bx; c < TT / 64; c += F.G) s5_pass2(F, l, c);
}
__device__ __forceinline__ void rwkv_post(Frame& F, int l) {
    const int gw = F.bx * NWAVES + F.wave, NGW = F.G * NWAVES, lane = F.lane;
    for (int it0 = gw * 4; it0 < TT * 4; it0 += NGW * 4) {
        const int t = it0 >> 2, b = t / SEQ, pos = t & (SEQ - 1);
        float o[4], r[4], k[4], v[4], g[4];
#pragma unroll
        for (int hh = 0; hh < 4; ++hh) { const int c = hh * 64 + lane; o[hh] = F.O[(size_t)t * 256 + c]; g[hh] = (float)F.G16[(size_t)t * 256 + c];
            const h16* rw = (const h16*)(F.RW + ((size_t)(b * 4 + hh) * SEQ + pos) * 896 + 256) + lane; r[hh] = (float)rw[0]; k[hh] = (float)rw[64]; v[hh] = (float)rw[128]; }
#pragma unroll
        for (int hh = 0; hh < 4; ++hh) { const int c = hh * 64 + lane;
            const float mu = wave_sum(o[hh]) * (1.0f / 64.0f); const float d = o[hh] - mu; const float var = wave_sum(d * d) * (1.0f / 64.0f);
            const float on = d * rsqrtf(var + 64e-5f) * F.in[31][(size_t)l * 256 + c] + F.in[32][(size_t)l * 256 + c];
            const float bs = wave_sum(r[hh] * k[hh] * F.in[30][(size_t)l * 256 + c]);
            F.B2[(size_t)t * 1024 + 512 + c] = (bf16_t)f2bf((on + bs * v[hh]) * g[hh]); }
    }
}

constexpr int NPH = 25;
#ifndef PHMASK
#define PHMASK 0xFFFF
#endif
#define PHON(k) (((PHMASK) >> (k)) & 1)
#ifndef REP_PART
#define REP_PART 0
#endif
template <int PH, int PART = 0> __device__ __forceinline__ void run_phase(const int wave_s, unsigned char* lds_raw, const XcdBarrier& xbar) {
    typedef pg8::StaticOrder SO;
    int tid = wave_s * 64 + (int)__builtin_amdgcn_mbcnt_hi(~0u, __builtin_amdgcn_mbcnt_lo(~0u, 0u)); asm volatile("" : "+v"(tid));
    int G = gridDim.x, bx = blockIdx.x; asm volatile("" : "+s"(G), "+s"(bx));
    const __attribute__((address_space(4))) unsigned char* ka = (const __attribute__((address_space(4))) unsigned char*)__builtin_amdgcn_kernarg_segment_ptr();
    asm volatile("" : "+s"(ka));
    const __attribute__((address_space(4))) Args* ap = (const __attribute__((address_space(4))) Args*)ka;
    Frame F;
    F.lds = (LAS unsigned char*)lds_raw;
    F.tid = tid; F.lane = tid & 63; F.wave = __builtin_amdgcn_readfirstlane(tid >> 6); F.G = G; F.bx = bx;
    F.in = (in_t)ka; F.X = ap->out; F.ws = ap->ws;
    unsigned char* ws = F.ws;
    F.SS = (float*)(ws + WS_SS); F.E = (float*)(ws + WS_E); F.B1 = (bf16_t*)(ws + WS_B1); F.B2 = (bf16_t*)(ws + WS_B2);
    unsigned char* z = ws + WS_Z;
    F.HID = (bf16_t*)(z + Z_HID); F.GL = (bf16_t*)(z + Z_GL); F.U5 = (h16*)(z + Z_U5); F.PP = (h16*)(z + Z_PP); F.L16 = (h16*)(z + Z_L16); F.G16 = (h16*)(z + Z_G16); F.R = (h16*)(z + Z_R);
    F.O = (float*)(z + Z_O); F.RW = z + Z_RW; F.PB = (float*)(z + Z_PB); F.LB = (float*)(z + Z_LB); F.SB = (float*)(z + Z_SB);
    if constexpr (PH == 0) { conv_first_half(F, 0); prep_x(F); }
    else { constexpr int l = (PH - 1) / 12, k = (PH - 1) % 12;
        if constexpr (k == 0) { pg8::Gemm g{F.B1, (const bf16_t*)(ws + WS_W + W_GU1), TT, 2 * FF, DM, 1}; SO S; S.init(TT, 2 * FF, G, bx); pg8::EpiGU E{F.HID, F.SS}; pg8::gemm_phase<pg8::EpiGU, SO, true, true>(F.lds, g, S, E, tid); }
        else if constexpr (k == 1) { pg8::Gemm g{F.HID, (const bf16_t*)(ws + WS_W + W_D1), TT, DM, FF, 1}; SO S; S.init(TT, DM, G, bx); pg8::EpiDown E{l == 0 ? F.in[0] : F.X, F.X, F.B1, F.SS, 0.5f}; pg8::gemm_phase<pg8::EpiDown, SO, true, true>(F.lds, g, S, E, tid); }
        else if constexpr (k == 2) { pg8::Gemm g{F.B1, (const bf16_t*)(ws + WS_W + W_INA), TT, 2560, DM, 1}; SO S; S.init(TT, 2560, G, bx); pg8::EpiInA E{F.U5, F.PP, F.L16, F.SS}; pg8::gemm_phase<pg8::EpiInA, SO, true, true>(F.lds, g, S, E, tid); }
        else if constexpr (k == 3) { m1_phase(F, l); }
        else if constexpr (k == 4) { m2_phase<PART>(F, l, xbar); }
        else if constexpr (k == 5) { { pg8::Gemm g{F.GL, (const bf16_t*)(ws + WS_W + W_GLU), TT, 256, 256, 1}; SO S; S.init(TT, 256, G, bx); pg8::EpiGlu E{F.GL, F.B2}; pg8::gemm_phase<pg8::EpiGlu, SO, true, true>(F.lds, g, S, E, tid); } rwkv_post(F, l); }
        else if constexpr (k == 6) { pg8::Gemm g{F.B1, (const bf16_t*)(ws + WS_W + W_ING), TT, 4096, DM, 1}; SO S; S.init(TT, 4096, G, bx); pg8::EpiGate E{F.R, F.SS}; pg8::gemm_phase<pg8::EpiGate, SO, true, true>(F.lds, g, S, E, tid); }
        else if constexpr (k == 7) { pg8::Gemm g{F.B2, (const bf16_t*)(ws + WS_W + W_BR), TT, DM, DM, 4}; pg8::SegOrder4 S; S.so.init(TT, DM, G, bx); pg8::EpiBranch E{F.R, F.B1}; pg8::gemm_phase<pg8::EpiBranch, pg8::SegOrder4, true, true>(F.lds, g, S, E, tid); }
        else if constexpr (k == 8) { pg8::Gemm g{F.B1, (const bf16_t*)(ws + WS_W + W_O), TT, DM, DM, 1}; SO S; S.init(TT, DM, G, bx); pg8::EpiDown E{F.X, F.X, F.B2, F.SS, 1.0f}; pg8::gemm_phase<pg8::EpiDown, SO, true, true>(F.lds, g, S, E, tid); }
        else if constexpr (k == 9) { pg8::Gemm g{F.B2, (const bf16_t*)(ws + WS_W + W_GU2), TT, 2 * FF, DM, 1}; SO S; S.init(TT, 2 * FF, G, bx); pg8::EpiGU E{F.HID, F.SS}; pg8::gemm_phase<pg8::EpiGU, SO, true, true>(F.lds, g, S, E, tid); }
        else if constexpr (k == 10) { pg8::Gemm g{F.HID, (const bf16_t*)(ws + WS_W + W_D2), TT, DM, FF, 1}; SO S; S.init(TT, DM, G, bx); pg8::EpiDown E{F.X, F.X, F.B1, F.SS, 0.5f}; pg8::gemm_phase<pg8::EpiDown, SO, true, true>(F.lds, g, S, E, tid); }
        else { if constexpr (l == 0) conv_first_half(F, 1); else final_norm(F); }
    }
}
#ifndef REPMASK
#define REPMASK 0
#endif
#define SEAM(k_) do { if ((k_) == 0) { __syncthreads(); cg::this_grid().sync(); } else xcd_barrier(xbar); } while (0)
#define PHASE(k) if (ph_lo <= (k) && (k) < ph_hi) { run_phase<(k)>(wave_s, lds_raw, xbar); \
    if ((k) >= 1 && ((REPMASK >> (((k) - 1) % 12)) & 1)) { SEAM(k); run_phase<(k), REP_PART>(wave_s, lds_raw, xbar); } \
    if ((k) + 1 < ph_hi) SEAM(k); }
__global__ void __launch_bounds__(NTHR, 2) mk_fwd(Args args) {
    extern __shared__ __attribute__((aligned(16))) unsigned char lds_raw[];
    const int ph_lo = args.ph_lo, ph_hi = args.ph_hi;
    volatile LAS unsigned* xst = (volatile LAS unsigned*)((LAS unsigned char*)lds_raw + (LDS_BYTES - 64));
    if (threadIdx.x == 0) { xst[0] = 0u; xst[1] = 0u; }
    __syncthreads();
    const XcdBarrier xbar = xcd_barrier_post((unsigned*)(args.ws + WS_CTL), xst);
    const int wave_s = __builtin_amdgcn_readfirstlane((int)threadIdx.x >> 6);
    PHASE(0) PHASE(1) PHASE(2) PHASE(3) PHASE(4) PHASE(5) PHASE(6) PHASE(7) PHASE(8) PHASE(9) PHASE(10) PHASE(11) PHASE(12)
    PHASE(13) PHASE(14) PHASE(15) PHASE(16) PHASE(17) PHASE(18) PHASE(19) PHASE(20) PHASE(21) PHASE(22) PHASE(23) PHASE(24)
}

extern "C" void kernel_launch(void* const* d_in, const int* in_sizes, int n_in, void* d_out, int out_size, void* d_ws, size_t ws_size, hipStream_t stream) {
    static int grid = 0;
    if (grid == 0) {
        if (n_in != 41 || out_size != TT * DM || ws_size < WS_END) { fprintf(stderr, "kernel_launch: unexpected shapes (n_in %d out %d ws %zu)\n", n_in, out_size, ws_size); grid = -1; return; }
        int dev = 0, cus = 0, per_cu = 0;
        (void)hipGetDevice(&dev); (void)hipDeviceGetAttribute(&cus, hipDeviceAttributeMultiprocessorCount, dev);
        if (hipFuncSetAttribute((const void*)mk_fwd, hipFuncAttributeMaxDynamicSharedMemorySize, LDS_BYTES) != hipSuccess) { fprintf(stderr, "kernel_launch: hipFuncSetAttribute failed\n"); grid = -1; return; }
        if (hipOccupancyMaxActiveBlocksPerMultiprocessor(&per_cu, (const void*)mk_fwd, NTHR, LDS_BYTES) != hipSuccess || per_cu < 1) { fprintf(stderr, "kernel_launch: occupancy query says %d\n", per_cu); per_cu = 1; }
        (void)hipGetLastError();
        grid = cus * (per_cu >= 1 ? 1 : 1);
        if (grid < 64) { fprintf(stderr, "kernel_launch: grid %d too small\n", grid); }
    }
    if (grid < 0) return;
    if (hipMemsetAsync((char*)d_ws + WS_CTL, 0, CTL_ZERO_BYTES, stream) != hipSuccess) { fprintf(stderr, "kernel_launch: hipMemsetAsync failed\n"); return; }
    Args a{};
    for (int i = 0; i < 41; ++i) a.in[i] = (const float*)d_in[i];
    a.out = (float*)d_out; a.ws = (unsigned char*)d_ws;
#if ONE_LAUNCH
    a.ph_lo = 0; a.ph_hi = NPH;
    void* kargs[] = {&a};
    hipError_t e = hipLaunchCooperativeKernel((const void*)mk_fwd, dim3(grid), dim3(NTHR), kargs, LDS_BYTES, stream);
    if (e != hipSuccess) fprintf(stderr, "cooperative launch failed: %s (grid %d)\n", hipGetErrorString(e), grid);
#else
    for (int ph = 0; ph < NPH; ++ph) { a.ph_lo = ph; a.ph_hi = ph + 1; hipLaunchKernelGGL(mk_fwd, dim3(grid), dim3(NTHR), LDS_BYTES, stream, a); }
#endif
}
```

```cpp
#include <hip/hip_runtime.h>
#include <hip/hip_cooperative_groups.h>
#include <cstdio>
#include <cstdint>
#include <cstddef>
namespace cg = cooperative_groups;
namespace pg8 {
#define PG8_LAS __attribute__((address_space(3)))
typedef unsigned short bf16_t;
typedef short bf16x8 __attribute__((ext_vector_type(8)));
typedef float f32x4 __attribute__((ext_vector_type(4)));
typedef unsigned u32x4 __attribute__((ext_vector_type(4)));
constexpr int BM = 256, BK = 64, HALF = 128, HTB = HALF * BK * 2  , STAGE_BYTES = 8 * HTB, NXCD = 8, WGM = 8;

__host__ __device__ __forceinline__ int lds_byte(int r, int c) { const int st = (r >> 4) * 2 + (c >> 5), rr = r & 15, cc = c & 31, ob = rr * 64 + cc * 2; return st * 1024 + (ob ^ (((ob >> 9) & 1) << 5)); }
__host__ __device__ __forceinline__ void stage_rc(int b, int& R, int& C) { const int st = b / 1024, sb = b % 1024, swz = sb ^ (((sb >> 9) & 1) << 5); R = (st >> 1) * 16 + swz / 64; C = (st & 1) * 32 + (swz % 64) / 2; }
__host__ __device__ __forceinline__ int perm32(int rho) { const int n = rho >> 4, i = rho & 15; return 8 * (i >> 2) + 4 * n + (i & 3); }

struct Unit { int pm, pn, g; };
struct Gemm { const bf16_t* A; const bf16_t* Bt; int M, N, K, nseg; };

struct StaticOrder {
    int nM, nN, nwg, G, c;
    __host__ __device__ void init(int M, int N, int G_, int c_) { nM = M / BM; nN = N / BM; nwg = nM * nN; G = G_; c = c_; }
    __host__ __device__ bool next(int i, Unit& u) const {
        const long L = (long)i * G + c; if (L >= nwg) return false;
        int wgid = (int)L; { const int q = nwg / NXCD, r = nwg % NXCD, xcd = wgid % NXCD, off = wgid / NXCD; wgid = (xcd < r ? xcd * (q + 1) : r * (q + 1) + (xcd - r) * q) + off; }
        const int nig = WGM * nN, gid = wgid / nig, fm = gid * WGM, gsz = (nM - fm) < WGM ? (nM - fm) : WGM;
        u.pm = fm + ((wgid % nig) % gsz); u.pn = (wgid % nig) / gsz; u.g = 0; return true;
    }
    __device__ __forceinline__ void a_ready(const Unit&) const {}
    __device__ __forceinline__ void done(const Unit&) const {}
};


struct SegOrder4 {
    StaticOrder so;
    __host__ __device__ bool next(int i, Unit& u) const { if (!so.next(i >> 2, u)) return false; u.g = i & 3; return true; }
    __device__ __forceinline__ void a_ready(const Unit&) const {}
    __device__ __forceinline__ void done(const Unit&) const {}
};

typedef _Float16 h16;
typedef _Float16 h16x4 __attribute__((ext_vector_type(4)));
typedef unsigned u32x2 __attribute__((ext_vector_type(2)));
__device__ __forceinline__ unsigned cvt_pk_bf16(float lo, float hi) { unsigned r; asm volatile("v_cvt_pk_bf16_f32 %0, %1, %2" : "=v"(r) : "v"(lo), "v"(hi)); return r; }
__device__ __forceinline__ u32x2 pack_bf16x4(f32x4 v) { u32x2 w; w.x = cvt_pk_bf16(v[0], v[1]); w.y = cvt_pk_bf16(v[2], v[3]); return w; }
__device__ __forceinline__ h16x4 pack_h16x4(f32x4 v) { h16x4 w; w[0] = (h16)v[0]; w[1] = (h16)v[1]; w[2] = (h16)v[2]; w[3] = (h16)v[3]; return w; }
__device__ __forceinline__ float fast_sigmoid(float x) { return __builtin_amdgcn_rcpf(1.0f + __expf(-x)); }
__device__ __forceinline__ float row_rstd(const float* SS, int row) {
    const f32x4* p = (const f32x4*)(SS + (size_t)row * 16);
    const f32x4 a = p[0], b = p[1], c = p[2], d = p[3];
    const float s = ((a[0] + a[1]) + (a[2] + a[3])) + ((b[0] + b[1]) + (b[2] + b[3])) + ((c[0] + c[1]) + (c[2] + c[3])) + ((d[0] + d[1]) + (d[2] + d[3]));
    return rsqrtf(s * (1.0f / 1024.0f) + 1e-6f);
}

__device__ __forceinline__ void rows_rstd(const float* SS, int row0, int fq, float (&rs)[8]) {
    f32x4 q[8];
#pragma unroll
    for (int sl = 0; sl < 8; ++sl) q[sl] = *(const f32x4*)(SS + (size_t)(row0 + (sl >> 2) * HALF + (sl & 3) * 16) * 16 + 4 * fq);
#pragma unroll
    for (int sl = 0; sl < 8; ++sl) { float s = (q[sl][0] + q[sl][1]) + (q[sl][2] + q[sl][3]); s += __shfl_xor(s, 16); s += __shfl_xor(s, 32); rs[sl] = rsqrtf(s * (1.0f / 1024.0f) + 1e-6f); }
}

struct EpiGU {
    static constexpr bool PERM = true, KSEG = false;
    bf16_t* hid; const float* SS;
    __device__ __forceinline__ void operator()(const f32x4 (&acc)[2][2][4][2], const Unit& u, int wr, int wc, int fr, int fq) const {
        int row0 = u.pm * BM + wr * 64 + fr; asm volatile("" : "+v"(row0)); const int j0 = u.pn * 128 + wc * 32 + fq * 8;
        float rsv[8]; rows_rstd(SS, row0, fq, rsv);
#pragma unroll
        for (int ai = 0; ai < 2; ++ai)
#pragma unroll
            for (int m = 0; m < 4; ++m) { const int row = row0 + ai * HALF + m * 16; const float rs = rsv[ai * 4 + m]; u32x4 w;
#pragma unroll
                for (int n = 0; n < 2; ++n) { const f32x4 g = acc[ai][0][m][n] * rs, up = acc[ai][1][m][n] * rs; f32x4 h;
#pragma unroll
                    for (int i = 0; i < 4; ++i) h[i] = g[i] * fast_sigmoid(g[i]) * up[i];
                    const u32x2 p = pack_bf16x4(h); if (n == 0) { w.x = p.x; w.y = p.y; } else { w.z = p.x; w.w = p.y; } }
                *(u32x4*)(hid + (size_t)row * 2816 + j0) = w; }
    }
};
struct EpiDown {
    static constexpr bool PERM = true, KSEG = false;
    const float* res; float* X; bf16_t* xb; float* SS; float alpha;
    __device__ __forceinline__ void operator()(const f32x4 (&acc)[2][2][4][2], const Unit& u, int wr, int wc, int fr, int fq) const {
        int row0 = u.pm * BM + wr * 64 + fr; asm volatile("" : "+v"(row0)); const int c0 = u.pn * BM + wc * 32 + fq * 8;
#pragma unroll
        for (int ai = 0; ai < 2; ++ai) {
            f32x4 rv[4][2][2];
#pragma unroll
            for (int m = 0; m < 4; ++m)
#pragma unroll
                for (int bj = 0; bj < 2; ++bj)
#pragma unroll
                    for (int n = 0; n < 2; ++n) rv[m][bj][n] = *(const f32x4*)(res + (size_t)(row0 + ai * HALF + m * 16) * 1024 + c0 + bj * HALF + n * 4);
#pragma unroll
            for (int m = 0; m < 4; ++m) { const int row = row0 + ai * HALF + m * 16; float ss = 0.f;
#pragma unroll
                for (int bj = 0; bj < 2; ++bj) { const size_t off = (size_t)row * 1024 + c0 + bj * HALF;
                    const f32x4 o0 = rv[m][bj][0] + acc[ai][bj][m][0] * alpha, o1 = rv[m][bj][1] + acc[ai][bj][m][1] * alpha;
                    *(f32x4*)(X + off) = o0; *(f32x4*)(X + off + 4) = o1;
                    const u32x2 p0 = pack_bf16x4(o0), p1 = pack_bf16x4(o1); u32x4 w; w.x = p0.x; w.y = p0.y; w.z = p1.x; w.w = p1.y; *(u32x4*)(xb + off) = w;
                    ss += ((o0[0] * o0[0] + o0[1] * o0[1]) + (o0[2] * o0[2] + o0[3] * o0[3])) + ((o1[0] * o1[0] + o1[1] * o1[1]) + (o1[2] * o1[2] + o1[3] * o1[3])); }
                ss += __shfl_xor(ss, 16); ss += __shfl_xor(ss, 32);
                if (fq == 0) SS[(size_t)row * 16 + u.pn * 4 + wc] = ss; }
            asm volatile("" ::: "memory"); }
    }
};
struct EpiInA {
    static constexpr bool PERM = true, KSEG = false;
    h16* U5; h16* PP; h16* L16; const float* SS;
    __device__ __forceinline__ void operator()(const f32x4 (&acc)[2][2][4][2], const Unit& u, int wr, int wc, int fr, int fq) const {
        typedef _Float16 h16x8 __attribute__((ext_vector_type(8)));
        int row0 = u.pm * BM + wr * 64 + fr; asm volatile("" : "+v"(row0)); const int cl = wc * 32 + fq * 8;
        float rsv[8]; rows_rstd(SS, row0, fq, rsv);
        h16* base; int ld, cb;
        if (u.pn == 0) { base = U5; ld = 256; cb = 0; } else if (u.pn < 8) { base = PP; ld = 1792; cb = (u.pn - 1) * 256; } else { base = L16; ld = 512; cb = (u.pn - 8) * 256; }
#pragma unroll
        for (int ai = 0; ai < 2; ++ai)
#pragma unroll
            for (int m = 0; m < 4; ++m) { const int row = row0 + ai * HALF + m * 16; const float rs = rsv[ai * 4 + m];
#pragma unroll
                for (int bj = 0; bj < 2; ++bj) { const f32x4 a = acc[ai][bj][m][0] * rs, b = acc[ai][bj][m][1] * rs; h16x8 w;
                    w[0] = (h16)a[0]; w[1] = (h16)a[1]; w[2] = (h16)a[2]; w[3] = (h16)a[3]; w[4] = (h16)b[0]; w[5] = (h16)b[1]; w[6] = (h16)b[2]; w[7] = (h16)b[3];
                    *(h16x8*)(base + (size_t)row * ld + cb + cl + bj * HALF) = w; } }
    }
};
struct EpiGate {
    static constexpr bool PERM = false, KSEG = false;
    h16* R; const float* SS;
    __device__ __forceinline__ void operator()(const f32x4 (&acc)[2][2][4][2], const Unit& u, int wr, int wc, int fr, int fq) const {
        float rsv[8]; int row0 = u.pm * BM + wr * 64 + fr; asm volatile("" : "+v"(row0)); rows_rstd(SS, row0, fq, rsv); const int d0 = 256 * (u.pn >> 2) + 128 * ((u.pn >> 1) & 1) + 16 * (u.pn & 1) + 32 * wc + 4 * fq;
#pragma unroll
        for (int ai = 0; ai < 2; ++ai)
#pragma unroll
            for (int m = 0; m < 4; ++m) { const int row = row0 + ai * HALF + m * 16; const float rs = rsv[ai * 4 + m];
                f32x4 e[4];
#pragma unroll
                for (int g = 0; g < 4; ++g)
#pragma unroll
                    for (int i = 0; i < 4; ++i) e[g][i] = 1.0f + __expf(-fminf(fmaxf(acc[ai][g >> 1][m][g & 1][i] * rs, -10.f), 30.f));
                f32x4 r[4];
#pragma unroll
                for (int i = 0; i < 4; ++i) { const float i0 = __builtin_amdgcn_rcpf(e[0][i]), i1 = __builtin_amdgcn_rcpf(e[1][i]), i2 = __builtin_amdgcn_rcpf(e[2][i]), i3 = __builtin_amdgcn_rcpf(e[3][i]);
                    r[0][i] = e[1][i] * i0; r[1][i] = e[2][i] * i1; r[2][i] = e[3][i] * i2; r[3][i] = i3; }
#pragma unroll
                for (int g = 0; g < 4; ++g) *(h16x4*)(R + ((size_t)row * 4 + g) * 1024 + d0) = pack_h16x4(r[g]); }
    }
};
struct EpiBranch {
    static constexpr bool PERM = false, KSEG = true;
    const h16* R; bf16_t* out;
    __device__ __forceinline__ void operator()(f32x4 (&acc)[2][2][4][2], const Unit& u, int wr, int wc, int fr, int fq) const {
        unsigned q0 = (unsigned)(u.pm * BM + wr * 64 + fr) * 1024u + (unsigned)(u.pn * BM + wc * 32 + fq * 4); asm volatile("" : "+v"(q0));
        const unsigned r0 = (q0 - (q0 & 1023u)) * 4u + (unsigned)u.g * 1024u + (q0 & 1023u);
        const bool last = u.g == 3;
        h16x4 rr[2][4][2][2];
#pragma unroll
        for (int ai = 0; ai < 2; ++ai)
#pragma unroll
            for (int m = 0; m < 4; ++m)
#pragma unroll
                for (int bj = 0; bj < 2; ++bj)
#pragma unroll
                    for (int n = 0; n < 2; ++n) rr[ai][m][bj][n] = *(const h16x4*)(R + (r0 + (unsigned)((ai * HALF + m * 16) * 4096 + bj * HALF + n * 16)));
#pragma unroll
        for (int ai = 0; ai < 2; ++ai)
#pragma unroll
            for (int m = 0; m < 4; ++m) {
#pragma unroll
                for (int bj = 0; bj < 2; ++bj)
#pragma unroll
                    for (int n = 0; n < 2; ++n) { const unsigned off = q0 + (unsigned)((ai * HALF + m * 16) * 1024 + bj * HALF + n * 16);
                        const h16x4 r = rr[ai][m][bj][n];
                        f32x4 rf; rf[0] = (float)r[0]; rf[1] = (float)r[1]; rf[2] = (float)r[2]; rf[3] = (float)r[3];
                        acc[ai][bj][m][n] = acc[ai][bj][m][n] * rf;
                        if (last) *(u32x2*)(out + off) = pack_bf16x4(acc[ai][bj][m][n]); } }
    }
};
struct EpiGlu {
    static constexpr bool PERM = false, KSEG = false;
    const bf16_t* gl; bf16_t* ys;
    __device__ __forceinline__ void operator()(const f32x4 (&acc)[2][2][4][2], const Unit& u, int wr, int wc, int fr, int fq) const {
        int row0 = u.pm * BM + wr * 64 + fr; asm volatile("" : "+v"(row0)); const int c0 = wc * 32 + fq * 4;
        u32x2 gv[2][4][2][2];
#pragma unroll
        for (int ai = 0; ai < 2; ++ai)
#pragma unroll
            for (int m = 0; m < 4; ++m)
#pragma unroll
                for (int bj = 0; bj < 2; ++bj)
#pragma unroll
                    for (int n = 0; n < 2; ++n) gv[ai][m][bj][n] = *(const u32x2*)(gl + (size_t)(row0 + ai * HALF + m * 16) * 256 + c0 + bj * HALF + n * 16);
#pragma unroll
        for (int ai = 0; ai < 2; ++ai)
#pragma unroll
            for (int m = 0; m < 4; ++m) { const int row = row0 + ai * HALF + m * 16;
#pragma unroll
                for (int bj = 0; bj < 2; ++bj)
#pragma unroll
                    for (int n = 0; n < 2; ++n) { const int c = c0 + bj * HALF + n * 16; const u32x2 g2 = gv[ai][m][bj][n];
                        f32x4 g; g[0] = __uint_as_float(g2.x << 16); g[1] = __uint_as_float(g2.x & 0xffff0000u); g[2] = __uint_as_float(g2.y << 16); g[3] = __uint_as_float(g2.y & 0xffff0000u);
                        f32x4 o;
#pragma unroll
                        for (int i = 0; i < 4; ++i) o[i] = g[i] * fast_sigmoid(acc[ai][bj][m][n][i]);
                        *(u32x2*)(ys + (size_t)row * 1024 + c) = pack_bf16x4(o); } }
    }
};

template <class Epi, class Sched, bool ALIGN_EPI = false, bool SP2 = false>
__device__ __forceinline__ void gemm_phase(PG8_LAS unsigned char* lds, const Gemm g, const Sched& S, const Epi& E, const int tid) {
    const int wid = __builtin_amdgcn_readfirstlane(tid >> 6), lane = tid & 63, wr = wid >> 2, wc = wid & 3, fr = lane & 15, fq = lane >> 4;
    const int K = g.K, nt = K / BK / g.nseg; const size_t segb = (size_t)(K / g.nseg) * 2;
    unsigned voffA[2], voffB[2];
#pragma unroll
    for (int i = 0; i < 2; ++i) { int R, C; stage_rc(tid * 16 + i * 8192, R, C); const int Rb = Epi::PERM ? ((R & ~31) + perm32(R & 31)) : R;
        voffA[i] = (unsigned)(R * K + C) * 2u; voffB[i] = (unsigned)(Rb * K + C) * 2u; }
    const size_t kstep = (size_t)(BK * 2);
    const size_t hstep = (size_t)HALF * K * 2;
    const size_t tstep = 2 * hstep;
    const unsigned ldsw = (unsigned)wid * 1024u;
    const int aoff = lds_byte(wr * 64 + fr, fq * 8), boff = lds_byte(wc * 32 + fr, fq * 8);
#define PG8_SA(b, h) (((b) * 2 + (h)) * HTB)
#define PG8_SB(b, h) ((4 + (b) * 2 + (h)) * HTB)
#define PG8_STAGE(bufoff, gbase, voff) do { _Pragma("unroll") for (int _i = 0; _i < 2; ++_i) \
        __builtin_amdgcn_global_load_lds((const unsigned*)((const char*)(gbase) + (voff)[_i]), (PG8_LAS unsigned*)(lds + (bufoff) + ldsw + _i * 8192), 16, 0, 0); } while (0)
#define PG8_LDA(dst, b, h) do { _Pragma("unroll") for (int m = 0; m < 4; ++m) _Pragma("unroll") for (int k = 0; k < 2; ++k) dst[m][k] = *(const PG8_LAS bf16x8*)(lds + PG8_SA(b, h) + aoff + m * 2048 + k * 1024); } while (0)
#define PG8_LDB(dst, b, h) do { _Pragma("unroll") for (int n = 0; n < 2; ++n) _Pragma("unroll") for (int k = 0; k < 2; ++k) dst[n][k] = *(const PG8_LAS bf16x8*)(lds + PG8_SB(b, h) + boff + n * 2048 + k * 1024); } while (0)
#define PG8_MMA(ai, bj, At, Bt) do { __builtin_amdgcn_s_setprio(1); _Pragma("unroll") for (int m = 0; m < 4; ++m) _Pragma("unroll") for (int n = 0; n < 2; ++n) _Pragma("unroll") for (int k = 0; k < 2; ++k) \
        acc[ai][bj][m][n] = __builtin_amdgcn_mfma_f32_16x16x32_bf16(Bt[n][k], At[m][k], acc[ai][bj][m][n], 0, 0, 0); __builtin_amdgcn_s_setprio(0); } while (0)
#define PG8_WAIT_V(n) asm volatile("s_waitcnt vmcnt(" #n ")" ::: "memory")
#define PG8_WAIT_L(n) asm volatile("s_waitcnt lgkmcnt(" #n ")" ::: "memory")
#define PG8_BAR __builtin_amdgcn_s_barrier()
#define PG8_SCHED __builtin_amdgcn_sched_barrier(0)
    Unit cur, nxt; int ui = 0;
    if (!S.next(0, cur)) return;
    f32x4 acc[2][2][4][2];
#pragma unroll
    for (int a = 0; a < 2; ++a)
#pragma unroll
        for (int b = 0; b < 2; ++b)
#pragma unroll
            for (int m = 0; m < 4; ++m)
#pragma unroll
                for (int n = 0; n < 2; ++n) acc[a][b][m][n] = (f32x4){0.f, 0.f, 0.f, 0.f};
    bf16x8 At[4][2], B0[2][2], B1[2][2];
    const char* cA = (const char*)g.A + (size_t)cur.pm * tstep + (size_t)cur.g * segb; const char* cB = (const char*)g.Bt + (size_t)cur.pn * tstep + (size_t)cur.g * segb;
    S.a_ready(cur);
    if constexpr (SP2) {
        PG8_STAGE(PG8_SB(0, 0), cB, voffB); PG8_STAGE(PG8_SB(0, 1), cB + hstep, voffB); PG8_STAGE(PG8_SA(0, 0), cA, voffA); PG8_STAGE(PG8_SA(0, 1), cA + hstep, voffA);
        if (wr == 1) PG8_BAR;
        PG8_WAIT_V(2); PG8_BAR;
        PG8_STAGE(PG8_SB(1, 0), cB + kstep, voffB); PG8_STAGE(PG8_SA(1, 0), cA + kstep, voffA); PG8_STAGE(PG8_SB(1, 1), cB + hstep + kstep, voffB);
        PG8_WAIT_V(6); PG8_BAR;
    } else {
        PG8_STAGE(PG8_SB(0, 0), cB, voffB); PG8_STAGE(PG8_SA(0, 0), cA, voffA); PG8_STAGE(PG8_SB(0, 1), cB + hstep, voffB); PG8_STAGE(PG8_SA(0, 1), cA + hstep, voffA);
        if (wr == 1) PG8_BAR;
        PG8_WAIT_V(4); PG8_BAR;
        PG8_STAGE(PG8_SB(1, 0), cB + kstep, voffB); PG8_STAGE(PG8_SA(1, 0), cA + kstep, voffA); PG8_STAGE(PG8_SB(1, 1), cB + hstep + kstep, voffB);
        PG8_WAIT_V(6); PG8_BAR;
    }
    for (;;) {
        const bool has_next = S.next(ui + 1, nxt);
        const char* nA = has_next ? (const char*)g.A + (size_t)nxt.pm * tstep + (size_t)nxt.g * segb : cA; const char* nB = has_next ? (const char*)g.Bt + (size_t)nxt.pn * tstep + (size_t)nxt.g * segb : cB;
        for (int t = 0; t < nt; t += 2) {
            const bool last = (t == nt - 2);
            const char* a1 = cA + (size_t)(t + 1) * kstep;
            const char* a2 = last ? nA : cA + (size_t)(t + 2) * kstep; const char* b2 = last ? nB : cB + (size_t)(t + 2) * kstep;
            const char* a3 = a2 + kstep; const char* b3 = b2 + kstep;
            if (last && has_next) S.a_ready(nxt);
            if constexpr (SP2) {
            PG8_LDB(B0, 0, 0); PG8_LDB(B1, 0, 1); PG8_SCHED; PG8_LDA(At, 0, 0); PG8_STAGE(PG8_SA(1, 1), a1 + hstep, voffA);
            PG8_WAIT_V(8); PG8_WAIT_L(0); PG8_BAR; PG8_MMA(0, 0, At, B0); PG8_MMA(0, 1, At, B1); PG8_BAR; PG8_SCHED;
            PG8_LDA(At, 0, 1); PG8_STAGE(PG8_SB(0, 0), b2, voffB); PG8_STAGE(PG8_SB(0, 1), b2 + hstep, voffB); PG8_STAGE(PG8_SA(0, 0), a2, voffA);
            PG8_WAIT_V(8); PG8_WAIT_L(0); PG8_BAR; PG8_MMA(1, 0, At, B0); PG8_MMA(1, 1, At, B1); PG8_BAR; PG8_SCHED;
            PG8_LDB(B0, 1, 0); PG8_LDB(B1, 1, 1); PG8_SCHED; PG8_LDA(At, 1, 0); PG8_STAGE(PG8_SA(0, 1), a2 + hstep, voffA);
            PG8_WAIT_V(8); PG8_WAIT_L(0); PG8_BAR; PG8_MMA(0, 0, At, B0); PG8_MMA(0, 1, At, B1); PG8_BAR; PG8_SCHED;
            PG8_LDA(At, 1, 1); PG8_STAGE(PG8_SB(1, 0), b3, voffB); PG8_STAGE(PG8_SB(1, 1), b3 + hstep, voffB); PG8_STAGE(PG8_SA(1, 0), a3, voffA);
            PG8_WAIT_V(8); PG8_WAIT_L(0); PG8_BAR; PG8_MMA(1, 0, At, B0); PG8_MMA(1, 1, At, B1); PG8_BAR; PG8_SCHED;
            } else {
            PG8_LDB(B0, 0, 0); PG8_SCHED; PG8_LDA(At, 0, 0); PG8_STAGE(PG8_SA(1, 1), a1 + hstep, voffA);
            PG8_WAIT_L(8); PG8_BAR; PG8_WAIT_L(0); PG8_MMA(0, 0, At, B0); PG8_BAR; PG8_SCHED;
            PG8_LDB(B1, 0, 1); PG8_STAGE(PG8_SB(0, 0), b2, voffB);
            PG8_BAR; PG8_WAIT_L(0); PG8_MMA(0, 1, At, B1); PG8_BAR;
            PG8_LDA(At, 0, 1); PG8_STAGE(PG8_SA(0, 0), a2, voffA);
            PG8_BAR; PG8_WAIT_L(0); PG8_MMA(1, 0, At, B0); PG8_BAR; PG8_SCHED;
            PG8_STAGE(PG8_SB(0, 1), b2 + hstep, voffB);
            PG8_WAIT_V(6); PG8_BAR; PG8_MMA(1, 1, At, B1); PG8_BAR;
            PG8_LDB(B0, 1, 0); PG8_SCHED; PG8_LDA(At, 1, 0); PG8_STAGE(PG8_SA(0, 1), a2 + hstep, voffA);
            PG8_WAIT_L(8); PG8_BAR; PG8_WAIT_L(0); PG8_MMA(0, 0, At, B0); PG8_BAR; PG8_SCHED;
            PG8_LDB(B1, 1, 1); PG8_STAGE(PG8_SB(1, 0), b3, voffB);
            PG8_BAR; PG8_WAIT_L(0); PG8_MMA(0, 1, At, B1); PG8_BAR;
            PG8_LDA(At, 1, 1); PG8_STAGE(PG8_SA(1, 0), a3, voffA);
            PG8_BAR; PG8_WAIT_L(0); PG8_MMA(1, 0, At, B0); PG8_BAR; PG8_SCHED;
            PG8_STAGE(PG8_SB(1, 1), b3 + hstep, voffB);
            PG8_WAIT_V(6); PG8_BAR; PG8_MMA(1, 1, At, B1); PG8_BAR;
            }
        }
        if constexpr (ALIGN_EPI) { if (wr == 0) PG8_BAR; }
        E(acc, cur, wr, wc, fr, fq); S.done(cur);
        if (!has_next) break;
        if (!(Epi::KSEG && nxt.g != 0))
#pragma unroll
        for (int a = 0; a < 2; ++a)
#pragma unroll
            for (int b = 0; b < 2; ++b)
#pragma unroll
                for (int m = 0; m < 4; ++m)
#pragma unroll
                    for (int n = 0; n < 2; ++n) acc[a][b][m][n] = (f32x4){0.f, 0.f, 0.f, 0.f};
        cur = nxt; cA = nA; cB = nB; ++ui;
        if constexpr (ALIGN_EPI) { if (wr == 1) PG8_BAR; }
    }
    PG8_WAIT_V(0);
    if constexpr (!ALIGN_EPI) { if (wr == 0) PG8_BAR; }
    PG8_BAR;
#undef PG8_SA
#undef PG8_SB
#undef PG8_STAGE
#undef PG8_LDA
#undef PG8_LDB
#undef PG8_MMA
#undef PG8_WAIT_V
#undef PG8_WAIT_L
#undef PG8_BAR
#undef PG8_SCHED
}
}

#define LAS __attribute__((address_space(3)))
typedef unsigned short bf16_t;
typedef _Float16 h16;
typedef _Float16 h16x4 __attribute__((ext_vector_type(4)));
typedef _Float16 h16x8 __attribute__((ext_vector_type(8)));
typedef float f32x4 __attribute__((ext_vector_type(4)));
typedef float f32x2 __attribute__((ext_vector_type(2)));
typedef unsigned u32x4 __attribute__((ext_vector_type(4)));
typedef unsigned u32x2 __attribute__((ext_vector_type(2)));

#ifndef ONE_LAUNCH
#define ONE_LAUNCH 1
#endif
constexpr int NWAVES = 8, NTHR = 512;
constexpr int TT = 16384, SEQ = 8192, DM = 1024, FF = 2816, MW = 256, INW = 6144;
constexpr int LDS_BYTES = 147456;
constexpr size_t MiB = 1u << 20;
constexpr size_t WS_CTL = 0, CTL_ZERO_BYTES = 16384, WS_SS = 1 * MiB, WS_E = 2 * MiB, WS_W = 4 * MiB, WS_B1 = 34 * MiB, WS_B2 = 66 * MiB, WS_Z = 98 * MiB, WS_END = 262 * MiB;
constexpr size_t W_GU1 = 0, W_D1 = W_GU1 + (size_t)2 * FF * DM * 2, W_INA = W_D1 + (size_t)DM * FF * 2;
constexpr size_t W_ING = 0, W_BR = W_ING + (size_t)4096 * DM * 2, W_O = W_BR + (size_t)DM * DM * 2, W_GU2 = W_O + (size_t)DM * DM * 2, W_D2 = W_GU2 + (size_t)2 * FF * DM * 2, W_GLU = W_D2 + (size_t)DM * FF * 2, W_END2 = W_GLU + 256 * 256 * 2;
constexpr size_t W_L2 = 23 * MiB;
static_assert(W_END2 <= 30 * MiB && W_INA + (size_t)2560 * DM * 2 <= 30 * MiB, "W region");
constexpr size_t Z_RW = 0, Z_G16 = 56 * MiB, Z_U5 = 64 * MiB, Z_L16 = 72 * MiB, Z_PP = 88 * MiB, Z_O = 72 * MiB, Z_GL = 144 * MiB, Z_PB = 152 * MiB, Z_LB = 156 * MiB, Z_SB = 160 * MiB;
constexpr size_t Z_HID = 0, Z_R = 0;
static_assert((size_t)TT * 4 * 896 <= 56 * MiB && (size_t)TT * 1792 * 2 <= 56 * MiB && (size_t)TT * FF * 2 <= 144 * MiB && (size_t)TT * 4096 * 2 <= 144 * MiB, "Z region");

typedef const float* cfp_t;
typedef const __attribute__((address_space(4))) cfp_t* in_t;
struct Args { const float* in[41]; float* out; unsigned char* ws; int ph_lo, ph_hi; };

struct Frame {
    LAS unsigned char* lds;
    int tid, lane, wave, G, bx;
    in_t in;
    float* X; unsigned char* ws;
    float* SS; float* E;
    bf16_t *B1, *B2, *HID, *GL;
    h16 *U5, *PP, *L16, *G16, *R;
    float* O; unsigned char* RW;
    float *PB, *LB, *SB;
};

__device__ __forceinline__ unsigned f2bf(float f) { unsigned u = __builtin_bit_cast(unsigned, f); return (u + 0x7fffu + ((u >> 16) & 1u)) >> 16; }
__device__ __forceinline__ unsigned pk2(float lo, float hi) { return f2bf(lo) | (f2bf(hi) << 16); }
#define LDS_WAIT() asm volatile("s_waitcnt lgkmcnt(0)" ::: "memory")
template <int CTRL> __device__ __forceinline__ float dppx(float x) { return __builtin_bit_cast(float, __builtin_amdgcn_update_dpp(0, __builtin_bit_cast(int, x), CTRL, 0xf, 0xf, true)); }
__device__ __forceinline__ float allreduce16(float x) { x += dppx<0xB1>(x); x += dppx<0x4E>(x); x += dppx<0x141>(x); x += dppx<0x140>(x); return x; }
__device__ __forceinline__ float wave_sum(float x) { x = allreduce16(x); x += __shfl_xor(x, 16); x += __shfl_xor(x, 32); return x; }
__device__ __forceinline__ float sigmoidf_(float x) { return __builtin_amdgcn_rcpf(1.0f + __expf(-x)); }

__device__ __forceinline__ int tr_rowmap(int mode, int j, int row0) {
    if (mode == 0) return row0 + j;
    if (mode == 1) return (j >> 7) * 256 + (j & 127);
    if (mode == 2) return (j >> 7) * 256 + 128 + (j & 127);
    const int g = j >> 10, d = j & 1023;
    const int pn = 4 * (d >> 8) + 2 * ((d >> 7) & 1) + ((d >> 4) & 1);
    return 256 * pn + 128 * (g >> 1) + 32 * ((d >> 5) & 3) + 16 * (g & 1) + 4 * ((d >> 2) & 3) + (d & 3);
}
__device__ __forceinline__ void tr_item(const float* W, int ldw, int K, int N, bf16_t* WT, int mode, int row0, const float* s1, const float* s2, int smode, LAS float* scr, int item, int lane) {
    const int nblk = N / 32, kb = item / nblk, nb = item % nblk, k0 = 64 * kb, n0 = 32 * nb;
#pragma unroll
    for (int i = 0; i < 32; ++i) { const int kk = 2 * i + (lane >> 5); const int k = k0 + kk; float sc = 1.0f;
        if (s1) sc = s1[k];
        if (smode == 1) sc *= s2[k]; else if (smode == 2) sc *= (1.0f - s2[k]);
        scr[kk * 33 + (lane & 31)] = W[(size_t)k * ldw + n0 + (lane & 31)] * sc; }
    LDS_WAIT(); asm volatile("" ::: "memory");
    const int c = lane & 7;
#pragma unroll
    for (int j = 0; j < 4; ++j) { const int n = (lane >> 3) + 8 * j; const LAS float* s = scr + (8 * c) * 33 + n;
        u32x4 o; o.x = pk2(s[0 * 33], s[1 * 33]); o.y = pk2(s[2 * 33], s[3 * 33]); o.z = pk2(s[4 * 33], s[5 * 33]); o.w = pk2(s[6 * 33], s[7 * 33]);
        *(u32x4*)(WT + (size_t)tr_rowmap(mode, n0 + n, row0) * K + k0 + 8 * c) = o; }
    LDS_WAIT(); asm volatile("" ::: "memory");
}
#define TRJ(W_, ldw_, K_, N_, dst_, mode_, row0_, s1_, s2_, smode_) { const int ni_ = ((K_) / 64) * ((N_) / 32); if (r >= 0 && r < ni_) tr_item(W_, ldw_, K_, N_, dst_, mode_, row0_, s1_, s2_, smode_, scr, r, F.lane); r -= ni_; }
__device__ __forceinline__ void conv_first_half(Frame& F, int l) {
    LAS float* scr = (LAS float*)(F.lds + F.wave * 16384);
    const int gw = F.bx * NWAVES + F.wave, NGW = F.G * NWAVES;
    unsigned char* wb = F.ws + WS_W;
    const float* n1 = F.in[1] + (size_t)l * DM; const float* nm = F.in[5] + (size_t)l * DM; const float* mu = F.in[19] + (size_t)l * 3 * DM;
    const float* w1 = F.in[21] + (size_t)l * DM * 64; const float* a1 = F.in[24] + (size_t)l * DM * 64; const float* g1 = F.in[26] + (size_t)l * DM * 128;
    bf16_t* ina = (bf16_t*)(wb + W_INA);
    for (int it = gw;; it += NGW) { int r = it;
        TRJ(F.in[2] + (size_t)l * DM * FF, FF, DM, FF, (bf16_t*)(wb + W_GU1), 1, 0, n1, nullptr, 0)
        TRJ(F.in[3] + (size_t)l * DM * FF, FF, DM, FF, (bf16_t*)(wb + W_GU1), 2, 0, n1, nullptr, 0)
        TRJ(F.in[4] + (size_t)l * FF * DM, DM, FF, DM, (bf16_t*)(wb + W_D1), 0, 0, nullptr, nullptr, 0)
        TRJ(F.in[6] + (size_t)l * DM * INW, INW, DM, 2048, ina, 0, 0, nm, nullptr, 0)
        TRJ(w1, 64, DM, 64, ina, 0, 2048, nm, mu, 2)
        TRJ(a1, 64, DM, 64, ina, 0, 2112, nm, mu + DM, 2)
        TRJ(g1, 128, DM, 128, ina, 0, 2176, nm, mu + 2 * DM, 2)
        TRJ(w1, 64, DM, 64, ina, 0, 2304, nm, mu, 1)
        TRJ(a1, 64, DM, 64, ina, 0, 2368, nm, mu + DM, 1)
        TRJ(g1, 128, DM, 128, ina, 0, 2432, nm, mu + 2 * DM, 1)
        TRJ(F.in[22] + (size_t)l * 64 * 256, 256, 64, 256, (bf16_t*)(wb + W_L2), 0, 0, nullptr, nullptr, 0)
        TRJ(F.in[25] + (size_t)l * 64 * 256, 256, 64, 256, (bf16_t*)(wb + W_L2) + 256 * 64, 0, 0, nullptr, nullptr, 0)
        TRJ(F.in[27] + (size_t)l * 128 * 256, 256, 128, 256, (bf16_t*)(wb + W_L2) + 2 * 256 * 64, 0, 0, nullptr, nullptr, 0)
        TRJ(F.in[16] + ((size_t)l * 4 + 0) * 4096, 64, 64, 64, (bf16_t*)(wb + W_L2) + 4 * 256 * 64, 0, 0, nullptr, nullptr, 0)
        TRJ(F.in[16] + ((size_t)l * 4 + 1) * 4096, 64, 64, 64, (bf16_t*)(wb + W_L2) + 4 * 256 * 64, 0, 64, nullptr, nullptr, 0)
        TRJ(F.in[16] + ((size_t)l * 4 + 2) * 4096, 64, 64, 64, (bf16_t*)(wb + W_L2) + 4 * 256 * 64, 0, 128, nullptr, nullptr, 0)
        TRJ(F.in[16] + ((size_t)l * 4 + 3) * 4096, 64, 64, 64, (bf16_t*)(wb + W_L2) + 4 * 256 * 64, 0, 192, nullptr, nullptr, 0)
        if (r >= 0) break; }
}
__device__ __forceinline__ void conv_second_half(Frame& F, int l, int b0) {
    LAS float* scr = (LAS float*)(F.lds + F.wave * 16384);
    const int gw = (F.bx - b0) * NWAVES + F.wave, NGW = (F.G - b0) * NWAVES;
    unsigned char* wb = F.ws + WS_W;
    const float* nm = F.in[5] + (size_t)l * DM; const float* n2 = F.in[36] + (size_t)l * DM;
    for (int it = gw;; it += NGW) { int r = it;
        TRJ(F.in[6] + (size_t)l * DM * INW + 2048, INW, DM, 4096, (bf16_t*)(wb + W_ING), 3, 0, nm, nullptr, 0)
        TRJ(F.in[34] + (size_t)l * DM * DM, DM, DM, DM, (bf16_t*)(wb + W_BR), 0, 0, nullptr, nullptr, 0)
        TRJ(F.in[35] + (size_t)l * DM * DM, DM, DM, DM, (bf16_t*)(wb + W_O), 0, 0, nullptr, nullptr, 0)
        TRJ(F.in[37] + (size_t)l * DM * FF, FF, DM, FF, (bf16_t*)(wb + W_GU2), 1, 0, n2, nullptr, 0)
        TRJ(F.in[38] + (size_t)l * DM * FF, FF, DM, FF, (bf16_t*)(wb + W_GU2), 2, 0, n2, nullptr, 0)
        TRJ(F.in[39] + (size_t)l * FF * DM, DM, FF, DM, (bf16_t*)(wb + W_D2), 0, 0, nullptr, nullptr, 0)
        TRJ(F.in[15] + (size_t)l * 256 * 256, 256, 256, 256, (bf16_t*)(wb + W_GLU), 0, 0, nullptr, nullptr, 0)
        if (r >= 0) break; }
}
__device__ __forceinline__ void prep_x(Frame& F) {
    const int gw = F.bx * NWAVES + F.wave, NGW = F.G * NWAVES;
    const float* x = F.in[0];
    for (int m = gw; m < TT; m += NGW) {
        const f32x4* xr = (const f32x4*)(x + (size_t)m * DM) + F.lane; float s = 0.f;
        unsigned long long* o8 = (unsigned long long*)(F.B1 + (size_t)m * DM) + F.lane;
#pragma unroll
        for (int j = 0; j < 4; ++j) { const f32x4 v = xr[64 * j]; s += (v[0] * v[0] + v[1] * v[1]) + (v[2] * v[2] + v[3] * v[3]);
            o8[64 * j] = (unsigned long long)pk2(v[0], v[1]) | ((unsigned long long)pk2(v[2], v[3]) << 32); }
        s += __shfl_xor(s, 1); s += __shfl_xor(s, 2);
        if ((F.lane & 3) == 0) F.SS[(size_t)m * 16 + (F.lane >> 2)] = s;
    }
}
__device__ __forceinline__ void final_norm(Frame& F) {
    const int gw = F.bx * NWAVES + F.wave, NGW = F.G * NWAVES;
    const f32x4* gn = (const f32x4*)F.in[40] + F.lane;
    for (int m = gw; m < TT; m += NGW) {
        const float rs = pg8::row_rstd(F.SS, m);
        f32x4* xr = (f32x4*)(F.X + (size_t)m * DM) + F.lane;
#pragma unroll
        for (int j = 0; j < 4; ++j) { const f32x4 v = xr[64 * j]; xr[64 * j] = v * rs * gn[64 * j]; }
    }
}

struct S5Par { float ar, ai; float bbr[16], bbi[16]; };
__device__ __forceinline__ void s5_params(Frame& F, int l, int g, int p, S5Par& P) {
    asm volatile("" : "+v"(p));
    const float lr = F.in[7][((size_t)l * 16 + g) * 64 + p], li = F.in[8][((size_t)l * 16 + g) * 64 + p], dt = expf(F.in[9][l * 16 + g]);
    const float mag = expf(lr * dt); P.ar = mag * cosf(li * dt); P.ai = mag * sinf(li * dt);
    const float inv = 1.0f / (lr * lr + li * li); const float qr = lr * inv, qi = -li * inv;
    const float cr = (P.ar - 1.0f) * qr - P.ai * qi, ci = (P.ar - 1.0f) * qi + P.ai * qr;
    const f32x4* br = (const f32x4*)(F.in[10] + (((size_t)l * 16 + g) * 64 + p) * 16); const f32x4* bi = (const f32x4*)(F.in[11] + (((size_t)l * 16 + g) * 64 + p) * 16);
#pragma unroll
    for (int q = 0; q < 4; ++q) { const f32x4 a = br[q], b = bi[q];
#pragma unroll
        for (int i = 0; i < 4; ++i) { P.bbr[4 * q + i] = cr * a[i] - ci * b[i]; P.bbi[4 * q + i] = cr * b[i] + ci * a[i]; } }
}
__device__ __forceinline__ void s5_step(const S5Par& P, const LAS float* urow, float& hr, float& hi) {
    const LAS f32x4* u4 = (const LAS f32x4*)urow; float bur = 0.f, bui = 0.f;
#pragma unroll
    for (int q = 0; q < 4; ++q) { const f32x4 u = u4[q];
#pragma unroll
        for (int i = 0; i < 4; ++i) { bur += P.bbr[4 * q + i] * u[i]; bui += P.bbi[4 * q + i] * u[i]; } }
    const float nr = P.ar * hr - P.ai * hi + bur, ni = P.ar * hi + P.ai * hr + bui; hr = nr; hi = ni;
}
__device__ __forceinline__ void load_u5_tile(Frame& F, int t0, LAS float* ubuf) {
    for (int i = F.tid; i < 64 * 64; i += NTHR) { const int t = i >> 6, q = i & 63; const h16x4 v = *(const h16x4*)(F.U5 + (size_t)(t0 + t) * 256 + 4 * q);
        f32x4 f; f[0] = (float)v[0]; f[1] = (float)v[1]; f[2] = (float)v[2]; f[3] = (float)v[3]; *(LAS f32x4*)(ubuf + t * 256 + 4 * q) = f; }
}


template <bool FIRST> __device__ __forceinline__ void mv32(LAS float* accp, float init, const LAS float* hb, const float* wsrc, int ldw) {
    float w[32];
    asm volatile("" : "+v"(wsrc));
#pragma unroll
    for (int j = 0; j < 32; ++j) w[j] = wsrc[(size_t)j * ldw];
#pragma unroll 2
    for (int tt = 0; tt < 32; ++tt) { const LAS f32x4* h4 = (const LAS f32x4*)(hb + tt * 256); float a = FIRST ? init : accp[tt * 256];
#pragma unroll
        for (int q = 0; q < 8; ++q) { const f32x4 v = h4[q]; a += v[0] * w[4 * q] + v[1] * w[4 * q + 1] + v[2] * w[4 * q + 2] + v[3] * w[4 * q + 3]; }
        accp[tt * 256] = a; }
}
template <int K> __device__ __forceinline__ void lora_mfma(const LAS unsigned short* hb16, int kofs, const bf16_t* Wt, LAS float* outb, int wave, int lane) {
    typedef short bf16x8_t __attribute__((ext_vector_type(8)));
    const int r16 = lane & 15, quad = lane >> 4;
    f32x4 acc[4][2];
#pragma unroll
    for (int rt = 0; rt < 4; ++rt)
#pragma unroll
        for (int ct = 0; ct < 2; ++ct) acc[rt][ct] = (f32x4){0.f, 0.f, 0.f, 0.f};
    bf16x8_t bfr[K / 32][2];
#pragma unroll
    for (int ks = 0; ks < K / 32; ++ks)
#pragma unroll
        for (int ct = 0; ct < 2; ++ct) bfr[ks][ct] = *(const bf16x8_t*)(Wt + (size_t)(wave * 32 + ct * 16 + r16) * K + ks * 32 + quad * 8);
#pragma unroll
    for (int ks = 0; ks < K / 32; ++ks)
#pragma unroll
        for (int rt = 0; rt < 4; ++rt) { const bf16x8_t a = *(const LAS bf16x8_t*)(hb16 + (rt * 16 + r16) * 264 + kofs + ks * 32 + quad * 8);
#pragma unroll
            for (int ct = 0; ct < 2; ++ct) acc[rt][ct] = __builtin_amdgcn_mfma_f32_16x16x32_bf16(a, bfr[ks][ct], acc[rt][ct], 0, 0, 0); }
#pragma unroll
    for (int rt = 0; rt < 4; ++rt)
#pragma unroll
        for (int ct = 0; ct < 2; ++ct)
#pragma unroll
            for (int j = 0; j < 4; ++j) outb[(rt * 16 + quad * 4 + j) * 256 + wave * 32 + ct * 16 + r16] = acc[rt][ct][j];
}
__device__ __forceinline__ void m1_phase(Frame& F, int l) {
    LAS float* ubuf = (LAS float*)F.lds;
    LAS float* pl = (LAS float*)(F.lds + 65536);
    const int tid = F.tid, lane = F.lane, wave = F.wave;
    const int ch = tid & 255, half = tid >> 8;
    for (int c = F.bx; c < TT / 64; c += F.G) {
        const int t0 = c * 64, tb = t0 + half * 32, sb = tb & (SEQ - 1);
        load_u5_tile(F, t0, ubuf);
        __syncthreads();
#pragma unroll 1
        for (int gi = 0; gi < 2; ++gi) { const int g = wave + 8 * gi; S5Par P; s5_params(F, l, g, lane, P); float hr = 0.f, hi = 0.f;
#pragma unroll 2
            for (int j = 0; j < 64; ++j) s5_step(P, ubuf + j * 256 + g * 16, hr, hi);
            *(f32x2*)(F.E + (((size_t)c * 16 + g) * 64 + lane) * 2) = (f32x2){hr, hi}; }
        __syncthreads();
        LAS float* accp = pl + half * 32 * 256 + ch;
        LAS unsigned short* hb16 = (LAS unsigned short*)F.lds;
        const bf16_t* l2w = (const bf16_t*)(F.ws + WS_W + W_L2);
        h16 la[32], lb[32];
#pragma unroll
        for (int tt = 0; tt < 32; ++tt) { const int t = tb + tt; la[tt] = F.L16[(size_t)t * 512 + ch]; lb[tt] = (sb + tt > 0) ? F.L16[(size_t)(t - 1) * 512 + 256 + ch] : (h16)0.f; }
#pragma unroll
        for (int tt = 0; tt < 32; ++tt) { float pre = (float)la[tt] + (float)lb[tt];
            float a = pre; if (ch < 64) a = 1.0f - 2.0f * __builtin_amdgcn_rcpf(1.0f + __expf(2.0f * pre)); else if (ch >= 128) a = sigmoidf_(pre);
            hb16[(half * 32 + tt) * 264 + ch] = (unsigned short)f2bf(a); }
        __syncthreads();
        const int hb = (t0 / SEQ) * 4 + (ch >> 6);
        unsigned char* rwb = F.RW + ((size_t)hb * SEQ + sb) * 896;
        const int cl = ch & 63;
        {
            lora_mfma<64>(hb16, 0, l2w, pl, wave, lane);
            __syncthreads();
            const float w0 = F.in[20][(size_t)l * 256 + ch];
#pragma unroll 2
            for (int tt = 0; tt < 32; ++tt) { const float z = -(accp[tt * 256] + w0); const float sp = fmaxf(z, 0.f) + __logf(1.0f + __expf(-fabsf(z)));
                const float wlog = -sp - 0.5f; const float dec = __expf(-__expf(wlog));
                *(float*)(rwb + (size_t)tt * 896 + cl * 4) = dec; }
        }
        {
            __syncthreads();
            lora_mfma<128>(hb16, 128, l2w + 2 * 256 * 64, pl, wave, lane);
            __syncthreads();
#pragma unroll 4
            for (int tt = 0; tt < 32; ++tt) F.G16[(size_t)(tb + tt) * 256 + ch] = (h16)accp[tt * 256];
        }
        {
            __syncthreads();
            lora_mfma<64>(hb16, 64, l2w + 256 * 64, pl, wave, lane);
            __syncthreads();
            const float a0 = F.in[23][(size_t)l * 256 + ch];
            const float mur = F.in[18][((size_t)l * 3 + 0) * 256 + ch], muk = F.in[18][((size_t)l * 3 + 1) * 256 + ch], muv = F.in[18][((size_t)l * 3 + 2) * 256 + ch];
            const float kkw = F.in[28][(size_t)l * 256 + ch], kaw = F.in[29][(size_t)l * 256 + ch];
            const h16* pp = F.PP + (size_t)tb * 1792 + 256 + ch;
            float rprev = 0.f, kprev = 0.f, vprev = 0.f;
            if (sb > 0) { rprev = (float)pp[-(ptrdiff_t)1792]; kprev = (float)pp[-(ptrdiff_t)1792 + 256]; vprev = (float)pp[-(ptrdiff_t)1792 + 512]; }
#pragma unroll 1
            for (int t16 = 0; t16 < 32; t16 += 16) {
                h16 rq[16], kq[16], vq[16];
#pragma unroll
                for (int tt = 0; tt < 16; ++tt) { const h16* q = pp + (size_t)(t16 + tt) * 1792; rq[tt] = q[0]; kq[tt] = q[256]; vq[tt] = q[512]; }
#pragma unroll
                for (int tt = 0; tt < 16; ++tt) { const float a = sigmoidf_(accp[(t16 + tt) * 256] + a0);
                    const float rp = (float)rq[tt], kp = (float)kq[tt], vp = (float)vq[tt];
                    const float r = rp + (rprev - rp) * mur, k = kp + (kprev - kp) * muk, v = vp + (vprev - vp) * muv;
                    rprev = rp; kprev = kp; vprev = vp;
                    const float kkv = k * kkw; const float kk = kkv * rsqrtf(fmaxf(wave_sum(kkv * kkv), 1e-24f));
                    const float kt = k * (1.0f + (a - 1.0f) * kaw); const float bb = kk * a;
                    h16* o = (h16*)(rwb + (size_t)(t16 + tt) * 896 + 256) + cl;
                    o[0] = (h16)r; o[64] = (h16)kt; o[128] = (h16)v; o[192] = (h16)kk; o[256] = (h16)bb; } }
        }
        __syncthreads();
    }
}

__device__ __forceinline__ void pool_conv_chunk(Frame& F, int l, int c) {
    LAS float* ubuf = (LAS float*)F.lds;
    LAS unsigned short* pb16 = (LAS unsigned short*)(F.lds + 65536);
    const int tid = F.tid; const int ch = tid & 255, half = tid >> 8;
    const int t0 = c * 64, tb = t0 + half * 32, sb = tb & (SEQ - 1);
    {
    {
        const int grp = ch >> 6, win = 2 << grp;
        const h16* up = F.PP + (size_t)tb * 1792 + ch;
        float s = 0.f;
        for (int j = 1; j <= win; ++j) if (sb - j >= 0) s += (float)up[-(ptrdiff_t)j * 1792];
#pragma unroll 1
        for (int t16 = 0; t16 < 32; t16 += 16) {
            h16 uq[16], ul[16];
#pragma unroll
            for (int tt = 0; tt < 16; ++tt) { uq[tt] = up[(size_t)(t16 + tt) * 1792]; ul[tt] = (sb + t16 + tt - win >= 0) ? up[(ptrdiff_t)(t16 + tt - win) * 1792] : (h16)0.f; }
#pragma unroll
            for (int tt = 0; tt < 16; ++tt) { const float u = (float)uq[tt]; s += u; const int pos = sb + t16 + tt;
                s -= (float)ul[tt];
                const float cnt = (float)((pos + 1 < win) ? (pos + 1) : win);
                pb16[(half * 32 + t16 + tt) * 264 + ch] = (unsigned short)f2bf(s / cnt - u); } }
    }
    {
        const h16* zp = F.PP + (size_t)tb * 1792 + 1024 + ch;
        const float cw0 = F.in[33][((size_t)l * 3 + 0) * 256 + ch], cw1 = F.in[33][((size_t)l * 3 + 1) * 256 + ch], cw2 = F.in[33][((size_t)l * 3 + 2) * 256 + ch];
        float z2 = 0.f, z1 = 0.f;
        if (sb >= 1) z1 = (float)zp[-(ptrdiff_t)1792 + 512] * (float)zp[-(ptrdiff_t)1792];
        if (sb >= 2) z2 = (float)zp[-(ptrdiff_t)2 * 1792 + 512] * (float)zp[-(ptrdiff_t)2 * 1792];
#pragma unroll 1
        for (int t16 = 0; t16 < 32; t16 += 16) {
            h16 zx[16], zb[16], zc[16];
#pragma unroll
            for (int tt = 0; tt < 16; ++tt) { const h16* q = zp + (size_t)(t16 + tt) * 1792; zx[tt] = q[0]; zb[tt] = q[256]; zc[tt] = q[512]; }
#pragma unroll
            for (int tt = 0; tt < 16; ++tt) { const float z0 = (float)zc[tt] * (float)zx[tt];
                const float y = (float)zb[tt] * (cw0 * z2 + cw1 * z1 + cw2 * z0);
                F.B2[(size_t)(tb + t16 + tt) * 1024 + 768 + ch] = (bf16_t)f2bf(y); z2 = z1; z1 = z0; } }
    }
    __syncthreads();
    LAS float* accu = ubuf + half * 32 * 256 + ch;
    {
        lora_mfma<64>(pb16, (F.wave >> 1) * 64, (const bf16_t*)(F.ws + WS_W + W_L2) + 4 * 256 * 64, ubuf, F.wave, F.lane);
        __syncthreads();
        const float sc = F.in[17][(size_t)l * 256 + ch];
#pragma unroll 4
        for (int tt = 0; tt < 32; ++tt) F.B2[(size_t)(tb + tt) * 1024 + 256 + ch] = (bf16_t)f2bf(accu[tt * 256] * sc);
    }
    __syncthreads();
    }
}

#define XB_TMO      128
#define XB_XCNT(j)  (256  + 64 * (j))
#define XB_XSUB(j)  (1280 + 64 * (j))
#define XB_XGEN(j)  (2304 + 64 * (j))
#define XB_TOP      3328
#define XB_TOPGEN   3392
#define XCD_BAR_WORDS 3456
#define XB_SPIN_CAP (1u << 18)

__device__ __forceinline__ unsigned xb_ld(unsigned* p)              { return __hip_atomic_load(p, __ATOMIC_RELAXED, __HIP_MEMORY_SCOPE_AGENT); }
__device__ __forceinline__ unsigned xb_add(unsigned* p, unsigned v) { return __hip_atomic_fetch_add(p, v, __ATOMIC_RELAXED, __HIP_MEMORY_SCOPE_AGENT); }
__device__ __forceinline__ unsigned xb_xcc_id() { return (unsigned)__builtin_amdgcn_s_getreg((3 << 11) | 20) & 0xFu; }
#define XB_SPIN(cond, bar) do { unsigned _sp = 0; while (cond) { __builtin_amdgcn_s_sleep(1); \
    if ((++_sp & 255u) == 0u) { if (xb_ld(&(bar)[XB_TMO])) break; if (_sp > XB_SPIN_CAP) { atomicAdd(&(bar)[XB_TMO], 1u); break; } } } } while (0)

struct XcdBarrier {
    unsigned* bar; unsigned x;
    volatile LAS unsigned* st;
};

__device__ __forceinline__ XcdBarrier xcd_barrier_post(unsigned* bar, volatile LAS unsigned* st) {
    XcdBarrier b; b.bar = bar; b.x = xb_xcc_id(); b.st = st;
    if (threadIdx.x == 0) (void)xb_add(&bar[XB_XCNT(b.x)], 1u);
    return b;
}
__device__ __forceinline__ void xcd_barrier_complete(unsigned* bar, unsigned x, unsigned& nloc, unsigned& nx) {
    const unsigned G = gridDim.x * gridDim.y * gridDim.z;
    unsigned sum, cnt, mine, sp = 0u;
    for (;;) {
        sum = 0u; cnt = 0u; mine = 0u;
#pragma unroll
        for (unsigned j = 0; j < 16; ++j) { const unsigned c = xb_ld(&bar[XB_XCNT(j)]); sum += c; cnt += (c > 0u) ? 1u : 0u; mine = (j == x) ? c : mine; }
        if (sum == G) break;
        __builtin_amdgcn_s_sleep(1);
        if ((++sp & 255u) == 0u) { if (xb_ld(&bar[XB_TMO])) break; if (sp > XB_SPIN_CAP) { atomicAdd(&bar[XB_TMO], 1u); break; } }
    }
    nloc = mine > 0u ? mine : 1u; nx = cnt > 0u ? cnt : 1u;
}

__device__ __forceinline__ void xcd_barrier(const XcdBarrier& b) {
    asm volatile("s_waitcnt vmcnt(0)" ::: "memory");
    __syncthreads();
    if (threadIdx.x == 0) {
        unsigned* bar = b.bar;
        __builtin_amdgcn_s_waitcnt(0);
        unsigned nloc = b.st[0], nx = b.st[1];
        if (nloc == 0u) { xcd_barrier_complete(bar, b.x, nloc, nx); b.st[0] = nloc; b.st[1] = nx; }
        const unsigned old = xb_add(&bar[XB_XSUB(b.x)], 1u);
        const unsigned gen = old / nloc;
        if (old + 1u == (gen + 1u) * nloc) {
            __builtin_amdgcn_fence(__ATOMIC_RELEASE, "agent");
            asm volatile("s_waitcnt vmcnt(0)" ::: "memory");
            const unsigned og = xb_add(&bar[XB_TOP], 1u);
            const unsigned tg = og / nx;
            if (og + 1u == (tg + 1u) * nx) xb_add(&bar[XB_TOPGEN], 1u);
            else XB_SPIN(xb_ld(&bar[XB_TOPGEN]) == tg, bar);
            __builtin_amdgcn_fence(__ATOMIC_ACQUIRE, "agent");
            xb_add(&bar[XB_XGEN(b.x)], 1u);
            asm volatile("s_waitcnt vmcnt(0)" ::: "memory");
        } else {
            XB_SPIN(xb_ld(&bar[XB_XGEN(b.x)]) == gen, bar);
            __builtin_amdgcn_fence(__ATOMIC_ACQUIRE, "agent");
            asm volatile("s_waitcnt vmcnt(0)" ::: "memory");
        }
    }
    __syncthreads();
}

__device__ __forceinline__ float a_fma(float a, float b, float c) { float d; asm("v_fma_f32 %0, %1, %2, %3" : "=v"(d) : "v"(a), "v"(b), "v"(c)); return d; }
__device__ __forceinline__ float a_fnma(float a, float b, float c) { float d; asm("v_fma_f32 %0, -%1, %2, %3" : "=v"(d) : "v"(a), "v"(b), "v"(c)); return d; }
__device__ __forceinline__ float a_mul(float a, float b) { float d; asm("v_mul_f32 %0, %1, %2" : "=v"(d) : "v"(a), "v"(b)); return d; }
__device__ __forceinline__ float a_add(float a, float b) { float d; asm("v_add_f32 %0, %1, %2" : "=v"(d) : "v"(a), "v"(b)); return d; }
constexpr int RC_LEN = 256, RC_N = SEQ / RC_LEN;
constexpr int ST_STEPS = 16, ST_FL = ST_STEPS * 384, ST_NPC = ST_STEPS * 56, ST_OB = ST_STEPS * 32 * 16, ST_NSUB = RC_LEN / ST_STEPS;
__device__ __forceinline__ void st_load(const unsigned char* src, int sub, int tid, u32x4 (&rg)[2]) {
#pragma unroll
    for (int n = 0; n < 2; ++n) { const int i = tid + NTHR * n; if (i < ST_NPC) { const int step = i / 56, j = i % 56;
        rg[n] = *(const u32x4*)(src + ((size_t)sub * ST_STEPS + step) * 896 + (j < 16 ? j * 16 : 256 + (j - 16) * 16)); } }
}
__device__ __forceinline__ void st_store(LAS float* buf, int tid, const u32x4 (&rg)[2]) {
#pragma unroll
    for (int n = 0; n < 2; ++n) { const int i = tid + NTHR * n; if (i < ST_NPC) { const int step = i / 56, j = i % 56;
        if (j < 16) { *(LAS u32x4*)(buf + step * 384 + j * 4) = rg[n]; }
        else { const int a = (j - 16) >> 3, e = (j - 16) & 7; const h16x8 h = __builtin_bit_cast(h16x8, rg[n]); f32x4 lo, hi;
            lo[0] = (float)h[0]; lo[1] = (float)h[1]; lo[2] = (float)h[2]; lo[3] = (float)h[3]; hi[0] = (float)h[4]; hi[1] = (float)h[5]; hi[2] = (float)h[6]; hi[3] = (float)h[7];
            LAS f32x4* d = (LAS f32x4*)(buf + step * 384 + 64 + a * 64 + e * 8); d[0] = lo; d[1] = hi; } } }
}
#define RAW_BAR() do { asm volatile("s_waitcnt lgkmcnt(0)" ::: "memory"); __builtin_amdgcn_s_barrier(); asm volatile("" ::: "memory"); } while (0)
#define DPP_ADD(x_, ctl_) "v_add_f32_dpp %[" x_ "], %[" x_ "], %[" x_ "] " ctl_ " row_mask:0xf bank_mask:0xf bound_ctrl:1\n\t"
template <bool OUT> __device__ __forceinline__ void scan_task(Frame& F, const unsigned char* src, const float* initS, bool ident, bool use_v, float* endS, float* Og) {
    constexpr int STS = OUT ? 8 : 16, NSUB = RC_LEN / STS, FL = STS * 384, NPC = STS * 56, PT = (NPC + NTHR - 1) / NTHR, OB = STS * 64 * 16;
    LAS float* buf = (LAS float*)F.lds;
    LAS float* obuf = (LAS float*)(F.lds + 2 * FL * 4);
    const int tid = F.tid, wave = F.wave, lane = F.lane, ks = lane & 15;
    int rowr[2]; float S[2][4];
#pragma unroll
    for (int r = 0; r < 2; ++r) { rowr[r] = (wave * 2 + r) * 4 + (lane >> 4);
        if (initS) { const f32x4 i4 = *(const f32x4*)(initS + (size_t)rowr[r] * 64 + 4 * ks); S[r][0] = i4[0]; S[r][1] = i4[1]; S[r][2] = i4[2]; S[r][3] = i4[3]; }
        else {
#pragma unroll
            for (int e = 0; e < 4; ++e) S[r][e] = (ident && 4 * ks + e == rowr[r]) ? 1.f : 0.f; } }
    u32x4 rg[2][PT];
#define ST_LOAD(sub_, rg_) do { _Pragma("unroll") for (int n_ = 0; n_ < PT; ++n_) { const int i_ = tid + NTHR * n_; if (i_ < NPC) { const int step_ = i_ / 56, j_ = i_ % 56; \
        rg_[n_] = *(const u32x4*)(src + ((size_t)(sub_) * STS + step_) * 896 + (j_ < 16 ? j_ * 16 : 256 + (j_ - 16) * 16)); } } } while (0)
#define ST_STORE(buf_, rg_) do { _Pragma("unroll") for (int n_ = 0; n_ < PT; ++n_) { const int i_ = tid + NTHR * n_; if (i_ < NPC) { const int step_ = i_ / 56, j_ = i_ % 56; \
        if (j_ < 16) { *(LAS u32x4*)((buf_) + step_ * 384 + j_ * 4) = rg_[n_]; } \
        else { const int a_ = (j_ - 16) >> 3, e_ = (j_ - 16) & 7; const h16x8 h_ = __builtin_bit_cast(h16x8, rg_[n_]); f32x4 lo_, hi_; \
            lo_[0] = (float)h_[0]; lo_[1] = (float)h_[1]; lo_[2] = (float)h_[2]; lo_[3] = (float)h_[3]; hi_[0] = (float)h_[4]; hi_[1] = (float)h_[5]; hi_[2] = (float)h_[6]; hi_[3] = (float)h_[7]; \
            LAS f32x4* d_ = (LAS f32x4*)((buf_) + step_ * 384 + 64 + a_ * 64 + e_ * 8); d_[0] = lo_; d_[1] = hi_; } } } } while (0)
    ST_LOAD(0, rg[0]); ST_STORE(buf, rg[0]); ST_LOAD(1, rg[1]); ST_LOAD(2, rg[0]);
    RAW_BAR();
#pragma unroll 1
    for (int sc2 = 0; sc2 < NSUB; sc2 += 2) {
#pragma unroll
      for (int u = 0; u < 2; ++u) { const int sc = sc2 + u;
        if (sc + 1 < NSUB) { ST_STORE(buf + ((sc + 1) & 1) * FL, rg[(u + 1) & 1]); if (sc + 3 < NSUB) ST_LOAD(sc + 3, rg[(u + 1) & 1]); }
        {
            const LAS float* bb = buf + (sc & 1) * FL + 4 * ks; const LAS float* vb0 = buf + (sc & 1) * FL + 192 + rowr[0]; const LAS float* vb1 = buf + (sc & 1) * FL + 192 + rowr[1];
            LAS float* ob0 = obuf + (sc & 1) * OB + rowr[0] * 16 + ks; LAS float* ob1 = obuf + (sc & 1) * OB + rowr[1] * 16 + ks;
            f32x4 w_[2], r_[2], k_[2], kk_[2], b_[2]; float v_[2][2];
#define SC_LD(s_, j_) do { const LAS float* p_ = bb + (s_) * 384; w_[j_] = *(const LAS f32x4*)(p_); if (OUT) r_[j_] = *(const LAS f32x4*)(p_ + 64); k_[j_] = *(const LAS f32x4*)(p_ + 128); \
                kk_[j_] = *(const LAS f32x4*)(p_ + 256); b_[j_] = *(const LAS f32x4*)(p_ + 320); v_[j_][0] = vb0[(s_) * 384]; v_[j_][1] = vb1[(s_) * 384]; } while (0)
            SC_LD(0, 0);
#pragma unroll
            for (int s = 0; s < STS; ++s) { const int j = s & 1;
                f32x4 rp; if (OUT) rp = r_[j ^ 1];
                if (s + 1 < STS) SC_LD(s + 1, j ^ 1);
                const f32x4 w = w_[j], k = k_[j], kk = kk_[j], bv = b_[j];
#pragma unroll
                for (int r = 0; r < 2; ++r) { const float v = use_v ? v_[j][r] : 0.f;
                    float sa, op, u0, u1, u2, u3;
                    if (OUT && s > 0) {
                        asm volatile(
                            "v_mul_f32 %[sa], %[Sa], %[kk0]\n\t" "v_fma_f32 %[sa], %[Sb], %[kk1], %[sa]\n\t" "v_fma_f32 %[sa], %[Sc], %[kk2], %[sa]\n\t" "v_fma_f32 %[sa], %[Sd], %[kk3], %[sa]\n\t"
                            "v_mul_f32 %[op], %[Sa], %[r0]\n\t" "v_fma_f32 %[op], %[Sb], %[r1], %[op]\n\t"
                            DPP_ADD("sa", "quad_perm:[1,0,3,2]") "v_fma_f32 %[op], %[Sc], %[r2], %[op]\n\t" "v_fma_f32 %[op], %[Sd], %[r3], %[op]\n\t"
                            DPP_ADD("sa", "quad_perm:[2,3,0,1]") "v_mul_f32 %[u0], %[v], %[k0]\n\t" "v_mul_f32 %[u1], %[v], %[k1]\n\t"
                            DPP_ADD("sa", "row_half_mirror") "v_mul_f32 %[u2], %[v], %[k2]\n\t" "v_mul_f32 %[u3], %[v], %[k3]\n\t"
                            DPP_ADD("sa", "row_mirror")
                            : [sa] "=&v"(sa), [op] "=&v"(op), [u0] "=&v"(u0), [u1] "=&v"(u1), [u2] "=&v"(u2), [u3] "=&v"(u3)
                            : [Sa] "v"(S[r][0]), [Sb] "v"(S[r][1]), [Sc] "v"(S[r][2]), [Sd] "v"(S[r][3]), [kk0] "v"(kk[0]), [kk1] "v"(kk[1]), [kk2] "v"(kk[2]), [kk3] "v"(kk[3]),
                              [r0] "v"(rp[0]), [r1] "v"(rp[1]), [r2] "v"(rp[2]), [r3] "v"(rp[3]), [v] "v"(v), [k0] "v"(k[0]), [k1] "v"(k[1]), [k2] "v"(k[2]), [k3] "v"(k[3]));
                        (r == 0 ? ob0 : ob1)[(s - 1) * 1024] = op;
                    } else {
                        asm volatile(
                            "v_mul_f32 %[sa], %[Sa], %[kk0]\n\t" "v_fma_f32 %[sa], %[Sb], %[kk1], %[sa]\n\t" "v_fma_f32 %[sa], %[Sc], %[kk2], %[sa]\n\t" "v_fma_f32 %[sa], %[Sd], %[kk3], %[sa]\n\t"
                            "v_mul_f32 %[u0], %[v], %[k0]\n\t" "v_mul_f32 %[u1], %[v], %[k1]\n\t"
                            DPP_ADD("sa", "quad_perm:[1,0,3,2]") "v_mul_f32 %[u2], %[v], %[k2]\n\t" "v_mul_f32 %[u3], %[v], %[k3]\n\t"
                            DPP_ADD("sa", "quad_perm:[2,3,0,1]") "s_nop 1\n\t"
                            DPP_ADD("sa", "row_half_mirror") "s_nop 1\n\t"
                            DPP_ADD("sa", "row_mirror")
                            : [sa] "=&v"(sa), [u0] "=&v"(u0), [u1] "=&v"(u1), [u2] "=&v"(u2), [u3] "=&v"(u3)
                            : [Sa] "v"(S[r][0]), [Sb] "v"(S[r][1]), [Sc] "v"(S[r][2]), [Sd] "v"(S[r][3]), [kk0] "v"(kk[0]), [kk1] "v"(kk[1]), [kk2] "v"(kk[2]), [kk3] "v"(kk[3]),
                              [v] "v"(v), [k0] "v"(k[0]), [k1] "v"(k[1]), [k2] "v"(k[2]), [k3] "v"(k[3]));
                    }
                    asm volatile(
                        "v_fma_f32 %[u0], -%[sa], %[b0], %[u0]\n\t" "v_fma_f32 %[u1], -%[sa], %[b1], %[u1]\n\t" "v_fma_f32 %[u2], -%[sa], %[b2], %[u2]\n\t" "v_fma_f32 %[u3], -%[sa], %[b3], %[u3]\n\t"
                        "v_fma_f32 %[Sa], %[Sa], %[w0], %[u0]\n\t" "v_fma_f32 %[Sb], %[Sb], %[w1], %[u1]\n\t" "v_fma_f32 %[Sc], %[Sc], %[w2], %[u2]\n\t" "v_fma_f32 %[Sd], %[Sd], %[w3], %[u3]\n\t"
                        : [Sa] "+v"(S[r][0]), [Sb] "+v"(S[r][1]), [Sc] "+v"(S[r][2]), [Sd] "+v"(S[r][3]), [u0] "+v"(u0), [u1] "+v"(u1), [u2] "+v"(u2), [u3] "+v"(u3)
                        : [sa] "v"(sa), [b0] "v"(bv[0]), [b1] "v"(bv[1]), [b2] "v"(bv[2]), [b3] "v"(bv[3]), [w0] "v"(w[0]), [w1] "v"(w[1]), [w2] "v"(w[2]), [w3] "v"(w[3])); }
                __builtin_amdgcn_sched_barrier(0); }
            if (OUT) { const f32x4 r4 = r_[(STS - 1) & 1];
              ob0[(STS - 1) * 1024] = a_fma(S[0][3], r4[3], a_fma(S[0][2], r4[2], a_fma(S[0][1], r4[1], a_mul(S[0][0], r4[0]))));
              ob1[(STS - 1) * 1024] = a_fma(S[1][3], r4[3], a_fma(S[1][2], r4[2], a_fma(S[1][1], r4[1], a_mul(S[1][0], r4[0])))); }
#undef SC_LD
        }
        RAW_BAR();
        if (OUT) {
            const LAS f32x4* p = (const LAS f32x4*)(obuf + (sc & 1) * OB + tid * 16); const f32x4 a = p[0], b = p[1], c = p[2], d = p[3];
            const float o = (((a[0] + a[1]) + (a[2] + a[3])) + ((b[0] + b[1]) + (b[2] + b[3]))) + (((c[0] + c[1]) + (c[2] + c[3])) + ((d[0] + d[1]) + (d[2] + d[3])));
            Og[((size_t)sc * STS + (tid >> 6)) * 256 + (tid & 63)] = o; }
      }
    }
#undef ST_LOAD
#undef ST_STORE
    if (endS) {
#pragma unroll
        for (int r = 0; r < 2; ++r) *(f32x4*)(endS + (size_t)rowr[r] * 64 + 4 * ks) = (f32x4){S[r][0], S[r][1], S[r][2], S[r][3]}; }
    RAW_BAR();
}
#undef DPP_ADD
__device__ __forceinline__ void rwkv_carry(Frame& F) {
    const int hb = F.bx >> 3, row = (F.bx & 7) * 8 + F.wave, lane = F.lane, tid = F.tid;
    LAS float* Pl = (LAS float*)F.lds;
    LAS float* Sl = (LAS float*)(F.lds + 16384) + F.wave * 64;
    float S = 0.f;
    const size_t m0 = (size_t)hb * RC_N * 4096;
    f32x4 p0 = *(const f32x4*)(F.PB + m0 + (size_t)tid * 8), p1 = *(const f32x4*)(F.PB + m0 + (size_t)tid * 8 + 4);
    float lc = F.LB[m0 + (size_t)row * 64 + lane];
#pragma unroll 1
    for (int c = 0; c < RC_N; ++c) { const size_t mo = m0 + (size_t)c * 4096;
        F.SB[mo + (size_t)row * 64 + lane] = S;
        if (c + 1 == RC_N) break;
        float acc = lc;
        *(LAS f32x4*)(Pl + tid * 8) = p0; *(LAS f32x4*)(Pl + tid * 8 + 4) = p1; Sl[lane] = S;
        if (c + 2 < RC_N) { p0 = *(const f32x4*)(F.PB + mo + 4096 + (size_t)tid * 8); p1 = *(const f32x4*)(F.PB + mo + 4096 + (size_t)tid * 8 + 4); lc = F.LB[mo + 4096 + (size_t)row * 64 + lane]; }
        RAW_BAR();
        float a0 = 0.f, a1 = 0.f, a2 = 0.f, a3 = 0.f;
#pragma unroll 4
        for (int j = 0; j < 64; j += 4) { const f32x4 s4 = *(const LAS f32x4*)(Sl + j);
            a0 += s4[0] * Pl[(j + 0) * 64 + lane]; a1 += s4[1] * Pl[(j + 1) * 64 + lane]; a2 += s4[2] * Pl[(j + 2) * 64 + lane]; a3 += s4[3] * Pl[(j + 3) * 64 + lane]; }
        S = acc + ((a0 + a1) + (a2 + a3));
        RAW_BAR();
    }
}
__device__ __forceinline__ float gelu_tanh(float x) { const float u = 0.7978845608028654f * (x + 0.044715f * x * x * x); return 0.5f * x * (1.0f + tanhf(u)); }
__device__ __forceinline__ void s5_pass2(Frame& F, int l, int c) {
    typedef short bf16x8_t __attribute__((ext_vector_type(8)));
    LAS float* ubuf = (LAS float*)F.lds;
    const int t0 = c * 64, lane = F.lane, wave = F.wave, cb0 = c & ~127;
    LAS unsigned short* hb = (LAS unsigned short*)(F.lds + 65536) + wave * (16 * 136);
    load_u5_tile(F, t0, ubuf);
    __syncthreads();
    const int r16 = lane & 15, quad = lane >> 4;
#pragma unroll 1
    for (int gi = 0; gi < 2; ++gi) { const int g = wave + 8 * gi; S5Par P; s5_params(F, l, g, lane, P);
        int lane_l = lane; asm volatile("" : "+v"(lane_l));
        bf16x8_t cf[4];
#pragma unroll
        for (int ks = 0; ks < 4; ++ks) { const float* src = (ks < 2 ? F.in[12] : F.in[13]) + (((size_t)l * 16 + g) * 16 + (lane_l & 15)) * 64 + (ks & 1) * 32 + quad * 8;
            const f32x4 a = *(const f32x4*)src, b = *(const f32x4*)(src + 4); const float sg = ks < 2 ? 1.0f : -1.0f;
            cf[ks][0] = (short)f2bf(a[0] * sg); cf[ks][1] = (short)f2bf(a[1] * sg); cf[ks][2] = (short)f2bf(a[2] * sg); cf[ks][3] = (short)f2bf(a[3] * sg);
            cf[ks][4] = (short)f2bf(b[0] * sg); cf[ks][5] = (short)f2bf(b[1] * sg); cf[ks][6] = (short)f2bf(b[2] * sg); cf[ks][7] = (short)f2bf(b[3] * sg); }
        const int chy = g * 16 + r16; const float dd = F.in[14][(size_t)l * 256 + chy];
        float pr = P.ar, pi = P.ai;
#pragma unroll
        for (int s = 0; s < 6; ++s) { const float nr = pr * pr - pi * pi, ni = 2.0f * pr * pi; pr = nr; pi = ni; }
        float hr = 0.f, hi = 0.f;
#pragma unroll 1
        for (int c2 = cb0; c2 < c; c2 += 16) {
            f32x2 e[16];
#pragma unroll
            for (int q = 0; q < 16; ++q) { const int cq = (c2 + q < c) ? c2 + q : c2; e[q] = *(const f32x2*)(F.E + (((size_t)cq * 16 + g) * 64 + lane_l) * 2); }
#pragma unroll
            for (int q = 0; q < 16; ++q) if (c2 + q < c) { const float nr = pr * hr - pi * hi + e[q][0], ni = pr * hi + pi * hr + e[q][1]; hr = nr; hi = ni; } }
#pragma unroll 1
        for (int tb = 0; tb < 4; ++tb) {
#pragma unroll 4
            for (int j = 0; j < 16; ++j) { s5_step(P, ubuf + (tb * 16 + j) * 256 + g * 16, hr, hi);
                hb[j * 136 + lane] = (unsigned short)f2bf(hr); hb[j * 136 + 64 + lane] = (unsigned short)f2bf(hi); }
            f32x4 acc = {0.f, 0.f, 0.f, 0.f};
#pragma unroll
            for (int ks = 0; ks < 4; ++ks) { const bf16x8_t a = *(const LAS bf16x8_t*)(hb + r16 * 136 + ks * 32 + quad * 8);
                acc = __builtin_amdgcn_mfma_f32_16x16x32_bf16(a, cf[ks], acc, 0, 0, 0); }
#pragma unroll
            for (int j = 0; j < 4; ++j) { const int tl = tb * 16 + quad * 4 + j; const float y = acc[j] + dd * ubuf[tl * 256 + chy];
                F.GL[(size_t)(t0 + tl) * 256 + chy] = (bf16_t)f2bf(gelu_tanh(y)); }
        }
    }
    __syncthreads();
}
template <int PART> __device__ __forceinline__ void m2_phase(Frame& F, int l, const XcdBarrier& xbar) {
    if (PART == 0 || PART == 1)
#pragma unroll 1
    for (int id = F.bx; id < 8 * RC_N * 2; id += F.G) { const int hb = id >> 6, c = (id >> 1) & (RC_N - 1), tk = id & 1; const size_t mo = ((size_t)hb * RC_N + c) * 4096;
        if (c == RC_N - 1) continue;
        const unsigned char* src = F.RW + ((size_t)hb * SEQ + (size_t)c * RC_LEN) * 896;
        scan_task<false>(F, src, nullptr, tk == 1, tk == 0, (tk == 0 ? F.LB : F.PB) + mo, nullptr); }
    if (PART == 0 || PART == 2)
#pragma unroll 1
    for (int c = F.bx; c < TT / 64; c += F.G) pool_conv_chunk(F, l, c);
    xcd_barrier(xbar);
    if (PART == 0 || PART == 3) { int bxs = F.bx; asm volatile("" : "+s"(bxs));
      if (bxs < 64) rwkv_carry(F);
      else conv_second_half(F, l, 64); }
    xcd_barrier(xbar);
    if (PART == 0 || PART == 4)
#pragma unroll 1
    for (int id = F.bx; id < 8 * RC_N; id += F.G) { const int hb = id >> 5, c = id & (RC_N - 1); const size_t mo = ((size_t)hb * RC_N + c) * 4096;
        const unsigned char* src = F.RW + ((size_t)hb * SEQ + (size_t)c * RC_LEN) * 896;
        float* Og = F.O + ((size_t)(hb >> 2) * SEQ + (size_t)c * RC_LEN) * 256 + (hb & 3) * 64;
        scan_task<true>(F, src, F.SB + mo, false, true, nullptr, Og); }
    if (PART == 0 || PART == 5)
#pragma unroll 1
    for (int c = F.bx; c < TT / 64; c += F.G) s5_pass2(F, l, c);
}
__device__ __forceinline__ void rwkv_post(Frame& F, int l) {
    const int gw = F.bx * NWAVES + F.wave, NGW = F.G * NWAVES, lane = F.lane;
    for (int it0 = gw * 4; it0 < TT * 4; it0 += NGW * 4) {
        const int t = it0 >> 2, b = t / SEQ, pos = t & (SEQ - 1);
        float o[4], r[4], k[4], v[4], g[4];
#pragma unroll
        for (int hh = 0; hh < 4; ++hh) { const int c = hh * 64 + lane; o[hh] = F.O[(size_t)t * 256 + c]; g[hh] = (float)F.G16[(size_t)t * 256 + c];
            const h16* rw = (const h16*)(F.RW + ((size_t)(b * 4 + hh) * SEQ + pos) * 896 + 256) + lane; r[hh] = (float)rw[0]; k[hh] = (float)rw[64]; v[hh] = (float)rw[128]; }
#pragma unroll
        for (int hh = 0; hh < 4; ++hh) { const int c = hh * 64 + lane;
            const float mu = wave_sum(o[hh]) * (1.0f / 64.0f); const float d = o[hh] - mu; const float var = wave_sum(d * d) * (1.0f / 64.0f);
            const float on = d * rsqrtf(var + 64e-5f) * F.in[31][(size_t)l * 256 + c] + F.in[32][(size_t)l * 256 + c];
            const float bs = wave_sum(r[hh] * k[hh] * F.in[30][(size_t)l * 256 + c]);
            F.B2[(size_t)t * 1024 + 512 + c] = (bf16_t)f2bf((on + bs * v[hh]) * g[hh]); }
    }
}

constexpr int NPH = 25;
#ifndef PHMASK
#define PHMASK 0xFFFF
#endif
#define PHON(k) (((PHMASK) >> (k)) & 1)
#ifndef REP_PART
#define REP_PART 0
#endif
template <int PH, int PART = 0> __device__ __forceinline__ void run_phase(const int wave_s, unsigned char* lds_raw, const XcdBarrier& xbar) {
    typedef pg8::StaticOrder SO;
    int tid = wave_s * 64 + (int)__builtin_amdgcn_mbcnt_hi(~0u, __builtin_amdgcn_mbcnt_lo(~0u, 0u)); asm volatile("" : "+v"(tid));
    int G = gridDim.x, bx = blockIdx.x; asm volatile("" : "+s"(G), "+s"(bx));
    const __attribute__((address_space(4))) unsigned char* ka = (const __attribute__((address_space(4))) unsigned char*)__builtin_amdgcn_kernarg_segment_ptr();
    asm volatile("" : "+s"(ka));
    const __attribute__((address_space(4))) Args* ap = (const __attribute__((address_space(4))) Args*)ka;
    Frame F;
    F.lds = (LAS unsigned char*)lds_raw;
    F.tid = tid; F.lane = tid & 63; F.wave = __builtin_amdgcn_readfirstlane(tid >> 6); F.G = G; F.bx = bx;
    F.in = (in_t)ka; F.X = ap->out; F.ws = ap->ws;
    unsigned char* ws = F.ws;
    F.SS = (float*)(ws + WS_SS); F.E = (float*)(ws + WS_E); F.B1 = (bf16_t*)(ws + WS_B1); F.B2 = (bf16_t*)(ws + WS_B2);
    unsigned char* z = ws + WS_Z;
    F.HID = (bf16_t*)(z + Z_HID); F.GL = (bf16_t*)(z + Z_GL); F.U5 = (h16*)(z + Z_U5); F.PP = (h16*)(z + Z_PP); F.L16 = (h16*)(z + Z_L16); F.G16 = (h16*)(z + Z_G16); F.R = (h16*)(z + Z_R);
    F.O = (float*)(z + Z_O); F.RW = z + Z_RW; F.PB = (float*)(z + Z_PB); F.LB = (float*)(z + Z_LB); F.SB = (float*)(z + Z_SB);
    if constexpr (PH == 0) { conv_first_half(F, 0); prep_x(F); }
    else { constexpr int l = (PH - 1) / 12, k = (PH - 1) % 12;
        if constexpr (k == 0) { pg8::Gemm g{F.B1, (const bf16_t*)(ws + WS_W + W_GU1), TT, 2 * FF, DM, 1}; SO S; S.init(TT, 2 * FF, G, bx); pg8::EpiGU E{F.HID, F.SS}; pg8::gemm_phase<pg8::EpiGU, SO, true, true>(F.lds, g, S, E, tid); }
        else if constexpr (k == 1) { pg8::Gemm g{F.HID, (const bf16_t*)(ws + WS_W + W_D1), TT, DM, FF, 1}; SO S; S.init(TT, DM, G, bx); pg8::EpiDown E{l == 0 ? F.in[0] : F.X, F.X, F.B1, F.SS, 0.5f}; pg8::gemm_phase<pg8::EpiDown, SO, true, true>(F.lds, g, S, E, tid); }
        else if constexpr (k == 2) { pg8::Gemm g{F.B1, (const bf16_t*)(ws + WS_W + W_INA), TT, 2560, DM, 1}; SO S; S.init(TT, 2560, G, bx); pg8::EpiInA E{F.U5, F.PP, F.L16, F.SS}; pg8::gemm_phase<pg8::EpiInA, SO, true, true>(F.lds, g, S, E, tid); }
        else if constexpr (k == 3) { m1_phase(F, l); }
        else if constexpr (k == 4) { m2_phase<PART>(F, l, xbar); }
        else if constexpr (k == 5) { { pg8::Gemm g{F.GL, (const bf16_t*)(ws + WS_W + W_GLU), TT, 256, 256, 1}; SO S; S.init(TT, 256, G, bx); pg8::EpiGlu E{F.GL, F.B2}; pg8::gemm_phase<pg8::EpiGlu, SO, true, true>(F.lds, g, S, E, tid); } rwkv_post(F, l); }
        else if constexpr (k == 6) { pg8::Gemm g{F.B1, (const bf16_t*)(ws + WS_W + W_ING), TT, 4096, DM, 1}; SO S; S.init(TT, 4096, G, bx); pg8::EpiGate E{F.R, F.SS}; pg8::gemm_phase<pg8::EpiGate, SO, true, true>(F.lds, g, S, E, tid); }
        else if constexpr (k == 7) { pg8::Gemm g{F.B2, (const bf16_t*)(ws + WS_W + W_BR), TT, DM, DM, 4}; pg8::SegOrder4 S; S.so.init(TT, DM, G, bx); pg8::EpiBranch E{F.R, F.B1}; pg8::gemm_phase<pg8::EpiBranch, pg8::SegOrder4, true, true>(F.lds, g, S, E, tid); }
        else if constexpr (k == 8) { pg8::Gemm g{F.B1, (const bf16_t*)(ws + WS_W + W_O), TT, DM, DM, 1}; SO S; S.init(TT, DM, G, bx); pg8::EpiDown E{F.X, F.X, F.B2, F.SS, 1.0f}; pg8::gemm_phase<pg8::EpiDown, SO, true, true>(F.lds, g, S, E, tid); }
        else if constexpr (k == 9) { pg8::Gemm g{F.B2, (const bf16_t*)(ws + WS_W + W_GU2), TT, 2 * FF, DM, 1}; SO S; S.init(TT, 2 * FF, G, bx); pg8::EpiGU E{F.HID, F.SS}; pg8::gemm_phase<pg8::EpiGU, SO, true, true>(F.lds, g, S, E, tid); }
        else if constexpr (k == 10) { pg8::Gemm g{F.HID, (const bf16_t*)(ws + WS_W + W_D2), TT, DM, FF, 1}; SO S; S.init(TT, DM, G, bx); pg8::EpiDown E{F.X, F.X, F.B1, F.SS, 0.5f}; pg8::gemm_phase<pg8::EpiDown, SO, true, true>(F.lds, g, S, E, tid); }
        else { if constexpr (l == 0) conv_first_half(F, 1); else final_norm(F); }
    }
}
#ifndef REPMASK
#define REPMASK 0
#endif
#define SEAM(k_) do { if ((k_) == 0) { __syncthreads(); cg::this_grid().sync(); } else xcd_barrier(xbar); } while (0)
#define PHASE(k) if (ph_lo <= (k) && (k) < ph_hi) { run_phase<(k)>(wave_s, lds_raw, xbar); \
    if ((k) >= 1 && ((REPMASK >> (((k) - 1) % 12)) & 1)) { SEAM(k); run_phase<(k), REP_PART>(wave_s, lds_raw, xbar); } \
    if ((k) + 1 < ph_hi) SEAM(k); }
__global__ void __launch_bounds__(NTHR, 2) mk_fwd(Args args) {
    extern __shared__ __attribute__((aligned(16))) unsigned char lds_raw[];
    const int ph_lo = args.ph_lo, ph_hi = args.ph_hi;
    volatile LAS unsigned* xst = (volatile LAS unsigned*)((LAS unsigned char*)lds_raw + (LDS_BYTES - 64));
    if (threadIdx.x == 0) { xst[0] = 0u; xst[1] = 0u; }
    __syncthreads();
    const XcdBarrier xbar = xcd_barrier_post((unsigned*)(args.ws + WS_CTL), xst);
    const int wave_s = __builtin_amdgcn_readfirstlane((int)threadIdx.x >> 6);
    PHASE(0) PHASE(1) PHASE(2) PHASE(3) PHASE(4) PHASE(5) PHASE(6) PHASE(7) PHASE(8) PHASE(9) PHASE(10) PHASE(11) PHASE(12)
    PHASE(13) PHASE(14) PHASE(15) PHASE(16) PHASE(17) PHASE(18) PHASE(19) PHASE(20) PHASE(21) PHASE(22) PHASE(23) PHASE(24)
}

extern "C" void kernel_launch(void* const* d_in, const int* in_sizes, int n_in, void* d_out, int out_size, void* d_ws, size_t ws_size, hipStream_t stream) {
    static int grid = 0;
    if (grid == 0) {
        if (n_in != 41 || out_size != TT * DM || ws_size < WS_END) { fprintf(stderr, "kernel_launch: unexpected shapes (n_in %d out %d ws %zu)\n", n_in, out_size, ws_size); grid = -1; return; }
        int dev = 0, cus = 0, per_cu = 0;
        (void)hipGetDevice(&dev); (void)hipDeviceGetAttribute(&cus, hipDeviceAttributeMultiprocessorCount, dev);
        if (hipFuncSetAttribute((const void*)mk_fwd, hipFuncAttributeMaxDynamicSharedMemorySize, LDS_BYTES) != hipSuccess) { fprintf(stderr, "kernel_launch: hipFuncSetAttribute failed\n"); grid = -1; return; }
        if (hipOccupancyMaxActiveBlocksPerMultiprocessor(&per_cu, (const void*)mk_fwd, NTHR, LDS_BYTES) != hipSuccess || per_cu < 1) { fprintf(stderr, "kernel_launch: occupancy query says %d\n", per_cu); per_cu = 1; }
        (void)hipGetLastError();
        grid = cus * (per_cu >= 1 ? 1 : 1);
        if (grid < 64) { fprintf(stderr, "kernel_launch: grid %d too small\n", grid); }
    }
    if (grid < 0) return;
    if (hipMemsetAsync((char*)d_ws + WS_CTL, 0, CTL_ZERO_BYTES, stream) != hipSuccess) { fprintf(stderr, "kernel_launch: hipMemsetAsync failed\n"); return; }
    Args a{};
    for (int i = 0; i < 41; ++i) a.in[i] = (const float*)d_in[i];
    a.out = (float*)d_out; a.ws = (unsigned char*)d_ws;
#if ONE_LAUNCH
    a.ph_lo = 0; a.ph_hi = NPH;
    void* kargs[] = {&a};
    hipError_t e = hipLaunchCooperativeKernel((const void*)mk_fwd, dim3(grid), dim3(NTHR), kargs, LDS_BYTES, stream);
    if (e != hipSuccess) fprintf(stderr, "cooperative launch failed: %s (grid %d)\n", hipGetErrorString(e), grid);
#else
    for (int ph = 0; ph < NPH; ++ph) { a.ph_lo = ph; a.ph_hi = ph + 1; hipLaunchKernelGGL(mk_fwd, dim3(grid), dim3(NTHR), LDS_BYTES, stream, a); }
#endif
}
```

```cpp
#include <hip/hip_runtime.h>
#include <hip/hip_cooperative_groups.h>
#include <cstdio>
#include <cstdint>
#include <cstddef>
namespace cg = cooperative_groups;
namespace pg8 {
#define PG8_LAS __attribute__((address_space(3)))
typedef unsigned short bf16_t;
typedef short bf16x8 __attribute__((ext_vector_type(8)));
typedef float f32x4 __attribute__((ext_vector_type(4)));
typedef unsigned u32x4 __attribute__((ext_vector_type(4)));
constexpr int BM = 256, BK = 64, HALF = 128, HTB = HALF * BK * 2  , STAGE_BYTES = 8 * HTB, NXCD = 8, WGM = 8;

__host__ __device__ __forceinline__ int lds_byte(int r, int c) { const int st = (r >> 4) * 2 + (c >> 5), rr = r & 15, cc = c & 31, ob = rr * 64 + cc * 2; return st * 1024 + (ob ^ (((ob >> 9) & 1) << 5)); }
__host__ __device__ __forceinline__ void stage_rc(int b, int& R, int& C) { const int st = b / 1024, sb = b % 1024, swz = sb ^ (((sb >> 9) & 1) << 5); R = (st >> 1) * 16 + swz / 64; C = (st & 1) * 32 + (swz % 64) / 2; }
__host__ __device__ __forceinline__ int perm32(int rho) { const int n = rho >> 4, i = rho & 15; return 8 * (i >> 2) + 4 * n + (i & 3); }

struct Unit { int pm, pn, g; };
struct Gemm { const bf16_t* A; const bf16_t* Bt; int M, N, K, nseg; };

struct StaticOrder {
    int nM, nN, nwg, G, c;
    __host__ __device__ void init(int M, int N, int G_, int c_) { nM = M / BM; nN = N / BM; nwg = nM * nN; G = G_; c = c_; }
    __host__ __device__ bool next(int i, Unit& u) const {
        const long L = (long)i * G + c; if (L >= nwg) return false;
        int wgid = (int)L; { const int q = nwg / NXCD, r = nwg % NXCD, xcd = wgid % NXCD, off = wgid / NXCD; wgid = (xcd < r ? xcd * (q + 1) : r * (q + 1) + (xcd - r) * q) + off; }
        const int nig = WGM * nN, gid = wgid / nig, fm = gid * WGM, gsz = (nM - fm) < WGM ? (nM - fm) : WGM;
        u.pm = fm + ((wgid % nig) % gsz); u.pn = (wgid % nig) / gsz; u.g = 0; return true;
    }
    __device__ __forceinline__ void a_ready(const Unit&) const {}
    __device__ __forceinline__ void done(const Unit&) const {}
};


struct SegOrder4 {
    StaticOrder so;
    __host__ __device__ bool next(int i, Unit& u) const { if (!so.next(i >> 2, u)) return false; u.g = i & 3; return true; }
    __device__ __forceinline__ void a_ready(const Unit&) const {}
    __device__ __forceinline__ void done(const Unit&) const {}
};

typedef _Float16 h16;
typedef _Float16 h16x4 __attribute__((ext_vector_type(4)));
typedef unsigned u32x2 __attribute__((ext_vector_type(2)));
__device__ __forceinline__ unsigned cvt_pk_bf16(float lo, float hi) { unsigned r; asm volatile("v_cvt_pk_bf16_f32 %0, %1, %2" : "=v"(r) : "v"(lo), "v"(hi)); return r; }
__device__ __forceinline__ u32x2 pack_bf16x4(f32x4 v) { u32x2 w; w.x = cvt_pk_bf16(v[0], v[1]); w.y = cvt_pk_bf16(v[2], v[3]); return w; }
__device__ __forceinline__ h16x4 pack_h16x4(f32x4 v) { h16x4 w; w[0] = (h16)v[0]; w[1] = (h16)v[1]; w[2] = (h16)v[2]; w[3] = (h16)v[3]; return w; }
__device__ __forceinline__ float fast_sigmoid(float x) { return __builtin_amdgcn_rcpf(1.0f + __expf(-x)); }
__device__ __forceinline__ float row_rstd(const float* SS, int row) {
    const f32x4* p = (const f32x4*)(SS + (size_t)row * 16);
    const f32x4 a = p[0], b = p[1], c = p[2], d = p[3];
    const float s = ((a[0] + a[1]) + (a[2] + a[3])) + ((b[0] + b[1]) + (b[2] + b[3])) + ((c[0] + c[1]) + (c[2] + c[3])) + ((d[0] + d[1]) + (d[2] + d[3]));
    return rsqrtf(s * (1.0f / 1024.0f) + 1e-6f);
}

__device__ __forceinline__ void rows_rstd(const float* SS, int row0, int fq, float (&rs)[8]) {
    f32x4 q[8];
#pragma unroll
    for (int sl = 0; sl < 8; ++sl) q[sl] = *(const f32x4*)(SS + (size_t)(row0 + (sl >> 2) * HALF + (sl & 3) * 16) * 16 + 4 * fq);
#pragma unroll
    for (int sl = 0; sl < 8; ++sl) { float s = (q[sl][0] + q[sl][1]) + (q[sl][2] + q[sl][3]); s += __shfl_xor(s, 16); s += __shfl_xor(s, 32); rs[sl] = rsqrtf(s * (1.0f / 1024.0f) + 1e-6f); }
}

struct EpiGU {
    static constexpr bool PERM = true, KSEG = false;
    bf16_t* hid; const float* SS;
    __device__ __forceinline__ void operator()(const f32x4 (&acc)[2][2][4][2], const Unit& u, int wr, int wc, int fr, int fq) const {
        int row0 = u.pm * BM + wr * 64 + fr; asm volatile("" : "+v"(row0)); const int j0 = u.pn * 128 + wc * 32 + fq * 8;
        float rsv[8]; rows_rstd(SS, row0, fq, rsv);
#pragma unroll
        for (int ai = 0; ai < 2; ++ai)
#pragma unroll
            for (int m = 0; m < 4; ++m) { const int row = row0 + ai * HALF + m * 16; const float rs = rsv[ai * 4 + m]; u32x4 w;
#pragma unroll
                for (int n = 0; n < 2; ++n) { const f32x4 g = acc[ai][0][m][n] * rs, up = acc[ai][1][m][n] * rs; f32x4 h;
#pragma unroll
                    for (int i = 0; i < 4; ++i) h[i] = g[i] * fast_sigmoid(g[i]) * up[i];
                    const u32x2 p = pack_bf16x4(h); if (n == 0) { w.x = p.x; w.y = p.y; } else { w.z = p.x; w.w = p.y; } }
                *(u32x4*)(hid + (size_t)row * 2816 + j0) = w; }
    }
};
struct EpiDown {
    static constexpr bool PERM = true, KSEG = false;
    const float* res; float* X; bf16_t* xb; float* SS; float alpha;
    __device__ __forceinline__ void operator()(const f32x4 (&acc)[2][2][4][2], const Unit& u, int wr, int wc, int fr, int fq) const {
        int row0 = u.pm * BM + wr * 64 + fr; asm volatile("" : "+v"(row0)); const int c0 = u.pn * BM + wc * 32 + fq * 8;
#pragma unroll
        for (int ai = 0; ai < 2; ++ai) {
            f32x4 rv[4][2][2];
#pragma unroll
            for (int m = 0; m < 4; ++m)
#pragma unroll
                for (int bj = 0; bj < 2; ++bj)
#pragma unroll
                    for (int n = 0; n < 2; ++n) rv[m][bj][n] = *(const f32x4*)(res + (size_t)(row0 + ai * HALF + m * 16) * 1024 + c0 + bj * HALF + n * 4);
#pragma unroll
            for (int m = 0; m < 4; ++m) { const int row = row0 + ai * HALF + m * 16; float ss = 0.f;
#pragma unroll
                for (int bj = 0; bj < 2; ++bj) { const size_t off = (size_t)row * 1024 + c0 + bj * HALF;
                    const f32x4 o0 = rv[m][bj][0] + acc[ai][bj][m][0] * alpha, o1 = rv[m][bj][1] + acc[ai][bj][m][1] * alpha;
                    *(f32x4*)(X + off) = o0; *(f32x4*)(X + off + 4) = o1;
                    const u32x2 p0 = pack_bf16x4(o0), p1 = pack_bf16x4(o1); u32x4 w; w.x = p0.x; w.y = p0.y; w.z = p1.x; w.w = p1.y; *(u32x4*)(xb + off) = w;
                    ss += ((o0[0] * o0[0] + o0[1] * o0[1]) + (o0[2] * o0[2] + o0[3] * o0[3])) + ((o1[0] * o1[0] + o1[1] * o1[1]) + (o1[2] * o1[2] + o1[3] * o1[3])); }
                ss += __shfl_xor(ss, 16); ss += __shfl_xor(ss, 32);
                if (fq == 0) SS[(size_t)row * 16 + u.pn * 4 + wc] = ss; }
            asm volatile("" ::: "memory"); }
    }
};
struct EpiInA {
    static constexpr bool PERM = true, KSEG = false;
    h16* U5; h16* PP; h16* L16; const float* SS;
    __device__ __forceinline__ void operator()(const f32x4 (&acc)[2][2][4][2], const Unit& u, int wr, int wc, int fr, int fq) const {
        typedef _Float16 h16x8 __attribute__((ext_vector_type(8)));
        int row0 = u.pm * BM + wr * 64 + fr; asm volatile("" : "+v"(row0)); const int cl = wc * 32 + fq * 8;
        float rsv[8]; rows_rstd(SS, row0, fq, rsv);
        h16* base; int ld, cb;
        if (u.pn == 0) { base = U5; ld = 256; cb = 0; } else if (u.pn < 8) { base = PP; ld = 1792; cb = (u.pn - 1) * 256; } else { base = L16; ld = 512; cb = (u.pn - 8) * 256; }
#pragma unroll
        for (int ai = 0; ai < 2; ++ai)
#pragma unroll
            for (int m = 0; m < 4; ++m) { const int row = row0 + ai * HALF + m * 16; const float rs = rsv[ai * 4 + m];
#pragma unroll
                for (int bj = 0; bj < 2; ++bj) { const f32x4 a = acc[ai][bj][m][0] * rs, b = acc[ai][bj][m][1] * rs; h16x8 w;
                    w[0] = (h16)a[0]; w[1] = (h16)a[1]; w[2] = (h16)a[2]; w[3] = (h16)a[3]; w[4] = (h16)b[0]; w[5] = (h16)b[1]; w[6] = (h16)b[2]; w[7] = (h16)b[3];
                    *(h16x8*)(base + (size_t)row * ld + cb + cl + bj * HALF) = w; } }
    }
};
struct EpiGate {
    static constexpr bool PERM = false, KSEG = false;
    h16* R; const float* SS;
    __device__ __forceinline__ void operator()(const f32x4 (&acc)[2][2][4][2], const Unit& u, int wr, int wc, int fr, int fq) const {
        float rsv[8]; int row0 = u.pm * BM + wr * 64 + fr; asm volatile("" : "+v"(row0)); rows_rstd(SS, row0, fq, rsv); const int d0 = 256 * (u.pn >> 2) + 128 * ((u.pn >> 1) & 1) + 16 * (u.pn & 1) + 32 * wc + 4 * fq;
#pragma unroll
        for (int ai = 0; ai < 2; ++ai)
#pragma unroll
            for (int m = 0; m < 4; ++m) { const int row = row0 + ai * HALF + m * 16; const float rs = rsv[ai * 4 + m];
                f32x4 e[4];
#pragma unroll
                for (int g = 0; g < 4; ++g)
#pragma unroll
                    for (int i = 0; i < 4; ++i) e[g][i] = 1.0f + __expf(-fminf(fmaxf(acc[ai][g >> 1][m][g & 1][i] * rs, -10.f), 30.f));
                f32x4 r[4];
#pragma unroll
                for (int i = 0; i < 4; ++i) { const float i0 = __builtin_amdgcn_rcpf(e[0][i]), i1 = __builtin_amdgcn_rcpf(e[1][i]), i2 = __builtin_amdgcn_rcpf(e[2][i]), i3 = __builtin_amdgcn_rcpf(e[3][i]);
                    r[0][i] = e[1][i] * i0; r[1][i] = e[2][i] * i1; r[2][i] = e[3][i] * i2; r[3][i] = i3; }
#pragma unroll
                for (int g = 0; g < 4; ++g) *(h16x4*)(R + ((size_t)row * 4 + g) * 1024 + d0) = pack_h16x4(r[g]); }
    }
};
struct EpiBranch {
    static constexpr bool PERM = false, KSEG = true;
    const h16* R; bf16_t* out;
    __device__ __forceinline__ void operator()(f32x4 (&acc)[2][2][4][2], const Unit& u, int wr, int wc, int fr, int fq) const {
        unsigned q0 = (unsigned)(u.pm * BM + wr * 64 + fr) * 1024u + (unsigned)(u.pn * BM + wc * 32 + fq * 4); asm volatile("" : "+v"(q0));
        const unsigned r0 = (q0 - (q0 & 1023u)) * 4u + (unsigned)u.g * 1024u + (q0 & 1023u);
        const bool last = u.g == 3;
        h16x4 rr[2][4][2][2];
#pragma unroll
        for (int ai = 0; ai < 2; ++ai)
#pragma unroll
            for (int m = 0; m < 4; ++m)
#pragma unroll
                for (int bj = 0; bj < 2; ++bj)
#pragma unroll
                    for (int n = 0; n < 2; ++n) rr[ai][m][bj][n] = *(const h16x4*)(R + (r0 + (unsigned)((ai * HALF + m * 16) * 4096 + bj * HALF + n * 16)));
#pragma unroll
        for (int ai = 0; ai < 2; ++ai)
#pragma unroll
            for (int m = 0; m < 4; ++m) {
#pragma unroll
                for (int bj = 0; bj < 2; ++bj)
#pragma unroll
                    for (int n = 0; n < 2; ++n) { const unsigned off = q0 + (unsigned)((ai * HALF + m * 16) * 1024 + bj * HALF + n * 16);
                        const h16x4 r = rr[ai][m][bj][n];
                        f32x4 rf; rf[0] = (float)r[0]; rf[1] = (float)r[1]; rf[2] = (float)r[2]; rf[3] = (float)r[3];
                        acc[ai][bj][m][n] = acc[ai][bj][m][n] * rf;
                        if (last) *(u32x2*)(out + off) = pack_bf16x4(acc[ai][bj][m][n]); } }
    }
};
struct EpiGlu {
    static constexpr bool PERM = false, KSEG = false;
    const bf16_t* gl; bf16_t* ys;
    __device__ __forceinline__ void operator()(const f32x4 (&acc)[2][2][4][2], const Unit& u, int wr, int wc, int fr, int fq) const {
        int row0 = u.pm * BM + wr * 64 + fr; asm volatile("" : "+v"(row0)); const int c0 = wc * 32 + fq * 4;
        u32x2 gv[2][4][2][2];
#pragma unroll
        for (int ai = 0; ai < 2; ++ai)
#pragma unroll
            for (int m = 0; m < 4; ++m)
#pragma unroll
                for (int bj = 0; bj < 2; ++bj)
#pragma unroll
                    for (int n = 0; n < 2; ++n) gv[ai][m][bj][n] = *(const u32x2*)(gl + (size_t)(row0 + ai * HALF + m * 16) * 256 + c0 + bj * HALF + n * 16);
#pragma unroll
        for (int ai = 0; ai < 2; ++ai)
#pragma unroll
            for (int m = 0; m < 4; ++m) { const int row = row0 + ai * HALF + m * 16;
#pragma unroll
                for (int bj = 0; bj < 2; ++bj)
#pragma unroll
                    for (int n = 0; n < 2; ++n) { const int c = c0 + bj * HALF + n * 16; const u32x2 g2 = gv[ai][m][bj][n];
                        f32x4 g; g[0] = __uint_as_float(g2.x << 16); g[1] = __uint_as_float(g2.x & 0xffff0000u); g[2] = __uint_as_float(g2.y << 16); g[3] = __uint_as_float(g2.y & 0xffff0000u);
                        f32x4 o;
#pragma unroll
                        for (int i = 0; i < 4; ++i) o[i] = g[i] * fast_sigmoid(acc[ai][bj][m][n][i]);
                        *(u32x2*)(ys + (size_t)row * 1024 + c) = pack_bf16x4(o); } }
    }
};

template <class Epi, class Sched, bool ALIGN_EPI = false, bool SP2 = false>
__device__ __forceinline__ void gemm_phase(PG8_LAS unsigned char* lds, const Gemm g, const Sched& S, const Epi& E, const int tid) {
    const int wid = __builtin_amdgcn_readfirstlane(tid >> 6), lane = tid & 63, wr = wid >> 2, wc = wid & 3, fr = lane & 15, fq = lane >> 4;
    const int K = g.K, nt = K / BK / g.nseg; const size_t segb = (size_t)(K / g.nseg) * 2;
    unsigned voffA[2], voffB[2];
#pragma unroll
    for (int i = 0; i < 2; ++i) { int R, C; stage_rc(tid * 16 + i * 8192, R, C); const int Rb = Epi::PERM ? ((R & ~31) + perm32(R & 31)) : R;
        voffA[i] = (unsigned)(R * K + C) * 2u; voffB[i] = (unsigned)(Rb * K + C) * 2u; }
    const size_t kstep = (size_t)(BK * 2);
    const size_t hstep = (size_t)HALF * K * 2;
    const size_t tstep = 2 * hstep;
    const unsigned ldsw = (unsigned)wid * 1024u;
    const int aoff = lds_byte(wr * 64 + fr, fq * 8), boff = lds_byte(wc * 32 + fr, fq * 8);
#define PG8_SA(b, h) (((b) * 2 + (h)) * HTB)
#define PG8_SB(b, h) ((4 + (b) * 2 + (h)) * HTB)
#define PG8_STAGE(bufoff, gbase, voff) do { _Pragma("unroll") for (int _i = 0; _i < 2; ++_i) \
        __builtin_amdgcn_global_load_lds((const unsigned*)((const char*)(gbase) + (voff)[_i]), (PG8_LAS unsigned*)(lds + (bufoff) + ldsw + _i * 8192), 16, 0, 0); } while (0)
#define PG8_LDA(dst, b, h) do { _Pragma("unroll") for (int m = 0; m < 4; ++m) _Pragma("unroll") for (int k = 0; k < 2; ++k) dst[m][k] = *(const PG8_LAS bf16x8*)(lds + PG8_SA(b, h) + aoff + m * 2048 + k * 1024); } while (0)
#define PG8_LDB(dst, b, h) do { _Pragma("unroll") for (int n = 0; n < 2; ++n) _Pragma("unroll") for (int k = 0; k < 2; ++k) dst[n][k] = *(const PG8_LAS bf16x8*)(lds + PG8_SB(b, h) + boff + n * 2048 + k * 1024); } while (0)
#define PG8_MMA(ai, bj, At, Bt) do { __builtin_amdgcn_s_setprio(1); _Pragma("unroll") for (int m = 0; m < 4; ++m) _Pragma("unroll") for (int n = 0; n < 2; ++n) _Pragma("unroll") for (int k = 0; k < 2; ++k) \
        acc[ai][bj][m][n] = __builtin_amdgcn_mfma_f32_16x16x32_bf16(Bt[n][k], At[m][k], acc[ai][bj][m][n], 0, 0, 0); __builtin_amdgcn_s_setprio(0); } while (0)
#define PG8_WAIT_V(n) asm volatile("s_waitcnt vmcnt(" #n ")" ::: "memory")
#define PG8_WAIT_L(n) asm volatile("s_waitcnt lgkmcnt(" #n ")" ::: "memory")
#define PG8_BAR __builtin_amdgcn_s_barrier()
#define PG8_SCHED __builtin_amdgcn_sched_barrier(0)
    Unit cur, nxt; int ui = 0;
    if (!S.next(0, cur)) return;
    f32x4 acc[2][2][4][2];
#pragma unroll
    for (int a = 0; a < 2; ++a)
#pragma unroll
        for (int b = 0; b < 2; ++b)
#pragma unroll
            for (int m = 0; m < 4; ++m)
#pragma unroll
                for (int n = 0; n < 2; ++n) acc[a][b][m][n] = (f32x4){0.f, 0.f, 0.f, 0.f};
    bf16x8 At[4][2], B0[2][2], B1[2][2];
    const char* cA = (const char*)g.A + (size_t)cur.pm * tstep + (size_t)cur.g * segb; const char* cB = (const char*)g.Bt + (size_t)cur.pn * tstep + (size_t)cur.g * segb;
    S.a_ready(cur);
    if constexpr (SP2) {
        PG8_STAGE(PG8_SB(0, 0), cB, voffB); PG8_STAGE(PG8_SB(0, 1), cB + hstep, voffB); PG8_STAGE(PG8_SA(0, 0), cA, voffA); PG8_STAGE(PG8_SA(0, 1), cA + hstep, voffA);
        if (wr == 1) PG8_BAR;
        PG8_WAIT_V(2); PG8_BAR;
        PG8_STAGE(PG8_SB(1, 0), cB + kstep, voffB); PG8_STAGE(PG8_SA(1, 0), cA + kstep, voffA); PG8_STAGE(PG8_SB(1, 1), cB + hstep + kstep, voffB);
        PG8_WAIT_V(6); PG8_BAR;
    } else {
        PG8_STAGE(PG8_SB(0, 0), cB, voffB); PG8_STAGE(PG8_SA(0, 0), cA, voffA); PG8_STAGE(PG8_SB(0, 1), cB + hstep, voffB); PG8_STAGE(PG8_SA(0, 1), cA + hstep, voffA);
        if (wr == 1) PG8_BAR;
        PG8_WAIT_V(4); PG8_BAR;
        PG8_STAGE(PG8_SB(1, 0), cB + kstep, voffB); PG8_STAGE(PG8_SA(1, 0), cA + kstep, voffA); PG8_STAGE(PG8_SB(1, 1), cB + hstep + kstep, voffB);
        PG8_WAIT_V(6); PG8_BAR;
    }
    for (;;) {
        const bool has_next = S.next(ui + 1, nxt);
        const char* nA = has_next ? (const char*)g.A + (size_t)nxt.pm * tstep + (size_t)nxt.g * segb : cA; const char* nB = has_next ? (const char*)g.Bt + (size_t)nxt.pn * tstep + (size_t)nxt.g * segb : cB;
        for (int t = 0; t < nt; t += 2) {
            const bool last = (t == nt - 2);
            const char* a1 = cA + (size_t)(t + 1) * kstep;
            const char* a2 = last ? nA : cA + (size_t)(t + 2) * kstep; const char* b2 = last ? nB : cB + (size_t)(t + 2) * kstep;
            const char* a3 = a2 + kstep; const char* b3 = b2 + kstep;
            if (last && has_next) S.a_ready(nxt);
            if constexpr (SP2) {
            PG8_LDB(B0, 0, 0); PG8_LDB(B1, 0, 1); PG8_SCHED; PG8_LDA(At, 0, 0); PG8_STAGE(PG8_SA(1, 1), a1 + hstep, voffA);
            PG8_WAIT_V(8); PG8_WAIT_L(0); PG8_BAR; PG8_MMA(0, 0, At, B0); PG8_MMA(0, 1, At, B1); PG8_BAR; PG8_SCHED;
            PG8_LDA(At, 0, 1); PG8_STAGE(PG8_SB(0, 0), b2, voffB); PG8_STAGE(PG8_SB(0, 1), b2 + hstep, voffB); PG8_STAGE(PG8_SA(0, 0), a2, voffA);
            PG8_WAIT_V(8); PG8_WAIT_L(0); PG8_BAR; PG8_MMA(1, 0, At, B0); PG8_MMA(1, 1, At, B1); PG8_BAR; PG8_SCHED;
            PG8_LDB(B0, 1, 0); PG8_LDB(B1, 1, 1); PG8_SCHED; PG8_LDA(At, 1, 0); PG8_STAGE(PG8_SA(0, 1), a2 + hstep, voffA);
            PG8_WAIT_V(8); PG8_WAIT_L(0); PG8_BAR; PG8_MMA(0, 0, At, B0); PG8_MMA(0, 1, At, B1); PG8_BAR; PG8_SCHED;
            PG8_LDA(At, 1, 1); PG8_STAGE(PG8_SB(1, 0), b3, voffB); PG8_STAGE(PG8_SB(1, 1), b3 + hstep, voffB); PG8_STAGE(PG8_SA(1, 0), a3, voffA);
            PG8_WAIT_V(8); PG8_WAIT_L(0); PG8_BAR; PG8_MMA(1, 0, At, B0); PG8_MMA(1, 1, At, B1); PG8_BAR; PG8_SCHED;
            } else {
            PG8_LDB(B0, 0, 0); PG8_SCHED; PG8_LDA(At, 0, 0); PG8_STAGE(PG8_SA(1, 1), a1 + hstep, voffA);
            PG8_WAIT_L(8); PG8_BAR; PG8_WAIT_L(0); PG8_MMA(0, 0, At, B0); PG8_BAR; PG8_SCHED;
            PG8_LDB(B1, 0, 1); PG8_STAGE(PG8_SB(0, 0), b2, voffB);
            PG8_BAR; PG8_WAIT_L(0); PG8_MMA(0, 1, At, B1); PG8_BAR;
            PG8_LDA(At, 0, 1); PG8_STAGE(PG8_SA(0, 0), a2, voffA);
            PG8_BAR; PG8_WAIT_L(0); PG8_MMA(1, 0, At, B0); PG8_BAR; PG8_SCHED;
            PG8_STAGE(PG8_SB(0, 1), b2 + hstep, voffB);
            PG8_WAIT_V(6); PG8_BAR; PG8_MMA(1, 1, At, B1); PG8_BAR;
            PG8_LDB(B0, 1, 0); PG8_SCHED; PG8_LDA(At, 1, 0); PG8_STAGE(PG8_SA(0, 1), a2 + hstep, voffA);
            PG8_WAIT_L(8); PG8_BAR; PG8_WAIT_L(0); PG8_MMA(0, 0, At, B0); PG8_BAR; PG8_SCHED;
            PG8_LDB(B1, 1, 1); PG8_STAGE(PG8_SB(1, 0), b3, voffB);
            PG8_BAR; PG8_WAIT_L(0); PG8_MMA(0, 1, At, B1); PG8_BAR;
            PG8_LDA(At, 1, 1); PG8_STAGE(PG8_SA(1, 0), a3, voffA);
            PG8_BAR; PG8_WAIT_L(0); PG8_MMA(1, 0, At, B0); PG8_BAR; PG8_SCHED;
            PG8_STAGE(PG8_SB(1, 1), b3 + hstep, voffB);
            PG8_WAIT_V(6); PG8_BAR; PG8_MMA(1, 1, At, B1); PG8_BAR;
            }
        }
        if constexpr (ALIGN_EPI) { if (wr == 0) PG8_BAR; }
        E(acc, cur, wr, wc, fr, fq); S.done(cur);
        if (!has_next) break;
        if (!(Epi::KSEG && nxt.g != 0))
#pragma unroll
        for (int a = 0; a < 2; ++a)
#pragma unroll
            for (int b = 0; b < 2; ++b)
#pragma unroll
                for (int m = 0; m < 4; ++m)
#pragma unroll
                    for (int n = 0; n < 2; ++n) acc[a][b][m][n] = (f32x4){0.f, 0.f, 0.f, 0.f};
        cur = nxt; cA = nA; cB = nB; ++ui;
        if constexpr (ALIGN_EPI) { if (wr == 1) PG8_BAR; }
    }
    PG8_WAIT_V(0);
    if constexpr (!ALIGN_EPI) { if (wr == 0) PG8_BAR; }
    PG8_BAR;
#undef PG8_SA
#undef PG8_SB
#undef PG8_STAGE
#undef PG8_LDA
#undef PG8_LDB
#undef PG8_MMA
#undef PG8_WAIT_V
#undef PG8_WAIT_L
#undef PG8_BAR
#undef PG8_SCHED
}
}

#define LAS __attribute__((address_space(3)))
typedef unsigned short bf16_t;
typedef _Float16 h16;
typedef _Float16 h16x4 __attribute__((ext_vector_type(4)));
typedef _Float16 h16x8 __attribute__((ext_vector_type(8)));
typedef float f32x4 __attribute__((ext_vector_type(4)));
typedef float f32x2 __attribute__((ext_vector_type(2)));
typedef unsigned u32x4 __attribute__((ext_vector_type(4)));
typedef unsigned u32x2 __attribute__((ext_vector_type(2)));

#ifndef ONE_LAUNCH
#define ONE_LAUNCH 1
#endif
constexpr int NWAVES = 8, NTHR = 512;
constexpr int TT = 16384, SEQ = 8192, DM = 1024, FF = 2816, MW = 256, INW = 6144;
constexpr int LDS_BYTES = 147456;
constexpr size_t MiB = 1u << 20;
constexpr size_t WS_CTL = 0, CTL_ZERO_BYTES = 16384, WS_SS = 1 * MiB, WS_E = 2 * MiB, WS_W = 4 * MiB, WS_B1 = 34 * MiB, WS_B2 = 66 * MiB, WS_Z = 98 * MiB, WS_END = 262 * MiB;
constexpr size_t W_GU1 = 0, W_D1 = W_GU1 + (size_t)2 * FF * DM * 2, W_INA = W_D1 + (size_t)DM * FF * 2;
constexpr size_t W_ING = 0, W_BR = W_ING + (size_t)4096 * DM * 2, W_O = W_BR + (size_t)DM * DM * 2, W_GU2 = W_O + (size_t)DM * DM * 2, W_D2 = W_GU2 + (size_t)2 * FF * DM * 2, W_GLU = W_D2 + (size_t)DM * FF * 2, W_END2 = W_GLU + 256 * 256 * 2;
constexpr size_t W_L2 = 23 * MiB;
static_assert(W_END2 <= 30 * MiB && W_INA + (size_t)2560 * DM * 2 <= 30 * MiB, "W region");
constexpr size_t Z_RW = 0, Z_G16 = 56 * MiB, Z_U5 = 64 * MiB, Z_L16 = 72 * MiB, Z_PP = 88 * MiB, Z_O = 72 * MiB, Z_GL = 144 * MiB, Z_PB = 152 * MiB, Z_LB = 156 * MiB, Z_SB = 160 * MiB;
constexpr size_t Z_HID = 0, Z_R = 0;
static_assert((size_t)TT * 4 * 896 <= 56 * MiB && (size_t)TT * 1792 * 2 <= 56 * MiB && (size_t)TT * FF * 2 <= 144 * MiB && (size_t)TT * 4096 * 2 <= 144 * MiB, "Z region");

typedef const float* cfp_t;
typedef const __attribute__((address_space(4))) cfp_t* in_t;
struct Args { const float* in[41]; float* out; unsigned char* ws; int ph_lo, ph_hi; };

struct Frame {
    LAS unsigned char* lds;
    int tid, lane, wave, G, bx;
    in_t in;
    float* X; unsigned char* ws;
    float* SS; float* E;
    bf16_t *B1, *B2, *HID, *GL;
    h16 *U5, *PP, *L16, *G16, *R;
    float* O; unsigned char* RW;
    float *PB, *LB, *SB;
};

__device__ __forceinline__ unsigned f2bf(float f) { unsigned u = __builtin_bit_cast(unsigned, f); return (u + 0x7fffu + ((u >> 16) & 1u)) >> 16; }
__device__ __forceinline__ unsigned pk2(float lo, float hi) { return f2bf(lo) | (f2bf(hi) << 16); }
#define LDS_WAIT() asm volatile("s_waitcnt lgkmcnt(0)" ::: "memory")
template <int CTRL> __device__ __forceinline__ float dppx(float x) { return __builtin_bit_cast(float, __builtin_amdgcn_update_dpp(0, __builtin_bit_cast(int, x), CTRL, 0xf, 0xf, true)); }
__device__ __forceinline__ float allreduce16(float x) { x += dppx<0xB1>(x); x += dppx<0x4E>(x); x += dppx<0x141>(x); x += dppx<0x140>(x); return x; }
__device__ __forceinline__ float wave_sum(float x) { x = allreduce16(x); x += __shfl_xor(x, 16); x += __shfl_xor(x, 32); return x; }
__device__ __forceinline__ float sigmoidf_(float x) { return __builtin_amdgcn_rcpf(1.0f + __expf(-x)); }

__device__ __forceinline__ int tr_rowmap(int mode, int j, int row0) {
    if (mode == 0) return row0 + j;
    if (mode == 1) return (j >> 7) * 256 + (j & 127);
    if (mode == 2) return (j >> 7) * 256 + 128 + (j & 127);
    const int g = j >> 10, d = j & 1023;
    const int pn = 4 * (d >> 8) + 2 * ((d >> 7) & 1) + ((d >> 4) & 1);
    return 256 * pn + 128 * (g >> 1) + 32 * ((d >> 5) & 3) + 16 * (g & 1) + 4 * ((d >> 2) & 3) + (d & 3);
}
__device__ __forceinline__ void tr_item(const float* W, int ldw, int K, int N, bf16_t* WT, int mode, int row0, const float* s1, const float* s2, int smode, LAS float* scr, int item, int lane) {
    const int nblk = N / 32, kb = item / nblk, nb = item % nblk, k0 = 64 * kb, n0 = 32 * nb;
#pragma unroll
    for (int i = 0; i < 8; ++i) { const int kk = 8 * i + (lane >> 3); const int k = k0 + kk; float sc = 1.0f;
        if (s1) sc = s1[k];
        if (smode == 1) sc *= s2[k]; else if (smode == 2) sc *= (1.0f - s2[k]);
        const f32x4 v = *(const f32x4*)(W + (size_t)k * ldw + n0 + 4 * (lane & 7)) * sc;
        LAS float* d = scr + kk * 33 + 4 * (lane & 7); d[0] = v[0]; d[1] = v[1]; d[2] = v[2]; d[3] = v[3]; }
    LDS_WAIT(); asm volatile("" ::: "memory");
    const int c = lane & 7;
#pragma unroll
    for (int j = 0; j < 4; ++j) { const int n = (lane >> 3) + 8 * j; const LAS float* s = scr + (8 * c) * 33 + n;
        u32x4 o; o.x = pk2(s[0 * 33], s[1 * 33]); o.y = pk2(s[2 * 33], s[3 * 33]); o.z = pk2(s[4 * 33], s[5 * 33]); o.w = pk2(s[6 * 33], s[7 * 33]);
        *(u32x4*)(WT + (size_t)tr_rowmap(mode, n0 + n, row0) * K + k0 + 8 * c) = o; }
    LDS_WAIT(); asm volatile("" ::: "memory");
}
#define TRJ(W_, ldw_, K_, N_, dst_, mode_, row0_, s1_, s2_, smode_) { const int ni_ = ((K_) / 64) * ((N_) / 32); if (r >= 0 && r < ni_) tr_item(W_, ldw_, K_, N_, dst_, mode_, row0_, s1_, s2_, smode_, scr, r, F.lane); r -= ni_; }
__device__ __forceinline__ void conv_first_half(Frame& F, int l) {
    LAS float* scr = (LAS float*)(F.lds + F.wave * 16384);
    const int gw = F.bx * NWAVES + F.wave, NGW = F.G * NWAVES;
    unsigned char* wb = F.ws + WS_W;
    const float* n1 = F.in[1] + (size_t)l * DM; const float* nm = F.in[5] + (size_t)l * DM; const float* mu = F.in[19] + (size_t)l * 3 * DM;
    const float* w1 = F.in[21] + (size_t)l * DM * 64; const float* a1 = F.in[24] + (size_t)l * DM * 64; const float* g1 = F.in[26] + (size_t)l * DM * 128;
    bf16_t* ina = (bf16_t*)(wb + W_INA);
    for (int it = gw;; it += NGW) { int r = it;
        TRJ(F.in[2] + (size_t)l * DM * FF, FF, DM, FF, (bf16_t*)(wb + W_GU1), 1, 0, n1, nullptr, 0)
        TRJ(F.in[3] + (size_t)l * DM * FF, FF, DM, FF, (bf16_t*)(wb + W_GU1), 2, 0, n1, nullptr, 0)
        TRJ(F.in[4] + (size_t)l * FF * DM, DM, FF, DM, (bf16_t*)(wb + W_D1), 0, 0, nullptr, nullptr, 0)
        TRJ(F.in[6] + (size_t)l * DM * INW, INW, DM, 2048, ina, 0, 0, nm, nullptr, 0)
        TRJ(w1, 64, DM, 64, ina, 0, 2048, nm, mu, 2)
        TRJ(a1, 64, DM, 64, ina, 0, 2112, nm, mu + DM, 2)
        TRJ(g1, 128, DM, 128, ina, 0, 2176, nm, mu + 2 * DM, 2)
        TRJ(w1, 64, DM, 64, ina, 0, 2304, nm, mu, 1)
        TRJ(a1, 64, DM, 64, ina, 0, 2368, nm, mu + DM, 1)
        TRJ(g1, 128, DM, 128, ina, 0, 2432, nm, mu + 2 * DM, 1)
        TRJ(F.in[22] + (size_t)l * 64 * 256, 256, 64, 256, (bf16_t*)(wb + W_L2), 0, 0, nullptr, nullptr, 0)
        TRJ(F.in[25] + (size_t)l * 64 * 256, 256, 64, 256, (bf16_t*)(wb + W_L2) + 256 * 64, 0, 0, nullptr, nullptr, 0)
        TRJ(F.in[27] + (size_t)l * 128 * 256, 256, 128, 256, (bf16_t*)(wb + W_L2) + 2 * 256 * 64, 0, 0, nullptr, nullptr, 0)
        TRJ(F.in[16] + ((size_t)l * 4 + 0) * 4096, 64, 64, 64, (bf16_t*)(wb + W_L2) + 4 * 256 * 64, 0, 0, nullptr, nullptr, 0)
        TRJ(F.in[16] + ((size_t)l * 4 + 1) * 4096, 64, 64, 64, (bf16_t*)(wb + W_L2) + 4 * 256 * 64, 0, 64, nullptr, nullptr, 0)
        TRJ(F.in[16] + ((size_t)l * 4 + 2) * 4096, 64, 64, 64, (bf16_t*)(wb + W_L2) + 4 * 256 * 64, 0, 128, nullptr, nullptr, 0)
        TRJ(F.in[16] + ((size_t)l * 4 + 3) * 4096, 64, 64, 64, (bf16_t*)(wb + W_L2) + 4 * 256 * 64, 0, 192, nullptr, nullptr, 0)
        if (r >= 0) break; }
}
__device__ __forceinline__ void conv_second_half(Frame& F, int l, int b0) {
    LAS float* scr = (LAS float*)(F.lds + F.wave * 16384);
    const int gw = (F.bx - b0) * NWAVES + F.wave, NGW = (F.G - b0) * NWAVES;
    unsigned char* wb = F.ws + WS_W;
    const float* nm = F.in[5] + (size_t)l * DM; const float* n2 = F.in[36] + (size_t)l * DM;
    for (int it = gw;; it += NGW) { int r = it;
        TRJ(F.in[6] + (size_t)l * DM * INW + 2048, INW, DM, 4096, (bf16_t*)(wb + W_ING), 3, 0, nm, nullptr, 0)
        TRJ(F.in[34] + (size_t)l * DM * DM, DM, DM, DM, (bf16_t*)(wb + W_BR), 0, 0, nullptr, nullptr, 0)
        TRJ(F.in[35] + (size_t)l * DM * DM, DM, DM, DM, (bf16_t*)(wb + W_O), 0, 0, nullptr, nullptr, 0)
        TRJ(F.in[37] + (size_t)l * DM * FF, FF, DM, FF, (bf16_t*)(wb + W_GU2), 1, 0, n2, nullptr, 0)
        TRJ(F.in[38] + (size_t)l * DM * FF, FF, DM, FF, (bf16_t*)(wb + W_GU2), 2, 0, n2, nullptr, 0)
        TRJ(F.in[39] + (size_t)l * FF * DM, DM, FF, DM, (bf16_t*)(wb + W_D2), 0, 0, nullptr, nullptr, 0)
        TRJ(F.in[15] + (size_t)l * 256 * 256, 256, 256, 256, (bf16_t*)(wb + W_GLU), 0, 0, nullptr, nullptr, 0)
        if (r >= 0) break; }
}
__device__ __forceinline__ void prep_x(Frame& F) {
    const int gw = F.bx * NWAVES + F.wave, NGW = F.G * NWAVES;
    const float* x = F.in[0];
    for (int m = gw; m < TT; m += NGW) {
        const f32x4* xr = (const f32x4*)(x + (size_t)m * DM) + F.lane; float s = 0.f;
        unsigned long long* o8 = (unsigned long long*)(F.B1 + (size_t)m * DM) + F.lane;
#pragma unroll
        for (int j = 0; j < 4; ++j) { const f32x4 v = xr[64 * j]; s += (v[0] * v[0] + v[1] * v[1]) + (v[2] * v[2] + v[3] * v[3]);
            o8[64 * j] = (unsigned long long)pk2(v[0], v[1]) | ((unsigned long long)pk2(v[2], v[3]) << 32); }
        s += __shfl_xor(s, 1); s += __shfl_xor(s, 2);
        if ((F.lane & 3) == 0) F.SS[(size_t)m * 16 + (F.lane >> 2)] = s;
    }
}
__device__ __forceinline__ void final_norm(Frame& F) {
    const int gw = F.bx * NWAVES + F.wave, NGW = F.G * NWAVES;
    const f32x4* gn = (const f32x4*)F.in[40] + F.lane;
    for (int m = gw; m < TT; m += NGW) {
        const float rs = pg8::row_rstd(F.SS, m);
        f32x4* xr = (f32x4*)(F.X + (size_t)m * DM) + F.lane;
#pragma unroll
        for (int j = 0; j < 4; ++j) { const f32x4 v = xr[64 * j]; xr[64 * j] = v * rs * gn[64 * j]; }
    }
}

struct S5Par { float ar, ai; float bbr[16], bbi[16]; };
__device__ __forceinline__ void s5_params(Frame& F, int l, int g, int p, S5Par& P) {
    asm volatile("" : "+v"(p));
    const float lr = F.in[7][((size_t)l * 16 + g) * 64 + p], li = F.in[8][((size_t)l * 16 + g) * 64 + p], dt = expf(F.in[9][l * 16 + g]);
    const float mag = expf(lr * dt); P.ar = mag * cosf(li * dt); P.ai = mag * sinf(li * dt);
    const float inv = 1.0f / (lr * lr + li * li); const float qr = lr * inv, qi = -li * inv;
    const float cr = (P.ar - 1.0f) * qr - P.ai * qi, ci = (P.ar - 1.0f) * qi + P.ai * qr;
    const f32x4* br = (const f32x4*)(F.in[10] + (((size_t)l * 16 + g) * 64 + p) * 16); const f32x4* bi = (const f32x4*)(F.in[11] + (((size_t)l * 16 + g) * 64 + p) * 16);
#pragma unroll
    for (int q = 0; q < 4; ++q) { const f32x4 a = br[q], b = bi[q];
#pragma unroll
        for (int i = 0; i < 4; ++i) { P.bbr[4 * q + i] = cr * a[i] - ci * b[i]; P.bbi[4 * q + i] = cr * b[i] + ci * a[i]; } }
}
__device__ __forceinline__ void s5_step(const S5Par& P, const LAS float* urow, float& hr, float& hi) {
    const LAS f32x4* u4 = (const LAS f32x4*)urow; float bur = 0.f, bui = 0.f;
#pragma unroll
    for (int q = 0; q < 4; ++q) { const f32x4 u = u4[q];
#pragma unroll
        for (int i = 0; i < 4; ++i) { bur += P.bbr[4 * q + i] * u[i]; bui += P.bbi[4 * q + i] * u[i]; } }
    const float nr = P.ar * hr - P.ai * hi + bur, ni = P.ar * hi + P.ai * hr + bui; hr = nr; hi = ni;
}
__device__ __forceinline__ void load_u5_tile(Frame& F, int t0, LAS float* ubuf) {
    for (int i = F.tid; i < 64 * 64; i += NTHR) { const int t = i >> 6, q = i & 63; const h16x4 v = *(const h16x4*)(F.U5 + (size_t)(t0 + t) * 256 + 4 * q);
        f32x4 f; f[0] = (float)v[0]; f[1] = (float)v[1]; f[2] = (float)v[2]; f[3] = (float)v[3]; *(LAS f32x4*)(ubuf + t * 256 + 4 * q) = f; }
}


template <bool FIRST> __device__ __forceinline__ void mv32(LAS float* accp, float init, const LAS float* hb, const float* wsrc, int ldw) {
    float w[32];
    asm volatile("" : "+v"(wsrc));
#pragma unroll
    for (int j = 0; j < 32; ++j) w[j] = wsrc[(size_t)j * ldw];
#pragma unroll 2
    for (int tt = 0; tt < 32; ++tt) { const LAS f32x4* h4 = (const LAS f32x4*)(hb + tt * 256); float a = FIRST ? init : accp[tt * 256];
#pragma unroll
        for (int q = 0; q < 8; ++q) { const f32x4 v = h4[q]; a += v[0] * w[4 * q] + v[1] * w[4 * q + 1] + v[2] * w[4 * q + 2] + v[3] * w[4 * q + 3]; }
        accp[tt * 256] = a; }
}
template <int K> __device__ __forceinline__ void lora_mfma(const LAS unsigned short* hb16, int kofs, const bf16_t* Wt, LAS float* outb, int wave, int lane) {
    typedef short bf16x8_t __attribute__((ext_vector_type(8)));
    const int r16 = lane & 15, quad = lane >> 4;
    f32x4 acc[4][2];
#pragma unroll
    for (int rt = 0; rt < 4; ++rt)
#pragma unroll
        for (int ct = 0; ct < 2; ++ct) acc[rt][ct] = (f32x4){0.f, 0.f, 0.f, 0.f};
    bf16x8_t bfr[K / 32][2];
#pragma unroll
    for (int ks = 0; ks < K / 32; ++ks)
#pragma unroll
        for (int ct = 0; ct < 2; ++ct) bfr[ks][ct] = *(const bf16x8_t*)(Wt + (size_t)(wave * 32 + ct * 16 + r16) * K + ks * 32 + quad * 8);
#pragma unroll
    for (int ks = 0; ks < K / 32; ++ks)
#pragma unroll
        for (int rt = 0; rt < 4; ++rt) { const bf16x8_t a = *(const LAS bf16x8_t*)(hb16 + (rt * 16 + r16) * 264 + kofs + ks * 32 + quad * 8);
#pragma unroll
            for (int ct = 0; ct < 2; ++ct) acc[rt][ct] = __builtin_amdgcn_mfma_f32_16x16x32_bf16(a, bfr[ks][ct], acc[rt][ct], 0, 0, 0); }
#pragma unroll
    for (int rt = 0; rt < 4; ++rt)
#pragma unroll
        for (int ct = 0; ct < 2; ++ct)
#pragma unroll
            for (int j = 0; j < 4; ++j) outb[(rt * 16 + quad * 4 + j) * 256 + wave * 32 + ct * 16 + r16] = acc[rt][ct][j];
}
__device__ __forceinline__ void m1_phase(Frame& F, int l) {
    LAS float* ubuf = (LAS float*)F.lds;
    LAS float* pl = (LAS float*)(F.lds + 65536);
    const int tid = F.tid, lane = F.lane, wave = F.wave;
    const int ch = tid & 255, half = tid >> 8;
    for (int c = F.bx; c < TT / 64; c += F.G) {
        const int t0 = c * 64, tb = t0 + half * 32, sb = tb & (SEQ - 1);
        load_u5_tile(F, t0, ubuf);
        __syncthreads();
#pragma unroll 1
        for (int gi = 0; gi < 2; ++gi) { const int g = wave + 8 * gi; S5Par P; s5_params(F, l, g, lane, P); float hr = 0.f, hi = 0.f;
#pragma unroll 2
            for (int j = 0; j < 64; ++j) s5_step(P, ubuf + j * 256 + g * 16, hr, hi);
            *(f32x2*)(F.E + (((size_t)c * 16 + g) * 64 + lane) * 2) = (f32x2){hr, hi}; }
        __syncthreads();
        LAS float* accp = pl + half * 32 * 256 + ch;
        LAS unsigned short* hb16 = (LAS unsigned short*)F.lds;
        const bf16_t* l2w = (const bf16_t*)(F.ws + WS_W + W_L2);
        h16 la[32], lb[32];
#pragma unroll
        for (int tt = 0; tt < 32; ++tt) { const int t = tb + tt; la[tt] = F.L16[(size_t)t * 512 + ch]; lb[tt] = (sb + tt > 0) ? F.L16[(size_t)(t - 1) * 512 + 256 + ch] : (h16)0.f; }
#pragma unroll
        for (int tt = 0; tt < 32; ++tt) { float pre = (float)la[tt] + (float)lb[tt];
            float a = pre; if (ch < 64) a = 1.0f - 2.0f * __builtin_amdgcn_rcpf(1.0f + __expf(2.0f * pre)); else if (ch >= 128) a = sigmoidf_(pre);
            hb16[(half * 32 + tt) * 264 + ch] = (unsigned short)f2bf(a); }
        __syncthreads();
        const int hb = (t0 / SEQ) * 4 + (ch >> 6);
        unsigned char* rwb = F.RW + ((size_t)hb * SEQ + sb) * 896;
        const int cl = ch & 63;
        {
            lora_mfma<64>(hb16, 0, l2w, pl, wave, lane);
            __syncthreads();
            const float w0 = F.in[20][(size_t)l * 256 + ch];
#pragma unroll 2
            for (int tt = 0; tt < 32; ++tt) { const float z = -(accp[tt * 256] + w0); const float sp = fmaxf(z, 0.f) + __logf(1.0f + __expf(-fabsf(z)));
                const float wlog = -sp - 0.5f; const float dec = __expf(-__expf(wlog));
                *(float*)(rwb + (size_t)tt * 896 + cl * 4) = dec; }
        }
        {
            __syncthreads();
            lora_mfma<128>(hb16, 128, l2w + 2 * 256 * 64, pl, wave, lane);
            __syncthreads();
#pragma unroll 4
            for (int tt = 0; tt < 32; ++tt) F.G16[(size_t)(tb + tt) * 256 + ch] = (h16)accp[tt * 256];
        }
        {
            __syncthreads();
            lora_mfma<64>(hb16, 64, l2w + 256 * 64, pl, wave, lane);
            __syncthreads();
            const float a0 = F.in[23][(size_t)l * 256 + ch];
            const float mur = F.in[18][((size_t)l * 3 + 0) * 256 + ch], muk = F.in[18][((size_t)l * 3 + 1) * 256 + ch], muv = F.in[18][((size_t)l * 3 + 2) * 256 + ch];
            const float kkw = F.in[28][(size_t)l * 256 + ch], kaw = F.in[29][(size_t)l * 256 + ch];
            const h16* pp = F.PP + (size_t)tb * 1792 + 256 + ch;
            float rprev = 0.f, kprev = 0.f, vprev = 0.f;
            if (sb > 0) { rprev = (float)pp[-(ptrdiff_t)1792]; kprev = (float)pp[-(ptrdiff_t)1792 + 256]; vprev = (float)pp[-(ptrdiff_t)1792 + 512]; }
#pragma unroll 1
            for (int t16 = 0; t16 < 32; t16 += 16) {
                h16 rq[16], kq[16], vq[16];
#pragma unroll
                for (int tt = 0; tt < 16; ++tt) { const h16* q = pp + (size_t)(t16 + tt) * 1792; rq[tt] = q[0]; kq[tt] = q[256]; vq[tt] = q[512]; }
#pragma unroll
                for (int tt = 0; tt < 16; ++tt) { const float a = sigmoidf_(accp[(t16 + tt) * 256] + a0);
                    const float rp = (float)rq[tt], kp = (float)kq[tt], vp = (float)vq[tt];
                    const float r = rp + (rprev - rp) * mur, k = kp + (kprev - kp) * muk, v = vp + (vprev - vp) * muv;
                    rprev = rp; kprev = kp; vprev = vp;
                    const float kkv = k * kkw; const float kk = kkv * rsqrtf(fmaxf(wave_sum(kkv * kkv), 1e-24f));
                    const float kt = k * (1.0f + (a - 1.0f) * kaw); const float bb = kk * a;
                    h16* o = (h16*)(rwb + (size_t)(t16 + tt) * 896 + 256) + cl;
                    o[0] = (h16)r; o[64] = (h16)kt; o[128] = (h16)v; o[192] = (h16)kk; o[256] = (h16)bb; } }
        }
        __syncthreads();
    }
}

__device__ __forceinline__ void pool_conv_chunk(Frame& F, int l, int c) {
    LAS float* ubuf = (LAS float*)F.lds;
    LAS unsigned short* pb16 = (LAS unsigned short*)(F.lds + 65536);
    const int tid = F.tid; const int ch = tid & 255, half = tid >> 8;
    const int t0 = c * 64, tb = t0 + half * 32, sb = tb & (SEQ - 1);
    {
    {
        const int grp = ch >> 6, win = 2 << grp;
        const h16* up = F.PP + (size_t)tb * 1792 + ch;
        float s = 0.f;
        for (int j = 1; j <= win; ++j) if (sb - j >= 0) s += (float)up[-(ptrdiff_t)j * 1792];
#pragma unroll 1
        for (int t16 = 0; t16 < 32; t16 += 16) {
            h16 uq[16], ul[16];
#pragma unroll
            for (int tt = 0; tt < 16; ++tt) { uq[tt] = up[(size_t)(t16 + tt) * 1792]; ul[tt] = (sb + t16 + tt - win >= 0) ? up[(ptrdiff_t)(t16 + tt - win) * 1792] : (h16)0.f; }
#pragma unroll
            for (int tt = 0; tt < 16; ++tt) { const float u = (float)uq[tt]; s += u; const int pos = sb + t16 + tt;
                s -= (float)ul[tt];
                const float cnt = (float)((pos + 1 < win) ? (pos + 1) : win);
                pb16[(half * 32 + t16 + tt) * 264 + ch] = (unsigned short)f2bf(s / cnt - u); } }
    }
    {
        const h16* zp = F.PP + (size_t)tb * 1792 + 1024 + ch;
        const float cw0 = F.in[33][((size_t)l * 3 + 0) * 256 + ch], cw1 = F.in[33][((size_t)l * 3 + 1) * 256 + ch], cw2 = F.in[33][((size_t)l * 3 + 2) * 256 + ch];
        float z2 = 0.f, z1 = 0.f;
        if (sb >= 1) z1 = (float)zp[-(ptrdiff_t)1792 + 512] * (float)zp[-(ptrdiff_t)1792];
        if (sb >= 2) z2 = (float)zp[-(ptrdiff_t)2 * 1792 + 512] * (float)zp[-(ptrdiff_t)2 * 1792];
#pragma unroll 1
        for (int t16 = 0; t16 < 32; t16 += 16) {
            h16 zx[16], zb[16], zc[16];
#pragma unroll
            for (int tt = 0; tt < 16; ++tt) { const h16* q = zp + (size_t)(t16 + tt) * 1792; zx[tt] = q[0]; zb[tt] = q[256]; zc[tt] = q[512]; }
#pragma unroll
            for (int tt = 0; tt < 16; ++tt) { const float z0 = (float)zc[tt] * (float)zx[tt];
                const float y = (float)zb[tt] * (cw0 * z2 + cw1 * z1 + cw2 * z0);
                F.B2[(size_t)(tb + t16 + tt) * 1024 + 768 + ch] = (bf16_t)f2bf(y); z2 = z1; z1 = z0; } }
    }
    __syncthreads();
    LAS float* accu = ubuf + half * 32 * 256 + ch;
    {
        lora_mfma<64>(pb16, (F.wave >> 1) * 64, (const bf16_t*)(F.ws + WS_W + W_L2) + 4 * 256 * 64, ubuf, F.wave, F.lane);
        __syncthreads();
        const float sc = F.in[17][(size_t)l * 256 + ch];
#pragma unroll 4
        for (int tt = 0; tt < 32; ++tt) F.B2[(size_t)(tb + tt) * 1024 + 256 + ch] = (bf16_t)f2bf(accu[tt * 256] * sc);
    }
    __syncthreads();
    }
}

#define XB_TMO      128
#define XB_XCNT(j)  (256  + 64 * (j))
#define XB_XSUB(j)  (1280 + 64 * (j))
#define XB_XGEN(j)  (2304 + 64 * (j))
#define XB_TOP      3328
#define XB_TOPGEN   3392
#define XCD_BAR_WORDS 3456
#define XB_SPIN_CAP (1u << 18)

__device__ __forceinline__ unsigned xb_ld(unsigned* p)              { return __hip_atomic_load(p, __ATOMIC_RELAXED, __HIP_MEMORY_SCOPE_AGENT); }
__device__ __forceinline__ unsigned xb_add(unsigned* p, unsigned v) { return __hip_atomic_fetch_add(p, v, __ATOMIC_RELAXED, __HIP_MEMORY_SCOPE_AGENT); }
__device__ __forceinline__ unsigned xb_xcc_id() { return (unsigned)__builtin_amdgcn_s_getreg((3 << 11) | 20) & 0xFu; }
#define XB_SPIN(cond, bar) do { unsigned _sp = 0; while (cond) { __builtin_amdgcn_s_sleep(1); \
    if ((++_sp & 255u) == 0u) { if (xb_ld(&(bar)[XB_TMO])) break; if (_sp > XB_SPIN_CAP) { atomicAdd(&(bar)[XB_TMO], 1u); break; } } } } while (0)

struct XcdBarrier {
    unsigned* bar; unsigned x;
    volatile LAS unsigned* st;
};

__device__ __forceinline__ XcdBarrier xcd_barrier_post(unsigned* bar, volatile LAS unsigned* st) {
    XcdBarrier b; b.bar = bar; b.x = xb_xcc_id(); b.st = st;
    if (threadIdx.x == 0) (void)xb_add(&bar[XB_XCNT(b.x)], 1u);
    return b;
}
__device__ __forceinline__ void xcd_barrier_complete(unsigned* bar, unsigned x, unsigned& nloc, unsigned& nx) {
    const unsigned G = gridDim.x * gridDim.y * gridDim.z;
    unsigned sum, cnt, mine, sp = 0u;
    for (;;) {
        sum = 0u; cnt = 0u; mine = 0u;
#pragma unroll
        for (unsigned j = 0; j < 16; ++j) { const unsigned c = xb_ld(&bar[XB_XCNT(j)]); sum += c; cnt += (c > 0u) ? 1u : 0u; mine = (j == x) ? c : mine; }
        if (sum == G) break;
        __builtin_amdgcn_s_sleep(1);
        if ((++sp & 255u) == 0u) { if (xb_ld(&bar[XB_TMO])) break; if (sp > XB_SPIN_CAP) { atomicAdd(&bar[XB_TMO], 1u); break; } }
    }
    nloc = mine > 0u ? mine : 1u; nx = cnt > 0u ? cnt : 1u;
}

__device__ __forceinline__ void xcd_barrier(const XcdBarrier& b) {
    asm volatile("s_waitcnt vmcnt(0)" ::: "memory");
    __syncthreads();
    if (threadIdx.x == 0) {
        unsigned* bar = b.bar;
        __builtin_amdgcn_s_waitcnt(0);
        unsigned nloc = b.st[0], nx = b.st[1];
        if (nloc == 0u) { xcd_barrier_complete(bar, b.x, nloc, nx); b.st[0] = nloc; b.st[1] = nx; }
        const unsigned old = xb_add(&bar[XB_XSUB(b.x)], 1u);
        const unsigned gen = old / nloc;
        if (old + 1u == (gen + 1u) * nloc) {
            __builtin_amdgcn_fence(__ATOMIC_RELEASE, "agent");
            asm volatile("s_waitcnt vmcnt(0)" ::: "memory");
            const unsigned og = xb_add(&bar[XB_TOP], 1u);
            const unsigned tg = og / nx;
            if (og + 1u == (tg + 1u) * nx) xb_add(&bar[XB_TOPGEN], 1u);
            else XB_SPIN(xb_ld(&bar[XB_TOPGEN]) == tg, bar);
            __builtin_amdgcn_fence(__ATOMIC_ACQUIRE, "agent");
            xb_add(&bar[XB_XGEN(b.x)], 1u);
            asm volatile("s_waitcnt vmcnt(0)" ::: "memory");
        } else {
            XB_SPIN(xb_ld(&bar[XB_XGEN(b.x)]) == gen, bar);
            __builtin_amdgcn_fence(__ATOMIC_ACQUIRE, "agent");
            asm volatile("s_waitcnt vmcnt(0)" ::: "memory");
        }
    }
    __syncthreads();
}

__device__ __forceinline__ float a_fma(float a, float b, float c) { float d; asm("v_fma_f32 %0, %1, %2, %3" : "=v"(d) : "v"(a), "v"(b), "v"(c)); return d; }
__device__ __forceinline__ float a_fnma(float a, float b, float c) { float d; asm("v_fma_f32 %0, -%1, %2, %3" : "=v"(d) : "v"(a), "v"(b), "v"(c)); return d; }
__device__ __forceinline__ float a_mul(float a, float b) { float d; asm("v_mul_f32 %0, %1, %2" : "=v"(d) : "v"(a), "v"(b)); return d; }
__device__ __forceinline__ float a_add(float a, float b) { float d; asm("v_add_f32 %0, %1, %2" : "=v"(d) : "v"(a), "v"(b)); return d; }
constexpr int RC_LEN = 256, RC_N = SEQ / RC_LEN;
constexpr int ST_STEPS = 16, ST_FL = ST_STEPS * 384, ST_NPC = ST_STEPS * 56, ST_OB = ST_STEPS * 32 * 16, ST_NSUB = RC_LEN / ST_STEPS;
__device__ __forceinline__ void st_load(const unsigned char* src, int sub, int tid, u32x4 (&rg)[2]) {
#pragma unroll
    for (int n = 0; n < 2; ++n) { const int i = tid + NTHR * n; if (i < ST_NPC) { const int step = i / 56, j = i % 56;
        rg[n] = *(const u32x4*)(src + ((size_t)sub * ST_STEPS + step) * 896 + (j < 16 ? j * 16 : 256 + (j - 16) * 16)); } }
}
__device__ __forceinline__ void st_store(LAS float* buf, int tid, const u32x4 (&rg)[2]) {
#pragma unroll
    for (int n = 0; n < 2; ++n) { const int i = tid + NTHR * n; if (i < ST_NPC) { const int step = i / 56, j = i % 56;
        if (j < 16) { *(LAS u32x4*)(buf + step * 384 + j * 4) = rg[n]; }
        else { const int a = (j - 16) >> 3, e = (j - 16) & 7; const h16x8 h = __builtin_bit_cast(h16x8, rg[n]); f32x4 lo, hi;
            lo[0] = (float)h[0]; lo[1] = (float)h[1]; lo[2] = (float)h[2]; lo[3] = (float)h[3]; hi[0] = (float)h[4]; hi[1] = (float)h[5]; hi[2] = (float)h[6]; hi[3] = (float)h[7];
            LAS f32x4* d = (LAS f32x4*)(buf + step * 384 + 64 + a * 64 + e * 8); d[0] = lo; d[1] = hi; } } }
}
#define RAW_BAR() do { asm volatile("s_waitcnt lgkmcnt(0)" ::: "memory"); __builtin_amdgcn_s_barrier(); asm volatile("" ::: "memory"); } while (0)
#define DPP_ADD(x_, ctl_) "v_add_f32_dpp %[" x_ "], %[" x_ "], %[" x_ "] " ctl_ " row_mask:0xf bank_mask:0xf bound_ctrl:1\n\t"
template <bool OUT> __device__ __forceinline__ void scan_task(Frame& F, const unsigned char* src, const float* initS, bool ident, bool use_v, float* endS, float* Og) {
    constexpr int STS = OUT ? 8 : 16, NSUB = RC_LEN / STS, FL = STS * 384, NPC = STS * 56, PT = (NPC + NTHR - 1) / NTHR, OB = STS * 64 * 16;
    LAS float* buf = (LAS float*)F.lds;
    LAS float* obuf = (LAS float*)(F.lds + 2 * FL * 4);
    const int tid = F.tid, wave = F.wave, lane = F.lane, ks = lane & 15;
    int rowr[2]; float S[2][4];
#pragma unroll
    for (int r = 0; r < 2; ++r) { rowr[r] = (wave * 2 + r) * 4 + (lane >> 4);
        if (initS) { const f32x4 i4 = *(const f32x4*)(initS + (size_t)rowr[r] * 64 + 4 * ks); S[r][0] = i4[0]; S[r][1] = i4[1]; S[r][2] = i4[2]; S[r][3] = i4[3]; }
        else {
#pragma unroll
            for (int e = 0; e < 4; ++e) S[r][e] = (ident && 4 * ks + e == rowr[r]) ? 1.f : 0.f; } }
    u32x4 rg[2][PT];
#define ST_LOAD(sub_, rg_) do { _Pragma("unroll") for (int n_ = 0; n_ < PT; ++n_) { const int i_ = tid + NTHR * n_; if (i_ < NPC) { const int step_ = i_ / 56, j_ = i_ % 56; \
        rg_[n_] = *(const u32x4*)(src + ((size_t)(sub_) * STS + step_) * 896 + (j_ < 16 ? j_ * 16 : 256 + (j_ - 16) * 16)); } } } while (0)
#define ST_STORE(buf_, rg_) do { _Pragma("unroll") for (int n_ = 0; n_ < PT; ++n_) { const int i_ = tid + NTHR * n_; if (i_ < NPC) { const int step_ = i_ / 56, j_ = i_ % 56; \
        if (j_ < 16) { *(LAS u32x4*)((buf_) + step_ * 384 + j_ * 4) = rg_[n_]; } \
        else { const int a_ = (j_ - 16) >> 3, e_ = (j_ - 16) & 7; const h16x8 h_ = __builtin_bit_cast(h16x8, rg_[n_]); f32x4 lo_, hi_; \
            lo_[0] = (float)h_[0]; lo_[1] = (float)h_[1]; lo_[2] = (float)h_[2]; lo_[3] = (float)h_[3]; hi_[0] = (float)h_[4]; hi_[1] = (float)h_[5]; hi_[2] = (float)h_[6]; hi_[3] = (float)h_[7]; \
            LAS f32x4* d_ = (LAS f32x4*)((buf_) + step_ * 384 + 64 + a_ * 64 + e_ * 8); d_[0] = lo_; d_[1] = hi_; } } } } while (0)
    ST_LOAD(0, rg[0]); ST_STORE(buf, rg[0]); ST_LOAD(1, rg[1]); ST_LOAD(2, rg[0]);
    RAW_BAR();
#pragma unroll 1
    for (int sc2 = 0; sc2 < NSUB; sc2 += 2) {
#pragma unroll
      for (int u = 0; u < 2; ++u) { const int sc = sc2 + u;
        if (sc + 1 < NSUB) { ST_STORE(buf + ((sc + 1) & 1) * FL, rg[(u + 1) & 1]); if (sc + 3 < NSUB) ST_LOAD(sc + 3, rg[(u + 1) & 1]); }
        {
            const LAS float* bb = buf + (sc & 1) * FL + 4 * ks; const LAS float* vb0 = buf + (sc & 1) * FL + 192 + rowr[0]; const LAS float* vb1 = buf + (sc & 1) * FL + 192 + rowr[1];
            LAS float* ob0 = obuf + (sc & 1) * OB + rowr[0] * 16 + ks; LAS float* ob1 = obuf + (sc & 1) * OB + rowr[1] * 16 + ks;
            f32x4 w_[2], r_[2], k_[2], kk_[2], b_[2]; float v_[2][2];
#define SC_LD(s_, j_) do { const LAS float* p_ = bb + (s_) * 384; w_[j_] = *(const LAS f32x4*)(p_); if (OUT) r_[j_] = *(const LAS f32x4*)(p_ + 64); k_[j_] = *(const LAS f32x4*)(p_ + 128); \
                kk_[j_] = *(const LAS f32x4*)(p_ + 256); b_[j_] = *(const LAS f32x4*)(p_ + 320); v_[j_][0] = vb0[(s_) * 384]; v_[j_][1] = vb1[(s_) * 384]; } while (0)
            SC_LD(0, 0);
#pragma unroll
            for (int s = 0; s < STS; ++s) { const int j = s & 1;
                f32x4 rp; if (OUT) rp = r_[j ^ 1];
                if (s + 1 < STS) SC_LD(s + 1, j ^ 1);
                const f32x4 w = w_[j], k = k_[j], kk = kk_[j], bv = b_[j];
#pragma unroll
                for (int r = 0; r < 2; ++r) { const float v = use_v ? v_[j][r] : 0.f;
                    float sa, op, u0, u1, u2, u3;
                    if (OUT && s > 0) {
                        asm volatile(
                            "v_mul_f32 %[sa], %[Sa], %[kk0]\n\t" "v_fma_f32 %[sa], %[Sb], %[kk1], %[sa]\n\t" "v_fma_f32 %[sa], %[Sc], %[kk2], %[sa]\n\t" "v_fma_f32 %[sa], %[Sd], %[kk3], %[sa]\n\t"
                            "v_mul_f32 %[op], %[Sa], %[r0]\n\t" "v_fma_f32 %[op], %[Sb], %[r1], %[op]\n\t"
                            DPP_ADD("sa", "quad_perm:[1,0,3,2]") "v_fma_f32 %[op], %[Sc], %[r2], %[op]\n\t" "v_fma_f32 %[op], %[Sd], %[r3], %[op]\n\t"
                            DPP_ADD("sa", "quad_perm:[2,3,0,1]") "v_mul_f32 %[u0], %[v], %[k0]\n\t" "v_mul_f32 %[u1], %[v], %[k1]\n\t"
                            DPP_ADD("sa", "row_half_mirror") "v_mul_f32 %[u2], %[v], %[k2]\n\t" "v_mul_f32 %[u3], %[v], %[k3]\n\t"
                            DPP_ADD("sa", "row_mirror")
                            : [sa] "=&v"(sa), [op] "=&v"(op), [u0] "=&v"(u0), [u1] "=&v"(u1), [u2] "=&v"(u2), [u3] "=&v"(u3)
                            : [Sa] "v"(S[r][0]), [Sb] "v"(S[r][1]), [Sc] "v"(S[r][2]), [Sd] "v"(S[r][3]), [kk0] "v"(kk[0]), [kk1] "v"(kk[1]), [kk2] "v"(kk[2]), [kk3] "v"(kk[3]),
                              [r0] "v"(rp[0]), [r1] "v"(rp[1]), [r2] "v"(rp[2]), [r3] "v"(rp[3]), [v] "v"(v), [k0] "v"(k[0]), [k1] "v"(k[1]), [k2] "v"(k[2]), [k3] "v"(k[3]));
                        (r == 0 ? ob0 : ob1)[(s - 1) * 1024] = op;
                    } else {
                        asm volatile(
                            "v_mul_f32 %[sa], %[Sa], %[kk0]\n\t" "v_fma_f32 %[sa], %[Sb], %[kk1], %[sa]\n\t" "v_fma_f32 %[sa], %[Sc], %[kk2], %[sa]\n\t" "v_fma_f32 %[sa], %[Sd], %[kk3], %[sa]\n\t"
                            "v_mul_f32 %[u0], %[v], %[k0]\n\t" "v_mul_f32 %[u1], %[v], %[k1]\n\t"
                            DPP_ADD("sa", "quad_perm:[1,0,3,2]") "v_mul_f32 %[u2], %[v], %[k2]\n\t" "v_mul_f32 %[u3], %[v], %[k3]\n\t"
                            DPP_ADD("sa", "quad_perm:[2,3,0,1]") "s_nop 1\n\t"
                            DPP_ADD("sa", "row_half_mirror") "s_nop 1\n\t"
                            DPP_ADD("sa", "row_mirror")
                            : [sa] "=&v"(sa), [u0] "=&v"(u0), [u1] "=&v"(u1), [u2] "=&v"(u2), [u3] "=&v"(u3)
                            : [Sa] "v"(S[r][0]), [Sb] "v"(S[r][1]), [Sc] "v"(S[r][2]), [Sd] "v"(S[r][3]), [kk0] "v"(kk[0]), [kk1] "v"(kk[1]), [kk2] "v"(kk[2]), [kk3] "v"(kk[3]),
                              [v] "v"(v), [k0] "v"(k[0]), [k1] "v"(k[1]), [k2] "v"(k[2]), [k3] "v"(k[3]));
                    }
                    asm volatile(
                        "v_fma_f32 %[u0], -%[sa], %[b0], %[u0]\n\t" "v_fma_f32 %[u1], -%[sa], %[b1], %[u1]\n\t" "v_fma_f32 %[u2], -%[sa], %[b2], %[u2]\n\t" "v_fma_f32 %[u3], -%[sa], %[b3], %[u3]\n\t"
                        "v_fma_f32 %[Sa], %[Sa], %[w0], %[u0]\n\t" "v_fma_f32 %[Sb], %[Sb], %[w1], %[u1]\n\t" "v_fma_f32 %[Sc], %[Sc], %[w2], %[u2]\n\t" "v_fma_f32 %[Sd], %[Sd], %[w3], %[u3]\n\t"
                        : [Sa] "+v"(S[r][0]), [Sb] "+v"(S[r][1]), [Sc] "+v"(S[r][2]), [Sd] "+v"(S[r][3]), [u0] "+v"(u0), [u1] "+v"(u1), [u2] "+v"(u2), [u3] "+v"(u3)
                        : [sa] "v"(sa), [b0] "v"(bv[0]), [b1] "v"(bv[1]), [b2] "v"(bv[2]), [b3] "v"(bv[3]), [w0] "v"(w[0]), [w1] "v"(w[1]), [w2] "v"(w[2]), [w3] "v"(w[3])); }
                __builtin_amdgcn_sched_barrier(0); }
            if (OUT) { const f32x4 r4 = r_[(STS - 1) & 1];
              ob0[(STS - 1) * 1024] = a_fma(S[0][3], r4[3], a_fma(S[0][2], r4[2], a_fma(S[0][1], r4[1], a_mul(S[0][0], r4[0]))));
              ob1[(STS - 1) * 1024] = a_fma(S[1][3], r4[3], a_fma(S[1][2], r4[2], a_fma(S[1][1], r4[1], a_mul(S[1][0], r4[0])))); }
#undef SC_LD
        }
        RAW_BAR();
        if (OUT) {
            const LAS f32x4* p = (const LAS f32x4*)(obuf + (sc & 1) * OB + tid * 16); const f32x4 a = p[0], b = p[1], c = p[2], d = p[3];
            const float o = (((a[0] + a[1]) + (a[2] + a[3])) + ((b[0] + b[1]) + (b[2] + b[3]))) + (((c[0] + c[1]) + (c[2] + c[3])) + ((d[0] + d[1]) + (d[2] + d[3])));
            Og[((size_t)sc * STS + (tid >> 6)) * 256 + (tid & 63)] = o; }
      }
    }
#undef ST_LOAD
#undef ST_STORE
    if (endS) {
#pragma unroll
        for (int r = 0; r < 2; ++r) *(f32x4*)(endS + (size_t)rowr[r] * 64 + 4 * ks) = (f32x4){S[r][0], S[r][1], S[r][2], S[r][3]}; }
    RAW_BAR();
}
#undef DPP_ADD
__device__ __forceinline__ void rwkv_carry(Frame& F) {
    const int hb = F.bx >> 3, row = (F.bx & 7) * 8 + F.wave, lane = F.lane, tid = F.tid;
    LAS float* Pl = (LAS float*)F.lds;
    LAS float* Sl = (LAS float*)(F.lds + 16384) + F.wave * 64;
    float S = 0.f;
    const size_t m0 = (size_t)hb * RC_N * 4096;
    f32x4 p0 = *(const f32x4*)(F.PB + m0 + (size_t)tid * 8), p1 = *(const f32x4*)(F.PB + m0 + (size_t)tid * 8 + 4);
    float lc = F.LB[m0 + (size_t)row * 64 + lane];
#pragma unroll 1
    for (int c = 0; c < RC_N; ++c) { const size_t mo = m0 + (size_t)c * 4096;
        F.SB[mo + (size_t)row * 64 + lane] = S;
        if (c + 1 == RC_N) break;
        float acc = lc;
        *(LAS f32x4*)(Pl + tid * 8) = p0; *(LAS f32x4*)(Pl + tid * 8 + 4) = p1; Sl[lane] = S;
        if (c + 2 < RC_N) { p0 = *(const f32x4*)(F.PB + mo + 4096 + (size_t)tid * 8); p1 = *(const f32x4*)(F.PB + mo + 4096 + (size_t)tid * 8 + 4); lc = F.LB[mo + 4096 + (size_t)row * 64 + lane]; }
        RAW_BAR();
        float a0 = 0.f, a1 = 0.f, a2 = 0.f, a3 = 0.f;
#pragma unroll 4
        for (int j = 0; j < 64; j += 4) { const f32x4 s4 = *(const LAS f32x4*)(Sl + j);
            a0 += s4[0] * Pl[(j + 0) * 64 + lane]; a1 += s4[1] * Pl[(j + 1) * 64 + lane]; a2 += s4[2] * Pl[(j + 2) * 64 + lane]; a3 += s4[3] * Pl[(j + 3) * 64 + lane]; }
        S = acc + ((a0 + a1) + (a2 + a3));
        RAW_BAR();
    }
}
__device__ __forceinline__ float gelu_tanh(float x) { const float u = 0.7978845608028654f * (x + 0.044715f * x * x * x); return 0.5f * x * (1.0f + tanhf(u)); }
__device__ __forceinline__ void s5_pass2(Frame& F, int l, int c) {
    typedef short bf16x8_t __attribute__((ext_vector_type(8)));
    LAS float* ubuf = (LAS float*)F.lds;
    const int t0 = c * 64, lane = F.lane, wave = F.wave, cb0 = c & ~127;
    LAS unsigned short* hb = (LAS unsigned short*)(F.lds + 65536) + wave * (16 * 136);
    load_u5_tile(F, t0, ubuf);
    __syncthreads();
    const int r16 = lane & 15, quad = lane >> 4;
#pragma unroll 1
    for (int gi = 0; gi < 2; ++gi) { const int g = wave + 8 * gi; S5Par P; s5_params(F, l, g, lane, P);
        int lane_l = lane; asm volatile("" : "+v"(lane_l));
        bf16x8_t cf[4];
#pragma unroll
        for (int ks = 0; ks < 4; ++ks) { const float* src = (ks < 2 ? F.in[12] : F.in[13]) + (((size_t)l * 16 + g) * 16 + (lane_l & 15)) * 64 + (ks & 1) * 32 + quad * 8;
            const f32x4 a = *(const f32x4*)src, b = *(const f32x4*)(src + 4); const float sg = ks < 2 ? 1.0f : -1.0f;
            cf[ks][0] = (short)f2bf(a[0] * sg); cf[ks][1] = (short)f2bf(a[1] * sg); cf[ks][2] = (short)f2bf(a[2] * sg); cf[ks][3] = (short)f2bf(a[3] * sg);
            cf[ks][4] = (short)f2bf(b[0] * sg); cf[ks][5] = (short)f2bf(b[1] * sg); cf[ks][6] = (short)f2bf(b[2] * sg); cf[ks][7] = (short)f2bf(b[3] * sg); }
        const int chy = g * 16 + r16; const float dd = F.in[14][(size_t)l * 256 + chy];
        float pr = P.ar, pi = P.ai;
#pragma unroll
        for (int s = 0; s < 6; ++s) { const float nr = pr * pr - pi * pi, ni = 2.0f * pr * pi; pr = nr; pi = ni; }
        float hr = 0.f, hi = 0.f;
#pragma unroll 1
        for (int c2 = cb0; c2 < c; c2 += 16) {
            f32x2 e[16];
#pragma unroll
            for (int q = 0; q < 16; ++q) { const int cq = (c2 + q < c) ? c2 + q : c2; e[q] = *(const f32x2*)(F.E + (((size_t)cq * 16 + g) * 64 + lane_l) * 2); }
#pragma unroll
            for (int q = 0; q < 16; ++q) if (c2 + q < c) { const float nr = pr * hr - pi * hi + e[q][0], ni = pr * hi + pi * hr + e[q][1]; hr = nr; hi = ni; } }
#pragma unroll 1
        for (int tb = 0; tb < 4; ++tb) {
#pragma unroll 4
            for (int j = 0; j < 16; ++j) { s5_step(P, ubuf + (tb * 16 + j) * 256 + g * 16, hr, hi);
                hb[j * 136 + lane] = (unsigned short)f2bf(hr); hb[j * 136 + 64 + lane] = (unsigned short)f2bf(hi); }
            f32x4 acc = {0.f, 0.f, 0.f, 0.f};
#pragma unroll
            for (int ks = 0; ks < 4; ++ks) { const bf16x8_t a = *(const LAS bf16x8_t*)(hb + r16 * 136 + ks * 32 + quad * 8);
                acc = __builtin_amdgcn_mfma_f32_16x16x32_bf16(a, cf[ks], acc, 0, 0, 0); }
#pragma unroll
            for (int j = 0; j < 4; ++j) { const int tl = tb * 16 + quad * 4 + j; const float y = acc[j] + dd * ubuf[tl * 256 + chy];
                F.GL[(size_t)(t0 + tl) * 256 + chy] = (bf16_t)f2bf(gelu_tanh(y)); }
        }
    }
    __syncthreads();
}
template <int PART> __device__ __forceinline__ void m2_phase(Frame& F, int l, const XcdBarrier& xbar) {
    if (PART == 0 || PART == 1)
#pragma unroll 1
    for (int id = F.bx; id < 8 * RC_N * 2; id += F.G) { const int hb = id >> 6, c = (id >> 1) & (RC_N - 1), tk = id & 1; const size_t mo = ((size_t)hb * RC_N + c) * 4096;
        if (c == RC_N - 1) continue;
        const unsigned char* src = F.RW + ((size_t)hb * SEQ + (size_t)c * RC_LEN) * 896;
        scan_task<false>(F, src, nullptr, tk == 1, tk == 0, (tk == 0 ? F.LB : F.PB) + mo, nullptr); }
    if (PART == 0 || PART == 2)
#pragma unroll 1
    for (int c = F.bx; c < TT / 64; c += F.G) pool_conv_chunk(F, l, c);
    xcd_barrier(xbar);
    if (PART == 0 || PART == 3) { int bxs = F.bx; asm volatile("" : "+s"(bxs));
      if (bxs < 64) rwkv_carry(F);
      else conv_second_half(F, l, 64); }
    xcd_barrier(xbar);
    if (PART == 0 || PART == 4)
#pragma unroll 1
    for (int id = F.bx; id < 8 * RC_N; id += F.G) { const int hb = id >> 5, c = id & (RC_N - 1); const size_t mo = ((size_t)hb * RC_N + c) * 4096;
        const unsigned char* src = F.RW + ((size_t)hb * SEQ + (size_t)c * RC_LEN) * 896;
        float* Og = F.O + ((size_t)(hb >> 2) * SEQ + (size_t)c * RC_LEN) * 256 + (hb & 3) * 64;
        scan_task<true>(F, src, F.SB + mo, false, true, nullptr, Og); }
    if (PART == 0 || PART == 5)
#pragma unroll 1
    for (int c = F.bx; c < TT / 64; c += F.G) s5_pass2(F, l, c);
}
__device__ __forceinline__ void rwkv_post(Frame& F, int l) {
    const int gw = F.bx * NWAVES + F.wave, NGW = F.G * NWAVES, lane = F.lane;
    for (int it0 = gw * 4; it0 < TT * 4; it0 += NGW * 4) {
        const int t = it0 >> 2, b = t / SEQ, pos = t & (SEQ - 1);
        float o[4], r[4], k[4], v[4], g[4];
#pragma unroll
        for (int hh = 0; hh < 4; ++hh) { const int c = hh * 64 + lane; o[hh] = F.O[(size_t)t * 256 + c]; g[hh] = (float)F.G16[(size_t)t * 256 + c];
            const h16* rw = (const h16*)(F.RW + ((size_t)(b * 4 + hh) * SEQ + pos) * 896 + 256) + lane; r[hh] = (float)rw[0]; k[hh] = (float)rw[64]; v[hh] = (float)rw[128]; }
#pragma unroll
        for (int hh = 0; hh < 4; ++hh) { const int c = hh * 64 + lane;
            const float mu = wave_sum(o[hh]) * (1.0f / 64.0f); const float d = o[hh] - mu; const float var = wave_sum(d * d) * (1.0f / 64.0f);
            const float on = d * rsqrtf(var + 64e-5f) * F.in[31][(size_t)l * 256 + c] + F.in[32][(size_t)l * 256 + c];
            const float bs = wave_sum(r[hh] * k[hh] * F.in[30][(size_t)l * 256 + c]);
            F.B2[(size_t)t * 1024 + 512 + c] = (bf16_t)f2bf((on + bs * v[hh]) * g[hh]); }
    }
}

constexpr int NPH = 25;
#ifndef PHMASK
#define PHMASK 0xFFFF
#endif
#define PHON(k) (((PHMASK) >> (k)) & 1)
#ifndef REP_PART
#define REP_PART 0
#endif
template <int PH, int PART = 0> __device__ __forceinline__ void run_phase(const int wave_s, unsigned char* lds_raw, const XcdBarrier& xbar) {
    typedef pg8::StaticOrder SO;
    int tid = wave_s * 64 + (int)__builtin_amdgcn_mbcnt_hi(~0u, __builtin_amdgcn_mbcnt_lo(~0u, 0u)); asm volatile("" : "+v"(tid));
    int G = gridDim.x, bx = blockIdx.x; asm volatile("" : "+s"(G), "+s"(bx));
    const __attribute__((address_space(4))) unsigned char* ka = (const __attribute__((address_space(4))) unsigned char*)__builtin_amdgcn_kernarg_segment_ptr();
    asm volatile("" : "+s"(ka));
    const __attribute__((address_space(4))) Args* ap = (const __attribute__((address_space(4))) Args*)ka;
    Frame F;
    F.lds = (LAS unsigned char*)lds_raw;
    F.tid = tid; F.lane = tid & 63; F.wave = __builtin_amdgcn_readfirstlane(tid >> 6); F.G = G; F.bx = bx;
    F.in = (in_t)ka; F.X = ap->out; F.ws = ap->ws;
    unsigned char* ws = F.ws;
    F.SS = (float*)(ws + WS_SS); F.E = (float*)(ws + WS_E); F.B1 = (bf16_t*)(ws + WS_B1); F.B2 = (bf16_t*)(ws + WS_B2);
    unsigned char* z = ws + WS_Z;
    F.HID = (bf16_t*)(z + Z_HID); F.GL = (bf16_t*)(z + Z_GL); F.U5 = (h16*)(z + Z_U5); F.PP = (h16*)(z + Z_PP); F.L16 = (h16*)(z + Z_L16); F.G16 = (h16*)(z + Z_G16); F.R = (h16*)(z + Z_R);
    F.O = (float*)(z + Z_O); F.RW = z + Z_RW; F.PB = (float*)(z + Z_PB); F.LB = (float*)(z + Z_LB); F.SB = (float*)(z + Z_SB);
    if constexpr (PH == 0) { conv_first_half(F, 0); prep_x(F); }
    else { constexpr int l = (PH - 1) / 12, k = (PH - 1) % 12;
        if constexpr (k == 0) { pg8::Gemm g{F.B1, (const bf16_t*)(ws + WS_W + W_GU1), TT, 2 * FF, DM, 1}; SO S; S.init(TT, 2 * FF, G, bx); pg8::EpiGU E{F.HID, F.SS}; pg8::gemm_phase<pg8::EpiGU, SO, true, true>(F.lds, g, S, E, tid); }
        else if constexpr (k == 1) { pg8::Gemm g{F.HID, (const bf16_t*)(ws + WS_W + W_D1), TT, DM, FF, 1}; SO S; S.init(TT, DM, G, bx); pg8::EpiDown E{l == 0 ? F.in[0] : F.X, F.X, F.B1, F.SS, 0.5f}; pg8::gemm_phase<pg8::EpiDown, SO, true, true>(F.lds, g, S, E, tid); }
        else if constexpr (k == 2) { pg8::Gemm g{F.B1, (const bf16_t*)(ws + WS_W + W_INA), TT, 2560, DM, 1}; SO S; S.init(TT, 2560, G, bx); pg8::EpiInA E{F.U5, F.PP, F.L16, F.SS}; pg8::gemm_phase<pg8::EpiInA, SO, true, true>(F.lds, g, S, E, tid); }
        else if constexpr (k == 3) { m1_phase(F, l); }
        else if constexpr (k == 4) { m2_phase<PART>(F, l, xbar); }
        else if constexpr (k == 5) { { pg8::Gemm g{F.GL, (const bf16_t*)(ws + WS_W + W_GLU), TT, 256, 256, 1}; SO S; S.init(TT, 256, G, bx); pg8::EpiGlu E{F.GL, F.B2}; pg8::gemm_phase<pg8::EpiGlu, SO, true, true>(F.lds, g, S, E, tid); } rwkv_post(F, l); }
        else if constexpr (k == 6) { pg8::Gemm g{F.B1, (const bf16_t*)(ws + WS_W + W_ING), TT, 4096, DM, 1}; SO S; S.init(TT, 4096, G, bx); pg8::EpiGate E{F.R, F.SS}; pg8::gemm_phase<pg8::EpiGate, SO, true, true>(F.lds, g, S, E, tid); }
        else if constexpr (k == 7) { pg8::Gemm g{F.B2, (const bf16_t*)(ws + WS_W + W_BR), TT, DM, DM, 4}; pg8::SegOrder4 S; S.so.init(TT, DM, G, bx); pg8::EpiBranch E{F.R, F.B1}; pg8::gemm_phase<pg8::EpiBranch, pg8::SegOrder4, true, true>(F.lds, g, S, E, tid); }
        else if constexpr (k == 8) { pg8::Gemm g{F.B1, (const bf16_t*)(ws + WS_W + W_O), TT, DM, DM, 1}; SO S; S.init(TT, DM, G, bx); pg8::EpiDown E{F.X, F.X, F.B2, F.SS, 1.0f}; pg8::gemm_phase<pg8::EpiDown, SO, true, true>(F.lds, g, S, E, tid); }
        else if constexpr (k == 9) { pg8::Gemm g{F.B2, (const bf16_t*)(ws + WS_W + W_GU2), TT, 2 * FF, DM, 1}; SO S; S.init(TT, 2 * FF, G, bx); pg8::EpiGU E{F.HID, F.SS}; pg8::gemm_phase<pg8::EpiGU, SO, true, true>(F.lds, g, S, E, tid); }
        else if constexpr (k == 10) { pg8::Gemm g{F.HID, (const bf16_t*)(ws + WS_W + W_D2), TT, DM, FF, 1}; SO S; S.init(TT, DM, G, bx); pg8::EpiDown E{F.X, F.X, F.B1, F.SS, 0.5f}; pg8::gemm_phase<pg8::EpiDown, SO, true, true>(F.lds, g, S, E, tid); }
        else { if constexpr (l == 0) conv_first_half(F, 1); else final_norm(F); }
    }
}
#ifndef REPMASK
#define REPMASK 0
#endif
#define SEAM(k_) do { if ((k_) == 0) { __syncthreads(); cg::this_grid().sync(); } else xcd_barrier(xbar); } while (0)
#define PHASE(k) if (ph_lo <= (k) && (k) < ph_hi) { run_phase<(k)>(wave_s, lds_raw, xbar); \
    if ((k) >= 1 && ((REPMASK >> (((k) - 1) % 12)) & 1)) { SEAM(k); run_phase<(k), REP_PART>(wave_s, lds_raw, xbar); } \
    if ((k) + 1 < ph_hi) SEAM(k); }
__global__ void __launch_bounds__(NTHR, 2) mk_fwd(Args args) {
    extern __shared__ __attribute__((aligned(16))) unsigned char lds_raw[];
    const int ph_lo = args.ph_lo, ph_hi = args.ph_hi;
    volatile LAS unsigned* xst = (volatile LAS unsigned*)((LAS unsigned char*)lds_raw + (LDS_BYTES - 64));
    if (threadIdx.x == 0) { xst[0] = 0u; xst[1] = 0u; }
    __syncthreads();
    const XcdBarrier xbar = xcd_barrier_post((unsigned*)(args.ws + WS_CTL), xst);
    const int wave_s = __builtin_amdgcn_readfirstlane((int)threadIdx.x >> 6);
    PHASE(0) PHASE(1) PHASE(2) PHASE(3) PHASE(4) PHASE(5) PHASE(6) PHASE(7) PHASE(8) PHASE(9) PHASE(10) PHASE(11) PHASE(12)
    PHASE(13) PHASE(14) PHASE(15) PHASE(16) PHASE(17) PHASE(18) PHASE(19) PHASE(20) PHASE(21) PHASE(22) PHASE(23) PHASE(24)
}

extern "C" void kernel_launch(void* const* d_in, const int* in_sizes, int n_in, void* d_out, int out_size, void* d_ws, size_t ws_size, hipStream_t stream) {
    static int grid = 0;
    if (grid == 0) {
        if (n_in != 41 || out_size != TT * DM || ws_size < WS_END) { fprintf(stderr, "kernel_launch: unexpected shapes (n_in %d out %d ws %zu)\n", n_in, out_size, ws_size); grid = -1; return; }
        int dev = 0, cus = 0, per_cu = 0;
        (void)hipGetDevice(&dev); (void)hipDeviceGetAttribute(&cus, hipDeviceAttributeMultiprocessorCount, dev);
        if (hipFuncSetAttribute((const void*)mk_fwd, hipFuncAttributeMaxDynamicSharedMemorySize, LDS_BYTES) != hipSuccess) { fprintf(stderr, "kernel_launch: hipFuncSetAttribute failed\n"); grid = -1; return; }
        if (hipOccupancyMaxActiveBlocksPerMultiprocessor(&per_cu, (const void*)mk_fwd, NTHR, LDS_BYTES) != hipSuccess || per_cu < 1) { fprintf(stderr, "kernel_launch: occupancy query says %d\n", per_cu); per_cu = 1; }
        (void)hipGetLastError();
        grid = cus * (per_cu >= 1 ? 1 : 1);
        if (grid < 64) { fprintf(stderr, "kernel_launch: grid %d too small\n", grid); }
    }
    if (grid < 0) return;
    if (hipMemsetAsync((char*)d_ws + WS_CTL, 0, CTL_ZERO_BYTES, stream) != hipSuccess) { fprintf(stderr, "kernel_launch: hipMemsetAsync failed\n"); return; }
    Args a{};
    for (int i = 0; i < 41; ++i) a.in[i] = (const float*)d_in[i];
    a.out = (float*)d_out; a.ws = (unsigned char*)d_ws;
#if ONE_LAUNCH
    a.ph_lo = 0; a.ph_hi = NPH;
    void* kargs[] = {&a};
    hipError_t e = hipLaunchCooperativeKernel((const void*)mk_fwd, dim3(grid), dim3(NTHR), kargs, LDS_BYTES, stream);
    if (e != hipSuccess) fprintf(stderr, "cooperative launch failed: %s (grid %d)\n", hipGetErrorString(e), grid);
#else
    for (int ph = 0; ph < NPH; ++ph) { a.ph_lo = ph; a.ph_hi = ph + 1; hipLaunchKernelGGL(mk_fwd, dim3(grid), dim3(NTHR), LDS_BYTES, stream, a); }
#endif
}
```

```cpp
#include <hip/hip_runtime.h>
#include <hip/hip_cooperative_groups.h>
#include <cstdio>
#include <cstdint>
#include <cstddef>
namespace cg = cooperative_groups;
namespace pg8 {
#define PG8_LAS __attribute__((address_space(3)))
typedef unsigned short bf16_t;
typedef short bf16x8 __attribute__((ext_vector_type(8)));
typedef float f32x4 __attribute__((ext_vector_type(4)));
typedef unsigned u32x4 __attribute__((ext_vector_type(4)));
constexpr int BM = 256, BK = 64, HALF = 128, HTB = HALF * BK * 2  , STAGE_BYTES = 8 * HTB, NXCD = 8, WGM = 8;

__host__ __device__ __forceinline__ int lds_byte(int r, int c) { const int st = (r >> 4) * 2 + (c >> 5), rr = r & 15, cc = c & 31, ob = rr * 64 + cc * 2; return st * 1024 + (ob ^ (((ob >> 9) & 1) << 5)); }
__host__ __device__ __forceinline__ void stage_rc(int b, int& R, int& C) { const int st = b / 1024, sb = b % 1024, swz = sb ^ (((sb >> 9) & 1) << 5); R = (st >> 1) * 16 + swz / 64; C = (st & 1) * 32 + (swz % 64) / 2; }
__host__ __device__ __forceinline__ int perm32(int rho) { const int n = rho >> 4, i = rho & 15; return 8 * (i >> 2) + 4 * n + (i & 3); }

struct Unit { int pm, pn, g; };
struct Gemm { const bf16_t* A; const bf16_t* Bt; int M, N, K, nseg; };

struct StaticOrder {
    int nM, nN, nwg, G, c;
    __host__ __device__ void init(int M, int N, int G_, int c_) { nM = M / BM; nN = N / BM; nwg = nM * nN; G = G_; c = c_; }
    __host__ __device__ bool next(int i, Unit& u) const {
        const long L = (long)i * G + c; if (L >= nwg) return false;
        int wgid = (int)L; { const int q = nwg / NXCD, r = nwg % NXCD, xcd = wgid % NXCD, off = wgid / NXCD; wgid = (xcd < r ? xcd * (q + 1) : r * (q + 1) + (xcd - r) * q) + off; }
        const int nig = WGM * nN, gid = wgid / nig, fm = gid * WGM, gsz = (nM - fm) < WGM ? (nM - fm) : WGM;
        u.pm = fm + ((wgid % nig) % gsz); u.pn = (wgid % nig) / gsz; u.g = 0; return true;
    }
    __device__ __forceinline__ void a_ready(const Unit&) const {}
    __device__ __forceinline__ void done(const Unit&) const {}
};


struct SegOrder4 {
    StaticOrder so;
    __host__ __device__ bool next(int i, Unit& u) const { if (!so.next(i >> 2, u)) return false; u.g = i & 3; return true; }
    __device__ __forceinline__ void a_ready(const Unit&) const {}
    __device__ __forceinline__ void done(const Unit&) const {}
};

typedef _Float16 h16;
typedef _Float16 h16x4 __attribute__((ext_vector_type(4)));
typedef unsigned u32x2 __attribute__((ext_vector_type(2)));
__device__ __forceinline__ unsigned cvt_pk_bf16(float lo, float hi) { unsigned r; asm volatile("v_cvt_pk_bf16_f32 %0, %1, %2" : "=v"(r) : "v"(lo), "v"(hi)); return r; }
__device__ __forceinline__ u32x2 pack_bf16x4(f32x4 v) { u32x2 w; w.x = cvt_pk_bf16(v[0], v[1]); w.y = cvt_pk_bf16(v[2], v[3]); return w; }
__device__ __forceinline__ h16x4 pack_h16x4(f32x4 v) { h16x4 w; w[0] = (h16)v[0]; w[1] = (h16)v[1]; w[2] = (h16)v[2]; w[3] = (h16)v[3]; return w; }
__device__ __forceinline__ float fast_sigmoid(float x) { return __builtin_amdgcn_rcpf(1.0f + __expf(-x)); }
__device__ __forceinline__ float row_rstd(const float* SS, int row) {
    const f32x4* p = (const f32x4*)(SS + (size_t)row * 16);
    const f32x4 a = p[0], b = p[1], c = p[2], d = p[3];
    const float s = ((a[0] + a[1]) + (a[2] + a[3])) + ((b[0] + b[1]) + (b[2] + b[3])) + ((c[0] + c[1]) + (c[2] + c[3])) + ((d[0] + d[1]) + (d[2] + d[3]));
    return rsqrtf(s * (1.0f / 1024.0f) + 1e-6f);
}

__device__ __forceinline__ void rows_rstd(const float* SS, int row0, int fq, float (&rs)[8]) {
    f32x4 q[8];
#pragma unroll
    for (int sl = 0; sl < 8; ++sl) q[sl] = *(const f32x4*)(SS + (size_t)(row0 + (sl >> 2) * HALF + (sl & 3) * 16) * 16 + 4 * fq);
#pragma unroll
    for (int sl = 0; sl < 8; ++sl) { float s = (q[sl][0] + q[sl][1]) + (q[sl][2] + q[sl][3]); s += __shfl_xor(s, 16); s += __shfl_xor(s, 32); rs[sl] = rsqrtf(s * (1.0f / 1024.0f) + 1e-6f); }
}

struct EpiGU {
    static constexpr bool PERM = true, KSEG = false;
    bf16_t* hid; const float* SS;
    __device__ __forceinline__ void operator()(const f32x4 (&acc)[2][2][4][2], const Unit& u, int wr, int wc, int fr, int fq) const {
        int row0 = u.pm * BM + wr * 64 + fr; asm volatile("" : "+v"(row0)); const int j0 = u.pn * 128 + wc * 32 + fq * 8;
        float rsv[8]; rows_rstd(SS, row0, fq, rsv);
#pragma unroll
        for (int ai = 0; ai < 2; ++ai)
#pragma unroll
            for (int m = 0; m < 4; ++m) { const int row = row0 + ai * HALF + m * 16; const float rs = rsv[ai * 4 + m]; u32x4 w;
#pragma unroll
                for (int n = 0; n < 2; ++n) { const f32x4 g = acc[ai][0][m][n] * rs, up = acc[ai][1][m][n] * rs; f32x4 h;
#pragma unroll
                    for (int i = 0; i < 4; ++i) h[i] = g[i] * fast_sigmoid(g[i]) * up[i];
                    const u32x2 p = pack_bf16x4(h); if (n == 0) { w.x = p.x; w.y = p.y; } else { w.z = p.x; w.w = p.y; } }
                *(u32x4*)(hid + (size_t)row * 2816 + j0) = w; }
    }
};
struct EpiDown {
    static constexpr bool PERM = true, KSEG = false;
    const float* res; float* X; bf16_t* xb; float* SS; float alpha;
    __device__ __forceinline__ void operator()(const f32x4 (&acc)[2][2][4][2], const Unit& u, int wr, int wc, int fr, int fq) const {
        int row0 = u.pm * BM + wr * 64 + fr; asm volatile("" : "+v"(row0)); const int c0 = u.pn * BM + wc * 32 + fq * 8;
#pragma unroll
        for (int ai = 0; ai < 2; ++ai) {
            f32x4 rv[4][2][2];
#pragma unroll
            for (int m = 0; m < 4; ++m)
#pragma unroll
                for (int bj = 0; bj < 2; ++bj)
#pragma unroll
                    for (int n = 0; n < 2; ++n) rv[m][bj][n] = *(const f32x4*)(res + (size_t)(row0 + ai * HALF + m * 16) * 1024 + c0 + bj * HALF + n * 4);
#pragma unroll
            for (int m = 0; m < 4; ++m) { const int row = row0 + ai * HALF + m * 16; float ss = 0.f;
#pragma unroll
                for (int bj = 0; bj < 2; ++bj) { const size_t off = (size_t)row * 1024 + c0 + bj * HALF;
                    const f32x4 o0 = rv[m][bj][0] + acc[ai][bj][m][0] * alpha, o1 = rv[m][bj][1] + acc[ai][bj][m][1] * alpha;
                    *(f32x4*)(X + off) = o0; *(f32x4*)(X + off + 4) = o1;
                    const u32x2 p0 = pack_bf16x4(o0), p1 = pack_bf16x4(o1); u32x4 w; w.x = p0.x; w.y = p0.y; w.z = p1.x; w.w = p1.y; *(u32x4*)(xb + off) = w;
                    ss += ((o0[0] * o0[0] + o0[1] * o0[1]) + (o0[2] * o0[2] + o0[3] * o0[3])) + ((o1[0] * o1[0] + o1[1] * o1[1]) + (o1[2] * o1[2] + o1[3] * o1[3])); }
                ss += __shfl_xor(ss, 16); ss += __shfl_xor(ss, 32);
                if (fq == 0) SS[(size_t)row * 16 + u.pn * 4 + wc] = ss; }
            asm volatile("" ::: "memory"); }
    }
};
struct EpiInA {
    static constexpr bool PERM = true, KSEG = false;
    h16* U5; h16* PP; h16* L16; const float* SS;
    __device__ __forceinline__ void operator()(const f32x4 (&acc)[2][2][4][2], const Unit& u, int wr, int wc, int fr, int fq) const {
        typedef _Float16 h16x8 __attribute__((ext_vector_type(8)));
        int row0 = u.pm * BM + wr * 64 + fr; asm volatile("" : "+v"(row0)); const int cl = wc * 32 + fq * 8;
        float rsv[8]; rows_rstd(SS, row0, fq, rsv);
        h16* base; int ld, cb;
        if (u.pn == 0) { base = U5; ld = 256; cb = 0; } else if (u.pn < 8) { base = PP; ld = 1792; cb = (u.pn - 1) * 256; } else { base = L16; ld = 512; cb = (u.pn - 8) * 256; }
#pragma unroll
        for (int ai = 0; ai < 2; ++ai)
#pragma unroll
            for (int m = 0; m < 4; ++m) { const int row = row0 + ai * HALF + m * 16; const float rs = rsv[ai * 4 + m];
#pragma unroll
                for (int bj = 0; bj < 2; ++bj) { const f32x4 a = acc[ai][bj][m][0] * rs, b = acc[ai][bj][m][1] * rs; h16x8 w;
                    w[0] = (h16)a[0]; w[1] = (h16)a[1]; w[2] = (h16)a[2]; w[3] = (h16)a[3]; w[4] = (h16)b[0]; w[5] = (h16)b[1]; w[6] = (h16)b[2]; w[7] = (h16)b[3];
                    *(h16x8*)(base + (size_t)row * ld + cb + cl + bj * HALF) = w; } }
    }
};
struct EpiGate {
    static constexpr bool PERM = false, KSEG = false;
    h16* R; const float* SS;
    __device__ __forceinline__ void operator()(const f32x4 (&acc)[2][2][4][2], const Unit& u, int wr, int wc, int fr, int fq) const {
        float rsv[8]; int row0 = u.pm * BM + wr * 64 + fr; asm volatile("" : "+v"(row0)); rows_rstd(SS, row0, fq, rsv); const int d0 = 256 * (u.pn >> 2) + 128 * ((u.pn >> 1) & 1) + 16 * (u.pn & 1) + 32 * wc + 4 * fq;
#pragma unroll
        for (int ai = 0; ai < 2; ++ai)
#pragma unroll
            for (int m = 0; m < 4; ++m) { const int row = row0 + ai * HALF + m * 16; const float rs = rsv[ai * 4 + m];
                f32x4 e[4];
#pragma unroll
                for (int g = 0; g < 4; ++g)
#pragma unroll
                    for (int i = 0; i < 4; ++i) e[g][i] = 1.0f + __expf(-fminf(fmaxf(acc[ai][g >> 1][m][g & 1][i] * rs, -10.f), 30.f));
                f32x4 r[4];
#pragma unroll
                for (int i = 0; i < 4; ++i) { const float i0 = __builtin_amdgcn_rcpf(e[0][i]), i1 = __builtin_amdgcn_rcpf(e[1][i]), i2 = __builtin_amdgcn_rcpf(e[2][i]), i3 = __builtin_amdgcn_rcpf(e[3][i]);
                    r[0][i] = e[1][i] * i0; r[1][i] = e[2][i] * i1; r[2][i] = e[3][i] * i2; r[3][i] = i3; }
#pragma unroll
                for (int g = 0; g < 4; ++g) *(h16x4*)(R + ((size_t)row * 4 + g) * 1024 + d0) = pack_h16x4(r[g]); }
    }
};
struct EpiBranch {
    static constexpr bool PERM = false, KSEG = true;
    const h16* R; bf16_t* out;
    __device__ __forceinline__ void operator()(f32x4 (&acc)[2][2][4][2], const Unit& u, int wr, int wc, int fr, int fq) const {
        unsigned q0 = (unsigned)(u.pm * BM + wr * 64 + fr) * 1024u + (unsigned)(u.pn * BM + wc * 32 + fq * 4); asm volatile("" : "+v"(q0));
        const unsigned r0 = (q0 - (q0 & 1023u)) * 4u + (unsigned)u.g * 1024u + (q0 & 1023u);
        const bool last = u.g == 3;
        h16x4 rr[2][4][2][2];
#pragma unroll
        for (int ai = 0; ai < 2; ++ai)
#pragma unroll
            for (int m = 0; m < 4; ++m)
#pragma unroll
                for (int bj = 0; bj < 2; ++bj)
#pragma unroll
                    for (int n = 0; n < 2; ++n) rr[ai][m][bj][n] = *(const h16x4*)(R + (r0 + (unsigned)((ai * HALF + m * 16) * 4096 + bj * HALF + n * 16)));
#pragma unroll
        for (int ai = 0; ai < 2; ++ai)
#pragma unroll
            for (int m = 0; m < 4; ++m) {
#pragma unroll
                for (int bj = 0; bj < 2; ++bj)
#pragma unroll
                    for (int n = 0; n < 2; ++n) { const unsigned off = q0 + (unsigned)((ai * HALF + m * 16) * 1024 + bj * HALF + n * 16);
                        const h16x4 r = rr[ai][m][bj][n];
                        f32x4 rf; rf[0] = (float)r[0]; rf[1] = (float)r[1]; rf[2] = (float)r[2]; rf[3] = (float)r[3];
                        acc[ai][bj][m][n] = acc[ai][bj][m][n] * rf;
                        if (last) *(u32x2*)(out + off) = pack_bf16x4(acc[ai][bj][m][n]); } }
    }
};
struct EpiGlu {
    static constexpr bool PERM = false, KSEG = false;
    const bf16_t* gl; bf16_t* ys;
    __device__ __forceinline__ void operator()(const f32x4 (&acc)[2][2][4][2], const Unit& u, int wr, int wc, int fr, int fq) const {
        int row0 = u.pm * BM + wr * 64 + fr; asm volatile("" : "+v"(row0)); const int c0 = wc * 32 + fq * 4;
        u32x2 gv[2][4][2][2];
#pragma unroll
        for (int ai = 0; ai < 2; ++ai)
#pragma unroll
            for (int m = 0; m < 4; ++m)
#pragma unroll
                for (int bj = 0; bj < 2; ++bj)
#pragma unroll
                    for (int n = 0; n < 2; ++n) gv[ai][m][bj][n] = *(const u32x2*)(gl + (size_t)(row0 + ai * HALF + m * 16) * 256 + c0 + bj * HALF + n * 16);
#pragma unroll
        for (int ai = 0; ai < 2; ++ai)
#pragma unroll
            for (int m = 0; m < 4; ++m) { const int row = row0 + ai * HALF + m * 16;
#pragma unroll
                for (int bj = 0; bj < 2; ++bj)
#pragma unroll
                    for (int n = 0; n < 2; ++n) { const int c = c0 + bj * HALF + n * 16; const u32x2 g2 = gv[ai][m][bj][n];
                        f32x4 g; g[0] = __uint_as_float(g2.x << 16); g[1] = __uint_as_float(g2.x & 0xffff0000u); g[2] = __uint_as_float(g2.y << 16); g[3] = __uint_as_float(g2.y & 0xffff0000u);
                        f32x4 o;
#pragma unroll
                        for (int i = 0; i < 4; ++i) o[i] = g[i] * fast_sigmoid(acc[ai][bj][m][n][i]);
                        *(u32x2*)(ys + (size_t)row * 1024 + c) = pack_bf16x4(o); } }
    }
};

template <class Epi, class Sched, bool ALIGN_EPI = false, bool SP2 = false>
__device__ __forceinline__ void gemm_phase(PG8_LAS unsigned char* lds, const Gemm g, const Sched& S, const Epi& E, const int tid) {
    const int wid = __builtin_amdgcn_readfirstlane(tid >> 6), lane = tid & 63, wr = wid >> 2, wc = wid & 3, fr = lane & 15, fq = lane >> 4;
    const int K = g.K, nt = K / BK / g.nseg; const size_t segb = (size_t)(K / g.nseg) * 2;
    unsigned voffA[2], voffB[2];
#pragma unroll
    for (int i = 0; i < 2; ++i) { int R, C; stage_rc(tid * 16 + i * 8192, R, C); const int Rb = Epi::PERM ? ((R & ~31) + perm32(R & 31)) : R;
        voffA[i] = (unsigned)(R * K + C) * 2u; voffB[i] = (unsigned)(Rb * K + C) * 2u; }
    const size_t kstep = (size_t)(BK * 2);
    const size_t hstep = (size_t)HALF * K * 2;
    const size_t tstep = 2 * hstep;
    const unsigned ldsw = (unsigned)wid * 1024u;
    const int aoff = lds_byte(wr * 64 + fr, fq * 8), boff = lds_byte(wc * 32 + fr, fq * 8);
#define PG8_SA(b, h) (((b) * 2 + (h)) * HTB)
#define PG8_SB(b, h) ((4 + (b) * 2 + (h)) * HTB)
#define PG8_STAGE(bufoff, gbase, voff) do { _Pragma("unroll") for (int _i = 0; _i < 2; ++_i) \
        __builtin_amdgcn_global_load_lds((const unsigned*)((const char*)(gbase) + (voff)[_i]), (PG8_LAS unsigned*)(lds + (bufoff) + ldsw + _i * 8192), 16, 0, 0); } while (0)
#define PG8_LDA(dst, b, h) do { _Pragma("unroll") for (int m = 0; m < 4; ++m) _Pragma("unroll") for (int k = 0; k < 2; ++k) dst[m][k] = *(const PG8_LAS bf16x8*)(lds + PG8_SA(b, h) + aoff + m * 2048 + k * 1024); } while (0)
#define PG8_LDB(dst, b, h) do { _Pragma("unroll") for (int n = 0; n < 2; ++n) _Pragma("unroll") for (int k = 0; k < 2; ++k) dst[n][k] = *(const PG8_LAS bf16x8*)(lds + PG8_SB(b, h) + boff + n * 2048 + k * 1024); } while (0)
#define PG8_MMA(ai, bj, At, Bt) do { __builtin_amdgcn_s_setprio(1); _Pragma("unroll") for (int m = 0; m < 4; ++m) _Pragma("unroll") for (int n = 0; n < 2; ++n) _Pragma("unroll") for (int k = 0; k < 2; ++k) \
        acc[ai][bj][m][n] = __builtin_amdgcn_mfma_f32_16x16x32_bf16(Bt[n][k], At[m][k], acc[ai][bj][m][n], 0, 0, 0); __builtin_amdgcn_s_setprio(0); } while (0)
#define PG8_WAIT_V(n) asm volatile("s_waitcnt vmcnt(" #n ")" ::: "memory")
#define PG8_WAIT_L(n) asm volatile("s_waitcnt lgkmcnt(" #n ")" ::: "memory")
#define PG8_BAR __builtin_amdgcn_s_barrier()
#define PG8_SCHED __builtin_amdgcn_sched_barrier(0)
    Unit cur, nxt; int ui = 0;
    if (!S.next(0, cur)) return;
    f32x4 acc[2][2][4][2];
#pragma unroll
    for (int a = 0; a < 2; ++a)
#pragma unroll
        for (int b = 0; b < 2; ++b)
#pragma unroll
            for (int m = 0; m < 4; ++m)
#pragma unroll
                for (int n = 0; n < 2; ++n) acc[a][b][m][n] = (f32x4){0.f, 0.f, 0.f, 0.f};
    bf16x8 At[4][2], B0[2][2], B1[2][2];
    const char* cA = (const char*)g.A + (size_t)cur.pm * tstep + (size_t)cur.g * segb; const char* cB = (const char*)g.Bt + (size_t)cur.pn * tstep + (size_t)cur.g * segb;
    S.a_ready(cur);
    if constexpr (SP2) {
        PG8_STAGE(PG8_SB(0, 0), cB, voffB); PG8_STAGE(PG8_SB(0, 1), cB + hstep, voffB); PG8_STAGE(PG8_SA(0, 0), cA, voffA); PG8_STAGE(PG8_SA(0, 1), cA + hstep, voffA);
        if (wr == 1) PG8_BAR;
        PG8_WAIT_V(2); PG8_BAR;
        PG8_STAGE(PG8_SB(1, 0), cB + kstep, voffB); PG8_STAGE(PG8_SA(1, 0), cA + kstep, voffA); PG8_STAGE(PG8_SB(1, 1), cB + hstep + kstep, voffB);
        PG8_WAIT_V(6); PG8_BAR;
    } else {
        PG8_STAGE(PG8_SB(0, 0), cB, voffB); PG8_STAGE(PG8_SA(0, 0), cA, voffA); PG8_STAGE(PG8_SB(0, 1), cB + hstep, voffB); PG8_STAGE(PG8_SA(0, 1), cA + hstep, voffA);
        if (wr == 1) PG8_BAR;
        PG8_WAIT_V(4); PG8_BAR;
        PG8_STAGE(PG8_SB(1, 0), cB + kstep, voffB); PG8_STAGE(PG8_SA(1, 0), cA + kstep, voffA); PG8_STAGE(PG8_SB(1, 1), cB + hstep + kstep, voffB);
        PG8_WAIT_V(6); PG8_BAR;
    }
    for (;;) {
        const bool has_next = S.next(ui + 1, nxt);
        const char* nA = has_next ? (const char*)g.A + (size_t)nxt.pm * tstep + (size_t)nxt.g * segb : cA; const char* nB = has_next ? (const char*)g.Bt + (size_t)nxt.pn * tstep + (size_t)nxt.g * segb : cB;
        for (int t = 0; t < nt; t += 2) {
            const bool last = (t == nt - 2);
            const char* a1 = cA + (size_t)(t + 1) * kstep;
            const char* a2 = last ? nA : cA + (size_t)(t + 2) * kstep; const char* b2 = last ? nB : cB + (size_t)(t + 2) * kstep;
            const char* a3 = a2 + kstep; const char* b3 = b2 + kstep;
            if (last && has_next) S.a_ready(nxt);
            if constexpr (SP2) {
            PG8_LDB(B0, 0, 0); PG8_LDB(B1, 0, 1); PG8_SCHED; PG8_LDA(At, 0, 0); PG8_STAGE(PG8_SA(1, 1), a1 + hstep, voffA);
            PG8_WAIT_V(8); PG8_WAIT_L(0); PG8_BAR; PG8_MMA(0, 0, At, B0); PG8_MMA(0, 1, At, B1); PG8_BAR; PG8_SCHED;
            PG8_LDA(At, 0, 1); PG8_STAGE(PG8_SB(0, 0), b2, voffB); PG8_STAGE(PG8_SB(0, 1), b2 + hstep, voffB); PG8_STAGE(PG8_SA(0, 0), a2, voffA);
            PG8_WAIT_V(8); PG8_WAIT_L(0); PG8_BAR; PG8_MMA(1, 0, At, B0); PG8_MMA(1, 1, At, B1); PG8_BAR; PG8_SCHED;
            PG8_LDB(B0, 1, 0); PG8_LDB(B1, 1, 1); PG8_SCHED; PG8_LDA(At, 1, 0); PG8_STAGE(PG8_SA(0, 1), a2 + hstep, voffA);
            PG8_WAIT_V(8); PG8_WAIT_L(0); PG8_BAR; PG8_MMA(0, 0, At, B0); PG8_MMA(0, 1, At, B1); PG8_BAR; PG8_SCHED;
            PG8_LDA(At, 1, 1); PG8_STAGE(PG8_SB(1, 0), b3, voffB); PG8_STAGE(PG8_SB(1, 1), b3 + hstep, voffB); PG8_STAGE(PG8_SA(1, 0), a3, voffA);
            PG8_WAIT_V(8); PG8_WAIT_L(0); PG8_BAR; PG8_MMA(1, 0, At, B0); PG8_MMA(1, 1, At, B1); PG8_BAR; PG8_SCHED;
            } else {
            PG8_LDB(B0, 0, 0); PG8_SCHED; PG8_LDA(At, 0, 0); PG8_STAGE(PG8_SA(1, 1), a1 + hstep, voffA);
            PG8_WAIT_L(8); PG8_BAR; PG8_WAIT_L(0); PG8_MMA(0, 0, At, B0); PG8_BAR; PG8_SCHED;
            PG8_LDB(B1, 0, 1); PG8_STAGE(PG8_SB(0, 0), b2, voffB);
            PG8_BAR; PG8_WAIT_L(0); PG8_MMA(0, 1, At, B1); PG8_BAR;
            PG8_LDA(At, 0, 1); PG8_STAGE(PG8_SA(0, 0), a2, voffA);
            PG8_BAR; PG8_WAIT_L(0); PG8_MMA(1, 0, At, B0); PG8_BAR; PG8_SCHED;
            PG8_STAGE(PG8_SB(0, 1), b2 + hstep, voffB);
            PG8_WAIT_V(6); PG8_BAR; PG8_MMA(1, 1, At, B1); PG8_BAR;
            PG8_LDB(B0, 1, 0); PG8_SCHED; PG8_LDA(At, 1, 0); PG8_STAGE(PG8_SA(0, 1), a2 + hstep, voffA);
            PG8_WAIT_L(8); PG8_BAR; PG8_WAIT_L(0); PG8_MMA(0, 0, At, B0); PG8_BAR; PG8_SCHED;
            PG8_LDB(B1, 1, 1); PG8_STAGE(PG8_SB(1, 0), b3, voffB);
            PG8_BAR; PG8_WAIT_L(0); PG8_MMA(0, 1, At, B1); PG8_BAR;
            PG8_LDA(At, 1, 1); PG8_STAGE(PG8_SA(1, 0), a3, voffA);
            PG8_BAR; PG8_WAIT_L(0); PG8_MMA(1, 0, At, B0); PG8_BAR; PG8_SCHED;
            PG8_STAGE(PG8_SB(1, 1), b3 + hstep, voffB);
            PG8_WAIT_V(6); PG8_BAR; PG8_MMA(1, 1, At, B1); PG8_BAR;
            }
        }
        if constexpr (ALIGN_EPI) { if (wr == 0) PG8_BAR; }
        E(acc, cur, wr, wc, fr, fq); S.done(cur);
        if (!has_next) break;
        if (!(Epi::KSEG && nxt.g != 0))
#pragma unroll
        for (int a = 0; a < 2; ++a)
#pragma unroll
            for (int b = 0; b < 2; ++b)
#pragma unroll
                for (int m = 0; m < 4; ++m)
#pragma unroll
                    for (int n = 0; n < 2; ++n) acc[a][b][m][n] = (f32x4){0.f, 0.f, 0.f, 0.f};
        cur = nxt; cA = nA; cB = nB; ++ui;
        if constexpr (ALIGN_EPI) { if (wr == 1) PG8_BAR; }
    }
    PG8_WAIT_V(0);
    if constexpr (!ALIGN_EPI) { if (wr == 0) PG8_BAR; }
    PG8_BAR;
#undef PG8_SA
#undef PG8_SB
#undef PG8_STAGE
#undef PG8_LDA
#undef PG8_LDB
#undef PG8_MMA
#undef PG8_WAIT_V
#undef PG8_WAIT_L
#undef PG8_BAR
#undef PG8_SCHED
}
}

#define LAS __attribute__((address_space(3)))
typedef unsigned short bf16_t;
typedef _Float16 h16;
typedef _Float16 h16x4 __attribute__((ext_vector_type(4)));
typedef _Float16 h16x8 __attribute__((ext_vector_type(8)));
typedef float f32x4 __attribute__((ext_vector_type(4)));
typedef float f32x2 __attribute__((ext_vector_type(2)));
typedef unsigned u32x4 __attribute__((ext_vector_type(4)));
typedef unsigned u32x2 __attribute__((ext_vector_type(2)));

#ifndef ONE_LAUNCH
#define ONE_LAUNCH 1
#endif
constexpr int NWAVES = 8, NTHR = 512;
constexpr int TT = 16384, SEQ = 8192, DM = 1024, FF = 2816, MW = 256, INW = 6144;
constexpr int LDS_BYTES = 147456;
constexpr size_t MiB = 1u << 20;
constexpr size_t WS_CTL = 0, CTL_ZERO_BYTES = 16384, WS_SS = 1 * MiB, WS_E = 2 * MiB, WS_W = 4 * MiB, WS_B1 = 34 * MiB, WS_B2 = 66 * MiB, WS_Z = 98 * MiB, WS_END = 262 * MiB;
constexpr size_t W_GU1 = 0, W_D1 = W_GU1 + (size_t)2 * FF * DM * 2, W_INA = W_D1 + (size_t)DM * FF * 2;
constexpr size_t W_ING = 0, W_BR = W_ING + (size_t)4096 * DM * 2, W_O = W_BR + (size_t)DM * DM * 2, W_GU2 = W_O + (size_t)DM * DM * 2, W_D2 = W_GU2 + (size_t)2 * FF * DM * 2, W_GLU = W_D2 + (size_t)DM * FF * 2, W_END2 = W_GLU + 256 * 256 * 2;
constexpr size_t W_L2 = 23 * MiB;
static_assert(W_END2 <= 30 * MiB && W_INA + (size_t)2560 * DM * 2 <= 30 * MiB, "W region");
constexpr size_t Z_RW = 0, Z_G16 = 56 * MiB, Z_U5 = 64 * MiB, Z_L16 = 72 * MiB, Z_PP = 88 * MiB, Z_O = 72 * MiB, Z_GL = 144 * MiB, Z_PB = 152 * MiB, Z_LB = 156 * MiB, Z_SB = 160 * MiB;
constexpr size_t Z_HID = 0, Z_R = 0;
static_assert((size_t)TT * 4 * 896 <= 56 * MiB && (size_t)TT * 1792 * 2 <= 56 * MiB && (size_t)TT * FF * 2 <= 144 * MiB && (size_t)TT * 4096 * 2 <= 144 * MiB, "Z region");

typedef const float* cfp_t;
typedef const __attribute__((address_space(4))) cfp_t* in_t;
struct Args { const float* in[41]; float* out; unsigned char* ws; int ph_lo, ph_hi; };

struct Frame {
    LAS unsigned char* lds;
    int tid, lane, wave, G, bx;
    in_t in;
    float* X; unsigned char* ws;
    float* SS; float* E;
    bf16_t *B1, *B2, *HID, *GL;
    h16 *U5, *PP, *L16, *G16, *R;
    float* O; unsigned char* RW;
    float *PB, *LB, *SB;
};

__device__ __forceinline__ unsigned f2bf(float f) { unsigned u = __builtin_bit_cast(unsigned, f); return (u + 0x7fffu + ((u >> 16) & 1u)) >> 16; }
__device__ __forceinline__ unsigned pk2(float lo, float hi) { return f2bf(lo) | (f2bf(hi) << 16); }
#define LDS_WAIT() asm volatile("s_waitcnt lgkmcnt(0)" ::: "memory")
template <int CTRL> __device__ __forceinline__ float dppx(float x) { return __builtin_bit_cast(float, __builtin_amdgcn_update_dpp(0, __builtin_bit_cast(int, x), CTRL, 0xf, 0xf, true)); }
__device__ __forceinline__ float allreduce16(float x) { x += dppx<0xB1>(x); x += dppx<0x4E>(x); x += dppx<0x141>(x); x += dppx<0x140>(x); return x; }
__device__ __forceinline__ float wave_sum(float x) { x = allreduce16(x); x += __shfl_xor(x, 16); x += __shfl_xor(x, 32); return x; }
__device__ __forceinline__ float sigmoidf_(float x) { return __builtin_amdgcn_rcpf(1.0f + __expf(-x)); }

__device__ __forceinline__ int tr_rowmap(int mode, int j, int row0) {
    if (mode == 0) return row0 + j;
    if (mode == 1) return (j >> 7) * 256 + (j & 127);
    if (mode == 2) return (j >> 7) * 256 + 128 + (j & 127);
    const int g = j >> 10, d = j & 1023;
    const int pn = 4 * (d >> 8) + 2 * ((d >> 7) & 1) + ((d >> 4) & 1);
    return 256 * pn + 128 * (g >> 1) + 32 * ((d >> 5) & 3) + 16 * (g & 1) + 4 * ((d >> 2) & 3) + (d & 3);
}
__device__ __forceinline__ void tr_item(const float* W, int ldw, int K, int N, bf16_t* WT, int mode, int row0, const float* s1, const float* s2, int smode, LAS float* scr, int item, int lane) {
    const int nblk = N / 32, kb = item / nblk, nb = item % nblk, k0 = 64 * kb, n0 = 32 * nb;
#pragma unroll
    for (int i = 0; i < 8; ++i) { const int kk = 8 * i + (lane >> 3); const int k = k0 + kk; float sc = 1.0f;
        if (s1) sc = s1[k];
        if (smode == 1) sc *= s2[k]; else if (smode == 2) sc *= (1.0f - s2[k]);
        const f32x4 v = *(const f32x4*)(W + (size_t)k * ldw + n0 + 4 * (lane & 7)) * sc;
        LAS float* d = scr + kk * 33 + 4 * (lane & 7); d[0] = v[0]; d[1] = v[1]; d[2] = v[2]; d[3] = v[3]; }
    LDS_WAIT(); asm volatile("" ::: "memory");
    const int c = lane & 7;
#pragma unroll
    for (int j = 0; j < 4; ++j) { const int n = (lane >> 3) + 8 * j; const LAS float* s = scr + (8 * c) * 33 + n;
        u32x4 o; o.x = pk2(s[0 * 33], s[1 * 33]); o.y = pk2(s[2 * 33], s[3 * 33]); o.z = pk2(s[4 * 33], s[5 * 33]); o.w = pk2(s[6 * 33], s[7 * 33]);
        *(u32x4*)(WT + (size_t)tr_rowmap(mode, n0 + n, row0) * K + k0 + 8 * c) = o; }
    LDS_WAIT(); asm volatile("" ::: "memory");
}
#define TRJ(W_, ldw_, K_, N_, dst_, mode_, row0_, s1_, s2_, smode_) { const int ni_ = ((K_) / 64) * ((N_) / 32); if (r >= 0 && r < ni_) tr_item(W_, ldw_, K_, N_, dst_, mode_, row0_, s1_, s2_, smode_, scr, r, F.lane); r -= ni_; }
__device__ __forceinline__ void conv_first_half(Frame& F, int l) {
    LAS float* scr = (LAS float*)(F.lds + F.wave * 16384);
    const int gw = F.bx * NWAVES + F.wave, NGW = F.G * NWAVES;
    unsigned char* wb = F.ws + WS_W;
    const float* n1 = F.in[1] + (size_t)l * DM; const float* nm = F.in[5] + (size_t)l * DM; const float* mu = F.in[19] + (size_t)l * 3 * DM;
    const float* w1 = F.in[21] + (size_t)l * DM * 64; const float* a1 = F.in[24] + (size_t)l * DM * 64; const float* g1 = F.in[26] + (size_t)l * DM * 128;
    bf16_t* ina = (bf16_t*)(wb + W_INA);
    for (int it = gw;; it += NGW) { int r = it;
        TRJ(F.in[2] + (size_t)l * DM * FF, FF, DM, FF, (bf16_t*)(wb + W_GU1), 1, 0, n1, nullptr, 0)
        TRJ(F.in[3] + (size_t)l * DM * FF, FF, DM, FF, (bf16_t*)(wb + W_GU1), 2, 0, n1, nullptr, 0)
        TRJ(F.in[4] + (size_t)l * FF * DM, DM, FF, DM, (bf16_t*)(wb + W_D1), 0, 0, nullptr, nullptr, 0)
        TRJ(F.in[6] + (size_t)l * DM * INW, INW, DM, 2048, ina, 0, 0, nm, nullptr, 0)
        TRJ(w1, 64, DM, 64, ina, 0, 2048, nm, mu, 2)
        TRJ(a1, 64, DM, 64, ina, 0, 2112, nm, mu + DM, 2)
        TRJ(g1, 128, DM, 128, ina, 0, 2176, nm, mu + 2 * DM, 2)
        TRJ(w1, 64, DM, 64, ina, 0, 2304, nm, mu, 1)
        TRJ(a1, 64, DM, 64, ina, 0, 2368, nm, mu + DM, 1)
        TRJ(g1, 128, DM, 128, ina, 0, 2432, nm, mu + 2 * DM, 1)
        TRJ(F.in[22] + (size_t)l * 64 * 256, 256, 64, 256, (bf16_t*)(wb + W_L2), 0, 0, nullptr, nullptr, 0)
        TRJ(F.in[25] + (size_t)l * 64 * 256, 256, 64, 256, (bf16_t*)(wb + W_L2) + 256 * 64, 0, 0, nullptr, nullptr, 0)
        TRJ(F.in[27] + (size_t)l * 128 * 256, 256, 128, 256, (bf16_t*)(wb + W_L2) + 2 * 256 * 64, 0, 0, nullptr, nullptr, 0)
        TRJ(F.in[16] + ((size_t)l * 4 + 0) * 4096, 64, 64, 64, (bf16_t*)(wb + W_L2) + 4 * 256 * 64, 0, 0, nullptr, nullptr, 0)
        TRJ(F.in[16] + ((size_t)l * 4 + 1) * 4096, 64, 64, 64, (bf16_t*)(wb + W_L2) + 4 * 256 * 64, 0, 64, nullptr, nullptr, 0)
        TRJ(F.in[16] + ((size_t)l * 4 + 2) * 4096, 64, 64, 64, (bf16_t*)(wb + W_L2) + 4 * 256 * 64, 0, 128, nullptr, nullptr, 0)
        TRJ(F.in[16] + ((size_t)l * 4 + 3) * 4096, 64, 64, 64, (bf16_t*)(wb + W_L2) + 4 * 256 * 64, 0, 192, nullptr, nullptr, 0)
        if (r >= 0) break; }
}
__device__ __forceinline__ void conv_second_half(Frame& F, int l, int b0) {
    LAS float* scr = (LAS float*)(F.lds + F.wave * 16384);
    const int gw = (F.bx - b0) * NWAVES + F.wave, NGW = (F.G - b0) * NWAVES;
    unsigned char* wb = F.ws + WS_W;
    const float* nm = F.in[5] + (size_t)l * DM; const float* n2 = F.in[36] + (size_t)l * DM;
    for (int it = gw;; it += NGW) { int r = it;
        TRJ(F.in[6] + (size_t)l * DM * INW + 2048, INW, DM, 4096, (bf16_t*)(wb + W_ING), 3, 0, nm, nullptr, 0)
        TRJ(F.in[34] + (size_t)l * DM * DM, DM, DM, DM, (bf16_t*)(wb + W_BR), 0, 0, nullptr, nullptr, 0)
        TRJ(F.in[35] + (size_t)l * DM * DM, DM, DM, DM, (bf16_t*)(wb + W_O), 0, 0, nullptr, nullptr, 0)
        TRJ(F.in[37] + (size_t)l * DM * FF, FF, DM, FF, (bf16_t*)(wb + W_GU2), 1, 0, n2, nullptr, 0)
        TRJ(F.in[38] + (size_t)l * DM * FF, FF, DM, FF, (bf16_t*)(wb + W_GU2), 2, 0, n2, nullptr, 0)
        TRJ(F.in[39] + (size_t)l * FF * DM, DM, FF, DM, (bf16_t*)(wb + W_D2), 0, 0, nullptr, nullptr, 0)
        TRJ(F.in[15] + (size_t)l * 256 * 256, 256, 256, 256, (bf16_t*)(wb + W_GLU), 0, 0, nullptr, nullptr, 0)
        if (r >= 0) break; }
}
__device__ __forceinline__ void prep_x(Frame& F) {
    const int gw = F.bx * NWAVES + F.wave, NGW = F.G * NWAVES;
    const float* x = F.in[0];
    for (int m = gw; m < TT; m += NGW) {
        const f32x4* xr = (const f32x4*)(x + (size_t)m * DM) + F.lane; float s = 0.f;
        unsigned long long* o8 = (unsigned long long*)(F.B1 + (size_t)m * DM) + F.lane;
#pragma unroll
        for (int j = 0; j < 4; ++j) { const f32x4 v = xr[64 * j]; s += (v[0] * v[0] + v[1] * v[1]) + (v[2] * v[2] + v[3] * v[3]);
            o8[64 * j] = (unsigned long long)pk2(v[0], v[1]) | ((unsigned long long)pk2(v[2], v[3]) << 32); }
        s += __shfl_xor(s, 1); s += __shfl_xor(s, 2);
        if ((F.lane & 3) == 0) F.SS[(size_t)m * 16 + (F.lane >> 2)] = s;
    }
}
__device__ __forceinline__ void final_norm(Frame& F) {
    const int gw = F.bx * NWAVES + F.wave, NGW = F.G * NWAVES;
    const f32x4* gn = (const f32x4*)F.in[40] + F.lane;
    for (int m = gw; m < TT; m += NGW) {
        const float rs = pg8::row_rstd(F.SS, m);
        f32x4* xr = (f32x4*)(F.X + (size_t)m * DM) + F.lane;
#pragma unroll
        for (int j = 0; j < 4; ++j) { const f32x4 v = xr[64 * j]; xr[64 * j] = v * rs * gn[64 * j]; }
    }
}

struct S5Par { float ar, ai; float bbr[16], bbi[16]; };
__device__ __forceinline__ void s5_params(Frame& F, int l, int g, int p, S5Par& P) {
    asm volatile("" : "+v"(p));
    const float lr = F.in[7][((size_t)l * 16 + g) * 64 + p], li = F.in[8][((size_t)l * 16 + g) * 64 + p], dt = expf(F.in[9][l * 16 + g]);
    const float mag = expf(lr * dt); P.ar = mag * cosf(li * dt); P.ai = mag * sinf(li * dt);
    const float inv = 1.0f / (lr * lr + li * li); const float qr = lr * inv, qi = -li * inv;
    const float cr = (P.ar - 1.0f) * qr - P.ai * qi, ci = (P.ar - 1.0f) * qi + P.ai * qr;
    const f32x4* br = (const f32x4*)(F.in[10] + (((size_t)l * 16 + g) * 64 + p) * 16); const f32x4* bi = (const f32x4*)(F.in[11] + (((size_t)l * 16 + g) * 64 + p) * 16);
#pragma unroll
    for (int q = 0; q < 4; ++q) { const f32x4 a = br[q], b = bi[q];
#pragma unroll
        for (int i = 0; i < 4; ++i) { P.bbr[4 * q + i] = cr * a[i] - ci * b[i]; P.bbi[4 * q + i] = cr * b[i] + ci * a[i]; } }
}
__device__ __forceinline__ void s5_step(const S5Par& P, const LAS float* urow, float& hr, float& hi) {
    const LAS f32x4* u4 = (const LAS f32x4*)urow; float bur = 0.f, bui = 0.f;
#pragma unroll
    for (int q = 0; q < 4; ++q) { const f32x4 u = u4[q];
#pragma unroll
        for (int i = 0; i < 4; ++i) { bur += P.bbr[4 * q + i] * u[i]; bui += P.bbi[4 * q + i] * u[i]; } }
    const float nr = P.ar * hr - P.ai * hi + bur, ni = P.ar * hi + P.ai * hr + bui; hr = nr; hi = ni;
}
__device__ __forceinline__ void load_u5_tile(Frame& F, int t0, LAS float* ubuf) {
    for (int i = F.tid; i < 64 * 64; i += NTHR) { const int t = i >> 6, q = i & 63; const h16x4 v = *(const h16x4*)(F.U5 + (size_t)(t0 + t) * 256 + 4 * q);
        f32x4 f; f[0] = (float)v[0]; f[1] = (float)v[1]; f[2] = (float)v[2]; f[3] = (float)v[3]; *(LAS f32x4*)(ubuf + t * 256 + 4 * q) = f; }
}


template <bool FIRST> __device__ __forceinline__ void mv32(LAS float* accp, float init, const LAS float* hb, const float* wsrc, int ldw) {
    float w[32];
    asm volatile("" : "+v"(wsrc));
#pragma unroll
    for (int j = 0; j < 32; ++j) w[j] = wsrc[(size_t)j * ldw];
#pragma unroll 2
    for (int tt = 0; tt < 32; ++tt) { const LAS f32x4* h4 = (const LAS f32x4*)(hb + tt * 256); float a = FIRST ? init : accp[tt * 256];
#pragma unroll
        for (int q = 0; q < 8; ++q) { const f32x4 v = h4[q]; a += v[0] * w[4 * q] + v[1] * w[4 * q + 1] + v[2] * w[4 * q + 2] + v[3] * w[4 * q + 3]; }
        accp[tt * 256] = a; }
}
template <int K> __device__ __forceinline__ void lora_mfma(const LAS unsigned short* hb16, int kofs, const bf16_t* Wt, LAS float* outb, int wave, int lane) {
    typedef short bf16x8_t __attribute__((ext_vector_type(8)));
    const int r16 = lane & 15, quad = lane >> 4;
    f32x4 acc[4][2];
#pragma unroll
    for (int rt = 0; rt < 4; ++rt)
#pragma unroll
        for (int ct = 0; ct < 2; ++ct) acc[rt][ct] = (f32x4){0.f, 0.f, 0.f, 0.f};
    bf16x8_t bfr[K / 32][2];
#pragma unroll
    for (int ks = 0; ks < K / 32; ++ks)
#pragma unroll
        for (int ct = 0; ct < 2; ++ct) bfr[ks][ct] = *(const bf16x8_t*)(Wt + (size_t)(wave * 32 + ct * 16 + r16) * K + ks * 32 + quad * 8);
#pragma unroll
    for (int ks = 0; ks < K / 32; ++ks)
#pragma unroll
        for (int rt = 0; rt < 4; ++rt) { const bf16x8_t a = *(const LAS bf16x8_t*)(hb16 + (rt * 16 + r16) * 264 + kofs + ks * 32 + quad * 8);
#pragma unroll
            for (int ct = 0; ct < 2; ++ct) acc[rt][ct] = __builtin_amdgcn_mfma_f32_16x16x32_bf16(a, bfr[ks][ct], acc[rt][ct], 0, 0, 0); }
#pragma unroll
    for (int rt = 0; rt < 4; ++rt)
#pragma unroll
        for (int ct = 0; ct < 2; ++ct)
#pragma unroll
            for (int j = 0; j < 4; ++j) outb[(rt * 16 + quad * 4 + j) * 256 + wave * 32 + ct * 16 + r16] = acc[rt][ct][j];
}
__device__ __forceinline__ void m1_phase(Frame& F, int l) {
    LAS float* ubuf = (LAS float*)F.lds;
    LAS float* pl = (LAS float*)(F.lds + 65536);
    const int tid = F.tid, lane = F.lane, wave = F.wave;
    const int ch = tid & 255, half = tid >> 8;
    for (int c = F.bx; c < TT / 64; c += F.G) {
        const int t0 = c * 64, tb = t0 + half * 32, sb = tb & (SEQ - 1);
        load_u5_tile(F, t0, ubuf);
        __syncthreads();
#pragma unroll 1
        for (int gi = 0; gi < 2; ++gi) { const int g = wave + 8 * gi; S5Par P; s5_params(F, l, g, lane, P); float hr = 0.f, hi = 0.f;
#pragma unroll 2
            for (int j = 0; j < 64; ++j) s5_step(P, ubuf + j * 256 + g * 16, hr, hi);
            *(f32x2*)(F.E + (((size_t)c * 16 + g) * 64 + lane) * 2) = (f32x2){hr, hi}; }
        __syncthreads();
        LAS float* accp = pl + half * 32 * 256 + ch;
        LAS unsigned short* hb16 = (LAS unsigned short*)F.lds;
        const bf16_t* l2w = (const bf16_t*)(F.ws + WS_W + W_L2);
        h16 la[32], lb[32];
#pragma unroll
        for (int tt = 0; tt < 32; ++tt) { const int t = tb + tt; la[tt] = F.L16[(size_t)t * 512 + ch]; lb[tt] = (sb + tt > 0) ? F.L16[(size_t)(t - 1) * 512 + 256 + ch] : (h16)0.f; }
#pragma unroll
        for (int tt = 0; tt < 32; ++tt) { float pre = (float)la[tt] + (float)lb[tt];
            float a = pre; if (ch < 64) a = 1.0f - 2.0f * __builtin_amdgcn_rcpf(1.0f + __expf(2.0f * pre)); else if (ch >= 128) a = sigmoidf_(pre);
            hb16[(half * 32 + tt) * 264 + ch] = (unsigned short)f2bf(a); }
        __syncthreads();
        const int hb = (t0 / SEQ) * 4 + (ch >> 6);
        unsigned char* rwb = F.RW + ((size_t)hb * SEQ + sb) * 896;
        const int cl = ch & 63;
        {
            lora_mfma<64>(hb16, 0, l2w, pl, wave, lane);
            __syncthreads();
            const float w0 = F.in[20][(size_t)l * 256 + ch];
#pragma unroll 2
            for (int tt = 0; tt < 32; ++tt) { const float z = -(accp[tt * 256] + w0); const float sp = fmaxf(z, 0.f) + __logf(1.0f + __expf(-fabsf(z)));
                const float wlog = -sp - 0.5f; const float dec = __expf(-__expf(wlog));
                *(float*)(rwb + (size_t)tt * 896 + cl * 4) = dec; }
        }
        {
            __syncthreads();
            lora_mfma<128>(hb16, 128, l2w + 2 * 256 * 64, pl, wave, lane);
            __syncthreads();
#pragma unroll 4
            for (int tt = 0; tt < 32; ++tt) F.G16[(size_t)(tb + tt) * 256 + ch] = (h16)accp[tt * 256];
        }
        {
            __syncthreads();
            lora_mfma<64>(hb16, 64, l2w + 256 * 64, pl, wave, lane);
            __syncthreads();
            const float a0 = F.in[23][(size_t)l * 256 + ch];
            const float mur = F.in[18][((size_t)l * 3 + 0) * 256 + ch], muk = F.in[18][((size_t)l * 3 + 1) * 256 + ch], muv = F.in[18][((size_t)l * 3 + 2) * 256 + ch];
            const float kkw = F.in[28][(size_t)l * 256 + ch], kaw = F.in[29][(size_t)l * 256 + ch];
            const h16* pp = F.PP + (size_t)tb * 1792 + 256 + ch;
            float rprev = 0.f, kprev = 0.f, vprev = 0.f;
            if (sb > 0) { rprev = (float)pp[-(ptrdiff_t)1792]; kprev = (float)pp[-(ptrdiff_t)1792 + 256]; vprev = (float)pp[-(ptrdiff_t)1792 + 512]; }
#pragma unroll 1
            for (int t16 = 0; t16 < 32; t16 += 16) {
                h16 rq[16], kq[16], vq[16];
#pragma unroll
                for (int tt = 0; tt < 16; ++tt) { const h16* q = pp + (size_t)(t16 + tt) * 1792; rq[tt] = q[0]; kq[tt] = q[256]; vq[tt] = q[512]; }
#pragma unroll
                for (int tt = 0; tt < 16; ++tt) { const float a = sigmoidf_(accp[(t16 + tt) * 256] + a0);
                    const float rp = (float)rq[tt], kp = (float)kq[tt], vp = (float)vq[tt];
                    const float r = rp + (rprev - rp) * mur, k = kp + (kprev - kp) * muk, v = vp + (vprev - vp) * muv;
                    rprev = rp; kprev = kp; vprev = vp;
                    const float kkv = k * kkw; const float kk = kkv * rsqrtf(fmaxf(wave_sum(kkv * kkv), 1e-24f));
                    const float kt = k * (1.0f + (a - 1.0f) * kaw); const float bb = kk * a;
                    h16* o = (h16*)(rwb + (size_t)(t16 + tt) * 896 + 256) + cl;
                    o[0] = (h16)r; o[64] = (h16)kt; o[128] = (h16)v; o[192] = (h16)kk; o[256] = (h16)bb; } }
        }
        __syncthreads();
    }
}

__device__ __forceinline__ void pool_conv_chunk(Frame& F, int l, int c) {
    LAS float* ubuf = (LAS float*)F.lds;
    LAS unsigned short* pb16 = (LAS unsigned short*)(F.lds + 65536);
    const int tid = F.tid; const int ch = tid & 255, half = tid >> 8;
    const int t0 = c * 64, tb = t0 + half * 32, sb = tb & (SEQ - 1);
    {
    {
        const int grp = ch >> 6, win = 2 << grp;
        const h16* up = F.PP + (size_t)tb * 1792 + ch;
        float s = 0.f;
        for (int j = 1; j <= win; ++j) if (sb - j >= 0) s += (float)up[-(ptrdiff_t)j * 1792];
#pragma unroll 1
        for (int t16 = 0; t16 < 32; t16 += 16) {
            h16 uq[16], ul[16];
#pragma unroll
            for (int tt = 0; tt < 16; ++tt) { uq[tt] = up[(size_t)(t16 + tt) * 1792]; ul[tt] = (sb + t16 + tt - win >= 0) ? up[(ptrdiff_t)(t16 + tt - win) * 1792] : (h16)0.f; }
#pragma unroll
            for (int tt = 0; tt < 16; ++tt) { const float u = (float)uq[tt]; s += u; const int pos = sb + t16 + tt;
                s -= (float)ul[tt];
                const float cnt = (float)((pos + 1 < win) ? (pos + 1) : win);
                pb16[(half * 32 + t16 + tt) * 264 + ch] = (unsigned short)f2bf(s / cnt - u); } }
    }
    {
        const h16* zp = F.PP + (size_t)tb * 1792 + 1024 + ch;
        const float cw0 = F.in[33][((size_t)l * 3 + 0) * 256 + ch], cw1 = F.in[33][((size_t)l * 3 + 1) * 256 + ch], cw2 = F.in[33][((size_t)l * 3 + 2) * 256 + ch];
        float z2 = 0.f, z1 = 0.f;
        if (sb >= 1) z1 = (float)zp[-(ptrdiff_t)1792 + 512] * (float)zp[-(ptrdiff_t)1792];
        if (sb >= 2) z2 = (float)zp[-(ptrdiff_t)2 * 1792 + 512] * (float)zp[-(ptrdiff_t)2 * 1792];
#pragma unroll 1
        for (int t16 = 0; t16 < 32; t16 += 16) {
            h16 zx[16], zb[16], zc[16];
#pragma unroll
            for (int tt = 0; tt < 16; ++tt) { const h16* q = zp + (size_t)(t16 + tt) * 1792; zx[tt] = q[0]; zb[tt] = q[256]; zc[tt] = q[512]; }
#pragma unroll
            for (int tt = 0; tt < 16; ++tt) { const float z0 = (float)zc[tt] * (float)zx[tt];
                const float y = (float)zb[tt] * (cw0 * z2 + cw1 * z1 + cw2 * z0);
                F.B2[(size_t)(tb + t16 + tt) * 1024 + 768 + ch] = (bf16_t)f2bf(y); z2 = z1; z1 = z0; } }
    }
    __syncthreads();
    LAS float* accu = ubuf + half * 32 * 256 + ch;
    {
        lora_mfma<64>(pb16, (F.wave >> 1) * 64, (const bf16_t*)(F.ws + WS_W + W_L2) + 4 * 256 * 64, ubuf, F.wave, F.lane);
        __syncthreads();
        const float sc = F.in[17][(size_t)l * 256 + ch];
#pragma unroll 4
        for (int tt = 0; tt < 32; ++tt) F.B2[(size_t)(tb + tt) * 1024 + 256 + ch] = (bf16_t)f2bf(accu[tt * 256] * sc);
    }
    __syncthreads();
    }
}

#define XB_TMO      128
#define XB_XCNT(j)  (256  + 64 * (j))
#define XB_XSUB(j)  (1280 + 64 * (j))
#define XB_XGEN(j)  (2304 + 64 * (j))
#define XB_TOP      3328
#define XB_TOPGEN   3392
#define XCD_BAR_WORDS 3456
#define XB_SPIN_CAP (1u << 18)

__device__ __forceinline__ unsigned xb_ld(unsigned* p)              { return __hip_atomic_load(p, __ATOMIC_RELAXED, __HIP_MEMORY_SCOPE_AGENT); }
__device__ __forceinline__ unsigned xb_add(unsigned* p, unsigned v) { return __hip_atomic_fetch_add(p, v, __ATOMIC_RELAXED, __HIP_MEMORY_SCOPE_AGENT); }
__device__ __forceinline__ unsigned xb_xcc_id() { return (unsigned)__builtin_amdgcn_s_getreg((3 << 11) | 20) & 0xFu; }
#define XB_SPIN(cond, bar) do { unsigned _sp = 0; while (cond) { __builtin_amdgcn_s_sleep(1); \
    if ((++_sp & 255u) == 0u) { if (xb_ld(&(bar)[XB_TMO])) break; if (_sp > XB_SPIN_CAP) { atomicAdd(&(bar)[XB_TMO], 1u); break; } } } } while (0)

struct XcdBarrier {
    unsigned* bar; unsigned x;
    volatile LAS unsigned* st;
};

__device__ __forceinline__ XcdBarrier xcd_barrier_post(unsigned* bar, volatile LAS unsigned* st) {
    XcdBarrier b; b.bar = bar; b.x = xb_xcc_id(); b.st = st;
    if (threadIdx.x == 0) (void)xb_add(&bar[XB_XCNT(b.x)], 1u);
    return b;
}
__device__ __forceinline__ void xcd_barrier_complete(unsigned* bar, unsigned x, unsigned& nloc, unsigned& nx) {
    const unsigned G = gridDim.x * gridDim.y * gridDim.z;
    unsigned sum, cnt, mine, sp = 0u;
    for (;;) {
        sum = 0u; cnt = 0u; mine = 0u;
#pragma unroll
        for (unsigned j = 0; j < 16; ++j) { const unsigned c = xb_ld(&bar[XB_XCNT(j)]); sum += c; cnt += (c > 0u) ? 1u : 0u; mine = (j == x) ? c : mine; }
        if (sum == G) break;
        __builtin_amdgcn_s_sleep(1);
        if ((++sp & 255u) == 0u) { if (xb_ld(&bar[XB_TMO])) break; if (sp > XB_SPIN_CAP) { atomicAdd(&bar[XB_TMO], 1u); break; } }
    }
    nloc = mine > 0u ? mine : 1u; nx = cnt > 0u ? cnt : 1u;
}

__device__ __forceinline__ void xcd_barrier(const XcdBarrier& b) {
    asm volatile("s_waitcnt vmcnt(0)" ::: "memory");
    __syncthreads();
    if (threadIdx.x == 0) {
        unsigned* bar = b.bar;
        __builtin_amdgcn_s_waitcnt(0);
        unsigned nloc = b.st[0], nx = b.st[1];
        if (nloc == 0u) { xcd_barrier_complete(bar, b.x, nloc, nx); b.st[0] = nloc; b.st[1] = nx; }
        const unsigned old = xb_add(&bar[XB_XSUB(b.x)], 1u);
        const unsigned gen = old / nloc;
        if (old + 1u == (gen + 1u) * nloc) {
            __builtin_amdgcn_fence(__ATOMIC_RELEASE, "agent");
            asm volatile("s_waitcnt vmcnt(0)" ::: "memory");
            const unsigned og = xb_add(&bar[XB_TOP], 1u);
            const unsigned tg = og / nx;
            if (og + 1u == (tg + 1u) * nx) xb_add(&bar[XB_TOPGEN], 1u);
            else XB_SPIN(xb_ld(&bar[XB_TOPGEN]) == tg, bar);
            __builtin_amdgcn_fence(__ATOMIC_ACQUIRE, "agent");
            xb_add(&bar[XB_XGEN(b.x)], 1u);
            asm volatile("s_waitcnt vmcnt(0)" ::: "memory");
        } else {
            XB_SPIN(xb_ld(&bar[XB_XGEN(b.x)]) == gen, bar);
            __builtin_amdgcn_fence(__ATOMIC_ACQUIRE, "agent");
            asm volatile("s_waitcnt vmcnt(0)" ::: "memory");
        }
    }
    __syncthreads();
}

__device__ __forceinline__ float a_fma(float a, float b, float c) { float d; asm("v_fma_f32 %0, %1, %2, %3" : "=v"(d) : "v"(a), "v"(b), "v"(c)); return d; }
__device__ __forceinline__ float a_fnma(float a, float b, float c) { float d; asm("v_fma_f32 %0, -%1, %2, %3" : "=v"(d) : "v"(a), "v"(b), "v"(c)); return d; }
__device__ __forceinline__ float a_mul(float a, float b) { float d; asm("v_mul_f32 %0, %1, %2" : "=v"(d) : "v"(a), "v"(b)); return d; }
__device__ __forceinline__ float a_add(float a, float b) { float d; asm("v_add_f32 %0, %1, %2" : "=v"(d) : "v"(a), "v"(b)); return d; }
constexpr int RC_LEN = 256, RC_N = SEQ / RC_LEN;
constexpr int ST_STEPS = 16, ST_FL = ST_STEPS * 384, ST_NPC = ST_STEPS * 56, ST_OB = ST_STEPS * 32 * 16, ST_NSUB = RC_LEN / ST_STEPS;
__device__ __forceinline__ void st_load(const unsigned char* src, int sub, int tid, u32x4 (&rg)[2]) {
#pragma unroll
    for (int n = 0; n < 2; ++n) { const int i = tid + NTHR * n; if (i < ST_NPC) { const int step = i / 56, j = i % 56;
        rg[n] = *(const u32x4*)(src + ((size_t)sub * ST_STEPS + step) * 896 + (j < 16 ? j * 16 : 256 + (j - 16) * 16)); } }
}
__device__ __forceinline__ void st_store(LAS float* buf, int tid, const u32x4 (&rg)[2]) {
#pragma unroll
    for (int n = 0; n < 2; ++n) { const int i = tid + NTHR * n; if (i < ST_NPC) { const int step = i / 56, j = i % 56;
        if (j < 16) { *(LAS u32x4*)(buf + step * 384 + j * 4) = rg[n]; }
        else { const int a = (j - 16) >> 3, e = (j - 16) & 7; const h16x8 h = __builtin_bit_cast(h16x8, rg[n]); f32x4 lo, hi;
            lo[0] = (float)h[0]; lo[1] = (float)h[1]; lo[2] = (float)h[2]; lo[3] = (float)h[3]; hi[0] = (float)h[4]; hi[1] = (float)h[5]; hi[2] = (float)h[6]; hi[3] = (float)h[7];
            LAS f32x4* d = (LAS f32x4*)(buf + step * 384 + 64 + a * 64 + e * 8); d[0] = lo; d[1] = hi; } } }
}
#define RAW_BAR() do { asm volatile("s_waitcnt lgkmcnt(0)" ::: "memory"); __builtin_amdgcn_s_barrier(); asm volatile("" ::: "memory"); } while (0)
#define DPP_ADD(x_, ctl_) "v_add_f32_dpp %[" x_ "], %[" x_ "], %[" x_ "] " ctl_ " row_mask:0xf bank_mask:0xf bound_ctrl:1\n\t"
template <bool OUT> __device__ __forceinline__ void scan_task(Frame& F, const unsigned char* src, const float* initS, bool ident, bool use_v, float* endS, float* Og) {
    constexpr int STS = OUT ? 8 : 16, NSUB = RC_LEN / STS, FL = STS * 384, NPC = STS * 56, PT = (NPC + NTHR - 1) / NTHR, OB = STS * 64 * 16;
    LAS float* buf = (LAS float*)F.lds;
    LAS float* obuf = (LAS float*)(F.lds + 2 * FL * 4);
    const int tid = F.tid, wave = F.wave, lane = F.lane, ks = lane & 15;
    int rowr[2]; float S[2][4];
#pragma unroll
    for (int r = 0; r < 2; ++r) { rowr[r] = (wave * 2 + r) * 4 + (lane >> 4);
        if (initS) { const f32x4 i4 = *(const f32x4*)(initS + (size_t)rowr[r] * 64 + 4 * ks); S[r][0] = i4[0]; S[r][1] = i4[1]; S[r][2] = i4[2]; S[r][3] = i4[3]; }
        else {
#pragma unroll
            for (int e = 0; e < 4; ++e) S[r][e] = (ident && 4 * ks + e == rowr[r]) ? 1.f : 0.f; } }
    u32x4 rg[2][PT];
#define ST_LOAD(sub_, rg_) do { _Pragma("unroll") for (int n_ = 0; n_ < PT; ++n_) { const int i_ = tid + NTHR * n_; if (i_ < NPC) { const int step_ = i_ / 56, j_ = i_ % 56; \
        rg_[n_] = *(const u32x4*)(src + ((size_t)(sub_) * STS + step_) * 896 + (j_ < 16 ? j_ * 16 : 256 + (j_ - 16) * 16)); } } } while (0)
#define ST_STORE(buf_, rg_) do { _Pragma("unroll") for (int n_ = 0; n_ < PT; ++n_) { const int i_ = tid + NTHR * n_; if (i_ < NPC) { const int step_ = i_ / 56, j_ = i_ % 56; \
        if (j_ < 16) { *(LAS u32x4*)((buf_) + step_ * 384 + j_ * 4) = rg_[n_]; } \
        else { const int a_ = (j_ - 16) >> 3, e_ = (j_ - 16) & 7; const h16x8 h_ = __builtin_bit_cast(h16x8, rg_[n_]); f32x4 lo_, hi_; \
            lo_[0] = (float)h_[0]; lo_[1] = (float)h_[1]; lo_[2] = (float)h_[2]; lo_[3] = (float)h_[3]; hi_[0] = (float)h_[4]; hi_[1] = (float)h_[5]; hi_[2] = (float)h_[6]; hi_[3] = (float)h_[7]; \
            LAS f32x4* d_ = (LAS f32x4*)((buf_) + step_ * 384 + 64 + a_ * 64 + e_ * 8); d_[0] = lo_; d_[1] = hi_; } } } } while (0)
    ST_LOAD(0, rg[0]); ST_STORE(buf, rg[0]); ST_LOAD(1, rg[1]); ST_LOAD(2, rg[0]);
    RAW_BAR();
#pragma unroll 1
    for (int sc2 = 0; sc2 < NSUB; sc2 += 2) {
#pragma unroll
      for (int u = 0; u < 2; ++u) { const int sc = sc2 + u;
        if (sc + 1 < NSUB) { ST_STORE(buf + ((sc + 1) & 1) * FL, rg[(u + 1) & 1]); if (sc + 3 < NSUB) ST_LOAD(sc + 3, rg[(u + 1) & 1]); }
        {
            const LAS float* bb = buf + (sc & 1) * FL + 4 * ks; const LAS float* vb0 = buf + (sc & 1) * FL + 192 + rowr[0]; const LAS float* vb1 = buf + (sc & 1) * FL + 192 + rowr[1];
            LAS float* ob0 = obuf + (sc & 1) * OB + rowr[0] * 16 + ks; LAS float* ob1 = obuf + (sc & 1) * OB + rowr[1] * 16 + ks;
            f32x4 w_[2], r_[2], k_[2], kk_[2], b_[2]; float v_[2][2];
#define SC_LD(s_, j_) do { const LAS float* p_ = bb + (s_) * 384; w_[j_] = *(const LAS f32x4*)(p_); if (OUT) r_[j_] = *(const LAS f32x4*)(p_ + 64); k_[j_] = *(const LAS f32x4*)(p_ + 128); \
                kk_[j_] = *(const LAS f32x4*)(p_ + 256); b_[j_] = *(const LAS f32x4*)(p_ + 320); v_[j_][0] = vb0[(s_) * 384]; v_[j_][1] = vb1[(s_) * 384]; } while (0)
            SC_LD(0, 0);
#pragma unroll
            for (int s = 0; s < STS; ++s) { const int j = s & 1;
                f32x4 rp; if (OUT) rp = r_[j ^ 1];
                if (s + 1 < STS) SC_LD(s + 1, j ^ 1);
                const f32x4 w = w_[j], k = k_[j], kk = kk_[j], bv = b_[j];
#pragma unroll
                for (int r = 0; r < 2; ++r) { const float v = use_v ? v_[j][r] : 0.f;
                    float sa, op, u0, u1, u2, u3;
                    if (OUT && s > 0) {
                        asm volatile(
                            "v_mul_f32 %[sa], %[Sa], %[kk0]\n\t" "v_fma_f32 %[sa], %[Sb], %[kk1], %[sa]\n\t" "v_fma_f32 %[sa], %[Sc], %[kk2], %[sa]\n\t" "v_fma_f32 %[sa], %[Sd], %[kk3], %[sa]\n\t"
                            "v_mul_f32 %[op], %[Sa], %[r0]\n\t" "v_fma_f32 %[op], %[Sb], %[r1], %[op]\n\t"
                            DPP_ADD("sa", "quad_perm:[1,0,3,2]") "v_fma_f32 %[op], %[Sc], %[r2], %[op]\n\t" "v_fma_f32 %[op], %[Sd], %[r3], %[op]\n\t"
                            DPP_ADD("sa", "quad_perm:[2,3,0,1]") "v_mul_f32 %[u0], %[v], %[k0]\n\t" "v_mul_f32 %[u1], %[v], %[k1]\n\t"
                            DPP_ADD("sa", "row_half_mirror") "v_mul_f32 %[u2], %[v], %[k2]\n\t" "v_mul_f32 %[u3], %[v], %[k3]\n\t"
                            DPP_ADD("sa", "row_mirror")
                            : [sa] "=&v"(sa), [op] "=&v"(op), [u0] "=&v"(u0), [u1] "=&v"(u1), [u2] "=&v"(u2), [u3] "=&v"(u3)
                            : [Sa] "v"(S[r][0]), [Sb] "v"(S[r][1]), [Sc] "v"(S[r][2]), [Sd] "v"(S[r][3]), [kk0] "v"(kk[0]), [kk1] "v"(kk[1]), [kk2] "v"(kk[2]), [kk3] "v"(kk[3]),
                              [r0] "v"(rp[0]), [r1] "v"(rp[1]), [r2] "v"(rp[2]), [r3] "v"(rp[3]), [v] "v"(v), [k0] "v"(k[0]), [k1] "v"(k[1]), [k2] "v"(k[2]), [k3] "v"(k[3]));
                        (r == 0 ? ob0 : ob1)[(s - 1) * 1024] = op;
                    } else {
                        asm volatile(
                            "v_mul_f32 %[sa], %[Sa], %[kk0]\n\t" "v_fma_f32 %[sa], %[Sb], %[kk1], %[sa]\n\t" "v_fma_f32 %[sa], %[Sc], %[kk2], %[sa]\n\t" "v_fma_f32 %[sa], %[Sd], %[kk3], %[sa]\n\t"
                            "v_mul_f32 %[u0], %[v], %[k0]\n\t" "v_mul_f32 %[u1], %[v], %[k1]\n\t"
                            DPP_ADD("sa", "quad_perm:[1,0,3,2]") "v_mul_f32 %[u2], %[v], %[k2]\n\t" "v_mul_f32 %[u3], %[v], %[k3]\n\t"
                            DPP_ADD("sa", "quad_perm:[2,3,0,1]") "s_nop 1\n\t"
                            DPP_ADD("sa", "row_half_mirror") "s_nop 1\n\t"
                            DPP_ADD("sa", "row_mirror")
                            : [sa] "=&v"(sa), [u0] "=&v"(u0), [u1] "=&v"(u1), [u2] "=&v"(u2), [u3] "=&v"(u3)
                            : [Sa] "v"(S[r][0]), [Sb] "v"(S[r][1]), [Sc] "v"(S[r][2]), [Sd] "v"(S[r][3]), [kk0] "v"(kk[0]), [kk1] "v"(kk[1]), [kk2] "v"(kk[2]), [kk3] "v"(kk[3]),
                              [v] "v"(v), [k0] "v"(k[0]), [k1] "v"(k[1]), [k2] "v"(k[2]), [k3] "v"(k[3]));
                    }
                    asm volatile(
                        "v_fma_f32 %[u0], -%[sa], %[b0], %[u0]\n\t" "v_fma_f32 %[u1], -%[sa], %[b1], %[u1]\n\t" "v_fma_f32 %[u2], -%[sa], %[b2], %[u2]\n\t" "v_fma_f32 %[u3], -%[sa], %[b3], %[u3]\n\t"
                        "v_fma_f32 %[Sa], %[Sa], %[w0], %[u0]\n\t" "v_fma_f32 %[Sb], %[Sb], %[w1], %[u1]\n\t" "v_fma_f32 %[Sc], %[Sc], %[w2], %[u2]\n\t" "v_fma_f32 %[Sd], %[Sd], %[w3], %[u3]\n\t"
                        : [Sa] "+v"(S[r][0]), [Sb] "+v"(S[r][1]), [Sc] "+v"(S[r][2]), [Sd] "+v"(S[r][3]), [u0] "+v"(u0), [u1] "+v"(u1), [u2] "+v"(u2), [u3] "+v"(u3)
                        : [sa] "v"(sa), [b0] "v"(bv[0]), [b1] "v"(bv[1]), [b2] "v"(bv[2]), [b3] "v"(bv[3]), [w0] "v"(w[0]), [w1] "v"(w[1]), [w2] "v"(w[2]), [w3] "v"(w[3])); }
                __builtin_amdgcn_sched_barrier(0); }
            if (OUT) { const f32x4 r4 = r_[(STS - 1) & 1];
              ob0[(STS - 1) * 1024] = a_fma(S[0][3], r4[3], a_fma(S[0][2], r4[2], a_fma(S[0][1], r4[1], a_mul(S[0][0], r4[0]))));
              ob1[(STS - 1) * 1024] = a_fma(S[1][3], r4[3], a_fma(S[1][2], r4[2], a_fma(S[1][1], r4[1], a_mul(S[1][0], r4[0])))); }
#undef SC_LD
        }
        RAW_BAR();
        if (OUT) {
            const LAS f32x4* p = (const LAS f32x4*)(obuf + (sc & 1) * OB + tid * 16); const f32x4 a = p[0], b = p[1], c = p[2], d = p[3];
            const float o = (((a[0] + a[1]) + (a[2] + a[3])) + ((b[0] + b[1]) + (b[2] + b[3]))) + (((c[0] + c[1]) + (c[2] + c[3])) + ((d[0] + d[1]) + (d[2] + d[3])));
            Og[((size_t)sc * STS + (tid >> 6)) * 256 + (tid & 63)] = o; }
      }
    }
#undef ST_LOAD
#undef ST_STORE
    if (endS) {
#pragma unroll
        for (int r = 0; r < 2; ++r) *(f32x4*)(endS + (size_t)rowr[r] * 64 + 4 * ks) = (f32x4){S[r][0], S[r][1], S[r][2], S[r][3]}; }
    RAW_BAR();
}
#undef DPP_ADD
__device__ __forceinline__ void rwkv_carry(Frame& F) {
    const int hb = F.bx >> 3, row = (F.bx & 7) * 8 + F.wave, lane = F.lane, tid = F.tid;
    LAS float* Pl = (LAS float*)F.lds;
    LAS float* Sl = (LAS float*)(F.lds + 32768) + F.wave * 64;
    float S = 0.f;
    const size_t m0 = (size_t)hb * RC_N * 4096;
    f32x4 p0 = *(const f32x4*)(F.PB + m0 + (size_t)tid * 8), p1 = *(const f32x4*)(F.PB + m0 + (size_t)tid * 8 + 4);
    float lc = F.LB[m0 + (size_t)row * 64 + lane];
#pragma unroll 1
    for (int c = 0; c < RC_N; ++c) { const size_t mo = m0 + (size_t)c * 4096; LAS float* Pc = Pl + (c & 1) * 4096;
        F.SB[mo + (size_t)row * 64 + lane] = S;
        if (c + 1 == RC_N) break;
        float acc = lc;
        *(LAS f32x4*)(Pc + tid * 8) = p0; *(LAS f32x4*)(Pc + tid * 8 + 4) = p1; Sl[lane] = S;
        if (c + 2 < RC_N) { p0 = *(const f32x4*)(F.PB + mo + 4096 + (size_t)tid * 8); p1 = *(const f32x4*)(F.PB + mo + 4096 + (size_t)tid * 8 + 4); lc = F.LB[mo + 4096 + (size_t)row * 64 + lane]; }
        RAW_BAR();
        float a0 = 0.f, a1 = 0.f, a2 = 0.f, a3 = 0.f;
#pragma unroll 4
        for (int j = 0; j < 64; j += 4) { const f32x4 s4 = *(const LAS f32x4*)(Sl + j);
            a0 += s4[0] * Pc[(j + 0) * 64 + lane]; a1 += s4[1] * Pc[(j + 1) * 64 + lane]; a2 += s4[2] * Pc[(j + 2) * 64 + lane]; a3 += s4[3] * Pc[(j + 3) * 64 + lane]; }
        S = acc + ((a0 + a1) + (a2 + a3));
    }
    __syncthreads();
}
__device__ __forceinline__ float gelu_tanh(float x) { const float u = 0.7978845608028654f * (x + 0.044715f * x * x * x); return 0.5f * x * (1.0f + tanhf(u)); }
__device__ __forceinline__ void s5_pass2(Frame& F, int l, int c) {
    typedef short bf16x8_t __attribute__((ext_vector_type(8)));
    LAS float* ubuf = (LAS float*)F.lds;
    const int t0 = c * 64, lane = F.lane, wave = F.wave, cb0 = c & ~127;
    LAS unsigned short* hb = (LAS unsigned short*)(F.lds + 65536) + wave * (16 * 136);
    load_u5_tile(F, t0, ubuf);
    __syncthreads();
    const int r16 = lane & 15, quad = lane >> 4;
#pragma unroll 1
    for (int gi = 0; gi < 2; ++gi) { const int g = wave + 8 * gi; S5Par P; s5_params(F, l, g, lane, P);
        int lane_l = lane; asm volatile("" : "+v"(lane_l));
        bf16x8_t cf[4];
#pragma unroll
        for (int ks = 0; ks < 4; ++ks) { const float* src = (ks < 2 ? F.in[12] : F.in[13]) + (((size_t)l * 16 + g) * 16 + (lane_l & 15)) * 64 + (ks & 1) * 32 + quad * 8;
            const f32x4 a = *(const f32x4*)src, b = *(const f32x4*)(src + 4); const float sg = ks < 2 ? 1.0f : -1.0f;
            cf[ks][0] = (short)f2bf(a[0] * sg); cf[ks][1] = (short)f2bf(a[1] * sg); cf[ks][2] = (short)f2bf(a[2] * sg); cf[ks][3] = (short)f2bf(a[3] * sg);
            cf[ks][4] = (short)f2bf(b[0] * sg); cf[ks][5] = (short)f2bf(b[1] * sg); cf[ks][6] = (short)f2bf(b[2] * sg); cf[ks][7] = (short)f2bf(b[3] * sg); }
        const int chy = g * 16 + r16; const float dd = F.in[14][(size_t)l * 256 + chy];
        float pr = P.ar, pi = P.ai;
#pragma unroll
        for (int s = 0; s < 6; ++s) { const float nr = pr * pr - pi * pi, ni = 2.0f * pr * pi; pr = nr; pi = ni; }
        float hr = 0.f, hi = 0.f;
#pragma unroll 1
        for (int c2 = cb0; c2 < c; c2 += 16) {
            f32x2 e[16];
#pragma unroll
            for (int q = 0; q < 16; ++q) { const int cq = (c2 + q < c) ? c2 + q : c2; e[q] = *(const f32x2*)(F.E + (((size_t)cq * 16 + g) * 64 + lane_l) * 2); }
#pragma unroll
            for (int q = 0; q < 16; ++q) if (c2 + q < c) { const float nr = pr * hr - pi * hi + e[q][0], ni = pr * hi + pi * hr + e[q][1]; hr = nr; hi = ni; } }
#pragma unroll 1
        for (int tb = 0; tb < 4; ++tb) {
#pragma unroll 4
            for (int j = 0; j < 16; ++j) { s5_step(P, ubuf + (tb * 16 + j) * 256 + g * 16, hr, hi);
                hb[j * 136 + lane] = (unsigned short)f2bf(hr); hb[j * 136 + 64 + lane] = (unsigned short)f2bf(hi); }
            f32x4 acc = {0.f, 0.f, 0.f, 0.f};
#pragma unroll
            for (int ks = 0; ks < 4; ++ks) { const bf16x8_t a = *(const LAS bf16x8_t*)(hb + r16 * 136 + ks * 32 + quad * 8);
                acc = __builtin_amdgcn_mfma_f32_16x16x32_bf16(a, cf[ks], acc, 0, 0, 0); }
#pragma unroll
            for (int j = 0; j < 4; ++j) { const int tl = tb * 16 + quad * 4 + j; const float y = acc[j] + dd * ubuf[tl * 256 + chy];
                F.GL[(size_t)(t0 + tl) * 256 + chy] = (bf16_t)f2bf(gelu_tanh(y)); }
        }
    }
    __syncthreads();
}
template <int PART> __device__ __forceinline__ void m2_phase(Frame& F, int l, const XcdBarrier& xbar) {
    if (PART == 0 || PART == 1)
#pragma unroll 1
    for (int id = F.bx; id < 8 * RC_N * 2; id += F.G) { const int hb = id >> 6, c = (id >> 1) & (RC_N - 1), tk = id & 1; const size_t mo = ((size_t)hb * RC_N + c) * 4096;
        if (c == RC_N - 1) continue;
        const unsigned char* src = F.RW + ((size_t)hb * SEQ + (size_t)c * RC_LEN) * 896;
        scan_task<false>(F, src, nullptr, tk == 1, tk == 0, (tk == 0 ? F.LB : F.PB) + mo, nullptr); }
    if (PART == 0 || PART == 2)
#pragma unroll 1
    for (int c = F.bx; c < TT / 64; c += F.G) pool_conv_chunk(F, l, c);
    xcd_barrier(xbar);
    if (PART == 0 || PART == 3) { int bxs = F.bx; asm volatile("" : "+s"(bxs));
      if (bxs < 64) rwkv_carry(F);
      else conv_second_half(F, l, 64); }
    xcd_barrier(xbar);
    if (PART == 0 || PART == 4)
#pragma unroll 1
    for (int id = F.bx; id < 8 * RC_N; id += F.G) { const int hb = id >> 5, c = id & (RC_N - 1); const size_t mo = ((size_t)hb * RC_N + c) * 4096;
        const unsigned char* src = F.RW + ((size_t)hb * SEQ + (size_t)c * RC_LEN) * 896;
        float* Og = F.O + ((size_t)(hb >> 2) * SEQ + (size_t)c * RC_LEN) * 256 + (hb & 3) * 64;
        scan_task<true>(F, src, F.SB + mo, false, true, nullptr, Og); }
    if (PART == 0 || PART == 5)
#pragma unroll 1
    for (int c = F.bx; c < TT / 64; c += F.G) s5_pass2(F, l, c);
}
__device__ __forceinline__ void rwkv_post(Frame& F, int l) {
    const int gw = F.bx * NWAVES + F.wave, NGW = F.G * NWAVES, lane = F.lane;
    for (int it0 = gw * 4; it0 < TT * 4; it0 += NGW * 4) {
        const int t = it0 >> 2, b = t / SEQ, pos = t & (SEQ - 1);
        float o[4], r[4], k[4], v[4], g[4];
#pragma unroll
        for (int hh = 0; hh < 4; ++hh) { const int c = hh * 64 + lane; o[hh] = F.O[(size_t)t * 256 + c]; g[hh] = (float)F.G16[(size_t)t * 256 + c];
            const h16* rw = (const h16*)(F.RW + ((size_t)(b * 4 + hh) * SEQ + pos) * 896 + 256) + lane; r[hh] = (float)rw[0]; k[hh] = (float)rw[64]; v[hh] = (float)rw[128]; }
#pragma unroll
        for (int hh = 0; hh < 4; ++hh) { const int c = hh * 64 + lane;
            const float mu = wave_sum(o[hh]) * (1.0f / 64.0f); const float d = o[hh] - mu; const float var = wave_sum(d * d) * (1.0f / 64.0f);
            const float on = d * rsqrtf(var + 64e-5f) * F.in[31][(size_t)l * 256 + c] + F.in[32][(size_t)l * 256 + c];
            const float bs = wave_sum(r[hh] * k[hh] * F.in[30][(size_t)l * 256 + c]);
            F.B2[(size_t)t * 1024 + 512 + c] = (bf16_t)f2bf((on + bs * v[hh]) * g[hh]); }
    }
}

constexpr int NPH = 25;
#ifndef PHMASK
#define PHMASK 0xFFFF
#endif
#define PHON(k) (((PHMASK) >> (k)) & 1)
#ifndef REP_PART
#define REP_PART 0
#endif
template <int PH, int PART = 0> __device__ __forceinline__ void run_phase(const int wave_s, unsigned char* lds_raw, const XcdBarrier& xbar) {
    typedef pg8::StaticOrder SO;
    int tid = wave_s * 64 + (int)__builtin_amdgcn_mbcnt_hi(~0u, __builtin_amdgcn_mbcnt_lo(~0u, 0u)); asm volatile("" : "+v"(tid));
    int G = gridDim.x, bx = blockIdx.x; asm volatile("" : "+s"(G), "+s"(bx));
    const __attribute__((address_space(4))) unsigned char* ka = (const __attribute__((address_space(4))) unsigned char*)__builtin_amdgcn_kernarg_segment_ptr();
    asm volatile("" : "+s"(ka));
    const __attribute__((address_space(4))) Args* ap = (const __attribute__((address_space(4))) Args*)ka;
    Frame F;
    F.lds = (LAS unsigned char*)lds_raw;
    F.tid = tid; F.lane = tid & 63; F.wave = __builtin_amdgcn_readfirstlane(tid >> 6); F.G = G; F.bx = bx;
    F.in = (in_t)ka; F.X = ap->out; F.ws = ap->ws;
    unsigned char* ws = F.ws;
    F.SS = (float*)(ws + WS_SS); F.E = (float*)(ws + WS_E); F.B1 = (bf16_t*)(ws + WS_B1); F.B2 = (bf16_t*)(ws + WS_B2);
    unsigned char* z = ws + WS_Z;
    F.HID = (bf16_t*)(z + Z_HID); F.GL = (bf16_t*)(z + Z_GL); F.U5 = (h16*)(z + Z_U5); F.PP = (h16*)(z + Z_PP); F.L16 = (h16*)(z + Z_L16); F.G16 = (h16*)(z + Z_G16); F.R = (h16*)(z + Z_R);
    F.O = (float*)(z + Z_O); F.RW = z + Z_RW; F.PB = (float*)(z + Z_PB); F.LB = (float*)(z + Z_LB); F.SB = (float*)(z + Z_SB);
    if constexpr (PH == 0) { conv_first_half(F, 0); prep_x(F); }
    else { constexpr int l = (PH - 1) / 12, k = (PH - 1) % 12;
        if constexpr (k == 0) { pg8::Gemm g{F.B1, (const bf16_t*)(ws + WS_W + W_GU1), TT, 2 * FF, DM, 1}; SO S; S.init(TT, 2 * FF, G, bx); pg8::EpiGU E{F.HID, F.SS}; pg8::gemm_phase<pg8::EpiGU, SO, true, true>(F.lds, g, S, E, tid); }
        else if constexpr (k == 1) { pg8::Gemm g{F.HID, (const bf16_t*)(ws + WS_W + W_D1), TT, DM, FF, 1}; SO S; S.init(TT, DM, G, bx); pg8::EpiDown E{l == 0 ? F.in[0] : F.X, F.X, F.B1, F.SS, 0.5f}; pg8::gemm_phase<pg8::EpiDown, SO, true, true>(F.lds, g, S, E, tid); }
        else if constexpr (k == 2) { pg8::Gemm g{F.B1, (const bf16_t*)(ws + WS_W + W_INA), TT, 2560, DM, 1}; SO S; S.init(TT, 2560, G, bx); pg8::EpiInA E{F.U5, F.PP, F.L16, F.SS}; pg8::gemm_phase<pg8::EpiInA, SO, true, true>(F.lds, g, S, E, tid); }
        else if constexpr (k == 3) { m1_phase(F, l); }
        else if constexpr (k == 4) { m2_phase<PART>(F, l, xbar); }
        else if constexpr (k == 5) { { pg8::Gemm g{F.GL, (const bf16_t*)(ws + WS_W + W_GLU), TT, 256, 256, 1}; SO S; S.init(TT, 256, G, bx); pg8::EpiGlu E{F.GL, F.B2}; pg8::gemm_phase<pg8::EpiGlu, SO, true, true>(F.lds, g, S, E, tid); } rwkv_post(F, l); }
        else if constexpr (k == 6) { pg8::Gemm g{F.B1, (const bf16_t*)(ws + WS_W + W_ING), TT, 4096, DM, 1}; SO S; S.init(TT, 4096, G, bx); pg8::EpiGate E{F.R, F.SS}; pg8::gemm_phase<pg8::EpiGate, SO, true, true>(F.lds, g, S, E, tid); }
        else if constexpr (k == 7) { pg8::Gemm g{F.B2, (const bf16_t*)(ws + WS_W + W_BR), TT, DM, DM, 4}; pg8::SegOrder4 S; S.so.init(TT, DM, G, bx); pg8::EpiBranch E{F.R, F.B1}; pg8::gemm_phase<pg8::EpiBranch, pg8::SegOrder4, true, true>(F.lds, g, S, E, tid); }
        else if constexpr (k == 8) { pg8::Gemm g{F.B1, (const bf16_t*)(ws + WS_W + W_O), TT, DM, DM, 1}; SO S; S.init(TT, DM, G, bx); pg8::EpiDown E{F.X, F.X, F.B2, F.SS, 1.0f}; pg8::gemm_phase<pg8::EpiDown, SO, true, true>(F.lds, g, S, E, tid); }
        else if constexpr (k == 9) { pg8::Gemm g{F.B2, (const bf16_t*)(ws + WS_W + W_GU2), TT, 2 * FF, DM, 1}; SO S; S.init(TT, 2 * FF, G, bx); pg8::EpiGU E{F.HID, F.SS}; pg8::gemm_phase<pg8::EpiGU, SO, true, true>(F.lds, g, S, E, tid); }
        else if constexpr (k == 10) { pg8::Gemm g{F.HID, (const bf16_t*)(ws + WS_W + W_D2), TT, DM, FF, 1}; SO S; S.init(TT, DM, G, bx); pg8::EpiDown E{F.X, F.X, F.B1, F.SS, 0.5f}; pg8::gemm_phase<pg8::EpiDown, SO, true, true>(F.lds, g, S, E, tid); }
        else { if constexpr (l == 0) conv_first_half(F, 1); else final_norm(F); }
    }
}
#ifndef REPMASK
#define REPMASK 0
#endif
#define SEAM(k_) do { if ((k_) == 0) { __syncthreads(); cg::this_grid().sync(); } else xcd_barrier(xbar); } while (0)
#define PHASE(k) if (ph_lo <= (k) && (k) < ph_hi) { run_phase<(k)>(wave_s, lds_raw, xbar); \
    if ((k) >= 1 && ((REPMASK >> (((k) - 1) % 12)) & 1)) { SEAM(k); run_phase<(k), REP_PART>(wave_s, lds_raw, xbar); } \
    if ((k) + 1 < ph_hi) SEAM(k); }
__global__ void __launch_bounds__(NTHR, 2) mk_fwd(Args args) {
    extern __shared__ __attribute__((aligned(16))) unsigned char lds_raw[];
    const int ph_lo = args.ph_lo, ph_hi = args.ph_hi;
    volatile LAS unsigned* xst = (volatile LAS unsigned*)((LAS unsigned char*)lds_raw + (LDS_BYTES - 64));
    if (threadIdx.x == 0) { xst[0] = 0u; xst[1] = 0u; }
    __syncthreads();
    const XcdBarrier xbar = xcd_barrier_post((unsigned*)(args.ws + WS_CTL), xst);
    const int wave_s = __builtin_amdgcn_readfirstlane((int)threadIdx.x >> 6);
    PHASE(0) PHASE(1) PHASE(2) PHASE(3) PHASE(4) PHASE(5) PHASE(6) PHASE(7) PHASE(8) PHASE(9) PHASE(10) PHASE(11) PHASE(12)
    PHASE(13) PHASE(14) PHASE(15) PHASE(16) PHASE(17) PHASE(18) PHASE(19) PHASE(20) PHASE(21) PHASE(22) PHASE(23) PHASE(24)
}

extern "C" void kernel_launch(void* const* d_in, const int* in_sizes, int n_in, void* d_out, int out_size, void* d_ws, size_t ws_size, hipStream_t stream) {
    static int grid = 0;
    if (grid == 0) {
        if (n_in != 41 || out_size != TT * DM || ws_size < WS_END) { fprintf(stderr, "kernel_launch: unexpected shapes (n_in %d out %d ws %zu)\n", n_in, out_size, ws_size); grid = -1; return; }
        int dev = 0, cus = 0, per_cu = 0;
        (void)hipGetDevice(&dev); (void)hipDeviceGetAttribute(&cus, hipDeviceAttributeMultiprocessorCount, dev);
        if (hipFuncSetAttribute((const void*)mk_fwd, hipFuncAttributeMaxDynamicSharedMemorySize, LDS_BYTES) != hipSuccess) { fprintf(stderr, "kernel_launch: hipFuncSetAttribute failed\n"); grid = -1; return; }
        if (hipOccupancyMaxActiveBlocksPerMultiprocessor(&per_cu, (const void*)mk_fwd, NTHR, LDS_BYTES) != hipSuccess || per_cu < 1) { fprintf(stderr, "kernel_launch: occupancy query says %d\n", per_cu); per_cu = 1; }
        (void)hipGetLastError();
        grid = cus * (per_cu >= 1 ? 1 : 1);
        if (grid < 64) { fprintf(stderr, "kernel_launch: grid %d too small\n", grid); }
    }
    if (grid < 0) return;
    if (hipMemsetAsync((char*)d_ws + WS_CTL, 0, CTL_ZERO_BYTES, stream) != hipSuccess) { fprintf(stderr, "kernel_launch: hipMemsetAsync failed\n"); return; }
    Args a{};
    for (int i = 0; i < 41; ++i) a.in[i] = (const float*)d_in[i];
    a.out = (float*)d_out; a.ws = (unsigned char*)d_ws;
#if ONE_LAUNCH
    a.ph_lo = 0; a.ph_hi = NPH;
    void* kargs[] = {&a};
    hipError_t e = hipLaunchCooperativeKernel((const void*)mk_fwd, dim3(grid), dim3(NTHR), kargs, LDS_BYTES, stream);
    if (e != hipSuccess) fprintf(stderr, "cooperative launch failed: %s (grid %d)\n", hipGetErrorString(e), grid);
#else
    for (int ph = 0; ph < NPH; ++ph) { a.ph_lo = ph; a.ph_hi = ph + 1; hipLaunchKernelGGL(mk_fwd, dim3(grid), dim3(NTHR), LDS_BYTES, stream, a); }
#endif
}
```
